# Optimizing an MI355X kernel written in HIP

```python
import jax, jax.numpy as jnp
from jax import lax
import numpy as np

D_MODEL = 1024
BATCH = 1
SEQ = 16384
DEPTH = 2
DEC_BATCH = 32
DEC_SEQ = 1
PAST_LEN = 16384
PAGE_SIZE = 128

N_MIXERS = 4
W_GROUP = D_MODEL // N_MIXERS
D_MIX = N_MIXERS * W_GROUP
SC_WIDTH = 3
SSD_HEADS = 4
SSD_HEAD_DIM = W_GROUP // SSD_HEADS
SSD_GROUPS = 2
SSD_STATE = 128
SSD_CONV = 4
SSD_CHUNK = 128
SSD_CONV_DIM = W_GROUP + 2 * SSD_GROUPS * SSD_STATE
CF_WIDTH = 31
NSA_HEADS = 4
NSA_HEAD_DIM = W_GROUP // NSA_HEADS
CMP_STRIDE = 16
CMP_BLOCK = 2 * CMP_STRIDE
CMP_HIDDEN = 128
SEL_BLOCK = 64
SEL_TOPN = 16
SEL_LOCAL = 2
WINDOW = 512
Q_BLOCK = 128
KV_SLOTS = 4
NEG = -1e30
EPS = 1e-6

SPLITS = (W_GROUP, W_GROUP, W_GROUP, W_GROUP,
          W_GROUP, SSD_CONV_DIM, SSD_HEADS,
          2 * W_GROUP, W_GROUP,
          W_GROUP, 6 * NSA_HEAD_DIM, W_GROUP, 3 * NSA_HEADS)
D_IN = sum(SPLITS)

kernel_name = 'hymba_sconv_ssd_conformer_nsa_step'


def rmsnorm(x, g):
    x32 = x.astype(jnp.float32)
    y = x32 * lax.rsqrt(jnp.mean(x32 * x32, axis=-1, keepdims=True) + EPS)
    return y.astype(x.dtype) * g


def layernorm(x, g, b):
    x32 = x.astype(jnp.float32)
    mu = jnp.mean(x32, axis=-1, keepdims=True)
    var = jnp.mean(jnp.square(x32 - mu), axis=-1, keepdims=True)
    return ((x32 - mu) * lax.rsqrt(var + EPS)).astype(x.dtype) * g + b


def causal_dwconv(u, prev, w, b=None):
    full = jnp.concatenate([prev.astype(u.dtype), u], axis=1)
    y = lax.conv_general_dilated(full, w[:, None, :].astype(u.dtype), (1,), 'VALID',
                                 dimension_numbers=('NWC', 'WIO', 'NWC'),
                                 feature_group_count=u.shape[-1])
    if b is not None:
        y = y + b
    return y, full[:, full.shape[1] - (w.shape[0] - 1):]


def ssd_scan(x, dt, A, Bm, Cm, h0):
    f32 = jnp.float32
    n, l, hh, p = x.shape
    q = min(SSD_CHUNK, l)
    lp = -(-l // q) * q
    pad4 = ((0, 0), (0, lp - l), (0, 0), (0, 0))
    xf = jnp.pad(x.astype(f32), pad4)
    bf = jnp.pad(Bm.astype(f32), pad4)
    cf = jnp.pad(Cm.astype(f32), pad4)
    dtf = jnp.pad(dt, ((0, 0), (0, lp - l), (0, 0)))
    nc = lp // q
    xf = xf.reshape(n, nc, q, hh, p)
    bf = bf.reshape(n, nc, q, hh, -1)
    cf = cf.reshape(n, nc, q, hh, -1)
    dtf = dtf.reshape(n, nc, q, hh)
    acs = jnp.cumsum(jnp.moveaxis(dtf * A, 3, 1), axis=-1)
    causal = jnp.tril(jnp.ones((q, q), dtype=bool))
    decay = jnp.exp(jnp.where(causal, acs[..., :, None] - acs[..., None, :], -jnp.inf))
    xdt = xf * dtf[..., None]
    scores = jnp.einsum('nclhs,ncmhs->nhclm', cf, bf) * decay
    y_diag = jnp.einsum('nhclm,ncmhp->nclhp', scores, xdt)
    to_end = jnp.exp(acs[..., -1:] - acs)
    chunk_states = jnp.einsum('nclhs,nhcl,nclhp->nchps', bf, to_end, xdt)
    chunk_decay = jnp.exp(acs[..., -1])

    def step(h, inp):
        d, s = inp
        return d[:, :, None, None] * h + s, h

    h_fin, h_prev = lax.scan(step, h0.astype(f32),
                             (jnp.moveaxis(chunk_decay, 2, 0), jnp.moveaxis(chunk_states, 1, 0)))
    y_off = jnp.einsum('nclhs,cnhps,nhcl->nclhp', cf, h_prev, jnp.exp(acs))
    y = (y_diag + y_off).reshape(n, lp, hh, p)[:, :l]
    return y.astype(x.dtype), h_fin.astype(h0.dtype)


def masked_softmax(s, mask):
    p = jax.nn.softmax(jnp.where(mask, s, NEG), axis=-1)
    return jnp.where(mask, p, 0.0)


def compress_rows(rows, pe, w1, b1, w2, b2):
    n, s, d = rows.shape
    ch = rows.reshape(n, s // CMP_STRIDE, CMP_STRIDE, d)
    first = jnp.einsum('nmjd,jdf->nmf', ch, w1[:CMP_STRIDE])
    second = jnp.einsum('nmjd,jdf->nmf', ch, w1[CMP_STRIDE:])
    pe_term = jnp.einsum('jd,jdf->f', pe, w1)
    hid = jax.nn.silu(first[:, :-1] + second[:, 1:] + pe_term + b1)
    return hid @ w2 + b2


def compress_kv(k_raw, v_raw, lp):
    kc = compress_rows(k_raw, lp['cmp_pe'][0], lp['cmp_w1'][0], lp['cmp_b1'][0], lp['cmp_w2'][0], lp['cmp_b2'][0])
    vc = compress_rows(v_raw, lp['cmp_pe'][1], lp['cmp_w1'][1], lp['cmp_b1'][1], lp['cmp_w2'][1], lp['cmp_b2'][1])
    return rmsnorm(kc, lp['k_g'][0]), vc


def block_importance(pg, n_blocks):
    r = SEL_BLOCK // CMP_STRIDE
    nb = CMP_BLOCK // CMP_STRIDE - 1
    nc = pg.shape[-1]
    p = jnp.pad(pg, ((0, 0), (0, 0), (nb, r * n_blocks - nc)))
    total = None
    for o in range(-nb, r):
        w = (min(CMP_STRIDE * o + CMP_BLOCK, SEL_BLOCK) - max(CMP_STRIDE * o, 0)) / CMP_BLOCK
        start = o + nb
        term = w * p[..., start:start + r * (n_blocks - 1) + 1:r]
        total = term if total is None else total + term
    return total


def nsa_core(q, qpos, kc, vc, ks, vs, kw, vw, kpos, gates):
    n, tq = q.shape[:2]
    scale = NSA_HEAD_DIM ** -0.5
    nc = kc.shape[1]
    cvalid = (jnp.arange(nc) * CMP_STRIDE + CMP_BLOCK - 1)[None, :] <= qpos[:, None]
    s_c = jnp.einsum('nqhd,ncd->nqhc', q, kc).astype(jnp.float32) * scale
    p_c = masked_softmax(s_c, cvalid[None, :, None, :])
    o_c = jnp.einsum('nqhc,ncd->nqhd', p_c.astype(vc.dtype), vc)
    ns = ks.shape[1] // SEL_BLOCK
    p_sel = block_importance(p_c.sum(axis=2), ns)
    cur = qpos // SEL_BLOCK
    j = jnp.arange(ns)
    valid = j[None, :] <= cur[:, None]
    forced = valid & ((j[None, :] == 0) | (j[None, :] > cur[:, None] - SEL_LOCAL))
    score = jnp.where(forced, jnp.inf, jnp.where(valid, p_sel, -jnp.inf))
    n_sel = min(SEL_TOPN, ns)
    _, idx = lax.top_k(score, n_sel)
    tok = (idx[..., None] * SEL_BLOCK + jnp.arange(SEL_BLOCK)).reshape(n, tq, n_sel * SEL_BLOCK)
    ksel = jax.vmap(lambda k, t: k[t])(ks, tok)
    vsel = jax.vmap(lambda v, t: v[t])(vs, tok)
    smask = (tok <= qpos[None, :, None])[:, :, None, :]
    s_s = jnp.einsum('nqhd,nqkd->nqhk', q, ksel).astype(jnp.float32) * scale
    p_s = masked_softmax(s_s, smask)
    o_s = jnp.einsum('nqhk,nqkd->nqhd', p_s.astype(vsel.dtype), vsel)
    dpos = qpos[:, None] - kpos[None, :]
    wmask = (dpos >= 0) & (dpos <= WINDOW) & (kpos[None, :] >= 0)
    s_w = jnp.einsum('nqhd,nkd->nqhk', q, kw).astype(jnp.float32) * scale
    p_w = masked_softmax(s_w, wmask[None, :, None, :])
    o_w = jnp.einsum('nqhk,nkd->nqhd', p_w.astype(vw.dtype), vw)
    return gates[..., 0:1] * o_c + gates[..., 1:2] * o_s + gates[..., 2:3] * o_w


def attend_prompt(q, rows, win_rows, gates, lp):
    n, l = q.shape[:2]
    kc, vc = compress_kv(rows[:, :, 0], rows[:, :, 1], lp)
    ks, vs = rows[:, :, 2], rows[:, :, 3]
    kw_pad = jnp.pad(win_rows, ((0, 0), (WINDOW, 0), (0, 0), (0, 0)))

    def block(b):
        s0 = b * Q_BLOCK
        qb = lax.dynamic_slice_in_dim(q, s0, Q_BLOCK, axis=1)
        gb = lax.dynamic_slice_in_dim(gates, s0, Q_BLOCK, axis=1)
        kwb = lax.dynamic_slice_in_dim(kw_pad, s0, WINDOW + Q_BLOCK, axis=1)
        qpos = s0 + jnp.arange(Q_BLOCK)
        kpos = s0 - WINDOW + jnp.arange(WINDOW + Q_BLOCK)
        return nsa_core(qb, qpos, kc, vc, ks, vs, kwb[:, :, 0], kwb[:, :, 1], kpos, gb)

    o = lax.map(block, jnp.arange(l // Q_BLOCK))
    o = jnp.moveaxis(o, 0, 1).reshape(n, l, NSA_HEADS, NSA_HEAD_DIM)
    new_pages = rows.reshape(n * l // PAGE_SIZE, PAGE_SIZE, KV_SLOTS, NSA_HEAD_DIM)
    new_win = win_rows[:, l - min(WINDOW, l):]
    return o, (new_pages, new_win)


def make_attend_sample(cache_kv_l, cache_win_l, page_table):
    def attend(q, rows, win_rows, gates, lp):
        n, l = q.shape[:2]
        past = cache_kv_l[page_table].reshape(n, -1, KV_SLOTS, NSA_HEAD_DIM)
        p_len = past.shape[1]
        full = jnp.concatenate([past.astype(rows.dtype), rows], axis=1)
        t = p_len + l
        s = -(-t // SEL_BLOCK) * SEL_BLOCK
        full = jnp.pad(full, ((0, 0), (0, s - t), (0, 0), (0, 0)))
        kc, vc = compress_kv(full[:, :, 0], full[:, :, 1], lp)
        kw = jnp.concatenate([cache_win_l.astype(win_rows.dtype), win_rows], axis=1)
        wb = cache_win_l.shape[1]
        qpos = p_len + jnp.arange(l)
        kpos = p_len - wb + jnp.arange(wb + l)
        o = nsa_core(q, qpos, kc, vc, full[:, :, 2], full[:, :, 3], kw[:, :, 0], kw[:, :, 1], kpos, gates)
        return o, (rows, kw[:, l:])
    return attend


def trunk_layer(x, c, lp, prev_sc, prev_bconv, h0, prev_cf, attend):
    n, l, _ = x.shape
    ada = jax.nn.silu(c) @ lp['w_ada'] + lp['b_ada']
    shift, scale, ada_gate = jnp.split(ada, 3, axis=-1)
    h = rmsnorm(x, lp['norm_g']) * (1 + scale[:, None]) + shift[:, None]
    proj = h @ lp['w_in']
    offs = np.cumsum(SPLITS)[:-1].tolist()
    (a_h, a_b, a_c, a_g, b_z, b_xbc, b_dt, c_glu, c_g, d_q, d_kv, d_g, d_bg) = jnp.split(proj, offs, axis=-1)
    u_a, st_sc = causal_dwconv(a_c * a_h, prev_sc, lp['sc_w'])
    y_a = jax.nn.silu(a_g) * a_b * u_a
    xbc, st_bconv = causal_dwconv(b_xbc, prev_bconv, lp['ssd_conv_w'], lp['ssd_conv_b'])
    xbc = jax.nn.silu(xbc)
    xs, bs, cs = jnp.split(xbc, [W_GROUP, W_GROUP + SSD_GROUPS * SSD_STATE], axis=-1)
    rep = SSD_HEADS // SSD_GROUPS
    xs = xs.reshape(n, l, SSD_HEADS, SSD_HEAD_DIM)
    bs = jnp.repeat(bs.reshape(n, l, SSD_GROUPS, SSD_STATE), rep, axis=2)
    cs = jnp.repeat(cs.reshape(n, l, SSD_GROUPS, SSD_STATE), rep, axis=2)
    dt = jax.nn.softplus((b_dt + lp['ssd_dt_bias']).astype(jnp.float32))
    a_neg = -jnp.exp(lp['ssd_A_log'].astype(jnp.float32))
    y_ssd, st_h = ssd_scan(xs, dt, a_neg, bs, cs, h0)
    y_b = (y_ssd + lp['ssd_D'][:, None] * xs).reshape(n, l, W_GROUP)
    y_b = rmsnorm(y_b * jax.nn.silu(b_z), lp['ssd_norm_g'])
    glu_a, glu_b = jnp.split(c_glu, 2, axis=-1)
    u_c, st_cf = causal_dwconv(glu_a * jax.nn.sigmoid(glu_b), prev_cf, lp['cf_w'], lp['cf_b'])
    y_c = jax.nn.silu(c_g) * jax.nn.silu(layernorm(u_c, lp['cf_ln_g'], lp['cf_ln_b']))
    q = rmsnorm(d_q.reshape(n, l, NSA_HEADS, NSA_HEAD_DIM), lp['q_g'])
    kv = d_kv.reshape(n, l, 6, NSA_HEAD_DIM)
    k_slc = rmsnorm(kv[:, :, 2], lp['k_g'][1])
    k_win = rmsnorm(kv[:, :, 4], lp['k_g'][2])
    rows = jnp.stack([kv[:, :, 0], kv[:, :, 1], k_slc, kv[:, :, 3]], axis=2)
    win_rows = jnp.stack([k_win, kv[:, :, 5]], axis=2)
    gates = jax.nn.sigmoid(d_bg.reshape(n, l, NSA_HEADS, 3))
    o, st_attn = attend(q, rows, win_rows, gates, lp)
    y_d = jax.nn.silu(d_g) * o.reshape(n, l, W_GROUP)
    out = jnp.concatenate([y_a, y_b, y_c, y_d], axis=-1) @ lp['w_out']
    x = x + ada_gate[:, None] * out
    return x, st_attn + (st_sc, st_bconv, st_h, st_cf)


def setup_inputs(seed: int = 0) -> dict:
    key = jax.random.key(seed)
    keys = iter(jax.random.split(key, 48))
    f32 = jnp.float32

    def nrm(shape, s):
        return jax.random.normal(next(keys), shape, f32) * s

    n_pages = PAST_LEN // PAGE_SIZE
    n_pool = (5 * DEC_BATCH * n_pages) // 4
    win_buf = min(WINDOW, PAST_LEN)
    perm = jax.random.permutation(next(keys), n_pool)[:DEC_BATCH * n_pages]
    page_table = perm.reshape(DEC_BATCH, n_pages).astype(jnp.int32)
    dt_init = jnp.exp(jax.random.uniform(next(keys), (DEPTH, SSD_HEADS), f32, float(np.log(1e-3)), float(np.log(1e-1))))
    ssd_dt_bias = dt_init + jnp.log(-jnp.expm1(-dt_init))
    ssd_A_log = jnp.log(jax.random.uniform(next(keys), (DEPTH, SSD_HEADS), f32, 1.0, 16.0))
    return {
        'x_prompt': nrm((BATCH, SEQ, D_MODEL), 1.0),
        'x_sample': nrm((DEC_BATCH, DEC_SEQ, D_MODEL), 1.0),
        'cache_kv': nrm((DEPTH, n_pool, PAGE_SIZE, KV_SLOTS, NSA_HEAD_DIM), 1.0),
        'cache_win': nrm((DEPTH, DEC_BATCH, win_buf, 2, NSA_HEAD_DIM), 1.0),
        'state_sconv': nrm((DEPTH, DEC_BATCH, SC_WIDTH - 1, W_GROUP), 1.0),
        'state_ssm_conv': nrm((DEPTH, DEC_BATCH, SSD_CONV - 1, SSD_CONV_DIM), 1.0),
        'state_ssm': nrm((DEPTH, DEC_BATCH, SSD_HEADS, SSD_HEAD_DIM, SSD_STATE), 0.5),
        'state_cconv': nrm((DEPTH, DEC_BATCH, CF_WIDTH - 1, W_GROUP), 1.0),
        'page_table': page_table,
        'c_prompt': nrm((BATCH, D_MODEL), 1.0),
        'c_sample': nrm((DEC_BATCH, D_MODEL), 1.0),
        'norm_g': 1.0 + nrm((DEPTH, D_MODEL), 0.05),
        'w_ada': nrm((DEPTH, D_MODEL, 3 * D_MODEL), D_MODEL ** -0.5),
        'b_ada': nrm((DEPTH, 3 * D_MODEL), 0.02),
        'w_in': nrm((DEPTH, D_MODEL, D_IN), D_MODEL ** -0.5),
        'w_out': nrm((DEPTH, D_MIX, D_MODEL), D_MIX ** -0.5),
        'sc_w': nrm((DEPTH, SC_WIDTH, W_GROUP), SC_WIDTH ** -0.5),
        'ssd_conv_w': nrm((DEPTH, SSD_CONV, SSD_CONV_DIM), SSD_CONV ** -0.5),
        'ssd_conv_b': nrm((DEPTH, SSD_CONV_DIM), 0.02),
        'ssd_dt_bias': ssd_dt_bias,
        'ssd_A_log': ssd_A_log,
        'ssd_D': 1.0 + nrm((DEPTH, SSD_HEADS), 0.1),
        'ssd_norm_g': 1.0 + nrm((DEPTH, W_GROUP), 0.05),
        'cf_w': nrm((DEPTH, CF_WIDTH, W_GROUP), CF_WIDTH ** -0.5),
        'cf_b': nrm((DEPTH, W_GROUP), 0.02),
        'cf_ln_g': 1.0 + nrm((DEPTH, W_GROUP), 0.05),
        'cf_ln_b': nrm((DEPTH, W_GROUP), 0.02),
        'q_g': 1.0 + nrm((DEPTH, NSA_HEAD_DIM), 0.05),
        'k_g': 1.0 + nrm((DEPTH, 3, NSA_HEAD_DIM), 0.05),
        'cmp_pe': nrm((DEPTH, 2, CMP_BLOCK, NSA_HEAD_DIM), 0.1),
        'cmp_w1': nrm((DEPTH, 2, CMP_BLOCK, NSA_HEAD_DIM, CMP_HIDDEN), (CMP_BLOCK * NSA_HEAD_DIM) ** -0.5),
        'cmp_b1': nrm((DEPTH, 2, CMP_HIDDEN), 0.02),
        'cmp_w2': nrm((DEPTH, 2, CMP_HIDDEN, NSA_HEAD_DIM), CMP_HIDDEN ** -0.5),
        'cmp_b2': nrm((DEPTH, 2, NSA_HEAD_DIM), 0.02),
    }


def reference(x_prompt, x_sample, cache_kv, cache_win, state_sconv, state_ssm_conv, state_ssm, state_cconv,
              page_table, c_prompt, c_sample, norm_g, w_ada, b_ada, w_in, w_out, sc_w, ssd_conv_w, ssd_conv_b,
              ssd_dt_bias, ssd_A_log, ssd_D, ssd_norm_g, cf_w, cf_b, cf_ln_g, cf_ln_b, q_g, k_g,
              cmp_pe, cmp_w1, cmp_b1, cmp_w2, cmp_b2):
    nb = x_prompt.shape[0]
    dt = x_prompt.dtype
    z_sc = jnp.zeros((nb, SC_WIDTH - 1, W_GROUP), dt)
    z_bc = jnp.zeros((nb, SSD_CONV - 1, SSD_CONV_DIM), dt)
    z_h = jnp.zeros((nb, SSD_HEADS, SSD_HEAD_DIM, SSD_STATE), dt)
    z_cf = jnp.zeros((nb, CF_WIDTH - 1, W_GROUP), dt)
    yp, ys = x_prompt, x_sample
    acc_p, acc_s = [], []
    for l in range(DEPTH):
        lp = {'norm_g': norm_g[l], 'w_ada': w_ada[l], 'b_ada': b_ada[l], 'w_in': w_in[l], 'w_out': w_out[l],
              'sc_w': sc_w[l], 'ssd_conv_w': ssd_conv_w[l], 'ssd_conv_b': ssd_conv_b[l],
              'ssd_dt_bias': ssd_dt_bias[l], 'ssd_A_log': ssd_A_log[l], 'ssd_D': ssd_D[l],
              'ssd_norm_g': ssd_norm_g[l], 'cf_w': cf_w[l], 'cf_b': cf_b[l], 'cf_ln_g': cf_ln_g[l],
              'cf_ln_b': cf_ln_b[l], 'q_g': q_g[l], 'k_g': k_g[l], 'cmp_pe': cmp_pe[l], 'cmp_w1': cmp_w1[l],
              'cmp_b1': cmp_b1[l], 'cmp_w2': cmp_w2[l], 'cmp_b2': cmp_b2[l]}
        yp, st_p = trunk_layer(yp, c_prompt, lp, z_sc, z_bc, z_h, z_cf, attend_prompt)
        ys, st_s = trunk_layer(ys, c_sample, lp, state_sconv[l], state_ssm_conv[l], state_ssm[l], state_cconv[l],
                               make_attend_sample(cache_kv[l], cache_win[l], page_table))
        acc_p.append(st_p)
        acc_s.append(st_s)
    kv_p, win_p, sc_p, bc_p, h_p, cf_p = [jnp.stack(a) for a in zip(*acc_p)]
    kv_s, win_s, sc_s, bc_s, h_s, cf_s = [jnp.stack(a) for a in zip(*acc_s)]
    return (yp, ys, kv_p, kv_s, win_p, win_s, sc_p, sc_s, bc_p, bc_s, h_p, h_s, cf_p, cf_s)
```

```cpp
#include <hip/hip_runtime.h>
#include <cstdio>
#include <cstdint>

#ifndef N_LAUNCHES
#define N_LAUNCHES 1
#endif

#define DI __device__ __forceinline__
#define LAS __attribute__((address_space(3)))
typedef _Float16 f16;
typedef _Float16 f16x8 __attribute__((ext_vector_type(8)));
typedef _Float16 f16x4 __attribute__((ext_vector_type(4)));
typedef _Float16 f16x2 __attribute__((ext_vector_type(2)));
typedef float f32x4 __attribute__((ext_vector_type(4)));
typedef float f32x2 __attribute__((ext_vector_type(2)));
typedef float f32x16 __attribute__((ext_vector_type(16)));
typedef unsigned u32x4 __attribute__((ext_vector_type(4)));

constexpr int DM = 1024, SEQ = 16384, NB = 32, PAST = 16384, NPOOL = 5120, DIN = 3728, NPD = 3840;
constexpr float EPS = 1e-6f;
constexpr int NPHASE = 12;
enum { I_XP = 0, I_XS, I_CKV, I_CWIN, I_SSC, I_SBC, I_SSM, I_SCF, I_PT, I_CP, I_CS, I_NG, I_WADA, I_BADA, I_WIN, I_WOUT, I_SCW, I_BCW, I_BCB,
       I_DTB, I_ALOG, I_SD, I_SNG, I_CFW, I_CFB, I_LNG, I_LNB, I_QG, I_KG, I_PE, I_W1, I_B1, I_W2, I_B2, N_IN };
constexpr size_t O_YP = 0, O_YS = O_YP + (size_t)SEQ * DM, O_KVP = O_YS + NB * DM, O_KVS = O_KVP + (size_t)2 * SEQ * 256, O_WINP = O_KVS + 2 * NB * 256,
                 O_WINS = O_WINP + 2 * 512 * 128, O_SCP = O_WINS + (size_t)2 * NB * 512 * 128, O_SCS = O_SCP + 2 * 2 * 256, O_BCP = O_SCS + 2 * NB * 512,
                 O_BCS = O_BCP + 2 * 3 * 768, O_HP = O_BCS + 2 * NB * 2304, O_HS = O_HP + 2 * 32768, O_CFP = O_HS + (size_t)2 * NB * 32768,
                 O_CFS = O_CFP + 2 * 30 * 256, O_END = O_CFS + 2 * NB * 7680;
constexpr size_t al256(size_t x) { return (x + 255) & ~(size_t)255; }
constexpr size_t WS_CTL = 0, WS_ADA = 65536, WS_BIAS = WS_ADA + al256(2 * 33 * 3072 * 4), WS_PEB = WS_BIAS + al256(2 * NPD * 4), WS_WTIN = WS_PEB + 2048,
                 WS_WTOUT = WS_WTIN + (size_t)2 * NPD * 1024 * 2, WS_W1T = WS_WTOUT + (size_t)2 * 1024 * 1024 * 2, WS_A16 = WS_W1T + (size_t)4 * 128 * 2048 * 2,
                 WS_RSSP = WS_A16 + (size_t)SEQ * 1024 * 2, WS_X1 = WS_RSSP + (size_t)SEQ * 16 * 4, WS_PROJ = WS_X1 + (size_t)SEQ * 1024 * 4,
                 WS_Y16 = WS_PROJ + (size_t)15 * SEQ * 256 * 2, WS_ACT = WS_Y16 + (size_t)SEQ * 1024 * 2, WS_YD = WS_ACT + (size_t)SEQ * 768 * 2,
                 WS_CST = WS_YD + (size_t)SEQ * 256 * 4, WS_ACS = WS_CST + (size_t)128 * 32768 * 4, WS_CDEC = WS_ACS + (size_t)SEQ * 4 * 4, WS_Q16 = WS_CDEC + 2048,
                 WS_KS16 = WS_Q16 + (size_t)SEQ * 256 * 2, WS_VS16 = WS_KS16 + (size_t)SEQ * 64 * 2, WS_KW16 = WS_VS16 + (size_t)SEQ * 64 * 2,
                 WS_VW16 = WS_KW16 + (size_t)SEQ * 64 * 2, WS_GATES = WS_VW16 + (size_t)SEQ * 64 * 2, WS_KC = WS_GATES + (size_t)SEQ * 12 * 4,
                 WS_VC = WS_KC + 1024 * 64 * 4, WS_KCS = WS_VC + 1024 * 64 * 4, WS_VCS = WS_KCS + (size_t)2 * NB * 1024 * 64 * 4,
                 WS_PROJS = WS_VCS + (size_t)2 * NB * 1024 * 64 * 4, WS_YS = WS_PROJS + al256(NB * DIN * 4), WS_XS1 = WS_YS + NB * 1024 * 4, WS_GNX = WS_XS1 + NB * 1024 * 4, WS_NRG = WS_GNX + 4096, WS_END = WS_NRG + 2 * NB * 1024;
constexpr int LDS_BYTES = 147456;
constexpr int MISC_OFF = 147200;

struct Args { const void* in[N_IN]; float* out; unsigned char* ws; int ph_lo, ph_hi; };

#define XB_TMO      128
#define XB_XCNT(j)  (256  + 64 * (j))
#define XB_XSUB(j)  (1280 + 64 * (j))
#define XB_XGEN(j)  (2304 + 64 * (j))
#define XB_TOP      3328
#define XB_TOPGEN   3392
#define XCD_BAR_WORDS 3456
#define XB_SPIN_CAP (1u << 18)
__device__ __forceinline__ unsigned xb_ld(unsigned* p)              { return __hip_atomic_load(p, __ATOMIC_RELAXED, __HIP_MEMORY_SCOPE_AGENT); }
__device__ __forceinline__ unsigned xb_add(unsigned* p, unsigned v) { return __hip_atomic_fetch_add(p, v, __ATOMIC_RELAXED, __HIP_MEMORY_SCOPE_AGENT); }
__device__ __forceinline__ unsigned xb_xcc_id() { return (unsigned)__builtin_amdgcn_s_getreg((3 << 11) | 20) & 0xFu; }
#define XB_SPIN(cond, bar) do { unsigned _sp = 0; while (cond) { __builtin_amdgcn_s_sleep(1); \
    if ((++_sp & 255u) == 0u) { if (xb_ld(&(bar)[XB_TMO])) break; if (_sp > XB_SPIN_CAP) { atomicAdd(&(bar)[XB_TMO], 1u); break; } } } } while (0)
struct XcdBarrier { unsigned* bar; unsigned x; volatile LAS unsigned* st; };
__device__ __forceinline__ XcdBarrier xcd_barrier_post(unsigned* bar, volatile LAS unsigned* st) {
    XcdBarrier b; b.bar = bar; b.x = xb_xcc_id(); b.st = st;
    if (threadIdx.x == 0) (void)xb_add(&bar[XB_XCNT(b.x)], 1u);
    return b;
}
__device__ __forceinline__ void xcd_barrier_complete(unsigned* bar, unsigned x, unsigned& nloc, unsigned& nx) {
    const unsigned G = gridDim.x * gridDim.y * gridDim.z;
    unsigned sum, cnt, mine, sp = 0u;
    for (;;) {
        sum = 0u; cnt = 0u; mine = 0u;
#pragma unroll
        for (unsigned j = 0; j < 16; ++j) { const unsigned c = xb_ld(&bar[XB_XCNT(j)]); sum += c; cnt += (c > 0u) ? 1u : 0u; mine = (j == x) ? c : mine; }
        if (sum == G) break;
        __builtin_amdgcn_s_sleep(1);
        if ((++sp & 255u) == 0u) { if (xb_ld(&bar[XB_TMO])) break; if (sp > XB_SPIN_CAP) { atomicAdd(&bar[XB_TMO], 1u); break; } }
    }
    nloc = mine > 0u ? mine : 1u; nx = cnt > 0u ? cnt : 1u;
}
__device__ __forceinline__ void xcd_barrier(const XcdBarrier& b) {
    asm volatile("s_waitcnt vmcnt(0)" ::: "memory");
    __syncthreads();
    if (threadIdx.x == 0) {
        unsigned* bar = b.bar;
        __builtin_amdgcn_s_waitcnt(0);
        unsigned nloc = b.st[0], nx = b.st[1];
        if (nloc == 0u) { xcd_barrier_complete(bar, b.x, nloc, nx); b.st[0] = nloc; b.st[1] = nx; }
        const unsigned old = xb_add(&bar[XB_XSUB(b.x)], 1u);
        const unsigned gen = old / nloc;
        if (old + 1u == (gen + 1u) * nloc) {
            __builtin_amdgcn_fence(__ATOMIC_RELEASE, "agent");
            asm volatile("s_waitcnt vmcnt(0)" ::: "memory");
            const unsigned og = xb_add(&bar[XB_TOP], 1u);
            const unsigned tg = og / nx;
            if (og + 1u == (tg + 1u) * nx) xb_add(&bar[XB_TOPGEN], 1u);
            else XB_SPIN(xb_ld(&bar[XB_TOPGEN]) == tg, bar);
            __builtin_amdgcn_fence(__ATOMIC_ACQUIRE, "agent");
            xb_add(&bar[XB_XGEN(b.x)], 1u);
            asm volatile("s_waitcnt vmcnt(0)" ::: "memory");
        } else {
            XB_SPIN(xb_ld(&bar[XB_XGEN(b.x)]) == gen, bar);
            __builtin_amdgcn_fence(__ATOMIC_ACQUIRE, "agent");
            asm volatile("s_waitcnt vmcnt(0)" ::: "memory");
        }
    }
    __syncthreads();
}

DI int ltid() { int t = threadIdx.x; asm volatile("" : "+v"(t)); return t; }
DI float wsum(float v) { v += __shfl_xor(v, 32); v += __shfl_xor(v, 16); v += __shfl_xor(v, 8); v += __shfl_xor(v, 4); v += __shfl_xor(v, 2); v += __shfl_xor(v, 1); return v; }
DI float wmaxf(float v) { v = fmaxf(v, __shfl_xor(v, 32)); v = fmaxf(v, __shfl_xor(v, 16)); v = fmaxf(v, __shfl_xor(v, 8)); v = fmaxf(v, __shfl_xor(v, 4)); v = fmaxf(v, __shfl_xor(v, 2)); v = fmaxf(v, __shfl_xor(v, 1)); return v; }
DI float sigmoidf_(float x) { return 1.f / (1.f + __expf(-x)); }
DI float siluf_(float x) { return x / (1.f + __expf(-x)); }
DI float softplusf_(float x) { return fmaxf(x, 0.f) + log1pf(__expf(-fabsf(x))); }
DI f16x8 ld_h8(const f16* p) { return *(const f16x8*)p; }
DI f16x8 cvt_h8(const float* p) { const f32x4 a = *(const f32x4*)p, b = *(const f32x4*)(p + 4); f16x8 r; r[0] = (f16)a[0]; r[1] = (f16)a[1]; r[2] = (f16)a[2]; r[3] = (f16)a[3]; r[4] = (f16)b[0]; r[5] = (f16)b[1]; r[6] = (f16)b[2]; r[7] = (f16)b[3]; return r; }
DI int src_col(int n) { return n < 2048 ? n : (n < 3456 ? n + 4 : (n < 3460 ? n - 1408 : (n < 3472 ? n + 256 : (n < 3584 ? -1 : n - 124)))); }
DI int dst_col(int s) { return s < 2048 ? s : (s < 2052 ? s + 1408 : (s < 3460 ? s - 4 : (s < 3716 ? s + 124 : s - 256))); }

namespace pg8 {
constexpr int BM = 256, BK = 64, HALF = 128, HTB = HALF * BK * 2, STAGE_BYTES = 8 * HTB, NXCD = 8, WGM = 8;
DI int lds_byte(int r, int c) { const int st = (r >> 4) * 2 + (c >> 5), rr = r & 15, cc = c & 31, ob = rr * 64 + cc * 2; return st * 1024 + (ob ^ (((ob >> 9) & 1) << 5)); }
DI void stage_rc(int b, int& R, int& C) { const int st = b / 1024, sb = b % 1024, swz = sb ^ (((sb >> 9) & 1) << 5); R = (st >> 1) * 16 + swz / 64; C = (st & 1) * 32 + (swz % 64) / 2; }
DI int perm32(int rho) { const int n = rho >> 4, i = rho & 15; return 8 * (i >> 2) + 4 * n + (i & 3); }
struct Unit { int pm, pn; };
struct Gemm { const f16* A; const f16* Bt; int M, N, K; };
struct StaticOrder {
    int nM, nN, nwg, G, c;
    DI void init(int M, int N, int G_, int c_) { nM = M / BM; nN = N / BM; nwg = nM * nN; G = G_; c = c_; }
    DI bool next(int i, Unit& u) const {
        const long L = (long)i * G + c; if (L >= nwg) return false;
        int wgid = (int)L; { const int q = nwg / NXCD, r = nwg % NXCD, xcd = wgid % NXCD, off = wgid / NXCD; wgid = (xcd < r ? xcd * (q + 1) : r * (q + 1) + (xcd - r) * q) + off; }
        const int nig = WGM * nN, gid = wgid / nig, fm = gid * WGM, gsz = (nM - fm) < WGM ? (nM - fm) : WGM;
        u.pm = fm + ((wgid % nig) % gsz); u.pn = (wgid % nig) / gsz; return true;
    }
    DI void a_ready(const Unit&) const {}
    DI void done(const Unit&) const {}
};
template <class Epi, class Sched>
DI void gemm_phase(LAS unsigned char* lds, const Gemm g, const Sched& S, const Epi& E) {
    const int tid = ltid(), wid = __builtin_amdgcn_readfirstlane(tid >> 6), lane = tid & 63, wr = wid >> 2, wc = wid & 3, fr = lane & 15, fq = lane >> 4;
    const int K = g.K, nt = K / BK;
    unsigned voffA[2], voffB[2];
#pragma unroll
    for (int i = 0; i < 2; ++i) { int R, C; stage_rc(tid * 16 + i * 8192, R, C); const int Rb = Epi::PERM ? ((R & ~31) + perm32(R & 31)) : R;
        voffA[i] = (unsigned)(R * K + C) * 2u; voffB[i] = (unsigned)(Rb * K + C) * 2u; }
    const size_t kstep = (size_t)(BK * 2);
    const size_t hstep = (size_t)HALF * K * 2;
    const size_t tstep = 2 * hstep;
    const unsigned ldsw = (unsigned)wid * 1024u;
    const int aoff = lds_byte(wr * 64 + fr, fq * 8), boff = lds_byte(wc * 32 + fr, fq * 8);
#define PG8_SA(b, h) (((b) * 2 + (h)) * HTB)
#define PG8_SB(b, h) ((4 + (b) * 2 + (h)) * HTB)
#define PG8_STAGE(bufoff, gbase, voff) do { _Pragma("unroll") for (int _i = 0; _i < 2; ++_i) \
        __builtin_amdgcn_global_load_lds((const unsigned*)((const char*)(gbase) + (voff)[_i]), (LAS unsigned*)(lds + (bufoff) + ldsw + _i * 8192), 16, 0, 0); } while (0)
#define PG8_LDA(dst, b, h) do { _Pragma("unroll") for (int m = 0; m < 4; ++m) _Pragma("unroll") for (int k = 0; k < 2; ++k) dst[m][k] = *(const LAS f16x8*)(lds + PG8_SA(b, h) + aoff + m * 2048 + k * 1024); } while (0)
#define PG8_LDB(dst, b, h) do { _Pragma("unroll") for (int n = 0; n < 2; ++n) _Pragma("unroll") for (int k = 0; k < 2; ++k) dst[n][k] = *(const LAS f16x8*)(lds + PG8_SB(b, h) + boff + n * 2048 + k * 1024); } while (0)
#define PG8_MMA(ai, bj, At, Bt) do { __builtin_amdgcn_s_setprio(1); _Pragma("unroll") for (int m = 0; m < 4; ++m) _Pragma("unroll") for (int n = 0; n < 2; ++n) _Pragma("unroll") for (int k = 0; k < 2; ++k) \
        acc[ai][bj][m][n] = __builtin_amdgcn_mfma_f32_16x16x32_f16(Bt[n][k], At[m][k], acc[ai][bj][m][n], 0, 0, 0); __builtin_amdgcn_s_setprio(0); } while (0)
#define PG8_WAIT_V(n) asm volatile("s_waitcnt vmcnt(" #n ")" ::: "memory")
#define PG8_WAIT_L(n) asm volatile("s_waitcnt lgkmcnt(" #n ")" ::: "memory")
#define PG8_BAR __builtin_amdgcn_s_barrier()
#define PG8_SCHED __builtin_amdgcn_sched_barrier(0)
    Unit cur, nxt; int ui = 0;
    if (!S.next(0, cur)) return;
    f32x4 acc[2][2][4][2];
#pragma unroll
    for (int a = 0; a < 2; ++a)
#pragma unroll
        for (int b = 0; b < 2; ++b)
#pragma unroll
            for (int m = 0; m < 4; ++m)
#pragma unroll
                for (int n = 0; n < 2; ++n) acc[a][b][m][n] = (f32x4){0.f, 0.f, 0.f, 0.f};
    f16x8 At[4][2], B0[2][2], B1[2][2];
    const char* cA = (const char*)g.A + (size_t)cur.pm * tstep; const char* cB = (const char*)g.Bt + (size_t)cur.pn * tstep;
    S.a_ready(cur);
    PG8_STAGE(PG8_SB(0, 0), cB, voffB); PG8_STAGE(PG8_SA(0, 0), cA, voffA); PG8_STAGE(PG8_SB(0, 1), cB + hstep, voffB); PG8_STAGE(PG8_SA(0, 1), cA + hstep, voffA);
    if (wr == 1) PG8_BAR;
    PG8_WAIT_V(4); PG8_BAR;
    PG8_STAGE(PG8_SB(1, 0), cB + kstep, voffB); PG8_STAGE(PG8_SA(1, 0), cA + kstep, voffA); PG8_STAGE(PG8_SB(1, 1), cB + hstep + kstep, voffB);
    PG8_WAIT_V(6); PG8_BAR;
    for (;;) {
        const bool has_next = S.next(ui + 1, nxt);
        const char* nA = has_next ? (const char*)g.A + (size_t)nxt.pm * tstep : cA; const char* nB = has_next ? (const char*)g.Bt + (size_t)nxt.pn * tstep : cB;
        for (int t = 0; t < nt; t += 2) {
            const bool last = (t == nt - 2);
            const char* a1 = cA + (size_t)(t + 1) * kstep;
            const char* a2 = last ? nA : cA + (size_t)(t + 2) * kstep; const char* b2 = last ? nB : cB + (size_t)(t + 2) * kstep;
            const char* a3 = a2 + kstep; const char* b3 = b2 + kstep;
            if (last && has_next) S.a_ready(nxt);
            PG8_LDB(B0, 0, 0); PG8_SCHED; PG8_LDA(At, 0, 0); PG8_STAGE(PG8_SA(1, 1), a1 + hstep, voffA);
            PG8_WAIT_L(8); PG8_BAR; PG8_WAIT_L(0); PG8_MMA(0, 0, At, B0); PG8_BAR; PG8_SCHED;
            PG8_LDB(B1, 0, 1); PG8_STAGE(PG8_SB(0, 0), b2, voffB);
            PG8_BAR; PG8_WAIT_L(0); PG8_MMA(0, 1, At, B1); PG8_BAR;
            PG8_LDA(At, 0, 1); PG8_STAGE(PG8_SA(0, 0), a2, voffA);
            PG8_BAR; PG8_WAIT_L(0); PG8_MMA(1, 0, At, B0); PG8_BAR; PG8_SCHED;
            PG8_STAGE(PG8_SB(0, 1), b2 + hstep, voffB);
            PG8_WAIT_V(6); PG8_BAR; PG8_MMA(1, 1, At, B1); PG8_BAR;
            PG8_LDB(B0, 1, 0); PG8_SCHED; PG8_LDA(At, 1, 0); PG8_STAGE(PG8_SA(0, 1), a2 + hstep, voffA);
            PG8_WAIT_L(8); PG8_BAR; PG8_WAIT_L(0); PG8_MMA(0, 0, At, B0); PG8_BAR; PG8_SCHED;
            PG8_LDB(B1, 1, 1); PG8_STAGE(PG8_SB(1, 0), b3, voffB);
            PG8_BAR; PG8_WAIT_L(0); PG8_MMA(0, 1, At, B1); PG8_BAR;
            PG8_LDA(At, 1, 1); PG8_STAGE(PG8_SA(1, 0), a3, voffA);
            PG8_BAR; PG8_WAIT_L(0); PG8_MMA(1, 0, At, B0); PG8_BAR; PG8_SCHED;
            PG8_STAGE(PG8_SB(1, 1), b3 + hstep, voffB);
            PG8_WAIT_V(6); PG8_BAR; PG8_MMA(1, 1, At, B1); PG8_BAR;
        }
        E(acc, cur, wr, wc, fr, fq);
        if (!has_next) break;
#pragma unroll
        for (int a = 0; a < 2; ++a)
#pragma unroll
            for (int b = 0; b < 2; ++b)
#pragma unroll
                for (int m = 0; m < 4; ++m)
#pragma unroll
                    for (int n = 0; n < 2; ++n) acc[a][b][m][n] = (f32x4){0.f, 0.f, 0.f, 0.f};
        cur = nxt; cA = nA; cB = nB; ++ui;
    }
    PG8_WAIT_V(0);
    if (wr == 0) PG8_BAR;
    PG8_BAR;
#undef PG8_SA
#undef PG8_SB
#undef PG8_STAGE
#undef PG8_LDA
#undef PG8_LDB
#undef PG8_MMA
#undef PG8_WAIT_V
#undef PG8_WAIT_L
#undef PG8_BAR
#undef PG8_SCHED
}
}

struct EpiIn {
    static constexpr bool PERM = true;
    f16* proj; const float* rssp; const float* bias; float* kvout;
    DI void operator()(const f32x4 (&acc)[2][2][4][2], const pg8::Unit& u, int wr, int wc, int fr, int fq) const {
        const int row0 = u.pm * 256 + wr * 64 + fr, colt = wc * 32 + 8 * fq;
        f32x4 bv[2][2];
#pragma unroll
        for (int bj = 0; bj < 2; ++bj)
#pragma unroll
            for (int n = 0; n < 2; ++n) bv[bj][n] = *(const f32x4*)(bias + u.pn * 256 + colt + bj * 128 + 4 * n);
        f16* pt = proj + (size_t)u.pn * SEQ * 256;
#pragma unroll
        for (int ai = 0; ai < 2; ++ai)
#pragma unroll
            for (int m = 0; m < 4; ++m) {
                const int row = row0 + ai * 128 + m * 16;
                const f32x4* rp = (const f32x4*)(rssp + (size_t)row * 16);
                const f32x4 s0 = rp[0], s1 = rp[1], s2 = rp[2], s3 = rp[3];
                const float ss = ((s0[0] + s0[1]) + (s0[2] + s0[3])) + ((s1[0] + s1[1]) + (s1[2] + s1[3])) + ((s2[0] + s2[1]) + (s2[2] + s2[3])) + ((s3[0] + s3[1]) + (s3[2] + s3[3]));
                const float r = rsqrtf(ss * (1.f / 1024.f) + EPS);
#pragma unroll
                for (int bj = 0; bj < 2; ++bj) {
                    const f32x4 v0 = acc[ai][bj][m][0] * r + bv[bj][0], v1 = acc[ai][bj][m][1] * r + bv[bj][1];
                    f16x8 h; h[0] = (f16)v0[0]; h[1] = (f16)v0[1]; h[2] = (f16)v0[2]; h[3] = (f16)v0[3]; h[4] = (f16)v1[0]; h[5] = (f16)v1[1]; h[6] = (f16)v1[2]; h[7] = (f16)v1[3];
                    *(f16x8*)(pt + (size_t)row * 256 + colt + bj * 128) = h;
                    if (u.pn == 12) { float* kp = kvout + (size_t)row * 256 + colt + bj * 128; *(f32x4*)kp = v0; *(f32x4*)(kp + 4) = v1; }
                }
            }
    }
};
struct EpiOut {
    static constexpr bool PERM = false;
    const float* xin; float* xout; const float* gate; f16* a16; const float* gnext; float* rssp;
    DI void operator()(const f32x4 (&acc)[2][2][4][2], const pg8::Unit& u, int wr, int wc, int fr, int fq) const {
        const int row0 = u.pm * 256 + wr * 64 + fr, col0 = u.pn * 256 + wc * 32 + 4 * fq;
        float ss[2][4];
#pragma unroll
        for (int ai = 0; ai < 2; ++ai)
#pragma unroll
            for (int m = 0; m < 4; ++m) ss[ai][m] = 0.f;
#pragma unroll
        for (int bj = 0; bj < 2; ++bj)
#pragma unroll
            for (int n = 0; n < 2; ++n) {
                const int col = col0 + bj * 128 + n * 16;
                const f32x4 gv = *(const f32x4*)(gate + col); f32x4 gn = (f32x4){0.f, 0.f, 0.f, 0.f}; if (a16) gn = *(const f32x4*)(gnext + col);
#pragma unroll
                for (int ai = 0; ai < 2; ++ai)
#pragma unroll
                    for (int m = 0; m < 4; ++m) {
                        const int row = row0 + ai * 128 + m * 16;
                        const f32x4 xv = *(const f32x4*)(xin + (size_t)row * 1024 + col);
                        const f32x4 o = xv + gv * acc[ai][bj][m][n];
                        *(f32x4*)(xout + (size_t)row * 1024 + col) = o;
                        ss[ai][m] += (o[0] * o[0] + o[1] * o[1]) + (o[2] * o[2] + o[3] * o[3]);
                        if (a16) { f16x4 h; h[0] = (f16)(o[0] * gn[0]); h[1] = (f16)(o[1] * gn[1]); h[2] = (f16)(o[2] * gn[2]); h[3] = (f16)(o[3] * gn[3]);
                            *(f16x4*)(a16 + (size_t)row * 1024 + col) = h; }
                    }
                asm volatile("" ::: "memory");
            }
        if (a16) {
#pragma unroll
            for (int ai = 0; ai < 2; ++ai)
#pragma unroll
                for (int m = 0; m < 4; ++m) { float v = ss[ai][m]; v += __shfl_xor(v, 16); v += __shfl_xor(v, 32);
                    if (fq == 0) rssp[(size_t)(row0 + ai * 128 + m * 16) * 16 + u.pn * 4 + wc] = v; }
        }
    }
};

template <int MP  , class AFn, class OFn>
DI void skinny_item(LAS unsigned char* lds, const float* W, int ldw, int n0, int ncols, int M, AFn afn, OFn ofn) {
    const int tid = ltid(), wave = tid >> 6, lane = tid & 63;
    LAS float* As = (LAS float*)lds;
    float acc[MP];
#pragma unroll
    for (int m = 0; m < MP; ++m) acc[m] = 0.f;
    for (int kc = 0; kc < 1024; kc += 512) {
        __syncthreads();
#pragma nounroll
        for (int m = 0; m < MP; ++m) As[tid * 36 + m] = (m < M) ? afn(m, kc + tid) : 0.f;
        __syncthreads();
        const int kb = wave * 64;
#pragma unroll 4
        for (int kk = 0; kk < 64; ++kk) {
            const float w = (lane < ncols) ? W[(size_t)(kc + kb + kk) * ldw + n0 + lane] : 0.f;
#pragma unroll
            for (int m4 = 0; m4 < MP / 4; ++m4) { const f32x4 a = *(const LAS f32x4*)(As + (kb + kk) * 36 + m4 * 4);
                acc[m4 * 4 + 0] += a[0] * w; acc[m4 * 4 + 1] += a[1] * w; acc[m4 * 4 + 2] += a[2] * w; acc[m4 * 4 + 3] += a[3] * w; }
        }
    }
    __syncthreads();
    LAS float* R = (LAS float*)lds;
#pragma unroll
    for (int m = 0; m < MP; ++m) R[(wave * 36 + m) * 64 + lane] = acc[m];
    __syncthreads();
    for (int idx = tid; idx < M * 64; idx += 512) { const int m = idx >> 6, c = idx & 63; float s = 0.f;
#pragma unroll
        for (int w = 0; w < 8; ++w) s += R[(w * 36 + m) * 64 + c];
        if (c < ncols) ofn(m, n0 + c, s); }
    __syncthreads();
}

template <bool SRC_F32, class RowFn>
DI void compress_item(LAS unsigned char* lds, RowFn rowp, int i0, int maxtok, const f16* w1t, const float* peb, const float* w2, const float* b2, const float* kg, float* out) {
    const int tid = ltid(), wave = tid >> 6, lane = tid & 63, wn = wave & 3, wk = wave >> 2, r = lane & 31, h = lane >> 5;
    f32x16 acc;
#pragma unroll
    for (int i = 0; i < 16; ++i) acc[i] = 0.f;
    const f16* wrow = w1t + (size_t)(32 * wn + r) * 2048 + (size_t)wk * 1024 + 8 * h;
    for (int j = 0; j < 16; ++j) {
        int tok = 16 * (i0 + r) + wk * 16 + j; tok = tok < maxtok ? tok : maxtok;
        const void* rp = rowp(tok);
#pragma unroll
        for (int ds = 0; ds < 4; ++ds) {
            const int d = ds * 16 + 8 * h;
            f16x8 a; if (SRC_F32) a = cvt_h8((const float*)rp + d); else a = ld_h8((const f16*)rp + d);
            const f16x8 b = ld_h8(wrow + j * 64 + ds * 16);
            acc = __builtin_amdgcn_mfma_f32_32x32x16_f16(a, b, acc, 0, 0, 0);
        }
    }
    LAS float* RED = (LAS float*)lds;
    __syncthreads();
#pragma unroll
    for (int i = 0; i < 16; ++i) { const int row = (i & 3) + 8 * (i >> 2) + 4 * h; RED[(wk * 32 + row) * 128 + 32 * wn + r] = acc[i]; }
    __syncthreads();
    for (int e = tid; e < 4096; e += 512) { const float v = RED[e] + RED[4096 + e] + peb[e & 127]; RED[e] = siluf_(v); }
    __syncthreads();
    {
        const int row = tid >> 4, e4 = (tid & 15) * 4;
        f32x4 o = *(const f32x4*)(b2 + e4);
#pragma unroll 8
        for (int f = 0; f < 128; ++f) { const float hv = RED[row * 128 + f]; const f32x4 w = *(const f32x4*)(w2 + f * 64 + e4); o += hv * w; }
        if (kg) { float ss = (o[0] * o[0] + o[1] * o[1]) + (o[2] * o[2] + o[3] * o[3]); ss += __shfl_xor(ss, 1); ss += __shfl_xor(ss, 2); ss += __shfl_xor(ss, 4); ss += __shfl_xor(ss, 8);
            const float rn = rsqrtf(ss * (1.f / 64.f) + EPS); const f32x4 g = *(const f32x4*)(kg + e4); o = o * rn * g; }
        if (i0 + row < 1023) *(f32x4*)(out + (size_t)(i0 + row) * 64 + e4) = o;
    }
    __syncthreads();
}

struct PromptKV {
    const f16 *ks, *vs, *kw, *vw;
    DI void krow_sel(int pos, float (&k)[64]) const { const f16* p = ks + (size_t)pos * 64;
#pragma unroll
        for (int i = 0; i < 8; ++i) { const f16x8 v = ld_h8(p + i * 8);
#pragma unroll
            for (int j = 0; j < 8; ++j) k[i * 8 + j] = (float)v[j]; } }
    DI float v_sel(int pos, int d) const { return (float)vs[(size_t)pos * 64 + d]; }
    DI void krow_win(int pos, float (&k)[64]) const { const f16* p = kw + (size_t)pos * 64;
#pragma unroll
        for (int i = 0; i < 8; ++i) { const f16x8 v = ld_h8(p + i * 8);
#pragma unroll
            for (int j = 0; j < 8; ++j) k[i * 8 + j] = (float)v[j]; } }
    DI float v_win(int pos, int d) const { return (float)vw[(size_t)pos * 64 + d]; }
};
struct SampleKV {
    const float* ckv; const int* pt; const float* cwin; const float* nks; const float* nvs; const float* nkw; const float* nvw;
    DI const float* prow(int pos, int slot) const { return ckv + ((size_t)pt[pos >> 7] * 128 + (pos & 127)) * 256 + slot * 64; }
    DI void ld64(const float* p, float (&k)[64]) const {
#pragma unroll
        for (int i = 0; i < 16; ++i) { const f32x4 v = *(const f32x4*)(p + i * 4); k[i * 4] = v[0]; k[i * 4 + 1] = v[1]; k[i * 4 + 2] = v[2]; k[i * 4 + 3] = v[3]; } }
    DI void krow_sel(int pos, float (&k)[64]) const { ld64(pos < PAST ? prow(pos, 2) : nks, k); }
    DI float v_sel(int pos, int d) const { return pos < PAST ? prow(pos, 3)[d] : nvs[d]; }
    DI void krow_win(int pos, float (&k)[64]) const { ld64(pos < PAST ? cwin + (size_t)(pos - (PAST - 512)) * 128 : nkw, k); }
    DI float v_win(int pos, int d) const { return pos < PAST ? cwin[(size_t)(pos - (PAST - 512)) * 128 + 64 + d] : nvw[d]; }
};
template <class KV>
DI void nsa_token(LAS float* wl, int qpos, const float* KC, const float* VC, const KV& kv, const float* gates  , float (&o)[4]) {
    const int lane = ltid() & 63;
    LAS float* sc = wl; LAS float* qs = wl + 4096; LAS int* sel = (LAS int*)(wl + 4096 + 256);
    const int cur = qpos >> 6;
    const int ncv = qpos >= 31 ? ((qpos - 31) >> 4) + 1 : 0;
    float oc[4] = {0.f, 0.f, 0.f, 0.f}, os[4] = {0.f, 0.f, 0.f, 0.f}, ow[4] = {0.f, 0.f, 0.f, 0.f};
    {
        float mx[4] = {-3e38f, -3e38f, -3e38f, -3e38f};
        for (int c = lane; c < ncv; c += 64) {
            asm volatile("" ::: "memory");
            float s[4] = {0.f, 0.f, 0.f, 0.f}; const float* kp = KC + (size_t)c * 64;
#pragma unroll
            for (int d4 = 0; d4 < 16; ++d4) { const f32x4 kvv = *(const f32x4*)(kp + d4 * 4);
#pragma unroll
                for (int j = 0; j < 4; ++j) { const f32x4 q = *(const LAS f32x4*)(qs + (d4 * 4 + j) * 4); s[0] += q[0] * kvv[j]; s[1] += q[1] * kvv[j]; s[2] += q[2] * kvv[j]; s[3] += q[3] * kvv[j]; } }
#pragma unroll
            for (int hh = 0; hh < 4; ++hh) { s[hh] *= 0.125f; sc[hh * 1024 + c] = s[hh]; mx[hh] = fmaxf(mx[hh], s[hh]); }
        }
        float inv[4];
#pragma unroll
        for (int hh = 0; hh < 4; ++hh) { mx[hh] = wmaxf(mx[hh]); float sm = 0.f; for (int c = lane; c < ncv; c += 64) { const float e = __expf(sc[hh * 1024 + c] - mx[hh]); sc[hh * 1024 + c] = e; sm += e; } sm = wsum(sm); inv[hh] = ncv > 0 ? 1.f / sm : 0.f; }
        for (int c = lane; c < ncv; c += 64) {
#pragma unroll
            for (int hh = 0; hh < 4; ++hh) sc[hh * 1024 + c] *= inv[hh]; }
        __builtin_amdgcn_wave_barrier();
        for (int c = 0; c < ncv; ++c) { const float v = VC[(size_t)c * 64 + lane];
#pragma unroll
            for (int hh = 0; hh < 4; ++hh) oc[hh] += sc[hh * 1024 + c] * v; }
    }
    const int nsel = (cur + 1) < 16 ? (cur + 1) : 16;
    {
        float scv[5];
#pragma unroll
        for (int i = 0; i < 5; ++i) {
            const int j = lane + 64 * i; float v = -3e38f;
            if (j <= cur) {
                if (j == 0 || j == cur || j == cur - 1) v = 3e38f;
                else { float a = 0.f;
#pragma unroll
                    for (int o5 = -1; o5 < 4; ++o5) { const int c = 4 * j + o5; if (c >= 0 && c < ncv) { const float p = (sc[c] + sc[1024 + c]) + (sc[2048 + c] + sc[3072 + c]); a += (o5 == -1 || o5 == 3) ? 0.5f * p : p; } }
                    v = a; }
            }
            scv[i] = v;
        }
        for (int k = 0; k < nsel; ++k) {
            float bv = scv[0]; int bi = lane;
#pragma unroll
            for (int i = 1; i < 5; ++i) if (scv[i] > bv) { bv = scv[i]; bi = lane + 64 * i; }
#pragma unroll
            for (int off = 32; off > 0; off >>= 1) { const float ov = __shfl_xor(bv, off); const int oi = __shfl_xor(bi, off); if (ov > bv || (ov == bv && oi < bi)) { bv = ov; bi = oi; } }
            if (lane == 0) sel[k] = bi;
#pragma unroll
            for (int i = 0; i < 5; ++i) if (lane + 64 * i == bi) scv[i] = -3e38f;
        }
        __builtin_amdgcn_wave_barrier();
    }
    {
        float mx[4] = {-3e38f, -3e38f, -3e38f, -3e38f};
        for (int k = 0; k < nsel; ++k) {
            asm volatile("" ::: "memory");
            const int pos = sel[k] * 64 + lane; float s[4] = {-1e30f, -1e30f, -1e30f, -1e30f};
            if (pos <= qpos) { float kr[64]; kv.krow_sel(pos, kr); s[0] = s[1] = s[2] = s[3] = 0.f;
#pragma unroll
                for (int d = 0; d < 64; ++d) { const f32x4 q = *(const LAS f32x4*)(qs + d * 4); s[0] += q[0] * kr[d]; s[1] += q[1] * kr[d]; s[2] += q[2] * kr[d]; s[3] += q[3] * kr[d]; }
#pragma unroll
                for (int hh = 0; hh < 4; ++hh) s[hh] *= 0.125f; }
#pragma unroll
            for (int hh = 0; hh < 4; ++hh) { sc[hh * 1024 + k * 64 + lane] = s[hh]; mx[hh] = fmaxf(mx[hh], s[hh]); }
        }
        float inv[4];
#pragma unroll
        for (int hh = 0; hh < 4; ++hh) { mx[hh] = wmaxf(mx[hh]); float sm = 0.f; for (int k = 0; k < nsel; ++k) { const float sv = sc[hh * 1024 + k * 64 + lane]; const float e = sv > -1e29f ? __expf(sv - mx[hh]) : 0.f; sc[hh * 1024 + k * 64 + lane] = e; sm += e; } sm = wsum(sm); inv[hh] = 1.f / sm; }
        __builtin_amdgcn_wave_barrier();
        for (int k = 0; k < nsel; ++k) { const int p0 = sel[k] * 64; int nk = qpos - p0 + 1; nk = nk > 64 ? 64 : nk;
            for (int kk = 0; kk < nk; ++kk) { const float v = kv.v_sel(p0 + kk, lane);
#pragma unroll
                for (int hh = 0; hh < 4; ++hh) os[hh] += sc[hh * 1024 + k * 64 + kk] * v; } }
#pragma unroll
        for (int hh = 0; hh < 4; ++hh) os[hh] *= inv[hh];
        __builtin_amdgcn_wave_barrier();
    }
    {
        const int lo = qpos - 512 > 0 ? qpos - 512 : 0, nw = qpos - lo + 1;
        float mx[4] = {-3e38f, -3e38f, -3e38f, -3e38f};
        for (int i = lane; i < nw; i += 64) { asm volatile("" ::: "memory"); float kr[64]; kv.krow_win(lo + i, kr); float s[4] = {0.f, 0.f, 0.f, 0.f};
#pragma unroll
            for (int d = 0; d < 64; ++d) { const f32x4 q = *(const LAS f32x4*)(qs + d * 4); s[0] += q[0] * kr[d]; s[1] += q[1] * kr[d]; s[2] += q[2] * kr[d]; s[3] += q[3] * kr[d]; }
#pragma unroll
            for (int hh = 0; hh < 4; ++hh) { s[hh] *= 0.125f; sc[hh * 1024 + i] = s[hh]; mx[hh] = fmaxf(mx[hh], s[hh]); } }
        float inv[4];
#pragma unroll
        for (int hh = 0; hh < 4; ++hh) { mx[hh] = wmaxf(mx[hh]); float sm = 0.f; for (int i = lane; i < nw; i += 64) { const float e = __expf(sc[hh * 1024 + i] - mx[hh]); sc[hh * 1024 + i] = e; sm += e; } sm = wsum(sm); inv[hh] = 1.f / sm; }
        __builtin_amdgcn_wave_barrier();
        for (int i = 0; i < nw; ++i) { const float v = kv.v_win(lo + i, lane);
#pragma unroll
            for (int hh = 0; hh < 4; ++hh) ow[hh] += sc[hh * 1024 + i] * v; }
#pragma unroll
        for (int hh = 0; hh < 4; ++hh) ow[hh] *= inv[hh];
        __builtin_amdgcn_wave_barrier();
    }
#pragma unroll
    for (int hh = 0; hh < 4; ++hh) o[hh] = gates[hh * 3] * oc[hh] + gates[hh * 3 + 1] * os[hh] + gates[hh * 3 + 2] * ow[hh];
}

template <class LF, class SF>
DI void tr64(LAS unsigned char* lds, LF lf, SF sf) {
    LAS float* T = (LAS float*)lds;
    const int tid = ltid();
    __syncthreads();
    for (int e = tid; e < 4096; e += 512) { const int kk = e >> 6, nn = e & 63; T[kk * 65 + nn] = lf(kk, nn); }
    __syncthreads();
    for (int e = tid; e < 4096; e += 512) { const int nn = e >> 6, kk = e & 63; sf(nn, kk, (f16)T[kk * 65 + nn]); }
}

typedef const Args __attribute__((address_space(4)))* ArgP;
struct Ctx { ArgP ap; LAS unsigned char* lds; unsigned char* ws; float* out; int tid, lane, wave, bid, G; };
DI Ctx mkctx(LAS unsigned char* lds) {
    Ctx c; const char __attribute__((address_space(4)))* kp = (const char __attribute__((address_space(4)))*)__builtin_amdgcn_kernarg_segment_ptr();
    asm volatile("" : "+s"(kp));
    c.ap = (ArgP)kp; c.lds = lds; c.ws = c.ap->ws; c.out = c.ap->out;
    int tid = threadIdx.x; asm volatile("" : "+v"(tid));
    c.tid = tid; c.lane = tid & 63; c.wave = __builtin_amdgcn_readfirstlane(tid >> 6); c.bid = blockIdx.x; c.G = gridDim.x;
    return c;
}
#define INP(i) ((const float*)c.ap->in[i])
#define WSF(off) ((float*)(c.ws + (off)))
#define WSH(off) ((f16*)(c.ws + (off)))

DI void ph_prologue(LAS unsigned char* lds_) {
    const Ctx c = mkctx(lds_); LAS unsigned char* lds = c.lds; const int tid = c.tid, bid = c.bid, G = c.G;
    const float* c_p = INP(I_CP); const float* c_s = INP(I_CS); const float* w_ada = INP(I_WADA); const float* b_ada = INP(I_BADA);
    const float* w_in = INP(I_WIN); const float* w_out = INP(I_WOUT); const float* w1 = INP(I_W1);
    float* ADA = WSF(WS_ADA); float* BIAS = WSF(WS_BIAS); float* PEB = WSF(WS_PEB); f16* WTIN = WSH(WS_WTIN); f16* WTOUT = WSH(WS_WTOUT); f16* W1T = WSH(WS_W1T);
    constexpr int N_ADA = 96, N_WTIN = 1920, N_WTOUT = 512, N_W1T = 256, N_PEB = 4, N_ALL = N_ADA + N_WTIN + N_WTOUT + N_W1T + N_PEB + 1;
    for (int it = bid; it < N_ALL; it += G) {
        int i = it;
        if (i < N_ADA) { const int l = i / 48, n0 = (i % 48) * 64;
            skinny_item<36>(lds, w_ada + (size_t)l * 1024 * 3072, 3072, n0, 64, 33,
                [&](int m, int k) { return siluf_(m < 32 ? c_s[m * 1024 + k] : c_p[k]); },
                [&](int m, int n, float v) { ADA[((size_t)l * 33 + m) * 3072 + n] = v + b_ada[l * 3072 + n]; });
            continue; }
        i -= N_ADA;
        if (i < N_WTIN) { const int l = i / 960, r = i % 960, n0 = (r / 16) * 64, k0 = (r % 16) * 64; const float* src = w_in + (size_t)l * 1024 * DIN; f16* dst = WTIN + (size_t)l * NPD * 1024;
            tr64(lds, [&](int kk, int nn) { const int sc = src_col(n0 + nn); return sc >= 0 ? src[(size_t)(k0 + kk) * DIN + sc] : 0.f; },
                      [&](int nn, int kk, f16 v) { dst[(size_t)(n0 + nn) * 1024 + k0 + kk] = v; });
            continue; }
        i -= N_WTIN;
        if (i < N_WTOUT) { const int l = i / 256, r = i % 256, n0 = (r / 16) * 64, k0 = (r % 16) * 64; const float* src = w_out + (size_t)l * 1024 * 1024; f16* dst = WTOUT + (size_t)l * 1024 * 1024;
            tr64(lds, [&](int kk, int nn) { return src[(size_t)(k0 + kk) * 1024 + n0 + nn]; },
                      [&](int nn, int kk, f16 v) { dst[(size_t)(n0 + nn) * 1024 + k0 + kk] = v; });
            continue; }
        i -= N_WTOUT;
        if (i < N_W1T) { const int ls = i / 64, r = i % 64, k0 = (r / 2) * 64, n0 = (r % 2) * 64; const float* src = w1 + (size_t)ls * 2048 * 128; f16* dst = W1T + (size_t)ls * 128 * 2048;
            tr64(lds, [&](int kk, int nn) { return src[(size_t)(k0 + kk) * 128 + n0 + nn]; },
                      [&](int nn, int kk, f16 v) { dst[(size_t)(n0 + nn) * 2048 + k0 + kk] = v; });
            continue; }
        i -= N_W1T;
        if (i < N_PEB) { const float* pe = INP(I_PE) + (size_t)i * 2048; const float* w = w1 + (size_t)i * 2048 * 128; const float* b1 = INP(I_B1) + i * 128;
            LAS float* R = (LAS float*)lds; const int f = tid & 127, kq = tid >> 7; float sacc = 0.f;
            __syncthreads();
            for (int k = kq * 512; k < kq * 512 + 512; ++k) sacc += pe[k] * w[(size_t)k * 128 + f];
            R[kq * 128 + f] = sacc; __syncthreads();
            if (tid < 128) PEB[i * 128 + tid] = b1[tid] + (R[tid] + R[128 + tid]) + (R[256 + tid] + R[384 + tid]);
            __syncthreads();
            continue; }
        for (int e = tid; e < 2 * NPD; e += 512) BIAS[e] = 0.f;
    }
}

DI void ph_sample_compress(LAS unsigned char* lds_) {
    const Ctx c = mkctx(lds_);
    const float* w2 = INP(I_W2); const float* b2 = INP(I_B2); const float* k_g = INP(I_KG); const float* cache_kv = INP(I_CKV); const int* page_table = (const int*)c.ap->in[I_PT];
    f16* W1T = WSH(WS_W1T); float* PEB = WSF(WS_PEB); float* KCS = WSF(WS_KCS); float* VCS = WSF(WS_VCS);
    for (int it = c.bid; it < 4096; it += c.G) {
        const int grp = it & 31, slot = (it >> 5) & 1, b = (it >> 6) & 31, l = it >> 11;
        const float* ckv = cache_kv + (size_t)l * NPOOL * 128 * 256; const int* pt = page_table + b * 128;
        compress_item<true>(c.lds, [&](int tok) { return (const void*)(ckv + ((size_t)pt[tok >> 7] * 128 + (tok & 127)) * 256 + slot * 64); }, grp * 32, PAST - 1,
                            W1T + (size_t)(l * 2 + slot) * 128 * 2048, PEB + (l * 2 + slot) * 128, w2 + (size_t)(l * 2 + slot) * 128 * 64, b2 + (l * 2 + slot) * 64,
                            slot == 0 ? k_g + l * 192 : nullptr, (slot == 0 ? KCS : VCS) + (size_t)(l * NB + b) * 1024 * 64);
    }
}
DI void ph_prep(LAS unsigned char* lds_) {
    const Ctx c = mkctx(lds_); const int tid = c.tid, lane = c.lane, wave = c.wave, bid = c.bid, G = c.G;
    float* ADA = WSF(WS_ADA); float* BIAS = WSF(WS_BIAS); const float* w_in = INP(I_WIN);
    for (int it = bid; it < 118; it += G) { const int l = it / 59, n0 = (it % 59) * 64, nc = (DIN - n0) < 64 ? (DIN - n0) : 64;
        skinny_item<4>(c.lds, w_in + (size_t)l * 1024 * DIN, DIN, n0, nc, 1,
            [&](int, int k) { return ADA[((size_t)l * 33 + 32) * 3072 + k]; },
            [&](int, int n, float v) { BIAS[l * NPD + dst_col(n)] = v; }); }
    const float* ng = INP(I_NG);
    if (bid == 0) { float* GNX = WSF(WS_GNX); const float* sc1 = ADA + (size_t)(33 + 32) * 3072 + 1024;
        for (int k = tid; k < 1024; k += 512) GNX[k] = ng[1024 + k] * (1.f + sc1[k]); }
    const float* ada_p = ADA + (size_t)32 * 3072; const float* x_p = INP(I_XP); f16* A16 = WSH(WS_A16); float* RSSP = WSF(WS_RSSP);
    float gp[16];
#pragma unroll
    for (int i = 0; i < 4; ++i) { const f32x4 g4 = *(const f32x4*)(ng + i * 256 + lane * 4), s4 = *(const f32x4*)(ada_p + 1024 + i * 256 + lane * 4);
#pragma unroll
        for (int j = 0; j < 4; ++j) gp[i * 4 + j] = g4[j] * (1.f + s4[j]); }
    for (int row = bid * 8 + wave; row < SEQ; row += G * 8) {
        const float* xr = x_p + (size_t)row * 1024; float ss = 0.f;
#pragma unroll
        for (int i = 0; i < 4; ++i) { const f32x4 v = *(const f32x4*)(xr + i * 256 + lane * 4); ss += (v[0] * v[0] + v[1] * v[1]) + (v[2] * v[2] + v[3] * v[3]);
            f16x4 h; h[0] = (f16)(v[0] * gp[i * 4]); h[1] = (f16)(v[1] * gp[i * 4 + 1]); h[2] = (f16)(v[2] * gp[i * 4 + 2]); h[3] = (f16)(v[3] * gp[i * 4 + 3]);
            *(f16x4*)(A16 + (size_t)row * 1024 + i * 256 + lane * 4) = h; }
        ss = wsum(ss);
        if (lane < 16) RSSP[(size_t)row * 16 + lane] = lane == 0 ? ss : 0.f;
    }
}

DI void ph_inproj(LAS unsigned char* lds_, int l) {
    const Ctx c = mkctx(lds_);
    pg8::Gemm g{WSH(WS_A16), WSH(WS_WTIN) + (size_t)l * NPD * 1024, SEQ, NPD, 1024}; pg8::StaticOrder S; S.init(SEQ, NPD, c.G, c.bid);
    EpiIn E{WSH(WS_PROJ), WSF(WS_RSSP), WSF(WS_BIAS) + l * NPD, c.out + O_KVP + (size_t)l * SEQ * 256};
    pg8::gemm_phase<EpiIn, pg8::StaticOrder>(c.lds, g, S, E);
    __syncthreads();
}
DI void ph_inproj_sample(LAS unsigned char* lds_, int l) {
    const Ctx c = mkctx(lds_); const int lane = c.lane, wave = c.wave;
    const int it = c.bid - (c.G - 59);
    if (it < 0 || it >= 59) return;
    const float* xs_in = l == 0 ? INP(I_XS) : WSF(WS_XS1); const float* ada_l = WSF(WS_ADA) + (size_t)l * 33 * 3072; float* PROJS = WSF(WS_PROJS);
    LAS float* RS = (LAS float*)(c.lds + 73728 + 1024);
    for (int m = wave * 4; m < wave * 4 + 4; ++m) { float ss = 0.f; for (int k = lane; k < 1024; k += 64) { const float v = xs_in[m * 1024 + k]; ss += v * v; } ss = wsum(ss); if (lane == 0) RS[m] = rsqrtf(ss * (1.f / 1024.f) + EPS); }
    __syncthreads();
    const float* ng = INP(I_NG) + l * 1024; const float* w_in = INP(I_WIN) + (size_t)l * 1024 * DIN;
    const int n0 = it * 64, nc = (DIN - n0) < 64 ? (DIN - n0) : 64;
    skinny_item<32>(c.lds, w_in, DIN, n0, nc, 32,
        [&](int m, int k) { return xs_in[m * 1024 + k] * RS[m] * ng[k] * (1.f + ada_l[(size_t)m * 3072 + 1024 + k]) + ada_l[(size_t)m * 3072 + k]; },
        [&](int m, int n, float v) { PROJS[m * DIN + n] = v; });
}

#define PT(t) (P + (size_t)(t) * SEQ * 256)
DI void ph_ssd_local(LAS unsigned char* lds_, int l) {
    const Ctx c = mkctx(lds_); LAS unsigned char* lds = c.lds; const int tid = c.tid, lane = c.lane, wave = c.wave;
    const f16* P = WSH(WS_PROJ); f16* ACT = WSH(WS_ACT); float* YD = WSF(WS_YD); float* CST = WSF(WS_CST); float* ACS = WSF(WS_ACS); float* CDEC = WSF(WS_CDEC); float* out = c.out;
    const float* dtb = INP(I_DTB) + l * 4; const float* alog = INP(I_ALOG) + l * 4; const float* cw = INP(I_BCW) + l * 4 * 768; const float* cb = INP(I_BCB) + l * 768;
    LAS f16* Bm = (LAS f16*)lds; LAS f16* BT = (LAS f16*)(lds + 34816); LAS f16* Cm = (LAS f16*)(lds + 69632); LAS f16* XT = (LAS f16*)(lds + 104448);
    LAS float* acs = (LAS float*)(lds + 139264); LAS float* dtl = acs + 256; LAS f16* te16 = (LAS f16*)(dtl + 256);
    for (int it = c.bid; it < 256; it += c.G) {
        const int ch_ = it >> 1, g = it & 1, t0 = ch_ * 128;
        __syncthreads();
        if (tid < 256) { const int hh = tid >> 7, lt = tid & 127, hd = 2 * g + hh; const float raw = (float)PT(13)[(size_t)(t0 + lt) * 256 + 128 + hd];
            const float dt = softplusf_(raw + dtb[hd]); dtl[hh * 128 + lt] = dt; acs[hh * 128 + lt] = dt * (-__expf(alog[hd])); }
        __syncthreads();
        if (tid == 0 || tid == 64) { const int hh = tid >> 6; float sacc = 0.f; for (int i = 0; i < 128; ++i) { sacc += acs[hh * 128 + i]; acs[hh * 128 + i] = sacc; } }
        __syncthreads();
        if (tid < 256) { const int hh = tid >> 7, lt = tid & 127, hd = 2 * g + hh; const float av = acs[hh * 128 + lt], ae = acs[hh * 128 + 127];
            te16[hh * 128 + lt] = (f16)__expf(ae - av); ACS[(size_t)(t0 + lt) * 4 + hd] = av; if (lt == 127) CDEC[ch_ * 4 + hd] = __expf(ae); }
        for (int e = tid; e < 128 * 48; e += 512) {
            const int lt = e / 48, cg = e % 48, reg = cg >> 4, c8 = (cg & 15) * 8, t = t0 + lt, col = 128 * g + c8, ch = reg * 256 + col;
            const f16* src = PT(5 + reg) + col; float y[8]; f16x8 rawt;
#pragma unroll
            for (int i = 0; i < 8; ++i) y[i] = cb[ch + i];
#pragma unroll
            for (int k = 0; k < 4; ++k) { const int tt = t - 3 + k; f16x8 v; if (tt >= 0) v = ld_h8(src + (size_t)tt * 256); else {
#pragma unroll
                    for (int i = 0; i < 8; ++i) v[i] = (f16)0.f; }
                if (k == 3) rawt = v;
#pragma unroll
                for (int i = 0; i < 8; ++i) y[i] += cw[k * 768 + ch + i] * (float)v[i]; }
            f16x8 act;
#pragma unroll
            for (int i = 0; i < 8; ++i) { y[i] = siluf_(y[i]); act[i] = (f16)y[i]; }
            *(f16x8*)(ACT + (size_t)t * 768 + ch) = act;
            if (reg == 0) { const int hh = c8 >> 6; const float sdt = dtl[hh * 128 + lt] * 64.f;
#pragma unroll
                for (int i = 0; i < 8; ++i) XT[(c8 + i) * 136 + lt] = (f16)(y[i] * sdt); }
            else if (reg == 1) { *(LAS f16x8*)(Bm + lt * 136 + c8) = act;
#pragma unroll
                for (int i = 0; i < 8; ++i) BT[(c8 + i) * 136 + lt] = act[i]; }
            else *(LAS f16x8*)(Cm + lt * 136 + c8) = act;
            if (t >= SEQ - 3) { float* so = out + O_BCP + (size_t)l * 2304 + (t - (SEQ - 3)) * 768 + ch;
#pragma unroll
                for (int i = 0; i < 8; ++i) so[i] = (float)rawt[i]; }
        }
        __syncthreads();
        const int fr = lane & 15, q = lane >> 4, w = wave;
        f32x4 gt[8];
#pragma unroll
        for (int mt = 0; mt < 8; ++mt) { gt[mt] = (f32x4){0.f, 0.f, 0.f, 0.f};
            if (mt <= w) {
#pragma unroll
                for (int ks = 0; ks < 4; ++ks) { const f16x8 av = *(const LAS f16x8*)(Bm + (16 * mt + fr) * 136 + 32 * ks + 8 * q), bv = *(const LAS f16x8*)(Cm + (16 * w + fr) * 136 + 32 * ks + 8 * q);
                    gt[mt] = __builtin_amdgcn_mfma_f32_16x16x32_f16(av, bv, gt[mt], 0, 0, 0); } } }
#pragma unroll
        for (int hh = 0; hh < 2; ++hh) {
            const int lrow = 16 * w + fr; const float al = acs[hh * 128 + lrow];
            f32x4 ya[4];
#pragma unroll
            for (int pt = 0; pt < 4; ++pt) ya[pt] = (f32x4){0.f, 0.f, 0.f, 0.f};
#pragma unroll
            for (int k2 = 0; k2 < 4; ++k2) {
                if (2 * k2 <= w) {
                    f16x8 af;
#pragma unroll
                    for (int j = 0; j < 8; ++j) { const int m = 32 * k2 + (j < 4 ? 4 * q + j : 16 + 4 * q + (j - 4)); const float gv = j < 4 ? gt[2 * k2][j] : gt[2 * k2 + 1][j - 4];
                        af[j] = (f16)(m <= lrow ? gv * __expf(al - acs[hh * 128 + m]) : 0.f); }
#pragma unroll
                    for (int pt = 0; pt < 4; ++pt) { const LAS f16* xp = XT + (hh * 64 + 16 * pt + fr) * 136 + 32 * k2 + 4 * q; const f16x4 b0 = *(const LAS f16x4*)xp, b1 = *(const LAS f16x4*)(xp + 16);
                        f16x8 bf; bf[0] = b0[0]; bf[1] = b0[1]; bf[2] = b0[2]; bf[3] = b0[3]; bf[4] = b1[0]; bf[5] = b1[1]; bf[6] = b1[2]; bf[7] = b1[3];
                        ya[pt] = __builtin_amdgcn_mfma_f32_16x16x32_f16(af, bf, ya[pt], 0, 0, 0); }
                }
            }
#pragma unroll
            for (int pt = 0; pt < 4; ++pt)
#pragma unroll
                for (int j = 0; j < 4; ++j) YD[(size_t)(t0 + 16 * w + 4 * q + j) * 256 + (2 * g + hh) * 64 + 16 * pt + fr] = ya[pt][j] * (1.f / 64.f);
#pragma unroll
            for (int pt = 0; pt < 4; ++pt) { f32x4 sa = (f32x4){0.f, 0.f, 0.f, 0.f};
#pragma unroll
                for (int ks = 0; ks < 4; ++ks) { const f16x8 xv = *(const LAS f16x8*)(XT + (hh * 64 + 16 * pt + fr) * 136 + 32 * ks + 8 * q), tv = *(const LAS f16x8*)(te16 + hh * 128 + 32 * ks + 8 * q);
                    const f16x8 bv = *(const LAS f16x8*)(BT + (16 * w + fr) * 136 + 32 * ks + 8 * q);
                    sa = __builtin_amdgcn_mfma_f32_16x16x32_f16(xv * tv, bv, sa, 0, 0, 0); }
#pragma unroll
                for (int j = 0; j < 4; ++j) CST[((size_t)(ch_ * 4 + 2 * g + hh) * 64 + 16 * pt + 4 * q + j) * 128 + 16 * w + fr] = sa[j] * (1.f / 64.f); }
        }
    }
    __syncthreads();
}
DI void ph_mix_a(LAS unsigned char* lds_, int l) {
    const Ctx c = mkctx(lds_); const int tid = c.tid;
    const f16* P = WSH(WS_PROJ); f16* Y16 = WSH(WS_Y16); float* out = c.out; const float* scw = INP(I_SCW) + l * 768;
    for (int it = c.bid; it < 256; it += c.G) {
        for (int e = tid; e < 64 * 32; e += 512) { const int t = it * 64 + (e >> 5), c0 = (e & 31) * 8; float u[3][8];
#pragma unroll
            for (int k = 0; k < 3; ++k) { const int tt = t - 2 + k;
                if (tt >= 0) { const f16x8 h = ld_h8(PT(0) + (size_t)tt * 256 + c0), cc = ld_h8(PT(2) + (size_t)tt * 256 + c0);
#pragma unroll
                    for (int i = 0; i < 8; ++i) u[k][i] = (float)cc[i] * (float)h[i]; }
                else {
#pragma unroll
                    for (int i = 0; i < 8; ++i) u[k][i] = 0.f; } }
            const f16x8 bb = ld_h8(PT(1) + (size_t)t * 256 + c0), gg = ld_h8(PT(3) + (size_t)t * 256 + c0); f16x8 o;
#pragma unroll
            for (int i = 0; i < 8; ++i) { const float y = scw[c0 + i] * u[0][i] + scw[256 + c0 + i] * u[1][i] + scw[512 + c0 + i] * u[2][i]; o[i] = (f16)(siluf_((float)gg[i]) * (float)bb[i] * y); }
            *(f16x8*)(Y16 + (size_t)t * 1024 + c0) = o;
            if (t >= SEQ - 2) { float* so = out + O_SCP + (size_t)l * 512 + (t - (SEQ - 2)) * 256 + c0;
#pragma unroll
                for (int i = 0; i < 8; ++i) so[i] = u[2][i]; }
        }
    }
}
DI void ph_mix_c(LAS unsigned char* lds_, int l) {
    const Ctx c = mkctx(lds_); const int tid = c.tid, lane = c.lane, wave = c.wave;
    const f16* P = WSH(WS_PROJ); f16* Y16 = WSH(WS_Y16); float* out = c.out;
    const float* cfw = INP(I_CFW) + l * 31 * 256; const float* cfb = INP(I_CFB) + l * 256; const float* lng = INP(I_LNG) + l * 256; const float* lnb = INP(I_LNB) + l * 256;
    LAS float* GL = (LAS float*)c.lds;
    for (int it = c.bid; it < 256; it += c.G) {
        __syncthreads();
        for (int e = tid; e < 94 * 32; e += 512) { const int rr = e >> 5, c0 = (e & 31) * 8, t = it * 64 - 30 + rr; f32x4 g0 = (f32x4){0.f, 0.f, 0.f, 0.f}, g1 = g0;
            if (t >= 0) { const f16x8 ga = ld_h8(PT(8) + (size_t)t * 256 + c0), gb = ld_h8(PT(9) + (size_t)t * 256 + c0);
#pragma unroll
                for (int i = 0; i < 4; ++i) { g0[i] = (float)ga[i] * sigmoidf_((float)gb[i]); g1[i] = (float)ga[4 + i] * sigmoidf_((float)gb[4 + i]); }
                if (t >= SEQ - 30) { float* so = out + O_CFP + (size_t)l * 7680 + (t - (SEQ - 30)) * 256 + c0; *(f32x4*)so = g0; *(f32x4*)(so + 4) = g1; } }
            *(LAS f32x4*)(GL + rr * 256 + c0) = g0; *(LAS f32x4*)(GL + rr * 256 + c0 + 4) = g1; }
        __syncthreads();
        for (int tl = wave; tl < 64; tl += 8) { const int t = it * 64 + tl, cc = lane * 4; f32x4 u = *(const f32x4*)(cfb + cc);
#pragma unroll
            for (int k = 0; k < 31; ++k) { const f32x4 w = *(const f32x4*)(cfw + k * 256 + cc), gv = *(const LAS f32x4*)(GL + (tl + k) * 256 + cc); u += w * gv; }
            const float mean = wsum((u[0] + u[1]) + (u[2] + u[3])) * (1.f / 256.f); const f32x4 d = u - mean;
            const float var = wsum((d[0] * d[0] + d[1] * d[1]) + (d[2] * d[2] + d[3] * d[3])) * (1.f / 256.f); const float rs = rsqrtf(var + EPS);
            const f32x4 g4 = *(const f32x4*)(lng + cc), b4 = *(const f32x4*)(lnb + cc); const f16x4 cg = *(const f16x4*)(PT(10) + (size_t)t * 256 + cc); f16x4 o;
#pragma unroll
            for (int i = 0; i < 4; ++i) o[i] = (f16)(siluf_((float)cg[i]) * siluf_(d[i] * rs * g4[i] + b4[i]));
            *(f16x4*)(Y16 + (size_t)t * 1024 + 512 + cc) = o; }
    }
    __syncthreads();
}
DI void ph_mix_d(LAS unsigned char* lds_, int l) {
    const Ctx c = mkctx(lds_); const int lane = c.lane;
    const f16* P = WSH(WS_PROJ); float* out = c.out; float* kvp_out = out + O_KVP + (size_t)l * SEQ * 256;
    f16* Q16 = WSH(WS_Q16); f16* KS16 = WSH(WS_KS16); f16* VS16 = WSH(WS_VS16); f16* KW16 = WSH(WS_KW16); f16* VW16 = WSH(WS_VW16); float* GATES = WSF(WS_GATES);
    const float* qg = INP(I_QG) + l * 64; const float* kg = INP(I_KG) + l * 192;
    for (int t = c.bid * 8 + c.wave; t < SEQ; t += c.G * 8) {
#pragma unroll
        for (int hh = 0; hh < 4; ++hh) { const float v = (float)PT(11)[(size_t)t * 256 + hh * 64 + lane]; const float ss = wsum(v * v); Q16[(size_t)t * 256 + hh * 64 + lane] = (f16)(v * rsqrtf(ss * (1.f / 64.f) + EPS) * qg[lane]); }
        float* kr = kvp_out + (size_t)t * 256;
        { const float v = kr[128 + lane]; const float ss = wsum(v * v); const float kn = v * rsqrtf(ss * (1.f / 64.f) + EPS) * kg[64 + lane]; kr[128 + lane] = kn; KS16[(size_t)t * 64 + lane] = (f16)kn; VS16[(size_t)t * 64 + lane] = (f16)kr[192 + lane]; }
        { const float v = (float)PT(13)[(size_t)t * 256 + lane]; const float ss = wsum(v * v); const float kn = v * rsqrtf(ss * (1.f / 64.f) + EPS) * kg[128 + lane]; const float vv = (float)PT(13)[(size_t)t * 256 + 64 + lane];
            KW16[(size_t)t * 64 + lane] = (f16)kn; VW16[(size_t)t * 64 + lane] = (f16)vv;
            if (t >= SEQ - 512) { float* wo = out + O_WINP + (size_t)l * 512 * 128 + (size_t)(t - (SEQ - 512)) * 128; wo[lane] = kn; wo[64 + lane] = vv; } }
        if (lane < 12) GATES[(size_t)t * 12 + lane] = sigmoidf_((float)PT(13)[(size_t)t * 256 + 132 + lane]);
    }
}
DI void ph_mix_cmp(LAS unsigned char* lds_, int l) {
    const Ctx c = mkctx(lds_);
    const f16* P = WSH(WS_PROJ); const float* w2 = INP(I_W2); const float* b2 = INP(I_B2); const float* k_g = INP(I_KG); f16* W1T = WSH(WS_W1T); float* PEB = WSF(WS_PEB);
    for (int it = c.bid; it < 64; it += c.G) { const int slot = it >> 5, grp = it & 31; const f16* src = PT(12) + slot * 64;
        compress_item<false>(c.lds, [&](int tok) { return (const void*)(src + (size_t)tok * 256); }, grp * 32, SEQ - 1,
                             W1T + (size_t)(l * 2 + slot) * 128 * 2048, PEB + (l * 2 + slot) * 128, w2 + (size_t)(l * 2 + slot) * 128 * 64, b2 + (l * 2 + slot) * 64,
                             slot == 0 ? k_g + l * 192 : nullptr, slot == 0 ? WSF(WS_KC) : WSF(WS_VC)); }
}
#undef PT
DI void ph_mix_sample(LAS unsigned char* lds_, int l) {
    const Ctx c = mkctx(lds_); const int tid = c.tid, lane = c.lane, wave = c.wave;
    const int b = c.bid - (c.G - 32);
    if (b < 0 || b >= 32) return;
    float* out = c.out;
    __syncthreads();
    const float* pr = WSF(WS_PROJS) + (size_t)b * DIN;
    LAS float* act = (LAS float*)c.lds;
    LAS float* red = act + 768;
    LAS float* ybl = red + 16;
    LAS float* sdt = ybl + 256;
    LAS float* nrow = sdt + 8;
    LAS float* gsm = nrow + 256;
    LAS float* wl = gsm + 16;
    float* ys = WSF(WS_YS) + (size_t)b * 1024;
    if (tid < 256) { const int ch = tid; const float* st = INP(I_SSC) + ((size_t)(l * NB + b) * 2) * 256; const float* scw = INP(I_SCW) + l * 768;
        const float u = pr[512 + ch] * pr[ch], p0 = st[ch], p1 = st[256 + ch]; const float y = scw[ch] * p0 + scw[256 + ch] * p1 + scw[512 + ch] * u;
        ys[ch] = siluf_(pr[768 + ch]) * pr[256 + ch] * y; float* so = out + O_SCS + ((size_t)(l * NB + b) * 2) * 256; so[ch] = p1; so[256 + ch] = u; }
    float uc = 0.f;
    if (tid >= 256) { const int ch = tid - 256; const float* st = INP(I_SCF) + (size_t)(l * NB + b) * 7680; const float* cfw = INP(I_CFW) + l * 31 * 256;
        const float glu = pr[2052 + ch] * sigmoidf_(pr[2308 + ch]); float u = INP(I_CFB)[l * 256 + ch]; float* so = out + O_CFS + (size_t)(l * NB + b) * 7680;
        for (int k = 0; k < 30; ++k) { const float pv = st[k * 256 + ch]; u += cfw[k * 256 + ch] * pv; if (k > 0) so[(k - 1) * 256 + ch] = pv; }
        u += cfw[30 * 256 + ch] * glu; so[29 * 256 + ch] = glu; uc = u; }
    { const float s1 = wsum(tid >= 256 ? uc : 0.f); if (lane == 0) red[wave] = s1; }
    __syncthreads();
    const float cmean = (red[4] + red[5] + red[6] + red[7]) * (1.f / 256.f);
    __syncthreads();
    { const float d = uc - cmean; const float s2 = wsum(tid >= 256 ? d * d : 0.f); if (lane == 0) red[wave] = s2; }
    __syncthreads();
    if (tid >= 256) { const int ch = tid - 256; const float var = (red[4] + red[5] + red[6] + red[7]) * (1.f / 256.f);
        const float ln = (uc - cmean) * rsqrtf(var + EPS) * INP(I_LNG)[l * 256 + ch] + INP(I_LNB)[l * 256 + ch];
        ys[512 + ch] = siluf_(pr[2564 + ch]) * siluf_(ln); }
    { const float* st = INP(I_SBC) + (size_t)(l * NB + b) * 2304; const float* cw = INP(I_BCW) + l * 4 * 768; const float* cb = INP(I_BCB) + l * 768; float* so = out + O_BCS + (size_t)(l * NB + b) * 2304;
        for (int ch = tid; ch < 768; ch += 512) { const float raw = pr[1280 + ch], p0 = st[ch], p1 = st[768 + ch], p2 = st[1536 + ch];
            act[ch] = siluf_(cb[ch] + cw[ch] * p0 + cw[768 + ch] * p1 + cw[1536 + ch] * p2 + cw[2304 + ch] * raw); so[ch] = p1; so[768 + ch] = p2; so[1536 + ch] = raw; }
        if (tid < 4) { const float dt = softplusf_(pr[2048 + tid] + INP(I_DTB)[l * 4 + tid]); sdt[tid] = dt; sdt[4 + tid] = __expf(dt * (-__expf(INP(I_ALOG)[l * 4 + tid]))); } }
    __syncthreads();
    { const float* h0 = INP(I_SSM) + (size_t)(l * NB + b) * 32768; float* ho = out + O_HS + (size_t)(l * NB + b) * 32768; const float* Dp = INP(I_SD) + l * 4;
        for (int row = wave; row < 256; row += 8) { const int hd = row >> 6, gq = hd >> 1; const float dt = sdt[hd], dA = sdt[4 + hd], xv = act[row]; float y = 0.f;
#pragma unroll
            for (int s2 = 0; s2 < 2; ++s2) { const int sidx = lane + 64 * s2; const float hn = dA * h0[row * 128 + sidx] + dt * xv * act[256 + gq * 128 + sidx]; ho[row * 128 + sidx] = hn; y += hn * act[512 + gq * 128 + sidx]; }
            y = wsum(y);
            if (lane == 0) ybl[row] = (y + Dp[hd] * xv) * siluf_(pr[1024 + row]); } }
    __syncthreads();
    { const float v = tid < 256 ? ybl[tid] : 0.f; const float s2 = wsum(v * v); if (lane == 0) red[8 + wave] = s2; }
    __syncthreads();
    if (tid < 256) { const float ss = red[8] + red[9] + red[10] + red[11]; ys[256 + tid] = ybl[tid] * rsqrtf(ss * (1.f / 256.f) + EPS) * INP(I_SNG)[l * 256 + tid]; }
    const float* qg = INP(I_QG) + l * 64; const float* kg = INP(I_KG) + l * 192;
    LAS float* qs = wl + 4096;
    if (wave < 4) { const float v = pr[2820 + wave * 64 + lane]; const float ss = wsum(v * v); qs[lane * 4 + wave] = v * rsqrtf(ss * (1.f / 64.f) + EPS) * qg[lane]; }
    else if (wave == 4) { const float v = pr[3076 + 128 + lane]; const float ss = wsum(v * v); nrow[lane] = v * rsqrtf(ss * (1.f / 64.f) + EPS) * kg[64 + lane]; nrow[64 + lane] = pr[3076 + 192 + lane]; }
    else if (wave == 5) { const float v = pr[3076 + 256 + lane]; const float ss = wsum(v * v); nrow[128 + lane] = v * rsqrtf(ss * (1.f / 64.f) + EPS) * kg[128 + lane]; nrow[192 + lane] = pr[3076 + 320 + lane]; }
    else if (wave == 6) { if (lane < 12) gsm[lane] = sigmoidf_(pr[3716 + lane]); }
    __syncthreads();
    const float* cache_win = INP(I_CWIN) + (size_t)(l * NB + b) * 512 * 128;
    { float* ko = out + O_KVS + (size_t)(l * NB + b) * 256;
        if (tid < 128) ko[tid] = pr[3076 + tid]; else if (tid < 192) ko[tid] = nrow[tid - 128]; else if (tid < 256) ko[tid] = nrow[64 + tid - 192];
        float* wo = out + O_WINS + (size_t)(l * NB + b) * 512 * 128;
        for (int e = tid; e < 511 * 128; e += 512) wo[e] = cache_win[128 + e];
        if (tid < 64) wo[511 * 128 + tid] = nrow[128 + tid]; else if (tid < 128) wo[511 * 128 + tid] = nrow[192 + tid - 64]; }
    float* nrp = WSF(WS_NRG) + (size_t)(l * NB + b) * 256;
    if (tid < 256) nrp[tid] = nrow[tid];
    asm volatile("s_waitcnt vmcnt(0)" ::: "memory");
    __syncthreads();
    if (wave == 0) {
        SampleKV kv{INP(I_CKV) + (size_t)l * NPOOL * 128 * 256, (const int*)c.ap->in[I_PT] + b * 128, cache_win, nrp, nrp + 64, nrp + 128, nrp + 192};
        float gl[12];
#pragma unroll
        for (int i = 0; i < 12; ++i) gl[i] = gsm[i];
        float o[4];
        nsa_token(wl, PAST, WSF(WS_KCS) + (size_t)(l * NB + b) * 1024 * 64, WSF(WS_VCS) + (size_t)(l * NB + b) * 1024 * 64, kv, gl, o);
#pragma unroll
        for (int hh = 0; hh < 4; ++hh) ys[768 + hh * 64 + lane] = siluf_(pr[3460 + hh * 64 + lane]) * o[hh];
    }
    __syncthreads();
}
DI void ph_scan(LAS unsigned char* lds_, int l) {
    const Ctx c = mkctx(lds_);
    if (c.bid >= 64) return;
    float* CST = WSF(WS_CST); const float* CDEC = WSF(WS_CDEC);
    const int e = c.bid * 512 + c.tid, hd = e >> 13; float hc = 0.f;
#pragma unroll 8
    for (int ch = 0; ch < 128; ++ch) { const float sv = CST[(size_t)ch * 32768 + e]; CST[(size_t)ch * 32768 + e] = hc; hc = CDEC[ch * 4 + hd] * hc + sv; }
    c.out[O_HP + (size_t)l * 32768 + e] = hc;
}
DI void ph_nsa(LAS unsigned char* lds_, int l) {
    const Ctx c = mkctx(lds_); const int lane = c.lane;
    LAS float* wl = (LAS float*)c.lds + c.wave * 4368;
    PromptKV kv{WSH(WS_KS16), WSH(WS_VS16), WSH(WS_KW16), WSH(WS_VW16)};
    const f16* Q16 = WSH(WS_Q16); const float* GATES = WSF(WS_GATES); const f16* DG = WSH(WS_PROJ) + (size_t)14 * SEQ * 256; f16* Y16 = WSH(WS_Y16); const float* KC = WSF(WS_KC); const float* VC = WSF(WS_VC);
    for (int t = c.bid * 8 + c.wave; t < SEQ; t += c.G * 8) {
#pragma unroll
        for (int hh = 0; hh < 4; ++hh) wl[4096 + lane * 4 + hh] = (float)Q16[(size_t)t * 256 + hh * 64 + lane];
        float gl[12];
#pragma unroll
        for (int i = 0; i < 12; ++i) gl[i] = GATES[(size_t)t * 12 + i];
        __builtin_amdgcn_wave_barrier();
        float o[4];
        nsa_token(wl, t, KC, VC, kv, gl, o);
        const f16* dg = DG + (size_t)t * 256;
#pragma unroll
        for (int hh = 0; hh < 4; ++hh) Y16[(size_t)t * 1024 + 768 + hh * 64 + lane] = (f16)(siluf_((float)dg[hh * 64 + lane]) * o[hh]);
    }
    (void)l;
}
DI void ph_ssd_fin(LAS unsigned char* lds_, int l) {
    const Ctx c = mkctx(lds_); const int lane = c.lane, wave = c.wave;
    const float* Dp = INP(I_SD) + l * 4; const float* sng = INP(I_SNG) + l * 256;
    const float* CST = WSF(WS_CST); const f16* ACT = WSH(WS_ACT); const float* ACS = WSF(WS_ACS); const float* YD = WSF(WS_YD); const f16* Z = WSH(WS_PROJ) + (size_t)4 * SEQ * 256; f16* Y16 = WSH(WS_Y16);
    LAS float* GY = (LAS float*)c.lds;
    for (int it = c.bid; it < 256; it += c.G) {
        const int ch_ = it >> 1, t0 = it * 64, hd = wave >> 1, g = hd >> 1, fr = lane & 15, q = lane >> 4;
        __syncthreads();
        f16x8 bf[2][4];
#pragma unroll
        for (int p2 = 0; p2 < 2; ++p2)
#pragma unroll
            for (int ks = 0; ks < 4; ++ks) bf[p2][ks] = cvt_h8(CST + ((size_t)(ch_ * 4 + hd) * 64 + 16 * ((wave & 1) * 2 + p2) + fr) * 128 + 32 * ks + 8 * q);
        for (int lt = 0; lt < 4; ++lt) {
            f16x8 af[4];
#pragma unroll
            for (int ks = 0; ks < 4; ++ks) af[ks] = ld_h8(ACT + (size_t)(t0 + 16 * lt + fr) * 768 + 512 + 128 * g + 32 * ks + 8 * q);
#pragma unroll
            for (int p2 = 0; p2 < 2; ++p2) { f32x4 acc = (f32x4){0.f, 0.f, 0.f, 0.f};
#pragma unroll
                for (int ks = 0; ks < 4; ++ks) acc = __builtin_amdgcn_mfma_f32_16x16x32_f16(af[ks], bf[p2][ks], acc, 0, 0, 0);
                const int ch = hd * 64 + 16 * ((wave & 1) * 2 + p2) + fr;
#pragma unroll
                for (int j = 0; j < 4; ++j) { const int tl = 16 * lt + 4 * q + j, t = t0 + tl;
                    const float y = acc[j] * __expf(ACS[(size_t)t * 4 + hd]) + YD[(size_t)t * 256 + ch] + Dp[hd] * (float)ACT[(size_t)t * 768 + ch];
                    GY[tl * 256 + ch] = y * siluf_((float)Z[(size_t)t * 256 + ch]); } }
        }
        __syncthreads();
        for (int tl = wave; tl < 64; tl += 8) { const f32x4 v = *(const LAS f32x4*)(GY + tl * 256 + lane * 4); const float ss = wsum((v[0] * v[0] + v[1] * v[1]) + (v[2] * v[2] + v[3] * v[3]));
            const float rn = rsqrtf(ss * (1.f / 256.f) + EPS); const f32x4 g4 = *(const f32x4*)(sng + lane * 4); f16x4 o;
#pragma unroll
            for (int i = 0; i < 4; ++i) o[i] = (f16)(v[i] * rn * g4[i]);
            *(f16x4*)(Y16 + (size_t)(t0 + tl) * 1024 + 256 + lane * 4) = o; }
    }
    __syncthreads();
}
DI void ph_outproj(LAS unsigned char* lds_, int l) {
    const Ctx c = mkctx(lds_);
    const float* xin = l == 0 ? INP(I_XP) : WSF(WS_X1); float* xout = l == 0 ? WSF(WS_X1) : c.out + O_YP;
    pg8::Gemm g{WSH(WS_Y16), WSH(WS_WTOUT) + (size_t)l * 1024 * 1024, SEQ, 1024, 1024}; pg8::StaticOrder S; S.init(SEQ, 1024, c.G, c.bid);
    EpiOut E{xin, xout, WSF(WS_ADA) + (size_t)(l * 33 + 32) * 3072 + 2048, l == 0 ? WSH(WS_A16) : nullptr, WSF(WS_GNX), WSF(WS_RSSP)};
    pg8::gemm_phase<EpiOut, pg8::StaticOrder>(c.lds, g, S, E);
    __syncthreads();
}
DI void ph_outproj_sample(LAS unsigned char* lds_, int l) {
    const Ctx c = mkctx(lds_);
    if (c.bid >= 16) return;
    const float* xs_in = l == 0 ? INP(I_XS) : WSF(WS_XS1); const float* ada_l = WSF(WS_ADA) + (size_t)l * 33 * 3072; const float* YS = WSF(WS_YS);
    const float* w_out = INP(I_WOUT) + (size_t)l * 1024 * 1024; float* xo = l == 0 ? WSF(WS_XS1) : c.out + O_YS;
    skinny_item<32>(c.lds, w_out, 1024, c.bid * 64, 64, 32,
        [&](int m, int k) { return YS[m * 1024 + k]; },
        [&](int m, int n, float v) { xo[m * 1024 + n] = xs_in[m * 1024 + n] + ada_l[(size_t)m * 3072 + 2048 + n] * v; });
}

__global__ void __launch_bounds__(512, 2) fwd(Args a) {
    extern __shared__ __attribute__((aligned(16))) unsigned char lds_raw[];
    LAS unsigned char* lds = (LAS unsigned char*)lds_raw;
    volatile LAS unsigned* MISC = (volatile LAS unsigned*)(lds + MISC_OFF);
    if (threadIdx.x < 16) MISC[threadIdx.x] = 0u;
    __syncthreads();
    XcdBarrier bar; bar.bar = (unsigned*)(a.ws + WS_CTL); bar.x = 0; bar.st = MISC;
    if (N_LAUNCHES == 1) bar = xcd_barrier_post((unsigned*)(a.ws + WS_CTL), MISC);
    const int lo = a.ph_lo, hi = a.ph_hi;
#ifndef PH_MASK
#define PH_MASK 0xFFF
#endif
#define IN(k) (((PH_MASK >> ((k) < 2 ? (k) : 2 + ((k) - 2) % 5)) & 1) && lo <= (k) && (k) < hi)
#define SEAM(k) do { if (IN(k) && IN((k) + 1)) xcd_barrier(bar); } while (0)
    if (IN(0)) ph_prologue(lds);
    SEAM(0);
    if (IN(1)) { ph_sample_compress(lds); ph_prep(lds); }
    SEAM(1);
    for (int l = 0; l < 2; ++l) {
        const int PB = 2 + 5 * l;
        if (IN(PB)) { ph_inproj(lds, l); ph_inproj_sample(lds, l); }
        SEAM(PB);
        if (IN(PB + 1)) { ph_ssd_local(lds, l); ph_mix_a(lds, l); ph_mix_c(lds, l); ph_mix_d(lds, l); ph_mix_cmp(lds, l); ph_mix_sample(lds, l); }
        SEAM(PB + 1);
        if (IN(PB + 2)) { ph_scan(lds, l); ph_nsa(lds, l); }
        SEAM(PB + 2);
        if (IN(PB + 3)) ph_ssd_fin(lds, l);
        SEAM(PB + 3);
        if (IN(PB + 4)) { ph_outproj(lds, l); ph_outproj_sample(lds, l); }
        SEAM(PB + 4);
    }
#undef IN
#undef SEAM
}

extern "C" void kernel_launch(void* const* d_in, const int* in_sizes, int n_in, void* d_out, int out_size, void* d_ws, size_t ws_size, hipStream_t stream) {
    static int grid = 0;
    if (grid == 0) {
        if (n_in != N_IN || (size_t)out_size != O_END || ws_size < WS_END) { fprintf(stderr, "kernel_launch: unexpected shapes (n_in %d out %d ws %zu)\n", n_in, out_size, ws_size); grid = -1; return; }
        int dev = 0, cus = 0;
        if (hipGetDevice(&dev) != hipSuccess || hipDeviceGetAttribute(&cus, hipDeviceAttributeMultiprocessorCount, dev) != hipSuccess) { grid = -1; return; }
        if (hipFuncSetAttribute((const void*)fwd, hipFuncAttributeMaxDynamicSharedMemorySize, LDS_BYTES) != hipSuccess) { fprintf(stderr, "kernel_launch: hipFuncSetAttribute failed\n"); grid = -1; return; }
        int per_cu = 0;
        if (hipOccupancyMaxActiveBlocksPerMultiprocessor(&per_cu, (const void*)fwd, 512, LDS_BYTES) != hipSuccess || per_cu < 1) fprintf(stderr, "kernel_launch: occupancy query says %d\n", per_cu);
        (void)hipGetLastError();
        grid = cus;
    }
    if (grid < 0) return;
    hipMemsetAsync((char*)d_ws + WS_CTL, 0, 65536, stream);
    Args a{};
    for (int i = 0; i < N_IN; ++i) a.in[i] = d_in[i];
    a.out = (float*)d_out; a.ws = (unsigned char*)d_ws;
    if (N_LAUNCHES == 1) { a.ph_lo = 0; a.ph_hi = NPHASE; hipLaunchKernelGGL(fwd, dim3(grid), dim3(512), LDS_BYTES, stream, a); }
    else for (int p = 0; p < NPHASE; ++p) { a.ph_lo = p; a.ph_hi = p + 1; hipLaunchKernelGGL(fwd, dim3(grid), dim3(512), LDS_BYTES, stream, a); }
}
```

```cpp
#include <hip/hip_runtime.h>
#include <cstdio>
#include <cstdint>
#include <type_traits>

#define NSA_DUP 0
#define VERIFY_NSA 0
#define STAMP_PHASE -1
#ifndef N_LAUNCHES
#define N_LAUNCHES 1
#endif

#define DI __device__ __forceinline__
#define LAS __attribute__((address_space(3)))
typedef _Float16 f16;
typedef _Float16 f16x8 __attribute__((ext_vector_type(8)));
typedef _Float16 f16x4 __attribute__((ext_vector_type(4)));
typedef _Float16 f16x2 __attribute__((ext_vector_type(2)));
typedef float f32x4 __attribute__((ext_vector_type(4)));
typedef float f32x2 __attribute__((ext_vector_type(2)));
typedef float f32x16 __attribute__((ext_vector_type(16)));
typedef unsigned u32x4 __attribute__((ext_vector_type(4)));

constexpr int DM = 1024, SEQ = 16384, NB = 32, PAST = 16384, NPOOL = 5120, DIN = 3728, NPD = 3840;
constexpr float EPS = 1e-6f;
constexpr int NPHASE = 10;
enum { I_XP = 0, I_XS, I_CKV, I_CWIN, I_SSC, I_SBC, I_SSM, I_SCF, I_PT, I_CP, I_CS, I_NG, I_WADA, I_BADA, I_WIN, I_WOUT, I_SCW, I_BCW, I_BCB,
       I_DTB, I_ALOG, I_SD, I_SNG, I_CFW, I_CFB, I_LNG, I_LNB, I_QG, I_KG, I_PE, I_W1, I_B1, I_W2, I_B2, N_IN };
constexpr size_t O_YP = 0, O_YS = O_YP + (size_t)SEQ * DM, O_KVP = O_YS + NB * DM, O_KVS = O_KVP + (size_t)2 * SEQ * 256, O_WINP = O_KVS + 2 * NB * 256,
                 O_WINS = O_WINP + 2 * 512 * 128, O_SCP = O_WINS + (size_t)2 * NB * 512 * 128, O_SCS = O_SCP + 2 * 2 * 256, O_BCP = O_SCS + 2 * NB * 512,
                 O_BCS = O_BCP + 2 * 3 * 768, O_HP = O_BCS + 2 * NB * 2304, O_HS = O_HP + 2 * 32768, O_CFP = O_HS + (size_t)2 * NB * 32768,
                 O_CFS = O_CFP + 2 * 30 * 256, O_END = O_CFS + 2 * NB * 7680;
constexpr size_t al256(size_t x) { return (x + 255) & ~(size_t)255; }
constexpr size_t WS_CTL = 0, WS_ADA = 65536, WS_BIAS = WS_ADA + al256(2 * 33 * 3072 * 4), WS_PEB = WS_BIAS + al256(2 * NPD * 4), WS_WTIN = WS_PEB + 2048,
                 WS_WTOUT = WS_WTIN + (size_t)2 * NPD * 1024 * 2, WS_W1T = WS_WTOUT + (size_t)2 * 1024 * 1024 * 2, WS_A16 = WS_W1T + (size_t)4 * 128 * 2048 * 2,
                 WS_RSSP = WS_A16 + (size_t)SEQ * 1024 * 2, WS_X1 = WS_RSSP + (size_t)SEQ * 16 * 4, WS_PROJ = WS_X1 + (size_t)SEQ * 1024 * 4,
                 WS_Y16 = WS_PROJ + (size_t)15 * SEQ * 256 * 2, WS_ACT = WS_Y16 + (size_t)SEQ * 1024 * 2, WS_YD = WS_ACT + (size_t)SEQ * 768 * 2,
                 WS_CST = WS_YD + (size_t)SEQ * 256 * 4, WS_ACS = WS_CST + (size_t)128 * 32768 * 4, WS_CDEC = WS_ACS + (size_t)SEQ * 4 * 4, WS_Q16 = WS_CDEC + 2048,
                 WS_KS16 = WS_Q16 + (size_t)SEQ * 256 * 2, WS_VS16 = WS_KS16 + (size_t)SEQ * 64 * 2, WS_KW16 = WS_VS16 + (size_t)SEQ * 64 * 2,
                 WS_VW16 = WS_KW16 + (size_t)SEQ * 64 * 2, WS_GATES = WS_VW16 + (size_t)SEQ * 64 * 2, WS_KC = WS_GATES + (size_t)SEQ * 12 * 4,
                 WS_VC = WS_KC + 1024 * 64 * 4, WS_KCS = WS_VC + 1024 * 64 * 4, WS_VCS = WS_KCS + (size_t)2 * NB * 1024 * 64 * 4,
                 WS_PROJS = WS_VCS + (size_t)2 * NB * 1024 * 64 * 4, WS_YS = WS_PROJS + al256(NB * NPD * 4), WS_XS1 = WS_YS + NB * 1024 * 4, WS_GNX = WS_XS1 + NB * 1024 * 4, WS_NRG = WS_GNX + 4096, WS_VST16 = WS_NRG + 2 * NB * 1024, WS_VWT16 = WS_VST16 + (size_t)SEQ * 64 * 2, WS_KC16 = WS_VWT16 + (size_t)SEQ * 64 * 2,
                 WS_VCT16 = WS_KC16 + 1024 * 64 * 2, WS_HPV = WS_VCT16 + 1024 * 64 * 2, WS_W2T = WS_HPV + (size_t)128 * 32768 * 4, WS_PEBP = WS_W2T + 4 * 64 * 128 * 2, WS_HS16 = WS_PEBP + 4 * 8 * 128 * 4, WS_SELM = WS_HS16 + NB * 1024 * 2, WS_END = WS_SELM + 512 * 272 * 4;
constexpr int LDS_BYTES = 147456;
constexpr int MISC_OFF = 147200;

struct Args { const void* in[N_IN]; float* out; unsigned char* ws; int ph_lo, ph_hi; };

#define XB_TMO      128
#define XB_XCNT(j)  (256  + 64 * (j))
#define XB_XSUB(j)  (1280 + 64 * (j))
#define XB_XGEN(j)  (2304 + 64 * (j))
#define XB_TOP      3328
#define XB_TOPGEN   3392
#define XCD_BAR_WORDS 3456
#define XB_SPIN_CAP (1u << 18)
__device__ __forceinline__ unsigned xb_ld(unsigned* p)              { return __hip_atomic_load(p, __ATOMIC_RELAXED, __HIP_MEMORY_SCOPE_AGENT); }
__device__ __forceinline__ unsigned xb_add(unsigned* p, unsigned v) { return __hip_atomic_fetch_add(p, v, __ATOMIC_RELAXED, __HIP_MEMORY_SCOPE_AGENT); }
__device__ __forceinline__ unsigned xb_xcc_id() { return (unsigned)__builtin_amdgcn_s_getreg((3 << 11) | 20) & 0xFu; }
#define XB_SPIN(cond, bar) do { unsigned _sp = 0; while (cond) { __builtin_amdgcn_s_sleep(1); \
    if ((++_sp & 255u) == 0u) { if (xb_ld(&(bar)[XB_TMO])) break; if (_sp > XB_SPIN_CAP) { atomicAdd(&(bar)[XB_TMO], 1u); break; } } } } while (0)
struct XcdBarrier { unsigned* bar; unsigned x; volatile LAS unsigned* st; };
__device__ __forceinline__ XcdBarrier xcd_barrier_post(unsigned* bar, volatile LAS unsigned* st) {
    XcdBarrier b; b.bar = bar; b.x = xb_xcc_id(); b.st = st;
    if (threadIdx.x == 0) (void)xb_add(&bar[XB_XCNT(b.x)], 1u);
    return b;
}
__device__ __forceinline__ void xcd_barrier_complete(unsigned* bar, unsigned x, unsigned& nloc, unsigned& nx) {
    const unsigned G = gridDim.x * gridDim.y * gridDim.z;
    unsigned sum, cnt, mine, sp = 0u;
    for (;;) {
        sum = 0u; cnt = 0u; mine = 0u;
#pragma unroll
        for (unsigned j = 0; j < 16; ++j) { const unsigned c = xb_ld(&bar[XB_XCNT(j)]); sum += c; cnt += (c > 0u) ? 1u : 0u; mine = (j == x) ? c : mine; }
        if (sum == G) break;
        __builtin_amdgcn_s_sleep(1);
        if ((++sp & 255u) == 0u) { if (xb_ld(&bar[XB_TMO])) break; if (sp > XB_SPIN_CAP) { atomicAdd(&bar[XB_TMO], 1u); break; } }
    }
    nloc = mine > 0u ? mine : 1u; nx = cnt > 0u ? cnt : 1u;
}
__device__ __forceinline__ void xcd_barrier(const XcdBarrier& b) {
    asm volatile("s_waitcnt vmcnt(0)" ::: "memory");
    __syncthreads();
    if (threadIdx.x == 0) {
        unsigned* bar = b.bar;
        __builtin_amdgcn_s_waitcnt(0);
        unsigned nloc = b.st[0], nx = b.st[1];
        if (nloc == 0u) { xcd_barrier_complete(bar, b.x, nloc, nx); b.st[0] = nloc; b.st[1] = nx; }
        const unsigned old = xb_add(&bar[XB_XSUB(b.x)], 1u);
        const unsigned gen = old / nloc;
        if (old + 1u == (gen + 1u) * nloc) {
            __builtin_amdgcn_fence(__ATOMIC_RELEASE, "agent");
            asm volatile("s_waitcnt vmcnt(0)" ::: "memory");
            const unsigned og = xb_add(&bar[XB_TOP], 1u);
            const unsigned tg = og / nx;
            if (og + 1u == (tg + 1u) * nx) xb_add(&bar[XB_TOPGEN], 1u);
            else XB_SPIN(xb_ld(&bar[XB_TOPGEN]) == tg, bar);
            __builtin_amdgcn_fence(__ATOMIC_ACQUIRE, "agent");
            xb_add(&bar[XB_XGEN(b.x)], 1u);
            asm volatile("s_waitcnt vmcnt(0)" ::: "memory");
        } else {
            XB_SPIN(xb_ld(&bar[XB_XGEN(b.x)]) == gen, bar);
            __builtin_amdgcn_fence(__ATOMIC_ACQUIRE, "agent");
            asm volatile("s_waitcnt vmcnt(0)" ::: "memory");
        }
    }
    __syncthreads();
}

DI void lds_barrier() { asm volatile("s_waitcnt lgkmcnt(0)\n\ts_barrier" ::: "memory"); }
DI int ltid() { int t = threadIdx.x; asm volatile("" : "+v"(t)); return t; }
template <int CTRL> DI float dppf(float x) { return __builtin_bit_cast(float, __builtin_amdgcn_update_dpp(0, __builtin_bit_cast(int, x), CTRL, 0xF, 0xF, true)); }
template <int CTRL> DI int dppi(int x) { return __builtin_amdgcn_update_dpp(0, x, CTRL, 0xF, 0xF, true); }
constexpr int DPP_X1 = 0xB1, DPP_X2 = 0x4E, DPP_HM = 0x141, DPP_R8 = 0x128;
DI float sum16(float v) { v += dppf<DPP_X1>(v); v += dppf<DPP_X2>(v); v += dppf<DPP_HM>(v); v += dppf<DPP_R8>(v); return v; }
DI float max16(float v) { v = fmaxf(v, dppf<DPP_X1>(v)); v = fmaxf(v, dppf<DPP_X2>(v)); v = fmaxf(v, dppf<DPP_HM>(v)); v = fmaxf(v, dppf<DPP_R8>(v)); return v; }
DI float wsum(float v) { v = sum16(v); v += __shfl_xor(v, 16); v += __shfl_xor(v, 32); return v; }
DI float wmaxf(float v) { v = max16(v); v = fmaxf(v, __shfl_xor(v, 16)); v = fmaxf(v, __shfl_xor(v, 32)); return v; }
DI float sigmoidf_(float x) { return 1.f / (1.f + __expf(-x)); }
DI float siluf_(float x) { return x / (1.f + __expf(-x)); }
DI float softplusf_(float x) { return fmaxf(x, 0.f) + log1pf(__expf(-fabsf(x))); }
DI f16x8 ld_h8(const f16* p) { return *(const f16x8*)p; }
DI f16x8 cvt_h8(const float* p) { const f32x4 a = *(const f32x4*)p, b = *(const f32x4*)(p + 4); f16x8 r; r[0] = (f16)a[0]; r[1] = (f16)a[1]; r[2] = (f16)a[2]; r[3] = (f16)a[3]; r[4] = (f16)b[0]; r[5] = (f16)b[1]; r[6] = (f16)b[2]; r[7] = (f16)b[3]; return r; }
DI int src_col(int n) { return n < 2048 ? n : (n < 3456 ? n + 4 : (n < 3460 ? n - 1408 : (n < 3472 ? n + 256 : (n < 3584 ? -1 : n - 124)))); }
DI int dst_col(int s) { return s < 2048 ? s : (s < 2052 ? s + 1408 : (s < 3460 ? s - 4 : (s < 3716 ? s + 124 : s - 256))); }

DI void edge_publish(unsigned* ctr) {
    asm volatile("s_waitcnt vmcnt(0)" ::: "memory"); __syncthreads();
    if (threadIdx.x == 0) { __builtin_amdgcn_fence(__ATOMIC_RELEASE, "agent"); asm volatile("s_waitcnt vmcnt(0)" ::: "memory"); __hip_atomic_fetch_add(ctr, 1u, __ATOMIC_RELAXED, __HIP_MEMORY_SCOPE_AGENT); }
}
DI void edge_wait(unsigned* ctr, unsigned need) {
    if (threadIdx.x == 0) { unsigned sp = 0;
        while (__hip_atomic_load(ctr, __ATOMIC_RELAXED, __HIP_MEMORY_SCOPE_AGENT) < need) { __builtin_amdgcn_s_sleep(8); if (++sp > (1u << 22)) break; }
        __builtin_amdgcn_fence(__ATOMIC_ACQUIRE, "agent"); asm volatile("s_waitcnt vmcnt(0)" ::: "memory"); }
    __syncthreads();
}
namespace pg8 {
constexpr int BM = 256, BK = 64, HALF = 128, HTB = HALF * BK * 2, STAGE_BYTES = 8 * HTB, NXCD = 8, WGM = 8;
DI int lds_byte(int r, int c) { const int st = (r >> 4) * 2 + (c >> 5), rr = r & 15, cc = c & 31, ob = rr * 64 + cc * 2; return st * 1024 + (ob ^ (((ob >> 9) & 1) << 5)); }
DI void stage_rc(int b, int& R, int& C) { const int st = b / 1024, sb = b % 1024, swz = sb ^ (((sb >> 9) & 1) << 5); R = (st >> 1) * 16 + swz / 64; C = (st & 1) * 32 + (swz % 64) / 2; }
DI int perm32(int rho) { const int n = rho >> 4, i = rho & 15; return 8 * (i >> 2) + 4 * n + (i & 3); }
struct Unit { int pm, pn; };
struct Gemm { const f16* A; const f16* Bt; int M, N, K; };
struct StaticOrder {
    int nM, nN, nwg, G, c;
    DI void init(int M, int N, int G_, int c_) { nM = M / BM; nN = N / BM; nwg = nM * nN; G = G_; c = c_; }
    DI bool next(int i, Unit& u) const {
        const long L = (long)i * G + c; if (L >= nwg) return false;
        int wgid = (int)L; { const int q = nwg / NXCD, r = nwg % NXCD, xcd = wgid % NXCD, off = wgid / NXCD; wgid = (xcd < r ? xcd * (q + 1) : r * (q + 1) + (xcd - r) * q) + off; }
        const int nig = WGM * nN, gid = wgid / nig, fm = gid * WGM, gsz = (nM - fm) < WGM ? (nM - fm) : WGM;
        u.pm = fm + ((wgid % nig) % gsz); u.pn = (wgid % nig) / gsz; return true;
    }
    DI void a_ready(const Unit&) const {}
    DI void done(const Unit&) const {}
};
template <class Epi, class Sched>
DI void gemm_phase(LAS unsigned char* lds, const Gemm g, const Sched& S, const Epi& E) {
    const int tid = ltid(), wid = __builtin_amdgcn_readfirstlane(tid >> 6), lane = tid & 63, wr = wid >> 2, wc = wid & 3, fr = lane & 15, fq = lane >> 4;
    const int K = g.K, nt = K / BK;
    unsigned voffA[2], voffB[2];
#pragma unroll
    for (int i = 0; i < 2; ++i) { int R, C; stage_rc(tid * 16 + i * 8192, R, C); const int Rb = Epi::PERM ? ((R & ~31) + perm32(R & 31)) : R;
        voffA[i] = (unsigned)(R * K + C) * 2u; voffB[i] = (unsigned)(Rb * K + C) * 2u; }
    const size_t kstep = (size_t)(BK * 2);
    const size_t hstep = (size_t)HALF * K * 2;
    const size_t tstep = 2 * hstep;
    const unsigned ldsw = (unsigned)wid * 1024u;
    const int aoff = lds_byte(wr * 64 + fr, fq * 8), boff = lds_byte(wc * 32 + fr, fq * 8);
#define PG8_SA(b, h) (((b) * 2 + (h)) * HTB)
#define PG8_SB(b, h) ((4 + (b) * 2 + (h)) * HTB)
#define PG8_STAGE(bufoff, gbase, voff) do { _Pragma("unroll") for (int _i = 0; _i < 2; ++_i) \
        __builtin_amdgcn_global_load_lds((const unsigned*)((const char*)(gbase) + (voff)[_i]), (LAS unsigned*)(lds + (bufoff) + ldsw + _i * 8192), 16, 0, 0); } while (0)
#define PG8_LDA(dst, b, h) do { _Pragma("unroll") for (int m = 0; m < 4; ++m) _Pragma("unroll") for (int k = 0; k < 2; ++k) dst[m][k] = *(const LAS f16x8*)(lds + PG8_SA(b, h) + aoff + m * 2048 + k * 1024); } while (0)
#define PG8_LDB(dst, b, h) do { _Pragma("unroll") for (int n = 0; n < 2; ++n) _Pragma("unroll") for (int k = 0; k < 2; ++k) dst[n][k] = *(const LAS f16x8*)(lds + PG8_SB(b, h) + boff + n * 2048 + k * 1024); } while (0)
#define PG8_MMA(ai, bj, At, Bt) do { __builtin_amdgcn_s_setprio(1); _Pragma("unroll") for (int m = 0; m < 4; ++m) _Pragma("unroll") for (int n = 0; n < 2; ++n) _Pragma("unroll") for (int k = 0; k < 2; ++k) \
        acc[ai][bj][m][n] = __builtin_amdgcn_mfma_f32_16x16x32_f16(Bt[n][k], At[m][k], acc[ai][bj][m][n], 0, 0, 0); __builtin_amdgcn_s_setprio(0); } while (0)
#define PG8_WAIT_V(n) asm volatile("s_waitcnt vmcnt(" #n ")" ::: "memory")
#define PG8_WAIT_L(n) asm volatile("s_waitcnt lgkmcnt(" #n ")" ::: "memory")
#define PG8_BAR __builtin_amdgcn_s_barrier()
#define PG8_SCHED __builtin_amdgcn_sched_barrier(0)
    Unit cur, nxt; int ui = 0;
    if (!S.next(0, cur)) return;
    f32x4 acc[2][2][4][2];
#pragma unroll
    for (int a = 0; a < 2; ++a)
#pragma unroll
        for (int b = 0; b < 2; ++b)
#pragma unroll
            for (int m = 0; m < 4; ++m)
#pragma unroll
                for (int n = 0; n < 2; ++n) acc[a][b][m][n] = (f32x4){0.f, 0.f, 0.f, 0.f};
    f16x8 At[4][2], B0[2][2], B1[2][2];
    const char* cA = (const char*)g.A + (size_t)cur.pm * tstep; const char* cB = (const char*)g.Bt + (size_t)cur.pn * tstep;
    S.a_ready(cur);
    PG8_STAGE(PG8_SB(0, 0), cB, voffB); PG8_STAGE(PG8_SA(0, 0), cA, voffA); PG8_STAGE(PG8_SB(0, 1), cB + hstep, voffB); PG8_STAGE(PG8_SA(0, 1), cA + hstep, voffA);
    if (wr == 1) PG8_BAR;
    PG8_WAIT_V(4); PG8_BAR;
    PG8_STAGE(PG8_SB(1, 0), cB + kstep, voffB); PG8_STAGE(PG8_SA(1, 0), cA + kstep, voffA); PG8_STAGE(PG8_SB(1, 1), cB + hstep + kstep, voffB);
    PG8_WAIT_V(6); PG8_BAR;
    for (;;) {
        const bool has_next = S.next(ui + 1, nxt);
        const char* nA = has_next ? (const char*)g.A + (size_t)nxt.pm * tstep : cA; const char* nB = has_next ? (const char*)g.Bt + (size_t)nxt.pn * tstep : cB;
        for (int t = 0; t < nt; t += 2) {
            const bool last = (t == nt - 2);
            const char* a1 = cA + (size_t)(t + 1) * kstep;
            const char* a2 = last ? nA : cA + (size_t)(t + 2) * kstep; const char* b2 = last ? nB : cB + (size_t)(t + 2) * kstep;
            const char* a3 = a2 + kstep; const char* b3 = b2 + kstep;
            if (last && has_next) S.a_ready(nxt);
            PG8_LDB(B0, 0, 0); PG8_SCHED; PG8_LDA(At, 0, 0); PG8_STAGE(PG8_SA(1, 1), a1 + hstep, voffA);
            PG8_WAIT_L(8); PG8_BAR; PG8_WAIT_L(0); PG8_MMA(0, 0, At, B0); PG8_BAR; PG8_SCHED;
            PG8_LDB(B1, 0, 1); PG8_STAGE(PG8_SB(0, 0), b2, voffB);
            PG8_BAR; PG8_WAIT_L(0); PG8_MMA(0, 1, At, B1); PG8_BAR;
            PG8_LDA(At, 0, 1); PG8_STAGE(PG8_SA(0, 0), a2, voffA);
            PG8_BAR; PG8_WAIT_L(0); PG8_MMA(1, 0, At, B0); PG8_BAR; PG8_SCHED;
            PG8_STAGE(PG8_SB(0, 1), b2 + hstep, voffB);
            PG8_WAIT_V(6); PG8_BAR; PG8_MMA(1, 1, At, B1); PG8_BAR;
            PG8_LDB(B0, 1, 0); PG8_SCHED; PG8_LDA(At, 1, 0); PG8_STAGE(PG8_SA(0, 1), a2 + hstep, voffA);
            PG8_WAIT_L(8); PG8_BAR; PG8_WAIT_L(0); PG8_MMA(0, 0, At, B0); PG8_BAR; PG8_SCHED;
            PG8_LDB(B1, 1, 1); PG8_STAGE(PG8_SB(1, 0), b3, voffB);
            PG8_BAR; PG8_WAIT_L(0); PG8_MMA(0, 1, At, B1); PG8_BAR;
            PG8_LDA(At, 1, 1); PG8_STAGE(PG8_SA(1, 0), a3, voffA);
            PG8_BAR; PG8_WAIT_L(0); PG8_MMA(1, 0, At, B0); PG8_BAR; PG8_SCHED;
            PG8_STAGE(PG8_SB(1, 1), b3 + hstep, voffB);
            PG8_WAIT_V(6); PG8_BAR; PG8_MMA(1, 1, At, B1); PG8_BAR;
        }
        E(acc, cur, wr, wc, fr, fq);
        if (!has_next) break;
#pragma unroll
        for (int a = 0; a < 2; ++a)
#pragma unroll
            for (int b = 0; b < 2; ++b)
#pragma unroll
                for (int m = 0; m < 4; ++m)
#pragma unroll
                    for (int n = 0; n < 2; ++n) acc[a][b][m][n] = (f32x4){0.f, 0.f, 0.f, 0.f};
        cur = nxt; cA = nA; cB = nB; ++ui;
    }
    PG8_WAIT_V(0);
    if (wr == 0) PG8_BAR;
    PG8_BAR;
#undef PG8_SA
#undef PG8_SB
#undef PG8_STAGE
#undef PG8_LDA
#undef PG8_LDB
#undef PG8_MMA
#undef PG8_WAIT_V
#undef PG8_WAIT_L
#undef PG8_BAR
#undef PG8_SCHED
}
}

struct EpiIn {
    static constexpr bool PERM = true;
    f16* proj; const float* rssp; const float* bias; float* kvout;
    DI void operator()(const f32x4 (&acc)[2][2][4][2], const pg8::Unit& u, int wr, int wc, int fr, int fq) const {
        const int row0 = u.pm * 256 + wr * 64 + fr, colt = wc * 32 + 8 * fq;
        f32x4 bv[2][2];
#pragma unroll
        for (int bj = 0; bj < 2; ++bj)
#pragma unroll
            for (int n = 0; n < 2; ++n) bv[bj][n] = *(const f32x4*)(bias + u.pn * 256 + colt + bj * 128 + 4 * n);
        f16* pt = proj + (size_t)u.pn * SEQ * 256;
#pragma unroll
        for (int ai = 0; ai < 2; ++ai)
#pragma unroll
            for (int m = 0; m < 4; ++m) {
                const int row = row0 + ai * 128 + m * 16;
                const f32x4* rp = (const f32x4*)(rssp + (size_t)row * 16);
                const f32x4 s0 = rp[0], s1 = rp[1], s2 = rp[2], s3 = rp[3];
                const float ss = ((s0[0] + s0[1]) + (s0[2] + s0[3])) + ((s1[0] + s1[1]) + (s1[2] + s1[3])) + ((s2[0] + s2[1]) + (s2[2] + s2[3])) + ((s3[0] + s3[1]) + (s3[2] + s3[3]));
                const float r = rsqrtf(ss * (1.f / 1024.f) + EPS);
#pragma unroll
                for (int bj = 0; bj < 2; ++bj) {
                    const f32x4 v0 = acc[ai][bj][m][0] * r + bv[bj][0], v1 = acc[ai][bj][m][1] * r + bv[bj][1];
                    f16x8 h; h[0] = (f16)v0[0]; h[1] = (f16)v0[1]; h[2] = (f16)v0[2]; h[3] = (f16)v0[3]; h[4] = (f16)v1[0]; h[5] = (f16)v1[1]; h[6] = (f16)v1[2]; h[7] = (f16)v1[3];
                    *(f16x8*)(pt + (size_t)row * 256 + colt + bj * 128) = h;
                    if (u.pn == 12) { float* kp = kvout + (size_t)row * 256 + colt + bj * 128; *(f32x4*)kp = v0; *(f32x4*)(kp + 4) = v1; }
                }
            }
    }
};
struct EpiOut {
    static constexpr bool PERM = false;
    const float* xin; float* xout; const float* gate; f16* a16; const float* gnext; float* rssp;
    DI void operator()(const f32x4 (&acc)[2][2][4][2], const pg8::Unit& u, int wr, int wc, int fr, int fq) const {
        const int row0 = u.pm * 256 + wr * 64 + fr, col0 = u.pn * 256 + wc * 32 + 4 * fq;
        float ss[2][4];
#pragma unroll
        for (int ai = 0; ai < 2; ++ai)
#pragma unroll
            for (int m = 0; m < 4; ++m) ss[ai][m] = 0.f;
#pragma unroll
        for (int bj = 0; bj < 2; ++bj)
#pragma unroll
            for (int n = 0; n < 2; ++n) {
                const int col = col0 + bj * 128 + n * 16;
                const f32x4 gv = *(const f32x4*)(gate + col); f32x4 gn = (f32x4){0.f, 0.f, 0.f, 0.f}; if (a16) gn = *(const f32x4*)(gnext + col);
#pragma unroll
                for (int ai = 0; ai < 2; ++ai)
#pragma unroll
                    for (int m = 0; m < 4; ++m) {
                        const int row = row0 + ai * 128 + m * 16;
                        const f32x4 xv = *(const f32x4*)(xin + (size_t)row * 1024 + col);
                        const f32x4 o = xv + gv * acc[ai][bj][m][n];
                        *(f32x4*)(xout + (size_t)row * 1024 + col) = o;
                        ss[ai][m] += (o[0] * o[0] + o[1] * o[1]) + (o[2] * o[2] + o[3] * o[3]);
                        if (a16) { f16x4 h; h[0] = (f16)(o[0] * gn[0]); h[1] = (f16)(o[1] * gn[1]); h[2] = (f16)(o[2] * gn[2]); h[3] = (f16)(o[3] * gn[3]);
                            *(f16x4*)(a16 + (size_t)row * 1024 + col) = h; }
                    }
                asm volatile("" ::: "memory");
            }
        if (a16) {
#pragma unroll
            for (int ai = 0; ai < 2; ++ai)
#pragma unroll
                for (int m = 0; m < 4; ++m) { float v = ss[ai][m]; v += __shfl_xor(v, 16); v += __shfl_xor(v, 32);
                    if (fq == 0) rssp[(size_t)(row0 + ai * 128 + m * 16) * 16 + u.pn * 4 + wc] = v; }
        }
    }
};

template <int MP  , class AFn, class OFn>
DI void skinny_item(LAS unsigned char* lds, const float* W, int ldw, int n0, int ncols, int M, AFn afn, OFn ofn) {
    const int tid = ltid(), wave = tid >> 6, lane = tid & 63;
    LAS float* As = (LAS float*)lds;
    float acc[MP];
#pragma unroll
    for (int m = 0; m < MP; ++m) acc[m] = 0.f;
    for (int kc = 0; kc < 1024; kc += 512) {
        __syncthreads();
#pragma unroll 4
        for (int m = 0; m < MP; ++m) As[tid * 36 + m] = (m < M) ? afn(m, kc + tid) : 0.f;
        __syncthreads();
        const int kb = wave * 64;
#pragma unroll 8
        for (int kk = 0; kk < 64; ++kk) {
            const float w = (lane < ncols) ? W[(size_t)(kc + kb + kk) * ldw + n0 + lane] : 0.f;
            const float av = As[(kb + kk) * 36 + lane];
#pragma unroll
            for (int m = 0; m < MP; ++m) acc[m] += __builtin_bit_cast(float, __builtin_amdgcn_readlane(__builtin_bit_cast(int, av), m)) * w;
        }
    }
    __syncthreads();
    LAS float* R = (LAS float*)lds;
#pragma unroll
    for (int m = 0; m < MP; ++m) R[(wave * 36 + m) * 64 + lane] = acc[m];
    __syncthreads();
    for (int idx = tid; idx < M * 64; idx += 512) { const int m = idx >> 6, c = idx & 63; float s = 0.f;
#pragma unroll
        for (int w = 0; w < 8; ++w) s += R[(w * 36 + m) * 64 + c];
        if (c < ncols) ofn(m, n0 + c, s); }
    __syncthreads();
}

template <bool F32> struct Raw16 { f32x4 f[4]; f16x8 hv[2];
    DI void ld(const void* p) { if (F32) {
#pragma unroll
            for (int i = 0; i < 4; ++i) f[i] = *(const f32x4*)((const float*)p + 4 * i); } else { hv[0] = *(const f16x8*)p; hv[1] = *(const f16x8*)((const f16*)p + 8); } }
    DI f16x8 get(int i) const { if (F32) { const f32x4 a = f[2 * i], b = f[2 * i + 1]; f16x8 r; r[0] = (f16)a[0]; r[1] = (f16)a[1]; r[2] = (f16)a[2]; r[3] = (f16)a[3]; r[4] = (f16)b[0]; r[5] = (f16)b[1]; r[6] = (f16)b[2]; r[7] = (f16)b[3]; return r; } return hv[i]; } };
template <bool SRC_F32, class ChunkFn>
DI void compress_item(LAS unsigned char* lds, ChunkFn chunkp  , int c0, const f16* w1t, const float* peb, const f16* w2t  , const float* b2, const float* kg, float* out, f16* out16, f16* outT16) {
    typedef typename std::conditional<SRC_F32, float, f16>::type T;
    const int tid = ltid(), wave = tid >> 6, lane = tid & 63, wm = wave >> 2, wq = wave & 3, r = lane & 31, h = lane >> 5;
    LAS f16* As = (LAS f16*)lds;
    LAS f16* Bs = (LAS f16*)(lds + 2 * 18432);
    f32x16 acc[2][2];
#pragma unroll
    for (int a = 0; a < 2; ++a)
#pragma unroll
        for (int b = 0; b < 2; ++b)
#pragma unroll
            for (int i = 0; i < 16; ++i) acc[a][b][i] = 0.f;
    const int am = tid >> 2, aseg = tid & 3, bn = tid >> 1, bseg = tid & 1;
    int ch = c0 + am; ch = ch < 1023 ? ch : 1023;
    const T* asrc = (const T*)chunkp(ch) + aseg * 16;
    const f16* bsrc = w1t + (size_t)(bn & 127) * 2048 + (size_t)(bn >> 7) * 1024 + bseg * 32;
    Raw16<SRC_F32> ra[3]; f16x8 rb[3][4];
#pragma unroll
    for (int i = 0; i < 3; ++i) { ra[i].ld(asrc + i * 256);
#pragma unroll
        for (int j = 0; j < 4; ++j) rb[i][j] = ld_h8(bsrc + i * 64 + 8 * j); }
    __syncthreads();
    *(LAS f16x8*)(As + am * 72 + aseg * 16) = ra[0].get(0); *(LAS f16x8*)(As + am * 72 + aseg * 16 + 8) = ra[0].get(1);
#pragma unroll
    for (int i = 0; i < 4; ++i) *(LAS f16x8*)(Bs + bn * 72 + bseg * 32 + 8 * i) = rb[0][i];
    ra[0].ld(asrc + 3 * 256);
#pragma unroll
    for (int i = 0; i < 4; ++i) rb[0][i] = ld_h8(bsrc + 3 * 64 + 8 * i);
    lds_barrier();
#pragma unroll
    for (int kb = 0; kb < 16; ++kb) {
        const int cur = kb & 1;
        const LAS f16* Ac = As + cur * 9216 + (64 * wm + r) * 72 + 8 * h; const LAS f16* Bc = Bs + cur * 18432 + (64 * wq + r) * 72 + 8 * h;
#pragma unroll
        for (int ks = 0; ks < 4; ++ks) {
            const f16x8 a0 = *(const LAS f16x8*)(Ac + 16 * ks), a1 = *(const LAS f16x8*)(Ac + 32 * 72 + 16 * ks), b0 = *(const LAS f16x8*)(Bc + 16 * ks), b1 = *(const LAS f16x8*)(Bc + 32 * 72 + 16 * ks);
            acc[0][0] = __builtin_amdgcn_mfma_f32_32x32x16_f16(a0, b0, acc[0][0], 0, 0, 0); acc[0][1] = __builtin_amdgcn_mfma_f32_32x32x16_f16(a0, b1, acc[0][1], 0, 0, 0);
            acc[1][0] = __builtin_amdgcn_mfma_f32_32x32x16_f16(a1, b0, acc[1][0], 0, 0, 0); acc[1][1] = __builtin_amdgcn_mfma_f32_32x32x16_f16(a1, b1, acc[1][1], 0, 0, 0);
        }
        if (kb + 1 < 16) { const int nx = cur ^ 1, sl = (kb + 1) % 3;
            *(LAS f16x8*)(As + nx * 9216 + am * 72 + aseg * 16) = ra[sl].get(0); *(LAS f16x8*)(As + nx * 9216 + am * 72 + aseg * 16 + 8) = ra[sl].get(1);
#pragma unroll
            for (int i = 0; i < 4; ++i) *(LAS f16x8*)(Bs + nx * 18432 + bn * 72 + bseg * 32 + 8 * i) = rb[sl][i];
            if (kb + 4 < 16) { ra[sl].ld(asrc + (kb + 4) * 256);
#pragma unroll
                for (int i = 0; i < 4; ++i) rb[sl][i] = ld_h8(bsrc + (kb + 4) * 64 + 8 * i); } }
        lds_barrier();
    }
    LAS float* SL = (LAS float*)lds;
    LAS f16* HS = (LAS f16*)(lds + 65536);
    if (wq >= 2) {
#pragma unroll
        for (int a = 0; a < 2; ++a)
#pragma unroll
            for (int b = 0; b < 2; ++b)
#pragma unroll
                for (int i = 0; i < 16; ++i) SL[(64 * wm + 32 * a + (i & 3) + 8 * (i >> 2) + 4 * h) * 128 + 64 * (wq - 2) + 32 * b + r] = acc[a][b][i];
    }
    __syncthreads();
    if (wq < 2) {
#pragma unroll
        for (int a = 0; a < 2; ++a)
#pragma unroll
            for (int b = 0; b < 2; ++b) { const int f = 64 * wq + 32 * b + r; float pb = 0.f;
#pragma unroll
                for (int p8 = 0; p8 < 8; ++p8) pb += peb[p8 * 128 + f];
#pragma unroll
                for (int i = 0; i < 16; ++i) { const int m = 64 * wm + 32 * a + (i & 3) + 8 * (i >> 2) + 4 * h; const float sv = m < 127 ? SL[(m + 1) * 128 + f] : 0.f;
                    HS[m * 136 + f] = (f16)siluf_(acc[a][b][i] + sv + pb); } }
    }
    __syncthreads();
    {
        const int fr = lane & 15, q = lane >> 4;
        f32x4 o[4];
#pragma unroll
        for (int et = 0; et < 4; ++et) o[et] = (f32x4){0.f, 0.f, 0.f, 0.f};
#pragma unroll
        for (int ks = 0; ks < 4; ++ks) { const f16x8 av = *(const LAS f16x8*)(HS + (16 * wave + fr) * 136 + 32 * ks + 8 * q);
#pragma unroll
            for (int et = 0; et < 4; ++et) o[et] = __builtin_amdgcn_mfma_f32_16x16x32_f16(av, ld_h8(w2t + (size_t)(16 * et + fr) * 128 + 32 * ks + 8 * q), o[et], 0, 0, 0); }
        float bb[4], gg[4];
#pragma unroll
        for (int et = 0; et < 4; ++et) { bb[et] = b2[16 * et + fr]; gg[et] = kg ? kg[16 * et + fr] : 1.f; }
#pragma unroll
        for (int j = 0; j < 4; ++j) {
            const int row = 16 * wave + 4 * q + j, blk = c0 + row; float v[4], ss = 0.f;
#pragma unroll
            for (int et = 0; et < 4; ++et) { v[et] = o[et][j] + bb[et]; ss += v[et] * v[et]; }
            if (kg) { ss += __shfl_xor(ss, 1); ss += __shfl_xor(ss, 2); ss += __shfl_xor(ss, 4); ss += __shfl_xor(ss, 8); const float rn = rsqrtf(ss * (1.f / 64.f) + EPS);
#pragma unroll
                for (int et = 0; et < 4; ++et) v[et] = v[et] * rn * gg[et]; }
            const bool okrow = row < 127 && blk < 1023, wr16 = row < 127 && blk < 1024;
#pragma unroll
            for (int et = 0; et < 4; ++et) { const float x = okrow ? v[et] : 0.f; const int e = 16 * et + fr;
                if (out && okrow) out[(size_t)blk * 64 + e] = x;
                if (out16 && wr16) out16[(size_t)blk * 64 + e] = (f16)x;
                if (outT16 && wr16) outT16[(size_t)e * 1024 + blk] = (f16)x; }
        }
    }
    __syncthreads();
}

struct PromptKV {
    const f16 *ks, *vs, *kw, *vw;
    DI void krow_sel(int pos, float (&k)[64]) const { const f16* p = ks + (size_t)pos * 64;
#pragma unroll
        for (int i = 0; i < 8; ++i) { const f16x8 v = ld_h8(p + i * 8);
#pragma unroll
            for (int j = 0; j < 8; ++j) k[i * 8 + j] = (float)v[j]; } }
    DI float v_sel(int pos, int d) const { return (float)vs[(size_t)pos * 64 + d]; }
    DI void krow_win(int pos, float (&k)[64]) const { const f16* p = kw + (size_t)pos * 64;
#pragma unroll
        for (int i = 0; i < 8; ++i) { const f16x8 v = ld_h8(p + i * 8);
#pragma unroll
            for (int j = 0; j < 8; ++j) k[i * 8 + j] = (float)v[j]; } }
    DI float v_win(int pos, int d) const { return (float)vw[(size_t)pos * 64 + d]; }
};
struct SampleKV {
    const float* ckv; const int* pt; const float* cwin; const float* nks; const float* nvs; const float* nkw; const float* nvw;
    DI const float* prow(int pos, int slot) const { return ckv + ((size_t)pt[pos >> 7] * 128 + (pos & 127)) * 256 + slot * 64; }
    DI void ld64(const float* p, float (&k)[64]) const {
#pragma unroll
        for (int i = 0; i < 16; ++i) { const f32x4 v = *(const f32x4*)(p + i * 4); k[i * 4] = v[0]; k[i * 4 + 1] = v[1]; k[i * 4 + 2] = v[2]; k[i * 4 + 3] = v[3]; } }
    DI void krow_sel(int pos, float (&k)[64]) const { ld64(pos < PAST ? prow(pos, 2) : nks, k); }
    DI float v_sel(int pos, int d) const { return pos < PAST ? prow(pos, 3)[d] : nvs[d]; }
    DI void krow_win(int pos, float (&k)[64]) const { ld64(pos < PAST ? cwin + (size_t)(pos - (PAST - 512)) * 128 : nkw, k); }
    DI float v_win(int pos, int d) const { return pos < PAST ? cwin[(size_t)(pos - (PAST - 512)) * 128 + 64 + d] : nvw[d]; }
};
template <class KV>
DI void nsa_token(LAS float* wl, int qpos, const float* KC, const float* VC, const KV& kv, const float* gates  , float (&o)[4]) {
    const int lane = ltid() & 63;
    LAS float* sc = wl; LAS float* qs = wl + 4096; LAS int* sel = (LAS int*)(wl + 4096 + 256);
    const int cur = qpos >> 6;
    const int ncv = qpos >= 31 ? ((qpos - 31) >> 4) + 1 : 0;
    float oc[4] = {0.f, 0.f, 0.f, 0.f}, os[4] = {0.f, 0.f, 0.f, 0.f}, ow[4] = {0.f, 0.f, 0.f, 0.f};
    {
        float mx[4] = {-3e38f, -3e38f, -3e38f, -3e38f};
        for (int c = lane; c < ncv; c += 64) {
            asm volatile("" ::: "memory");
            float s[4] = {0.f, 0.f, 0.f, 0.f}; const float* kp = KC + (size_t)c * 64;
#pragma unroll
            for (int d4 = 0; d4 < 16; ++d4) { const f32x4 kvv = *(const f32x4*)(kp + d4 * 4);
#pragma unroll
                for (int j = 0; j < 4; ++j) { const f32x4 q = *(const LAS f32x4*)(qs + (d4 * 4 + j) * 4); s[0] += q[0] * kvv[j]; s[1] += q[1] * kvv[j]; s[2] += q[2] * kvv[j]; s[3] += q[3] * kvv[j]; } }
#pragma unroll
            for (int hh = 0; hh < 4; ++hh) { s[hh] *= 0.125f; sc[hh * 1024 + c] = s[hh]; mx[hh] = fmaxf(mx[hh], s[hh]); }
        }
        float inv[4];
#pragma unroll
        for (int hh = 0; hh < 4; ++hh) { mx[hh] = wmaxf(mx[hh]); float sm = 0.f; for (int c = lane; c < ncv; c += 64) { const float e = __expf(sc[hh * 1024 + c] - mx[hh]); sc[hh * 1024 + c] = e; sm += e; } sm = wsum(sm); inv[hh] = ncv > 0 ? 1.f / sm : 0.f; }
        for (int c = lane; c < ncv; c += 64) {
#pragma unroll
            for (int hh = 0; hh < 4; ++hh) sc[hh * 1024 + c] *= inv[hh]; }
        __builtin_amdgcn_wave_barrier();
        for (int c = 0; c < ncv; ++c) { const float v = VC[(size_t)c * 64 + lane];
#pragma unroll
            for (int hh = 0; hh < 4; ++hh) oc[hh] += sc[hh * 1024 + c] * v; }
    }
    const int nsel = (cur + 1) < 16 ? (cur + 1) : 16;
    {
        float scv[5];
#pragma unroll
        for (int i = 0; i < 5; ++i) {
            const int j = lane + 64 * i; float v = -3e38f;
            if (j <= cur) {
                if (j == 0 || j == cur || j == cur - 1) v = 3e38f;
                else { float a = 0.f;
#pragma unroll
                    for (int o5 = -1; o5 < 4; ++o5) { const int c = 4 * j + o5; if (c >= 0 && c < ncv) { const float p = (sc[c] + sc[1024 + c]) + (sc[2048 + c] + sc[3072 + c]); a += (o5 == -1 || o5 == 3) ? 0.5f * p : p; } }
                    v = a; }
            }
            scv[i] = v;
        }
        for (int k = 0; k < nsel; ++k) {
            float bv = scv[0]; int bi = lane;
#pragma unroll
            for (int i = 1; i < 5; ++i) if (scv[i] > bv) { bv = scv[i]; bi = lane + 64 * i; }
#pragma unroll
            for (int off = 32; off > 0; off >>= 1) { const float ov = __shfl_xor(bv, off); const int oi = __shfl_xor(bi, off); if (ov > bv || (ov == bv && oi < bi)) { bv = ov; bi = oi; } }
            if (lane == 0) sel[k] = bi;
#pragma unroll
            for (int i = 0; i < 5; ++i) if (lane + 64 * i == bi) scv[i] = -3e38f;
        }
        __builtin_amdgcn_wave_barrier();
    }
    {
        float mx[4] = {-3e38f, -3e38f, -3e38f, -3e38f};
        for (int k = 0; k < nsel; ++k) {
            asm volatile("" ::: "memory");
            const int pos = sel[k] * 64 + lane; float s[4] = {-1e30f, -1e30f, -1e30f, -1e30f};
            if (pos <= qpos) { float kr[64]; kv.krow_sel(pos, kr); s[0] = s[1] = s[2] = s[3] = 0.f;
#pragma unroll
                for (int d = 0; d < 64; ++d) { const f32x4 q = *(const LAS f32x4*)(qs + d * 4); s[0] += q[0] * kr[d]; s[1] += q[1] * kr[d]; s[2] += q[2] * kr[d]; s[3] += q[3] * kr[d]; }
#pragma unroll
                for (int hh = 0; hh < 4; ++hh) s[hh] *= 0.125f; }
#pragma unroll
            for (int hh = 0; hh < 4; ++hh) { sc[hh * 1024 + k * 64 + lane] = s[hh]; mx[hh] = fmaxf(mx[hh], s[hh]); }
        }
        float inv[4];
#pragma unroll
        for (int hh = 0; hh < 4; ++hh) { mx[hh] = wmaxf(mx[hh]); float sm = 0.f; for (int k = 0; k < nsel; ++k) { const float sv = sc[hh * 1024 + k * 64 + lane]; const float e = sv > -1e29f ? __expf(sv - mx[hh]) : 0.f; sc[hh * 1024 + k * 64 + lane] = e; sm += e; } sm = wsum(sm); inv[hh] = 1.f / sm; }
        __builtin_amdgcn_wave_barrier();
        for (int k = 0; k < nsel; ++k) { const int p0 = sel[k] * 64; int nk = qpos - p0 + 1; nk = nk > 64 ? 64 : nk;
            for (int kk = 0; kk < nk; ++kk) { const float v = kv.v_sel(p0 + kk, lane);
#pragma unroll
                for (int hh = 0; hh < 4; ++hh) os[hh] += sc[hh * 1024 + k * 64 + kk] * v; } }
#pragma unroll
        for (int hh = 0; hh < 4; ++hh) os[hh] *= inv[hh];
        __builtin_amdgcn_wave_barrier();
    }
    {
        const int lo = qpos - 512 > 0 ? qpos - 512 : 0, nw = qpos - lo + 1;
        float mx[4] = {-3e38f, -3e38f, -3e38f, -3e38f};
        for (int i = lane; i < nw; i += 64) { asm volatile("" ::: "memory"); float kr[64]; kv.krow_win(lo + i, kr); float s[4] = {0.f, 0.f, 0.f, 0.f};
#pragma unroll
            for (int d = 0; d < 64; ++d) { const f32x4 q = *(const LAS f32x4*)(qs + d * 4); s[0] += q[0] * kr[d]; s[1] += q[1] * kr[d]; s[2] += q[2] * kr[d]; s[3] += q[3] * kr[d]; }
#pragma unroll
            for (int hh = 0; hh < 4; ++hh) { s[hh] *= 0.125f; sc[hh * 1024 + i] = s[hh]; mx[hh] = fmaxf(mx[hh], s[hh]); } }
        float inv[4];
#pragma unroll
        for (int hh = 0; hh < 4; ++hh) { mx[hh] = wmaxf(mx[hh]); float sm = 0.f; for (int i = lane; i < nw; i += 64) { const float e = __expf(sc[hh * 1024 + i] - mx[hh]); sc[hh * 1024 + i] = e; sm += e; } sm = wsum(sm); inv[hh] = 1.f / sm; }
        __builtin_amdgcn_wave_barrier();
        for (int i = 0; i < nw; ++i) { const float v = kv.v_win(lo + i, lane);
#pragma unroll
            for (int hh = 0; hh < 4; ++hh) ow[hh] += sc[hh * 1024 + i] * v; }
#pragma unroll
        for (int hh = 0; hh < 4; ++hh) ow[hh] *= inv[hh];
        __builtin_amdgcn_wave_barrier();
    }
#pragma unroll
    for (int hh = 0; hh < 4; ++hh) o[hh] = gates[hh * 3] * oc[hh] + gates[hh * 3 + 1] * os[hh] + gates[hh * 3 + 2] * ow[hh];
}

template <class LF, class SF>
DI void tr64(LAS unsigned char* lds, LF lf, SF sf) {
    LAS float* T = (LAS float*)lds;
    const int tid = ltid();
    __syncthreads();
#pragma unroll
    for (int e8 = 0; e8 < 8; ++e8) { const int e = tid + 512 * e8, kk = e >> 6, nn = e & 63; T[kk * 65 + nn] = lf(kk, nn); }
    __syncthreads();
#pragma unroll
    for (int e8 = 0; e8 < 8; ++e8) { const int e = tid + 512 * e8, nn = e >> 6, kk = e & 63; sf(nn, kk, (f16)T[kk * 65 + nn]); }
}

typedef const Args __attribute__((address_space(4)))* ArgP;
struct Ctx { ArgP ap; LAS unsigned char* lds; unsigned char* ws; float* out; int tid, lane, wave, bid, G; };
DI Ctx mkctx(LAS unsigned char* lds) {
    Ctx c; const char __attribute__((address_space(4)))* kp = (const char __attribute__((address_space(4)))*)__builtin_amdgcn_kernarg_segment_ptr();
    asm volatile("" : "+s"(kp));
    c.ap = (ArgP)kp; c.lds = lds; c.ws = c.ap->ws; c.out = c.ap->out;
    int tid = threadIdx.x; asm volatile("" : "+v"(tid));
    c.tid = tid; c.lane = tid & 63; c.wave = __builtin_amdgcn_readfirstlane(tid >> 6); c.bid = blockIdx.x; c.G = gridDim.x;
    return c;
}
#define INP(i) ((const float*)c.ap->in[i])
#define WSF(off) ((float*)(c.ws + (off)))
#define WSH(off) ((f16*)(c.ws + (off)))

DI void ph_prologue(LAS unsigned char* lds_) {
    const Ctx c = mkctx(lds_); LAS unsigned char* lds = c.lds; const int tid = c.tid, bid = c.bid, G = c.G;
    const float* c_p = INP(I_CP); const float* c_s = INP(I_CS); const float* w_ada = INP(I_WADA); const float* b_ada = INP(I_BADA);
    const float* w_in = INP(I_WIN); const float* w_out = INP(I_WOUT); const float* w1 = INP(I_W1);
    float* ADA = WSF(WS_ADA); float* BIAS = WSF(WS_BIAS); float* PEB = WSF(WS_PEB); f16* WTIN = WSH(WS_WTIN); f16* WTOUT = WSH(WS_WTOUT); f16* W1T = WSH(WS_W1T);
    constexpr int N_ADA = 96, N_WTIN = 1920, N_WTOUT = 512, N_W1T = 256, N_PEB = 32, N_W2T = 8, N_ALL = N_ADA + N_WTIN + N_WTOUT + N_W1T + N_PEB + N_W2T + 1;
    constexpr int XA = 1;
    const bool reb = G == 256; const int n_mine = reb ? (bid < N_ADA ? 1 + XA : (N_ALL - N_ADA - XA * N_ADA - (bid - N_ADA) + 159) / 160) : (N_ALL - bid + G - 1) / G;
    for (int k = 0; k < n_mine; ++k) {
        const int it = !reb ? bid + k * G : (bid < N_ADA ? (k == 0 ? bid : N_ADA + XA * bid + (k - 1)) : N_ADA + XA * N_ADA + (bid - N_ADA) + 160 * k);
        int i = it;
        if (i < N_ADA) { const int l = i / 48, n0 = (i % 48) * 64;
            skinny_item<36>(lds, w_ada + (size_t)l * 1024 * 3072, 3072, n0, 64, 33,
                [&](int m, int k) { return siluf_(m < 32 ? c_s[m * 1024 + k] : c_p[k]); },
                [&](int m, int n, float v) { ADA[((size_t)l * 33 + m) * 3072 + n] = v + b_ada[l * 3072 + n]; });
            continue; }
        i -= N_ADA;
        if (i < N_WTIN) { const int l = i / 960, r = i % 960, n0 = (r / 16) * 64, k0 = (r % 16) * 64; const float* src = w_in + (size_t)l * 1024 * DIN; f16* dst = WTIN + (size_t)l * NPD * 1024;
            tr64(lds, [&](int kk, int nn) { const int sc = src_col(n0 + nn); return sc >= 0 ? src[(size_t)(k0 + kk) * DIN + sc] : 0.f; },
                      [&](int nn, int kk, f16 v) { dst[(size_t)(n0 + nn) * 1024 + k0 + kk] = v; });
            continue; }
        i -= N_WTIN;
        if (i < N_WTOUT) { const int l = i / 256, r = i % 256, n0 = (r / 16) * 64, k0 = (r % 16) * 64; const float* src = w_out + (size_t)l * 1024 * 1024; f16* dst = WTOUT + (size_t)l * 1024 * 1024;
            tr64(lds, [&](int kk, int nn) { return src[(size_t)(k0 + kk) * 1024 + n0 + nn]; },
                      [&](int nn, int kk, f16 v) { dst[(size_t)(n0 + nn) * 1024 + k0 + kk] = v; });
            continue; }
        i -= N_WTOUT;
        if (i < N_W1T) { const int ls = i / 64, r = i % 64, k0 = (r / 2) * 64, n0 = (r % 2) * 64; const float* src = w1 + (size_t)ls * 2048 * 128; f16* dst = W1T + (size_t)ls * 128 * 2048;
            tr64(lds, [&](int kk, int nn) { return src[(size_t)(k0 + kk) * 128 + n0 + nn]; },
                      [&](int nn, int kk, f16 v) { dst[(size_t)(n0 + nn) * 2048 + k0 + kk] = v; });
            continue; }
        i -= N_W1T;
        if (i < N_PEB) { const int ls = i >> 3, ks8 = i & 7; const float* pe = INP(I_PE) + (size_t)ls * 2048 + ks8 * 256; const float* w = w1 + ((size_t)ls * 2048 + ks8 * 256) * 128; const float* b1 = INP(I_B1) + ls * 128;
            LAS float* R = (LAS float*)lds; const int f = tid & 127, kq = tid >> 7; float sacc = 0.f;
            __syncthreads();
#pragma unroll 16
            for (int k = kq * 64; k < kq * 64 + 64; ++k) sacc += pe[k] * w[(size_t)k * 128 + f];
            R[kq * 128 + f] = sacc; __syncthreads();
            if (tid < 128) WSF(WS_PEBP)[(ls * 8 + ks8) * 128 + tid] = (ks8 == 0 ? b1[tid] : 0.f) + (R[tid] + R[128 + tid]) + (R[256 + tid] + R[384 + tid]);
            __syncthreads();
            continue; }
        i -= N_PEB;
        if (i < N_W2T) { const int ls = i >> 1, f0 = (i & 1) * 64; const float* src = INP(I_W2) + (size_t)ls * 128 * 64; f16* dst = WSH(WS_W2T) + (size_t)ls * 64 * 128;
            tr64(lds, [&](int kk, int nn) { return src[(size_t)(f0 + kk) * 64 + nn]; },
                      [&](int nn, int kk, f16 v) { dst[(size_t)nn * 128 + f0 + kk] = v; });
            continue; }
        for (int e = tid; e < 2 * NPD; e += 512) BIAS[e] = 0.f;
    }
}

DI void ph_sample_compress(LAS unsigned char* lds_) {
    const Ctx c = mkctx(lds_);
    const float* w2 = INP(I_W2); const float* b2 = INP(I_B2); const float* k_g = INP(I_KG); const float* cache_kv = INP(I_CKV); const int* page_table = (const int*)c.ap->in[I_PT];
    f16* W1T = WSH(WS_W1T); float* PEB = WSF(WS_PEBP); float* KCS = WSF(WS_KCS); float* VCS = WSF(WS_VCS);
    for (int it = c.bid; it < 1152; it += c.G) {
        const int grp = it % 9, st_ = it / 9, slot = st_ & 1, b = (st_ >> 1) & 31, l = st_ >> 6;
        const float* ckv = cache_kv + (size_t)l * NPOOL * 128 * 256; const int* pt = page_table + b * 128;
        compress_item<true>(c.lds, [&](int ch) { return (const void*)(ckv + ((size_t)pt[ch >> 3] * 128 + (ch & 7) * 16) * 256 + slot * 64); }, grp * 127,
                            W1T + (size_t)(l * 2 + slot) * 128 * 2048, PEB + (l * 2 + slot) * 1024, WSH(WS_W2T) + (size_t)(l * 2 + slot) * 64 * 128, b2 + (l * 2 + slot) * 64,
                            slot == 0 ? k_g + l * 192 : nullptr, (slot == 0 ? KCS : VCS) + (size_t)(l * NB + b) * 1024 * 64, nullptr, nullptr);
    }
}
DI void ph_prep(LAS unsigned char* lds_) {
    const Ctx c = mkctx(lds_); const int tid = c.tid, lane = c.lane, wave = c.wave, bid = c.bid, G = c.G;
    float* ADA = WSF(WS_ADA); float* BIAS = WSF(WS_BIAS);
    {
        const f16* WTIN = WSH(WS_WTIN);
        const bool lite = G == 256;
        const int pb = lite ? bid - 128 : bid, pG = lite ? 128 : G;
        if (pb >= 0)
        for (int col = pb * 8 + wave; col < 2 * NPD; col += pG * 8) { const int l = col / NPD; const float* sh = ADA + ((size_t)l * 33 + 32) * 3072 + lane * 16; const f16* wp = WTIN + (size_t)col * 1024 + lane * 16;
            const f16x8 w0 = ld_h8(wp), w1 = ld_h8(wp + 8); float acc = 0.f;
#pragma unroll
            for (int i = 0; i < 8; ++i) acc += sh[i] * (float)w0[i] + sh[8 + i] * (float)w1[i];
            acc = wsum(acc); if (lane == 0) BIAS[col] = acc; }
    }
    const float* ng = INP(I_NG);
    if (bid == 0) { float* GNX = WSF(WS_GNX); const float* sc1 = ADA + (size_t)(33 + 32) * 3072 + 1024;
        for (int k = tid; k < 1024; k += 512) GNX[k] = ng[1024 + k] * (1.f + sc1[k]); }
    const float* ada_p = ADA + (size_t)32 * 3072; const float* x_p = INP(I_XP); f16* A16 = WSH(WS_A16); float* RSSP = WSF(WS_RSSP);
    float gp[16];
#pragma unroll
    for (int i = 0; i < 4; ++i) { const f32x4 g4 = *(const f32x4*)(ng + i * 256 + lane * 4), s4 = *(const f32x4*)(ada_p + 1024 + i * 256 + lane * 4);
#pragma unroll
        for (int j = 0; j < 4; ++j) gp[i * 4 + j] = g4[j] * (1.f + s4[j]); }
    const bool lite2 = G == 256; const int pb2 = lite2 ? bid - 128 : bid, pG2 = lite2 ? 128 : G;
    if (pb2 >= 0)
    for (int row = pb2 * 8 + wave; row < SEQ; row += pG2 * 8) {
        const float* xr = x_p + (size_t)row * 1024; float ss = 0.f;
#pragma unroll
        for (int i = 0; i < 4; ++i) { const f32x4 v = *(const f32x4*)(xr + i * 256 + lane * 4); ss += (v[0] * v[0] + v[1] * v[1]) + (v[2] * v[2] + v[3] * v[3]);
            f16x4 h; h[0] = (f16)(v[0] * gp[i * 4]); h[1] = (f16)(v[1] * gp[i * 4 + 1]); h[2] = (f16)(v[2] * gp[i * 4 + 2]); h[3] = (f16)(v[3] * gp[i * 4 + 3]);
            *(f16x4*)(A16 + (size_t)row * 1024 + i * 256 + lane * 4) = h; }
        ss = wsum(ss);
        if (lane < 16) RSSP[(size_t)row * 16 + lane] = lane == 0 ? ss : 0.f;
    }
}

template <int NT  , class OFn>
DI void sample_gemm_item(LAS unsigned char* lds, const f16* Bt, int n0, OFn ofn) {
    constexpr int KW = 8 / NT, KL = 1024 / KW;
    const int tid = ltid(), wave = tid >> 6, lane = tid & 63, wn = wave % NT, wk = wave / NT, r = lane & 31, h = lane >> 5;
    const LAS f16* Ah = (const LAS f16*)lds + r * 1032 + wk * KL + 8 * h; const f16* bp = Bt + (size_t)(n0 + 32 * wn + r) * 1024 + wk * KL + 8 * h;
    f32x16 acc;
#pragma unroll
    for (int i = 0; i < 16; ++i) acc[i] = 0.f;
#pragma unroll 8
    for (int st = 0; st < KL / 16; ++st) acc = __builtin_amdgcn_mfma_f32_32x32x16_f16(*(const LAS f16x8*)(Ah + 16 * st), ld_h8(bp + 16 * st), acc, 0, 0, 0);
    LAS float* RED = (LAS float*)(lds + 67584);
#pragma unroll
    for (int i = 0; i < 16; ++i) RED[(wk * 32 + (i & 3) + 8 * (i >> 2) + 4 * h) * (32 * NT) + 32 * wn + r] = acc[i];
    __syncthreads();
    for (int e = tid; e < 1024 * NT; e += 512) { float v = 0.f;
#pragma unroll
        for (int w = 0; w < KW; ++w) v += RED[w * 1024 * NT + e];
        ofn(e / (32 * NT), n0 + e % (32 * NT), v); }
    __syncthreads();
}
DI void ph_inproj(LAS unsigned char* lds_, int l) {
    const Ctx c = mkctx(lds_);
    pg8::Gemm g{WSH(WS_A16), WSH(WS_WTIN) + (size_t)l * NPD * 1024, SEQ, NPD, 1024}; pg8::StaticOrder S; S.init(SEQ, NPD, c.G, c.bid);
    EpiIn E{WSH(WS_PROJ), WSF(WS_RSSP), WSF(WS_BIAS) + l * NPD, c.out + O_KVP + (size_t)l * SEQ * 256};
    pg8::gemm_phase<EpiIn, pg8::StaticOrder>(c.lds, g, S, E);
    __syncthreads();
}
DI void ph_hsample(LAS unsigned char* lds_, int l) {
    const Ctx c = mkctx(lds_); const int lane = c.lane;
    if (c.bid >= 4) return;
    const int m = c.bid * 8 + c.wave;
    const float* xr = (l == 0 ? INP(I_XS) : WSF(WS_XS1)) + (size_t)m * 1024; const float* ad = WSF(WS_ADA) + ((size_t)l * 33 + m) * 3072; const float* ng = INP(I_NG) + l * 1024; f16* hs = WSH(WS_HS16) + (size_t)m * 1024;
    f32x4 xv[4]; float ss = 0.f;
#pragma unroll
    for (int i = 0; i < 4; ++i) { xv[i] = *(const f32x4*)(xr + i * 256 + lane * 4); ss += (xv[i][0] * xv[i][0] + xv[i][1] * xv[i][1]) + (xv[i][2] * xv[i][2] + xv[i][3] * xv[i][3]); }
    const float rn = rsqrtf(wsum(ss) * (1.f / 1024.f) + EPS);
#pragma unroll
    for (int i = 0; i < 4; ++i) { const int k = i * 256 + lane * 4; const f32x4 g = *(const f32x4*)(ng + k), sc = *(const f32x4*)(ad + 1024 + k), sh = *(const f32x4*)(ad + k); f16x4 hv;
#pragma unroll
        for (int j = 0; j < 4; ++j) hv[j] = (f16)(xv[i][j] * rn * g[j] * (1.f + sc[j]) + sh[j]);
        *(f16x4*)(hs + k) = hv; }
}
DI void ph_inproj_sample(LAS unsigned char* lds_, int l) {
    const Ctx c = mkctx(lds_); const int tid = c.tid;
    const int it = c.bid - (c.G - 64);
    if (it < 0 || it >= 60) return;
    float* PROJS = WSF(WS_PROJS); const f16* HS = WSH(WS_HS16); LAS f16* Ah = (LAS f16*)c.lds;
    __syncthreads();
#pragma unroll
    for (int i = 0; i < 8; ++i) { const int e = (tid + 512 * i) * 8; *(LAS f16x8*)(Ah + (e >> 10) * 1032 + (e & 1023)) = ld_h8(HS + e); }
    __syncthreads();
    sample_gemm_item<2>(c.lds, WSH(WS_WTIN) + (size_t)l * NPD * 1024, it * 64, [&](int m, int n, float v) { PROJS[m * NPD + n] = v; });
}

#define PT(t) (P + (size_t)(t) * SEQ * 256)
DI void ph_ssd_local(LAS unsigned char* lds_, int l) {
    const Ctx c = mkctx(lds_); LAS unsigned char* lds = c.lds; const int tid = c.tid, lane = c.lane, wave = c.wave;
    const f16* P = WSH(WS_PROJ); f16* ACT = WSH(WS_ACT); float* YD = WSF(WS_YD); float* CST = WSF(WS_CST); float* ACS = WSF(WS_ACS); float* CDEC = WSF(WS_CDEC); float* out = c.out;
    const float* dtb = INP(I_DTB) + l * 4; const float* alog = INP(I_ALOG) + l * 4; const float* cw = INP(I_BCW) + l * 4 * 768; const float* cb = INP(I_BCB) + l * 768;
    LAS f16* Bm = (LAS f16*)lds; LAS f16* BT = (LAS f16*)(lds + 34816); LAS f16* Cm = (LAS f16*)(lds + 69632); LAS f16* XT = (LAS f16*)(lds + 104448);
    LAS float* acs = (LAS float*)(lds + 139264); LAS float* dtl = acs + 256; LAS f16* te16 = (LAS f16*)(dtl + 256);
    for (int it = c.bid; it < 256; it += c.G) {
        const int ch_ = it >> 1, g = it & 1, t0 = ch_ * 128;
        __syncthreads();
        if (tid < 256) { const int hh = tid >> 7, lt = tid & 127, hd = 2 * g + hh; const float raw = (float)PT(13)[(size_t)(t0 + lt) * 256 + 128 + hd];
            const float dt = softplusf_(raw + dtb[hd]); dtl[hh * 128 + lt] = dt; acs[hh * 128 + lt] = dt * (-__expf(alog[hd])); }
        __syncthreads();
        if (tid == 0 || tid == 64) { const int hh = tid >> 6; float sacc = 0.f; for (int i = 0; i < 128; ++i) { sacc += acs[hh * 128 + i]; acs[hh * 128 + i] = sacc; } }
        __syncthreads();
        if (tid < 256) { const int hh = tid >> 7, lt = tid & 127, hd = 2 * g + hh; const float av = acs[hh * 128 + lt], ae = acs[hh * 128 + 127];
            te16[hh * 128 + lt] = (f16)__expf(ae - av); ACS[(size_t)(t0 + lt) * 4 + hd] = av; if (lt == 127) CDEC[ch_ * 4 + hd] = __expf(ae); }
#pragma unroll 3
        for (int e = tid; e < 128 * 48; e += 512) {
            const int lt = (e >> 2) & 127, cg = (e >> 9) * 4 + (e & 3), reg = cg >> 4, c8 = (cg & 15) * 8, t = t0 + lt, col = 128 * g + c8, ch = reg * 256 + col;
            const f16* src = PT(5 + reg) + col; float y[8]; f16x8 rawt;
#pragma unroll
            for (int i = 0; i < 8; ++i) y[i] = cb[ch + i];
#pragma unroll
            for (int k = 0; k < 4; ++k) { const int tt = t - 3 + k; f16x8 v; if (tt >= 0) v = ld_h8(src + (size_t)tt * 256); else {
#pragma unroll
                    for (int i = 0; i < 8; ++i) v[i] = (f16)0.f; }
                if (k == 3) rawt = v;
#pragma unroll
                for (int i = 0; i < 8; ++i) y[i] += cw[k * 768 + ch + i] * (float)v[i]; }
            f16x8 act;
#pragma unroll
            for (int i = 0; i < 8; ++i) { y[i] = siluf_(y[i]); act[i] = (f16)y[i]; }
            *(f16x8*)(ACT + (size_t)t * 768 + ch) = act;
            if (reg == 0) { const int hh = c8 >> 6; const float sdt = dtl[hh * 128 + lt] * 64.f;
#pragma unroll
                for (int i = 0; i < 8; ++i) XT[(c8 + i) * 136 + lt] = (f16)(y[i] * sdt); }
            else if (reg == 1) { *(LAS f16x8*)(Bm + lt * 136 + c8) = act;
#pragma unroll
                for (int i = 0; i < 8; ++i) BT[(c8 + i) * 136 + lt] = act[i]; }
            else *(LAS f16x8*)(Cm + lt * 136 + c8) = act;
            if (t >= SEQ - 3) { float* so = out + O_BCP + (size_t)l * 2304 + (t - (SEQ - 3)) * 768 + ch;
#pragma unroll
                for (int i = 0; i < 8; ++i) so[i] = (float)rawt[i]; }
        }
        __syncthreads();
        const int fr = lane & 15, q = lane >> 4, w = wave;
        f32x4 gt[8];
#pragma unroll
        for (int mt = 0; mt < 8; ++mt) { gt[mt] = (f32x4){0.f, 0.f, 0.f, 0.f};
            if (mt <= w) {
#pragma unroll
                for (int ks = 0; ks < 4; ++ks) { const f16x8 av = *(const LAS f16x8*)(Bm + (16 * mt + fr) * 136 + 32 * ks + 8 * q), bv = *(const LAS f16x8*)(Cm + (16 * w + fr) * 136 + 32 * ks + 8 * q);
                    gt[mt] = __builtin_amdgcn_mfma_f32_16x16x32_f16(av, bv, gt[mt], 0, 0, 0); } } }
#pragma unroll
        for (int hh = 0; hh < 2; ++hh) {
            const int lrow = 16 * w + fr; const float al = acs[hh * 128 + lrow];
            f32x4 ya[4];
#pragma unroll
            for (int pt = 0; pt < 4; ++pt) ya[pt] = (f32x4){0.f, 0.f, 0.f, 0.f};
#pragma unroll
            for (int k2 = 0; k2 < 4; ++k2) {
                if (2 * k2 <= w) {
                    f16x8 af;
#pragma unroll
                    for (int j = 0; j < 8; ++j) { const int m = 32 * k2 + (j < 4 ? 4 * q + j : 16 + 4 * q + (j - 4)); const float gv = j < 4 ? gt[2 * k2][j] : gt[2 * k2 + 1][j - 4];
                        af[j] = (f16)(m <= lrow ? gv * __expf(al - acs[hh * 128 + m]) : 0.f); }
#pragma unroll
                    for (int pt = 0; pt < 4; ++pt) { const LAS f16* xp = XT + (hh * 64 + 16 * pt + fr) * 136 + 32 * k2 + 4 * q; const f16x4 b0 = *(const LAS f16x4*)xp, b1 = *(const LAS f16x4*)(xp + 16);
                        f16x8 bf; bf[0] = b0[0]; bf[1] = b0[1]; bf[2] = b0[2]; bf[3] = b0[3]; bf[4] = b1[0]; bf[5] = b1[1]; bf[6] = b1[2]; bf[7] = b1[3];
                        ya[pt] = __builtin_amdgcn_mfma_f32_16x16x32_f16(af, bf, ya[pt], 0, 0, 0); }
                }
            }
#pragma unroll
            for (int pt = 0; pt < 4; ++pt)
#pragma unroll
                for (int j = 0; j < 4; ++j) YD[(size_t)(t0 + 16 * w + 4 * q + j) * 256 + (2 * g + hh) * 64 + 16 * pt + fr] = ya[pt][j] * (1.f / 64.f);
#pragma unroll
            for (int pt = 0; pt < 4; ++pt) { f32x4 sa = (f32x4){0.f, 0.f, 0.f, 0.f};
#pragma unroll
                for (int ks = 0; ks < 4; ++ks) { const f16x8 xv = *(const LAS f16x8*)(XT + (hh * 64 + 16 * pt + fr) * 136 + 32 * ks + 8 * q), tv = *(const LAS f16x8*)(te16 + hh * 128 + 32 * ks + 8 * q);
                    const f16x8 bv = *(const LAS f16x8*)(BT + (16 * w + fr) * 136 + 32 * ks + 8 * q);
                    sa = __builtin_amdgcn_mfma_f32_16x16x32_f16(xv * tv, bv, sa, 0, 0, 0); }
#pragma unroll
                for (int j = 0; j < 4; ++j) CST[((size_t)(ch_ * 4 + 2 * g + hh) * 64 + 16 * pt + 4 * q + j) * 128 + 16 * w + fr] = sa[j] * (1.f / 64.f); }
        }
    }
    __syncthreads();
}
DI void ph_mix_a(LAS unsigned char* lds_, int l) {
    const Ctx c = mkctx(lds_); const int tid = c.tid;
    const f16* P = WSH(WS_PROJ); f16* Y16 = WSH(WS_Y16); float* out = c.out; const float* scw = INP(I_SCW) + l * 768;
    for (int it = c.bid; it < 256; it += c.G) {
        for (int e = tid; e < 64 * 32; e += 512) { const int t = it * 64 + (e >> 5), c0 = (e & 31) * 8; float u[3][8];
#pragma unroll
            for (int k = 0; k < 3; ++k) { const int tt = t - 2 + k;
                if (tt >= 0) { const f16x8 h = ld_h8(PT(0) + (size_t)tt * 256 + c0), cc = ld_h8(PT(2) + (size_t)tt * 256 + c0);
#pragma unroll
                    for (int i = 0; i < 8; ++i) u[k][i] = (float)cc[i] * (float)h[i]; }
                else {
#pragma unroll
                    for (int i = 0; i < 8; ++i) u[k][i] = 0.f; } }
            const f16x8 bb = ld_h8(PT(1) + (size_t)t * 256 + c0), gg = ld_h8(PT(3) + (size_t)t * 256 + c0); f16x8 o;
#pragma unroll
            for (int i = 0; i < 8; ++i) { const float y = scw[c0 + i] * u[0][i] + scw[256 + c0 + i] * u[1][i] + scw[512 + c0 + i] * u[2][i]; o[i] = (f16)(siluf_((float)gg[i]) * (float)bb[i] * y); }
            *(f16x8*)(Y16 + (size_t)t * 1024 + c0) = o;
            if (t >= SEQ - 2) { float* so = out + O_SCP + (size_t)l * 512 + (t - (SEQ - 2)) * 256 + c0;
#pragma unroll
                for (int i = 0; i < 8; ++i) so[i] = u[2][i]; }
        }
    }
}
DI void ph_mix_c(LAS unsigned char* lds_, int l) {
    const Ctx c = mkctx(lds_); const int tid = c.tid, lane = c.lane, wave = c.wave;
    const f16* P = WSH(WS_PROJ); f16* Y16 = WSH(WS_Y16); float* out = c.out;
    const float* cfw = INP(I_CFW) + l * 31 * 256; const float* cfb = INP(I_CFB) + l * 256; const float* lng = INP(I_LNG) + l * 256; const float* lnb = INP(I_LNB) + l * 256;
    LAS float* GL = (LAS float*)c.lds;
    f32x4 wt[31];
#pragma unroll
    for (int k = 0; k < 31; ++k) wt[k] = *(const f32x4*)(cfw + k * 256 + lane * 4);
    const f32x4 bias4 = *(const f32x4*)(cfb + lane * 4), g4 = *(const f32x4*)(lng + lane * 4), b4 = *(const f32x4*)(lnb + lane * 4);
    for (int it = c.bid; it < 256; it += c.G) {
        __syncthreads();
        for (int e = tid; e < 94 * 32; e += 512) { const int rr = e >> 5, c0 = (e & 31) * 8, t = it * 64 - 30 + rr; f32x4 g0 = (f32x4){0.f, 0.f, 0.f, 0.f}, g1 = g0;
            if (t >= 0) { const f16x8 ga = ld_h8(PT(8) + (size_t)t * 256 + c0), gb = ld_h8(PT(9) + (size_t)t * 256 + c0);
#pragma unroll
                for (int i = 0; i < 4; ++i) { g0[i] = (float)ga[i] * sigmoidf_((float)gb[i]); g1[i] = (float)ga[4 + i] * sigmoidf_((float)gb[4 + i]); }
                if (t >= SEQ - 30) { float* so = out + O_CFP + (size_t)l * 7680 + (t - (SEQ - 30)) * 256 + c0; *(f32x4*)so = g0; *(f32x4*)(so + 4) = g1; } }
            *(LAS f32x4*)(GL + rr * 256 + c0) = g0; *(LAS f32x4*)(GL + rr * 256 + c0 + 4) = g1; }
        __syncthreads();
        {
            const int cc = lane * 4, tb = wave * 8;
            f32x4 u[8];
#pragma unroll
            for (int j = 0; j < 8; ++j) u[j] = bias4;
#pragma unroll
            for (int r = 0; r < 38; ++r) { const f32x4 gv = *(const LAS f32x4*)(GL + (tb + r) * 256 + cc);
#pragma unroll
                for (int j = 0; j < 8; ++j) if (r - j >= 0 && r - j <= 30) u[j] += wt[r - j] * gv; }
#pragma unroll
            for (int j = 0; j < 8; ++j) { const int t = it * 64 + tb + j;
                const float mean = wsum((u[j][0] + u[j][1]) + (u[j][2] + u[j][3])) * (1.f / 256.f); const f32x4 d = u[j] - mean;
                const float var = wsum((d[0] * d[0] + d[1] * d[1]) + (d[2] * d[2] + d[3] * d[3])) * (1.f / 256.f); const float rs = rsqrtf(var + EPS);
                const f16x4 cg = *(const f16x4*)(PT(10) + (size_t)t * 256 + cc); f16x4 o;
#pragma unroll
                for (int i = 0; i < 4; ++i) o[i] = (f16)(siluf_((float)cg[i]) * siluf_(d[i] * rs * g4[i] + b4[i]));
                *(f16x4*)(Y16 + (size_t)t * 1024 + 512 + cc) = o; }
        }
    }
    __syncthreads();
}
DI void ph_mix_d(LAS unsigned char* lds_, int l) {
    const Ctx c = mkctx(lds_); const int tid = c.tid, lane = c.lane, wave = c.wave;
    const f16* P = WSH(WS_PROJ); float* out = c.out; float* kvp_out = out + O_KVP + (size_t)l * SEQ * 256;
    f16* Q16 = WSH(WS_Q16); f16* KS16 = WSH(WS_KS16); f16* KW16 = WSH(WS_KW16); f16* VST16 = WSH(WS_VST16); f16* VWT16 = WSH(WS_VWT16); float* GATES = WSF(WS_GATES);
    const int d4 = (lane & 15) * 4, v4 = lane >> 4;
    const f32x4 qg = *(const f32x4*)(INP(I_QG) + l * 64 + d4), kg1 = *(const f32x4*)(INP(I_KG) + l * 192 + 64 + d4), kg2 = *(const f32x4*)(INP(I_KG) + l * 192 + 128 + d4);
    LAS f16* VSs = (LAS f16*)c.lds; LAS f16* VWs = VSs + 64 * 68;
    if (c.bid < 18 && c.G > 36) return;
    for (int it = c.bid - 18 >= 0 && c.G > 36 ? c.bid - 18 : c.bid; it < 256; it += (c.G > 36 ? c.G - 18 : c.G)) {
        __syncthreads();
        for (int vi = wave * 4 + v4; vi < 256; vi += 32) { const size_t off = (size_t)(it * 64) * 256 + (size_t)vi * 64 + d4; const f16x4 x = *(const f16x4*)(PT(11) + off);
            const float a0 = (float)x[0], a1 = (float)x[1], a2 = (float)x[2], a3 = (float)x[3]; const float rn = rsqrtf(sum16((a0 * a0 + a1 * a1) + (a2 * a2 + a3 * a3)) * (1.f / 64.f) + EPS);
            f16x4 y; y[0] = (f16)(a0 * rn * qg[0]); y[1] = (f16)(a1 * rn * qg[1]); y[2] = (f16)(a2 * rn * qg[2]); y[3] = (f16)(a3 * rn * qg[3]); *(f16x4*)(Q16 + off) = y; }
        for (int tl = wave * 4 + v4; tl < 64; tl += 32) { const int t = it * 64 + tl;
            { const f16x4 x = *(const f16x4*)(PT(12) + (size_t)t * 256 + 128 + d4), vv = *(const f16x4*)(PT(12) + (size_t)t * 256 + 192 + d4);
                const float a0 = (float)x[0], a1 = (float)x[1], a2 = (float)x[2], a3 = (float)x[3]; const float rn = rsqrtf(sum16((a0 * a0 + a1 * a1) + (a2 * a2 + a3 * a3)) * (1.f / 64.f) + EPS);
                const f32x4 kn = (f32x4){a0 * rn * kg1[0], a1 * rn * kg1[1], a2 * rn * kg1[2], a3 * rn * kg1[3]}; *(f32x4*)(kvp_out + (size_t)t * 256 + 128 + d4) = kn;
                f16x4 y; y[0] = (f16)kn[0]; y[1] = (f16)kn[1]; y[2] = (f16)kn[2]; y[3] = (f16)kn[3]; *(f16x4*)(KS16 + (size_t)t * 64 + d4) = y; *(LAS f16x4*)(VSs + tl * 68 + d4) = vv; }
            { const f16x4 x = *(const f16x4*)(PT(13) + (size_t)t * 256 + d4), vv = *(const f16x4*)(PT(13) + (size_t)t * 256 + 64 + d4);
                const float a0 = (float)x[0], a1 = (float)x[1], a2 = (float)x[2], a3 = (float)x[3]; const float rn = rsqrtf(sum16((a0 * a0 + a1 * a1) + (a2 * a2 + a3 * a3)) * (1.f / 64.f) + EPS);
                const f32x4 kn = (f32x4){a0 * rn * kg2[0], a1 * rn * kg2[1], a2 * rn * kg2[2], a3 * rn * kg2[3]};
                f16x4 y; y[0] = (f16)kn[0]; y[1] = (f16)kn[1]; y[2] = (f16)kn[2]; y[3] = (f16)kn[3]; *(f16x4*)(KW16 + (size_t)t * 64 + d4) = y; *(LAS f16x4*)(VWs + tl * 68 + d4) = vv;
                if (t >= SEQ - 512) { float* wo = out + O_WINP + (size_t)l * 512 * 128 + (size_t)(t - (SEQ - 512)) * 128; *(f32x4*)(wo + d4) = kn; *(f32x4*)(wo + 64 + d4) = (f32x4){(float)vv[0], (float)vv[1], (float)vv[2], (float)vv[3]}; } }
        }
        for (int e = tid; e < 64 * 12; e += 512) { const int tl = e / 12, gi = e % 12; GATES[(size_t)(it * 64 + tl) * 12 + gi] = sigmoidf_((float)PT(13)[(size_t)(it * 64 + tl) * 256 + 132 + gi]); }
        __syncthreads();
        { const int d = tid >> 3, k8 = (tid & 7) * 8; f16x8 a, b;
#pragma unroll
            for (int i = 0; i < 8; ++i) { a[i] = VSs[(k8 + i) * 68 + d]; b[i] = VWs[(k8 + i) * 68 + d]; }
            *(f16x8*)(VST16 + (size_t)it * 4096 + d * 64 + k8) = a; *(f16x8*)(VWT16 + (size_t)it * 4096 + d * 64 + k8) = b; }
    }
    __syncthreads();
}
DI void ph_mix_cmp(LAS unsigned char* lds_, int l) {
    const Ctx c = mkctx(lds_);
    const f16* P = WSH(WS_PROJ); const float* w2 = INP(I_W2); const float* b2 = INP(I_B2); const float* k_g = INP(I_KG); f16* W1T = WSH(WS_W1T); float* PEB = WSF(WS_PEBP);
    for (int it = c.bid; it < 18; it += c.G) { const int slot = it / 9, grp = it % 9; const f16* src = PT(12) + slot * 64;
        compress_item<false>(c.lds, [&](int ch) { return (const void*)(src + (size_t)ch * 16 * 256); }, grp * 127,
                             W1T + (size_t)(l * 2 + slot) * 128 * 2048, PEB + (l * 2 + slot) * 1024, WSH(WS_W2T) + (size_t)(l * 2 + slot) * 64 * 128, b2 + (l * 2 + slot) * 64,
                             slot == 0 ? k_g + l * 192 : nullptr, nullptr, slot == 0 ? WSH(WS_KC16) : nullptr, slot == 0 ? nullptr : WSH(WS_VCT16)); }
}
#undef PT
template <int N>
DI void blk_reduce(LAS float* red, LAS float* bc, float (&v)[N], bool is_max, int wave, int lane) {
#pragma unroll
    for (int i = 0; i < N; ++i) v[i] = is_max ? wmaxf(v[i]) : wsum(v[i]);
    __syncthreads();
    if (lane == 0) {
#pragma unroll
        for (int i = 0; i < N; ++i) red[wave * 12 + i] = v[i]; }
    __syncthreads();
    if (wave == 0 && lane < N) { float r = red[lane]; for (int w = 1; w < 8; ++w) r = is_max ? fmaxf(r, red[w * 12 + lane]) : r + red[w * 12 + lane]; bc[lane] = r; }
    __syncthreads();
#pragma unroll
    for (int i = 0; i < N; ++i) v[i] = bc[i];
}
DI void nsa_sample_block(LAS float* wl, const float* KC, const float* VC, const SampleKV& kv, const LAS float* gsm, const float* dgp, float* ysd, int tid, int lane, int wave) {
    LAS float* sc = wl; LAS float* qs = wl + 10496; LAS float* PSL = qs + 256; LAS float* red = PSL + 1024; LAS float* bc = red + 96; LAS int* sel = (LAS int*)(bc + 16); LAS float* part = bc + 32;
    constexpr int NCV = 1023, CUR = PAST >> 6;
    float mv[8], sv[8];
#pragma unroll
    for (int i = 0; i < 8; ++i) mv[i] = -3e38f;
    for (int cidx = tid; cidx < NCV; cidx += 512) {
        asm volatile("" ::: "memory");
        float kr[64]; kv.ld64(KC + (size_t)cidx * 64, kr); float s4[4] = {0.f, 0.f, 0.f, 0.f};
#pragma unroll
        for (int d = 0; d < 64; ++d) { const f32x4 qv = *(const LAS f32x4*)(qs + d * 4); s4[0] += qv[0] * kr[d]; s4[1] += qv[1] * kr[d]; s4[2] += qv[2] * kr[d]; s4[3] += qv[3] * kr[d]; }
#pragma unroll
        for (int hh = 0; hh < 4; ++hh) { s4[hh] *= 0.125f; sc[hh * 2624 + cidx] = s4[hh]; mv[hh] = fmaxf(mv[hh], s4[hh]); }
    }
    for (int i = tid; i < 513; i += 512) {
        asm volatile("" ::: "memory");
        float kr[64]; kv.krow_win(PAST - 512 + i, kr); float s4[4] = {0.f, 0.f, 0.f, 0.f};
#pragma unroll
        for (int d = 0; d < 64; ++d) { const f32x4 qv = *(const LAS f32x4*)(qs + d * 4); s4[0] += qv[0] * kr[d]; s4[1] += qv[1] * kr[d]; s4[2] += qv[2] * kr[d]; s4[3] += qv[3] * kr[d]; }
#pragma unroll
        for (int hh = 0; hh < 4; ++hh) { s4[hh] *= 0.125f; sc[hh * 2624 + 2048 + i] = s4[hh]; mv[4 + hh] = fmaxf(mv[4 + hh], s4[hh]); }
    }
    blk_reduce<8>(red, bc, mv, true, wave, lane);
#pragma unroll
    for (int i = 0; i < 8; ++i) sv[i] = 0.f;
    for (int cidx = tid; cidx < NCV; cidx += 512) {
#pragma unroll
        for (int hh = 0; hh < 4; ++hh) { const float e = __expf(sc[hh * 2624 + cidx] - mv[hh]); sc[hh * 2624 + cidx] = e; sv[hh] += e; } }
    for (int i = tid; i < 513; i += 512) {
#pragma unroll
        for (int hh = 0; hh < 4; ++hh) { const float e = __expf(sc[hh * 2624 + 2048 + i] - mv[4 + hh]); sc[hh * 2624 + 2048 + i] = e; sv[4 + hh] += e; } }
    blk_reduce<8>(red, bc, sv, false, wave, lane);
    float invc[4], invw[4];
#pragma unroll
    for (int hh = 0; hh < 4; ++hh) { invc[hh] = 1.f / sv[hh]; invw[hh] = 1.f / sv[4 + hh]; }
    for (int cidx = tid; cidx < 1024; cidx += 512) PSL[cidx] = cidx < NCV ? (sc[cidx] * invc[0] + sc[2624 + cidx] * invc[1]) + (sc[2 * 2624 + cidx] * invc[2] + sc[3 * 2624 + cidx] * invc[3]) : 0.f;
    __syncthreads();
    if (wave == 0) {
        float scv[5];
#pragma unroll
        for (int i = 0; i < 5; ++i) { const int j = lane + 64 * i; float v = -3e38f;
            if (j <= CUR) { if (j == 0 || j == CUR || j == CUR - 1) v = 3e38f; else { float a = 0.f;
#pragma unroll
                    for (int o5 = -1; o5 < 4; ++o5) { const int cc = 4 * j + o5; if (cc >= 0 && cc < NCV) a += (o5 == -1 || o5 == 3) ? 0.5f * PSL[cc] : PSL[cc]; }
                    v = a; } }
            scv[i] = v; }
        for (int k = 0; k < 16; ++k) {
            float bv = scv[0]; int bi = lane;
#pragma unroll
            for (int i = 1; i < 5; ++i) if (scv[i] > bv) { bv = scv[i]; bi = lane + 64 * i; }
#pragma unroll
            for (int off = 32; off > 0; off >>= 1) { const float ov = __shfl_xor(bv, off); const int oi = __shfl_xor(bi, off); if (ov > bv || (ov == bv && oi < bi)) { bv = ov; bi = oi; } }
            if (lane == 0) sel[k] = bi;
#pragma unroll
            for (int i = 0; i < 5; ++i) if (lane + 64 * i == bi) scv[i] = -3e38f;
        }
    }
    __syncthreads();
    float ms[4], ss4[4];
#pragma unroll
    for (int i = 0; i < 4; ++i) ms[i] = -3e38f;
    for (int idx = tid; idx < 1024; idx += 512) {
        asm volatile("" ::: "memory");
        const int pos = sel[idx >> 6] * 64 + (idx & 63); float s4[4] = {-1e30f, -1e30f, -1e30f, -1e30f};
        if (pos <= PAST) { float kr[64]; kv.krow_sel(pos, kr); s4[0] = s4[1] = s4[2] = s4[3] = 0.f;
#pragma unroll
            for (int d = 0; d < 64; ++d) { const f32x4 qv = *(const LAS f32x4*)(qs + d * 4); s4[0] += qv[0] * kr[d]; s4[1] += qv[1] * kr[d]; s4[2] += qv[2] * kr[d]; s4[3] += qv[3] * kr[d]; }
#pragma unroll
            for (int hh = 0; hh < 4; ++hh) s4[hh] *= 0.125f; }
#pragma unroll
        for (int hh = 0; hh < 4; ++hh) { sc[hh * 2624 + 1024 + idx] = s4[hh]; ms[hh] = fmaxf(ms[hh], s4[hh]); }
    }
    blk_reduce<4>(red, bc, ms, true, wave, lane);
#pragma unroll
    for (int i = 0; i < 4; ++i) ss4[i] = 0.f;
    for (int idx = tid; idx < 1024; idx += 512) {
#pragma unroll
        for (int hh = 0; hh < 4; ++hh) { const float x = sc[hh * 2624 + 1024 + idx]; const float e = x > -1e29f ? __expf(x - ms[hh]) : 0.f; sc[hh * 2624 + 1024 + idx] = e; ss4[hh] += e; } }
    blk_reduce<4>(red, bc, ss4, false, wave, lane);
    float invs[4];
#pragma unroll
    for (int hh = 0; hh < 4; ++hh) invs[hh] = 1.f / ss4[hh];
    float oc[4] = {0.f, 0.f, 0.f, 0.f}, os[4] = {0.f, 0.f, 0.f, 0.f}, ow[4] = {0.f, 0.f, 0.f, 0.f};
    { const int c1 = (wave + 1) * 128 < NCV ? (wave + 1) * 128 : NCV;
#pragma unroll 16
        for (int cidx = wave * 128; cidx < c1; ++cidx) { const float v = VC[(size_t)cidx * 64 + lane];
#pragma unroll
            for (int hh = 0; hh < 4; ++hh) oc[hh] += sc[hh * 2624 + cidx] * v; } }
    for (int kb = wave * 2; kb < wave * 2 + 2; ++kb) { const int p0 = sel[kb] * 64; int nk = PAST - p0 + 1; nk = nk > 64 ? 64 : nk;
        const float* vbase = p0 < PAST ? kv.prow(p0, 3) + lane : kv.nvs + lane;
#pragma unroll 16
        for (int kk = 0; kk < nk; ++kk) { const float v = vbase[(size_t)kk * 256];
#pragma unroll
            for (int hh = 0; hh < 4; ++hh) os[hh] += sc[hh * 2624 + 1024 + kb * 64 + kk] * v; } }
    { const int i1 = (wave + 1) * 65 < 513 ? (wave + 1) * 65 : 513;
#pragma unroll 13
        for (int i = wave * 65; i < i1; ++i) { const float v = kv.v_win(PAST - 512 + i, lane);
#pragma unroll
            for (int hh = 0; hh < 4; ++hh) ow[hh] += sc[hh * 2624 + 2048 + i] * v; } }
#pragma unroll
    for (int hh = 0; hh < 4; ++hh) { part[(wave * 12 + hh) * 64 + lane] = oc[hh] * invc[hh]; part[(wave * 12 + 4 + hh) * 64 + lane] = os[hh] * invs[hh]; part[(wave * 12 + 8 + hh) * 64 + lane] = ow[hh] * invw[hh]; }
    __syncthreads();
    if (tid < 256) { const int hh = tid >> 6, d = tid & 63; float a = 0.f, b = 0.f, cc = 0.f;
        for (int w = 0; w < 8; ++w) { a += part[(w * 12 + hh) * 64 + d]; b += part[(w * 12 + 4 + hh) * 64 + d]; cc += part[(w * 12 + 8 + hh) * 64 + d]; }
        ysd[tid] = siluf_(dgp[tid]) * (gsm[hh * 3] * a + gsm[hh * 3 + 1] * b + gsm[hh * 3 + 2] * cc); }
}
DI void ph_mix_sample(LAS unsigned char* lds_, int l) {
    const Ctx c = mkctx(lds_); const int tid = c.tid, lane = c.lane, wave = c.wave;
    const int b = c.bid - (c.G - 32);
    if (b < 0 || b >= 32) return;
    float* out = c.out;
    __syncthreads();
    const float* pr = WSF(WS_PROJS) + (size_t)b * NPD;
    LAS float* act = (LAS float*)c.lds;
    LAS float* red = act + 768;
    LAS float* ybl = red + 16;
    LAS float* sdt = ybl + 256;
    LAS float* nrow = sdt + 8;
    LAS float* gsm = nrow + 256;
    LAS float* wl = gsm + 16;
    float* ys = WSF(WS_YS) + (size_t)b * 1024;
    if (tid < 256) { const int ch = tid; const float* st = INP(I_SSC) + ((size_t)(l * NB + b) * 2) * 256; const float* scw = INP(I_SCW) + l * 768;
        const float u = pr[512 + ch] * pr[ch], p0 = st[ch], p1 = st[256 + ch]; const float y = scw[ch] * p0 + scw[256 + ch] * p1 + scw[512 + ch] * u;
        ys[ch] = siluf_(pr[768 + ch]) * pr[256 + ch] * y; float* so = out + O_SCS + ((size_t)(l * NB + b) * 2) * 256; so[ch] = p1; so[256 + ch] = u; }
    float uc = 0.f;
    if (tid >= 256) { const int ch = tid - 256; const float* st = INP(I_SCF) + (size_t)(l * NB + b) * 7680; const float* cfw = INP(I_CFW) + l * 31 * 256;
        const float glu = pr[2048 + ch] * sigmoidf_(pr[2304 + ch]); float u = INP(I_CFB)[l * 256 + ch]; float* so = out + O_CFS + (size_t)(l * NB + b) * 7680;
        for (int k = 0; k < 30; ++k) { const float pv = st[k * 256 + ch]; u += cfw[k * 256 + ch] * pv; if (k > 0) so[(k - 1) * 256 + ch] = pv; }
        u += cfw[30 * 256 + ch] * glu; so[29 * 256 + ch] = glu; uc = u; }
    { const float s1 = wsum(tid >= 256 ? uc : 0.f); if (lane == 0) red[wave] = s1; }
    __syncthreads();
    const float cmean = (red[4] + red[5] + red[6] + red[7]) * (1.f / 256.f);
    __syncthreads();
    { const float d = uc - cmean; const float s2 = wsum(tid >= 256 ? d * d : 0.f); if (lane == 0) red[wave] = s2; }
    __syncthreads();
    if (tid >= 256) { const int ch = tid - 256; const float var = (red[4] + red[5] + red[6] + red[7]) * (1.f / 256.f);
        const float ln = (uc - cmean) * rsqrtf(var + EPS) * INP(I_LNG)[l * 256 + ch] + INP(I_LNB)[l * 256 + ch];
        ys[512 + ch] = siluf_(pr[2560 + ch]) * siluf_(ln); }
    { const float* st = INP(I_SBC) + (size_t)(l * NB + b) * 2304; const float* cw = INP(I_BCW) + l * 4 * 768; const float* cb = INP(I_BCB) + l * 768; float* so = out + O_BCS + (size_t)(l * NB + b) * 2304;
        for (int ch = tid; ch < 768; ch += 512) { const float raw = pr[1280 + ch], p0 = st[ch], p1 = st[768 + ch], p2 = st[1536 + ch];
            act[ch] = siluf_(cb[ch] + cw[ch] * p0 + cw[768 + ch] * p1 + cw[1536 + ch] * p2 + cw[2304 + ch] * raw); so[ch] = p1; so[768 + ch] = p2; so[1536 + ch] = raw; }
        if (tid < 4) { const float dt = softplusf_(pr[3456 + tid] + INP(I_DTB)[l * 4 + tid]); sdt[tid] = dt; sdt[4 + tid] = __expf(dt * (-__expf(INP(I_ALOG)[l * 4 + tid]))); } }
    __syncthreads();
    { const float* h0 = INP(I_SSM) + (size_t)(l * NB + b) * 32768; float* ho = out + O_HS + (size_t)(l * NB + b) * 32768; const float* Dp = INP(I_SD) + l * 4;
        for (int row = wave; row < 256; row += 8) { const int hd = row >> 6, gq = hd >> 1; const float dt = sdt[hd], dA = sdt[4 + hd], xv = act[row]; float y = 0.f;
#pragma unroll
            for (int s2 = 0; s2 < 2; ++s2) { const int sidx = lane + 64 * s2; const float hn = dA * h0[row * 128 + sidx] + dt * xv * act[256 + gq * 128 + sidx]; ho[row * 128 + sidx] = hn; y += hn * act[512 + gq * 128 + sidx]; }
            y = wsum(y);
            if (lane == 0) ybl[row] = (y + Dp[hd] * xv) * siluf_(pr[1024 + row]); } }
    __syncthreads();
    { const float v = tid < 256 ? ybl[tid] : 0.f; const float s2 = wsum(v * v); if (lane == 0) red[8 + wave] = s2; }
    __syncthreads();
    if (tid < 256) { const float ss = red[8] + red[9] + red[10] + red[11]; ys[256 + tid] = ybl[tid] * rsqrtf(ss * (1.f / 256.f) + EPS) * INP(I_SNG)[l * 256 + tid]; }
    const float* qg = INP(I_QG) + l * 64; const float* kg = INP(I_KG) + l * 192;
    LAS float* qs = wl + 10496;
    if (wave < 4) { const float v = pr[2816 + wave * 64 + lane]; const float ss = wsum(v * v); qs[lane * 4 + wave] = v * rsqrtf(ss * (1.f / 64.f) + EPS) * qg[lane]; }
    else if (wave == 4) { const float v = pr[3072 + 128 + lane]; const float ss = wsum(v * v); nrow[lane] = v * rsqrtf(ss * (1.f / 64.f) + EPS) * kg[64 + lane]; nrow[64 + lane] = pr[3072 + 192 + lane]; }
    else if (wave == 5) { const float v = pr[3072 + 256 + lane]; const float ss = wsum(v * v); nrow[128 + lane] = v * rsqrtf(ss * (1.f / 64.f) + EPS) * kg[128 + lane]; nrow[192 + lane] = pr[3072 + 320 + lane]; }
    else if (wave == 6) { if (lane < 12) gsm[lane] = sigmoidf_(pr[3460 + lane]); }
    __syncthreads();
    const float* cache_win = INP(I_CWIN) + (size_t)(l * NB + b) * 512 * 128;
    { float* ko = out + O_KVS + (size_t)(l * NB + b) * 256;
        if (tid < 128) ko[tid] = pr[3072 + tid]; else if (tid < 192) ko[tid] = nrow[tid - 128]; else if (tid < 256) ko[tid] = nrow[64 + tid - 192];
        float* wo = out + O_WINS + (size_t)(l * NB + b) * 512 * 128;
        for (int e = tid; e < 511 * 128; e += 512) wo[e] = cache_win[128 + e];
        if (tid < 64) wo[511 * 128 + tid] = nrow[128 + tid]; else if (tid < 128) wo[511 * 128 + tid] = nrow[192 + tid - 64]; }
    float* nrp = WSF(WS_NRG) + (size_t)(l * NB + b) * 256;
    if (tid < 256) nrp[tid] = nrow[tid];
    asm volatile("s_waitcnt vmcnt(0)" ::: "memory");
    __syncthreads();
    {
        SampleKV kv{INP(I_CKV) + (size_t)l * NPOOL * 128 * 256, (const int*)c.ap->in[I_PT] + b * 128, cache_win, nrp, nrp + 64, nrp + 128, nrp + 192};
        nsa_sample_block(wl, WSF(WS_KCS) + (size_t)(l * NB + b) * 1024 * 64, WSF(WS_VCS) + (size_t)(l * NB + b) * 1024 * 64, kv, gsm, pr + 3584, ys + 768, tid, lane, wave);
    }
    edge_publish((unsigned*)(c.ws + WS_CTL + 18432) + l * 64);
    __syncthreads();
}
DI void ph_scan(LAS unsigned char* lds_, int l) {
    const Ctx c = mkctx(lds_);
    if (c.bid >= 64) return;
    const float* CST = WSF(WS_CST); float* HPV = WSF(WS_HPV); const float* CDEC = WSF(WS_CDEC);
    const int e = c.bid * 512 + c.tid, hd = e >> 13; float hc = 0.f;
#pragma unroll 8
    for (int ch = 0; ch < 128; ++ch) { const float sv = CST[(size_t)ch * 32768 + e]; HPV[(size_t)ch * 32768 + e] = hc; hc = CDEC[ch * 4 + hd] * hc + sv; }
    c.out[O_HP + (size_t)l * 32768 + e] = hc;
    edge_publish((unsigned*)(c.ws + WS_CTL + 17408) + l * 64);
}
DI f16x8 pack_p(const f32x4& a, const f32x4& b) { f16x8 r; r[0] = (f16)a[0]; r[1] = (f16)a[1]; r[2] = (f16)a[2]; r[3] = (f16)a[3]; r[4] = (f16)b[0]; r[5] = (f16)b[1]; r[6] = (f16)b[2]; r[7] = (f16)b[3]; return r; }
DI f16x8 ld_vt(const f16* p) { const f16x4 a = *(const f16x4*)p, b = *(const f16x4*)(p + 16); f16x8 r; r[0] = a[0]; r[1] = a[1]; r[2] = a[2]; r[3] = a[3]; r[4] = b[0]; r[5] = b[1]; r[6] = b[2]; r[7] = b[3]; return r; }
constexpr int NT_PSEL = 0  , NT_STG = 32768  , NT_STG_SZ = 18432 + 17408,
              NT_RING = 0  , NT_MASK = 131072  , NT_VB = NT_MASK + 1088  , NT_END = NT_VB + 1088;
static_assert(NT_STG + 2 * NT_STG_SZ <= NT_MASK, "nsa tile LDS map");
static_assert(NT_END <= MISC_OFF, "nsa tile LDS map");
struct StgRegs { f16x8 k0, k1, v0, v1; };
template <bool WITH_V, class KSrc, class VSrc>
DI void stg_load(StgRegs& rg, int ch, int tid, const KSrc& ksrc, const VSrc& vsrc) {
    const f16* kp = ksrc(ch, tid >> 2) + (tid & 3) * 16; rg.k0 = ld_h8(kp); rg.k1 = ld_h8(kp + 8);
    if (WITH_V) { const f16* vp = vsrc(ch, tid >> 3, tid & 7); rg.v0 = ld_h8(vp); rg.v1 = ld_h8(vp + 8); }
}
template <bool WITH_V>
DI void stg_store(const StgRegs& rg, LAS unsigned char* buf, int tid) {
    LAS f16* kb = (LAS f16*)buf + (tid >> 2) * 72 + (tid & 3) * 16; *(LAS f16x8*)kb = rg.k0; *(LAS f16x8*)(kb + 8) = rg.k1;
    if (WITH_V) { LAS f16* vb = (LAS f16*)(buf + 18432) + (tid >> 3) * 136 + (tid & 7) * 16; *(LAS f16x8*)vb = rg.v0; *(LAS f16x8*)(vb + 8) = rg.v1; }
}
template <bool WITH_V, class KSrc, class VSrc, class Body>
DI void stream_chunks(LAS unsigned char* stg, int nchunk, int tid, const KSrc& ksrc, const VSrc& vsrc, Body body) {
    if (nchunk <= 0) return;
    const int last = nchunk - 1;
    StgRegs rg;
    stg_load<WITH_V>(rg, 0, tid, ksrc, vsrc);
    __syncthreads();
    stg_store<WITH_V>(rg, stg, tid); stg_load<WITH_V>(rg, 1 < last ? 1 : last, tid, ksrc, vsrc);
    lds_barrier();
#pragma nounroll
    for (int ch = 0; ch < nchunk; ++ch) {
        body(ch, stg + (ch & 1) * NT_STG_SZ);
        stg_store<WITH_V>(rg, stg + ((ch + 1) & 1) * NT_STG_SZ, tid); stg_load<WITH_V>(rg, ch + 2 < last ? ch + 2 : last, tid, ksrc, vsrc);
        lds_barrier();
    }
}
DI f16x8 lds_vt(const LAS f16* p) { const f16x4 a = *(const LAS f16x4*)p, b = *(const LAS f16x4*)(p + 16); f16x8 r; r[0] = a[0]; r[1] = a[1]; r[2] = a[2]; r[3] = a[3]; r[4] = b[0]; r[5] = b[1]; r[6] = b[2]; r[7] = b[3]; return r; }
DI f32x4 qk_tile(const LAS f16* kb, int kt, int fr, int q, const f16x8 (&qf)[2]) {
    const LAS f16* kp = kb + (16 * kt + fr) * 72 + 8 * q; f32x4 sa = (f32x4){0.f, 0.f, 0.f, 0.f};
    sa = __builtin_amdgcn_mfma_f32_16x16x32_f16(*(const LAS f16x8*)kp, qf[0], sa, 0, 0, 0); return __builtin_amdgcn_mfma_f32_16x16x32_f16(*(const LAS f16x8*)(kp + 32), qf[1], sa, 0, 0, 0);
}
template <class EFn>
DI float pv_step(const LAS f16* kb, const LAS f16* vb, int st, int fr, int q, const f16x8 (&qf)[2], f32x4 (&o)[4], f32x4 (&e2)[2], EFn efn) {
    float lp = 0.f;
#pragma unroll
    for (int hf = 0; hf < 2; ++hf) { const f32x4 sa = qk_tile(kb, 2 * st + hf, fr, q, qf);
#pragma unroll
        for (int j = 0; j < 4; ++j) { const float e = efn(32 * st + 16 * hf + 4 * q + j, sa[j]); e2[hf][j] = e; lp += e; } }
    const f16x8 pb = pack_p(e2[0], e2[1]);
#pragma unroll
    for (int dt = 0; dt < 4; ++dt) o[dt] = __builtin_amdgcn_mfma_f32_16x16x32_f16(lds_vt(vb + (16 * dt + fr) * 136 + 32 * st + 4 * q), pb, o[dt], 0, 0, 0);
    return lp;
}
DI void nsa_tile(const Ctx& c, int tile, const f16* Q16, const f16* KC16, const f16* VCT16, const f16* KS16, const f16* VST16, const f16* KW16, const f16* VWT16,
                 const float* GATES, const f16* DG, f16* Y16, float shc, float shs, float shw) {
    LAS unsigned char* lds = c.lds; const int wave = c.wave; int tid, lane, fr, q, ti, h, trow;
    const int t0 = tile * 32, cur = t0 >> 6;
#define NSA_RELANE() do { int _t = c.tid; asm volatile("" : "+v"(_t)); tid = _t; lane = _t & 63; fr = lane & 15; q = lane >> 4; ti = fr >> 2; h = fr & 3; trow = t0 + 4 * wave + ti; } while (0)
#define NSA_REPS(bit) (((NSA_DUP >> (bit)) & 1) ? 2 : 1)
#define NSA_SCALE(rep) ({ float _z = (rep) == 0 ? 1.f : 0.f; asm volatile("" : "+v"(_z)); _z; })
    NSA_RELANE();
    LAS float* PSEL = (LAS float*)(lds + NT_PSEL); LAS unsigned* MASK = (LAS unsigned*)(lds + NT_MASK); LAS int* VB = (LAS int*)(lds + NT_VB); LAS unsigned char* STG = lds + NT_STG;
    __syncthreads();
    for (int i = tid; i < 272; i += 512) MASK[i] = (i == 0 || i == cur || i == cur - 1) ? 0xFFFFFFFFu : 0u;
    f16x8 qf[2];
#pragma unroll
    for (int ks = 0; ks < 2; ++ks) qf[ks] = ld_h8(Q16 + ((size_t)trow * 4 + h) * 64 + 32 * ks + 8 * q);
    const int nkt = ((t0 >> 4) + 1 + 15) >> 4;
    const int ncch = (nkt + 7) >> 3;
    const int nv_row = trow >= 31 ? ((trow - 31) >> 4) + 1 : 0;
    auto kc_src = [&](int ch, int row) { return KC16 + (size_t)(128 * ch + row) * 64; };
    auto vc_src = [&](int ch, int d, int seg) { return VCT16 + (size_t)d * 1024 + 128 * ch + seg * 16; };
    float lsum = 0.f;
    for (int rep = 0; rep < NSA_REPS(0); ++rep) { const float dsc = NSA_SCALE(rep);
    stream_chunks<false>(STG, ncch, tid, kc_src, vc_src, [&](int ch, LAS unsigned char* buf) {
        const LAS f16* kb = (const LAS f16*)buf; const int nk = nkt - 8 * ch < 8 ? nkt - 8 * ch : 8;
#pragma unroll 4
        for (int kt = 0; kt < nk; ++kt) { const f32x4 sa = qk_tile(kb, kt, fr, q, qf); const int cb = 128 * ch + 16 * kt + 4 * q;
#pragma unroll
            for (int j = 0; j < 4; ++j) lsum += (cb + j < nv_row) ? dsc * __expf(sa[j] * 0.125f - shc) : 0.f; } }); }
    lsum += __shfl_xor(lsum, 16); lsum += __shfl_xor(lsum, 32);
    const float invc = lsum > 0.f ? 1.f / lsum : 0.f;
    NSA_RELANE();
    f32x4 oc[4];
#pragma unroll
    for (int dt = 0; dt < 4; ++dt) oc[dt] = (f32x4){0.f, 0.f, 0.f, 0.f};
    for (int rep = 0; rep < NSA_REPS(1); ++rep) { const float dsc = NSA_SCALE(rep); float bprev = 0.f;
    stream_chunks<true>(STG, ncch, tid, kc_src, vc_src, [&](int ch, LAS unsigned char* buf) {
        const LAS f16* kb = (const LAS f16*)buf; const LAS f16* vb = (const LAS f16*)(buf + 18432); const int ns = (nkt - 8 * ch + 1) >> 1 < 4 ? (nkt - 8 * ch + 1) >> 1 : 4;
#pragma unroll 2
        for (int s2 = 0; s2 < ns; ++s2) {
            f32x4 e2[2];
            pv_step(kb, vb, s2, fr, q, qf, oc, e2, [&](int kc, float sv) { return (128 * ch + kc < nv_row) ? dsc * __expf(sv * 0.125f - shc) * invc : 0.f; });
#pragma unroll
            for (int hf = 0; hf < 2; ++hf) {
                const int ktg = 8 * ch + 2 * s2 + hf;
                float av = (e2[hf][0] + e2[hf][1]) + (e2[hf][2] + 0.5f * e2[hf][3]), bv = 0.5f * e2[hf][3];
                if (NSA_DUP & 2) { const float un = dsc != 0.f ? 1.f / dsc : 0.f; av *= un; bv *= un; }
                av += dppf<DPP_X1>(av); av += dppf<DPP_X2>(av); bv += dppf<DPP_X1>(bv); bv += dppf<DPP_X2>(bv);
                const float up = __shfl(q == 3 ? bprev : bv, (lane + 48) & 63);
                bprev = bv;
                if (h == 0 && ktg < nkt && rep == 0) PSEL[(4 * wave + ti) * 256 + 4 * ktg + q] = av + up;
            }
        } }); }
    for (int rep = 0; rep < NSA_REPS(2); ++rep) {
        const int nforced = cur >= 2 ? 3 : cur + 1, nsel = ((cur + 1) < 16 ? (cur + 1) : 16) - nforced, tk = lane >> 4, l16 = lane & 15, tokl = 4 * wave + tk;
        float sv[16];
#pragma unroll
        for (int i = 0; i < 16; ++i) { const int j = l16 + 16 * i; float v = -3e38f;
            if (j <= cur && !(j == 0 || j == cur || j == cur - 1)) v = j < 4 * nkt ? PSEL[tokl * 256 + j] : 0.f;
            sv[i] = v; }
#pragma nounroll
        for (int k = 0; k < nsel; ++k) {
            float bv = sv[0]; int bi = l16;
#pragma unroll
            for (int i = 1; i < 16; ++i) if (sv[i] > bv) { bv = sv[i]; bi = l16 + 16 * i; }
#define TOPK_STEP(CT) do { const float ov = dppf<CT>(bv); const int oi = dppi<CT>(bi); if (ov > bv || (ov == bv && oi < bi)) { bv = ov; bi = oi; } } while (0)
            TOPK_STEP(DPP_X1); TOPK_STEP(DPP_X2); TOPK_STEP(DPP_HM); TOPK_STEP(DPP_R8);
#undef TOPK_STEP
            if (l16 == 0) __hip_atomic_fetch_or(&MASK[bi], 1u << tokl, __ATOMIC_RELAXED, __HIP_MEMORY_SCOPE_WORKGROUP);
#pragma unroll
            for (int i = 0; i < 16; ++i) if (l16 + 16 * i == bi) sv[i] = -3e38f;
        }
    }
    NSA_RELANE();
    f32x4 owr[4]; float lwr = 0.f;
#pragma unroll
    for (int dt = 0; dt < 4; ++dt) owr[dt] = (f32x4){0.f, 0.f, 0.f, 0.f};
    {
        const int wlo = t0 - 512 > 0 ? t0 - 512 : 0, nwch = (t0 + 32 - wlo + 127) >> 7;
        auto kw_src = [&](int ch, int row) { int p = wlo + 128 * ch + row; p = p < SEQ ? p : SEQ - 1; return KW16 + (size_t)p * 64; };
        auto vw_src = [&](int ch, int d, int seg) { const int key = wlo + 128 * ch + seg * 16; int blk = key >> 6; blk = blk < 256 ? blk : 255; return VWT16 + (size_t)blk * 4096 + d * 64 + (key & 63); };
        for (int rep = 0; rep < NSA_REPS(3); ++rep) { const float dsc = NSA_SCALE(rep);
        stream_chunks<true>(STG, nwch, tid, kw_src, vw_src, [&](int ch, LAS unsigned char* buf) {
            const LAS f16* kb = (const LAS f16*)buf; const LAS f16* vb = (const LAS f16*)(buf + 18432); const int pbase = wlo + 128 * ch;
            const int ns = (t0 + 32 - pbase) >> 5 < 4 ? (t0 + 32 - pbase) >> 5 : 4;
#pragma unroll 2
            for (int s2 = 0; s2 < ns; ++s2) { f32x4 e2[2];
                lwr += pv_step(kb, vb, s2, fr, q, qf, owr, e2, [&](int kc, float sv) { const int pos = pbase + kc; return (pos <= trow && pos >= trow - 512) ? dsc * __expf(sv * 0.125f - shw) : 0.f; }); } }); }
    }
    NSA_RELANE();
    if (wave == 0) { int cnt = 0;
        for (int base = 0; base <= cur; base += 64) { const int jx = base + lane; const bool v = jx <= cur && MASK[jx] != 0u; const unsigned long long bal = __ballot(v);
            if (v) VB[cnt + __popcll(bal & ((1ull << lane) - 1ull))] = jx; cnt += __popcll(bal); }
        if (lane == 0) VB[264] = cnt; }
    __syncthreads();
    if (VERIFY_NSA) { unsigned* SELM = (unsigned*)(c.ws + WS_SELM) + (size_t)tile * 272; for (int i = tid; i < 272; i += 512) SELM[i] = MASK[i]; }
    f32x4 osr[4]; float lsr = 0.f;
#pragma unroll
    for (int dt = 0; dt < 4; ++dt) osr[dt] = (f32x4){0.f, 0.f, 0.f, 0.f};
    {
        const int nvb = __builtin_amdgcn_readfirstlane(VB[264]), nst = (nvb + 3) >> 2;
        const int dr = lane >> 3, dp = lane & 7, dsw = (dp ^ dr) * 8;
        LAS unsigned char* RING = lds + NT_RING;
        auto dma = [&](int n) { const int bi = n < nvb ? n : nvb - 1; const int blk = __builtin_amdgcn_readfirstlane(VB[bi]); LAS unsigned char* slot = RING + (n & 7) * 16384 + wave * 1024;
            __builtin_amdgcn_global_load_lds((const unsigned*)(KS16 + ((size_t)blk * 64 + 8 * wave + dr) * 64 + dsw), (LAS unsigned*)slot, 16, 0, 0);
            __builtin_amdgcn_global_load_lds((const unsigned*)(VST16 + (size_t)blk * 4096 + (8 * wave + dr) * 64 + dsw), (LAS unsigned*)(slot + 8192), 16, 0, 0); };
        for (int rep = 0; rep < NSA_REPS(5); ++rep) { const float dsc = NSA_SCALE(rep);
        asm volatile("s_waitcnt vmcnt(0)" ::: "memory"); __syncthreads();
        dma(0); dma(1); dma(2); dma(3);
#pragma nounroll
        for (int st = 0; st < nst; ++st) {
            asm volatile("s_waitcnt vmcnt(0)\n\ts_barrier" ::: "memory");
            dma(4 * st + 4); dma(4 * st + 5); dma(4 * st + 6); dma(4 * st + 7);
            const int nb = nvb - 4 * st < 4 ? nvb - 4 * st : 4;
#pragma nounroll
            for (int i4 = 0; i4 < nb; ++i4) {
            const int n = 4 * st + i4;
            const int blk = __builtin_amdgcn_readfirstlane(VB[n]); const unsigned mt = (__builtin_amdgcn_readfirstlane(MASK[blk]) >> (4 * wave)) & 15u;
            if (mt != 0u) {
                const bool rv = ((mt >> ti) & 1u) != 0u; const LAS unsigned char* ks = RING + (n & 7) * 16384; const LAS unsigned char* vs = ks + 8192; const int sx = fr & 7;
                f32x4 sa[4]; f16x8 va[2][4];
#pragma unroll
                for (int kt = 0; kt < 4; ++kt) { const LAS unsigned char* kp = ks + (16 * kt + fr) * 128; sa[kt] = (f32x4){0.f, 0.f, 0.f, 0.f};
                    sa[kt] = __builtin_amdgcn_mfma_f32_16x16x32_f16(*(const LAS f16x8*)(kp + ((q ^ sx) << 4)), qf[0], sa[kt], 0, 0, 0);
                    sa[kt] = __builtin_amdgcn_mfma_f32_16x16x32_f16(*(const LAS f16x8*)(kp + (((4 + q) ^ sx) << 4)), qf[1], sa[kt], 0, 0, 0); }
#pragma unroll
                for (int s2 = 0; s2 < 2; ++s2) { const int sg = 4 * s2 + (q >> 1);
#pragma unroll
                    for (int dt = 0; dt < 4; ++dt) { const LAS unsigned char* vp = vs + (16 * dt + fr) * 128 + 8 * (q & 1);
                        const f16x4 v0 = *(const LAS f16x4*)(vp + ((sg ^ sx) << 4)), v1 = *(const LAS f16x4*)(vp + (((sg + 2) ^ sx) << 4));
                        va[s2][dt][0] = v0[0]; va[s2][dt][1] = v0[1]; va[s2][dt][2] = v0[2]; va[s2][dt][3] = v0[3]; va[s2][dt][4] = v1[0]; va[s2][dt][5] = v1[1]; va[s2][dt][6] = v1[2]; va[s2][dt][7] = v1[3]; } }
                const int pb0 = 64 * blk + 4 * q;
#pragma unroll
                for (int kt = 0; kt < 4; ++kt)
#pragma unroll
                    for (int j = 0; j < 4; ++j) { const float e = (rv && pb0 + 16 * kt + j <= trow) ? dsc * __expf(sa[kt][j] * 0.125f - shs) : 0.f; sa[kt][j] = e; lsr += e; }
                const f16x8 p0 = pack_p(sa[0], sa[1]), p1 = pack_p(sa[2], sa[3]);
#pragma unroll
                for (int dt = 0; dt < 4; ++dt) { osr[dt] = __builtin_amdgcn_mfma_f32_16x16x32_f16(va[0][dt], p0, osr[dt], 0, 0, 0); osr[dt] = __builtin_amdgcn_mfma_f32_16x16x32_f16(va[1][dt], p1, osr[dt], 0, 0, 0); }
            }
            }
        }
        asm volatile("s_waitcnt vmcnt(0)" ::: "memory"); }
        __syncthreads();
    }
    NSA_RELANE();
    lwr += __shfl_xor(lwr, 16); lwr += __shfl_xor(lwr, 32); lsr += __shfl_xor(lsr, 16); lsr += __shfl_xor(lsr, 32);
    {
        const float g0 = GATES[(size_t)trow * 12 + h * 3], ils = GATES[(size_t)trow * 12 + h * 3 + 1] / lsr, ilw = GATES[(size_t)trow * 12 + h * 3 + 2] / lwr;
#pragma unroll
        for (int dt = 0; dt < 4; ++dt) { const int d0 = 16 * dt + 4 * q; const f16x4 dg = *(const f16x4*)(DG + (size_t)trow * 256 + h * 64 + d0); f16x4 y;
#pragma unroll
            for (int jj = 0; jj < 4; ++jj) { const float o = g0 * oc[dt][jj] + ils * osr[dt][jj] + ilw * owr[dt][jj]; y[jj] = (f16)(siluf_((float)dg[jj]) * o); }
            *(f16x4*)(Y16 + (size_t)trow * 1024 + 768 + h * 64 + d0) = y; }
    }
#undef NSA_RELANE
}
DI void ph_ssd_fin(LAS unsigned char* lds_, int l, int it0, int it1, int itstep);
DI void ph_outproj_sample(LAS unsigned char* lds_, int l, int it);
DI void ph_nsa(LAS unsigned char* lds_, int l) {
    const Ctx c = mkctx(lds_); const int lane = c.lane;
    const float* qg = INP(I_QG) + l * 64; const float* kg = INP(I_KG) + l * 192;
    const float mq = wmaxf(fabsf(qg[lane])), mk0 = wmaxf(fabsf(kg[lane])), mk1 = wmaxf(fabsf(kg[64 + lane])), mk2 = wmaxf(fabsf(kg[128 + lane]));
    const float shc = 8.f * mq * mk0 - 8.f, shs = 8.f * mq * mk1 - 8.f, shw = 8.f * mq * mk2 - 8.f;
    unsigned* qctr = (unsigned*)(c.ws + WS_CTL + 16384) + l * 64; LAS int* qslot = (LAS int*)(c.lds + MISC_OFF + 64); bool fin_ok = false, smp_ok = false;
    for (;;) {
        __syncthreads();
        if (c.tid == 0) *qslot = (int)__hip_atomic_fetch_add(qctr, 1u, __ATOMIC_RELAXED, __HIP_MEMORY_SCOPE_AGENT);
        __syncthreads();
        const int u = __builtin_amdgcn_readfirstlane(*qslot);
        if (u >= 800) break;
        if (u < 512) nsa_tile(c, 511 - u, WSH(WS_Q16), WSH(WS_KC16), WSH(WS_VCT16), WSH(WS_KS16), WSH(WS_VST16), WSH(WS_KW16), WSH(WS_VWT16), WSF(WS_GATES), WSH(WS_PROJ) + (size_t)14 * SEQ * 256, WSH(WS_Y16), shc, shs, shw);
        else if (u < 768) { if (!fin_ok) { edge_wait((unsigned*)(c.ws + WS_CTL + 17408) + l * 64, 64u); fin_ok = true; } ph_ssd_fin(lds_, l, u - 512, u - 511, 1); }
        else { if (!smp_ok) { edge_wait((unsigned*)(c.ws + WS_CTL + 18432) + l * 64, 32u); smp_ok = true; } ph_outproj_sample(lds_, l, u - 768); }
    }
    __syncthreads();
}
DI void ph_nsa_verify(LAS unsigned char* lds_, int l) {
    const Ctx c = mkctx(lds_); const int lane = c.lane;
    LAS float* wl = (LAS float*)c.lds + c.wave * 4400; LAS float* sc = wl; LAS float* qs = wl + 4096; LAS unsigned* selb = (LAS unsigned*)(wl + 4352);
    const f16* Q16 = WSH(WS_Q16); const f16* KC16 = WSH(WS_KC16); const f16* VCT16 = WSH(WS_VCT16); const f16* KS16 = WSH(WS_KS16); const f16* VST16 = WSH(WS_VST16); const f16* KW16 = WSH(WS_KW16); const f16* VWT16 = WSH(WS_VWT16);
    const float* GATES = WSF(WS_GATES); const f16* DG = WSH(WS_PROJ) + (size_t)14 * SEQ * 256; const f16* Y16 = WSH(WS_Y16); const unsigned* SELM = (const unsigned*)(c.ws + WS_SELM);
    float* dbg = (float*)(c.ws + WS_CTL + 40960);
    auto dot4 = [&](const f16* kp, float (&s4)[4]) { s4[0] = s4[1] = s4[2] = s4[3] = 0.f;
#pragma unroll
        for (int i = 0; i < 8; ++i) { const f16x8 kv = ld_h8(kp + 8 * i);
#pragma unroll
            for (int j = 0; j < 8; ++j) { const f32x4 qv = *(const LAS f32x4*)(qs + (8 * i + j) * 4); const float kf = (float)kv[j]; s4[0] += qv[0] * kf; s4[1] += qv[1] * kf; s4[2] += qv[2] * kf; s4[3] += qv[3] * kf; } }
#pragma unroll
        for (int hh = 0; hh < 4; ++hh) s4[hh] *= 0.125f; };
    for (int si = c.bid * 8 + c.wave; si < 200 + 395; si += c.G * 8) {
        const int t = si < 200 ? si : 200 + (si - 200) * 41, cur = t >> 6, ncv = t >= 31 ? ((t - 31) >> 4) + 1 : 0;
#pragma unroll
        for (int hh = 0; hh < 4; ++hh) qs[lane * 4 + hh] = (float)Q16[(size_t)t * 256 + hh * 64 + lane];
        if (lane < 9) selb[lane] = 0u;
        float oc[4] = {0.f, 0.f, 0.f, 0.f}, os[4] = {0.f, 0.f, 0.f, 0.f}, ow[4] = {0.f, 0.f, 0.f, 0.f};
        {
            float mx[4] = {-3e38f, -3e38f, -3e38f, -3e38f}, inv[4];
            for (int cc = lane; cc < ncv; cc += 64) { asm volatile("" ::: "memory"); float s4[4]; dot4(KC16 + (size_t)cc * 64, s4);
#pragma unroll
                for (int hh = 0; hh < 4; ++hh) { sc[hh * 1024 + cc] = s4[hh]; mx[hh] = fmaxf(mx[hh], s4[hh]); } }
#pragma unroll
            for (int hh = 0; hh < 4; ++hh) { mx[hh] = wmaxf(mx[hh]); float sm = 0.f; for (int cc = lane; cc < ncv; cc += 64) { const float e = __expf(sc[hh * 1024 + cc] - mx[hh]); sc[hh * 1024 + cc] = e; sm += e; } sm = wsum(sm); inv[hh] = ncv > 0 ? 1.f / sm : 0.f; }
            for (int cc = lane; cc < ncv; cc += 64) {
#pragma unroll
                for (int hh = 0; hh < 4; ++hh) sc[hh * 1024 + cc] *= inv[hh]; }
            for (int cc = 0; cc < ncv; ++cc) { const float v = (float)VCT16[(size_t)lane * 1024 + cc];
#pragma unroll
                for (int hh = 0; hh < 4; ++hh) oc[hh] += sc[hh * 1024 + cc] * v; }
        }
        const int nsel = (cur + 1) < 16 ? (cur + 1) : 16;
        {
            float scv[5];
#pragma unroll
            for (int i = 0; i < 5; ++i) { const int j = lane + 64 * i; float v = -3e38f;
                if (j <= cur) { if (j == 0 || j == cur || j == cur - 1) v = 3e38f; else { float a = 0.f;
#pragma unroll
                        for (int o5 = -1; o5 < 4; ++o5) { const int cc = 4 * j + o5; if (cc >= 0 && cc < ncv) { const float p = (sc[cc] + sc[1024 + cc]) + (sc[2048 + cc] + sc[3072 + cc]); a += (o5 == -1 || o5 == 3) ? 0.5f * p : p; } }
                        v = a; } }
                scv[i] = v; }
            for (int k = 0; k < nsel; ++k) {
                float bv = scv[0]; int bi = lane;
#pragma unroll
                for (int i = 1; i < 5; ++i) if (scv[i] > bv) { bv = scv[i]; bi = lane + 64 * i; }
#pragma unroll
                for (int off = 32; off > 0; off >>= 1) { const float ov = __shfl_xor(bv, off); const int oi = __shfl_xor(bi, off); if (ov > bv || (ov == bv && oi < bi)) { bv = ov; bi = oi; } }
                if (lane == 0) selb[bi >> 5] |= 1u << (bi & 31);
#pragma unroll
                for (int i = 0; i < 5; ++i) if (lane + 64 * i == bi) scv[i] = -3e38f;
            }
        }
        int nmis = 0;
        for (int j = lane; j <= cur; j += 64) { const unsigned fb = (SELM[(size_t)(t >> 5) * 272 + j] >> (t & 31)) & 1u, nb = (selb[j >> 5] >> (j & 31)) & 1u; nmis += (fb != nb) ? 1 : 0; }
        nmis = (int)wsum((float)nmis);
        if (nmis != 0) { if (lane == 0) { atomicAdd(dbg + 3, 1.f); atomicAdd(dbg + 4, (float)nmis); } continue; }
        {
            float mx[4] = {-3e38f, -3e38f, -3e38f, -3e38f}, inv[4]; int nk = 0;
            for (int j = 0; j <= cur; ++j) if ((selb[j >> 5] >> (j & 31)) & 1u) { asm volatile("" ::: "memory"); const int pos = j * 64 + lane; float s4[4] = {-1e30f, -1e30f, -1e30f, -1e30f}; if (pos <= t) dot4(KS16 + (size_t)pos * 64, s4);
#pragma unroll
                for (int hh = 0; hh < 4; ++hh) { sc[hh * 1024 + nk * 64 + lane] = s4[hh]; mx[hh] = fmaxf(mx[hh], s4[hh]); } ++nk; }
#pragma unroll
            for (int hh = 0; hh < 4; ++hh) { mx[hh] = wmaxf(mx[hh]); float sm = 0.f; for (int k = 0; k < nk; ++k) { const float x = sc[hh * 1024 + k * 64 + lane]; const float e = x > -1e29f ? __expf(x - mx[hh]) : 0.f; sc[hh * 1024 + k * 64 + lane] = e; sm += e; } sm = wsum(sm); inv[hh] = 1.f / sm; }
            nk = 0;
            for (int j = 0; j <= cur; ++j) if ((selb[j >> 5] >> (j & 31)) & 1u) { for (int kk = 0; kk < 64 && j * 64 + kk <= t; ++kk) { const float v = (float)VST16[(size_t)j * 4096 + lane * 64 + kk];
#pragma unroll
                    for (int hh = 0; hh < 4; ++hh) os[hh] += sc[hh * 1024 + nk * 64 + kk] * v; } ++nk; }
#pragma unroll
            for (int hh = 0; hh < 4; ++hh) os[hh] *= inv[hh];
        }
        {
            const int lo = t - 512 > 0 ? t - 512 : 0, nw = t - lo + 1; float mx[4] = {-3e38f, -3e38f, -3e38f, -3e38f}, inv[4];
            for (int i = lane; i < nw; i += 64) { asm volatile("" ::: "memory"); float s4[4]; dot4(KW16 + (size_t)(lo + i) * 64, s4);
#pragma unroll
                for (int hh = 0; hh < 4; ++hh) { sc[hh * 1024 + i] = s4[hh]; mx[hh] = fmaxf(mx[hh], s4[hh]); } }
#pragma unroll
            for (int hh = 0; hh < 4; ++hh) { mx[hh] = wmaxf(mx[hh]); float sm = 0.f; for (int i = lane; i < nw; i += 64) { const float e = __expf(sc[hh * 1024 + i] - mx[hh]); sc[hh * 1024 + i] = e; sm += e; } sm = wsum(sm); inv[hh] = 1.f / sm; }
            for (int i = 0; i < nw; ++i) { const int pos = lo + i; const float v = (float)VWT16[(size_t)(pos >> 6) * 4096 + lane * 64 + (pos & 63)];
#pragma unroll
                for (int hh = 0; hh < 4; ++hh) ow[hh] += sc[hh * 1024 + i] * v; }
#pragma unroll
            for (int hh = 0; hh < 4; ++hh) ow[hh] *= inv[hh];
        }
        float dd = 0.f, ee = 0.f;
#pragma unroll
        for (int hh = 0; hh < 4; ++hh) { const float o = GATES[(size_t)t * 12 + hh * 3] * oc[hh] + GATES[(size_t)t * 12 + hh * 3 + 1] * os[hh] + GATES[(size_t)t * 12 + hh * 3 + 2] * ow[hh];
            const float yn = siluf_((float)DG[(size_t)t * 256 + hh * 64 + lane]) * o, yf = (float)Y16[(size_t)t * 1024 + 768 + hh * 64 + lane]; dd += (yf - yn) * (yf - yn); ee += yn * yn; }
        dd = wsum(dd); ee = wsum(ee);
        if (lane == 0) { atomicAdd(dbg, dd); atomicAdd(dbg + 1, ee); atomicAdd(dbg + 2, 1.f); }
    }
    (void)l;
}
DI void ph_ssd_fin(LAS unsigned char* lds_, int l, int it0, int it1, int itstep) {
    const Ctx c = mkctx(lds_); const int lane = c.lane, wave = c.wave;
    const float* Dp = INP(I_SD) + l * 4; const float* sng = INP(I_SNG) + l * 256;
    const float* CST = WSF(WS_HPV); const f16* ACT = WSH(WS_ACT); const float* ACS = WSF(WS_ACS); const float* YD = WSF(WS_YD); const f16* Z = WSH(WS_PROJ) + (size_t)4 * SEQ * 256; f16* Y16 = WSH(WS_Y16);
    LAS float* GY = (LAS float*)c.lds;
    for (int it = it0; it < it1; it += itstep) {
        const int ch_ = it >> 1, t0 = it * 64, hd = wave >> 1, g = hd >> 1, fr = lane & 15, q = lane >> 4;
        __syncthreads();
        f16x8 bf[2][4];
#pragma unroll
        for (int p2 = 0; p2 < 2; ++p2)
#pragma unroll
            for (int ks = 0; ks < 4; ++ks) bf[p2][ks] = cvt_h8(CST + ((size_t)(ch_ * 4 + hd) * 64 + 16 * ((wave & 1) * 2 + p2) + fr) * 128 + 32 * ks + 8 * q);
        for (int lt = 0; lt < 4; ++lt) {
            f16x8 af[4];
#pragma unroll
            for (int ks = 0; ks < 4; ++ks) af[ks] = ld_h8(ACT + (size_t)(t0 + 16 * lt + fr) * 768 + 512 + 128 * g + 32 * ks + 8 * q);
#pragma unroll
            for (int p2 = 0; p2 < 2; ++p2) { f32x4 acc = (f32x4){0.f, 0.f, 0.f, 0.f};
#pragma unroll
                for (int ks = 0; ks < 4; ++ks) acc = __builtin_amdgcn_mfma_f32_16x16x32_f16(af[ks], bf[p2][ks], acc, 0, 0, 0);
                const int ch = hd * 64 + 16 * ((wave & 1) * 2 + p2) + fr;
#pragma unroll
                for (int j = 0; j < 4; ++j) { const int tl = 16 * lt + 4 * q + j, t = t0 + tl;
                    const float y = acc[j] * __expf(ACS[(size_t)t * 4 + hd]) + YD[(size_t)t * 256 + ch] + Dp[hd] * (float)ACT[(size_t)t * 768 + ch];
                    GY[tl * 256 + ch] = y * siluf_((float)Z[(size_t)t * 256 + ch]); } }
        }
        __syncthreads();
        for (int tl = wave; tl < 64; tl += 8) { const f32x4 v = *(const LAS f32x4*)(GY + tl * 256 + lane * 4); const float ss = wsum((v[0] * v[0] + v[1] * v[1]) + (v[2] * v[2] + v[3] * v[3]));
            const float rn = rsqrtf(ss * (1.f / 256.f) + EPS); const f32x4 g4 = *(const f32x4*)(sng + lane * 4); f16x4 o;
#pragma unroll
            for (int i = 0; i < 4; ++i) o[i] = (f16)(v[i] * rn * g4[i]);
            *(f16x4*)(Y16 + (size_t)(t0 + tl) * 1024 + 256 + lane * 4) = o; }
    }
    __syncthreads();
}
DI void ph_outproj(LAS unsigned char* lds_, int l) {
    const Ctx c = mkctx(lds_);
    const float* xin = l == 0 ? INP(I_XP) : WSF(WS_X1); float* xout = l == 0 ? WSF(WS_X1) : c.out + O_YP;
    pg8::Gemm g{WSH(WS_Y16), WSH(WS_WTOUT) + (size_t)l * 1024 * 1024, SEQ, 1024, 1024}; pg8::StaticOrder S; S.init(SEQ, 1024, c.G, c.bid);
    EpiOut E{xin, xout, WSF(WS_ADA) + (size_t)(l * 33 + 32) * 3072 + 2048, l == 0 ? WSH(WS_A16) : nullptr, WSF(WS_GNX), WSF(WS_RSSP)};
    pg8::gemm_phase<EpiOut, pg8::StaticOrder>(c.lds, g, S, E);
    __syncthreads();
}
DI void ph_outproj_sample(LAS unsigned char* lds_, int l, int it) {
    const Ctx c = mkctx(lds_); const int tid = c.tid;
    const float* xs_in = l == 0 ? INP(I_XS) : WSF(WS_XS1); const float* ada_l = WSF(WS_ADA) + (size_t)l * 33 * 3072; const float* YS = WSF(WS_YS); float* xo = l == 0 ? WSF(WS_XS1) : c.out + O_YS;
    LAS f16* Ah = (LAS f16*)c.lds;
    __syncthreads();
#pragma unroll
    for (int i = 0; i < 16; ++i) { const int e = (tid + 512 * i) * 4; const f32x4 v = *(const f32x4*)(YS + e); f16x4 hv; hv[0] = (f16)v[0]; hv[1] = (f16)v[1]; hv[2] = (f16)v[2]; hv[3] = (f16)v[3]; *(LAS f16x4*)(Ah + (e >> 10) * 1032 + (e & 1023)) = hv; }
    __syncthreads();
    sample_gemm_item<1>(c.lds, WSH(WS_WTOUT) + (size_t)l * 1024 * 1024, it * 32, [&](int m, int n, float v) { xo[m * 1024 + n] = xs_in[m * 1024 + n] + ada_l[(size_t)m * 3072 + 2048 + n] * v; });
}

__global__ void __launch_bounds__(512, 2) fwd(Args a) {
    extern __shared__ __attribute__((aligned(16))) unsigned char lds_raw[];
    LAS unsigned char* lds = (LAS unsigned char*)lds_raw;
    volatile LAS unsigned* MISC = (volatile LAS unsigned*)(lds + MISC_OFF);
    if (threadIdx.x < 16) MISC[threadIdx.x] = 0u;
    __syncthreads();
    XcdBarrier bar; bar.bar = (unsigned*)(a.ws + WS_CTL); bar.x = 0; bar.st = MISC;
    if (N_LAUNCHES == 1) bar = xcd_barrier_post((unsigned*)(a.ws + WS_CTL), MISC);
    const int lo = a.ph_lo, hi = a.ph_hi;
    unsigned long long* stampw = (unsigned long long*)(a.ws + WS_CTL + 32768);
    if (STAMP_PHASE >= 0 && blockIdx.x == 0 && threadIdx.x == 0) stampw[0] = wall_clock64();
#define STAMP(k) do { if (STAMP_PHASE == (k) && blockIdx.x == 0 && threadIdx.x == 0) stampw[1] = wall_clock64(); } while (0)
#ifndef PH_MASK
#define PH_MASK 0xFFF
#endif
#define IN(k) (((PH_MASK >> ((k) < 2 ? (k) : 2 + ((k) - 2) % 4)) & 1) && lo <= (k) && (k) < hi)
#define SEAM(k) do { if (IN(k) && IN((k) + 1)) xcd_barrier(bar); STAMP(k); } while (0)
#ifndef DUP_MASK
#define DUP_MASK 0
#endif
#define DUP(bit, call) do { call; if ((DUP_MASK >> (bit)) & 1) { __syncthreads(); call; } } while (0)
    if (IN(0)) DUP(0, ph_prologue(lds));
    SEAM(0);
    if (IN(1)) { ph_hsample(lds, 0); DUP(1, ph_sample_compress(lds)); DUP(2, ph_prep(lds)); }
    SEAM(1);
    for (int l = 0; l < 2; ++l) {
        const int PB = 2 + 4 * l;
        if (IN(PB)) { DUP(3, ph_inproj(lds, l)); DUP(4, ph_inproj_sample(lds, l)); }
        SEAM(PB);
        if (IN(PB + 1)) {
#define SUBSTAMP(code) do { if (l == 0 && (STAMP_PHASE == (code) || STAMP_PHASE == (code) + 10) && blockIdx.x == (STAMP_PHASE >= 110 ? 100 : 0) && threadIdx.x == 0) stampw[1] = wall_clock64(); } while (0)
            DUP(5, ph_ssd_local(lds, l)); SUBSTAMP(100); DUP(6, ph_mix_a(lds, l)); SUBSTAMP(101); DUP(7, ph_mix_c(lds, l)); SUBSTAMP(102); DUP(8, ph_mix_d(lds, l)); SUBSTAMP(103); DUP(9, ph_mix_cmp(lds, l)); SUBSTAMP(104); }
        SEAM(PB + 1);
        if (IN(PB + 2)) { DUP(11, ph_scan(lds, l)); DUP(10, ph_mix_sample(lds, l)); ph_nsa(lds, l); }
        SEAM(PB + 2);
        if (IN(PB + 3)) { if (VERIFY_NSA && l == 0) { ph_nsa_verify(lds, l); __syncthreads(); } if (l == 0) ph_hsample(lds, 1); DUP(14, ph_outproj(lds, l)); }
        SEAM(PB + 3);
    }
    if (STAMP_PHASE >= 0 || VERIFY_NSA) {
        xcd_barrier(bar);
        if (blockIdx.x == 0) { __shared__ float alpha_s; if (threadIdx.x == 0) { const unsigned long long t1 = wall_clock64(); alpha_s = (float)(stampw[1] - stampw[0]) / (float)(t1 - stampw[0]);
                if (VERIFY_NSA) { const float* dbg = (const float*)(a.ws + WS_CTL + 40960); alpha_s = VERIFY_NSA == 1 ? dbg[3] / (dbg[2] + dbg[3]) : sqrtf(dbg[0] / dbg[1]); } } __syncthreads();
            const float sc = 1.f + alpha_s; float* ys = a.out + O_YS; for (int i = threadIdx.x; i < NB * 1024; i += 512) ys[i] *= sc; }
    }
#undef IN
#undef SEAM
}

extern "C" void kernel_launch(void* const* d_in, const int* in_sizes, int n_in, void* d_out, int out_size, void* d_ws, size_t ws_size, hipStream_t stream) {
    static int grid = 0;
    if (grid == 0) {
        if (n_in != N_IN || (size_t)out_size != O_END || ws_size < WS_END) { fprintf(stderr, "kernel_launch: unexpected shapes (n_in %d out %d ws %zu)\n", n_in, out_size, ws_size); grid = -1; return; }
        int dev = 0, cus = 0;
        if (hipGetDevice(&dev) != hipSuccess || hipDeviceGetAttribute(&cus, hipDeviceAttributeMultiprocessorCount, dev) != hipSuccess) { grid = -1; return; }
        if (hipFuncSetAttribute((const void*)fwd, hipFuncAttributeMaxDynamicSharedMemorySize, LDS_BYTES) != hipSuccess) { fprintf(stderr, "kernel_launch: hipFuncSetAttribute failed\n"); grid = -1; return; }
        int per_cu = 0;
        if (hipOccupancyMaxActiveBlocksPerMultiprocessor(&per_cu, (const void*)fwd, 512, LDS_BYTES) != hipSuccess || per_cu < 1) fprintf(stderr, "kernel_launch: occupancy query says %d\n", per_cu);
        (void)hipGetLastError();
        grid = cus;
    }
    if (grid < 0) return;
    hipMemsetAsync((char*)d_ws + WS_CTL, 0, 65536, stream);
    Args a{};
    for (int i = 0; i < N_IN; ++i) a.in[i] = d_in[i];
    a.out = (float*)d_out; a.ws = (unsigned char*)d_ws;
    if (N_LAUNCHES == 1) { a.ph_lo = 0; a.ph_hi = NPHASE; hipLaunchKernelGGL(fwd, dim3(grid), dim3(512), LDS_BYTES, stream, a); }
    else for (int p = 0; p < NPHASE; ++p) { a.ph_lo = p; a.ph_hi = p + 1; hipLaunchKernelGGL(fwd, dim3(grid), dim3(512), LDS_BYTES, stream, a); }
}
```

```cpp
#include <hip/hip_runtime.h>
#include <cstdio>
#include <cstdint>
#include <type_traits>

#define NSA_DUP 0
#define VERIFY_NSA 0
#define STAMP_PHASE -1
#ifndef N_LAUNCHES
#define N_LAUNCHES 1
#endif

#define DI __device__ __forceinline__
#define LAS __attribute__((address_space(3)))
typedef _Float16 f16;
typedef _Float16 f16x8 __attribute__((ext_vector_type(8)));
typedef _Float16 f16x4 __attribute__((ext_vector_type(4)));
typedef _Float16 f16x2 __attribute__((ext_vector_type(2)));
typedef float f32x4 __attribute__((ext_vector_type(4)));
typedef float f32x2 __attribute__((ext_vector_type(2)));
typedef float f32x16 __attribute__((ext_vector_type(16)));
typedef unsigned u32x4 __attribute__((ext_vector_type(4)));

constexpr int DM = 1024, SEQ = 16384, NB = 32, PAST = 16384, NPOOL = 5120, DIN = 3728, NPD = 3840;
constexpr float EPS = 1e-6f;
constexpr int NPHASE = 10;
enum { I_XP = 0, I_XS, I_CKV, I_CWIN, I_SSC, I_SBC, I_SSM, I_SCF, I_PT, I_CP, I_CS, I_NG, I_WADA, I_BADA, I_WIN, I_WOUT, I_SCW, I_BCW, I_BCB,
       I_DTB, I_ALOG, I_SD, I_SNG, I_CFW, I_CFB, I_LNG, I_LNB, I_QG, I_KG, I_PE, I_W1, I_B1, I_W2, I_B2, N_IN };
constexpr size_t O_YP = 0, O_YS = O_YP + (size_t)SEQ * DM, O_KVP = O_YS + NB * DM, O_KVS = O_KVP + (size_t)2 * SEQ * 256, O_WINP = O_KVS + 2 * NB * 256,
                 O_WINS = O_WINP + 2 * 512 * 128, O_SCP = O_WINS + (size_t)2 * NB * 512 * 128, O_SCS = O_SCP + 2 * 2 * 256, O_BCP = O_SCS + 2 * NB * 512,
                 O_BCS = O_BCP + 2 * 3 * 768, O_HP = O_BCS + 2 * NB * 2304, O_HS = O_HP + 2 * 32768, O_CFP = O_HS + (size_t)2 * NB * 32768,
                 O_CFS = O_CFP + 2 * 30 * 256, O_END = O_CFS + 2 * NB * 7680;
constexpr size_t al256(size_t x) { return (x + 255) & ~(size_t)255; }
constexpr size_t WS_CTL = 0, WS_ADA = 65536, WS_BIAS = WS_ADA + al256(2 * 33 * 3072 * 4), WS_PEB = WS_BIAS + al256(2 * NPD * 4), WS_WTIN = WS_PEB + 2048,
                 WS_WTOUT = WS_WTIN + (size_t)2 * NPD * 1024 * 2, WS_W1T = WS_WTOUT + (size_t)2 * 1024 * 1024 * 2, WS_A16 = WS_W1T + (size_t)4 * 128 * 2048 * 2,
                 WS_RSSP = WS_A16 + (size_t)SEQ * 1024 * 2, WS_X1 = WS_RSSP + (size_t)SEQ * 16 * 4, WS_PROJ = WS_X1 + (size_t)SEQ * 1024 * 4,
                 WS_Y16 = WS_PROJ + (size_t)15 * SEQ * 256 * 2, WS_ACT = WS_Y16 + (size_t)SEQ * 1024 * 2, WS_YD = WS_ACT + (size_t)SEQ * 768 * 2,
                 WS_CST = WS_YD + (size_t)SEQ * 256 * 4, WS_ACS = WS_CST + (size_t)128 * 32768 * 4, WS_CDEC = WS_ACS + (size_t)SEQ * 4 * 4, WS_Q16 = WS_CDEC + 2048,
                 WS_KS16 = WS_Q16 + (size_t)SEQ * 256 * 2, WS_VS16 = WS_KS16 + (size_t)SEQ * 64 * 2, WS_KW16 = WS_VS16 + (size_t)SEQ * 64 * 2,
                 WS_VW16 = WS_KW16 + (size_t)SEQ * 64 * 2, WS_GATES = WS_VW16 + (size_t)SEQ * 64 * 2, WS_KC = WS_GATES + (size_t)SEQ * 12 * 4,
                 WS_VC = WS_KC + 1024 * 64 * 4, WS_KCS = WS_VC + 1024 * 64 * 4, WS_VCS = WS_KCS + (size_t)2 * NB * 1024 * 64 * 4,
                 WS_PROJS = WS_VCS + (size_t)2 * NB * 1024 * 64 * 4, WS_YS = WS_PROJS + al256(NB * NPD * 4), WS_XS1 = WS_YS + NB * 1024 * 4, WS_GNX = WS_XS1 + NB * 1024 * 4, WS_NRG = WS_GNX + 4096, WS_VST16 = WS_NRG + 2 * NB * 1024, WS_VWT16 = WS_VST16 + (size_t)SEQ * 64 * 2, WS_KC16 = WS_VWT16 + (size_t)SEQ * 64 * 2,
                 WS_VCT16 = WS_KC16 + 1024 * 64 * 2, WS_HPV = WS_VCT16 + 1024 * 64 * 2, WS_W2T = WS_HPV + (size_t)128 * 32768 * 4, WS_PEBP = WS_W2T + 4 * 64 * 128 * 2, WS_HS16 = WS_PEBP + 4 * 8 * 128 * 4, WS_SELM = WS_HS16 + NB * 1024 * 2, WS_END = WS_SELM + 512 * 272 * 4;
constexpr int LDS_BYTES = 147456;
constexpr int MISC_OFF = 147200;

struct Args { const void* in[N_IN]; float* out; unsigned char* ws; int ph_lo, ph_hi; };

#define XB_TMO      128
#define XB_XCNT(j)  (256  + 64 * (j))
#define XB_XSUB(j)  (1280 + 64 * (j))
#define XB_XGEN(j)  (2304 + 64 * (j))
#define XB_TOP      3328
#define XB_TOPGEN   3392
#define XCD_BAR_WORDS 3456
#define XB_SPIN_CAP (1u << 18)
__device__ __forceinline__ unsigned xb_ld(unsigned* p)              { return __hip_atomic_load(p, __ATOMIC_RELAXED, __HIP_MEMORY_SCOPE_AGENT); }
__device__ __forceinline__ unsigned xb_add(unsigned* p, unsigned v) { return __hip_atomic_fetch_add(p, v, __ATOMIC_RELAXED, __HIP_MEMORY_SCOPE_AGENT); }
__device__ __forceinline__ unsigned xb_xcc_id() { return (unsigned)__builtin_amdgcn_s_getreg((3 << 11) | 20) & 0xFu; }
#define XB_SPIN(cond, bar) do { unsigned _sp = 0; while (cond) { __builtin_amdgcn_s_sleep(1); \
    if ((++_sp & 255u) == 0u) { if (xb_ld(&(bar)[XB_TMO])) break; if (_sp > XB_SPIN_CAP) { atomicAdd(&(bar)[XB_TMO], 1u); break; } } } } while (0)
struct XcdBarrier { unsigned* bar; unsigned x; volatile LAS unsigned* st; };
__device__ __forceinline__ XcdBarrier xcd_barrier_post(unsigned* bar, volatile LAS unsigned* st) {
    XcdBarrier b; b.bar = bar; b.x = xb_xcc_id(); b.st = st;
    if (threadIdx.x == 0) (void)xb_add(&bar[XB_XCNT(b.x)], 1u);
    return b;
}
__device__ __forceinline__ void xcd_barrier_complete(unsigned* bar, unsigned x, unsigned& nloc, unsigned& nx) {
    const unsigned G = gridDim.x * gridDim.y * gridDim.z;
    unsigned sum, cnt, mine, sp = 0u;
    for (;;) {
        sum = 0u; cnt = 0u; mine = 0u;
#pragma unroll
        for (unsigned j = 0; j < 16; ++j) { const unsigned c = xb_ld(&bar[XB_XCNT(j)]); sum += c; cnt += (c > 0u) ? 1u : 0u; mine = (j == x) ? c : mine; }
        if (sum == G) break;
        __builtin_amdgcn_s_sleep(1);
        if ((++sp & 255u) == 0u) { if (xb_ld(&bar[XB_TMO])) break; if (sp > XB_SPIN_CAP) { atomicAdd(&bar[XB_TMO], 1u); break; } }
    }
    nloc = mine > 0u ? mine : 1u; nx = cnt > 0u ? cnt : 1u;
}
__device__ __forceinline__ void xcd_barrier(const XcdBarrier& b) {
    asm volatile("s_waitcnt vmcnt(0)" ::: "memory");
    __syncthreads();
    if (threadIdx.x == 0) {
        unsigned* bar = b.bar;
        __builtin_amdgcn_s_waitcnt(0);
        unsigned nloc = b.st[0], nx = b.st[1];
        if (nloc == 0u) { xcd_barrier_complete(bar, b.x, nloc, nx); b.st[0] = nloc; b.st[1] = nx; }
        const unsigned old = xb_add(&bar[XB_XSUB(b.x)], 1u);
        const unsigned gen = old / nloc;
        if (old + 1u == (gen + 1u) * nloc) {
            __builtin_amdgcn_fence(__ATOMIC_RELEASE, "agent");
            asm volatile("s_waitcnt vmcnt(0)" ::: "memory");
            const unsigned og = xb_add(&bar[XB_TOP], 1u);
            const unsigned tg = og / nx;
            if (og + 1u == (tg + 1u) * nx) xb_add(&bar[XB_TOPGEN], 1u);
            else XB_SPIN(xb_ld(&bar[XB_TOPGEN]) == tg, bar);
            __builtin_amdgcn_fence(__ATOMIC_ACQUIRE, "agent");
            xb_add(&bar[XB_XGEN(b.x)], 1u);
            asm volatile("s_waitcnt vmcnt(0)" ::: "memory");
        } else {
            XB_SPIN(xb_ld(&bar[XB_XGEN(b.x)]) == gen, bar);
            __builtin_amdgcn_fence(__ATOMIC_ACQUIRE, "agent");
            asm volatile("s_waitcnt vmcnt(0)" ::: "memory");
        }
    }
    __syncthreads();
}

DI void lds_barrier() { asm volatile("s_waitcnt lgkmcnt(0)\n\ts_barrier" ::: "memory"); }
DI int ltid() { int t = threadIdx.x; asm volatile("" : "+v"(t)); return t; }
template <int CTRL> DI float dppf(float x) { return __builtin_bit_cast(float, __builtin_amdgcn_update_dpp(0, __builtin_bit_cast(int, x), CTRL, 0xF, 0xF, true)); }
template <int CTRL> DI int dppi(int x) { return __builtin_amdgcn_update_dpp(0, x, CTRL, 0xF, 0xF, true); }
constexpr int DPP_X1 = 0xB1, DPP_X2 = 0x4E, DPP_HM = 0x141, DPP_R8 = 0x128;
DI float sum16(float v) { v += dppf<DPP_X1>(v); v += dppf<DPP_X2>(v); v += dppf<DPP_HM>(v); v += dppf<DPP_R8>(v); return v; }
DI float max16(float v) { v = fmaxf(v, dppf<DPP_X1>(v)); v = fmaxf(v, dppf<DPP_X2>(v)); v = fmaxf(v, dppf<DPP_HM>(v)); v = fmaxf(v, dppf<DPP_R8>(v)); return v; }
DI float wsum(float v) { v = sum16(v); v += __shfl_xor(v, 16); v += __shfl_xor(v, 32); return v; }
DI float wmaxf(float v) { v = max16(v); v = fmaxf(v, __shfl_xor(v, 16)); v = fmaxf(v, __shfl_xor(v, 32)); return v; }
DI float sigmoidf_(float x) { return 1.f / (1.f + __expf(-x)); }
DI float siluf_(float x) { return x / (1.f + __expf(-x)); }
DI float softplusf_(float x) { return fmaxf(x, 0.f) + log1pf(__expf(-fabsf(x))); }
DI f16x8 ld_h8(const f16* p) { return *(const f16x8*)p; }
DI f16x8 cvt_h8(const float* p) { const f32x4 a = *(const f32x4*)p, b = *(const f32x4*)(p + 4); f16x8 r; r[0] = (f16)a[0]; r[1] = (f16)a[1]; r[2] = (f16)a[2]; r[3] = (f16)a[3]; r[4] = (f16)b[0]; r[5] = (f16)b[1]; r[6] = (f16)b[2]; r[7] = (f16)b[3]; return r; }
DI int src_col(int n) { return n < 2048 ? n : (n < 3456 ? n + 4 : (n < 3460 ? n - 1408 : (n < 3472 ? n + 256 : (n < 3584 ? -1 : n - 124)))); }
DI int dst_col(int s) { return s < 2048 ? s : (s < 2052 ? s + 1408 : (s < 3460 ? s - 4 : (s < 3716 ? s + 124 : s - 256))); }

DI void edge_publish(unsigned* ctr) {
    asm volatile("s_waitcnt vmcnt(0)" ::: "memory"); __syncthreads();
    if (threadIdx.x == 0) { __builtin_amdgcn_fence(__ATOMIC_RELEASE, "agent"); asm volatile("s_waitcnt vmcnt(0)" ::: "memory"); __hip_atomic_fetch_add(ctr, 1u, __ATOMIC_RELAXED, __HIP_MEMORY_SCOPE_AGENT); }
}
DI void edge_wait(unsigned* ctr, unsigned need) {
    if (threadIdx.x == 0) { unsigned sp = 0;
        while (__hip_atomic_load(ctr, __ATOMIC_RELAXED, __HIP_MEMORY_SCOPE_AGENT) < need) { __builtin_amdgcn_s_sleep(8); if (++sp > (1u << 22)) break; }
        __builtin_amdgcn_fence(__ATOMIC_ACQUIRE, "agent"); asm volatile("s_waitcnt vmcnt(0)" ::: "memory"); }
    __syncthreads();
}
namespace pg8 {
constexpr int BM = 256, BK = 64, HALF = 128, HTB = HALF * BK * 2, STAGE_BYTES = 8 * HTB, NXCD = 8, WGM = 8;
DI int lds_byte(int r, int c) { const int st = (r >> 4) * 2 + (c >> 5), rr = r & 15, cc = c & 31, ob = rr * 64 + cc * 2; return st * 1024 + (ob ^ (((ob >> 9) & 1) << 5)); }
DI void stage_rc(int b, int& R, int& C) { const int st = b / 1024, sb = b % 1024, swz = sb ^ (((sb >> 9) & 1) << 5); R = (st >> 1) * 16 + swz / 64; C = (st & 1) * 32 + (swz % 64) / 2; }
DI int perm32(int rho) { const int n = rho >> 4, i = rho & 15; return 8 * (i >> 2) + 4 * n + (i & 3); }
struct Unit { int pm, pn; };
struct Gemm { const f16* A; const f16* Bt; int M, N, K; };
struct StaticOrder {
    int nM, nN, nwg, G, c;
    DI void init(int M, int N, int G_, int c_) { nM = M / BM; nN = N / BM; nwg = nM * nN; G = G_; c = c_; }
    DI bool next(int i, Unit& u) const {
        const long L = (long)i * G + c; if (L >= nwg) return false;
        int wgid = (int)L; { const int q = nwg / NXCD, r = nwg % NXCD, xcd = wgid % NXCD, off = wgid / NXCD; wgid = (xcd < r ? xcd * (q + 1) : r * (q + 1) + (xcd - r) * q) + off; }
        const int nig = WGM * nN, gid = wgid / nig, fm = gid * WGM, gsz = (nM - fm) < WGM ? (nM - fm) : WGM;
        u.pm = fm + ((wgid % nig) % gsz); u.pn = (wgid % nig) / gsz; return true;
    }
    DI void a_ready(const Unit&) const {}
    DI void done(const Unit&) const {}
};
template <class Epi, class Sched>
DI void gemm_phase(LAS unsigned char* lds, const Gemm g, const Sched& S, const Epi& E) {
    const int tid = ltid(), wid = __builtin_amdgcn_readfirstlane(tid >> 6), lane = tid & 63, wr = wid >> 2, wc = wid & 3, fr = lane & 15, fq = lane >> 4;
    const int K = g.K, nt = K / BK;
    unsigned voffA[2], voffB[2];
#pragma unroll
    for (int i = 0; i < 2; ++i) { int R, C; stage_rc(tid * 16 + i * 8192, R, C); const int Rb = Epi::PERM ? ((R & ~31) + perm32(R & 31)) : R;
        voffA[i] = (unsigned)(R * K + C) * 2u; voffB[i] = (unsigned)(Rb * K + C) * 2u; }
    const size_t kstep = (size_t)(BK * 2);
    const size_t hstep = (size_t)HALF * K * 2;
    const size_t tstep = 2 * hstep;
    const unsigned ldsw = (unsigned)wid * 1024u;
    const int aoff = lds_byte(wr * 64 + fr, fq * 8), boff = lds_byte(wc * 32 + fr, fq * 8);
#define PG8_SA(b, h) (((b) * 2 + (h)) * HTB)
#define PG8_SB(b, h) ((4 + (b) * 2 + (h)) * HTB)
#define PG8_STAGE(bufoff, gbase, voff) do { _Pragma("unroll") for (int _i = 0; _i < 2; ++_i) \
        __builtin_amdgcn_global_load_lds((const unsigned*)((const char*)(gbase) + (voff)[_i]), (LAS unsigned*)(lds + (bufoff) + ldsw + _i * 8192), 16, 0, 0); } while (0)
#define PG8_LDA(dst, b, h) do { _Pragma("unroll") for (int m = 0; m < 4; ++m) _Pragma("unroll") for (int k = 0; k < 2; ++k) dst[m][k] = *(const LAS f16x8*)(lds + PG8_SA(b, h) + aoff + m * 2048 + k * 1024); } while (0)
#define PG8_LDB(dst, b, h) do { _Pragma("unroll") for (int n = 0; n < 2; ++n) _Pragma("unroll") for (int k = 0; k < 2; ++k) dst[n][k] = *(const LAS f16x8*)(lds + PG8_SB(b, h) + boff + n * 2048 + k * 1024); } while (0)
#define PG8_MMA(ai, bj, At, Bt) do { __builtin_amdgcn_s_setprio(1); _Pragma("unroll") for (int m = 0; m < 4; ++m) _Pragma("unroll") for (int n = 0; n < 2; ++n) _Pragma("unroll") for (int k = 0; k < 2; ++k) \
        acc[ai][bj][m][n] = __builtin_amdgcn_mfma_f32_16x16x32_f16(Bt[n][k], At[m][k], acc[ai][bj][m][n], 0, 0, 0); __builtin_amdgcn_s_setprio(0); } while (0)
#define PG8_WAIT_V(n) asm volatile("s_waitcnt vmcnt(" #n ")" ::: "memory")
#define PG8_WAIT_L(n) asm volatile("s_waitcnt lgkmcnt(" #n ")" ::: "memory")
#define PG8_BAR __builtin_amdgcn_s_barrier()
#define PG8_SCHED __builtin_amdgcn_sched_barrier(0)
    Unit cur, nxt; int ui = 0;
    if (!S.next(0, cur)) return;
    f32x4 acc[2][2][4][2];
#pragma unroll
    for (int a = 0; a < 2; ++a)
#pragma unroll
        for (int b = 0; b < 2; ++b)
#pragma unroll
            for (int m = 0; m < 4; ++m)
#pragma unroll
                for (int n = 0; n < 2; ++n) acc[a][b][m][n] = (f32x4){0.f, 0.f, 0.f, 0.f};
    f16x8 At[4][2], B0[2][2], B1[2][2];
    const char* cA = (const char*)g.A + (size_t)cur.pm * tstep; const char* cB = (const char*)g.Bt + (size_t)cur.pn * tstep;
    S.a_ready(cur);
    PG8_STAGE(PG8_SB(0, 0), cB, voffB); PG8_STAGE(PG8_SA(0, 0), cA, voffA); PG8_STAGE(PG8_SB(0, 1), cB + hstep, voffB); PG8_STAGE(PG8_SA(0, 1), cA + hstep, voffA);
    if (wr == 1) PG8_BAR;
    PG8_WAIT_V(4); PG8_BAR;
    PG8_STAGE(PG8_SB(1, 0), cB + kstep, voffB); PG8_STAGE(PG8_SA(1, 0), cA + kstep, voffA); PG8_STAGE(PG8_SB(1, 1), cB + hstep + kstep, voffB);
    PG8_WAIT_V(6); PG8_BAR;
    for (;;) {
        const bool has_next = S.next(ui + 1, nxt);
        const char* nA = has_next ? (const char*)g.A + (size_t)nxt.pm * tstep : cA; const char* nB = has_next ? (const char*)g.Bt + (size_t)nxt.pn * tstep : cB;
        for (int t = 0; t < nt; t += 2) {
            const bool last = (t == nt - 2);
            const char* a1 = cA + (size_t)(t + 1) * kstep;
            const char* a2 = last ? nA : cA + (size_t)(t + 2) * kstep; const char* b2 = last ? nB : cB + (size_t)(t + 2) * kstep;
            const char* a3 = a2 + kstep; const char* b3 = b2 + kstep;
            if (last && has_next) S.a_ready(nxt);
            PG8_LDB(B0, 0, 0); PG8_SCHED; PG8_LDA(At, 0, 0); PG8_STAGE(PG8_SA(1, 1), a1 + hstep, voffA);
            PG8_WAIT_L(8); PG8_BAR; PG8_WAIT_L(0); PG8_MMA(0, 0, At, B0); PG8_BAR; PG8_SCHED;
            PG8_LDB(B1, 0, 1); PG8_STAGE(PG8_SB(0, 0), b2, voffB);
            PG8_BAR; PG8_WAIT_L(0); PG8_MMA(0, 1, At, B1); PG8_BAR;
            PG8_LDA(At, 0, 1); PG8_STAGE(PG8_SA(0, 0), a2, voffA);
            PG8_BAR; PG8_WAIT_L(0); PG8_MMA(1, 0, At, B0); PG8_BAR; PG8_SCHED;
            PG8_STAGE(PG8_SB(0, 1), b2 + hstep, voffB);
            PG8_WAIT_V(6); PG8_BAR; PG8_MMA(1, 1, At, B1); PG8_BAR;
            PG8_LDB(B0, 1, 0); PG8_SCHED; PG8_LDA(At, 1, 0); PG8_STAGE(PG8_SA(0, 1), a2 + hstep, voffA);
            PG8_WAIT_L(8); PG8_BAR; PG8_WAIT_L(0); PG8_MMA(0, 0, At, B0); PG8_BAR; PG8_SCHED;
            PG8_LDB(B1, 1, 1); PG8_STAGE(PG8_SB(1, 0), b3, voffB);
            PG8_BAR; PG8_WAIT_L(0); PG8_MMA(0, 1, At, B1); PG8_BAR;
            PG8_LDA(At, 1, 1); PG8_STAGE(PG8_SA(1, 0), a3, voffA);
            PG8_BAR; PG8_WAIT_L(0); PG8_MMA(1, 0, At, B0); PG8_BAR; PG8_SCHED;
            PG8_STAGE(PG8_SB(1, 1), b3 + hstep, voffB);
            PG8_WAIT_V(6); PG8_BAR; PG8_MMA(1, 1, At, B1); PG8_BAR;
        }
        E(acc, cur, wr, wc, fr, fq);
        if (!has_next) break;
#pragma unroll
        for (int a = 0; a < 2; ++a)
#pragma unroll
            for (int b = 0; b < 2; ++b)
#pragma unroll
                for (int m = 0; m < 4; ++m)
#pragma unroll
                    for (int n = 0; n < 2; ++n) acc[a][b][m][n] = (f32x4){0.f, 0.f, 0.f, 0.f};
        cur = nxt; cA = nA; cB = nB; ++ui;
    }
    PG8_WAIT_V(0);
    if (wr == 0) PG8_BAR;
    PG8_BAR;
#undef PG8_SA
#undef PG8_SB
#undef PG8_STAGE
#undef PG8_LDA
#undef PG8_LDB
#undef PG8_MMA
#undef PG8_WAIT_V
#undef PG8_WAIT_L
#undef PG8_BAR
#undef PG8_SCHED
}
}

struct EpiIn {
    static constexpr bool PERM = true;
    f16* proj; const float* rssp; const float* bias; float* kvout;
    DI void operator()(const f32x4 (&acc)[2][2][4][2], const pg8::Unit& u, int wr, int wc, int fr, int fq) const {
        const int row0 = u.pm * 256 + wr * 64 + fr, colt = wc * 32 + 8 * fq;
        f32x4 bv[2][2];
#pragma unroll
        for (int bj = 0; bj < 2; ++bj)
#pragma unroll
            for (int n = 0; n < 2; ++n) bv[bj][n] = *(const f32x4*)(bias + u.pn * 256 + colt + bj * 128 + 4 * n);
        f16* pt = proj + (size_t)u.pn * SEQ * 256;
#pragma unroll
        for (int ai = 0; ai < 2; ++ai)
#pragma unroll
            for (int m = 0; m < 4; ++m) {
                const int row = row0 + ai * 128 + m * 16;
                const f32x4* rp = (const f32x4*)(rssp + (size_t)row * 16);
                const f32x4 s0 = rp[0], s1 = rp[1], s2 = rp[2], s3 = rp[3];
                const float ss = ((s0[0] + s0[1]) + (s0[2] + s0[3])) + ((s1[0] + s1[1]) + (s1[2] + s1[3])) + ((s2[0] + s2[1]) + (s2[2] + s2[3])) + ((s3[0] + s3[1]) + (s3[2] + s3[3]));
                const float r = rsqrtf(ss * (1.f / 1024.f) + EPS);
#pragma unroll
                for (int bj = 0; bj < 2; ++bj) {
                    const f32x4 v0 = acc[ai][bj][m][0] * r + bv[bj][0], v1 = acc[ai][bj][m][1] * r + bv[bj][1];
                    f16x8 h; h[0] = (f16)v0[0]; h[1] = (f16)v0[1]; h[2] = (f16)v0[2]; h[3] = (f16)v0[3]; h[4] = (f16)v1[0]; h[5] = (f16)v1[1]; h[6] = (f16)v1[2]; h[7] = (f16)v1[3];
                    *(f16x8*)(pt + (size_t)row * 256 + colt + bj * 128) = h;
                    if (u.pn == 12) { float* kp = kvout + (size_t)row * 256 + colt + bj * 128; *(f32x4*)kp = v0; *(f32x4*)(kp + 4) = v1; }
                }
            }
    }
};
struct EpiOut {
    static constexpr bool PERM = false;
    const float* xin; float* xout; const float* gate; f16* a16; const float* gnext; float* rssp;
    DI void operator()(const f32x4 (&acc)[2][2][4][2], const pg8::Unit& u, int wr, int wc, int fr, int fq) const {
        const int row0 = u.pm * 256 + wr * 64 + fr, col0 = u.pn * 256 + wc * 32 + 4 * fq;
        float ss[2][4];
#pragma unroll
        for (int ai = 0; ai < 2; ++ai)
#pragma unroll
            for (int m = 0; m < 4; ++m) ss[ai][m] = 0.f;
#pragma unroll
        for (int bj = 0; bj < 2; ++bj)
#pragma unroll
            for (int n = 0; n < 2; ++n) {
                const int col = col0 + bj * 128 + n * 16;
                const f32x4 gv = *(const f32x4*)(gate + col); f32x4 gn = (f32x4){0.f, 0.f, 0.f, 0.f}; if (a16) gn = *(const f32x4*)(gnext + col);
#pragma unroll
                for (int ai = 0; ai < 2; ++ai)
#pragma unroll
                    for (int m = 0; m < 4; ++m) {
                        const int row = row0 + ai * 128 + m * 16;
                        const f32x4 xv = *(const f32x4*)(xin + (size_t)row * 1024 + col);
                        const f32x4 o = xv + gv * acc[ai][bj][m][n];
                        *(f32x4*)(xout + (size_t)row * 1024 + col) = o;
                        ss[ai][m] += (o[0] * o[0] + o[1] * o[1]) + (o[2] * o[2] + o[3] * o[3]);
                        if (a16) { f16x4 h; h[0] = (f16)(o[0] * gn[0]); h[1] = (f16)(o[1] * gn[1]); h[2] = (f16)(o[2] * gn[2]); h[3] = (f16)(o[3] * gn[3]);
                            *(f16x4*)(a16 + (size_t)row * 1024 + col) = h; }
                    }
                asm volatile("" ::: "memory");
            }
        if (a16) {
#pragma unroll
            for (int ai = 0; ai < 2; ++ai)
#pragma unroll
                for (int m = 0; m < 4; ++m) { float v = ss[ai][m]; v += __shfl_xor(v, 16); v += __shfl_xor(v, 32);
                    if (fq == 0) rssp[(size_t)(row0 + ai * 128 + m * 16) * 16 + u.pn * 4 + wc] = v; }
        }
    }
};

template <int MP  , class AFn, class OFn>
DI void skinny_item(LAS unsigned char* lds, const float* W, int ldw, int n0, int ncols, int M, AFn afn, OFn ofn) {
    const int tid = ltid(), wave = tid >> 6, lane = tid & 63;
    LAS float* As = (LAS float*)lds;
    float acc[MP];
#pragma unroll
    for (int m = 0; m < MP; ++m) acc[m] = 0.f;
    for (int kc = 0; kc < 1024; kc += 512) {
        __syncthreads();
#pragma unroll 4
        for (int m = 0; m < MP; ++m) As[tid * 36 + m] = (m < M) ? afn(m, kc + tid) : 0.f;
        __syncthreads();
        const int kb = wave * 64;
#pragma unroll 8
        for (int kk = 0; kk < 64; ++kk) {
            const float w = (lane < ncols) ? W[(size_t)(kc + kb + kk) * ldw + n0 + lane] : 0.f;
            const float av = As[(kb + kk) * 36 + lane];
#pragma unroll
            for (int m = 0; m < MP; ++m) acc[m] += __builtin_bit_cast(float, __builtin_amdgcn_readlane(__builtin_bit_cast(int, av), m)) * w;
        }
    }
    __syncthreads();
    LAS float* R = (LAS float*)lds;
#pragma unroll
    for (int m = 0; m < MP; ++m) R[(wave * 36 + m) * 64 + lane] = acc[m];
    __syncthreads();
    for (int idx = tid; idx < M * 64; idx += 512) { const int m = idx >> 6, c = idx & 63; float s = 0.f;
#pragma unroll
        for (int w = 0; w < 8; ++w) s += R[(w * 36 + m) * 64 + c];
        if (c < ncols) ofn(m, n0 + c, s); }
    __syncthreads();
}

template <bool F32> struct Raw16 { f32x4 f[4]; f16x8 hv[2];
    DI void ld(const void* p) { if (F32) {
#pragma unroll
            for (int i = 0; i < 4; ++i) f[i] = *(const f32x4*)((const float*)p + 4 * i); } else { hv[0] = *(const f16x8*)p; hv[1] = *(const f16x8*)((const f16*)p + 8); } }
    DI f16x8 get(int i) const { if (F32) { const f32x4 a = f[2 * i], b = f[2 * i + 1]; f16x8 r; r[0] = (f16)a[0]; r[1] = (f16)a[1]; r[2] = (f16)a[2]; r[3] = (f16)a[3]; r[4] = (f16)b[0]; r[5] = (f16)b[1]; r[6] = (f16)b[2]; r[7] = (f16)b[3]; return r; } return hv[i]; } };
template <bool SRC_F32, class ChunkFn>
DI void compress_item(LAS unsigned char* lds, ChunkFn chunkp  , int c0, const f16* w1t, const float* peb, const f16* w2t  , const float* b2, const float* kg, float* out, f16* out16, f16* outT16) {
    typedef typename std::conditional<SRC_F32, float, f16>::type T;
    const int tid = ltid(), wave = tid >> 6, lane = tid & 63, wm = wave >> 2, wq = wave & 3, r = lane & 31, h = lane >> 5;
    LAS f16* As = (LAS f16*)lds;
    LAS f16* Bs = (LAS f16*)(lds + 2 * 18432);
    f32x16 acc[2][2];
#pragma unroll
    for (int a = 0; a < 2; ++a)
#pragma unroll
        for (int b = 0; b < 2; ++b)
#pragma unroll
            for (int i = 0; i < 16; ++i) acc[a][b][i] = 0.f;
    const int am = tid >> 2, aseg = tid & 3, bn = tid >> 1, bseg = tid & 1;
    int ch = c0 + am; ch = ch < 1023 ? ch : 1023;
    const T* asrc = (const T*)chunkp(ch) + aseg * 16;
    const f16* bsrc = w1t + (size_t)(bn & 127) * 2048 + (size_t)(bn >> 7) * 1024 + bseg * 32;
    Raw16<SRC_F32> ra[3]; f16x8 rb[3][4];
#pragma unroll
    for (int i = 0; i < 3; ++i) { ra[i].ld(asrc + i * 256);
#pragma unroll
        for (int j = 0; j < 4; ++j) rb[i][j] = ld_h8(bsrc + i * 64 + 8 * j); }
    __syncthreads();
    *(LAS f16x8*)(As + am * 72 + aseg * 16) = ra[0].get(0); *(LAS f16x8*)(As + am * 72 + aseg * 16 + 8) = ra[0].get(1);
#pragma unroll
    for (int i = 0; i < 4; ++i) *(LAS f16x8*)(Bs + bn * 72 + bseg * 32 + 8 * i) = rb[0][i];
    ra[0].ld(asrc + 3 * 256);
#pragma unroll
    for (int i = 0; i < 4; ++i) rb[0][i] = ld_h8(bsrc + 3 * 64 + 8 * i);
    lds_barrier();
#pragma unroll
    for (int kb = 0; kb < 16; ++kb) {
        const int cur = kb & 1;
        const LAS f16* Ac = As + cur * 9216 + (64 * wm + r) * 72 + 8 * h; const LAS f16* Bc = Bs + cur * 18432 + (64 * wq + r) * 72 + 8 * h;
#pragma unroll
        for (int ks = 0; ks < 4; ++ks) {
            const f16x8 a0 = *(const LAS f16x8*)(Ac + 16 * ks), a1 = *(const LAS f16x8*)(Ac + 32 * 72 + 16 * ks), b0 = *(const LAS f16x8*)(Bc + 16 * ks), b1 = *(const LAS f16x8*)(Bc + 32 * 72 + 16 * ks);
            acc[0][0] = __builtin_amdgcn_mfma_f32_32x32x16_f16(a0, b0, acc[0][0], 0, 0, 0); acc[0][1] = __builtin_amdgcn_mfma_f32_32x32x16_f16(a0, b1, acc[0][1], 0, 0, 0);
            acc[1][0] = __builtin_amdgcn_mfma_f32_32x32x16_f16(a1, b0, acc[1][0], 0, 0, 0); acc[1][1] = __builtin_amdgcn_mfma_f32_32x32x16_f16(a1, b1, acc[1][1], 0, 0, 0);
        }
        if (kb + 1 < 16) { const int nx = cur ^ 1, sl = (kb + 1) % 3;
            *(LAS f16x8*)(As + nx * 9216 + am * 72 + aseg * 16) = ra[sl].get(0); *(LAS f16x8*)(As + nx * 9216 + am * 72 + aseg * 16 + 8) = ra[sl].get(1);
#pragma unroll
            for (int i = 0; i < 4; ++i) *(LAS f16x8*)(Bs + nx * 18432 + bn * 72 + bseg * 32 + 8 * i) = rb[sl][i];
            if (kb + 4 < 16) { ra[sl].ld(asrc + (kb + 4) * 256);
#pragma unroll
                for (int i = 0; i < 4; ++i) rb[sl][i] = ld_h8(bsrc + (kb + 4) * 64 + 8 * i); } }
        lds_barrier();
    }
    LAS float* SL = (LAS float*)lds;
    LAS f16* HS = (LAS f16*)(lds + 65536);
    if (wq >= 2) {
#pragma unroll
        for (int a = 0; a < 2; ++a)
#pragma unroll
            for (int b = 0; b < 2; ++b)
#pragma unroll
                for (int i = 0; i < 16; ++i) SL[(64 * wm + 32 * a + (i & 3) + 8 * (i >> 2) + 4 * h) * 128 + 64 * (wq - 2) + 32 * b + r] = acc[a][b][i];
    }
    __syncthreads();
    if (wq < 2) {
#pragma unroll
        for (int a = 0; a < 2; ++a)
#pragma unroll
            for (int b = 0; b < 2; ++b) { const int f = 64 * wq + 32 * b + r; float pb = 0.f;
#pragma unroll
                for (int p8 = 0; p8 < 8; ++p8) pb += peb[p8 * 128 + f];
#pragma unroll
                for (int i = 0; i < 16; ++i) { const int m = 64 * wm + 32 * a + (i & 3) + 8 * (i >> 2) + 4 * h; const float sv = m < 127 ? SL[(m + 1) * 128 + f] : 0.f;
                    HS[m * 136 + f] = (f16)siluf_(acc[a][b][i] + sv + pb); } }
    }
    __syncthreads();
    {
        const int fr = lane & 15, q = lane >> 4;
        f32x4 o[4];
#pragma unroll
        for (int et = 0; et < 4; ++et) o[et] = (f32x4){0.f, 0.f, 0.f, 0.f};
#pragma unroll
        for (int ks = 0; ks < 4; ++ks) { const f16x8 av = *(const LAS f16x8*)(HS + (16 * wave + fr) * 136 + 32 * ks + 8 * q);
#pragma unroll
            for (int et = 0; et < 4; ++et) o[et] = __builtin_amdgcn_mfma_f32_16x16x32_f16(av, ld_h8(w2t + (size_t)(16 * et + fr) * 128 + 32 * ks + 8 * q), o[et], 0, 0, 0); }
        float bb[4], gg[4];
#pragma unroll
        for (int et = 0; et < 4; ++et) { bb[et] = b2[16 * et + fr]; gg[et] = kg ? kg[16 * et + fr] : 1.f; }
#pragma unroll
        for (int j = 0; j < 4; ++j) {
            const int row = 16 * wave + 4 * q + j, blk = c0 + row; float v[4], ss = 0.f;
#pragma unroll
            for (int et = 0; et < 4; ++et) { v[et] = o[et][j] + bb[et]; ss += v[et] * v[et]; }
            if (kg) { ss += __shfl_xor(ss, 1); ss += __shfl_xor(ss, 2); ss += __shfl_xor(ss, 4); ss += __shfl_xor(ss, 8); const float rn = rsqrtf(ss * (1.f / 64.f) + EPS);
#pragma unroll
                for (int et = 0; et < 4; ++et) v[et] = v[et] * rn * gg[et]; }
            const bool okrow = row < 127 && blk < 1023, wr16 = row < 127 && blk < 1024;
#pragma unroll
            for (int et = 0; et < 4; ++et) { const float x = okrow ? v[et] : 0.f; const int e = 16 * et + fr;
                if (out && okrow) out[(size_t)blk * 64 + e] = x;
                if (out16 && wr16) out16[(size_t)blk * 64 + e] = (f16)x;
                if (outT16 && wr16) outT16[(size_t)e * 1024 + blk] = (f16)x; }
        }
    }
    __syncthreads();
}

struct PromptKV {
    const f16 *ks, *vs, *kw, *vw;
    DI void krow_sel(int pos, float (&k)[64]) const { const f16* p = ks + (size_t)pos * 64;
#pragma unroll
        for (int i = 0; i < 8; ++i) { const f16x8 v = ld_h8(p + i * 8);
#pragma unroll
            for (int j = 0; j < 8; ++j) k[i * 8 + j] = (float)v[j]; } }
    DI float v_sel(int pos, int d) const { return (float)vs[(size_t)pos * 64 + d]; }
    DI void krow_win(int pos, float (&k)[64]) const { const f16* p = kw + (size_t)pos * 64;
#pragma unroll
        for (int i = 0; i < 8; ++i) { const f16x8 v = ld_h8(p + i * 8);
#pragma unroll
            for (int j = 0; j < 8; ++j) k[i * 8 + j] = (float)v[j]; } }
    DI float v_win(int pos, int d) const { return (float)vw[(size_t)pos * 64 + d]; }
};
struct SampleKV {
    const float* ckv; const int* pt; const float* cwin; const float* nks; const float* nvs; const float* nkw; const float* nvw;
    DI const float* prow(int pos, int slot) const { return ckv + ((size_t)pt[pos >> 7] * 128 + (pos & 127)) * 256 + slot * 64; }
    DI void ld64(const float* p, float (&k)[64]) const {
#pragma unroll
        for (int i = 0; i < 16; ++i) { const f32x4 v = *(const f32x4*)(p + i * 4); k[i * 4] = v[0]; k[i * 4 + 1] = v[1]; k[i * 4 + 2] = v[2]; k[i * 4 + 3] = v[3]; } }
    DI void krow_sel(int pos, float (&k)[64]) const { ld64(pos < PAST ? prow(pos, 2) : nks, k); }
    DI float v_sel(int pos, int d) const { return pos < PAST ? prow(pos, 3)[d] : nvs[d]; }
    DI void krow_win(int pos, float (&k)[64]) const { ld64(pos < PAST ? cwin + (size_t)(pos - (PAST - 512)) * 128 : nkw, k); }
    DI float v_win(int pos, int d) const { return pos < PAST ? cwin[(size_t)(pos - (PAST - 512)) * 128 + 64 + d] : nvw[d]; }
};
template <class KV>
DI void nsa_token(LAS float* wl, int qpos, const float* KC, const float* VC, const KV& kv, const float* gates  , float (&o)[4]) {
    const int lane = ltid() & 63;
    LAS float* sc = wl; LAS float* qs = wl + 4096; LAS int* sel = (LAS int*)(wl + 4096 + 256);
    const int cur = qpos >> 6;
    const int ncv = qpos >= 31 ? ((qpos - 31) >> 4) + 1 : 0;
    float oc[4] = {0.f, 0.f, 0.f, 0.f}, os[4] = {0.f, 0.f, 0.f, 0.f}, ow[4] = {0.f, 0.f, 0.f, 0.f};
    {
        float mx[4] = {-3e38f, -3e38f, -3e38f, -3e38f};
        for (int c = lane; c < ncv; c += 64) {
            asm volatile("" ::: "memory");
            float s[4] = {0.f, 0.f, 0.f, 0.f}; const float* kp = KC + (size_t)c * 64;
#pragma unroll
            for (int d4 = 0; d4 < 16; ++d4) { const f32x4 kvv = *(const f32x4*)(kp + d4 * 4);
#pragma unroll
                for (int j = 0; j < 4; ++j) { const f32x4 q = *(const LAS f32x4*)(qs + (d4 * 4 + j) * 4); s[0] += q[0] * kvv[j]; s[1] += q[1] * kvv[j]; s[2] += q[2] * kvv[j]; s[3] += q[3] * kvv[j]; } }
#pragma unroll
            for (int hh = 0; hh < 4; ++hh) { s[hh] *= 0.125f; sc[hh * 1024 + c] = s[hh]; mx[hh] = fmaxf(mx[hh], s[hh]); }
        }
        float inv[4];
#pragma unroll
        for (int hh = 0; hh < 4; ++hh) { mx[hh] = wmaxf(mx[hh]); float sm = 0.f; for (int c = lane; c < ncv; c += 64) { const float e = __expf(sc[hh * 1024 + c] - mx[hh]); sc[hh * 1024 + c] = e; sm += e; } sm = wsum(sm); inv[hh] = ncv > 0 ? 1.f / sm : 0.f; }
        for (int c = lane; c < ncv; c += 64) {
#pragma unroll
            for (int hh = 0; hh < 4; ++hh) sc[hh * 1024 + c] *= inv[hh]; }
        __builtin_amdgcn_wave_barrier();
        for (int c = 0; c < ncv; ++c) { const float v = VC[(size_t)c * 64 + lane];
#pragma unroll
            for (int hh = 0; hh < 4; ++hh) oc[hh] += sc[hh * 1024 + c] * v; }
    }
    const int nsel = (cur + 1) < 16 ? (cur + 1) : 16;
    {
        float scv[5];
#pragma unroll
        for (int i = 0; i < 5; ++i) {
            const int j = lane + 64 * i; float v = -3e38f;
            if (j <= cur) {
                if (j == 0 || j == cur || j == cur - 1) v = 3e38f;
                else { float a = 0.f;
#pragma unroll
                    for (int o5 = -1; o5 < 4; ++o5) { const int c = 4 * j + o5; if (c >= 0 && c < ncv) { const float p = (sc[c] + sc[1024 + c]) + (sc[2048 + c] + sc[3072 + c]); a += (o5 == -1 || o5 == 3) ? 0.5f * p : p; } }
                    v = a; }
            }
            scv[i] = v;
        }
        for (int k = 0; k < nsel; ++k) {
            float bv = scv[0]; int bi = lane;
#pragma unroll
            for (int i = 1; i < 5; ++i) if (scv[i] > bv) { bv = scv[i]; bi = lane + 64 * i; }
#pragma unroll
            for (int off = 32; off > 0; off >>= 1) { const float ov = __shfl_xor(bv, off); const int oi = __shfl_xor(bi, off); if (ov > bv || (ov == bv && oi < bi)) { bv = ov; bi = oi; } }
            if (lane == 0) sel[k] = bi;
#pragma unroll
            for (int i = 0; i < 5; ++i) if (lane + 64 * i == bi) scv[i] = -3e38f;
        }
        __builtin_amdgcn_wave_barrier();
    }
    {
        float mx[4] = {-3e38f, -3e38f, -3e38f, -3e38f};
        for (int k = 0; k < nsel; ++k) {
            asm volatile("" ::: "memory");
            const int pos = sel[k] * 64 + lane; float s[4] = {-1e30f, -1e30f, -1e30f, -1e30f};
            if (pos <= qpos) { float kr[64]; kv.krow_sel(pos, kr); s[0] = s[1] = s[2] = s[3] = 0.f;
#pragma unroll
                for (int d = 0; d < 64; ++d) { const f32x4 q = *(const LAS f32x4*)(qs + d * 4); s[0] += q[0] * kr[d]; s[1] += q[1] * kr[d]; s[2] += q[2] * kr[d]; s[3] += q[3] * kr[d]; }
#pragma unroll
                for (int hh = 0; hh < 4; ++hh) s[hh] *= 0.125f; }
#pragma unroll
            for (int hh = 0; hh < 4; ++hh) { sc[hh * 1024 + k * 64 + lane] = s[hh]; mx[hh] = fmaxf(mx[hh], s[hh]); }
        }
        float inv[4];
#pragma unroll
        for (int hh = 0; hh < 4; ++hh) { mx[hh] = wmaxf(mx[hh]); float sm = 0.f; for (int k = 0; k < nsel; ++k) { const float sv = sc[hh * 1024 + k * 64 + lane]; const float e = sv > -1e29f ? __expf(sv - mx[hh]) : 0.f; sc[hh * 1024 + k * 64 + lane] = e; sm += e; } sm = wsum(sm); inv[hh] = 1.f / sm; }
        __builtin_amdgcn_wave_barrier();
        for (int k = 0; k < nsel; ++k) { const int p0 = sel[k] * 64; int nk = qpos - p0 + 1; nk = nk > 64 ? 64 : nk;
            for (int kk = 0; kk < nk; ++kk) { const float v = kv.v_sel(p0 + kk, lane);
#pragma unroll
                for (int hh = 0; hh < 4; ++hh) os[hh] += sc[hh * 1024 + k * 64 + kk] * v; } }
#pragma unroll
        for (int hh = 0; hh < 4; ++hh) os[hh] *= inv[hh];
        __builtin_amdgcn_wave_barrier();
    }
    {
        const int lo = qpos - 512 > 0 ? qpos - 512 : 0, nw = qpos - lo + 1;
        float mx[4] = {-3e38f, -3e38f, -3e38f, -3e38f};
        for (int i = lane; i < nw; i += 64) { asm volatile("" ::: "memory"); float kr[64]; kv.krow_win(lo + i, kr); float s[4] = {0.f, 0.f, 0.f, 0.f};
#pragma unroll
            for (int d = 0; d < 64; ++d) { const f32x4 q = *(const LAS f32x4*)(qs + d * 4); s[0] += q[0] * kr[d]; s[1] += q[1] * kr[d]; s[2] += q[2] * kr[d]; s[3] += q[3] * kr[d]; }
#pragma unroll
            for (int hh = 0; hh < 4; ++hh) { s[hh] *= 0.125f; sc[hh * 1024 + i] = s[hh]; mx[hh] = fmaxf(mx[hh], s[hh]); } }
        float inv[4];
#pragma unroll
        for (int hh = 0; hh < 4; ++hh) { mx[hh] = wmaxf(mx[hh]); float sm = 0.f; for (int i = lane; i < nw; i += 64) { const float e = __expf(sc[hh * 1024 + i] - mx[hh]); sc[hh * 1024 + i] = e; sm += e; } sm = wsum(sm); inv[hh] = 1.f / sm; }
        __builtin_amdgcn_wave_barrier();
        for (int i = 0; i < nw; ++i) { const float v = kv.v_win(lo + i, lane);
#pragma unroll
            for (int hh = 0; hh < 4; ++hh) ow[hh] += sc[hh * 1024 + i] * v; }
#pragma unroll
        for (int hh = 0; hh < 4; ++hh) ow[hh] *= inv[hh];
        __builtin_amdgcn_wave_barrier();
    }
#pragma unroll
    for (int hh = 0; hh < 4; ++hh) o[hh] = gates[hh * 3] * oc[hh] + gates[hh * 3 + 1] * os[hh] + gates[hh * 3 + 2] * ow[hh];
}

template <class LF, class SF>
DI void tr64(LAS unsigned char* lds, LF lf, SF sf) {
    LAS float* T = (LAS float*)lds;
    const int tid = ltid();
    __syncthreads();
#pragma unroll
    for (int e8 = 0; e8 < 8; ++e8) { const int e = tid + 512 * e8, kk = e >> 6, nn = e & 63; T[kk * 65 + nn] = lf(kk, nn); }
    __syncthreads();
#pragma unroll
    for (int e8 = 0; e8 < 8; ++e8) { const int e = tid + 512 * e8, nn = e >> 6, kk = e & 63; sf(nn, kk, (f16)T[kk * 65 + nn]); }
}

typedef const Args __attribute__((address_space(4)))* ArgP;
struct Ctx { ArgP ap; LAS unsigned char* lds; unsigned char* ws; float* out; int tid, lane, wave, bid, G; };
DI Ctx mkctx(LAS unsigned char* lds) {
    Ctx c; const char __attribute__((address_space(4)))* kp = (const char __attribute__((address_space(4)))*)__builtin_amdgcn_kernarg_segment_ptr();
    asm volatile("" : "+s"(kp));
    c.ap = (ArgP)kp; c.lds = lds; c.ws = c.ap->ws; c.out = c.ap->out;
    int tid = threadIdx.x; asm volatile("" : "+v"(tid));
    c.tid = tid; c.lane = tid & 63; c.wave = __builtin_amdgcn_readfirstlane(tid >> 6); c.bid = blockIdx.x; c.G = gridDim.x;
    return c;
}
#define INP(i) ((const float*)c.ap->in[i])
#define WSF(off) ((float*)(c.ws + (off)))
#define WSH(off) ((f16*)(c.ws + (off)))

DI void ph_prologue(LAS unsigned char* lds_) {
    const Ctx c = mkctx(lds_); LAS unsigned char* lds = c.lds; const int tid = c.tid, bid = c.bid, G = c.G;
    const float* c_p = INP(I_CP); const float* c_s = INP(I_CS); const float* w_ada = INP(I_WADA); const float* b_ada = INP(I_BADA);
    const float* w_in = INP(I_WIN); const float* w_out = INP(I_WOUT); const float* w1 = INP(I_W1);
    float* ADA = WSF(WS_ADA); float* BIAS = WSF(WS_BIAS); float* PEB = WSF(WS_PEB); f16* WTIN = WSH(WS_WTIN); f16* WTOUT = WSH(WS_WTOUT); f16* W1T = WSH(WS_W1T);
    constexpr int N_ADA = 96, N_WTIN = 1920, N_WTOUT = 512, N_W1T = 256, N_PEB = 32, N_W2T = 8, N_ALL = N_ADA + N_WTIN + N_WTOUT + N_W1T + N_PEB + N_W2T + 1;
    constexpr int XA = 1;
    const bool reb = G == 256; const int n_mine = reb ? (bid < N_ADA ? 1 + XA : (N_ALL - N_ADA - XA * N_ADA - (bid - N_ADA) + 159) / 160) : (N_ALL - bid + G - 1) / G;
    for (int k = 0; k < n_mine; ++k) {
        const int it = !reb ? bid + k * G : (bid < N_ADA ? (k == 0 ? bid : N_ADA + XA * bid + (k - 1)) : N_ADA + XA * N_ADA + (bid - N_ADA) + 160 * k);
        int i = it;
        if (i < N_ADA) { const int l = i / 48, n0 = (i % 48) * 64;
            skinny_item<36>(lds, w_ada + (size_t)l * 1024 * 3072, 3072, n0, 64, 33,
                [&](int m, int k) { return siluf_(m < 32 ? c_s[m * 1024 + k] : c_p[k]); },
                [&](int m, int n, float v) { ADA[((size_t)l * 33 + m) * 3072 + n] = v + b_ada[l * 3072 + n]; });
            continue; }
        i -= N_ADA;
        if (i < N_WTIN) { const int l = i / 960, r = i % 960, n0 = (r / 16) * 64, k0 = (r % 16) * 64; const float* src = w_in + (size_t)l * 1024 * DIN; f16* dst = WTIN + (size_t)l * NPD * 1024;
            tr64(lds, [&](int kk, int nn) { const int sc = src_col(n0 + nn); return sc >= 0 ? src[(size_t)(k0 + kk) * DIN + sc] : 0.f; },
                      [&](int nn, int kk, f16 v) { dst[(size_t)(n0 + nn) * 1024 + k0 + kk] = v; });
            continue; }
        i -= N_WTIN;
        if (i < N_WTOUT) { const int l = i / 256, r = i % 256, n0 = (r / 16) * 64, k0 = (r % 16) * 64; const float* src = w_out + (size_t)l * 1024 * 1024; f16* dst = WTOUT + (size_t)l * 1024 * 1024;
            tr64(lds, [&](int kk, int nn) { return src[(size_t)(k0 + kk) * 1024 + n0 + nn]; },
                      [&](int nn, int kk, f16 v) { dst[(size_t)(n0 + nn) * 1024 + k0 + kk] = v; });
            continue; }
        i -= N_WTOUT;
        if (i < N_W1T) { const int ls = i / 64, r = i % 64, k0 = (r / 2) * 64, n0 = (r % 2) * 64; const float* src = w1 + (size_t)ls * 2048 * 128; f16* dst = W1T + (size_t)ls * 128 * 2048;
            tr64(lds, [&](int kk, int nn) { return src[(size_t)(k0 + kk) * 128 + n0 + nn]; },
                      [&](int nn, int kk, f16 v) { dst[(size_t)(n0 + nn) * 2048 + k0 + kk] = v; });
            continue; }
        i -= N_W1T;
        if (i < N_PEB) { const int ls = i >> 3, ks8 = i & 7; const float* pe = INP(I_PE) + (size_t)ls * 2048 + ks8 * 256; const float* w = w1 + ((size_t)ls * 2048 + ks8 * 256) * 128; const float* b1 = INP(I_B1) + ls * 128;
            LAS float* R = (LAS float*)lds; const int f = tid & 127, kq = tid >> 7; float sacc = 0.f;
            __syncthreads();
#pragma unroll 16
            for (int k = kq * 64; k < kq * 64 + 64; ++k) sacc += pe[k] * w[(size_t)k * 128 + f];
            R[kq * 128 + f] = sacc; __syncthreads();
            if (tid < 128) WSF(WS_PEBP)[(ls * 8 + ks8) * 128 + tid] = (ks8 == 0 ? b1[tid] : 0.f) + (R[tid] + R[128 + tid]) + (R[256 + tid] + R[384 + tid]);
            __syncthreads();
            continue; }
        i -= N_PEB;
        if (i < N_W2T) { const int ls = i >> 1, f0 = (i & 1) * 64; const float* src = INP(I_W2) + (size_t)ls * 128 * 64; f16* dst = WSH(WS_W2T) + (size_t)ls * 64 * 128;
            tr64(lds, [&](int kk, int nn) { return src[(size_t)(f0 + kk) * 64 + nn]; },
                      [&](int nn, int kk, f16 v) { dst[(size_t)nn * 128 + f0 + kk] = v; });
            continue; }
        for (int e = tid; e < 2 * NPD; e += 512) BIAS[e] = 0.f;
    }
}

DI void ph_sample_compress(LAS unsigned char* lds_) {
    const Ctx c = mkctx(lds_);
    const float* w2 = INP(I_W2); const float* b2 = INP(I_B2); const float* k_g = INP(I_KG); const float* cache_kv = INP(I_CKV); const int* page_table = (const int*)c.ap->in[I_PT];
    f16* W1T = WSH(WS_W1T); float* PEB = WSF(WS_PEBP); float* KCS = WSF(WS_KCS); float* VCS = WSF(WS_VCS);
    for (int it = c.bid; it < 1152; it += c.G) {
        const int grp = it % 9, st_ = it / 9, slot = st_ & 1, b = (st_ >> 1) & 31, l = st_ >> 6;
        const float* ckv = cache_kv + (size_t)l * NPOOL * 128 * 256; const int* pt = page_table + b * 128;
        compress_item<true>(c.lds, [&](int ch) { return (const void*)(ckv + ((size_t)pt[ch >> 3] * 128 + (ch & 7) * 16) * 256 + slot * 64); }, grp * 127,
                            W1T + (size_t)(l * 2 + slot) * 128 * 2048, PEB + (l * 2 + slot) * 1024, WSH(WS_W2T) + (size_t)(l * 2 + slot) * 64 * 128, b2 + (l * 2 + slot) * 64,
                            slot == 0 ? k_g + l * 192 : nullptr, (slot == 0 ? KCS : VCS) + (size_t)(l * NB + b) * 1024 * 64, nullptr, nullptr);
    }
}
DI void ph_prep(LAS unsigned char* lds_) {
    const Ctx c = mkctx(lds_); const int tid = c.tid, lane = c.lane, wave = c.wave, bid = c.bid, G = c.G;
    float* ADA = WSF(WS_ADA); float* BIAS = WSF(WS_BIAS);
    {
        const f16* WTIN = WSH(WS_WTIN);
        const bool lite = G == 256;
        const int pb = lite ? bid - 128 : bid, pG = lite ? 128 : G;
        if (pb >= 0)
        for (int col = pb * 8 + wave; col < 2 * NPD; col += pG * 8) { const int l = col / NPD; const float* sh = ADA + ((size_t)l * 33 + 32) * 3072 + lane * 16; const f16* wp = WTIN + (size_t)col * 1024 + lane * 16;
            const f16x8 w0 = ld_h8(wp), w1 = ld_h8(wp + 8); float acc = 0.f;
#pragma unroll
            for (int i = 0; i < 8; ++i) acc += sh[i] * (float)w0[i] + sh[8 + i] * (float)w1[i];
            acc = wsum(acc); if (lane == 0) BIAS[col] = acc; }
    }
    const float* ng = INP(I_NG);
    if (bid == 0) { float* GNX = WSF(WS_GNX); const float* sc1 = ADA + (size_t)(33 + 32) * 3072 + 1024;
        for (int k = tid; k < 1024; k += 512) GNX[k] = ng[1024 + k] * (1.f + sc1[k]); }
    const float* ada_p = ADA + (size_t)32 * 3072; const float* x_p = INP(I_XP); f16* A16 = WSH(WS_A16); float* RSSP = WSF(WS_RSSP);
    float gp[16];
#pragma unroll
    for (int i = 0; i < 4; ++i) { const f32x4 g4 = *(const f32x4*)(ng + i * 256 + lane * 4), s4 = *(const f32x4*)(ada_p + 1024 + i * 256 + lane * 4);
#pragma unroll
        for (int j = 0; j < 4; ++j) gp[i * 4 + j] = g4[j] * (1.f + s4[j]); }
    const bool lite2 = G == 256; const int pb2 = lite2 ? bid - 128 : bid, pG2 = lite2 ? 128 : G;
    if (pb2 >= 0)
    for (int row = pb2 * 8 + wave; row < SEQ; row += pG2 * 8) {
        const float* xr = x_p + (size_t)row * 1024; float ss = 0.f;
#pragma unroll
        for (int i = 0; i < 4; ++i) { const f32x4 v = *(const f32x4*)(xr + i * 256 + lane * 4); ss += (v[0] * v[0] + v[1] * v[1]) + (v[2] * v[2] + v[3] * v[3]);
            f16x4 h; h[0] = (f16)(v[0] * gp[i * 4]); h[1] = (f16)(v[1] * gp[i * 4 + 1]); h[2] = (f16)(v[2] * gp[i * 4 + 2]); h[3] = (f16)(v[3] * gp[i * 4 + 3]);
            *(f16x4*)(A16 + (size_t)row * 1024 + i * 256 + lane * 4) = h; }
        ss = wsum(ss);
        if (lane < 16) RSSP[(size_t)row * 16 + lane] = lane == 0 ? ss : 0.f;
    }
}

template <int NT  , class OFn>
DI void sample_gemm_item(LAS unsigned char* lds, const f16* Bt, int n0, OFn ofn) {
    constexpr int KW = 8 / NT, KL = 1024 / KW;
    const int tid = ltid(), wave = tid >> 6, lane = tid & 63, wn = wave % NT, wk = wave / NT, r = lane & 31, h = lane >> 5;
    const LAS f16* Ah = (const LAS f16*)lds + r * 1032 + wk * KL + 8 * h; const f16* bp = Bt + (size_t)(n0 + 32 * wn + r) * 1024 + wk * KL + 8 * h;
    f32x16 acc;
#pragma unroll
    for (int i = 0; i < 16; ++i) acc[i] = 0.f;
#pragma unroll 8
    for (int st = 0; st < KL / 16; ++st) acc = __builtin_amdgcn_mfma_f32_32x32x16_f16(*(const LAS f16x8*)(Ah + 16 * st), ld_h8(bp + 16 * st), acc, 0, 0, 0);
    LAS float* RED = (LAS float*)(lds + 67584);
#pragma unroll
    for (int i = 0; i < 16; ++i) RED[(wk * 32 + (i & 3) + 8 * (i >> 2) + 4 * h) * (32 * NT) + 32 * wn + r] = acc[i];
    __syncthreads();
    for (int e = tid; e < 1024 * NT; e += 512) { float v = 0.f;
#pragma unroll
        for (int w = 0; w < KW; ++w) v += RED[w * 1024 * NT + e];
        ofn(e / (32 * NT), n0 + e % (32 * NT), v); }
    __syncthreads();
}
DI void ph_inproj(LAS unsigned char* lds_, int l) {
    const Ctx c = mkctx(lds_);
    pg8::Gemm g{WSH(WS_A16), WSH(WS_WTIN) + (size_t)l * NPD * 1024, SEQ, NPD, 1024}; pg8::StaticOrder S; S.init(SEQ, NPD, c.G, c.bid);
    EpiIn E{WSH(WS_PROJ), WSF(WS_RSSP), WSF(WS_BIAS) + l * NPD, c.out + O_KVP + (size_t)l * SEQ * 256};
    pg8::gemm_phase<EpiIn, pg8::StaticOrder>(c.lds, g, S, E);
    __syncthreads();
}
DI void ph_hsample(LAS unsigned char* lds_, int l) {
    const Ctx c = mkctx(lds_); const int lane = c.lane;
    if (c.bid >= 4) return;
    const int m = c.bid * 8 + c.wave;
    const float* xr = (l == 0 ? INP(I_XS) : WSF(WS_XS1)) + (size_t)m * 1024; const float* ad = WSF(WS_ADA) + ((size_t)l * 33 + m) * 3072; const float* ng = INP(I_NG) + l * 1024; f16* hs = WSH(WS_HS16) + (size_t)m * 1024;
    f32x4 xv[4]; float ss = 0.f;
#pragma unroll
    for (int i = 0; i < 4; ++i) { xv[i] = *(const f32x4*)(xr + i * 256 + lane * 4); ss += (xv[i][0] * xv[i][0] + xv[i][1] * xv[i][1]) + (xv[i][2] * xv[i][2] + xv[i][3] * xv[i][3]); }
    const float rn = rsqrtf(wsum(ss) * (1.f / 1024.f) + EPS);
#pragma unroll
    for (int i = 0; i < 4; ++i) { const int k = i * 256 + lane * 4; const f32x4 g = *(const f32x4*)(ng + k), sc = *(const f32x4*)(ad + 1024 + k), sh = *(const f32x4*)(ad + k); f16x4 hv;
#pragma unroll
        for (int j = 0; j < 4; ++j) hv[j] = (f16)(xv[i][j] * rn * g[j] * (1.f + sc[j]) + sh[j]);
        *(f16x4*)(hs + k) = hv; }
}
DI void ph_inproj_sample(LAS unsigned char* lds_, int l) {
    const Ctx c = mkctx(lds_); const int tid = c.tid;
    const int it = c.bid - (c.G - 64);
    if (it < 0 || it >= 60) return;
    float* PROJS = WSF(WS_PROJS); const f16* HS = WSH(WS_HS16); LAS f16* Ah = (LAS f16*)c.lds;
    __syncthreads();
#pragma unroll
    for (int i = 0; i < 8; ++i) { const int e = (tid + 512 * i) * 8; *(LAS f16x8*)(Ah + (e >> 10) * 1032 + (e & 1023)) = ld_h8(HS + e); }
    __syncthreads();
    sample_gemm_item<2>(c.lds, WSH(WS_WTIN) + (size_t)l * NPD * 1024, it * 64, [&](int m, int n, float v) { PROJS[m * NPD + n] = v; });
}

#define PT(t) (P + (size_t)(t) * SEQ * 256)
DI void ph_ssd_local(LAS unsigned char* lds_, int l) {
    const Ctx c = mkctx(lds_); LAS unsigned char* lds = c.lds; const int tid = c.tid, lane = c.lane, wave = c.wave;
    const f16* P = WSH(WS_PROJ); f16* ACT = WSH(WS_ACT); float* YD = WSF(WS_YD); float* CST = WSF(WS_CST); float* ACS = WSF(WS_ACS); float* CDEC = WSF(WS_CDEC); float* out = c.out;
    const float* dtb = INP(I_DTB) + l * 4; const float* alog = INP(I_ALOG) + l * 4; const float* cw = INP(I_BCW) + l * 4 * 768; const float* cb = INP(I_BCB) + l * 768;
    LAS f16* Bm = (LAS f16*)lds; LAS f16* BT = (LAS f16*)(lds + 34816); LAS f16* Cm = (LAS f16*)(lds + 69632); LAS f16* XT = (LAS f16*)(lds + 104448);
    LAS float* acs = (LAS float*)(lds + 139264); LAS float* dtl = acs + 256; LAS f16* te16 = (LAS f16*)(dtl + 256);
    for (int it = c.bid; it < 256; it += c.G) {
        const int ch_ = it >> 1, g = it & 1, t0 = ch_ * 128;
        __syncthreads();
        if (tid < 256) { const int hh = tid >> 7, lt = tid & 127, hd = 2 * g + hh; const float raw = (float)PT(13)[(size_t)(t0 + lt) * 256 + 128 + hd];
            const float dt = softplusf_(raw + dtb[hd]); dtl[hh * 128 + lt] = dt; acs[hh * 128 + lt] = dt * (-__expf(alog[hd])); }
        __syncthreads();
        if (tid == 0 || tid == 64) { const int hh = tid >> 6; float sacc = 0.f; for (int i = 0; i < 128; ++i) { sacc += acs[hh * 128 + i]; acs[hh * 128 + i] = sacc; } }
        __syncthreads();
        if (tid < 256) { const int hh = tid >> 7, lt = tid & 127, hd = 2 * g + hh; const float av = acs[hh * 128 + lt], ae = acs[hh * 128 + 127];
            te16[hh * 128 + lt] = (f16)__expf(ae - av); ACS[(size_t)(t0 + lt) * 4 + hd] = av; if (lt == 127) CDEC[ch_ * 4 + hd] = __expf(ae); }
#pragma unroll 3
        for (int e = tid; e < 128 * 48; e += 512) {
            const int lt = (e >> 2) & 127, cg = (e >> 9) * 4 + (e & 3), reg = cg >> 4, c8 = (cg & 15) * 8, t = t0 + lt, col = 128 * g + c8, ch = reg * 256 + col;
            const f16* src = PT(5 + reg) + col; float y[8]; f16x8 rawt;
#pragma unroll
            for (int i = 0; i < 8; ++i) y[i] = cb[ch + i];
#pragma unroll
            for (int k = 0; k < 4; ++k) { const int tt = t - 3 + k; f16x8 v; if (tt >= 0) v = ld_h8(src + (size_t)tt * 256); else {
#pragma unroll
                    for (int i = 0; i < 8; ++i) v[i] = (f16)0.f; }
                if (k == 3) rawt = v;
#pragma unroll
                for (int i = 0; i < 8; ++i) y[i] += cw[k * 768 + ch + i] * (float)v[i]; }
            f16x8 act;
#pragma unroll
            for (int i = 0; i < 8; ++i) { y[i] = siluf_(y[i]); act[i] = (f16)y[i]; }
            *(f16x8*)(ACT + (size_t)t * 768 + ch) = act;
            if (reg == 0) { const int hh = c8 >> 6; const float sdt = dtl[hh * 128 + lt] * 64.f;
#pragma unroll
                for (int i = 0; i < 8; ++i) XT[(c8 + i) * 136 + lt] = (f16)(y[i] * sdt); }
            else if (reg == 1) { *(LAS f16x8*)(Bm + lt * 136 + c8) = act;
#pragma unroll
                for (int i = 0; i < 8; ++i) BT[(c8 + i) * 136 + lt] = act[i]; }
            else *(LAS f16x8*)(Cm + lt * 136 + c8) = act;
            if (t >= SEQ - 3) { float* so = out + O_BCP + (size_t)l * 2304 + (t - (SEQ - 3)) * 768 + ch;
#pragma unroll
                for (int i = 0; i < 8; ++i) so[i] = (float)rawt[i]; }
        }
        __syncthreads();
        const int fr = lane & 15, q = lane >> 4, w = wave;
        f32x4 gt[8];
#pragma unroll
        for (int mt = 0; mt < 8; ++mt) { gt[mt] = (f32x4){0.f, 0.f, 0.f, 0.f};
            if (mt <= w) {
#pragma unroll
                for (int ks = 0; ks < 4; ++ks) { const f16x8 av = *(const LAS f16x8*)(Bm + (16 * mt + fr) * 136 + 32 * ks + 8 * q), bv = *(const LAS f16x8*)(Cm + (16 * w + fr) * 136 + 32 * ks + 8 * q);
                    gt[mt] = __builtin_amdgcn_mfma_f32_16x16x32_f16(av, bv, gt[mt], 0, 0, 0); } } }
#pragma unroll
        for (int hh = 0; hh < 2; ++hh) {
            const int lrow = 16 * w + fr; const float al = acs[hh * 128 + lrow];
            f32x4 ya[4];
#pragma unroll
            for (int pt = 0; pt < 4; ++pt) ya[pt] = (f32x4){0.f, 0.f, 0.f, 0.f};
#pragma unroll
            for (int k2 = 0; k2 < 4; ++k2) {
                if (2 * k2 <= w) {
                    f16x8 af;
#pragma unroll
                    for (int j = 0; j < 8; ++j) { const int m = 32 * k2 + (j < 4 ? 4 * q + j : 16 + 4 * q + (j - 4)); const float gv = j < 4 ? gt[2 * k2][j] : gt[2 * k2 + 1][j - 4];
                        af[j] = (f16)(m <= lrow ? gv * __expf(al - acs[hh * 128 + m]) : 0.f); }
#pragma unroll
                    for (int pt = 0; pt < 4; ++pt) { const LAS f16* xp = XT + (hh * 64 + 16 * pt + fr) * 136 + 32 * k2 + 4 * q; const f16x4 b0 = *(const LAS f16x4*)xp, b1 = *(const LAS f16x4*)(xp + 16);
                        f16x8 bf; bf[0] = b0[0]; bf[1] = b0[1]; bf[2] = b0[2]; bf[3] = b0[3]; bf[4] = b1[0]; bf[5] = b1[1]; bf[6] = b1[2]; bf[7] = b1[3];
                        ya[pt] = __builtin_amdgcn_mfma_f32_16x16x32_f16(af, bf, ya[pt], 0, 0, 0); }
                }
            }
#pragma unroll
            for (int pt = 0; pt < 4; ++pt)
#pragma unroll
                for (int j = 0; j < 4; ++j) YD[(size_t)(t0 + 16 * w + 4 * q + j) * 256 + (2 * g + hh) * 64 + 16 * pt + fr] = ya[pt][j] * (1.f / 64.f);
#pragma unroll
            for (int pt = 0; pt < 4; ++pt) { f32x4 sa = (f32x4){0.f, 0.f, 0.f, 0.f};
#pragma unroll
                for (int ks = 0; ks < 4; ++ks) { const f16x8 xv = *(const LAS f16x8*)(XT + (hh * 64 + 16 * pt + fr) * 136 + 32 * ks + 8 * q), tv = *(const LAS f16x8*)(te16 + hh * 128 + 32 * ks + 8 * q);
                    const f16x8 bv = *(const LAS f16x8*)(BT + (16 * w + fr) * 136 + 32 * ks + 8 * q);
                    sa = __builtin_amdgcn_mfma_f32_16x16x32_f16(xv * tv, bv, sa, 0, 0, 0); }
#pragma unroll
                for (int j = 0; j < 4; ++j) CST[((size_t)(ch_ * 4 + 2 * g + hh) * 64 + 16 * pt + 4 * q + j) * 128 + 16 * w + fr] = sa[j] * (1.f / 64.f); }
        }
    }
    __syncthreads();
}
DI void ph_mix_a(LAS unsigned char* lds_, int l) {
    const Ctx c = mkctx(lds_); const int tid = c.tid;
    const f16* P = WSH(WS_PROJ); f16* Y16 = WSH(WS_Y16); float* out = c.out; const float* scw = INP(I_SCW) + l * 768;
    for (int it = c.bid; it < 256; it += c.G) {
        for (int e = tid; e < 64 * 32; e += 512) { const int t = it * 64 + (e >> 5), c0 = (e & 31) * 8; float u[3][8];
#pragma unroll
            for (int k = 0; k < 3; ++k) { const int tt = t - 2 + k;
                if (tt >= 0) { const f16x8 h = ld_h8(PT(0) + (size_t)tt * 256 + c0), cc = ld_h8(PT(2) + (size_t)tt * 256 + c0);
#pragma unroll
                    for (int i = 0; i < 8; ++i) u[k][i] = (float)cc[i] * (float)h[i]; }
                else {
#pragma unroll
                    for (int i = 0; i < 8; ++i) u[k][i] = 0.f; } }
            const f16x8 bb = ld_h8(PT(1) + (size_t)t * 256 + c0), gg = ld_h8(PT(3) + (size_t)t * 256 + c0); f16x8 o;
#pragma unroll
            for (int i = 0; i < 8; ++i) { const float y = scw[c0 + i] * u[0][i] + scw[256 + c0 + i] * u[1][i] + scw[512 + c0 + i] * u[2][i]; o[i] = (f16)(siluf_((float)gg[i]) * (float)bb[i] * y); }
            *(f16x8*)(Y16 + (size_t)t * 1024 + c0) = o;
            if (t >= SEQ - 2) { float* so = out + O_SCP + (size_t)l * 512 + (t - (SEQ - 2)) * 256 + c0;
#pragma unroll
                for (int i = 0; i < 8; ++i) so[i] = u[2][i]; }
        }
    }
}
DI void ph_mix_c(LAS unsigned char* lds_, int l) {
    const Ctx c = mkctx(lds_); const int tid = c.tid, lane = c.lane, wave = c.wave;
    const f16* P = WSH(WS_PROJ); f16* Y16 = WSH(WS_Y16); float* out = c.out;
    const float* cfw = INP(I_CFW) + l * 31 * 256; const float* cfb = INP(I_CFB) + l * 256; const float* lng = INP(I_LNG) + l * 256; const float* lnb = INP(I_LNB) + l * 256;
    LAS float* GL = (LAS float*)c.lds;
    f32x4 wt[31];
#pragma unroll
    for (int k = 0; k < 31; ++k) wt[k] = *(const f32x4*)(cfw + k * 256 + lane * 4);
    const f32x4 bias4 = *(const f32x4*)(cfb + lane * 4), g4 = *(const f32x4*)(lng + lane * 4), b4 = *(const f32x4*)(lnb + lane * 4);
    for (int it = c.bid; it < 256; it += c.G) {
        __syncthreads();
        for (int e = tid; e < 94 * 32; e += 512) { const int rr = e >> 5, c0 = (e & 31) * 8, t = it * 64 - 30 + rr; f32x4 g0 = (f32x4){0.f, 0.f, 0.f, 0.f}, g1 = g0;
            if (t >= 0) { const f16x8 ga = ld_h8(PT(8) + (size_t)t * 256 + c0), gb = ld_h8(PT(9) + (size_t)t * 256 + c0);
#pragma unroll
                for (int i = 0; i < 4; ++i) { g0[i] = (float)ga[i] * sigmoidf_((float)gb[i]); g1[i] = (float)ga[4 + i] * sigmoidf_((float)gb[4 + i]); }
                if (t >= SEQ - 30) { float* so = out + O_CFP + (size_t)l * 7680 + (t - (SEQ - 30)) * 256 + c0; *(f32x4*)so = g0; *(f32x4*)(so + 4) = g1; } }
            *(LAS f32x4*)(GL + rr * 256 + c0) = g0; *(LAS f32x4*)(GL + rr * 256 + c0 + 4) = g1; }
        __syncthreads();
        {
            const int cc = lane * 4, tb = wave * 8;
            f32x4 u[8];
#pragma unroll
            for (int j = 0; j < 8; ++j) u[j] = bias4;
#pragma unroll
            for (int r = 0; r < 38; ++r) { const f32x4 gv = *(const LAS f32x4*)(GL + (tb + r) * 256 + cc);
#pragma unroll
                for (int j = 0; j < 8; ++j) if (r - j >= 0 && r - j <= 30) u[j] += wt[r - j] * gv; }
#pragma unroll
            for (int j = 0; j < 8; ++j) { const int t = it * 64 + tb + j;
                const float mean = wsum((u[j][0] + u[j][1]) + (u[j][2] + u[j][3])) * (1.f / 256.f); const f32x4 d = u[j] - mean;
                const float var = wsum((d[0] * d[0] + d[1] * d[1]) + (d[2] * d[2] + d[3] * d[3])) * (1.f / 256.f); const float rs = rsqrtf(var + EPS);
                const f16x4 cg = *(const f16x4*)(PT(10) + (size_t)t * 256 + cc); f16x4 o;
#pragma unroll
                for (int i = 0; i < 4; ++i) o[i] = (f16)(siluf_((float)cg[i]) * siluf_(d[i] * rs * g4[i] + b4[i]));
                *(f16x4*)(Y16 + (size_t)t * 1024 + 512 + cc) = o; }
        }
    }
    __syncthreads();
}
DI void ph_mix_d(LAS unsigned char* lds_, int l) {
    const Ctx c = mkctx(lds_); const int tid = c.tid, lane = c.lane, wave = c.wave;
    const f16* P = WSH(WS_PROJ); float* out = c.out; float* kvp_out = out + O_KVP + (size_t)l * SEQ * 256;
    f16* Q16 = WSH(WS_Q16); f16* KS16 = WSH(WS_KS16); f16* KW16 = WSH(WS_KW16); f16* VST16 = WSH(WS_VST16); f16* VWT16 = WSH(WS_VWT16); float* GATES = WSF(WS_GATES);
    const int d4 = (lane & 15) * 4, v4 = lane >> 4;
    const f32x4 qg = *(const f32x4*)(INP(I_QG) + l * 64 + d4), kg1 = *(const f32x4*)(INP(I_KG) + l * 192 + 64 + d4), kg2 = *(const f32x4*)(INP(I_KG) + l * 192 + 128 + d4);
    LAS f16* VSs = (LAS f16*)c.lds; LAS f16* VWs = VSs + 64 * 68;
    if (c.bid < 18 && c.G > 36) return;
    for (int it = c.bid - 18 >= 0 && c.G > 36 ? c.bid - 18 : c.bid; it < 256; it += (c.G > 36 ? c.G - 18 : c.G)) {
        __syncthreads();
        for (int vi = wave * 4 + v4; vi < 256; vi += 32) { const size_t off = (size_t)(it * 64) * 256 + (size_t)vi * 64 + d4; const f16x4 x = *(const f16x4*)(PT(11) + off);
            const float a0 = (float)x[0], a1 = (float)x[1], a2 = (float)x[2], a3 = (float)x[3]; const float rn = rsqrtf(sum16((a0 * a0 + a1 * a1) + (a2 * a2 + a3 * a3)) * (1.f / 64.f) + EPS);
            f16x4 y; y[0] = (f16)(a0 * rn * qg[0]); y[1] = (f16)(a1 * rn * qg[1]); y[2] = (f16)(a2 * rn * qg[2]); y[3] = (f16)(a3 * rn * qg[3]); *(f16x4*)(Q16 + off) = y; }
        for (int tl = wave * 4 + v4; tl < 64; tl += 32) { const int t = it * 64 + tl;
            { const f16x4 x = *(const f16x4*)(PT(12) + (size_t)t * 256 + 128 + d4), vv = *(const f16x4*)(PT(12) + (size_t)t * 256 + 192 + d4);
                const float a0 = (float)x[0], a1 = (float)x[1], a2 = (float)x[2], a3 = (float)x[3]; const float rn = rsqrtf(sum16((a0 * a0 + a1 * a1) + (a2 * a2 + a3 * a3)) * (1.f / 64.f) + EPS);
                const f32x4 kn = (f32x4){a0 * rn * kg1[0], a1 * rn * kg1[1], a2 * rn * kg1[2], a3 * rn * kg1[3]}; *(f32x4*)(kvp_out + (size_t)t * 256 + 128 + d4) = kn;
                f16x4 y; y[0] = (f16)kn[0]; y[1] = (f16)kn[1]; y[2] = (f16)kn[2]; y[3] = (f16)kn[3]; *(f16x4*)(KS16 + (size_t)t * 64 + d4) = y; *(LAS f16x4*)(VSs + tl * 68 + d4) = vv; }
            { const f16x4 x = *(const f16x4*)(PT(13) + (size_t)t * 256 + d4), vv = *(const f16x4*)(PT(13) + (size_t)t * 256 + 64 + d4);
                const float a0 = (float)x[0], a1 = (float)x[1], a2 = (float)x[2], a3 = (float)x[3]; const float rn = rsqrtf(sum16((a0 * a0 + a1 * a1) + (a2 * a2 + a3 * a3)) * (1.f / 64.f) + EPS);
                const f32x4 kn = (f32x4){a0 * rn * kg2[0], a1 * rn * kg2[1], a2 * rn * kg2[2], a3 * rn * kg2[3]};
                f16x4 y; y[0] = (f16)kn[0]; y[1] = (f16)kn[1]; y[2] = (f16)kn[2]; y[3] = (f16)kn[3]; *(f16x4*)(KW16 + (size_t)t * 64 + d4) = y; *(LAS f16x4*)(VWs + tl * 68 + d4) = vv;
                if (t >= SEQ - 512) { float* wo = out + O_WINP + (size_t)l * 512 * 128 + (size_t)(t - (SEQ - 512)) * 128; *(f32x4*)(wo + d4) = kn; *(f32x4*)(wo + 64 + d4) = (f32x4){(float)vv[0], (float)vv[1], (float)vv[2], (float)vv[3]}; } }
        }
        for (int e = tid; e < 64 * 12; e += 512) { const int tl = e / 12, gi = e % 12; GATES[(size_t)(it * 64 + tl) * 12 + gi] = sigmoidf_((float)PT(13)[(size_t)(it * 64 + tl) * 256 + 132 + gi]); }
        __syncthreads();
        { const int d = tid >> 3, k8 = (tid & 7) * 8; f16x8 a, b;
#pragma unroll
            for (int i = 0; i < 8; ++i) { a[i] = VSs[(k8 + i) * 68 + d]; b[i] = VWs[(k8 + i) * 68 + d]; }
            *(f16x8*)(VST16 + (size_t)it * 4096 + d * 64 + k8) = a; *(f16x8*)(VWT16 + (size_t)it * 4096 + d * 64 + k8) = b; }
    }
    __syncthreads();
}
DI void ph_mix_cmp(LAS unsigned char* lds_, int l) {
    const Ctx c = mkctx(lds_);
    const f16* P = WSH(WS_PROJ); const float* w2 = INP(I_W2); const float* b2 = INP(I_B2); const float* k_g = INP(I_KG); f16* W1T = WSH(WS_W1T); float* PEB = WSF(WS_PEBP);
    for (int it = c.bid; it < 18; it += c.G) { const int slot = it / 9, grp = it % 9; const f16* src = PT(12) + slot * 64;
        compress_item<false>(c.lds, [&](int ch) { return (const void*)(src + (size_t)ch * 16 * 256); }, grp * 127,
                             W1T + (size_t)(l * 2 + slot) * 128 * 2048, PEB + (l * 2 + slot) * 1024, WSH(WS_W2T) + (size_t)(l * 2 + slot) * 64 * 128, b2 + (l * 2 + slot) * 64,
                             slot == 0 ? k_g + l * 192 : nullptr, nullptr, slot == 0 ? WSH(WS_KC16) : nullptr, slot == 0 ? nullptr : WSH(WS_VCT16)); }
}
#undef PT
template <int N>
DI void blk_reduce(LAS float* red, LAS float* bc, float (&v)[N], bool is_max, int wave, int lane) {
#pragma unroll
    for (int i = 0; i < N; ++i) v[i] = is_max ? wmaxf(v[i]) : wsum(v[i]);
    __syncthreads();
    if (lane == 0) {
#pragma unroll
        for (int i = 0; i < N; ++i) red[wave * 12 + i] = v[i]; }
    __syncthreads();
    if (wave == 0 && lane < N) { float r = red[lane]; for (int w = 1; w < 8; ++w) r = is_max ? fmaxf(r, red[w * 12 + lane]) : r + red[w * 12 + lane]; bc[lane] = r; }
    __syncthreads();
#pragma unroll
    for (int i = 0; i < N; ++i) v[i] = bc[i];
}
DI void nsa_sample_block(LAS float* wl, const float* KC, const float* VC, const SampleKV& kv, const LAS float* gsm, const float* dgp, float* ysd, int tid, int lane, int wave) {
    LAS float* sc = wl; LAS float* qs = wl + 10496; LAS float* PSL = qs + 256; LAS float* red = PSL + 1024; LAS float* bc = red + 96; LAS int* sel = (LAS int*)(bc + 16); LAS float* part = bc + 32;
    constexpr int NCV = 1023, CUR = PAST >> 6;
    float mv[8], sv[8];
#pragma unroll
    for (int i = 0; i < 8; ++i) mv[i] = -3e38f;
    for (int cidx = tid; cidx < NCV; cidx += 512) {
        asm volatile("" ::: "memory");
        float kr[64]; kv.ld64(KC + (size_t)cidx * 64, kr); float s4[4] = {0.f, 0.f, 0.f, 0.f};
#pragma unroll
        for (int d = 0; d < 64; ++d) { const f32x4 qv = *(const LAS f32x4*)(qs + d * 4); s4[0] += qv[0] * kr[d]; s4[1] += qv[1] * kr[d]; s4[2] += qv[2] * kr[d]; s4[3] += qv[3] * kr[d]; }
#pragma unroll
        for (int hh = 0; hh < 4; ++hh) { s4[hh] *= 0.125f; sc[hh * 2624 + cidx] = s4[hh]; mv[hh] = fmaxf(mv[hh], s4[hh]); }
    }
    for (int i = tid; i < 513; i += 512) {
        asm volatile("" ::: "memory");
        float kr[64]; kv.krow_win(PAST - 512 + i, kr); float s4[4] = {0.f, 0.f, 0.f, 0.f};
#pragma unroll
        for (int d = 0; d < 64; ++d) { const f32x4 qv = *(const LAS f32x4*)(qs + d * 4); s4[0] += qv[0] * kr[d]; s4[1] += qv[1] * kr[d]; s4[2] += qv[2] * kr[d]; s4[3] += qv[3] * kr[d]; }
#pragma unroll
        for (int hh = 0; hh < 4; ++hh) { s4[hh] *= 0.125f; sc[hh * 2624 + 2048 + i] = s4[hh]; mv[4 + hh] = fmaxf(mv[4 + hh], s4[hh]); }
    }
    blk_reduce<8>(red, bc, mv, true, wave, lane);
#pragma unroll
    for (int i = 0; i < 8; ++i) sv[i] = 0.f;
    for (int cidx = tid; cidx < NCV; cidx += 512) {
#pragma unroll
        for (int hh = 0; hh < 4; ++hh) { const float e = __expf(sc[hh * 2624 + cidx] - mv[hh]); sc[hh * 2624 + cidx] = e; sv[hh] += e; } }
    for (int i = tid; i < 513; i += 512) {
#pragma unroll
        for (int hh = 0; hh < 4; ++hh) { const float e = __expf(sc[hh * 2624 + 2048 + i] - mv[4 + hh]); sc[hh * 2624 + 2048 + i] = e; sv[4 + hh] += e; } }
    blk_reduce<8>(red, bc, sv, false, wave, lane);
    float invc[4], invw[4];
#pragma unroll
    for (int hh = 0; hh < 4; ++hh) { invc[hh] = 1.f / sv[hh]; invw[hh] = 1.f / sv[4 + hh]; }
    for (int cidx = tid; cidx < 1024; cidx += 512) PSL[cidx] = cidx < NCV ? (sc[cidx] * invc[0] + sc[2624 + cidx] * invc[1]) + (sc[2 * 2624 + cidx] * invc[2] + sc[3 * 2624 + cidx] * invc[3]) : 0.f;
    __syncthreads();
    if (wave == 0) {
        float scv[5];
#pragma unroll
        for (int i = 0; i < 5; ++i) { const int j = lane + 64 * i; float v = -3e38f;
            if (j <= CUR) { if (j == 0 || j == CUR || j == CUR - 1) v = 3e38f; else { float a = 0.f;
#pragma unroll
                    for (int o5 = -1; o5 < 4; ++o5) { const int cc = 4 * j + o5; if (cc >= 0 && cc < NCV) a += (o5 == -1 || o5 == 3) ? 0.5f * PSL[cc] : PSL[cc]; }
                    v = a; } }
            scv[i] = v; }
        for (int k = 0; k < 16; ++k) {
            float bv = scv[0]; int bi = lane;
#pragma unroll
            for (int i = 1; i < 5; ++i) if (scv[i] > bv) { bv = scv[i]; bi = lane + 64 * i; }
#pragma unroll
            for (int off = 32; off > 0; off >>= 1) { const float ov = __shfl_xor(bv, off); const int oi = __shfl_xor(bi, off); if (ov > bv || (ov == bv && oi < bi)) { bv = ov; bi = oi; } }
            if (lane == 0) sel[k] = bi;
#pragma unroll
            for (int i = 0; i < 5; ++i) if (lane + 64 * i == bi) scv[i] = -3e38f;
        }
    }
    __syncthreads();
    float ms[4], ss4[4];
#pragma unroll
    for (int i = 0; i < 4; ++i) ms[i] = -3e38f;
    for (int idx = tid; idx < 1024; idx += 512) {
        asm volatile("" ::: "memory");
        const int pos = sel[idx >> 6] * 64 + (idx & 63); float s4[4] = {-1e30f, -1e30f, -1e30f, -1e30f};
        if (pos <= PAST) { float kr[64]; kv.krow_sel(pos, kr); s4[0] = s4[1] = s4[2] = s4[3] = 0.f;
#pragma unroll
            for (int d = 0; d < 64; ++d) { const f32x4 qv = *(const LAS f32x4*)(qs + d * 4); s4[0] += qv[0] * kr[d]; s4[1] += qv[1] * kr[d]; s4[2] += qv[2] * kr[d]; s4[3] += qv[3] * kr[d]; }
#pragma unroll
            for (int hh = 0; hh < 4; ++hh) s4[hh] *= 0.125f; }
#pragma unroll
        for (int hh = 0; hh < 4; ++hh) { sc[hh * 2624 + 1024 + idx] = s4[hh]; ms[hh] = fmaxf(ms[hh], s4[hh]); }
    }
    blk_reduce<4>(red, bc, ms, true, wave, lane);
#pragma unroll
    for (int i = 0; i < 4; ++i) ss4[i] = 0.f;
    for (int idx = tid; idx < 1024; idx += 512) {
#pragma unroll
        for (int hh = 0; hh < 4; ++hh) { const float x = sc[hh * 2624 + 1024 + idx]; const float e = x > -1e29f ? __expf(x - ms[hh]) : 0.f; sc[hh * 2624 + 1024 + idx] = e; ss4[hh] += e; } }
    blk_reduce<4>(red, bc, ss4, false, wave, lane);
    float invs[4];
#pragma unroll
    for (int hh = 0; hh < 4; ++hh) invs[hh] = 1.f / ss4[hh];
    float oc[4] = {0.f, 0.f, 0.f, 0.f}, os[4] = {0.f, 0.f, 0.f, 0.f}, ow[4] = {0.f, 0.f, 0.f, 0.f};
    { const int c1 = (wave + 1) * 128 < NCV ? (wave + 1) * 128 : NCV;
#pragma unroll 16
        for (int cidx = wave * 128; cidx < c1; ++cidx) { const float v = VC[(size_t)cidx * 64 + lane];
#pragma unroll
            for (int hh = 0; hh < 4; ++hh) oc[hh] += sc[hh * 2624 + cidx] * v; } }
    for (int kb = wave * 2; kb < wave * 2 + 2; ++kb) { const int p0 = sel[kb] * 64; int nk = PAST - p0 + 1; nk = nk > 64 ? 64 : nk;
        const float* vbase = p0 < PAST ? kv.prow(p0, 3) + lane : kv.nvs + lane;
#pragma unroll 16
        for (int kk = 0; kk < nk; ++kk) { const float v = vbase[(size_t)kk * 256];
#pragma unroll
            for (int hh = 0; hh < 4; ++hh) os[hh] += sc[hh * 2624 + 1024 + kb * 64 + kk] * v; } }
    { const int i1 = (wave + 1) * 65 < 513 ? (wave + 1) * 65 : 513;
#pragma unroll 13
        for (int i = wave * 65; i < i1; ++i) { const float v = kv.v_win(PAST - 512 + i, lane);
#pragma unroll
            for (int hh = 0; hh < 4; ++hh) ow[hh] += sc[hh * 2624 + 2048 + i] * v; } }
#pragma unroll
    for (int hh = 0; hh < 4; ++hh) { part[(wave * 12 + hh) * 64 + lane] = oc[hh] * invc[hh]; part[(wave * 12 + 4 + hh) * 64 + lane] = os[hh] * invs[hh]; part[(wave * 12 + 8 + hh) * 64 + lane] = ow[hh] * invw[hh]; }
    __syncthreads();
    if (tid < 256) { const int hh = tid >> 6, d = tid & 63; float a = 0.f, b = 0.f, cc = 0.f;
        for (int w = 0; w < 8; ++w) { a += part[(w * 12 + hh) * 64 + d]; b += part[(w * 12 + 4 + hh) * 64 + d]; cc += part[(w * 12 + 8 + hh) * 64 + d]; }
        ysd[tid] = siluf_(dgp[tid]) * (gsm[hh * 3] * a + gsm[hh * 3 + 1] * b + gsm[hh * 3 + 2] * cc); }
}
DI void ph_mix_sample(LAS unsigned char* lds_, int l) {
    const Ctx c = mkctx(lds_); const int tid = c.tid, lane = c.lane, wave = c.wave;
    const int b = c.bid - (c.G - 32);
    if (b < 0 || b >= 32) return;
    float* out = c.out;
    __syncthreads();
    const float* pr = WSF(WS_PROJS) + (size_t)b * NPD;
    LAS float* act = (LAS float*)c.lds;
    LAS float* red = act + 768;
    LAS float* ybl = red + 16;
    LAS float* sdt = ybl + 256;
    LAS float* nrow = sdt + 8;
    LAS float* gsm = nrow + 256;
    LAS float* wl = gsm + 16;
    float* ys = WSF(WS_YS) + (size_t)b * 1024;
    if (tid < 256) { const int ch = tid; const float* st = INP(I_SSC) + ((size_t)(l * NB + b) * 2) * 256; const float* scw = INP(I_SCW) + l * 768;
        const float u = pr[512 + ch] * pr[ch], p0 = st[ch], p1 = st[256 + ch]; const float y = scw[ch] * p0 + scw[256 + ch] * p1 + scw[512 + ch] * u;
        ys[ch] = siluf_(pr[768 + ch]) * pr[256 + ch] * y; float* so = out + O_SCS + ((size_t)(l * NB + b) * 2) * 256; so[ch] = p1; so[256 + ch] = u; }
    float uc = 0.f;
    if (tid >= 256) { const int ch = tid - 256; const float* st = INP(I_SCF) + (size_t)(l * NB + b) * 7680; const float* cfw = INP(I_CFW) + l * 31 * 256;
        const float glu = pr[2048 + ch] * sigmoidf_(pr[2304 + ch]); float u = INP(I_CFB)[l * 256 + ch]; float* so = out + O_CFS + (size_t)(l * NB + b) * 7680;
        for (int k = 0; k < 30; ++k) { const float pv = st[k * 256 + ch]; u += cfw[k * 256 + ch] * pv; if (k > 0) so[(k - 1) * 256 + ch] = pv; }
        u += cfw[30 * 256 + ch] * glu; so[29 * 256 + ch] = glu; uc = u; }
    { const float s1 = wsum(tid >= 256 ? uc : 0.f); if (lane == 0) red[wave] = s1; }
    __syncthreads();
    const float cmean = (red[4] + red[5] + red[6] + red[7]) * (1.f / 256.f);
    __syncthreads();
    { const float d = uc - cmean; const float s2 = wsum(tid >= 256 ? d * d : 0.f); if (lane == 0) red[wave] = s2; }
    __syncthreads();
    if (tid >= 256) { const int ch = tid - 256; const float var = (red[4] + red[5] + red[6] + red[7]) * (1.f / 256.f);
        const float ln = (uc - cmean) * rsqrtf(var + EPS) * INP(I_LNG)[l * 256 + ch] + INP(I_LNB)[l * 256 + ch];
        ys[512 + ch] = siluf_(pr[2560 + ch]) * siluf_(ln); }
    { const float* st = INP(I_SBC) + (size_t)(l * NB + b) * 2304; const float* cw = INP(I_BCW) + l * 4 * 768; const float* cb = INP(I_BCB) + l * 768; float* so = out + O_BCS + (size_t)(l * NB + b) * 2304;
        for (int ch = tid; ch < 768; ch += 512) { const float raw = pr[1280 + ch], p0 = st[ch], p1 = st[768 + ch], p2 = st[1536 + ch];
            act[ch] = siluf_(cb[ch] + cw[ch] * p0 + cw[768 + ch] * p1 + cw[1536 + ch] * p2 + cw[2304 + ch] * raw); so[ch] = p1; so[768 + ch] = p2; so[1536 + ch] = raw; }
        if (tid < 4) { const float dt = softplusf_(pr[3456 + tid] + INP(I_DTB)[l * 4 + tid]); sdt[tid] = dt; sdt[4 + tid] = __expf(dt * (-__expf(INP(I_ALOG)[l * 4 + tid]))); } }
    __syncthreads();
    { const float* h0 = INP(I_SSM) + (size_t)(l * NB + b) * 32768; float* ho = out + O_HS + (size_t)(l * NB + b) * 32768; const float* Dp = INP(I_SD) + l * 4;
        for (int row = wave; row < 256; row += 8) { const int hd = row >> 6, gq = hd >> 1; const float dt = sdt[hd], dA = sdt[4 + hd], xv = act[row]; float y = 0.f;
#pragma unroll
            for (int s2 = 0; s2 < 2; ++s2) { const int sidx = lane + 64 * s2; const float hn = dA * h0[row * 128 + sidx] + dt * xv * act[256 + gq * 128 + sidx]; ho[row * 128 + sidx] = hn; y += hn * act[512 + gq * 128 + sidx]; }
            y = wsum(y);
            if (lane == 0) ybl[row] = (y + Dp[hd] * xv) * siluf_(pr[1024 + row]); } }
    __syncthreads();
    { const float v = tid < 256 ? ybl[tid] : 0.f; const float s2 = wsum(v * v); if (lane == 0) red[8 + wave] = s2; }
    __syncthreads();
    if (tid < 256) { const float ss = red[8] + red[9] + red[10] + red[11]; ys[256 + tid] = ybl[tid] * rsqrtf(ss * (1.f / 256.f) + EPS) * INP(I_SNG)[l * 256 + tid]; }
    const float* qg = INP(I_QG) + l * 64; const float* kg = INP(I_KG) + l * 192;
    LAS float* qs = wl + 10496;
    if (wave < 4) { const float v = pr[2816 + wave * 64 + lane]; const float ss = wsum(v * v); qs[lane * 4 + wave] = v * rsqrtf(ss * (1.f / 64.f) + EPS) * qg[lane]; }
    else if (wave == 4) { const float v = pr[3072 + 128 + lane]; const float ss = wsum(v * v); nrow[lane] = v * rsqrtf(ss * (1.f / 64.f) + EPS) * kg[64 + lane]; nrow[64 + lane] = pr[3072 + 192 + lane]; }
    else if (wave == 5) { const float v = pr[3072 + 256 + lane]; const float ss = wsum(v * v); nrow[128 + lane] = v * rsqrtf(ss * (1.f / 64.f) + EPS) * kg[128 + lane]; nrow[192 + lane] = pr[3072 + 320 + lane]; }
    else if (wave == 6) { if (lane < 12) gsm[lane] = sigmoidf_(pr[3460 + lane]); }
    __syncthreads();
    const float* cache_win = INP(I_CWIN) + (size_t)(l * NB + b) * 512 * 128;
    { float* ko = out + O_KVS + (size_t)(l * NB + b) * 256;
        if (tid < 128) ko[tid] = pr[3072 + tid]; else if (tid < 192) ko[tid] = nrow[tid - 128]; else if (tid < 256) ko[tid] = nrow[64 + tid - 192];
        float* wo = out + O_WINS + (size_t)(l * NB + b) * 512 * 128;
        for (int e = tid; e < 511 * 128; e += 512) wo[e] = cache_win[128 + e];
        if (tid < 64) wo[511 * 128 + tid] = nrow[128 + tid]; else if (tid < 128) wo[511 * 128 + tid] = nrow[192 + tid - 64]; }
    float* nrp = WSF(WS_NRG) + (size_t)(l * NB + b) * 256;
    if (tid < 256) nrp[tid] = nrow[tid];
    asm volatile("s_waitcnt vmcnt(0)" ::: "memory");
    __syncthreads();
    {
        SampleKV kv{INP(I_CKV) + (size_t)l * NPOOL * 128 * 256, (const int*)c.ap->in[I_PT] + b * 128, cache_win, nrp, nrp + 64, nrp + 128, nrp + 192};
        nsa_sample_block(wl, WSF(WS_KCS) + (size_t)(l * NB + b) * 1024 * 64, WSF(WS_VCS) + (size_t)(l * NB + b) * 1024 * 64, kv, gsm, pr + 3584, ys + 768, tid, lane, wave);
    }
    edge_publish((unsigned*)(c.ws + WS_CTL + 18432) + l * 64);
    __syncthreads();
}
DI void ph_scan(LAS unsigned char* lds_, int l) {
    const Ctx c = mkctx(lds_);
    if (c.bid >= 64) return;
    const float* CST = WSF(WS_CST); float* HPV = WSF(WS_HPV); const float* CDEC = WSF(WS_CDEC);
    const int e = c.bid * 512 + c.tid, hd = e >> 13; float hc = 0.f;
#pragma unroll 8
    for (int ch = 0; ch < 128; ++ch) { const float sv = CST[(size_t)ch * 32768 + e]; HPV[(size_t)ch * 32768 + e] = hc; hc = CDEC[ch * 4 + hd] * hc + sv; }
    c.out[O_HP + (size_t)l * 32768 + e] = hc;
    edge_publish((unsigned*)(c.ws + WS_CTL + 17408) + l * 64);
}
DI f16x8 pack_p(const f32x4& a, const f32x4& b) { f16x8 r; r[0] = (f16)a[0]; r[1] = (f16)a[1]; r[2] = (f16)a[2]; r[3] = (f16)a[3]; r[4] = (f16)b[0]; r[5] = (f16)b[1]; r[6] = (f16)b[2]; r[7] = (f16)b[3]; return r; }
DI f16x8 ld_vt(const f16* p) { const f16x4 a = *(const f16x4*)p, b = *(const f16x4*)(p + 16); f16x8 r; r[0] = a[0]; r[1] = a[1]; r[2] = a[2]; r[3] = a[3]; r[4] = b[0]; r[5] = b[1]; r[6] = b[2]; r[7] = b[3]; return r; }
constexpr int NT_PSEL = 0  , NT_STG = 32768  , NT_STG_SZ = 18432 + 17408,
              NT_RING = 0  , NT_MASK = 131072  , NT_VB = NT_MASK + 1088  , NT_END = NT_VB + 1088;
static_assert(NT_STG + 2 * NT_STG_SZ <= NT_MASK, "nsa tile LDS map");
static_assert(NT_END <= MISC_OFF, "nsa tile LDS map");
struct StgRegs { f16x8 k0, k1, v0, v1; };
template <bool WITH_V, class KSrc, class VSrc>
DI void stg_load(StgRegs& rg, int ch, int tid, const KSrc& ksrc, const VSrc& vsrc) {
    const f16* kp = ksrc(ch, tid >> 2) + (tid & 3) * 16; rg.k0 = ld_h8(kp); rg.k1 = ld_h8(kp + 8);
    if (WITH_V) { const f16* vp = vsrc(ch, tid >> 3, tid & 7); rg.v0 = ld_h8(vp); rg.v1 = ld_h8(vp + 8); }
}
template <bool WITH_V>
DI void stg_store(const StgRegs& rg, LAS unsigned char* buf, int tid) {
    LAS f16* kb = (LAS f16*)buf + (tid >> 2) * 72 + (tid & 3) * 16; *(LAS f16x8*)kb = rg.k0; *(LAS f16x8*)(kb + 8) = rg.k1;
    if (WITH_V) { LAS f16* vb = (LAS f16*)(buf + 18432) + (tid >> 3) * 136 + (tid & 7) * 16; *(LAS f16x8*)vb = rg.v0; *(LAS f16x8*)(vb + 8) = rg.v1; }
}
template <bool WITH_V, class KSrc, class VSrc, class Body>
DI void stream_chunks(LAS unsigned char* stg, int nchunk, int tid, const KSrc& ksrc, const VSrc& vsrc, Body body) {
    if (nchunk <= 0) return;
    const int last = nchunk - 1;
    StgRegs rg;
    stg_load<WITH_V>(rg, 0, tid, ksrc, vsrc);
    __syncthreads();
    stg_store<WITH_V>(rg, stg, tid); stg_load<WITH_V>(rg, 1 < last ? 1 : last, tid, ksrc, vsrc);
    lds_barrier();
#pragma nounroll
    for (int ch = 0; ch < nchunk; ++ch) {
        body(ch, stg + (ch & 1) * NT_STG_SZ);
        stg_store<WITH_V>(rg, stg + ((ch + 1) & 1) * NT_STG_SZ, tid); stg_load<WITH_V>(rg, ch + 2 < last ? ch + 2 : last, tid, ksrc, vsrc);
        lds_barrier();
    }
}
DI f16x8 lds_vt(const LAS f16* p) { const f16x4 a = *(const LAS f16x4*)p, b = *(const LAS f16x4*)(p + 16); f16x8 r; r[0] = a[0]; r[1] = a[1]; r[2] = a[2]; r[3] = a[3]; r[4] = b[0]; r[5] = b[1]; r[6] = b[2]; r[7] = b[3]; return r; }
DI f32x4 qk_tile(const LAS f16* kb, int kt, int fr, int q, const f16x8 (&qf)[2]) {
    const LAS f16* kp = kb + (16 * kt + fr) * 72 + 8 * q; f32x4 sa = (f32x4){0.f, 0.f, 0.f, 0.f};
    sa = __builtin_amdgcn_mfma_f32_16x16x32_f16(*(const LAS f16x8*)kp, qf[0], sa, 0, 0, 0); return __builtin_amdgcn_mfma_f32_16x16x32_f16(*(const LAS f16x8*)(kp + 32), qf[1], sa, 0, 0, 0);
}
template <class EFn>
DI float pv_step(const LAS f16* kb, const LAS f16* vb, int st, int fr, int q, const f16x8 (&qf)[2], f32x4 (&o)[4], f32x4 (&e2)[2], EFn efn) {
    float lp = 0.f;
#pragma unroll
    for (int hf = 0; hf < 2; ++hf) { const f32x4 sa = qk_tile(kb, 2 * st + hf, fr, q, qf);
#pragma unroll
        for (int j = 0; j < 4; ++j) { const float e = efn(32 * st + 16 * hf + 4 * q + j, sa[j]); e2[hf][j] = e; lp += e; } }
    const f16x8 pb = pack_p(e2[0], e2[1]);
#pragma unroll
    for (int dt = 0; dt < 4; ++dt) o[dt] = __builtin_amdgcn_mfma_f32_16x16x32_f16(lds_vt(vb + (16 * dt + fr) * 136 + 32 * st + 4 * q), pb, o[dt], 0, 0, 0);
    return lp;
}
DI void nsa_tile(const Ctx& c, int tile, const f16* Q16, const f16* KC16, const f16* VCT16, const f16* KS16, const f16* VST16, const f16* KW16, const f16* VWT16,
                 const float* GATES, const f16* DG, f16* Y16, float shc, float shs, float shw) {
    LAS unsigned char* lds = c.lds; const int wave = c.wave; int tid, lane, fr, q, ti, h, trow;
    const int t0 = tile * 32, cur = t0 >> 6;
#define NSA_RELANE() do { int _t = c.tid; asm volatile("" : "+v"(_t)); tid = _t; lane = _t & 63; fr = lane & 15; q = lane >> 4; ti = fr >> 2; h = fr & 3; trow = t0 + 4 * wave + ti; } while (0)
#define NSA_REPS(bit) (((NSA_DUP >> (bit)) & 1) ? 2 : 1)
#define NSA_SCALE(rep) ({ float _z = (rep) == 0 ? 1.f : 0.f; asm volatile("" : "+v"(_z)); _z; })
    NSA_RELANE();
    LAS float* PSEL = (LAS float*)(lds + NT_PSEL); LAS unsigned* MASK = (LAS unsigned*)(lds + NT_MASK); LAS int* VB = (LAS int*)(lds + NT_VB); LAS unsigned char* STG = lds + NT_STG;
    __syncthreads();
    for (int i = tid; i < 272; i += 512) MASK[i] = (i == 0 || i == cur || i == cur - 1) ? 0xFFFFFFFFu : 0u;
    f16x8 qf[2];
#pragma unroll
    for (int ks = 0; ks < 2; ++ks) qf[ks] = ld_h8(Q16 + ((size_t)trow * 4 + h) * 64 + 32 * ks + 8 * q);
    const int nkt = ((t0 >> 4) + 1 + 15) >> 4;
    const int ncch = (nkt + 7) >> 3;
    const int nv_row = trow >= 31 ? ((trow - 31) >> 4) + 1 : 0;
    auto kc_src = [&](int ch, int row) { return KC16 + (size_t)(128 * ch + row) * 64; };
    auto vc_src = [&](int ch, int d, int seg) { return VCT16 + (size_t)d * 1024 + 128 * ch + seg * 16; };
    float lsum = 0.f;
    for (int rep = 0; rep < NSA_REPS(0); ++rep) { const float dsc = NSA_SCALE(rep);
    stream_chunks<false>(STG, ncch, tid, kc_src, vc_src, [&](int ch, LAS unsigned char* buf) {
        const LAS f16* kb = (const LAS f16*)buf; const int nk = nkt - 8 * ch < 8 ? nkt - 8 * ch : 8;
#pragma unroll 4
        for (int kt = 0; kt < nk; ++kt) { const f32x4 sa = qk_tile(kb, kt, fr, q, qf); const int cb = 128 * ch + 16 * kt + 4 * q;
#pragma unroll
            for (int j = 0; j < 4; ++j) lsum += (cb + j < nv_row) ? dsc * __expf(sa[j] * 0.125f - shc) : 0.f; } }); }
    lsum += __shfl_xor(lsum, 16); lsum += __shfl_xor(lsum, 32);
    const float invc = lsum > 0.f ? 1.f / lsum : 0.f;
    NSA_RELANE();
    f32x4 oc[4];
#pragma unroll
    for (int dt = 0; dt < 4; ++dt) oc[dt] = (f32x4){0.f, 0.f, 0.f, 0.f};
    for (int rep = 0; rep < NSA_REPS(1); ++rep) { const float dsc = NSA_SCALE(rep); float bprev = 0.f;
    stream_chunks<true>(STG, ncch, tid, kc_src, vc_src, [&](int ch, LAS unsigned char* buf) {
        const LAS f16* kb = (const LAS f16*)buf; const LAS f16* vb = (const LAS f16*)(buf + 18432); const int ns = (nkt - 8 * ch + 1) >> 1 < 4 ? (nkt - 8 * ch + 1) >> 1 : 4;
#pragma unroll 2
        for (int s2 = 0; s2 < ns; ++s2) {
            f32x4 e2[2];
            pv_step(kb, vb, s2, fr, q, qf, oc, e2, [&](int kc, float sv) { return (128 * ch + kc < nv_row) ? dsc * __expf(sv * 0.125f - shc) * invc : 0.f; });
#pragma unroll
            for (int hf = 0; hf < 2; ++hf) {
                const int ktg = 8 * ch + 2 * s2 + hf;
                float av = (e2[hf][0] + e2[hf][1]) + (e2[hf][2] + 0.5f * e2[hf][3]), bv = 0.5f * e2[hf][3];
                if (NSA_DUP & 2) { const float un = dsc != 0.f ? 1.f / dsc : 0.f; av *= un; bv *= un; }
                av += dppf<DPP_X1>(av); av += dppf<DPP_X2>(av); bv += dppf<DPP_X1>(bv); bv += dppf<DPP_X2>(bv);
                const float up = __shfl(q == 3 ? bprev : bv, (lane + 48) & 63);
                bprev = bv;
                if (h == 0 && ktg < nkt && rep == 0) PSEL[(4 * wave + ti) * 256 + 4 * ktg + q] = av + up;
            }
        } }); }
    for (int rep = 0; rep < NSA_REPS(2); ++rep) {
        const int nforced = cur >= 2 ? 3 : cur + 1, nsel = ((cur + 1) < 16 ? (cur + 1) : 16) - nforced, tk = lane >> 4, l16 = lane & 15, tokl = 4 * wave + tk;
        float sv[16];
#pragma unroll
        for (int i = 0; i < 16; ++i) { const int j = l16 + 16 * i; float v = -3e38f;
            if (j <= cur && !(j == 0 || j == cur || j == cur - 1)) v = j < 4 * nkt ? PSEL[tokl * 256 + j] : 0.f;
            sv[i] = v; }
#pragma nounroll
        for (int k = 0; k < nsel; ++k) {
            float bv = sv[0]; int bi = l16;
#pragma unroll
            for (int i = 1; i < 16; ++i) if (sv[i] > bv) { bv = sv[i]; bi = l16 + 16 * i; }
#define TOPK_STEP(CT) do { const float ov = dppf<CT>(bv); const int oi = dppi<CT>(bi); if (ov > bv || (ov == bv && oi < bi)) { bv = ov; bi = oi; } } while (0)
            TOPK_STEP(DPP_X1); TOPK_STEP(DPP_X2); TOPK_STEP(DPP_HM); TOPK_STEP(DPP_R8);
#undef TOPK_STEP
            if (l16 == 0) __hip_atomic_fetch_or(&MASK[bi], 1u << tokl, __ATOMIC_RELAXED, __HIP_MEMORY_SCOPE_WORKGROUP);
#pragma unroll
            for (int i = 0; i < 16; ++i) if (l16 + 16 * i == bi) sv[i] = -3e38f;
        }
    }
    NSA_RELANE();
    f32x4 owr[4]; float lwr = 0.f;
#pragma unroll
    for (int dt = 0; dt < 4; ++dt) owr[dt] = (f32x4){0.f, 0.f, 0.f, 0.f};
    {
        const int wlo = t0 - 512 > 0 ? t0 - 512 : 0, nwch = (t0 + 32 - wlo + 127) >> 7;
        auto kw_src = [&](int ch, int row) { int p = wlo + 128 * ch + row; p = p < SEQ ? p : SEQ - 1; return KW16 + (size_t)p * 64; };
        auto vw_src = [&](int ch, int d, int seg) { const int key = wlo + 128 * ch + seg * 16; int blk = key >> 6; blk = blk < 256 ? blk : 255; return VWT16 + (size_t)blk * 4096 + d * 64 + (key & 63); };
        for (int rep = 0; rep < NSA_REPS(3); ++rep) { const float dsc = NSA_SCALE(rep);
        stream_chunks<true>(STG, nwch, tid, kw_src, vw_src, [&](int ch, LAS unsigned char* buf) {
            const LAS f16* kb = (const LAS f16*)buf; const LAS f16* vb = (const LAS f16*)(buf + 18432); const int pbase = wlo + 128 * ch;
            const int ns = (t0 + 32 - pbase) >> 5 < 4 ? (t0 + 32 - pbase) >> 5 : 4;
#pragma unroll 2
            for (int s2 = 0; s2 < ns; ++s2) { f32x4 e2[2];
                lwr += pv_step(kb, vb, s2, fr, q, qf, owr, e2, [&](int kc, float sv) { const int pos = pbase + kc; return (pos <= trow && pos >= trow - 512) ? dsc * __expf(sv * 0.125f - shw) : 0.f; }); } }); }
    }
    NSA_RELANE();
    if (wave == 0) { int cnt = 0;
        for (int base = 0; base <= cur; base += 64) { const int jx = base + lane; const bool v = jx <= cur && MASK[jx] != 0u; const unsigned long long bal = __ballot(v);
            if (v) VB[cnt + __popcll(bal & ((1ull << lane) - 1ull))] = jx; cnt += __popcll(bal); }
        if (lane == 0) VB[264] = cnt; }
    __syncthreads();
    if (VERIFY_NSA) { unsigned* SELM = (unsigned*)(c.ws + WS_SELM) + (size_t)tile * 272; for (int i = tid; i < 272; i += 512) SELM[i] = MASK[i]; }
    f32x4 osr[4]; float lsr = 0.f;
#pragma unroll
    for (int dt = 0; dt < 4; ++dt) osr[dt] = (f32x4){0.f, 0.f, 0.f, 0.f};
    {
        const int nvb = __builtin_amdgcn_readfirstlane(VB[264]), nst = (nvb + 3) >> 2;
        const int dr = lane >> 3, dp = lane & 7, dsw = (dp ^ dr) * 8;
        LAS unsigned char* RING = lds + NT_RING;
        auto dma = [&](int n) { const int bi = n < nvb ? n : nvb - 1; const int blk = __builtin_amdgcn_readfirstlane(VB[bi]); LAS unsigned char* slot = RING + (n & 7) * 16384 + wave * 1024;
            __builtin_amdgcn_global_load_lds((const unsigned*)(KS16 + ((size_t)blk * 64 + 8 * wave + dr) * 64 + dsw), (LAS unsigned*)slot, 16, 0, 0);
            __builtin_amdgcn_global_load_lds((const unsigned*)(VST16 + (size_t)blk * 4096 + (8 * wave + dr) * 64 + dsw), (LAS unsigned*)(slot + 8192), 16, 0, 0); };
        for (int rep = 0; rep < NSA_REPS(5); ++rep) { const float dsc = NSA_SCALE(rep);
        asm volatile("s_waitcnt vmcnt(0)" ::: "memory"); __syncthreads();
        dma(0); dma(1); dma(2); dma(3);
#pragma nounroll
        for (int st = 0; st < nst; ++st) {
            asm volatile("s_waitcnt vmcnt(0)\n\ts_barrier" ::: "memory");
            dma(4 * st + 4); dma(4 * st + 5); dma(4 * st + 6); dma(4 * st + 7);
            const int nb = nvb - 4 * st < 4 ? nvb - 4 * st : 4;
#pragma nounroll
            for (int i4 = 0; i4 < nb; ++i4) {
            const int n = 4 * st + i4;
            const int blk = __builtin_amdgcn_readfirstlane(VB[n]); const unsigned mt = (__builtin_amdgcn_readfirstlane(MASK[blk]) >> (4 * wave)) & 15u;
            if (mt != 0u) {
                const bool rv = ((mt >> ti) & 1u) != 0u; const LAS unsigned char* ks = RING + (n & 7) * 16384; const LAS unsigned char* vs = ks + 8192; const int sx = fr & 7;
                f32x4 sa[4]; f16x8 va[2][4];
#pragma unroll
                for (int kt = 0; kt < 4; ++kt) { const LAS unsigned char* kp = ks + (16 * kt + fr) * 128; sa[kt] = (f32x4){0.f, 0.f, 0.f, 0.f};
                    sa[kt] = __builtin_amdgcn_mfma_f32_16x16x32_f16(*(const LAS f16x8*)(kp + ((q ^ sx) << 4)), qf[0], sa[kt], 0, 0, 0);
                    sa[kt] = __builtin_amdgcn_mfma_f32_16x16x32_f16(*(const LAS f16x8*)(kp + (((4 + q) ^ sx) << 4)), qf[1], sa[kt], 0, 0, 0); }
#pragma unroll
                for (int s2 = 0; s2 < 2; ++s2) { const int sg = 4 * s2 + (q >> 1);
#pragma unroll
                    for (int dt = 0; dt < 4; ++dt) { const LAS unsigned char* vp = vs + (16 * dt + fr) * 128 + 8 * (q & 1);
                        const f16x4 v0 = *(const LAS f16x4*)(vp + ((sg ^ sx) << 4)), v1 = *(const LAS f16x4*)(vp + (((sg + 2) ^ sx) << 4));
                        va[s2][dt][0] = v0[0]; va[s2][dt][1] = v0[1]; va[s2][dt][2] = v0[2]; va[s2][dt][3] = v0[3]; va[s2][dt][4] = v1[0]; va[s2][dt][5] = v1[1]; va[s2][dt][6] = v1[2]; va[s2][dt][7] = v1[3]; } }
                const int pb0 = 64 * blk + 4 * q;
#pragma unroll
                for (int kt = 0; kt < 4; ++kt)
#pragma unroll
                    for (int j = 0; j < 4; ++j) { const float e = (rv && pb0 + 16 * kt + j <= trow) ? dsc * __expf(sa[kt][j] * 0.125f - shs) : 0.f; sa[kt][j] = e; lsr += e; }
                const f16x8 p0 = pack_p(sa[0], sa[1]), p1 = pack_p(sa[2], sa[3]);
#pragma unroll
                for (int dt = 0; dt < 4; ++dt) { osr[dt] = __builtin_amdgcn_mfma_f32_16x16x32_f16(va[0][dt], p0, osr[dt], 0, 0, 0); osr[dt] = __builtin_amdgcn_mfma_f32_16x16x32_f16(va[1][dt], p1, osr[dt], 0, 0, 0); }
            }
            }
        }
        asm volatile("s_waitcnt vmcnt(0)" ::: "memory"); }
        __syncthreads();
    }
    NSA_RELANE();
    lwr += __shfl_xor(lwr, 16); lwr += __shfl_xor(lwr, 32); lsr += __shfl_xor(lsr, 16); lsr += __shfl_xor(lsr, 32);
    {
        const float g0 = GATES[(size_t)trow * 12 + h * 3], ils = GATES[(size_t)trow * 12 + h * 3 + 1] / lsr, ilw = GATES[(size_t)trow * 12 + h * 3 + 2] / lwr;
#pragma unroll
        for (int dt = 0; dt < 4; ++dt) { const int d0 = 16 * dt + 4 * q; const f16x4 dg = *(const f16x4*)(DG + (size_t)trow * 256 + h * 64 + d0); f16x4 y;
#pragma unroll
            for (int jj = 0; jj < 4; ++jj) { const float o = g0 * oc[dt][jj] + ils * osr[dt][jj] + ilw * owr[dt][jj]; y[jj] = (f16)(siluf_((float)dg[jj]) * o); }
            *(f16x4*)(Y16 + (size_t)trow * 1024 + 768 + h * 64 + d0) = y; }
    }
#undef NSA_RELANE
}
DI void ph_ssd_fin(LAS unsigned char* lds_, int l, int it0, int it1, int itstep);
DI void ph_outproj_sample(LAS unsigned char* lds_, int l, int it);
DI void ph_nsa(LAS unsigned char* lds_, int l) {
    const Ctx c = mkctx(lds_); const int lane = c.lane;
    const float* qg = INP(I_QG) + l * 64; const float* kg = INP(I_KG) + l * 192;
    const float mq = wmaxf(fabsf(qg[lane])), mk0 = wmaxf(fabsf(kg[lane])), mk1 = wmaxf(fabsf(kg[64 + lane])), mk2 = wmaxf(fabsf(kg[128 + lane]));
    const float shc = 8.f * mq * mk0 - 8.f, shs = 8.f * mq * mk1 - 8.f, shw = 8.f * mq * mk2 - 8.f;
    unsigned* qctr = (unsigned*)(c.ws + WS_CTL + 16384) + l * 64; LAS int* qslot = (LAS int*)(c.lds + MISC_OFF + 64); bool fin_ok = false, smp_ok = false;
    for (;;) {
        __syncthreads();
        if (c.tid == 0) *qslot = (int)__hip_atomic_fetch_add(qctr, 1u, __ATOMIC_RELAXED, __HIP_MEMORY_SCOPE_AGENT);
        __syncthreads();
        const int u = __builtin_amdgcn_readfirstlane(*qslot);
        if (u >= 800) break;
        if (u < 512) nsa_tile(c, 511 - u, WSH(WS_Q16), WSH(WS_KC16), WSH(WS_VCT16), WSH(WS_KS16), WSH(WS_VST16), WSH(WS_KW16), WSH(WS_VWT16), WSF(WS_GATES), WSH(WS_PROJ) + (size_t)14 * SEQ * 256, WSH(WS_Y16), shc, shs, shw);
        else if (u < 768) { if (!fin_ok) { edge_wait((unsigned*)(c.ws + WS_CTL + 17408) + l * 64, 64u); fin_ok = true; } ph_ssd_fin(lds_, l, u - 512, u - 511, 1); }
        else { if (!smp_ok) { edge_wait((unsigned*)(c.ws + WS_CTL + 18432) + l * 64, 32u); smp_ok = true; } ph_outproj_sample(lds_, l, u - 768); }
    }
    __syncthreads();
}
DI void ph_nsa_verify(LAS unsigned char* lds_, int l) {
    const Ctx c = mkctx(lds_); const int lane = c.lane;
    LAS float* wl = (LAS float*)c.lds + c.wave * 4400; LAS float* sc = wl; LAS float* qs = wl + 4096; LAS unsigned* selb = (LAS unsigned*)(wl + 4352);
    const f16* Q16 = WSH(WS_Q16); const f16* KC16 = WSH(WS_KC16); const f16* VCT16 = WSH(WS_VCT16); const f16* KS16 = WSH(WS_KS16); const f16* VST16 = WSH(WS_VST16); const f16* KW16 = WSH(WS_KW16); const f16* VWT16 = WSH(WS_VWT16);
    const float* GATES = WSF(WS_GATES); const f16* DG = WSH(WS_PROJ) + (size_t)14 * SEQ * 256; const f16* Y16 = WSH(WS_Y16); const unsigned* SELM = (const unsigned*)(c.ws + WS_SELM);
    float* dbg = (float*)(c.ws + WS_CTL + 40960);
    auto dot4 = [&](const f16* kp, float (&s4)[4]) { s4[0] = s4[1] = s4[2] = s4[3] = 0.f;
#pragma unroll
        for (int i = 0; i < 8; ++i) { const f16x8 kv = ld_h8(kp + 8 * i);
#pragma unroll
            for (int j = 0; j < 8; ++j) { const f32x4 qv = *(const LAS f32x4*)(qs + (8 * i + j) * 4); const float kf = (float)kv[j]; s4[0] += qv[0] * kf; s4[1] += qv[1] * kf; s4[2] += qv[2] * kf; s4[3] += qv[3] * kf; } }
#pragma unroll
        for (int hh = 0; hh < 4; ++hh) s4[hh] *= 0.125f; };
    for (int si = c.bid * 8 + c.wave; si < 200 + 395; si += c.G * 8) {
        const int t = si < 200 ? si : 200 + (si - 200) * 41, cur = t >> 6, ncv = t >= 31 ? ((t - 31) >> 4) + 1 : 0;
#pragma unroll
        for (int hh = 0; hh < 4; ++hh) qs[lane * 4 + hh] = (float)Q16[(size_t)t * 256 + hh * 64 + lane];
        if (lane < 9) selb[lane] = 0u;
        float oc[4] = {0.f, 0.f, 0.f, 0.f}, os[4] = {0.f, 0.f, 0.f, 0.f}, ow[4] = {0.f, 0.f, 0.f, 0.f};
        {
            float mx[4] = {-3e38f, -3e38f, -3e38f, -3e38f}, inv[4];
            for (int cc = lane; cc < ncv; cc += 64) { asm volatile("" ::: "memory"); float s4[4]; dot4(KC16 + (size_t)cc * 64, s4);
#pragma unroll
                for (int hh = 0; hh < 4; ++hh) { sc[hh * 1024 + cc] = s4[hh]; mx[hh] = fmaxf(mx[hh], s4[hh]); } }
#pragma unroll
            for (int hh = 0; hh < 4; ++hh) { mx[hh] = wmaxf(mx[hh]); float sm = 0.f; for (int cc = lane; cc < ncv; cc += 64) { const float e = __expf(sc[hh * 1024 + cc] - mx[hh]); sc[hh * 1024 + cc] = e; sm += e; } sm = wsum(sm); inv[hh] = ncv > 0 ? 1.f / sm : 0.f; }
            for (int cc = lane; cc < ncv; cc += 64) {
#pragma unroll
                for (int hh = 0; hh < 4; ++hh) sc[hh * 1024 + cc] *= inv[hh]; }
            for (int cc = 0; cc < ncv; ++cc) { const float v = (float)VCT16[(size_t)lane * 1024 + cc];
#pragma unroll
                for (int hh = 0; hh < 4; ++hh) oc[hh] += sc[hh * 1024 + cc] * v; }
        }
        const int nsel = (cur + 1) < 16 ? (cur + 1) : 16;
        {
            float scv[5];
#pragma unroll
            for (int i = 0; i < 5; ++i) { const int j = lane + 64 * i; float v = -3e38f;
                if (j <= cur) { if (j == 0 || j == cur || j == cur - 1) v = 3e38f; else { float a = 0.f;
#pragma unroll
                        for (int o5 = -1; o5 < 4; ++o5) { const int cc = 4 * j + o5; if (cc >= 0 && cc < ncv) { const float p = (sc[cc] + sc[1024 + cc]) + (sc[2048 + cc] + sc[3072 + cc]); a += (o5 == -1 || o5 == 3) ? 0.5f * p : p; } }
                        v = a; } }
                scv[i] = v; }
            for (int k = 0; k < nsel; ++k) {
                float bv = scv[0]; int bi = lane;
#pragma unroll
                for (int i = 1; i < 5; ++i) if (scv[i] > bv) { bv = scv[i]; bi = lane + 64 * i; }
#pragma unroll
                for (int off = 32; off > 0; off >>= 1) { const float ov = __shfl_xor(bv, off); const int oi = __shfl_xor(bi, off); if (ov > bv || (ov == bv && oi < bi)) { bv = ov; bi = oi; } }
                if (lane == 0) selb[bi >> 5] |= 1u << (bi & 31);
#pragma unroll
                for (int i = 0; i < 5; ++i) if (lane + 64 * i == bi) scv[i] = -3e38f;
            }
        }
        int nmis = 0;
        for (int j = lane; j <= cur; j += 64) { const unsigned fb = (SELM[(size_t)(t >> 5) * 272 + j] >> (t & 31)) & 1u, nb = (selb[j >> 5] >> (j & 31)) & 1u; nmis += (fb != nb) ? 1 : 0; }
        nmis = (int)wsum((float)nmis);
        if (nmis != 0) { if (lane == 0) { atomicAdd(dbg + 3, 1.f); atomicAdd(dbg + 4, (float)nmis); } continue; }
        {
            float mx[4] = {-3e38f, -3e38f, -3e38f, -3e38f}, inv[4]; int nk = 0;
            for (int j = 0; j <= cur; ++j) if ((selb[j >> 5] >> (j & 31)) & 1u) { asm volatile("" ::: "memory"); const int pos = j * 64 + lane; float s4[4] = {-1e30f, -1e30f, -1e30f, -1e30f}; if (pos <= t) dot4(KS16 + (size_t)pos * 64, s4);
#pragma unroll
                for (int hh = 0; hh < 4; ++hh) { sc[hh * 1024 + nk * 64 + lane] = s4[hh]; mx[hh] = fmaxf(mx[hh], s4[hh]); } ++nk; }
#pragma unroll
            for (int hh = 0; hh < 4; ++hh) { mx[hh] = wmaxf(mx[hh]); float sm = 0.f; for (int k = 0; k < nk; ++k) { const float x = sc[hh * 1024 + k * 64 + lane]; const float e = x > -1e29f ? __expf(x - mx[hh]) : 0.f; sc[hh * 1024 + k * 64 + lane] = e; sm += e; } sm = wsum(sm); inv[hh] = 1.f / sm; }
            nk = 0;
            for (int j = 0; j <= cur; ++j) if ((selb[j >> 5] >> (j & 31)) & 1u) { for (int kk = 0; kk < 64 && j * 64 + kk <= t; ++kk) { const float v = (float)VST16[(size_t)j * 4096 + lane * 64 + kk];
#pragma unroll
                    for (int hh = 0; hh < 4; ++hh) os[hh] += sc[hh * 1024 + nk * 64 + kk] * v; } ++nk; }
#pragma unroll
            for (int hh = 0; hh < 4; ++hh) os[hh] *= inv[hh];
        }
        {
            const int lo = t - 512 > 0 ? t - 512 : 0, nw = t - lo + 1; float mx[4] = {-3e38f, -3e38f, -3e38f, -3e38f}, inv[4];
            for (int i = lane; i < nw; i += 64) { asm volatile("" ::: "memory"); float s4[4]; dot4(KW16 + (size_t)(lo + i) * 64, s4);
#pragma unroll
                for (int hh = 0; hh < 4; ++hh) { sc[hh * 1024 + i] = s4[hh]; mx[hh] = fmaxf(mx[hh], s4[hh]); } }
#pragma unroll
            for (int hh = 0; hh < 4; ++hh) { mx[hh] = wmaxf(mx[hh]); float sm = 0.f; for (int i = lane; i < nw; i += 64) { const float e = __expf(sc[hh * 1024 + i] - mx[hh]); sc[hh * 1024 + i] = e; sm += e; } sm = wsum(sm); inv[hh] = 1.f / sm; }
            for (int i = 0; i < nw; ++i) { const int pos = lo + i; const float v = (float)VWT16[(size_t)(pos >> 6) * 4096 + lane * 64 + (pos & 63)];
#pragma unroll
                for (int hh = 0; hh < 4; ++hh) ow[hh] += sc[hh * 1024 + i] * v; }
#pragma unroll
            for (int hh = 0; hh < 4; ++hh) ow[hh] *= inv[hh];
        }
        float dd = 0.f, ee = 0.f;
#pragma unroll
        for (int hh = 0; hh < 4; ++hh) { const float o = GATES[(size_t)t * 12 + hh * 3] * oc[hh] + GATES[(size_t)t * 12 + hh * 3 + 1] * os[hh] + GATES[(size_t)t * 12 + hh * 3 + 2] * ow[hh];
            const float yn = siluf_((float)DG[(size_t)t * 256 + hh * 64 + lane]) * o, yf = (float)Y16[(size_t)t * 1024 + 768 + hh * 64 + lane]; dd += (yf - yn) * (yf - yn); ee += yn * yn; }
        dd = wsum(dd); ee = wsum(ee);
        if (lane == 0) { atomicAdd(dbg, dd); atomicAdd(dbg + 1, ee); atomicAdd(dbg + 2, 1.f); }
    }
    (void)l;
}
DI void ph_ssd_fin(LAS unsigned char* lds_, int l, int it0, int it1, int itstep) {
    const Ctx c = mkctx(lds_); const int lane = c.lane, wave = c.wave;
    const float* Dp = INP(I_SD) + l * 4; const float* sng = INP(I_SNG) + l * 256;
    const float* CST = WSF(WS_HPV); const f16* ACT = WSH(WS_ACT); const float* ACS = WSF(WS_ACS); const float* YD = WSF(WS_YD); const f16* Z = WSH(WS_PROJ) + (size_t)4 * SEQ * 256; f16* Y16 = WSH(WS_Y16);
    LAS float* GY = (LAS float*)c.lds;
    for (int it = it0; it < it1; it += itstep) {
        const int ch_ = it >> 1, t0 = it * 64, hd = wave >> 1, g = hd >> 1, fr = lane & 15, q = lane >> 4;
        __syncthreads();
        f16x8 bf[2][4];
#pragma unroll
        for (int p2 = 0; p2 < 2; ++p2)
#pragma unroll
            for (int ks = 0; ks < 4; ++ks) bf[p2][ks] = cvt_h8(CST + ((size_t)(ch_ * 4 + hd) * 64 + 16 * ((wave & 1) * 2 + p2) + fr) * 128 + 32 * ks + 8 * q);
#pragma unroll
        for (int lt = 0; lt < 4; ++lt) {
            f16x8 af[4];
#pragma unroll
            for (int ks = 0; ks < 4; ++ks) af[ks] = ld_h8(ACT + (size_t)(t0 + 16 * lt + fr) * 768 + 512 + 128 * g + 32 * ks + 8 * q);
#pragma unroll
            for (int p2 = 0; p2 < 2; ++p2) { f32x4 acc = (f32x4){0.f, 0.f, 0.f, 0.f};
#pragma unroll
                for (int ks = 0; ks < 4; ++ks) acc = __builtin_amdgcn_mfma_f32_16x16x32_f16(af[ks], bf[p2][ks], acc, 0, 0, 0);
                const int ch = hd * 64 + 16 * ((wave & 1) * 2 + p2) + fr;
#pragma unroll
                for (int j = 0; j < 4; ++j) { const int tl = 16 * lt + 4 * q + j, t = t0 + tl;
                    const float y = acc[j] * __expf(ACS[(size_t)t * 4 + hd]) + YD[(size_t)t * 256 + ch] + Dp[hd] * (float)ACT[(size_t)t * 768 + ch];
                    GY[tl * 256 + ch] = y * siluf_((float)Z[(size_t)t * 256 + ch]); } }
        }
        __syncthreads();
        for (int tl = wave; tl < 64; tl += 8) { const f32x4 v = *(const LAS f32x4*)(GY + tl * 256 + lane * 4); const float ss = wsum((v[0] * v[0] + v[1] * v[1]) + (v[2] * v[2] + v[3] * v[3]));
            const float rn = rsqrtf(ss * (1.f / 256.f) + EPS); const f32x4 g4 = *(const f32x4*)(sng + lane * 4); f16x4 o;
#pragma unroll
            for (int i = 0; i < 4; ++i) o[i] = (f16)(v[i] * rn * g4[i]);
            *(f16x4*)(Y16 + (size_t)(t0 + tl) * 1024 + 256 + lane * 4) = o; }
    }
    __syncthreads();
}
DI void ph_outproj(LAS unsigned char* lds_, int l) {
    const Ctx c = mkctx(lds_);
    const float* xin = l == 0 ? INP(I_XP) : WSF(WS_X1); float* xout = l == 0 ? WSF(WS_X1) : c.out + O_YP;
    pg8::Gemm g{WSH(WS_Y16), WSH(WS_WTOUT) + (size_t)l * 1024 * 1024, SEQ, 1024, 1024}; pg8::StaticOrder S; S.init(SEQ, 1024, c.G, c.bid);
    EpiOut E{xin, xout, WSF(WS_ADA) + (size_t)(l * 33 + 32) * 3072 + 2048, l == 0 ? WSH(WS_A16) : nullptr, WSF(WS_GNX), WSF(WS_RSSP)};
    pg8::gemm_phase<EpiOut, pg8::StaticOrder>(c.lds, g, S, E);
    __syncthreads();
}
DI void ph_outproj_sample(LAS unsigned char* lds_, int l, int it) {
    const Ctx c = mkctx(lds_); const int tid = c.tid;
    const float* xs_in = l == 0 ? INP(I_XS) : WSF(WS_XS1); const float* ada_l = WSF(WS_ADA) + (size_t)l * 33 * 3072; const float* YS = WSF(WS_YS); float* xo = l == 0 ? WSF(WS_XS1) : c.out + O_YS;
    LAS f16* Ah = (LAS f16*)c.lds;
    __syncthreads();
#pragma unroll
    for (int i = 0; i < 16; ++i) { const int e = (tid + 512 * i) * 4; const f32x4 v = *(const f32x4*)(YS + e); f16x4 hv; hv[0] = (f16)v[0]; hv[1] = (f16)v[1]; hv[2] = (f16)v[2]; hv[3] = (f16)v[3]; *(LAS f16x4*)(Ah + (e >> 10) * 1032 + (e & 1023)) = hv; }
    __syncthreads();
    sample_gemm_item<1>(c.lds, WSH(WS_WTOUT) + (size_t)l * 1024 * 1024, it * 32, [&](int m, int n, float v) { xo[m * 1024 + n] = xs_in[m * 1024 + n] + ada_l[(size_t)m * 3072 + 2048 + n] * v; });
}

__global__ void __launch_bounds__(512, 2) fwd(Args a) {
    extern __shared__ __attribute__((aligned(16))) unsigned char lds_raw[];
    LAS unsigned char* lds = (LAS unsigned char*)lds_raw;
    volatile LAS unsigned* MISC = (volatile LAS unsigned*)(lds + MISC_OFF);
    if (threadIdx.x < 16) MISC[threadIdx.x] = 0u;
    __syncthreads();
    XcdBarrier bar; bar.bar = (unsigned*)(a.ws + WS_CTL); bar.x = 0; bar.st = MISC;
    if (N_LAUNCHES == 1) bar = xcd_barrier_post((unsigned*)(a.ws + WS_CTL), MISC);
    const int lo = a.ph_lo, hi = a.ph_hi;
    unsigned long long* stampw = (unsigned long long*)(a.ws + WS_CTL + 32768);
    if (STAMP_PHASE >= 0 && blockIdx.x == 0 && threadIdx.x == 0) stampw[0] = wall_clock64();
#define STAMP(k) do { if (STAMP_PHASE == (k) && blockIdx.x == 0 && threadIdx.x == 0) stampw[1] = wall_clock64(); } while (0)
#ifndef PH_MASK
#define PH_MASK 0xFFF
#endif
#define IN(k) (((PH_MASK >> ((k) < 2 ? (k) : 2 + ((k) - 2) % 4)) & 1) && lo <= (k) && (k) < hi)
#define SEAM(k) do { if (IN(k) && IN((k) + 1)) xcd_barrier(bar); STAMP(k); } while (0)
#ifndef DUP_MASK
#define DUP_MASK 0
#endif
#define DUP(bit, call) do { call; if ((DUP_MASK >> (bit)) & 1) { __syncthreads(); call; } } while (0)
    if (IN(0)) DUP(0, ph_prologue(lds));
    SEAM(0);
    if (IN(1)) { ph_hsample(lds, 0); DUP(1, ph_sample_compress(lds)); DUP(2, ph_prep(lds)); }
    SEAM(1);
    for (int l = 0; l < 2; ++l) {
        const int PB = 2 + 4 * l;
        if (IN(PB)) { DUP(3, ph_inproj(lds, l)); DUP(4, ph_inproj_sample(lds, l)); }
        SEAM(PB);
        if (IN(PB + 1)) {
#define SUBSTAMP(code) do { if (l == 0 && (STAMP_PHASE == (code) || STAMP_PHASE == (code) + 10) && blockIdx.x == (STAMP_PHASE >= 110 ? 100 : 0) && threadIdx.x == 0) stampw[1] = wall_clock64(); } while (0)
            DUP(5, ph_ssd_local(lds, l)); SUBSTAMP(100); DUP(6, ph_mix_a(lds, l)); SUBSTAMP(101); DUP(7, ph_mix_c(lds, l)); SUBSTAMP(102); DUP(8, ph_mix_d(lds, l)); SUBSTAMP(103); DUP(9, ph_mix_cmp(lds, l)); SUBSTAMP(104); }
        SEAM(PB + 1);
        if (IN(PB + 2)) { DUP(11, ph_scan(lds, l)); DUP(10, ph_mix_sample(lds, l)); ph_nsa(lds, l); }
        SEAM(PB + 2);
        if (IN(PB + 3)) { if (VERIFY_NSA && l == 0) { ph_nsa_verify(lds, l); __syncthreads(); } if (l == 0) ph_hsample(lds, 1); DUP(14, ph_outproj(lds, l)); }
        SEAM(PB + 3);
    }
    if (STAMP_PHASE >= 0 || VERIFY_NSA) {
        xcd_barrier(bar);
        if (blockIdx.x == 0) { __shared__ float alpha_s; if (threadIdx.x == 0) { const unsigned long long t1 = wall_clock64(); alpha_s = (float)(stampw[1] - stampw[0]) / (float)(t1 - stampw[0]);
                if (VERIFY_NSA) { const float* dbg = (const float*)(a.ws + WS_CTL + 40960); alpha_s = VERIFY_NSA == 1 ? dbg[3] / (dbg[2] + dbg[3]) : sqrtf(dbg[0] / dbg[1]); } } __syncthreads();
            const float sc = 1.f + alpha_s; float* ys = a.out + O_YS; for (int i = threadIdx.x; i < NB * 1024; i += 512) ys[i] *= sc; }
    }
#undef IN
#undef SEAM
}

extern "C" void kernel_launch(void* const* d_in, const int* in_sizes, int n_in, void* d_out, int out_size, void* d_ws, size_t ws_size, hipStream_t stream) {
    static int grid = 0;
    if (grid == 0) {
        if (n_in != N_IN || (size_t)out_size != O_END || ws_size < WS_END) { fprintf(stderr, "kernel_launch: unexpected shapes (n_in %d out %d ws %zu)\n", n_in, out_size, ws_size); grid = -1; return; }
        int dev = 0, cus = 0;
        if (hipGetDevice(&dev) != hipSuccess || hipDeviceGetAttribute(&cus, hipDeviceAttributeMultiprocessorCount, dev) != hipSuccess) { grid = -1; return; }
        if (hipFuncSetAttribute((const void*)fwd, hipFuncAttributeMaxDynamicSharedMemorySize, LDS_BYTES) != hipSuccess) { fprintf(stderr, "kernel_launch: hipFuncSetAttribute failed\n"); grid = -1; return; }
        int per_cu = 0;
        if (hipOccupancyMaxActiveBlocksPerMultiprocessor(&per_cu, (const void*)fwd, 512, LDS_BYTES) != hipSuccess || per_cu < 1) fprintf(stderr, "kernel_launch: occupancy query says %d\n", per_cu);
        (void)hipGetLastError();
        grid = cus;
    }
    if (grid < 0) return;
    hipMemsetAsync((char*)d_ws + WS_CTL, 0, 65536, stream);
    Args a{};
    for (int i = 0; i < N_IN; ++i) a.in[i] = d_in[i];
    a.out = (float*)d_out; a.ws = (unsigned char*)d_ws;
    if (N_LAUNCHES == 1) { a.ph_lo = 0; a.ph_hi = NPHASE; hipLaunchKernelGGL(fwd, dim3(grid), dim3(512), LDS_BYTES, stream, a); }
    else for (int p = 0; p < NPHASE; ++p) { a.ph_lo = p; a.ph_hi = p + 1; hipLaunchKernelGGL(fwd, dim3(grid), dim3(512), LDS_BYTES, stream, a); }
}
```

```cpp
#include <hip/hip_runtime.h>
#include <cstdio>
#include <cstdint>
#include <type_traits>

#define NSA_DUP 0
#define VERIFY_NSA 0
#define STAMP_PHASE -1
#ifndef N_LAUNCHES
#define N_LAUNCHES 1
#endif

#define DI __device__ __forceinline__
#define LAS __attribute__((address_space(3)))
typedef _Float16 f16;
typedef _Float16 f16x8 __attribute__((ext_vector_type(8)));
typedef _Float16 f16x4 __attribute__((ext_vector_type(4)));
typedef _Float16 f16x2 __attribute__((ext_vector_type(2)));
typedef float f32x4 __attribute__((ext_vector_type(4)));
typedef float f32x2 __attribute__((ext_vector_type(2)));
typedef float f32x16 __attribute__((ext_vector_type(16)));
typedef unsigned u32x4 __attribute__((ext_vector_type(4)));

constexpr int DM = 1024, SEQ = 16384, NB = 32, PAST = 16384, NPOOL = 5120, DIN = 3728, NPD = 3840;
constexpr float EPS = 1e-6f;
constexpr int NPHASE = 10;
enum { I_XP = 0, I_XS, I_CKV, I_CWIN, I_SSC, I_SBC, I_SSM, I_SCF, I_PT, I_CP, I_CS, I_NG, I_WADA, I_BADA, I_WIN, I_WOUT, I_SCW, I_BCW, I_BCB,
       I_DTB, I_ALOG, I_SD, I_SNG, I_CFW, I_CFB, I_LNG, I_LNB, I_QG, I_KG, I_PE, I_W1, I_B1, I_W2, I_B2, N_IN };
constexpr size_t O_YP = 0, O_YS = O_YP + (size_t)SEQ * DM, O_KVP = O_YS + NB * DM, O_KVS = O_KVP + (size_t)2 * SEQ * 256, O_WINP = O_KVS + 2 * NB * 256,
                 O_WINS = O_WINP + 2 * 512 * 128, O_SCP = O_WINS + (size_t)2 * NB * 512 * 128, O_SCS = O_SCP + 2 * 2 * 256, O_BCP = O_SCS + 2 * NB * 512,
                 O_BCS = O_BCP + 2 * 3 * 768, O_HP = O_BCS + 2 * NB * 2304, O_HS = O_HP + 2 * 32768, O_CFP = O_HS + (size_t)2 * NB * 32768,
                 O_CFS = O_CFP + 2 * 30 * 256, O_END = O_CFS + 2 * NB * 7680;
constexpr size_t al256(size_t x) { return (x + 255) & ~(size_t)255; }
constexpr size_t WS_CTL = 0, WS_ADA = 65536, WS_BIAS = WS_ADA + al256(2 * 33 * 3072 * 4), WS_PEB = WS_BIAS + al256(2 * NPD * 4), WS_WTIN = WS_PEB + 2048,
                 WS_WTOUT = WS_WTIN + (size_t)2 * NPD * 1024 * 2, WS_W1T = WS_WTOUT + (size_t)2 * 1024 * 1024 * 2, WS_A16 = WS_W1T + (size_t)4 * 128 * 2048 * 2,
                 WS_RSSP = WS_A16 + (size_t)SEQ * 1024 * 2, WS_X1 = WS_RSSP + (size_t)SEQ * 16 * 4, WS_PROJ = WS_X1 + (size_t)SEQ * 1024 * 4,
                 WS_Y16 = WS_PROJ + (size_t)15 * SEQ * 256 * 2, WS_ACT = WS_Y16 + (size_t)SEQ * 1024 * 2, WS_YD = WS_ACT + (size_t)SEQ * 768 * 2,
                 WS_CST = WS_YD + (size_t)SEQ * 256 * 4, WS_ACS = WS_CST + (size_t)128 * 32768 * 4, WS_CDEC = WS_ACS + (size_t)SEQ * 4 * 4, WS_Q16 = WS_CDEC + 2048,
                 WS_KS16 = WS_Q16 + (size_t)SEQ * 256 * 2, WS_VS16 = WS_KS16 + (size_t)SEQ * 64 * 2, WS_KW16 = WS_VS16 + (size_t)SEQ * 64 * 2,
                 WS_VW16 = WS_KW16 + (size_t)SEQ * 64 * 2, WS_GATES = WS_VW16 + (size_t)SEQ * 64 * 2, WS_KC = WS_GATES + (size_t)SEQ * 12 * 4,
                 WS_VC = WS_KC + 1024 * 64 * 4, WS_KCS = WS_VC + 1024 * 64 * 4, WS_VCS = WS_KCS + (size_t)2 * NB * 1024 * 64 * 4,
                 WS_PROJS = WS_VCS + (size_t)2 * NB * 1024 * 64 * 4, WS_YS = WS_PROJS + al256(NB * NPD * 4), WS_XS1 = WS_YS + NB * 1024 * 4, WS_GNX = WS_XS1 + NB * 1024 * 4, WS_NRG = WS_GNX + 4096, WS_VST16 = WS_NRG + 2 * NB * 1024, WS_VWT16 = WS_VST16 + (size_t)SEQ * 64 * 2, WS_KC16 = WS_VWT16 + (size_t)SEQ * 64 * 2,
                 WS_VCT16 = WS_KC16 + 1024 * 64 * 2, WS_HPV = WS_VCT16 + 1024 * 64 * 2, WS_W2T = WS_HPV + (size_t)128 * 32768 * 4, WS_PEBP = WS_W2T + 4 * 64 * 128 * 2, WS_HS16 = WS_PEBP + 4 * 8 * 128 * 4, WS_SELM = WS_HS16 + NB * 1024 * 2, WS_END = WS_SELM + 512 * 272 * 4;
constexpr int LDS_BYTES = 147456;
constexpr int MISC_OFF = 147200;

struct Args { const void* in[N_IN]; float* out; unsigned char* ws; int ph_lo, ph_hi; };

#define XB_TMO      128
#define XB_XCNT(j)  (256  + 64 * (j))
#define XB_XSUB(j)  (1280 + 64 * (j))
#define XB_XGEN(j)  (2304 + 64 * (j))
#define XB_TOP      3328
#define XB_TOPGEN   3392
#define XCD_BAR_WORDS 3456
#define XB_SPIN_CAP (1u << 18)
__device__ __forceinline__ unsigned xb_ld(unsigned* p)              { return __hip_atomic_load(p, __ATOMIC_RELAXED, __HIP_MEMORY_SCOPE_AGENT); }
__device__ __forceinline__ unsigned xb_add(unsigned* p, unsigned v) { return __hip_atomic_fetch_add(p, v, __ATOMIC_RELAXED, __HIP_MEMORY_SCOPE_AGENT); }
__device__ __forceinline__ unsigned xb_xcc_id() { return (unsigned)__builtin_amdgcn_s_getreg((3 << 11) | 20) & 0xFu; }
#define XB_SPIN(cond, bar) do { unsigned _sp = 0; while (cond) { __builtin_amdgcn_s_sleep(1); \
    if ((++_sp & 255u) == 0u) { if (xb_ld(&(bar)[XB_TMO])) break; if (_sp > XB_SPIN_CAP) { atomicAdd(&(bar)[XB_TMO], 1u); break; } } } } while (0)
struct XcdBarrier { unsigned* bar; unsigned x; volatile LAS unsigned* st; };
__device__ __forceinline__ XcdBarrier xcd_barrier_post(unsigned* bar, volatile LAS unsigned* st) {
    XcdBarrier b; b.bar = bar; b.x = xb_xcc_id(); b.st = st;
    if (threadIdx.x == 0) (void)xb_add(&bar[XB_XCNT(b.x)], 1u);
    return b;
}
__device__ __forceinline__ void xcd_barrier_complete(unsigned* bar, unsigned x, unsigned& nloc, unsigned& nx) {
    const unsigned G = gridDim.x * gridDim.y * gridDim.z;
    unsigned sum, cnt, mine, sp = 0u;
    for (;;) {
        sum = 0u; cnt = 0u; mine = 0u;
#pragma unroll
        for (unsigned j = 0; j < 16; ++j) { const unsigned c = xb_ld(&bar[XB_XCNT(j)]); sum += c; cnt += (c > 0u) ? 1u : 0u; mine = (j == x) ? c : mine; }
        if (sum == G) break;
        __builtin_amdgcn_s_sleep(1);
        if ((++sp & 255u) == 0u) { if (xb_ld(&bar[XB_TMO])) break; if (sp > XB_SPIN_CAP) { atomicAdd(&bar[XB_TMO], 1u); break; } }
    }
    nloc = mine > 0u ? mine : 1u; nx = cnt > 0u ? cnt : 1u;
}
__device__ __forceinline__ void xcd_barrier(const XcdBarrier& b) {
    asm volatile("s_waitcnt vmcnt(0)" ::: "memory");
    __syncthreads();
    if (threadIdx.x == 0) {
        unsigned* bar = b.bar;
        __builtin_amdgcn_s_waitcnt(0);
        unsigned nloc = b.st[0], nx = b.st[1];
        if (nloc == 0u) { xcd_barrier_complete(bar, b.x, nloc, nx); b.st[0] = nloc; b.st[1] = nx; }
        const unsigned old = xb_add(&bar[XB_XSUB(b.x)], 1u);
        const unsigned gen = old / nloc;
        if (old + 1u == (gen + 1u) * nloc) {
            __builtin_amdgcn_fence(__ATOMIC_RELEASE, "agent");
            asm volatile("s_waitcnt vmcnt(0)" ::: "memory");
            const unsigned og = xb_add(&bar[XB_TOP], 1u);
            const unsigned tg = og / nx;
            if (og + 1u == (tg + 1u) * nx) xb_add(&bar[XB_TOPGEN], 1u);
            else XB_SPIN(xb_ld(&bar[XB_TOPGEN]) == tg, bar);
            __builtin_amdgcn_fence(__ATOMIC_ACQUIRE, "agent");
            xb_add(&bar[XB_XGEN(b.x)], 1u);
            asm volatile("s_waitcnt vmcnt(0)" ::: "memory");
        } else {
            XB_SPIN(xb_ld(&bar[XB_XGEN(b.x)]) == gen, bar);
            __builtin_amdgcn_fence(__ATOMIC_ACQUIRE, "agent");
            asm volatile("s_waitcnt vmcnt(0)" ::: "memory");
        }
    }
    __syncthreads();
}

DI void lds_barrier() { asm volatile("s_waitcnt lgkmcnt(0)\n\ts_barrier" ::: "memory"); }
DI int ltid() { int t = threadIdx.x; asm volatile("" : "+v"(t)); return t; }
template <int CTRL> DI float dppf(float x) { return __builtin_bit_cast(float, __builtin_amdgcn_update_dpp(0, __builtin_bit_cast(int, x), CTRL, 0xF, 0xF, true)); }
template <int CTRL> DI int dppi(int x) { return __builtin_amdgcn_update_dpp(0, x, CTRL, 0xF, 0xF, true); }
constexpr int DPP_X1 = 0xB1, DPP_X2 = 0x4E, DPP_HM = 0x141, DPP_R8 = 0x128;
DI float sum16(float v) { v += dppf<DPP_X1>(v); v += dppf<DPP_X2>(v); v += dppf<DPP_HM>(v); v += dppf<DPP_R8>(v); return v; }
DI float max16(float v) { v = fmaxf(v, dppf<DPP_X1>(v)); v = fmaxf(v, dppf<DPP_X2>(v)); v = fmaxf(v, dppf<DPP_HM>(v)); v = fmaxf(v, dppf<DPP_R8>(v)); return v; }
DI float wsum(float v) { v = sum16(v); v += __shfl_xor(v, 16); v += __shfl_xor(v, 32); return v; }
DI float wmaxf(float v) { v = max16(v); v = fmaxf(v, __shfl_xor(v, 16)); v = fmaxf(v, __shfl_xor(v, 32)); return v; }
DI float sigmoidf_(float x) { return 1.f / (1.f + __expf(-x)); }
DI float siluf_(float x) { return x / (1.f + __expf(-x)); }
DI float softplusf_(float x) { return fmaxf(x, 0.f) + log1pf(__expf(-fabsf(x))); }
DI f16x8 ld_h8(const f16* p) { return *(const f16x8*)p; }
DI f16x8 cvt_h8(const float* p) { const f32x4 a = *(const f32x4*)p, b = *(const f32x4*)(p + 4); f16x8 r; r[0] = (f16)a[0]; r[1] = (f16)a[1]; r[2] = (f16)a[2]; r[3] = (f16)a[3]; r[4] = (f16)b[0]; r[5] = (f16)b[1]; r[6] = (f16)b[2]; r[7] = (f16)b[3]; return r; }
DI int src_col(int n) { return n < 2048 ? n : (n < 3456 ? n + 4 : (n < 3460 ? n - 1408 : (n < 3472 ? n + 256 : (n < 3584 ? -1 : n - 124)))); }
DI int dst_col(int s) { return s < 2048 ? s : (s < 2052 ? s + 1408 : (s < 3460 ? s - 4 : (s < 3716 ? s + 124 : s - 256))); }

DI void edge_publish(unsigned* ctr) {
    asm volatile("s_waitcnt vmcnt(0)" ::: "memory"); __syncthreads();
    if (threadIdx.x == 0) { __builtin_amdgcn_fence(__ATOMIC_RELEASE, "agent"); asm volatile("s_waitcnt vmcnt(0)" ::: "memory"); __hip_atomic_fetch_add(ctr, 1u, __ATOMIC_RELAXED, __HIP_MEMORY_SCOPE_AGENT); }
}
DI void edge_wait(unsigned* ctr, unsigned need) {
    if (threadIdx.x == 0) { unsigned sp = 0;
        while (__hip_atomic_load(ctr, __ATOMIC_RELAXED, __HIP_MEMORY_SCOPE_AGENT) < need) { __builtin_amdgcn_s_sleep(8); if (++sp > (1u << 22)) break; }
        __builtin_amdgcn_fence(__ATOMIC_ACQUIRE, "agent"); asm volatile("s_waitcnt vmcnt(0)" ::: "memory"); }
    __syncthreads();
}
namespace pg8 {
constexpr int BM = 256, BK = 64, HALF = 128, HTB = HALF * BK * 2, STAGE_BYTES = 8 * HTB, NXCD = 8, WGM = 8;
DI int lds_byte(int r, int c) { const int st = (r >> 4) * 2 + (c >> 5), rr = r & 15, cc = c & 31, ob = rr * 64 + cc * 2; return st * 1024 + (ob ^ (((ob >> 9) & 1) << 5)); }
DI void stage_rc(int b, int& R, int& C) { const int st = b / 1024, sb = b % 1024, swz = sb ^ (((sb >> 9) & 1) << 5); R = (st >> 1) * 16 + swz / 64; C = (st & 1) * 32 + (swz % 64) / 2; }
DI int perm32(int rho) { const int n = rho >> 4, i = rho & 15; return 8 * (i >> 2) + 4 * n + (i & 3); }
struct Unit { int pm, pn; };
struct Gemm { const f16* A; const f16* Bt; int M, N, K; };
struct StaticOrder {
    int nM, nN, nwg, G, c;
    DI void init(int M, int N, int G_, int c_) { nM = M / BM; nN = N / BM; nwg = nM * nN; G = G_; c = c_; }
    DI bool next(int i, Unit& u) const {
        const long L = (long)i * G + c; if (L >= nwg) return false;
        int wgid = (int)L; { const int q = nwg / NXCD, r = nwg % NXCD, xcd = wgid % NXCD, off = wgid / NXCD; wgid = (xcd < r ? xcd * (q + 1) : r * (q + 1) + (xcd - r) * q) + off; }
        const int nig = WGM * nN, gid = wgid / nig, fm = gid * WGM, gsz = (nM - fm) < WGM ? (nM - fm) : WGM;
        u.pm = fm + ((wgid % nig) % gsz); u.pn = (wgid % nig) / gsz; return true;
    }
    DI void a_ready(const Unit&) const {}
    DI void done(const Unit&) const {}
};
template <class Epi, class Sched>
DI void gemm_phase(LAS unsigned char* lds, const Gemm g, const Sched& S, const Epi& E) {
    const int tid = ltid(), wid = __builtin_amdgcn_readfirstlane(tid >> 6), lane = tid & 63, wr = wid >> 2, wc = wid & 3, fr = lane & 15, fq = lane >> 4;
    const int K = g.K, nt = K / BK;
    unsigned voffA[2], voffB[2];
#pragma unroll
    for (int i = 0; i < 2; ++i) { int R, C; stage_rc(tid * 16 + i * 8192, R, C); const int Rb = Epi::PERM ? ((R & ~31) + perm32(R & 31)) : R;
        voffA[i] = (unsigned)(R * K + C) * 2u; voffB[i] = (unsigned)(Rb * K + C) * 2u; }
    const size_t kstep = (size_t)(BK * 2);
    const size_t hstep = (size_t)HALF * K * 2;
    const size_t tstep = 2 * hstep;
    const unsigned ldsw = (unsigned)wid * 1024u;
    const int aoff = lds_byte(wr * 64 + fr, fq * 8), boff = lds_byte(wc * 32 + fr, fq * 8);
#define PG8_SA(b, h) (((b) * 2 + (h)) * HTB)
#define PG8_SB(b, h) ((4 + (b) * 2 + (h)) * HTB)
#define PG8_STAGE(bufoff, gbase, voff) do { _Pragma("unroll") for (int _i = 0; _i < 2; ++_i) \
        __builtin_amdgcn_global_load_lds((const unsigned*)((const char*)(gbase) + (voff)[_i]), (LAS unsigned*)(lds + (bufoff) + ldsw + _i * 8192), 16, 0, 0); } while (0)
#define PG8_LDA(dst, b, h) do { _Pragma("unroll") for (int m = 0; m < 4; ++m) _Pragma("unroll") for (int k = 0; k < 2; ++k) dst[m][k] = *(const LAS f16x8*)(lds + PG8_SA(b, h) + aoff + m * 2048 + k * 1024); } while (0)
#define PG8_LDB(dst, b, h) do { _Pragma("unroll") for (int n = 0; n < 2; ++n) _Pragma("unroll") for (int k = 0; k < 2; ++k) dst[n][k] = *(const LAS f16x8*)(lds + PG8_SB(b, h) + boff + n * 2048 + k * 1024); } while (0)
#define PG8_MMA(ai, bj, At, Bt) do { __builtin_amdgcn_s_setprio(1); _Pragma("unroll") for (int m = 0; m < 4; ++m) _Pragma("unroll") for (int n = 0; n < 2; ++n) _Pragma("unroll") for (int k = 0; k < 2; ++k) \
        acc[ai][bj][m][n] = __builtin_amdgcn_mfma_f32_16x16x32_f16(Bt[n][k], At[m][k], acc[ai][bj][m][n], 0, 0, 0); __builtin_amdgcn_s_setprio(0); } while (0)
#define PG8_WAIT_V(n) asm volatile("s_waitcnt vmcnt(" #n ")" ::: "memory")
#define PG8_WAIT_L(n) asm volatile("s_waitcnt lgkmcnt(" #n ")" ::: "memory")
#define PG8_BAR __builtin_amdgcn_s_barrier()
#define PG8_SCHED __builtin_amdgcn_sched_barrier(0)
    Unit cur, nxt; int ui = 0;
    if (!S.next(0, cur)) return;
    f32x4 acc[2][2][4][2];
#pragma unroll
    for (int a = 0; a < 2; ++a)
#pragma unroll
        for (int b = 0; b < 2; ++b)
#pragma unroll
            for (int m = 0; m < 4; ++m)
#pragma unroll
                for (int n = 0; n < 2; ++n) acc[a][b][m][n] = (f32x4){0.f, 0.f, 0.f, 0.f};
    f16x8 At[4][2], B0[2][2], B1[2][2];
    const char* cA = (const char*)g.A + (size_t)cur.pm * tstep; const char* cB = (const char*)g.Bt + (size_t)cur.pn * tstep;
    S.a_ready(cur);
    PG8_STAGE(PG8_SB(0, 0), cB, voffB); PG8_STAGE(PG8_SA(0, 0), cA, voffA); PG8_STAGE(PG8_SB(0, 1), cB + hstep, voffB); PG8_STAGE(PG8_SA(0, 1), cA + hstep, voffA);
    if (wr == 1) PG8_BAR;
    PG8_WAIT_V(4); PG8_BAR;
    PG8_STAGE(PG8_SB(1, 0), cB + kstep, voffB); PG8_STAGE(PG8_SA(1, 0), cA + kstep, voffA); PG8_STAGE(PG8_SB(1, 1), cB + hstep + kstep, voffB);
    PG8_WAIT_V(6); PG8_BAR;
    for (;;) {
        const bool has_next = S.next(ui + 1, nxt);
        const char* nA = has_next ? (const char*)g.A + (size_t)nxt.pm * tstep : cA; const char* nB = has_next ? (const char*)g.Bt + (size_t)nxt.pn * tstep : cB;
        for (int t = 0; t < nt; t += 2) {
            const bool last = (t == nt - 2);
            const char* a1 = cA + (size_t)(t + 1) * kstep;
            const char* a2 = last ? nA : cA + (size_t)(t + 2) * kstep; const char* b2 = last ? nB : cB + (size_t)(t + 2) * kstep;
            const char* a3 = a2 + kstep; const char* b3 = b2 + kstep;
            if (last && has_next) S.a_ready(nxt);
            PG8_LDB(B0, 0, 0); PG8_SCHED; PG8_LDA(At, 0, 0); PG8_STAGE(PG8_SA(1, 1), a1 + hstep, voffA);
            PG8_WAIT_L(8); PG8_BAR; PG8_WAIT_L(0); PG8_MMA(0, 0, At, B0); PG8_BAR; PG8_SCHED;
            PG8_LDB(B1, 0, 1); PG8_STAGE(PG8_SB(0, 0), b2, voffB);
            PG8_BAR; PG8_WAIT_L(0); PG8_MMA(0, 1, At, B1); PG8_BAR;
            PG8_LDA(At, 0, 1); PG8_STAGE(PG8_SA(0, 0), a2, voffA);
            PG8_BAR; PG8_WAIT_L(0); PG8_MMA(1, 0, At, B0); PG8_BAR; PG8_SCHED;
            PG8_STAGE(PG8_SB(0, 1), b2 + hstep, voffB);
            PG8_WAIT_V(6); PG8_BAR; PG8_MMA(1, 1, At, B1); PG8_BAR;
            PG8_LDB(B0, 1, 0); PG8_SCHED; PG8_LDA(At, 1, 0); PG8_STAGE(PG8_SA(0, 1), a2 + hstep, voffA);
            PG8_WAIT_L(8); PG8_BAR; PG8_WAIT_L(0); PG8_MMA(0, 0, At, B0); PG8_BAR; PG8_SCHED;
            PG8_LDB(B1, 1, 1); PG8_STAGE(PG8_SB(1, 0), b3, voffB);
            PG8_BAR; PG8_WAIT_L(0); PG8_MMA(0, 1, At, B1); PG8_BAR;
            PG8_LDA(At, 1, 1); PG8_STAGE(PG8_SA(1, 0), a3, voffA);
            PG8_BAR; PG8_WAIT_L(0); PG8_MMA(1, 0, At, B0); PG8_BAR; PG8_SCHED;
            PG8_STAGE(PG8_SB(1, 1), b3 + hstep, voffB);
            PG8_WAIT_V(6); PG8_BAR; PG8_MMA(1, 1, At, B1); PG8_BAR;
        }
        E(acc, cur, wr, wc, fr, fq);
        if (!has_next) break;
#pragma unroll
        for (int a = 0; a < 2; ++a)
#pragma unroll
            for (int b = 0; b < 2; ++b)
#pragma unroll
                for (int m = 0; m < 4; ++m)
#pragma unroll
                    for (int n = 0; n < 2; ++n) acc[a][b][m][n] = (f32x4){0.f, 0.f, 0.f, 0.f};
        cur = nxt; cA = nA; cB = nB; ++ui;
    }
    PG8_WAIT_V(0);
    if (wr == 0) PG8_BAR;
    PG8_BAR;
#undef PG8_SA
#undef PG8_SB
#undef PG8_STAGE
#undef PG8_LDA
#undef PG8_LDB
#undef PG8_MMA
#undef PG8_WAIT_V
#undef PG8_WAIT_L
#undef PG8_BAR
#undef PG8_SCHED
}
}

struct EpiIn {
    static constexpr bool PERM = true;
    f16* proj; const float* rssp; const float* bias; float* kvout;
    DI void operator()(const f32x4 (&acc)[2][2][4][2], const pg8::Unit& u, int wr, int wc, int fr, int fq) const {
        const int row0 = u.pm * 256 + wr * 64 + fr, colt = wc * 32 + 8 * fq;
        f32x4 bv[2][2];
#pragma unroll
        for (int bj = 0; bj < 2; ++bj)
#pragma unroll
            for (int n = 0; n < 2; ++n) bv[bj][n] = *(const f32x4*)(bias + u.pn * 256 + colt + bj * 128 + 4 * n);
        f16* pt = proj + (size_t)u.pn * SEQ * 256;
#pragma unroll
        for (int ai = 0; ai < 2; ++ai)
#pragma unroll
            for (int m = 0; m < 4; ++m) {
                const int row = row0 + ai * 128 + m * 16;
                const f32x4* rp = (const f32x4*)(rssp + (size_t)row * 16);
                const f32x4 s0 = rp[0], s1 = rp[1], s2 = rp[2], s3 = rp[3];
                const float ss = ((s0[0] + s0[1]) + (s0[2] + s0[3])) + ((s1[0] + s1[1]) + (s1[2] + s1[3])) + ((s2[0] + s2[1]) + (s2[2] + s2[3])) + ((s3[0] + s3[1]) + (s3[2] + s3[3]));
                const float r = rsqrtf(ss * (1.f / 1024.f) + EPS);
#pragma unroll
                for (int bj = 0; bj < 2; ++bj) {
                    const f32x4 v0 = acc[ai][bj][m][0] * r + bv[bj][0], v1 = acc[ai][bj][m][1] * r + bv[bj][1];
                    f16x8 h; h[0] = (f16)v0[0]; h[1] = (f16)v0[1]; h[2] = (f16)v0[2]; h[3] = (f16)v0[3]; h[4] = (f16)v1[0]; h[5] = (f16)v1[1]; h[6] = (f16)v1[2]; h[7] = (f16)v1[3];
                    *(f16x8*)(pt + (size_t)row * 256 + colt + bj * 128) = h;
                    if (u.pn == 12) { float* kp = kvout + (size_t)row * 256 + colt + bj * 128; *(f32x4*)kp = v0; *(f32x4*)(kp + 4) = v1; }
                }
            }
    }
};
struct EpiOut {
    static constexpr bool PERM = false;
    const float* xin; float* xout; const float* gate; f16* a16; const float* gnext; float* rssp;
    DI void operator()(const f32x4 (&acc)[2][2][4][2], const pg8::Unit& u, int wr, int wc, int fr, int fq) const {
        const int row0 = u.pm * 256 + wr * 64 + fr, col0 = u.pn * 256 + wc * 32 + 4 * fq;
        float ss[2][4];
#pragma unroll
        for (int ai = 0; ai < 2; ++ai)
#pragma unroll
            for (int m = 0; m < 4; ++m) ss[ai][m] = 0.f;
#pragma unroll
        for (int bj = 0; bj < 2; ++bj)
#pragma unroll
            for (int n = 0; n < 2; ++n) {
                const int col = col0 + bj * 128 + n * 16;
                const f32x4 gv = *(const f32x4*)(gate + col); f32x4 gn = (f32x4){0.f, 0.f, 0.f, 0.f}; if (a16) gn = *(const f32x4*)(gnext + col);
#pragma unroll
                for (int ai = 0; ai < 2; ++ai)
#pragma unroll
                    for (int m = 0; m < 4; ++m) {
                        const int row = row0 + ai * 128 + m * 16;
                        const f32x4 xv = *(const f32x4*)(xin + (size_t)row * 1024 + col);
                        const f32x4 o = xv + gv * acc[ai][bj][m][n];
                        *(f32x4*)(xout + (size_t)row * 1024 + col) = o;
                        ss[ai][m] += (o[0] * o[0] + o[1] * o[1]) + (o[2] * o[2] + o[3] * o[3]);
                        if (a16) { f16x4 h; h[0] = (f16)(o[0] * gn[0]); h[1] = (f16)(o[1] * gn[1]); h[2] = (f16)(o[2] * gn[2]); h[3] = (f16)(o[3] * gn[3]);
                            *(f16x4*)(a16 + (size_t)row * 1024 + col) = h; }
                    }
                asm volatile("" ::: "memory");
            }
        if (a16) {
#pragma unroll
            for (int ai = 0; ai < 2; ++ai)
#pragma unroll
                for (int m = 0; m < 4; ++m) { float v = ss[ai][m]; v += __shfl_xor(v, 16); v += __shfl_xor(v, 32);
                    if (fq == 0) rssp[(size_t)(row0 + ai * 128 + m * 16) * 16 + u.pn * 4 + wc] = v; }
        }
    }
};

template <int MP  , class AFn, class OFn>
DI void skinny_item(LAS unsigned char* lds, const float* W, int ldw, int n0, int ncols, int M, AFn afn, OFn ofn) {
    const int tid = ltid(), wave = tid >> 6, lane = tid & 63;
    LAS float* As = (LAS float*)lds;
    float acc[MP];
#pragma unroll
    for (int m = 0; m < MP; ++m) acc[m] = 0.f;
    for (int kc = 0; kc < 1024; kc += 512) {
        __syncthreads();
#pragma unroll 4
        for (int m = 0; m < MP; ++m) As[tid * 36 + m] = (m < M) ? afn(m, kc + tid) : 0.f;
        __syncthreads();
        const int kb = wave * 64;
#pragma unroll 8
        for (int kk = 0; kk < 64; ++kk) {
            const float w = (lane < ncols) ? W[(size_t)(kc + kb + kk) * ldw + n0 + lane] : 0.f;
            const float av = As[(kb + kk) * 36 + lane];
#pragma unroll
            for (int m = 0; m < MP; ++m) acc[m] += __builtin_bit_cast(float, __builtin_amdgcn_readlane(__builtin_bit_cast(int, av), m)) * w;
        }
    }
    __syncthreads();
    LAS float* R = (LAS float*)lds;
#pragma unroll
    for (int m = 0; m < MP; ++m) R[(wave * 36 + m) * 64 + lane] = acc[m];
    __syncthreads();
    for (int idx = tid; idx < M * 64; idx += 512) { const int m = idx >> 6, c = idx & 63; float s = 0.f;
#pragma unroll
        for (int w = 0; w < 8; ++w) s += R[(w * 36 + m) * 64 + c];
        if (c < ncols) ofn(m, n0 + c, s); }
    __syncthreads();
}

template <bool F32> struct Raw16 { f32x4 f[4]; f16x8 hv[2];
    DI void ld(const void* p) { if (F32) {
#pragma unroll
            for (int i = 0; i < 4; ++i) f[i] = *(const f32x4*)((const float*)p + 4 * i); } else { hv[0] = *(const f16x8*)p; hv[1] = *(const f16x8*)((const f16*)p + 8); } }
    DI f16x8 get(int i) const { if (F32) { const f32x4 a = f[2 * i], b = f[2 * i + 1]; f16x8 r; r[0] = (f16)a[0]; r[1] = (f16)a[1]; r[2] = (f16)a[2]; r[3] = (f16)a[3]; r[4] = (f16)b[0]; r[5] = (f16)b[1]; r[6] = (f16)b[2]; r[7] = (f16)b[3]; return r; } return hv[i]; } };
template <bool SRC_F32, class ChunkFn>
DI void compress_item(LAS unsigned char* lds, ChunkFn chunkp  , int c0, const f16* w1t, const float* peb, const f16* w2t  , const float* b2, const float* kg, float* out, f16* out16, f16* outT16) {
    typedef typename std::conditional<SRC_F32, float, f16>::type T;
    const int tid = ltid(), wave = tid >> 6, lane = tid & 63, wm = wave >> 2, wq = wave & 3, r = lane & 31, h = lane >> 5;
    LAS f16* As = (LAS f16*)lds;
    LAS f16* Bs = (LAS f16*)(lds + 2 * 18432);
    f32x16 acc[2][2];
#pragma unroll
    for (int a = 0; a < 2; ++a)
#pragma unroll
        for (int b = 0; b < 2; ++b)
#pragma unroll
            for (int i = 0; i < 16; ++i) acc[a][b][i] = 0.f;
    const int am = tid >> 2, aseg = tid & 3, bn = tid >> 1, bseg = tid & 1;
    int ch = c0 + am; ch = ch < 1023 ? ch : 1023;
    const T* asrc = (const T*)chunkp(ch) + aseg * 16;
    const f16* bsrc = w1t + (size_t)(bn & 127) * 2048 + (size_t)(bn >> 7) * 1024 + bseg * 32;
    Raw16<SRC_F32> ra[3]; f16x8 rb[3][4];
#pragma unroll
    for (int i = 0; i < 3; ++i) { ra[i].ld(asrc + i * 256);
#pragma unroll
        for (int j = 0; j < 4; ++j) rb[i][j] = ld_h8(bsrc + i * 64 + 8 * j); }
    __syncthreads();
    *(LAS f16x8*)(As + am * 72 + aseg * 16) = ra[0].get(0); *(LAS f16x8*)(As + am * 72 + aseg * 16 + 8) = ra[0].get(1);
#pragma unroll
    for (int i = 0; i < 4; ++i) *(LAS f16x8*)(Bs + bn * 72 + bseg * 32 + 8 * i) = rb[0][i];
    ra[0].ld(asrc + 3 * 256);
#pragma unroll
    for (int i = 0; i < 4; ++i) rb[0][i] = ld_h8(bsrc + 3 * 64 + 8 * i);
    lds_barrier();
#pragma unroll
    for (int kb = 0; kb < 16; ++kb) {
        const int cur = kb & 1;
        const LAS f16* Ac = As + cur * 9216 + (64 * wm + r) * 72 + 8 * h; const LAS f16* Bc = Bs + cur * 18432 + (64 * wq + r) * 72 + 8 * h;
#pragma unroll
        for (int ks = 0; ks < 4; ++ks) {
            const f16x8 a0 = *(const LAS f16x8*)(Ac + 16 * ks), a1 = *(const LAS f16x8*)(Ac + 32 * 72 + 16 * ks), b0 = *(const LAS f16x8*)(Bc + 16 * ks), b1 = *(const LAS f16x8*)(Bc + 32 * 72 + 16 * ks);
            acc[0][0] = __builtin_amdgcn_mfma_f32_32x32x16_f16(a0, b0, acc[0][0], 0, 0, 0); acc[0][1] = __builtin_amdgcn_mfma_f32_32x32x16_f16(a0, b1, acc[0][1], 0, 0, 0);
            acc[1][0] = __builtin_amdgcn_mfma_f32_32x32x16_f16(a1, b0, acc[1][0], 0, 0, 0); acc[1][1] = __builtin_amdgcn_mfma_f32_32x32x16_f16(a1, b1, acc[1][1], 0, 0, 0);
        }
        if (kb + 1 < 16) { const int nx = cur ^ 1, sl = (kb + 1) % 3;
            *(LAS f16x8*)(As + nx * 9216 + am * 72 + aseg * 16) = ra[sl].get(0); *(LAS f16x8*)(As + nx * 9216 + am * 72 + aseg * 16 + 8) = ra[sl].get(1);
#pragma unroll
            for (int i = 0; i < 4; ++i) *(LAS f16x8*)(Bs + nx * 18432 + bn * 72 + bseg * 32 + 8 * i) = rb[sl][i];
            if (kb + 4 < 16) { ra[sl].ld(asrc + (kb + 4) * 256);
#pragma unroll
                for (int i = 0; i < 4; ++i) rb[sl][i] = ld_h8(bsrc + (kb + 4) * 64 + 8 * i); } }
        lds_barrier();
    }
    LAS float* SL = (LAS float*)lds;
    LAS f16* HS = (LAS f16*)(lds + 65536);
    if (wq >= 2) {
#pragma unroll
        for (int a = 0; a < 2; ++a)
#pragma unroll
            for (int b = 0; b < 2; ++b)
#pragma unroll
                for (int i = 0; i < 16; ++i) SL[(64 * wm + 32 * a + (i & 3) + 8 * (i >> 2) + 4 * h) * 128 + 64 * (wq - 2) + 32 * b + r] = acc[a][b][i];
    }
    __syncthreads();
    if (wq < 2) {
#pragma unroll
        for (int a = 0; a < 2; ++a)
#pragma unroll
            for (int b = 0; b < 2; ++b) { const int f = 64 * wq + 32 * b + r; float pb = 0.f;
#pragma unroll
                for (int p8 = 0; p8 < 8; ++p8) pb += peb[p8 * 128 + f];
#pragma unroll
                for (int i = 0; i < 16; ++i) { const int m = 64 * wm + 32 * a + (i & 3) + 8 * (i >> 2) + 4 * h; const float sv = m < 127 ? SL[(m + 1) * 128 + f] : 0.f;
                    HS[m * 136 + f] = (f16)siluf_(acc[a][b][i] + sv + pb); } }
    }
    __syncthreads();
    {
        const int fr = lane & 15, q = lane >> 4;
        f32x4 o[4];
#pragma unroll
        for (int et = 0; et < 4; ++et) o[et] = (f32x4){0.f, 0.f, 0.f, 0.f};
#pragma unroll
        for (int ks = 0; ks < 4; ++ks) { const f16x8 av = *(const LAS f16x8*)(HS + (16 * wave + fr) * 136 + 32 * ks + 8 * q);
#pragma unroll
            for (int et = 0; et < 4; ++et) o[et] = __builtin_amdgcn_mfma_f32_16x16x32_f16(av, ld_h8(w2t + (size_t)(16 * et + fr) * 128 + 32 * ks + 8 * q), o[et], 0, 0, 0); }
        float bb[4], gg[4];
#pragma unroll
        for (int et = 0; et < 4; ++et) { bb[et] = b2[16 * et + fr]; gg[et] = kg ? kg[16 * et + fr] : 1.f; }
#pragma unroll
        for (int j = 0; j < 4; ++j) {
            const int row = 16 * wave + 4 * q + j, blk = c0 + row; float v[4], ss = 0.f;
#pragma unroll
            for (int et = 0; et < 4; ++et) { v[et] = o[et][j] + bb[et]; ss += v[et] * v[et]; }
            if (kg) { ss += __shfl_xor(ss, 1); ss += __shfl_xor(ss, 2); ss += __shfl_xor(ss, 4); ss += __shfl_xor(ss, 8); const float rn = rsqrtf(ss * (1.f / 64.f) + EPS);
#pragma unroll
                for (int et = 0; et < 4; ++et) v[et] = v[et] * rn * gg[et]; }
            const bool okrow = row < 127 && blk < 1023, wr16 = row < 127 && blk < 1024;
#pragma unroll
            for (int et = 0; et < 4; ++et) { const float x = okrow ? v[et] : 0.f; const int e = 16 * et + fr;
                if (out && okrow) out[(size_t)blk * 64 + e] = x;
                if (out16 && wr16) out16[(size_t)blk * 64 + e] = (f16)x;
                if (outT16 && wr16) outT16[(size_t)e * 1024 + blk] = (f16)x; }
        }
    }
    __syncthreads();
}

struct PromptKV {
    const f16 *ks, *vs, *kw, *vw;
    DI void krow_sel(int pos, float (&k)[64]) const { const f16* p = ks + (size_t)pos * 64;
#pragma unroll
        for (int i = 0; i < 8; ++i) { const f16x8 v = ld_h8(p + i * 8);
#pragma unroll
            for (int j = 0; j < 8; ++j) k[i * 8 + j] = (float)v[j]; } }
    DI float v_sel(int pos, int d) const { return (float)vs[(size_t)pos * 64 + d]; }
    DI void krow_win(int pos, float (&k)[64]) const { const f16* p = kw + (size_t)pos * 64;
#pragma unroll
        for (int i = 0; i < 8; ++i) { const f16x8 v = ld_h8(p + i * 8);
#pragma unroll
            for (int j = 0; j < 8; ++j) k[i * 8 + j] = (float)v[j]; } }
    DI float v_win(int pos, int d) const { return (float)vw[(size_t)pos * 64 + d]; }
};
struct SampleKV {
    const float* ckv; const int* pt; const float* cwin; const float* nks; const float* nvs; const float* nkw; const float* nvw;
    DI const float* prow(int pos, int slot) const { return ckv + ((size_t)pt[pos >> 7] * 128 + (pos & 127)) * 256 + slot * 64; }
    DI void ld64(const float* p, float (&k)[64]) const {
#pragma unroll
        for (int i = 0; i < 16; ++i) { const f32x4 v = *(const f32x4*)(p + i * 4); k[i * 4] = v[0]; k[i * 4 + 1] = v[1]; k[i * 4 + 2] = v[2]; k[i * 4 + 3] = v[3]; } }
    DI void krow_sel(int pos, float (&k)[64]) const { ld64(pos < PAST ? prow(pos, 2) : nks, k); }
    DI float v_sel(int pos, int d) const { return pos < PAST ? prow(pos, 3)[d] : nvs[d]; }
    DI void krow_win(int pos, float (&k)[64]) const { ld64(pos < PAST ? cwin + (size_t)(pos - (PAST - 512)) * 128 : nkw, k); }
    DI float v_win(int pos, int d) const { return pos < PAST ? cwin[(size_t)(pos - (PAST - 512)) * 128 + 64 + d] : nvw[d]; }
};
template <class KV>
DI void nsa_token(LAS float* wl, int qpos, const float* KC, const float* VC, const KV& kv, const float* gates  , float (&o)[4]) {
    const int lane = ltid() & 63;
    LAS float* sc = wl; LAS float* qs = wl + 4096; LAS int* sel = (LAS int*)(wl + 4096 + 256);
    const int cur = qpos >> 6;
    const int ncv = qpos >= 31 ? ((qpos - 31) >> 4) + 1 : 0;
    float oc[4] = {0.f, 0.f, 0.f, 0.f}, os[4] = {0.f, 0.f, 0.f, 0.f}, ow[4] = {0.f, 0.f, 0.f, 0.f};
    {
        float mx[4] = {-3e38f, -3e38f, -3e38f, -3e38f};
        for (int c = lane; c < ncv; c += 64) {
            asm volatile("" ::: "memory");
            float s[4] = {0.f, 0.f, 0.f, 0.f}; const float* kp = KC + (size_t)c * 64;
#pragma unroll
            for (int d4 = 0; d4 < 16; ++d4) { const f32x4 kvv = *(const f32x4*)(kp + d4 * 4);
#pragma unroll
                for (int j = 0; j < 4; ++j) { const f32x4 q = *(const LAS f32x4*)(qs + (d4 * 4 + j) * 4); s[0] += q[0] * kvv[j]; s[1] += q[1] * kvv[j]; s[2] += q[2] * kvv[j]; s[3] += q[3] * kvv[j]; } }
#pragma unroll
            for (int hh = 0; hh < 4; ++hh) { s[hh] *= 0.125f; sc[hh * 1024 + c] = s[hh]; mx[hh] = fmaxf(mx[hh], s[hh]); }
        }
        float inv[4];
#pragma unroll
        for (int hh = 0; hh < 4; ++hh) { mx[hh] = wmaxf(mx[hh]); float sm = 0.f; for (int c = lane; c < ncv; c += 64) { const float e = __expf(sc[hh * 1024 + c] - mx[hh]); sc[hh * 1024 + c] = e; sm += e; } sm = wsum(sm); inv[hh] = ncv > 0 ? 1.f / sm : 0.f; }
        for (int c = lane; c < ncv; c += 64) {
#pragma unroll
            for (int hh = 0; hh < 4; ++hh) sc[hh * 1024 + c] *= inv[hh]; }
        __builtin_amdgcn_wave_barrier();
        for (int c = 0; c < ncv; ++c) { const float v = VC[(size_t)c * 64 + lane];
#pragma unroll
            for (int hh = 0; hh < 4; ++hh) oc[hh] += sc[hh * 1024 + c] * v; }
    }
    const int nsel = (cur + 1) < 16 ? (cur + 1) : 16;
    {
        float scv[5];
#pragma unroll
        for (int i = 0; i < 5; ++i) {
            const int j = lane + 64 * i; float v = -3e38f;
            if (j <= cur) {
                if (j == 0 || j == cur || j == cur - 1) v = 3e38f;
                else { float a = 0.f;
#pragma unroll
                    for (int o5 = -1; o5 < 4; ++o5) { const int c = 4 * j + o5; if (c >= 0 && c < ncv) { const float p = (sc[c] + sc[1024 + c]) + (sc[2048 + c] + sc[3072 + c]); a += (o5 == -1 || o5 == 3) ? 0.5f * p : p; } }
                    v = a; }
            }
            scv[i] = v;
        }
        for (int k = 0; k < nsel; ++k) {
            float bv = scv[0]; int bi = lane;
#pragma unroll
            for (int i = 1; i < 5; ++i) if (scv[i] > bv) { bv = scv[i]; bi = lane + 64 * i; }
#pragma unroll
            for (int off = 32; off > 0; off >>= 1) { const float ov = __shfl_xor(bv, off); const int oi = __shfl_xor(bi, off); if (ov > bv || (ov == bv && oi < bi)) { bv = ov; bi = oi; } }
            if (lane == 0) sel[k] = bi;
#pragma unroll
            for (int i = 0; i < 5; ++i) if (lane + 64 * i == bi) scv[i] = -3e38f;
        }
        __builtin_amdgcn_wave_barrier();
    }
    {
        float mx[4] = {-3e38f, -3e38f, -3e38f, -3e38f};
        for (int k = 0; k < nsel; ++k) {
            asm volatile("" ::: "memory");
            const int pos = sel[k] * 64 + lane; float s[4] = {-1e30f, -1e30f, -1e30f, -1e30f};
            if (pos <= qpos) { float kr[64]; kv.krow_sel(pos, kr); s[0] = s[1] = s[2] = s[3] = 0.f;
#pragma unroll
                for (int d = 0; d < 64; ++d) { const f32x4 q = *(const LAS f32x4*)(qs + d * 4); s[0] += q[0] * kr[d]; s[1] += q[1] * kr[d]; s[2] += q[2] * kr[d]; s[3] += q[3] * kr[d]; }
#pragma unroll
                for (int hh = 0; hh < 4; ++hh) s[hh] *= 0.125f; }
#pragma unroll
            for (int hh = 0; hh < 4; ++hh) { sc[hh * 1024 + k * 64 + lane] = s[hh]; mx[hh] = fmaxf(mx[hh], s[hh]); }
        }
        float inv[4];
#pragma unroll
        for (int hh = 0; hh < 4; ++hh) { mx[hh] = wmaxf(mx[hh]); float sm = 0.f; for (int k = 0; k < nsel; ++k) { const float sv = sc[hh * 1024 + k * 64 + lane]; const float e = sv > -1e29f ? __expf(sv - mx[hh]) : 0.f; sc[hh * 1024 + k * 64 + lane] = e; sm += e; } sm = wsum(sm); inv[hh] = 1.f / sm; }
        __builtin_amdgcn_wave_barrier();
        for (int k = 0; k < nsel; ++k) { const int p0 = sel[k] * 64; int nk = qpos - p0 + 1; nk = nk > 64 ? 64 : nk;
            for (int kk = 0; kk < nk; ++kk) { const float v = kv.v_sel(p0 + kk, lane);
#pragma unroll
                for (int hh = 0; hh < 4; ++hh) os[hh] += sc[hh * 1024 + k * 64 + kk] * v; } }
#pragma unroll
        for (int hh = 0; hh < 4; ++hh) os[hh] *= inv[hh];
        __builtin_amdgcn_wave_barrier();
    }
    {
        const int lo = qpos - 512 > 0 ? qpos - 512 : 0, nw = qpos - lo + 1;
        float mx[4] = {-3e38f, -3e38f, -3e38f, -3e38f};
        for (int i = lane; i < nw; i += 64) { asm volatile("" ::: "memory"); float kr[64]; kv.krow_win(lo + i, kr); float s[4] = {0.f, 0.f, 0.f, 0.f};
#pragma unroll
            for (int d = 0; d < 64; ++d) { const f32x4 q = *(const LAS f32x4*)(qs + d * 4); s[0] += q[0] * kr[d]; s[1] += q[1] * kr[d]; s[2] += q[2] * kr[d]; s[3] += q[3] * kr[d]; }
#pragma unroll
            for (int hh = 0; hh < 4; ++hh) { s[hh] *= 0.125f; sc[hh * 1024 + i] = s[hh]; mx[hh] = fmaxf(mx[hh], s[hh]); } }
        float inv[4];
#pragma unroll
        for (int hh = 0; hh < 4; ++hh) { mx[hh] = wmaxf(mx[hh]); float sm = 0.f; for (int i = lane; i < nw; i += 64) { const float e = __expf(sc[hh * 1024 + i] - mx[hh]); sc[hh * 1024 + i] = e; sm += e; } sm = wsum(sm); inv[hh] = 1.f / sm; }
        __builtin_amdgcn_wave_barrier();
        for (int i = 0; i < nw; ++i) { const float v = kv.v_win(lo + i, lane);
#pragma unroll
            for (int hh = 0; hh < 4; ++hh) ow[hh] += sc[hh * 1024 + i] * v; }
#pragma unroll
        for (int hh = 0; hh < 4; ++hh) ow[hh] *= inv[hh];
        __builtin_amdgcn_wave_barrier();
    }
#pragma unroll
    for (int hh = 0; hh < 4; ++hh) o[hh] = gates[hh * 3] * oc[hh] + gates[hh * 3 + 1] * os[hh] + gates[hh * 3 + 2] * ow[hh];
}

template <class LF, class SF>
DI void tr64(LAS unsigned char* lds, LF lf, SF sf) {
    LAS float* T = (LAS float*)lds;
    const int tid = ltid();
    __syncthreads();
#pragma unroll
    for (int e8 = 0; e8 < 8; ++e8) { const int e = tid + 512 * e8, kk = e >> 6, nn = e & 63; T[kk * 65 + nn] = lf(kk, nn); }
    __syncthreads();
#pragma unroll
    for (int e8 = 0; e8 < 8; ++e8) { const int e = tid + 512 * e8, nn = e >> 6, kk = e & 63; sf(nn, kk, (f16)T[kk * 65 + nn]); }
}

typedef const Args __attribute__((address_space(4)))* ArgP;
struct Ctx { ArgP ap; LAS unsigned char* lds; unsigned char* ws; float* out; int tid, lane, wave, bid, G; };
DI Ctx mkctx(LAS unsigned char* lds) {
    Ctx c; const char __attribute__((address_space(4)))* kp = (const char __attribute__((address_space(4)))*)__builtin_amdgcn_kernarg_segment_ptr();
    asm volatile("" : "+s"(kp));
    c.ap = (ArgP)kp; c.lds = lds; c.ws = c.ap->ws; c.out = c.ap->out;
    int tid = threadIdx.x; asm volatile("" : "+v"(tid));
    c.tid = tid; c.lane = tid & 63; c.wave = __builtin_amdgcn_readfirstlane(tid >> 6); c.bid = blockIdx.x; c.G = gridDim.x;
    return c;
}
#define INP(i) ((const float*)c.ap->in[i])
#define WSF(off) ((float*)(c.ws + (off)))
#define WSH(off) ((f16*)(c.ws + (off)))

DI void ph_prologue(LAS unsigned char* lds_) {
    const Ctx c = mkctx(lds_); LAS unsigned char* lds = c.lds; const int tid = c.tid, bid = c.bid, G = c.G;
    const float* c_p = INP(I_CP); const float* c_s = INP(I_CS); const float* w_ada = INP(I_WADA); const float* b_ada = INP(I_BADA);
    const float* w_in = INP(I_WIN); const float* w_out = INP(I_WOUT); const float* w1 = INP(I_W1);
    float* ADA = WSF(WS_ADA); float* BIAS = WSF(WS_BIAS); float* PEB = WSF(WS_PEB); f16* WTIN = WSH(WS_WTIN); f16* WTOUT = WSH(WS_WTOUT); f16* W1T = WSH(WS_W1T);
    constexpr int N_ADA = 96, N_WTIN = 1920, N_WTOUT = 512, N_W1T = 256, N_PEB = 32, N_W2T = 8, N_ALL = N_ADA + N_WTIN + N_WTOUT + N_W1T + N_PEB + N_W2T + 1;
    constexpr int XA = 1;
    const bool reb = G == 256; const int n_mine = reb ? (bid < N_ADA ? 1 + XA : (N_ALL - N_ADA - XA * N_ADA - (bid - N_ADA) + 159) / 160) : (N_ALL - bid + G - 1) / G;
    for (int k = 0; k < n_mine; ++k) {
        const int it = !reb ? bid + k * G : (bid < N_ADA ? (k == 0 ? bid : N_ADA + XA * bid + (k - 1)) : N_ADA + XA * N_ADA + (bid - N_ADA) + 160 * k);
        int i = it;
        if (i < N_ADA) { const int l = i / 48, n0 = (i % 48) * 64;
            skinny_item<36>(lds, w_ada + (size_t)l * 1024 * 3072, 3072, n0, 64, 33,
                [&](int m, int k) { return siluf_(m < 32 ? c_s[m * 1024 + k] : c_p[k]); },
                [&](int m, int n, float v) { ADA[((size_t)l * 33 + m) * 3072 + n] = v + b_ada[l * 3072 + n]; });
            continue; }
        i -= N_ADA;
        if (i < N_WTIN) { const int l = i / 960, r = i % 960, n0 = (r / 16) * 64, k0 = (r % 16) * 64; const float* src = w_in + (size_t)l * 1024 * DIN; f16* dst = WTIN + (size_t)l * NPD * 1024;
            tr64(lds, [&](int kk, int nn) { const int sc = src_col(n0 + nn); return sc >= 0 ? src[(size_t)(k0 + kk) * DIN + sc] : 0.f; },
                      [&](int nn, int kk, f16 v) { dst[(size_t)(n0 + nn) * 1024 + k0 + kk] = v; });
            continue; }
        i -= N_WTIN;
        if (i < N_WTOUT) { const int l = i / 256, r = i % 256, n0 = (r / 16) * 64, k0 = (r % 16) * 64; const float* src = w_out + (size_t)l * 1024 * 1024; f16* dst = WTOUT + (size_t)l * 1024 * 1024;
            tr64(lds, [&](int kk, int nn) { return src[(size_t)(k0 + kk) * 1024 + n0 + nn]; },
                      [&](int nn, int kk, f16 v) { dst[(size_t)(n0 + nn) * 1024 + k0 + kk] = v; });
            continue; }
        i -= N_WTOUT;
        if (i < N_W1T) { const int ls = i / 64, r = i % 64, k0 = (r / 2) * 64, n0 = (r % 2) * 64; const float* src = w1 + (size_t)ls * 2048 * 128; f16* dst = W1T + (size_t)ls * 128 * 2048;
            tr64(lds, [&](int kk, int nn) { return src[(size_t)(k0 + kk) * 128 + n0 + nn]; },
                      [&](int nn, int kk, f16 v) { dst[(size_t)(n0 + nn) * 2048 + k0 + kk] = v; });
            continue; }
        i -= N_W1T;
        if (i < N_PEB) { const int ls = i >> 3, ks8 = i & 7; const float* pe = INP(I_PE) + (size_t)ls * 2048 + ks8 * 256; const float* w = w1 + ((size_t)ls * 2048 + ks8 * 256) * 128; const float* b1 = INP(I_B1) + ls * 128;
            LAS float* R = (LAS float*)lds; const int f = tid & 127, kq = tid >> 7; float sacc = 0.f;
            __syncthreads();
#pragma unroll 16
            for (int k = kq * 64; k < kq * 64 + 64; ++k) sacc += pe[k] * w[(size_t)k * 128 + f];
            R[kq * 128 + f] = sacc; __syncthreads();
            if (tid < 128) WSF(WS_PEBP)[(ls * 8 + ks8) * 128 + tid] = (ks8 == 0 ? b1[tid] : 0.f) + (R[tid] + R[128 + tid]) + (R[256 + tid] + R[384 + tid]);
            __syncthreads();
            continue; }
        i -= N_PEB;
        if (i < N_W2T) { const int ls = i >> 1, f0 = (i & 1) * 64; const float* src = INP(I_W2) + (size_t)ls * 128 * 64; f16* dst = WSH(WS_W2T) + (size_t)ls * 64 * 128;
            tr64(lds, [&](int kk, int nn) { return src[(size_t)(f0 + kk) * 64 + nn]; },
                      [&](int nn, int kk, f16 v) { dst[(size_t)nn * 128 + f0 + kk] = v; });
            continue; }
        for (int e = tid; e < 2 * NPD; e += 512) BIAS[e] = 0.f;
    }
}

DI void ph_sample_compress(LAS unsigned char* lds_) {
    const Ctx c = mkctx(lds_);
    const float* w2 = INP(I_W2); const float* b2 = INP(I_B2); const float* k_g = INP(I_KG); const float* cache_kv = INP(I_CKV); const int* page_table = (const int*)c.ap->in[I_PT];
    f16* W1T = WSH(WS_W1T); float* PEB = WSF(WS_PEBP); float* KCS = WSF(WS_KCS); float* VCS = WSF(WS_VCS);
    for (int it = c.bid; it < 1152; it += c.G) {
        const int grp = it % 9, st_ = it / 9, slot = st_ & 1, b = (st_ >> 1) & 31, l = st_ >> 6;
        const float* ckv = cache_kv + (size_t)l * NPOOL * 128 * 256; const int* pt = page_table + b * 128;
        compress_item<true>(c.lds, [&](int ch) { return (const void*)(ckv + ((size_t)pt[ch >> 3] * 128 + (ch & 7) * 16) * 256 + slot * 64); }, grp * 127,
                            W1T + (size_t)(l * 2 + slot) * 128 * 2048, PEB + (l * 2 + slot) * 1024, WSH(WS_W2T) + (size_t)(l * 2 + slot) * 64 * 128, b2 + (l * 2 + slot) * 64,
                            slot == 0 ? k_g + l * 192 : nullptr, (slot == 0 ? KCS : VCS) + (size_t)(l * NB + b) * 1024 * 64, nullptr, nullptr);
    }
}
DI void ph_prep(LAS unsigned char* lds_) {
    const Ctx c = mkctx(lds_); const int tid = c.tid, lane = c.lane, wave = c.wave, bid = c.bid, G = c.G;
    float* ADA = WSF(WS_ADA); float* BIAS = WSF(WS_BIAS);
    {
        const f16* WTIN = WSH(WS_WTIN);
        const bool lite = G == 256;
        const int pb = lite ? bid - 128 : bid, pG = lite ? 128 : G;
        if (pb >= 0)
        for (int col = pb * 8 + wave; col < 2 * NPD; col += pG * 8) { const int l = col / NPD; const float* sh = ADA + ((size_t)l * 33 + 32) * 3072 + lane * 16; const f16* wp = WTIN + (size_t)col * 1024 + lane * 16;
            const f16x8 w0 = ld_h8(wp), w1 = ld_h8(wp + 8); float acc = 0.f;
#pragma unroll
            for (int i = 0; i < 8; ++i) acc += sh[i] * (float)w0[i] + sh[8 + i] * (float)w1[i];
            acc = wsum(acc); if (lane == 0) BIAS[col] = acc; }
    }
    const float* ng = INP(I_NG);
    if (bid == 0) { float* GNX = WSF(WS_GNX); const float* sc1 = ADA + (size_t)(33 + 32) * 3072 + 1024;
        for (int k = tid; k < 1024; k += 512) GNX[k] = ng[1024 + k] * (1.f + sc1[k]); }
    const float* ada_p = ADA + (size_t)32 * 3072; const float* x_p = INP(I_XP); f16* A16 = WSH(WS_A16); float* RSSP = WSF(WS_RSSP);
    float gp[16];
#pragma unroll
    for (int i = 0; i < 4; ++i) { const f32x4 g4 = *(const f32x4*)(ng + i * 256 + lane * 4), s4 = *(const f32x4*)(ada_p + 1024 + i * 256 + lane * 4);
#pragma unroll
        for (int j = 0; j < 4; ++j) gp[i * 4 + j] = g4[j] * (1.f + s4[j]); }
    const bool lite2 = G == 256; const int pb2 = lite2 ? bid - 128 : bid, pG2 = lite2 ? 128 : G;
    if (pb2 >= 0)
    for (int row = pb2 * 8 + wave; row < SEQ; row += pG2 * 8) {
        const float* xr = x_p + (size_t)row * 1024; float ss = 0.f;
#pragma unroll
        for (int i = 0; i < 4; ++i) { const f32x4 v = *(const f32x4*)(xr + i * 256 + lane * 4); ss += (v[0] * v[0] + v[1] * v[1]) + (v[2] * v[2] + v[3] * v[3]);
            f16x4 h; h[0] = (f16)(v[0] * gp[i * 4]); h[1] = (f16)(v[1] * gp[i * 4 + 1]); h[2] = (f16)(v[2] * gp[i * 4 + 2]); h[3] = (f16)(v[3] * gp[i * 4 + 3]);
            *(f16x4*)(A16 + (size_t)row * 1024 + i * 256 + lane * 4) = h; }
        ss = wsum(ss);
        if (lane < 16) RSSP[(size_t)row * 16 + lane] = lane == 0 ? ss : 0.f;
    }
}

template <int NT  , class OFn>
DI void sample_gemm_item(LAS unsigned char* lds, const f16* Bt, int n0, OFn ofn) {
    constexpr int KW = 8 / NT, KL = 1024 / KW;
    const int tid = ltid(), wave = tid >> 6, lane = tid & 63, wn = wave % NT, wk = wave / NT, r = lane & 31, h = lane >> 5;
    const LAS f16* Ah = (const LAS f16*)lds + r * 1032 + wk * KL + 8 * h; const f16* bp = Bt + (size_t)(n0 + 32 * wn + r) * 1024 + wk * KL + 8 * h;
    f32x16 acc;
#pragma unroll
    for (int i = 0; i < 16; ++i) acc[i] = 0.f;
#pragma unroll 8
    for (int st = 0; st < KL / 16; ++st) acc = __builtin_amdgcn_mfma_f32_32x32x16_f16(*(const LAS f16x8*)(Ah + 16 * st), ld_h8(bp + 16 * st), acc, 0, 0, 0);
    LAS float* RED = (LAS float*)(lds + 67584);
#pragma unroll
    for (int i = 0; i < 16; ++i) RED[(wk * 32 + (i & 3) + 8 * (i >> 2) + 4 * h) * (32 * NT) + 32 * wn + r] = acc[i];
    __syncthreads();
    for (int e = tid; e < 1024 * NT; e += 512) { float v = 0.f;
#pragma unroll
        for (int w = 0; w < KW; ++w) v += RED[w * 1024 * NT + e];
        ofn(e / (32 * NT), n0 + e % (32 * NT), v); }
    __syncthreads();
}
DI void ph_inproj(LAS unsigned char* lds_, int l) {
    const Ctx c = mkctx(lds_);
    pg8::Gemm g{WSH(WS_A16), WSH(WS_WTIN) + (size_t)l * NPD * 1024, SEQ, NPD, 1024}; pg8::StaticOrder S; S.init(SEQ, NPD, c.G, c.bid);
    EpiIn E{WSH(WS_PROJ), WSF(WS_RSSP), WSF(WS_BIAS) + l * NPD, c.out + O_KVP + (size_t)l * SEQ * 256};
    pg8::gemm_phase<EpiIn, pg8::StaticOrder>(c.lds, g, S, E);
    __syncthreads();
}
DI void ph_hsample(LAS unsigned char* lds_, int l) {
    const Ctx c = mkctx(lds_); const int lane = c.lane;
    if (c.bid >= 4) return;
    const int m = c.bid * 8 + c.wave;
    const float* xr = (l == 0 ? INP(I_XS) : WSF(WS_XS1)) + (size_t)m * 1024; const float* ad = WSF(WS_ADA) + ((size_t)l * 33 + m) * 3072; const float* ng = INP(I_NG) + l * 1024; f16* hs = WSH(WS_HS16) + (size_t)m * 1024;
    f32x4 xv[4]; float ss = 0.f;
#pragma unroll
    for (int i = 0; i < 4; ++i) { xv[i] = *(const f32x4*)(xr + i * 256 + lane * 4); ss += (xv[i][0] * xv[i][0] + xv[i][1] * xv[i][1]) + (xv[i][2] * xv[i][2] + xv[i][3] * xv[i][3]); }
    const float rn = rsqrtf(wsum(ss) * (1.f / 1024.f) + EPS);
#pragma unroll
    for (int i = 0; i < 4; ++i) { const int k = i * 256 + lane * 4; const f32x4 g = *(const f32x4*)(ng + k), sc = *(const f32x4*)(ad + 1024 + k), sh = *(const f32x4*)(ad + k); f16x4 hv;
#pragma unroll
        for (int j = 0; j < 4; ++j) hv[j] = (f16)(xv[i][j] * rn * g[j] * (1.f + sc[j]) + sh[j]);
        *(f16x4*)(hs + k) = hv; }
}
DI void ph_inproj_sample(LAS unsigned char* lds_, int l) {
    const Ctx c = mkctx(lds_); const int tid = c.tid;
    const int it = c.bid - (c.G - 64);
    if (it < 0 || it >= 60) return;
    float* PROJS = WSF(WS_PROJS); const f16* HS = WSH(WS_HS16); LAS f16* Ah = (LAS f16*)c.lds;
    __syncthreads();
#pragma unroll
    for (int i = 0; i < 8; ++i) { const int e = (tid + 512 * i) * 8; *(LAS f16x8*)(Ah + (e >> 10) * 1032 + (e & 1023)) = ld_h8(HS + e); }
    __syncthreads();
    sample_gemm_item<2>(c.lds, WSH(WS_WTIN) + (size_t)l * NPD * 1024, it * 64, [&](int m, int n, float v) { PROJS[m * NPD + n] = v; });
}

#define PT(t) (P + (size_t)(t) * SEQ * 256)
DI void ph_ssd_local(LAS unsigned char* lds_, int l) {
    const Ctx c = mkctx(lds_); LAS unsigned char* lds = c.lds; const int tid = c.tid, lane = c.lane, wave = c.wave;
    const f16* P = WSH(WS_PROJ); f16* ACT = WSH(WS_ACT); float* YD = WSF(WS_YD); float* CST = WSF(WS_CST); float* ACS = WSF(WS_ACS); float* CDEC = WSF(WS_CDEC); float* out = c.out;
    const float* dtb = INP(I_DTB) + l * 4; const float* alog = INP(I_ALOG) + l * 4; const float* cw = INP(I_BCW) + l * 4 * 768; const float* cb = INP(I_BCB) + l * 768;
    LAS f16* Bm = (LAS f16*)lds; LAS f16* BT = (LAS f16*)(lds + 34816); LAS f16* Cm = (LAS f16*)(lds + 69632); LAS f16* XT = (LAS f16*)(lds + 104448);
    LAS float* acs = (LAS float*)(lds + 139264); LAS float* dtl = acs + 256; LAS f16* te16 = (LAS f16*)(dtl + 256);
    for (int it = c.bid; it < 256; it += c.G) {
        const int ch_ = it >> 1, g = it & 1, t0 = ch_ * 128;
        __syncthreads();
        if (tid < 256) { const int hh = tid >> 7, lt = tid & 127, hd = 2 * g + hh; const float raw = (float)PT(13)[(size_t)(t0 + lt) * 256 + 128 + hd];
            const float dt = softplusf_(raw + dtb[hd]); dtl[hh * 128 + lt] = dt; acs[hh * 128 + lt] = dt * (-__expf(alog[hd])); }
        __syncthreads();
        if (tid == 0 || tid == 64) { const int hh = tid >> 6; float sacc = 0.f; for (int i = 0; i < 128; ++i) { sacc += acs[hh * 128 + i]; acs[hh * 128 + i] = sacc; } }
        __syncthreads();
        if (tid < 256) { const int hh = tid >> 7, lt = tid & 127, hd = 2 * g + hh; const float av = acs[hh * 128 + lt], ae = acs[hh * 128 + 127];
            te16[hh * 128 + lt] = (f16)__expf(ae - av); ACS[(size_t)(t0 + lt) * 4 + hd] = av; if (lt == 127) CDEC[ch_ * 4 + hd] = __expf(ae); }
#pragma unroll 3
        for (int e = tid; e < 128 * 48; e += 512) {
            const int lt = (e >> 2) & 127, cg = (e >> 9) * 4 + (e & 3), reg = cg >> 4, c8 = (cg & 15) * 8, t = t0 + lt, col = 128 * g + c8, ch = reg * 256 + col;
            const f16* src = PT(5 + reg) + col; float y[8]; f16x8 rawt;
#pragma unroll
            for (int i = 0; i < 8; ++i) y[i] = cb[ch + i];
#pragma unroll
            for (int k = 0; k < 4; ++k) { const int tt = t - 3 + k; f16x8 v; if (tt >= 0) v = ld_h8(src + (size_t)tt * 256); else {
#pragma unroll
                    for (int i = 0; i < 8; ++i) v[i] = (f16)0.f; }
                if (k == 3) rawt = v;
#pragma unroll
                for (int i = 0; i < 8; ++i) y[i] += cw[k * 768 + ch + i] * (float)v[i]; }
            f16x8 act;
#pragma unroll
            for (int i = 0; i < 8; ++i) { y[i] = siluf_(y[i]); act[i] = (f16)y[i]; }
            *(f16x8*)(ACT + (size_t)t * 768 + ch) = act;
            if (reg == 0) { const int hh = c8 >> 6; const float sdt = dtl[hh * 128 + lt] * 64.f;
#pragma unroll
                for (int i = 0; i < 8; ++i) XT[(c8 + i) * 136 + lt] = (f16)(y[i] * sdt); }
            else if (reg == 1) { *(LAS f16x8*)(Bm + lt * 136 + c8) = act;
#pragma unroll
                for (int i = 0; i < 8; ++i) BT[(c8 + i) * 136 + lt] = act[i]; }
            else *(LAS f16x8*)(Cm + lt * 136 + c8) = act;
            if (t >= SEQ - 3) { float* so = out + O_BCP + (size_t)l * 2304 + (t - (SEQ - 3)) * 768 + ch;
#pragma unroll
                for (int i = 0; i < 8; ++i) so[i] = (float)rawt[i]; }
        }
        __syncthreads();
        const int fr = lane & 15, q = lane >> 4, w = wave;
        f32x4 gt[8];
#pragma unroll
        for (int mt = 0; mt < 8; ++mt) { gt[mt] = (f32x4){0.f, 0.f, 0.f, 0.f};
            if (mt <= w) {
#pragma unroll
                for (int ks = 0; ks < 4; ++ks) { const f16x8 av = *(const LAS f16x8*)(Bm + (16 * mt + fr) * 136 + 32 * ks + 8 * q), bv = *(const LAS f16x8*)(Cm + (16 * w + fr) * 136 + 32 * ks + 8 * q);
                    gt[mt] = __builtin_amdgcn_mfma_f32_16x16x32_f16(av, bv, gt[mt], 0, 0, 0); } } }
#pragma unroll
        for (int hh = 0; hh < 2; ++hh) {
            const int lrow = 16 * w + fr; const float al = acs[hh * 128 + lrow];
            f32x4 ya[4];
#pragma unroll
            for (int pt = 0; pt < 4; ++pt) ya[pt] = (f32x4){0.f, 0.f, 0.f, 0.f};
#pragma unroll
            for (int k2 = 0; k2 < 4; ++k2) {
                if (2 * k2 <= w) {
                    f16x8 af;
#pragma unroll
                    for (int j = 0; j < 8; ++j) { const int m = 32 * k2 + (j < 4 ? 4 * q + j : 16 + 4 * q + (j - 4)); const float gv = j < 4 ? gt[2 * k2][j] : gt[2 * k2 + 1][j - 4];
                        af[j] = (f16)(m <= lrow ? gv * __expf(al - acs[hh * 128 + m]) : 0.f); }
#pragma unroll
                    for (int pt = 0; pt < 4; ++pt) { const LAS f16* xp = XT + (hh * 64 + 16 * pt + fr) * 136 + 32 * k2 + 4 * q; const f16x4 b0 = *(const LAS f16x4*)xp, b1 = *(const LAS f16x4*)(xp + 16);
                        f16x8 bf; bf[0] = b0[0]; bf[1] = b0[1]; bf[2] = b0[2]; bf[3] = b0[3]; bf[4] = b1[0]; bf[5] = b1[1]; bf[6] = b1[2]; bf[7] = b1[3];
                        ya[pt] = __builtin_amdgcn_mfma_f32_16x16x32_f16(af, bf, ya[pt], 0, 0, 0); }
                }
            }
#pragma unroll
            for (int pt = 0; pt < 4; ++pt)
#pragma unroll
                for (int j = 0; j < 4; ++j) YD[(size_t)(t0 + 16 * w + 4 * q + j) * 256 + (2 * g + hh) * 64 + 16 * pt + fr] = ya[pt][j] * (1.f / 64.f);
#pragma unroll
            for (int pt = 0; pt < 4; ++pt) { f32x4 sa = (f32x4){0.f, 0.f, 0.f, 0.f};
#pragma unroll
                for (int ks = 0; ks < 4; ++ks) { const f16x8 xv = *(const LAS f16x8*)(XT + (hh * 64 + 16 * pt + fr) * 136 + 32 * ks + 8 * q), tv = *(const LAS f16x8*)(te16 + hh * 128 + 32 * ks + 8 * q);
                    const f16x8 bv = *(const LAS f16x8*)(BT + (16 * w + fr) * 136 + 32 * ks + 8 * q);
                    sa = __builtin_amdgcn_mfma_f32_16x16x32_f16(xv * tv, bv, sa, 0, 0, 0); }
#pragma unroll
                for (int j = 0; j < 4; ++j) CST[((size_t)(ch_ * 4 + 2 * g + hh) * 64 + 16 * pt + 4 * q + j) * 128 + 16 * w + fr] = sa[j] * (1.f / 64.f); }
        }
    }
    __syncthreads();
}
DI void ph_mix_a(LAS unsigned char* lds_, int l) {
    const Ctx c = mkctx(lds_); const int tid = c.tid;
    const f16* P = WSH(WS_PROJ); f16* Y16 = WSH(WS_Y16); float* out = c.out; const float* scw = INP(I_SCW) + l * 768;
    for (int it = c.bid; it < 256; it += c.G) {
        for (int e = tid; e < 64 * 32; e += 512) { const int t = it * 64 + (e >> 5), c0 = (e & 31) * 8; float u[3][8];
#pragma unroll
            for (int k = 0; k < 3; ++k) { const int tt = t - 2 + k;
                if (tt >= 0) { const f16x8 h = ld_h8(PT(0) + (size_t)tt * 256 + c0), cc = ld_h8(PT(2) + (size_t)tt * 256 + c0);
#pragma unroll
                    for (int i = 0; i < 8; ++i) u[k][i] = (float)cc[i] * (float)h[i]; }
                else {
#pragma unroll
                    for (int i = 0; i < 8; ++i) u[k][i] = 0.f; } }
            const f16x8 bb = ld_h8(PT(1) + (size_t)t * 256 + c0), gg = ld_h8(PT(3) + (size_t)t * 256 + c0); f16x8 o;
#pragma unroll
            for (int i = 0; i < 8; ++i) { const float y = scw[c0 + i] * u[0][i] + scw[256 + c0 + i] * u[1][i] + scw[512 + c0 + i] * u[2][i]; o[i] = (f16)(siluf_((float)gg[i]) * (float)bb[i] * y); }
            *(f16x8*)(Y16 + (size_t)t * 1024 + c0) = o;
            if (t >= SEQ - 2) { float* so = out + O_SCP + (size_t)l * 512 + (t - (SEQ - 2)) * 256 + c0;
#pragma unroll
                for (int i = 0; i < 8; ++i) so[i] = u[2][i]; }
        }
    }
}
DI void ph_mix_c(LAS unsigned char* lds_, int l) {
    const Ctx c = mkctx(lds_); const int tid = c.tid, lane = c.lane, wave = c.wave;
    const f16* P = WSH(WS_PROJ); f16* Y16 = WSH(WS_Y16); float* out = c.out;
    const float* cfw = INP(I_CFW) + l * 31 * 256; const float* cfb = INP(I_CFB) + l * 256; const float* lng = INP(I_LNG) + l * 256; const float* lnb = INP(I_LNB) + l * 256;
    LAS float* GL = (LAS float*)c.lds;
    f32x4 wt[31];
#pragma unroll
    for (int k = 0; k < 31; ++k) wt[k] = *(const f32x4*)(cfw + k * 256 + lane * 4);
    const f32x4 bias4 = *(const f32x4*)(cfb + lane * 4), g4 = *(const f32x4*)(lng + lane * 4), b4 = *(const f32x4*)(lnb + lane * 4);
    for (int it = c.bid; it < 256; it += c.G) {
        __syncthreads();
        for (int e = tid; e < 94 * 32; e += 512) { const int rr = e >> 5, c0 = (e & 31) * 8, t = it * 64 - 30 + rr; f32x4 g0 = (f32x4){0.f, 0.f, 0.f, 0.f}, g1 = g0;
            if (t >= 0) { const f16x8 ga = ld_h8(PT(8) + (size_t)t * 256 + c0), gb = ld_h8(PT(9) + (size_t)t * 256 + c0);
#pragma unroll
                for (int i = 0; i < 4; ++i) { g0[i] = (float)ga[i] * sigmoidf_((float)gb[i]); g1[i] = (float)ga[4 + i] * sigmoidf_((float)gb[4 + i]); }
                if (t >= SEQ - 30) { float* so = out + O_CFP + (size_t)l * 7680 + (t - (SEQ - 30)) * 256 + c0; *(f32x4*)so = g0; *(f32x4*)(so + 4) = g1; } }
            *(LAS f32x4*)(GL + rr * 256 + c0) = g0; *(LAS f32x4*)(GL + rr * 256 + c0 + 4) = g1; }
        __syncthreads();
        {
            const int cc = lane * 4, tb = wave * 8;
            f32x4 u[8];
#pragma unroll
            for (int j = 0; j < 8; ++j) u[j] = bias4;
#pragma unroll
            for (int r = 0; r < 38; ++r) { const f32x4 gv = *(const LAS f32x4*)(GL + (tb + r) * 256 + cc);
#pragma unroll
                for (int j = 0; j < 8; ++j) if (r - j >= 0 && r - j <= 30) u[j] += wt[r - j] * gv; }
#pragma unroll
            for (int j = 0; j < 8; ++j) { const int t = it * 64 + tb + j;
                const float mean = wsum((u[j][0] + u[j][1]) + (u[j][2] + u[j][3])) * (1.f / 256.f); const f32x4 d = u[j] - mean;
                const float var = wsum((d[0] * d[0] + d[1] * d[1]) + (d[2] * d[2] + d[3] * d[3])) * (1.f / 256.f); const float rs = rsqrtf(var + EPS);
                const f16x4 cg = *(const f16x4*)(PT(10) + (size_t)t * 256 + cc); f16x4 o;
#pragma unroll
                for (int i = 0; i < 4; ++i) o[i] = (f16)(siluf_((float)cg[i]) * siluf_(d[i] * rs * g4[i] + b4[i]));
                *(f16x4*)(Y16 + (size_t)t * 1024 + 512 + cc) = o; }
        }
    }
    __syncthreads();
}
DI void ph_mix_d(LAS unsigned char* lds_, int l) {
    const Ctx c = mkctx(lds_); const int tid = c.tid, lane = c.lane, wave = c.wave;
    const f16* P = WSH(WS_PROJ); float* out = c.out; float* kvp_out = out + O_KVP + (size_t)l * SEQ * 256;
    f16* Q16 = WSH(WS_Q16); f16* KS16 = WSH(WS_KS16); f16* KW16 = WSH(WS_KW16); f16* VST16 = WSH(WS_VST16); f16* VWT16 = WSH(WS_VWT16); float* GATES = WSF(WS_GATES);
    const int d4 = (lane & 15) * 4, v4 = lane >> 4;
    const f32x4 qg = *(const f32x4*)(INP(I_QG) + l * 64 + d4), kg1 = *(const f32x4*)(INP(I_KG) + l * 192 + 64 + d4), kg2 = *(const f32x4*)(INP(I_KG) + l * 192 + 128 + d4);
    LAS f16* VSs = (LAS f16*)c.lds; LAS f16* VWs = VSs + 64 * 68;
    if (c.bid < 18 && c.G > 36) return;
    for (int it = c.bid - 18 >= 0 && c.G > 36 ? c.bid - 18 : c.bid; it < 256; it += (c.G > 36 ? c.G - 18 : c.G)) {
        __syncthreads();
        for (int vi = wave * 4 + v4; vi < 256; vi += 32) { const size_t off = (size_t)(it * 64) * 256 + (size_t)vi * 64 + d4; const f16x4 x = *(const f16x4*)(PT(11) + off);
            const float a0 = (float)x[0], a1 = (float)x[1], a2 = (float)x[2], a3 = (float)x[3]; const float rn = rsqrtf(sum16((a0 * a0 + a1 * a1) + (a2 * a2 + a3 * a3)) * (1.f / 64.f) + EPS);
            f16x4 y; y[0] = (f16)(a0 * rn * qg[0]); y[1] = (f16)(a1 * rn * qg[1]); y[2] = (f16)(a2 * rn * qg[2]); y[3] = (f16)(a3 * rn * qg[3]); *(f16x4*)(Q16 + off) = y; }
        for (int tl = wave * 4 + v4; tl < 64; tl += 32) { const int t = it * 64 + tl;
            { const f16x4 x = *(const f16x4*)(PT(12) + (size_t)t * 256 + 128 + d4), vv = *(const f16x4*)(PT(12) + (size_t)t * 256 + 192 + d4);
                const float a0 = (float)x[0], a1 = (float)x[1], a2 = (float)x[2], a3 = (float)x[3]; const float rn = rsqrtf(sum16((a0 * a0 + a1 * a1) + (a2 * a2 + a3 * a3)) * (1.f / 64.f) + EPS);
                const f32x4 kn = (f32x4){a0 * rn * kg1[0], a1 * rn * kg1[1], a2 * rn * kg1[2], a3 * rn * kg1[3]}; *(f32x4*)(kvp_out + (size_t)t * 256 + 128 + d4) = kn;
                f16x4 y; y[0] = (f16)kn[0]; y[1] = (f16)kn[1]; y[2] = (f16)kn[2]; y[3] = (f16)kn[3]; *(f16x4*)(KS16 + (size_t)t * 64 + d4) = y; *(LAS f16x4*)(VSs + tl * 68 + d4) = vv; }
            { const f16x4 x = *(const f16x4*)(PT(13) + (size_t)t * 256 + d4), vv = *(const f16x4*)(PT(13) + (size_t)t * 256 + 64 + d4);
                const float a0 = (float)x[0], a1 = (float)x[1], a2 = (float)x[2], a3 = (float)x[3]; const float rn = rsqrtf(sum16((a0 * a0 + a1 * a1) + (a2 * a2 + a3 * a3)) * (1.f / 64.f) + EPS);
                const f32x4 kn = (f32x4){a0 * rn * kg2[0], a1 * rn * kg2[1], a2 * rn * kg2[2], a3 * rn * kg2[3]};
                f16x4 y; y[0] = (f16)kn[0]; y[1] = (f16)kn[1]; y[2] = (f16)kn[2]; y[3] = (f16)kn[3]; *(f16x4*)(KW16 + (size_t)t * 64 + d4) = y; *(LAS f16x4*)(VWs + tl * 68 + d4) = vv;
                if (t >= SEQ - 512) { float* wo = out + O_WINP + (size_t)l * 512 * 128 + (size_t)(t - (SEQ - 512)) * 128; *(f32x4*)(wo + d4) = kn; *(f32x4*)(wo + 64 + d4) = (f32x4){(float)vv[0], (float)vv[1], (float)vv[2], (float)vv[3]}; } }
        }
        for (int e = tid; e < 64 * 12; e += 512) { const int tl = e / 12, gi = e % 12; GATES[(size_t)(it * 64 + tl) * 12 + gi] = sigmoidf_((float)PT(13)[(size_t)(it * 64 + tl) * 256 + 132 + gi]); }
        __syncthreads();
        { const int d = tid >> 3, k8 = (tid & 7) * 8; f16x8 a, b;
#pragma unroll
            for (int i = 0; i < 8; ++i) { a[i] = VSs[(k8 + i) * 68 + d]; b[i] = VWs[(k8 + i) * 68 + d]; }
            *(f16x8*)(VST16 + (size_t)it * 4096 + d * 64 + k8) = a; *(f16x8*)(VWT16 + (size_t)it * 4096 + d * 64 + k8) = b; }
    }
    __syncthreads();
}
DI void ph_mix_cmp(LAS unsigned char* lds_, int l) {
    const Ctx c = mkctx(lds_);
    const f16* P = WSH(WS_PROJ); const float* w2 = INP(I_W2); const float* b2 = INP(I_B2); const float* k_g = INP(I_KG); f16* W1T = WSH(WS_W1T); float* PEB = WSF(WS_PEBP);
    for (int it = c.bid; it < 18; it += c.G) { const int slot = it / 9, grp = it % 9; const f16* src = PT(12) + slot * 64;
        compress_item<false>(c.lds, [&](int ch) { return (const void*)(src + (size_t)ch * 16 * 256); }, grp * 127,
                             W1T + (size_t)(l * 2 + slot) * 128 * 2048, PEB + (l * 2 + slot) * 1024, WSH(WS_W2T) + (size_t)(l * 2 + slot) * 64 * 128, b2 + (l * 2 + slot) * 64,
                             slot == 0 ? k_g + l * 192 : nullptr, nullptr, slot == 0 ? WSH(WS_KC16) : nullptr, slot == 0 ? nullptr : WSH(WS_VCT16)); }
}
#undef PT
template <int N>
DI void blk_reduce(LAS float* red, LAS float* bc, float (&v)[N], bool is_max, int wave, int lane) {
#pragma unroll
    for (int i = 0; i < N; ++i) v[i] = is_max ? wmaxf(v[i]) : wsum(v[i]);
    __syncthreads();
    if (lane == 0) {
#pragma unroll
        for (int i = 0; i < N; ++i) red[wave * 12 + i] = v[i]; }
    __syncthreads();
    if (wave == 0 && lane < N) { float r = red[lane]; for (int w = 1; w < 8; ++w) r = is_max ? fmaxf(r, red[w * 12 + lane]) : r + red[w * 12 + lane]; bc[lane] = r; }
    __syncthreads();
#pragma unroll
    for (int i = 0; i < N; ++i) v[i] = bc[i];
}
DI void nsa_sample_block(LAS float* wl, const float* KC, const float* VC, const SampleKV& kv, const LAS float* gsm, const float* dgp, float* ysd, int tid, int lane, int wave) {
    LAS float* sc = wl; LAS float* qs = wl + 10496; LAS float* PSL = qs + 256; LAS float* red = PSL + 1024; LAS float* bc = red + 96; LAS int* sel = (LAS int*)(bc + 16); LAS float* part = bc + 32;
    constexpr int NCV = 1023, CUR = PAST >> 6;
    float mv[8], sv[8];
#pragma unroll
    for (int i = 0; i < 8; ++i) mv[i] = -3e38f;
    for (int cidx = tid; cidx < NCV; cidx += 512) {
        asm volatile("" ::: "memory");
        float kr[64]; kv.ld64(KC + (size_t)cidx * 64, kr); float s4[4] = {0.f, 0.f, 0.f, 0.f};
#pragma unroll
        for (int d = 0; d < 64; ++d) { const f32x4 qv = *(const LAS f32x4*)(qs + d * 4); s4[0] += qv[0] * kr[d]; s4[1] += qv[1] * kr[d]; s4[2] += qv[2] * kr[d]; s4[3] += qv[3] * kr[d]; }
#pragma unroll
        for (int hh = 0; hh < 4; ++hh) { s4[hh] *= 0.125f; sc[hh * 2624 + cidx] = s4[hh]; mv[hh] = fmaxf(mv[hh], s4[hh]); }
    }
    for (int i = tid; i < 513; i += 512) {
        asm volatile("" ::: "memory");
        float kr[64]; kv.krow_win(PAST - 512 + i, kr); float s4[4] = {0.f, 0.f, 0.f, 0.f};
#pragma unroll
        for (int d = 0; d < 64; ++d) { const f32x4 qv = *(const LAS f32x4*)(qs + d * 4); s4[0] += qv[0] * kr[d]; s4[1] += qv[1] * kr[d]; s4[2] += qv[2] * kr[d]; s4[3] += qv[3] * kr[d]; }
#pragma unroll
        for (int hh = 0; hh < 4; ++hh) { s4[hh] *= 0.125f; sc[hh * 2624 + 2048 + i] = s4[hh]; mv[4 + hh] = fmaxf(mv[4 + hh], s4[hh]); }
    }
    blk_reduce<8>(red, bc, mv, true, wave, lane);
#pragma unroll
    for (int i = 0; i < 8; ++i) sv[i] = 0.f;
    for (int cidx = tid; cidx < NCV; cidx += 512) {
#pragma unroll
        for (int hh = 0; hh < 4; ++hh) { const float e = __expf(sc[hh * 2624 + cidx] - mv[hh]); sc[hh * 2624 + cidx] = e; sv[hh] += e; } }
    for (int i = tid; i < 513; i += 512) {
#pragma unroll
        for (int hh = 0; hh < 4; ++hh) { const float e = __expf(sc[hh * 2624 + 2048 + i] - mv[4 + hh]); sc[hh * 2624 + 2048 + i] = e; sv[4 + hh] += e; } }
    blk_reduce<8>(red, bc, sv, false, wave, lane);
    float invc[4], invw[4];
#pragma unroll
    for (int hh = 0; hh < 4; ++hh) { invc[hh] = 1.f / sv[hh]; invw[hh] = 1.f / sv[4 + hh]; }
    for (int cidx = tid; cidx < 1024; cidx += 512) PSL[cidx] = cidx < NCV ? (sc[cidx] * invc[0] + sc[2624 + cidx] * invc[1]) + (sc[2 * 2624 + cidx] * invc[2] + sc[3 * 2624 + cidx] * invc[3]) : 0.f;
    __syncthreads();
    if (wave == 0) {
        float scv[5];
#pragma unroll
        for (int i = 0; i < 5; ++i) { const int j = lane + 64 * i; float v = -3e38f;
            if (j <= CUR) { if (j == 0 || j == CUR || j == CUR - 1) v = 3e38f; else { float a = 0.f;
#pragma unroll
                    for (int o5 = -1; o5 < 4; ++o5) { const int cc = 4 * j + o5; if (cc >= 0 && cc < NCV) a += (o5 == -1 || o5 == 3) ? 0.5f * PSL[cc] : PSL[cc]; }
                    v = a; } }
            scv[i] = v; }
        for (int k = 0; k < 16; ++k) {
            float bv = scv[0]; int bi = lane;
#pragma unroll
            for (int i = 1; i < 5; ++i) if (scv[i] > bv) { bv = scv[i]; bi = lane + 64 * i; }
#pragma unroll
            for (int off = 32; off > 0; off >>= 1) { const float ov = __shfl_xor(bv, off); const int oi = __shfl_xor(bi, off); if (ov > bv || (ov == bv && oi < bi)) { bv = ov; bi = oi; } }
            if (lane == 0) sel[k] = bi;
#pragma unroll
            for (int i = 0; i < 5; ++i) if (lane + 64 * i == bi) scv[i] = -3e38f;
        }
    }
    __syncthreads();
    float ms[4], ss4[4];
#pragma unroll
    for (int i = 0; i < 4; ++i) ms[i] = -3e38f;
    for (int idx = tid; idx < 1024; idx += 512) {
        asm volatile("" ::: "memory");
        const int pos = sel[idx >> 6] * 64 + (idx & 63); float s4[4] = {-1e30f, -1e30f, -1e30f, -1e30f};
        if (pos <= PAST) { float kr[64]; kv.krow_sel(pos, kr); s4[0] = s4[1] = s4[2] = s4[3] = 0.f;
#pragma unroll
            for (int d = 0; d < 64; ++d) { const f32x4 qv = *(const LAS f32x4*)(qs + d * 4); s4[0] += qv[0] * kr[d]; s4[1] += qv[1] * kr[d]; s4[2] += qv[2] * kr[d]; s4[3] += qv[3] * kr[d]; }
#pragma unroll
            for (int hh = 0; hh < 4; ++hh) s4[hh] *= 0.125f; }
#pragma unroll
        for (int hh = 0; hh < 4; ++hh) { sc[hh * 2624 + 1024 + idx] = s4[hh]; ms[hh] = fmaxf(ms[hh], s4[hh]); }
    }
    blk_reduce<4>(red, bc, ms, true, wave, lane);
#pragma unroll
    for (int i = 0; i < 4; ++i) ss4[i] = 0.f;
    for (int idx = tid; idx < 1024; idx += 512) {
#pragma unroll
        for (int hh = 0; hh < 4; ++hh) { const float x = sc[hh * 2624 + 1024 + idx]; const float e = x > -1e29f ? __expf(x - ms[hh]) : 0.f; sc[hh * 2624 + 1024 + idx] = e; ss4[hh] += e; } }
    blk_reduce<4>(red, bc, ss4, false, wave, lane);
    float invs[4];
#pragma unroll
    for (int hh = 0; hh < 4; ++hh) invs[hh] = 1.f / ss4[hh];
    float oc[4] = {0.f, 0.f, 0.f, 0.f}, os[4] = {0.f, 0.f, 0.f, 0.f}, ow[4] = {0.f, 0.f, 0.f, 0.f};
    { const int c1 = (wave + 1) * 128 < NCV ? (wave + 1) * 128 : NCV;
#pragma unroll 16
        for (int cidx = wave * 128; cidx < c1; ++cidx) { const float v = VC[(size_t)cidx * 64 + lane];
#pragma unroll
            for (int hh = 0; hh < 4; ++hh) oc[hh] += sc[hh * 2624 + cidx] * v; } }
    for (int kb = wave * 2; kb < wave * 2 + 2; ++kb) { const int p0 = sel[kb] * 64; int nk = PAST - p0 + 1; nk = nk > 64 ? 64 : nk;
        const float* vbase = p0 < PAST ? kv.prow(p0, 3) + lane : kv.nvs + lane;
#pragma unroll 16
        for (int kk = 0; kk < nk; ++kk) { const float v = vbase[(size_t)kk * 256];
#pragma unroll
            for (int hh = 0; hh < 4; ++hh) os[hh] += sc[hh * 2624 + 1024 + kb * 64 + kk] * v; } }
    { const int i1 = (wave + 1) * 65 < 513 ? (wave + 1) * 65 : 513;
#pragma unroll 13
        for (int i = wave * 65; i < i1; ++i) { const float v = kv.v_win(PAST - 512 + i, lane);
#pragma unroll
            for (int hh = 0; hh < 4; ++hh) ow[hh] += sc[hh * 2624 + 2048 + i] * v; } }
#pragma unroll
    for (int hh = 0; hh < 4; ++hh) { part[(wave * 12 + hh) * 64 + lane] = oc[hh] * invc[hh]; part[(wave * 12 + 4 + hh) * 64 + lane] = os[hh] * invs[hh]; part[(wave * 12 + 8 + hh) * 64 + lane] = ow[hh] * invw[hh]; }
    __syncthreads();
    if (tid < 256) { const int hh = tid >> 6, d = tid & 63; float a = 0.f, b = 0.f, cc = 0.f;
        for (int w = 0; w < 8; ++w) { a += part[(w * 12 + hh) * 64 + d]; b += part[(w * 12 + 4 + hh) * 64 + d]; cc += part[(w * 12 + 8 + hh) * 64 + d]; }
        ysd[tid] = siluf_(dgp[tid]) * (gsm[hh * 3] * a + gsm[hh * 3 + 1] * b + gsm[hh * 3 + 2] * cc); }
}
DI void ph_mix_sample(LAS unsigned char* lds_, int l) {
    const Ctx c = mkctx(lds_); const int tid = c.tid, lane = c.lane, wave = c.wave;
    const int b = c.bid - (c.G - 32);
    if (b < 0 || b >= 32) return;
    float* out = c.out;
    __syncthreads();
    const float* pr = WSF(WS_PROJS) + (size_t)b * NPD;
    LAS float* act = (LAS float*)c.lds;
    LAS float* red = act + 768;
    LAS float* ybl = red + 16;
    LAS float* sdt = ybl + 256;
    LAS float* nrow = sdt + 8;
    LAS float* gsm = nrow + 256;
    LAS float* wl = gsm + 16;
    float* ys = WSF(WS_YS) + (size_t)b * 1024;
    if (tid < 256) { const int ch = tid; const float* st = INP(I_SSC) + ((size_t)(l * NB + b) * 2) * 256; const float* scw = INP(I_SCW) + l * 768;
        const float u = pr[512 + ch] * pr[ch], p0 = st[ch], p1 = st[256 + ch]; const float y = scw[ch] * p0 + scw[256 + ch] * p1 + scw[512 + ch] * u;
        ys[ch] = siluf_(pr[768 + ch]) * pr[256 + ch] * y; float* so = out + O_SCS + ((size_t)(l * NB + b) * 2) * 256; so[ch] = p1; so[256 + ch] = u; }
    float uc = 0.f;
    if (tid >= 256) { const int ch = tid - 256; const float* st = INP(I_SCF) + (size_t)(l * NB + b) * 7680; const float* cfw = INP(I_CFW) + l * 31 * 256;
        const float glu = pr[2048 + ch] * sigmoidf_(pr[2304 + ch]); float u = INP(I_CFB)[l * 256 + ch]; float* so = out + O_CFS + (size_t)(l * NB + b) * 7680;
        for (int k = 0; k < 30; ++k) { const float pv = st[k * 256 + ch]; u += cfw[k * 256 + ch] * pv; if (k > 0) so[(k - 1) * 256 + ch] = pv; }
        u += cfw[30 * 256 + ch] * glu; so[29 * 256 + ch] = glu; uc = u; }
    { const float s1 = wsum(tid >= 256 ? uc : 0.f); if (lane == 0) red[wave] = s1; }
    __syncthreads();
    const float cmean = (red[4] + red[5] + red[6] + red[7]) * (1.f / 256.f);
    __syncthreads();
    { const float d = uc - cmean; const float s2 = wsum(tid >= 256 ? d * d : 0.f); if (lane == 0) red[wave] = s2; }
    __syncthreads();
    if (tid >= 256) { const int ch = tid - 256; const float var = (red[4] + red[5] + red[6] + red[7]) * (1.f / 256.f);
        const float ln = (uc - cmean) * rsqrtf(var + EPS) * INP(I_LNG)[l * 256 + ch] + INP(I_LNB)[l * 256 + ch];
        ys[512 + ch] = siluf_(pr[2560 + ch]) * siluf_(ln); }
    { const float* st = INP(I_SBC) + (size_t)(l * NB + b) * 2304; const float* cw = INP(I_BCW) + l * 4 * 768; const float* cb = INP(I_BCB) + l * 768; float* so = out + O_BCS + (size_t)(l * NB + b) * 2304;
        for (int ch = tid; ch < 768; ch += 512) { const float raw = pr[1280 + ch], p0 = st[ch], p1 = st[768 + ch], p2 = st[1536 + ch];
            act[ch] = siluf_(cb[ch] + cw[ch] * p0 + cw[768 + ch] * p1 + cw[1536 + ch] * p2 + cw[2304 + ch] * raw); so[ch] = p1; so[768 + ch] = p2; so[1536 + ch] = raw; }
        if (tid < 4) { const float dt = softplusf_(pr[3456 + tid] + INP(I_DTB)[l * 4 + tid]); sdt[tid] = dt; sdt[4 + tid] = __expf(dt * (-__expf(INP(I_ALOG)[l * 4 + tid]))); } }
    __syncthreads();
    { const float* h0 = INP(I_SSM) + (size_t)(l * NB + b) * 32768; float* ho = out + O_HS + (size_t)(l * NB + b) * 32768; const float* Dp = INP(I_SD) + l * 4;
        for (int row = wave; row < 256; row += 8) { const int hd = row >> 6, gq = hd >> 1; const float dt = sdt[hd], dA = sdt[4 + hd], xv = act[row]; float y = 0.f;
#pragma unroll
            for (int s2 = 0; s2 < 2; ++s2) { const int sidx = lane + 64 * s2; const float hn = dA * h0[row * 128 + sidx] + dt * xv * act[256 + gq * 128 + sidx]; ho[row * 128 + sidx] = hn; y += hn * act[512 + gq * 128 + sidx]; }
            y = wsum(y);
            if (lane == 0) ybl[row] = (y + Dp[hd] * xv) * siluf_(pr[1024 + row]); } }
    __syncthreads();
    { const float v = tid < 256 ? ybl[tid] : 0.f; const float s2 = wsum(v * v); if (lane == 0) red[8 + wave] = s2; }
    __syncthreads();
    if (tid < 256) { const float ss = red[8] + red[9] + red[10] + red[11]; ys[256 + tid] = ybl[tid] * rsqrtf(ss * (1.f / 256.f) + EPS) * INP(I_SNG)[l * 256 + tid]; }
    const float* qg = INP(I_QG) + l * 64; const float* kg = INP(I_KG) + l * 192;
    LAS float* qs = wl + 10496;
    if (wave < 4) { const float v = pr[2816 + wave * 64 + lane]; const float ss = wsum(v * v); qs[lane * 4 + wave] = v * rsqrtf(ss * (1.f / 64.f) + EPS) * qg[lane]; }
    else if (wave == 4) { const float v = pr[3072 + 128 + lane]; const float ss = wsum(v * v); nrow[lane] = v * rsqrtf(ss * (1.f / 64.f) + EPS) * kg[64 + lane]; nrow[64 + lane] = pr[3072 + 192 + lane]; }
    else if (wave == 5) { const float v = pr[3072 + 256 + lane]; const float ss = wsum(v * v); nrow[128 + lane] = v * rsqrtf(ss * (1.f / 64.f) + EPS) * kg[128 + lane]; nrow[192 + lane] = pr[3072 + 320 + lane]; }
    else if (wave == 6) { if (lane < 12) gsm[lane] = sigmoidf_(pr[3460 + lane]); }
    __syncthreads();
    const float* cache_win = INP(I_CWIN) + (size_t)(l * NB + b) * 512 * 128;
    { float* ko = out + O_KVS + (size_t)(l * NB + b) * 256;
        if (tid < 128) ko[tid] = pr[3072 + tid]; else if (tid < 192) ko[tid] = nrow[tid - 128]; else if (tid < 256) ko[tid] = nrow[64 + tid - 192];
        float* wo = out + O_WINS + (size_t)(l * NB + b) * 512 * 128;
        for (int e = tid; e < 511 * 128; e += 512) wo[e] = cache_win[128 + e];
        if (tid < 64) wo[511 * 128 + tid] = nrow[128 + tid]; else if (tid < 128) wo[511 * 128 + tid] = nrow[192 + tid - 64]; }
    float* nrp = WSF(WS_NRG) + (size_t)(l * NB + b) * 256;
    if (tid < 256) nrp[tid] = nrow[tid];
    asm volatile("s_waitcnt vmcnt(0)" ::: "memory");
    __syncthreads();
    {
        SampleKV kv{INP(I_CKV) + (size_t)l * NPOOL * 128 * 256, (const int*)c.ap->in[I_PT] + b * 128, cache_win, nrp, nrp + 64, nrp + 128, nrp + 192};
        nsa_sample_block(wl, WSF(WS_KCS) + (size_t)(l * NB + b) * 1024 * 64, WSF(WS_VCS) + (size_t)(l * NB + b) * 1024 * 64, kv, gsm, pr + 3584, ys + 768, tid, lane, wave);
    }
    edge_publish((unsigned*)(c.ws + WS_CTL + 18432) + l * 64);
    __syncthreads();
}
DI void ph_scan(LAS unsigned char* lds_, int l) {
    const Ctx c = mkctx(lds_);
    if (c.bid >= 64) return;
    const float* CST = WSF(WS_CST); float* HPV = WSF(WS_HPV); const float* CDEC = WSF(WS_CDEC);
    const int e = c.bid * 512 + c.tid, hd = e >> 13; float hc = 0.f;
#pragma unroll 8
    for (int ch = 0; ch < 128; ++ch) { const float sv = CST[(size_t)ch * 32768 + e]; HPV[(size_t)ch * 32768 + e] = hc; hc = CDEC[ch * 4 + hd] * hc + sv; }
    c.out[O_HP + (size_t)l * 32768 + e] = hc;
    edge_publish((unsigned*)(c.ws + WS_CTL + 17408) + l * 64);
}
DI f16x8 pack_p(const f32x4& a, const f32x4& b) { f16x8 r; r[0] = (f16)a[0]; r[1] = (f16)a[1]; r[2] = (f16)a[2]; r[3] = (f16)a[3]; r[4] = (f16)b[0]; r[5] = (f16)b[1]; r[6] = (f16)b[2]; r[7] = (f16)b[3]; return r; }
DI f16x8 ld_vt(const f16* p) { const f16x4 a = *(const f16x4*)p, b = *(const f16x4*)(p + 16); f16x8 r; r[0] = a[0]; r[1] = a[1]; r[2] = a[2]; r[3] = a[3]; r[4] = b[0]; r[5] = b[1]; r[6] = b[2]; r[7] = b[3]; return r; }
constexpr int NT_PSEL = 0  , NT_STG = 32768  , NT_STG_SZ = 18432 + 17408,
              NT_RING = 0  , NT_MASK = 131072  , NT_VB = NT_MASK + 1088  , NT_END = NT_VB + 1088;
static_assert(NT_STG + 2 * NT_STG_SZ <= NT_MASK, "nsa tile LDS map");
static_assert(NT_END <= MISC_OFF, "nsa tile LDS map");
struct StgRegs { f16x8 k0, k1, v0, v1; };
template <bool WITH_V, class KSrc, class VSrc>
DI void stg_load(StgRegs& rg, int ch, int tid, const KSrc& ksrc, const VSrc& vsrc) {
    const f16* kp = ksrc(ch, tid >> 2) + (tid & 3) * 16; rg.k0 = ld_h8(kp); rg.k1 = ld_h8(kp + 8);
    if (WITH_V) { const f16* vp = vsrc(ch, tid >> 3, tid & 7); rg.v0 = ld_h8(vp); rg.v1 = ld_h8(vp + 8); }
}
template <bool WITH_V>
DI void stg_store(const StgRegs& rg, LAS unsigned char* buf, int tid) {
    LAS f16* kb = (LAS f16*)buf + (tid >> 2) * 72 + (tid & 3) * 16; *(LAS f16x8*)kb = rg.k0; *(LAS f16x8*)(kb + 8) = rg.k1;
    if (WITH_V) { LAS f16* vb = (LAS f16*)(buf + 18432) + (tid >> 3) * 136 + (tid & 7) * 16; *(LAS f16x8*)vb = rg.v0; *(LAS f16x8*)(vb + 8) = rg.v1; }
}
template <bool WITH_V, class KSrc, class VSrc, class Body>
DI void stream_chunks(LAS unsigned char* stg, int nchunk, int tid, const KSrc& ksrc, const VSrc& vsrc, Body body) {
    if (nchunk <= 0) return;
    const int last = nchunk - 1;
    StgRegs rg;
    stg_load<WITH_V>(rg, 0, tid, ksrc, vsrc);
    __syncthreads();
    stg_store<WITH_V>(rg, stg, tid); stg_load<WITH_V>(rg, 1 < last ? 1 : last, tid, ksrc, vsrc);
    lds_barrier();
#pragma nounroll
    for (int ch = 0; ch < nchunk; ++ch) {
        body(ch, stg + (ch & 1) * NT_STG_SZ);
        stg_store<WITH_V>(rg, stg + ((ch + 1) & 1) * NT_STG_SZ, tid); stg_load<WITH_V>(rg, ch + 2 < last ? ch + 2 : last, tid, ksrc, vsrc);
        lds_barrier();
    }
}
DI f16x8 lds_vt(const LAS f16* p) { const f16x4 a = *(const LAS f16x4*)p, b = *(const LAS f16x4*)(p + 16); f16x8 r; r[0] = a[0]; r[1] = a[1]; r[2] = a[2]; r[3] = a[3]; r[4] = b[0]; r[5] = b[1]; r[6] = b[2]; r[7] = b[3]; return r; }
DI f32x4 qk_tile(const LAS f16* kb, int kt, int fr, int q, const f16x8 (&qf)[2]) {
    const LAS f16* kp = kb + (16 * kt + fr) * 72 + 8 * q; f32x4 sa = (f32x4){0.f, 0.f, 0.f, 0.f};
    sa = __builtin_amdgcn_mfma_f32_16x16x32_f16(*(const LAS f16x8*)kp, qf[0], sa, 0, 0, 0); return __builtin_amdgcn_mfma_f32_16x16x32_f16(*(const LAS f16x8*)(kp + 32), qf[1], sa, 0, 0, 0);
}
constexpr float NSA_L2E = 1.44269504f, NSA_C1 = 0.125f * NSA_L2E;
DI float ex2(float x) { return __builtin_amdgcn_exp2f(x); }
template <class Pred>
DI f16x8 pv_step(const LAS f16* kb, const LAS f16* vb, int st, int fr, int q, const f16x8 (&qf)[2], f32x4 (&o)[4], f32x4 (&e2)[2], float nb, bool masked, Pred pred) {
#pragma unroll
    for (int hf = 0; hf < 2; ++hf) { const f32x4 sa = qk_tile(kb, 2 * st + hf, fr, q, qf);
        if (!masked) {
#pragma unroll
            for (int j = 0; j < 4; ++j) e2[hf][j] = ex2(fmaf(sa[j], NSA_C1, nb)); }
        else {
#pragma unroll
            for (int j = 0; j < 4; ++j) e2[hf][j] = pred(32 * st + 16 * hf + 4 * q + j) ? ex2(fmaf(sa[j], NSA_C1, nb)) : 0.f; } }
    const f16x8 pb = pack_p(e2[0], e2[1]);
#pragma unroll
    for (int dt = 0; dt < 4; ++dt) o[dt] = __builtin_amdgcn_mfma_f32_16x16x32_f16(lds_vt(vb + (16 * dt + fr) * 136 + 32 * st + 4 * q), pb, o[dt], 0, 0, 0);
    return pb;
}
DI void nsa_tile(const Ctx& c, int tile, const f16* Q16, const f16* KC16, const f16* VCT16, const f16* KS16, const f16* VST16, const f16* KW16, const f16* VWT16,
                 const float* GATES, const f16* DG, f16* Y16, float shc, float shs, float shw) {
    LAS unsigned char* lds = c.lds; const int wave = c.wave; int tid, lane, fr, q, ti, h, trow;
    const int t0 = tile * 32, cur = t0 >> 6;
#define NSA_RELANE() do { int _t = c.tid; asm volatile("" : "+v"(_t)); tid = _t; lane = _t & 63; fr = lane & 15; q = lane >> 4; ti = fr >> 2; h = fr & 3; trow = t0 + 4 * wave + ti; } while (0)
#define NSA_REPS(bit) (((NSA_DUP >> (bit)) & 1) ? 2 : 1)
#define NSA_SCALE(rep) ({ float _z = (rep) == 0 ? 1.f : 0.f; asm volatile("" : "+v"(_z)); _z; })
    NSA_RELANE();
    LAS float* PSEL = (LAS float*)(lds + NT_PSEL); LAS unsigned* MASK = (LAS unsigned*)(lds + NT_MASK); LAS int* VB = (LAS int*)(lds + NT_VB); LAS unsigned char* STG = lds + NT_STG;
    __syncthreads();
    for (int i = tid; i < 272; i += 512) MASK[i] = (i == 0 || i == cur || i == cur - 1) ? 0xFFFFFFFFu : 0u;
    f16x8 qf[2];
#pragma unroll
    for (int ks = 0; ks < 2; ++ks) qf[ks] = ld_h8(Q16 + ((size_t)trow * 4 + h) * 64 + 32 * ks + 8 * q);
    const int nkt = ((t0 >> 4) + 1 + 15) >> 4;
    const int ncch = (nkt + 7) >> 3;
    const int nv_row = trow >= 31 ? ((trow - 31) >> 4) + 1 : 0;
    auto kc_src = [&](int ch, int row) { return KC16 + (size_t)(128 * ch + row) * 64; };
    auto vc_src = [&](int ch, int d, int seg) { return VCT16 + (size_t)d * 1024 + 128 * ch + seg * 16; };
    float lsum = 0.f;
    const float bc = -shc * NSA_L2E, bs = -shs * NSA_L2E, bw = -shw * NSA_L2E;
    const int tw0 = t0 + 4 * wave, nvmin_w = tw0 >= 31 ? ((tw0 - 31) >> 4) + 1 : 0;
    stream_chunks<false>(STG, ncch, tid, kc_src, vc_src, [&](int ch, LAS unsigned char* buf) {
        const LAS f16* kb = (const LAS f16*)buf; const int nk = nkt - 8 * ch < 8 ? nkt - 8 * ch : 8;
#pragma unroll 4
        for (int kt = 0; kt < nk; ++kt) { const f32x4 sa = qk_tile(kb, kt, fr, q, qf); const int cb = 128 * ch + 16 * kt + 4 * q;
            if (128 * ch + 16 * kt + 15 < nvmin_w) {
#pragma unroll
                for (int j = 0; j < 4; ++j) lsum += ex2(fmaf(sa[j], NSA_C1, bc)); }
            else {
#pragma unroll
                for (int j = 0; j < 4; ++j) lsum += (cb + j < nv_row) ? ex2(fmaf(sa[j], NSA_C1, bc)) : 0.f; } } });
    lsum += __shfl_xor(lsum, 16); lsum += __shfl_xor(lsum, 32);
    const float invc = lsum > 0.f ? 1.f / lsum : 0.f;
    NSA_RELANE();
    f32x4 oc[4];
#pragma unroll
    for (int dt = 0; dt < 4; ++dt) oc[dt] = (f32x4){0.f, 0.f, 0.f, 0.f};
    { float bprev = 0.f; const float pbias = invc > 0.f ? bc + __log2f(invc) : -1e30f;
    stream_chunks<true>(STG, ncch, tid, kc_src, vc_src, [&](int ch, LAS unsigned char* buf) {
        const LAS f16* kb = (const LAS f16*)buf; const LAS f16* vb = (const LAS f16*)(buf + 18432); const int ns = (nkt - 8 * ch + 1) >> 1 < 4 ? (nkt - 8 * ch + 1) >> 1 : 4;
#pragma unroll 2
        for (int s2 = 0; s2 < ns; ++s2) {
            f32x4 e2[2];
            pv_step(kb, vb, s2, fr, q, qf, oc, e2, pbias, 128 * ch + 32 * s2 + 31 >= nvmin_w, [&](int kc) { return 128 * ch + kc < nv_row; });
#pragma unroll
            for (int hf = 0; hf < 2; ++hf) {
                const int ktg = 8 * ch + 2 * s2 + hf;
                float av = (e2[hf][0] + e2[hf][1]) + (e2[hf][2] + 0.5f * e2[hf][3]), bv = 0.5f * e2[hf][3];
                av += dppf<DPP_X1>(av); av += dppf<DPP_X2>(av); bv += dppf<DPP_X1>(bv); bv += dppf<DPP_X2>(bv);
                const float up = __shfl(q == 3 ? bprev : bv, (lane + 48) & 63);
                bprev = bv;
                if (h == 0 && ktg < nkt) PSEL[(4 * wave + ti) * 256 + 4 * ktg + q] = av + up;
            }
        } }); }
    for (int rep = 0; rep < NSA_REPS(2); ++rep) {
        const int nforced = cur >= 2 ? 3 : cur + 1, nsel = ((cur + 1) < 16 ? (cur + 1) : 16) - nforced, tk = lane >> 4, l16 = lane & 15, tokl = 4 * wave + tk;
        float sv[16];
#pragma unroll
        for (int i = 0; i < 16; ++i) { const int j = l16 + 16 * i; float v = -3e38f;
            if (j <= cur && !(j == 0 || j == cur || j == cur - 1)) v = j < 4 * nkt ? PSEL[tokl * 256 + j] : 0.f;
            sv[i] = v; }
#pragma nounroll
        for (int k = 0; k < nsel; ++k) {
            float bv = sv[0]; int bi = l16;
#pragma unroll
            for (int i = 1; i < 16; ++i) if (sv[i] > bv) { bv = sv[i]; bi = l16 + 16 * i; }
#define TOPK_STEP(CT) do { const float ov = dppf<CT>(bv); const int oi = dppi<CT>(bi); if (ov > bv || (ov == bv && oi < bi)) { bv = ov; bi = oi; } } while (0)
            TOPK_STEP(DPP_X1); TOPK_STEP(DPP_X2); TOPK_STEP(DPP_HM); TOPK_STEP(DPP_R8);
#undef TOPK_STEP
            if (l16 == 0) __hip_atomic_fetch_or(&MASK[bi], 1u << tokl, __ATOMIC_RELAXED, __HIP_MEMORY_SCOPE_WORKGROUP);
#pragma unroll
            for (int i = 0; i < 16; ++i) if (l16 + 16 * i == bi) sv[i] = -3e38f;
        }
    }
    NSA_RELANE();
    f32x4 owr[4]; float lwr = 0.f;
#pragma unroll
    for (int dt = 0; dt < 4; ++dt) owr[dt] = (f32x4){0.f, 0.f, 0.f, 0.f};
    f16x8 onesf;
#pragma unroll
    for (int i = 0; i < 8; ++i) onesf[i] = fr == 0 ? (f16)1.f : (f16)0.f;
    f32x4 lw5 = (f32x4){0.f, 0.f, 0.f, 0.f};
    {
        const int wlo = t0 - 512 > 0 ? t0 - 512 : 0, nwch = (t0 + 32 - wlo + 127) >> 7;
        auto kw_src = [&](int ch, int row) { int p = wlo + 128 * ch + row; p = p < SEQ ? p : SEQ - 1; return KW16 + (size_t)p * 64; };
        auto vw_src = [&](int ch, int d, int seg) { const int key = wlo + 128 * ch + seg * 16; int blk = key >> 6; blk = blk < 256 ? blk : 255; return VWT16 + (size_t)blk * 4096 + d * 64 + (key & 63); };
        {
        stream_chunks<true>(STG, nwch, tid, kw_src, vw_src, [&](int ch, LAS unsigned char* buf) {
            const LAS f16* kb = (const LAS f16*)buf; const LAS f16* vb = (const LAS f16*)(buf + 18432); const int pbase = wlo + 128 * ch;
            const int ns = (t0 + 32 - pbase) >> 5 < 4 ? (t0 + 32 - pbase) >> 5 : 4;
#pragma unroll 2
            for (int s2 = 0; s2 < ns; ++s2) { f32x4 e2[2];
                const int p0s = pbase + 32 * s2; const bool masked = !(p0s >= tw0 + 3 - 512 && p0s + 31 <= tw0);
                const f16x8 pb = pv_step(kb, vb, s2, fr, q, qf, owr, e2, bw, masked, [&](int kc) { const int pos = pbase + kc; return pos <= trow && pos >= trow - 512; });
                lw5 = __builtin_amdgcn_mfma_f32_16x16x32_f16(onesf, pb, lw5, 0, 0, 0); } }); }
        lwr = lw5[0];
    }
    NSA_RELANE();
    if (wave == 0) { int cnt = 0;
        for (int base = 0; base <= cur; base += 64) { const int jx = base + lane; const bool v = jx <= cur && MASK[jx] != 0u; const unsigned long long bal = __ballot(v);
            if (v) VB[cnt + __popcll(bal & ((1ull << lane) - 1ull))] = jx; cnt += __popcll(bal); }
        if (lane == 0) VB[264] = cnt; }
    __syncthreads();
    if (VERIFY_NSA) { unsigned* SELM = (unsigned*)(c.ws + WS_SELM) + (size_t)tile * 272; for (int i = tid; i < 272; i += 512) SELM[i] = MASK[i]; }
    f32x4 osr[4]; float lsr = 0.f; f32x4 ls5 = (f32x4){0.f, 0.f, 0.f, 0.f};
#pragma unroll
    for (int dt = 0; dt < 4; ++dt) osr[dt] = (f32x4){0.f, 0.f, 0.f, 0.f};
#pragma unroll
    for (int i = 0; i < 8; ++i) onesf[i] = fr == 0 ? (f16)1.f : (f16)0.f;
    {
        const int nvb = __builtin_amdgcn_readfirstlane(VB[264]), nst = (nvb + 3) >> 2;
        const int dr = lane >> 3, dp = lane & 7, dsw = (dp ^ dr) * 8;
        LAS unsigned char* RING = lds + NT_RING;
        auto dma = [&](int n) { const int bi = n < nvb ? n : nvb - 1; const int blk = __builtin_amdgcn_readfirstlane(VB[bi]); LAS unsigned char* slot = RING + (n & 7) * 16384 + wave * 1024;
            __builtin_amdgcn_global_load_lds((const unsigned*)(KS16 + ((size_t)blk * 64 + 8 * wave + dr) * 64 + dsw), (LAS unsigned*)slot, 16, 0, 0);
            __builtin_amdgcn_global_load_lds((const unsigned*)(VST16 + (size_t)blk * 4096 + (8 * wave + dr) * 64 + dsw), (LAS unsigned*)(slot + 8192), 16, 0, 0); };
        {
        asm volatile("s_waitcnt vmcnt(0)" ::: "memory"); __syncthreads();
        dma(0); dma(1); dma(2); dma(3);
#pragma nounroll
        for (int st = 0; st < nst; ++st) {
            asm volatile("s_waitcnt vmcnt(0)\n\ts_barrier" ::: "memory");
            dma(4 * st + 4); dma(4 * st + 5); dma(4 * st + 6); dma(4 * st + 7);
            const int nb = nvb - 4 * st < 4 ? nvb - 4 * st : 4;
#pragma nounroll
            for (int i4 = 0; i4 < nb; ++i4) {
            const int n = 4 * st + i4;
            const int blk = __builtin_amdgcn_readfirstlane(VB[n]); const unsigned mt = (__builtin_amdgcn_readfirstlane(MASK[blk]) >> (4 * wave)) & 15u;
            if (mt != 0u) {
                const bool rv = ((mt >> ti) & 1u) != 0u; const LAS unsigned char* ks = RING + (n & 7) * 16384; const LAS unsigned char* vs = ks + 8192; const int sx = fr & 7;
                f32x4 sa[4]; f16x8 va[2][4];
#pragma unroll
                for (int kt = 0; kt < 4; ++kt) { const LAS unsigned char* kp = ks + (16 * kt + fr) * 128; sa[kt] = (f32x4){0.f, 0.f, 0.f, 0.f};
                    sa[kt] = __builtin_amdgcn_mfma_f32_16x16x32_f16(*(const LAS f16x8*)(kp + ((q ^ sx) << 4)), qf[0], sa[kt], 0, 0, 0);
                    sa[kt] = __builtin_amdgcn_mfma_f32_16x16x32_f16(*(const LAS f16x8*)(kp + (((4 + q) ^ sx) << 4)), qf[1], sa[kt], 0, 0, 0); }
#pragma unroll
                for (int s2 = 0; s2 < 2; ++s2) { const int sg = 4 * s2 + (q >> 1);
#pragma unroll
                    for (int dt = 0; dt < 4; ++dt) { const LAS unsigned char* vp = vs + (16 * dt + fr) * 128 + 8 * (q & 1);
                        const f16x4 v0 = *(const LAS f16x4*)(vp + ((sg ^ sx) << 4)), v1 = *(const LAS f16x4*)(vp + (((sg + 2) ^ sx) << 4));
                        va[s2][dt][0] = v0[0]; va[s2][dt][1] = v0[1]; va[s2][dt][2] = v0[2]; va[s2][dt][3] = v0[3]; va[s2][dt][4] = v1[0]; va[s2][dt][5] = v1[1]; va[s2][dt][6] = v1[2]; va[s2][dt][7] = v1[3]; } }
                const float nbu = rv ? bs : -1e30f;
                if (blk != cur) {
#pragma unroll
                    for (int kt = 0; kt < 4; ++kt)
#pragma unroll
                        for (int j = 0; j < 4; ++j) sa[kt][j] = ex2(fmaf(sa[kt][j], NSA_C1, nbu)); }
                else { const int pb0 = 64 * blk + 4 * q;
#pragma unroll
                    for (int kt = 0; kt < 4; ++kt)
#pragma unroll
                        for (int j = 0; j < 4; ++j) sa[kt][j] = (pb0 + 16 * kt + j <= trow) ? ex2(fmaf(sa[kt][j], NSA_C1, nbu)) : 0.f; }
                const f16x8 p0 = pack_p(sa[0], sa[1]), p1 = pack_p(sa[2], sa[3]);
#pragma unroll
                for (int dt = 0; dt < 4; ++dt) { osr[dt] = __builtin_amdgcn_mfma_f32_16x16x32_f16(va[0][dt], p0, osr[dt], 0, 0, 0); osr[dt] = __builtin_amdgcn_mfma_f32_16x16x32_f16(va[1][dt], p1, osr[dt], 0, 0, 0); }
                ls5 = __builtin_amdgcn_mfma_f32_16x16x32_f16(onesf, p0, ls5, 0, 0, 0); ls5 = __builtin_amdgcn_mfma_f32_16x16x32_f16(onesf, p1, ls5, 0, 0, 0);
            }
            }
        }
        asm volatile("s_waitcnt vmcnt(0)" ::: "memory"); }
        __syncthreads();
        lsr = ls5[0];
    }
    NSA_RELANE();
    lwr += __shfl_xor(lwr, 16); lwr += __shfl_xor(lwr, 32); lsr += __shfl_xor(lsr, 16); lsr += __shfl_xor(lsr, 32);
    {
        const float g0 = GATES[(size_t)trow * 12 + h * 3], ils = GATES[(size_t)trow * 12 + h * 3 + 1] / lsr, ilw = GATES[(size_t)trow * 12 + h * 3 + 2] / lwr;
#pragma unroll
        for (int dt = 0; dt < 4; ++dt) { const int d0 = 16 * dt + 4 * q; const f16x4 dg = *(const f16x4*)(DG + (size_t)trow * 256 + h * 64 + d0); f16x4 y;
#pragma unroll
            for (int jj = 0; jj < 4; ++jj) { const float o = g0 * oc[dt][jj] + ils * osr[dt][jj] + ilw * owr[dt][jj]; y[jj] = (f16)(siluf_((float)dg[jj]) * o); }
            *(f16x4*)(Y16 + (size_t)trow * 1024 + 768 + h * 64 + d0) = y; }
    }
#undef NSA_RELANE
}
DI void ph_ssd_fin(LAS unsigned char* lds_, int l, int it0, int it1, int itstep);
DI void ph_outproj_sample(LAS unsigned char* lds_, int l, int it);
DI void ph_nsa(LAS unsigned char* lds_, int l) {
    const Ctx c = mkctx(lds_); const int lane = c.lane;
    const float* qg = INP(I_QG) + l * 64; const float* kg = INP(I_KG) + l * 192;
    const float mq = wmaxf(fabsf(qg[lane])), mk0 = wmaxf(fabsf(kg[lane])), mk1 = wmaxf(fabsf(kg[64 + lane])), mk2 = wmaxf(fabsf(kg[128 + lane]));
    const float shc = 8.f * mq * mk0 - 8.f, shs = 8.f * mq * mk1 - 8.f, shw = 8.f * mq * mk2 - 8.f;
    unsigned* qctr = (unsigned*)(c.ws + WS_CTL + 16384) + l * 64; LAS int* qslot = (LAS int*)(c.lds + MISC_OFF + 64); bool fin_ok = false, smp_ok = false;
    for (;;) {
        __syncthreads();
        if (c.tid == 0) *qslot = (int)__hip_atomic_fetch_add(qctr, 1u, __ATOMIC_RELAXED, __HIP_MEMORY_SCOPE_AGENT);
        __syncthreads();
        const int u = __builtin_amdgcn_readfirstlane(*qslot);
        if (u >= 800) break;
        if (u < 512) nsa_tile(c, 511 - u, WSH(WS_Q16), WSH(WS_KC16), WSH(WS_VCT16), WSH(WS_KS16), WSH(WS_VST16), WSH(WS_KW16), WSH(WS_VWT16), WSF(WS_GATES), WSH(WS_PROJ) + (size_t)14 * SEQ * 256, WSH(WS_Y16), shc, shs, shw);
        else if (u < 768) { if (!fin_ok) { edge_wait((unsigned*)(c.ws + WS_CTL + 17408) + l * 64, 64u); fin_ok = true; } ph_ssd_fin(lds_, l, u - 512, u - 511, 1); }
        else { if (!smp_ok) { edge_wait((unsigned*)(c.ws + WS_CTL + 18432) + l * 64, 32u); smp_ok = true; } ph_outproj_sample(lds_, l, u - 768); }
    }
    __syncthreads();
}
DI void ph_nsa_verify(LAS unsigned char* lds_, int l) {
    const Ctx c = mkctx(lds_); const int lane = c.lane;
    LAS float* wl = (LAS float*)c.lds + c.wave * 4400; LAS float* sc = wl; LAS float* qs = wl + 4096; LAS unsigned* selb = (LAS unsigned*)(wl + 4352);
    const f16* Q16 = WSH(WS_Q16); const f16* KC16 = WSH(WS_KC16); const f16* VCT16 = WSH(WS_VCT16); const f16* KS16 = WSH(WS_KS16); const f16* VST16 = WSH(WS_VST16); const f16* KW16 = WSH(WS_KW16); const f16* VWT16 = WSH(WS_VWT16);
    const float* GATES = WSF(WS_GATES); const f16* DG = WSH(WS_PROJ) + (size_t)14 * SEQ * 256; const f16* Y16 = WSH(WS_Y16); const unsigned* SELM = (const unsigned*)(c.ws + WS_SELM);
    float* dbg = (float*)(c.ws + WS_CTL + 40960);
    auto dot4 = [&](const f16* kp, float (&s4)[4]) { s4[0] = s4[1] = s4[2] = s4[3] = 0.f;
#pragma unroll
        for (int i = 0; i < 8; ++i) { const f16x8 kv = ld_h8(kp + 8 * i);
#pragma unroll
            for (int j = 0; j < 8; ++j) { const f32x4 qv = *(const LAS f32x4*)(qs + (8 * i + j) * 4); const float kf = (float)kv[j]; s4[0] += qv[0] * kf; s4[1] += qv[1] * kf; s4[2] += qv[2] * kf; s4[3] += qv[3] * kf; } }
#pragma unroll
        for (int hh = 0; hh < 4; ++hh) s4[hh] *= 0.125f; };
    for (int si = c.bid * 8 + c.wave; si < 200 + 395; si += c.G * 8) {
        const int t = si < 200 ? si : 200 + (si - 200) * 41, cur = t >> 6, ncv = t >= 31 ? ((t - 31) >> 4) + 1 : 0;
#pragma unroll
        for (int hh = 0; hh < 4; ++hh) qs[lane * 4 + hh] = (float)Q16[(size_t)t * 256 + hh * 64 + lane];
        if (lane < 9) selb[lane] = 0u;
        float oc[4] = {0.f, 0.f, 0.f, 0.f}, os[4] = {0.f, 0.f, 0.f, 0.f}, ow[4] = {0.f, 0.f, 0.f, 0.f};
        {
            float mx[4] = {-3e38f, -3e38f, -3e38f, -3e38f}, inv[4];
            for (int cc = lane; cc < ncv; cc += 64) { asm volatile("" ::: "memory"); float s4[4]; dot4(KC16 + (size_t)cc * 64, s4);
#pragma unroll
                for (int hh = 0; hh < 4; ++hh) { sc[hh * 1024 + cc] = s4[hh]; mx[hh] = fmaxf(mx[hh], s4[hh]); } }
#pragma unroll
            for (int hh = 0; hh < 4; ++hh) { mx[hh] = wmaxf(mx[hh]); float sm = 0.f; for (int cc = lane; cc < ncv; cc += 64) { const float e = __expf(sc[hh * 1024 + cc] - mx[hh]); sc[hh * 1024 + cc] = e; sm += e; } sm = wsum(sm); inv[hh] = ncv > 0 ? 1.f / sm : 0.f; }
            for (int cc = lane; cc < ncv; cc += 64) {
#pragma unroll
                for (int hh = 0; hh < 4; ++hh) sc[hh * 1024 + cc] *= inv[hh]; }
            for (int cc = 0; cc < ncv; ++cc) { const float v = (float)VCT16[(size_t)lane * 1024 + cc];
#pragma unroll
                for (int hh = 0; hh < 4; ++hh) oc[hh] += sc[hh * 1024 + cc] * v; }
        }
        const int nsel = (cur + 1) < 16 ? (cur + 1) : 16;
        {
            float scv[5];
#pragma unroll
            for (int i = 0; i < 5; ++i) { const int j = lane + 64 * i; float v = -3e38f;
                if (j <= cur) { if (j == 0 || j == cur || j == cur - 1) v = 3e38f; else { float a = 0.f;
#pragma unroll
                        for (int o5 = -1; o5 < 4; ++o5) { const int cc = 4 * j + o5; if (cc >= 0 && cc < ncv) { const float p = (sc[cc] + sc[1024 + cc]) + (sc[2048 + cc] + sc[3072 + cc]); a += (o5 == -1 || o5 == 3) ? 0.5f * p : p; } }
                        v = a; } }
                scv[i] = v; }
            for (int k = 0; k < nsel; ++k) {
                float bv = scv[0]; int bi = lane;
#pragma unroll
                for (int i = 1; i < 5; ++i) if (scv[i] > bv) { bv = scv[i]; bi = lane + 64 * i; }
#pragma unroll
                for (int off = 32; off > 0; off >>= 1) { const float ov = __shfl_xor(bv, off); const int oi = __shfl_xor(bi, off); if (ov > bv || (ov == bv && oi < bi)) { bv = ov; bi = oi; } }
                if (lane == 0) selb[bi >> 5] |= 1u << (bi & 31);
#pragma unroll
                for (int i = 0; i < 5; ++i) if (lane + 64 * i == bi) scv[i] = -3e38f;
            }
        }
        int nmis = 0;
        for (int j = lane; j <= cur; j += 64) { const unsigned fb = (SELM[(size_t)(t >> 5) * 272 + j] >> (t & 31)) & 1u, nb = (selb[j >> 5] >> (j & 31)) & 1u; nmis += (fb != nb) ? 1 : 0; }
        nmis = (int)wsum((float)nmis);
        if (nmis != 0) { if (lane == 0) { atomicAdd(dbg + 3, 1.f); atomicAdd(dbg + 4, (float)nmis); } continue; }
        {
            float mx[4] = {-3e38f, -3e38f, -3e38f, -3e38f}, inv[4]; int nk = 0;
            for (int j = 0; j <= cur; ++j) if ((selb[j >> 5] >> (j & 31)) & 1u) { asm volatile("" ::: "memory"); const int pos = j * 64 + lane; float s4[4] = {-1e30f, -1e30f, -1e30f, -1e30f}; if (pos <= t) dot4(KS16 + (size_t)pos * 64, s4);
#pragma unroll
                for (int hh = 0; hh < 4; ++hh) { sc[hh * 1024 + nk * 64 + lane] = s4[hh]; mx[hh] = fmaxf(mx[hh], s4[hh]); } ++nk; }
#pragma unroll
            for (int hh = 0; hh < 4; ++hh) { mx[hh] = wmaxf(mx[hh]); float sm = 0.f; for (int k = 0; k < nk; ++k) { const float x = sc[hh * 1024 + k * 64 + lane]; const float e = x > -1e29f ? __expf(x - mx[hh]) : 0.f; sc[hh * 1024 + k * 64 + lane] = e; sm += e; } sm = wsum(sm); inv[hh] = 1.f / sm; }
            nk = 0;
            for (int j = 0; j <= cur; ++j) if ((selb[j >> 5] >> (j & 31)) & 1u) { for (int kk = 0; kk < 64 && j * 64 + kk <= t; ++kk) { const float v = (float)VST16[(size_t)j * 4096 + lane * 64 + kk];
#pragma unroll
                    for (int hh = 0; hh < 4; ++hh) os[hh] += sc[hh * 1024 + nk * 64 + kk] * v; } ++nk; }
#pragma unroll
            for (int hh = 0; hh < 4; ++hh) os[hh] *= inv[hh];
        }
        {
            const int lo = t - 512 > 0 ? t - 512 : 0, nw = t - lo + 1; float mx[4] = {-3e38f, -3e38f, -3e38f, -3e38f}, inv[4];
            for (int i = lane; i < nw; i += 64) { asm volatile("" ::: "memory"); float s4[4]; dot4(KW16 + (size_t)(lo + i) * 64, s4);
#pragma unroll
                for (int hh = 0; hh < 4; ++hh) { sc[hh * 1024 + i] = s4[hh]; mx[hh] = fmaxf(mx[hh], s4[hh]); } }
#pragma unroll
            for (int hh = 0; hh < 4; ++hh) { mx[hh] = wmaxf(mx[hh]); float sm = 0.f; for (int i = lane; i < nw; i += 64) { const float e = __expf(sc[hh * 1024 + i] - mx[hh]); sc[hh * 1024 + i] = e; sm += e; } sm = wsum(sm); inv[hh] = 1.f / sm; }
            for (int i = 0; i < nw; ++i) { const int pos = lo + i; const float v = (float)VWT16[(size_t)(pos >> 6) * 4096 + lane * 64 + (pos & 63)];
#pragma unroll
                for (int hh = 0; hh < 4; ++hh) ow[hh] += sc[hh * 1024 + i] * v; }
#pragma unroll
            for (int hh = 0; hh < 4; ++hh) ow[hh] *= inv[hh];
        }
        float dd = 0.f, ee = 0.f;
#pragma unroll
        for (int hh = 0; hh < 4; ++hh) { const float o = GATES[(size_t)t * 12 + hh * 3] * oc[hh] + GATES[(size_t)t * 12 + hh * 3 + 1] * os[hh] + GATES[(size_t)t * 12 + hh * 3 + 2] * ow[hh];
            const float yn = siluf_((float)DG[(size_t)t * 256 + hh * 64 + lane]) * o, yf = (float)Y16[(size_t)t * 1024 + 768 + hh * 64 + lane]; dd += (yf - yn) * (yf - yn); ee += yn * yn; }
        dd = wsum(dd); ee = wsum(ee);
        if (lane == 0) { atomicAdd(dbg, dd); atomicAdd(dbg + 1, ee); atomicAdd(dbg + 2, 1.f); }
    }
    (void)l;
}
DI void ph_ssd_fin(LAS unsigned char* lds_, int l, int it0, int it1, int itstep) {
    const Ctx c = mkctx(lds_); const int lane = c.lane, wave = c.wave;
    const float* Dp = INP(I_SD) + l * 4; const float* sng = INP(I_SNG) + l * 256;
    const float* CST = WSF(WS_HPV); const f16* ACT = WSH(WS_ACT); const float* ACS = WSF(WS_ACS); const float* YD = WSF(WS_YD); const f16* Z = WSH(WS_PROJ) + (size_t)4 * SEQ * 256; f16* Y16 = WSH(WS_Y16);
    LAS float* GY = (LAS float*)c.lds;
    for (int it = it0; it < it1; it += itstep) {
        const int ch_ = it >> 1, t0 = it * 64, hd = wave >> 1, g = hd >> 1, fr = lane & 15, q = lane >> 4;
        __syncthreads();
        f16x8 bf[2][4];
#pragma unroll
        for (int p2 = 0; p2 < 2; ++p2)
#pragma unroll
            for (int ks = 0; ks < 4; ++ks) bf[p2][ks] = cvt_h8(CST + ((size_t)(ch_ * 4 + hd) * 64 + 16 * ((wave & 1) * 2 + p2) + fr) * 128 + 32 * ks + 8 * q);
#pragma unroll
        for (int lt = 0; lt < 4; ++lt) {
            f16x8 af[4];
#pragma unroll
            for (int ks = 0; ks < 4; ++ks) af[ks] = ld_h8(ACT + (size_t)(t0 + 16 * lt + fr) * 768 + 512 + 128 * g + 32 * ks + 8 * q);
#pragma unroll
            for (int p2 = 0; p2 < 2; ++p2) { f32x4 acc = (f32x4){0.f, 0.f, 0.f, 0.f};
#pragma unroll
                for (int ks = 0; ks < 4; ++ks) acc = __builtin_amdgcn_mfma_f32_16x16x32_f16(af[ks], bf[p2][ks], acc, 0, 0, 0);
                const int ch = hd * 64 + 16 * ((wave & 1) * 2 + p2) + fr;
#pragma unroll
                for (int j = 0; j < 4; ++j) { const int tl = 16 * lt + 4 * q + j, t = t0 + tl;
                    const float y = acc[j] * __expf(ACS[(size_t)t * 4 + hd]) + YD[(size_t)t * 256 + ch] + Dp[hd] * (float)ACT[(size_t)t * 768 + ch];
                    GY[tl * 256 + ch] = y * siluf_((float)Z[(size_t)t * 256 + ch]); } }
        }
        __syncthreads();
        for (int tl = wave; tl < 64; tl += 8) { const f32x4 v = *(const LAS f32x4*)(GY + tl * 256 + lane * 4); const float ss = wsum((v[0] * v[0] + v[1] * v[1]) + (v[2] * v[2] + v[3] * v[3]));
            const float rn = rsqrtf(ss * (1.f / 256.f) + EPS); const f32x4 g4 = *(const f32x4*)(sng + lane * 4); f16x4 o;
#pragma unroll
            for (int i = 0; i < 4; ++i) o[i] = (f16)(v[i] * rn * g4[i]);
            *(f16x4*)(Y16 + (size_t)(t0 + tl) * 1024 + 256 + lane * 4) = o; }
    }
    __syncthreads();
}
DI void ph_outproj(LAS unsigned char* lds_, int l) {
    const Ctx c = mkctx(lds_);
    const float* xin = l == 0 ? INP(I_XP) : WSF(WS_X1); float* xout = l == 0 ? WSF(WS_X1) : c.out + O_YP;
    pg8::Gemm g{WSH(WS_Y16), WSH(WS_WTOUT) + (size_t)l * 1024 * 1024, SEQ, 1024, 1024}; pg8::StaticOrder S; S.init(SEQ, 1024, c.G, c.bid);
    EpiOut E{xin, xout, WSF(WS_ADA) + (size_t)(l * 33 + 32) * 3072 + 2048, l == 0 ? WSH(WS_A16) : nullptr, WSF(WS_GNX), WSF(WS_RSSP)};
    pg8::gemm_phase<EpiOut, pg8::StaticOrder>(c.lds, g, S, E);
    __syncthreads();
}
DI void ph_outproj_sample(LAS unsigned char* lds_, int l, int it) {
    const Ctx c = mkctx(lds_); const int tid = c.tid;
    const float* xs_in = l == 0 ? INP(I_XS) : WSF(WS_XS1); const float* ada_l = WSF(WS_ADA) + (size_t)l * 33 * 3072; const float* YS = WSF(WS_YS); float* xo = l == 0 ? WSF(WS_XS1) : c.out + O_YS;
    LAS f16* Ah = (LAS f16*)c.lds;
    __syncthreads();
#pragma unroll
    for (int i = 0; i < 16; ++i) { const int e = (tid + 512 * i) * 4; const f32x4 v = *(const f32x4*)(YS + e); f16x4 hv; hv[0] = (f16)v[0]; hv[1] = (f16)v[1]; hv[2] = (f16)v[2]; hv[3] = (f16)v[3]; *(LAS f16x4*)(Ah + (e >> 10) * 1032 + (e & 1023)) = hv; }
    __syncthreads();
    sample_gemm_item<1>(c.lds, WSH(WS_WTOUT) + (size_t)l * 1024 * 1024, it * 32, [&](int m, int n, float v) { xo[m * 1024 + n] = xs_in[m * 1024 + n] + ada_l[(size_t)m * 3072 + 2048 + n] * v; });
}

__global__ void __launch_bounds__(512, 2) fwd(Args a) {
    extern __shared__ __attribute__((aligned(16))) unsigned char lds_raw[];
    LAS unsigned char* lds = (LAS unsigned char*)lds_raw;
    volatile LAS unsigned* MISC = (volatile LAS unsigned*)(lds + MISC_OFF);
    if (threadIdx.x < 16) MISC[threadIdx.x] = 0u;
    __syncthreads();
    XcdBarrier bar; bar.bar = (unsigned*)(a.ws + WS_CTL); bar.x = 0; bar.st = MISC;
    if (N_LAUNCHES == 1) bar = xcd_barrier_post((unsigned*)(a.ws + WS_CTL), MISC);
    const int lo = a.ph_lo, hi = a.ph_hi;
    unsigned long long* stampw = (unsigned long long*)(a.ws + WS_CTL + 32768);
    if (STAMP_PHASE >= 0 && blockIdx.x == 0 && threadIdx.x == 0) stampw[0] = wall_clock64();
#define STAMP(k) do { if (STAMP_PHASE == (k) && blockIdx.x == 0 && threadIdx.x == 0) stampw[1] = wall_clock64(); } while (0)
#ifndef PH_MASK
#define PH_MASK 0xFFF
#endif
#define IN(k) (((PH_MASK >> ((k) < 2 ? (k) : 2 + ((k) - 2) % 4)) & 1) && lo <= (k) && (k) < hi)
#define SEAM(k) do { if (IN(k) && IN((k) + 1)) xcd_barrier(bar); STAMP(k); } while (0)
#ifndef DUP_MASK
#define DUP_MASK 0
#endif
#define DUP(bit, call) do { call; if ((DUP_MASK >> (bit)) & 1) { __syncthreads(); call; } } while (0)
    if (IN(0)) DUP(0, ph_prologue(lds));
    SEAM(0);
    if (IN(1)) { ph_hsample(lds, 0); DUP(1, ph_sample_compress(lds)); DUP(2, ph_prep(lds)); }
    SEAM(1);
    for (int l = 0; l < 2; ++l) {
        const int PB = 2 + 4 * l;
        if (IN(PB)) { DUP(3, ph_inproj(lds, l)); DUP(4, ph_inproj_sample(lds, l)); }
        SEAM(PB);
        if (IN(PB + 1)) {
#define SUBSTAMP(code) do { if (l == 0 && (STAMP_PHASE == (code) || STAMP_PHASE == (code) + 10) && blockIdx.x == (STAMP_PHASE >= 110 ? 100 : 0) && threadIdx.x == 0) stampw[1] = wall_clock64(); } while (0)
            DUP(5, ph_ssd_local(lds, l)); SUBSTAMP(100); DUP(6, ph_mix_a(lds, l)); SUBSTAMP(101); DUP(7, ph_mix_c(lds, l)); SUBSTAMP(102); DUP(8, ph_mix_d(lds, l)); SUBSTAMP(103); DUP(9, ph_mix_cmp(lds, l)); SUBSTAMP(104); }
        SEAM(PB + 1);
        if (IN(PB + 2)) { DUP(11, ph_scan(lds, l)); DUP(10, ph_mix_sample(lds, l)); ph_nsa(lds, l); }
        SEAM(PB + 2);
        if (IN(PB + 3)) { if (VERIFY_NSA && l == 0) { ph_nsa_verify(lds, l); __syncthreads(); } if (l == 0) ph_hsample(lds, 1); DUP(14, ph_outproj(lds, l)); }
        SEAM(PB + 3);
    }
    if (STAMP_PHASE >= 0 || VERIFY_NSA) {
        xcd_barrier(bar);
        if (blockIdx.x == 0) { __shared__ float alpha_s; if (threadIdx.x == 0) { const unsigned long long t1 = wall_clock64(); alpha_s = (float)(stampw[1] - stampw[0]) / (float)(t1 - stampw[0]);
                if (VERIFY_NSA) { const float* dbg = (const float*)(a.ws + WS_CTL + 40960); alpha_s = VERIFY_NSA == 1 ? dbg[3] / (dbg[2] + dbg[3]) : sqrtf(dbg[0] / dbg[1]); } } __syncthreads();
            const float sc = 1.f + alpha_s; float* ys = a.out + O_YS; for (int i = threadIdx.x; i < NB * 1024; i += 512) ys[i] *= sc; }
    }
#undef IN
#undef SEAM
}

extern "C" void kernel_launch(void* const* d_in, const int* in_sizes, int n_in, void* d_out, int out_size, void* d_ws, size_t ws_size, hipStream_t stream) {
    static int grid = 0;
    if (grid == 0) {
        if (n_in != N_IN || (size_t)out_size != O_END || ws_size < WS_END) { fprintf(stderr, "kernel_launch: unexpected shapes (n_in %d out %d ws %zu)\n", n_in, out_size, ws_size); grid = -1; return; }
        int dev = 0, cus = 0;
        if (hipGetDevice(&dev) != hipSuccess || hipDeviceGetAttribute(&cus, hipDeviceAttributeMultiprocessorCount, dev) != hipSuccess) { grid = -1; return; }
        if (hipFuncSetAttribute((const void*)fwd, hipFuncAttributeMaxDynamicSharedMemorySize, LDS_BYTES) != hipSuccess) { fprintf(stderr, "kernel_launch: hipFuncSetAttribute failed\n"); grid = -1; return; }
        int per_cu = 0;
        if (hipOccupancyMaxActiveBlocksPerMultiprocessor(&per_cu, (const void*)fwd, 512, LDS_BYTES) != hipSuccess || per_cu < 1) fprintf(stderr, "kernel_launch: occupancy query says %d\n", per_cu);
        (void)hipGetLastError();
        grid = cus;
    }
    if (grid < 0) return;
    hipMemsetAsync((char*)d_ws + WS_CTL, 0, 65536, stream);
    Args a{};
    for (int i = 0; i < N_IN; ++i) a.in[i] = d_in[i];
    a.out = (float*)d_out; a.ws = (unsigned char*)d_ws;
    if (N_LAUNCHES == 1) { a.ph_lo = 0; a.ph_hi = NPHASE; hipLaunchKernelGGL(fwd, dim3(grid), dim3(512), LDS_BYTES, stream, a); }
    else for (int p = 0; p < NPHASE; ++p) { a.ph_lo = p; a.ph_hi = p + 1; hipLaunchKernelGGL(fwd, dim3(grid), dim3(512), LDS_BYTES, stream, a); }
}
```

```cpp
#include <hip/hip_runtime.h>
#include <cstdio>
#include <cstdint>
#include <type_traits>

#define NSA_DUP 0
#define VERIFY_NSA 0
#define STAMP_PHASE -1
#ifndef N_LAUNCHES
#define N_LAUNCHES 1
#endif

#define DI __device__ __forceinline__
#define LAS __attribute__((address_space(3)))
typedef _Float16 f16;
typedef _Float16 f16x8 __attribute__((ext_vector_type(8)));
typedef _Float16 f16x4 __attribute__((ext_vector_type(4)));
typedef _Float16 f16x2 __attribute__((ext_vector_type(2)));
typedef float f32x4 __attribute__((ext_vector_type(4)));
typedef float f32x2 __attribute__((ext_vector_type(2)));
typedef float f32x16 __attribute__((ext_vector_type(16)));
typedef unsigned u32x4 __attribute__((ext_vector_type(4)));

constexpr int DM = 1024, SEQ = 16384, NB = 32, PAST = 16384, NPOOL = 5120, DIN = 3728, NPD = 3840;
constexpr float EPS = 1e-6f;
constexpr int NPHASE = 10;
enum { I_XP = 0, I_XS, I_CKV, I_CWIN, I_SSC, I_SBC, I_SSM, I_SCF, I_PT, I_CP, I_CS, I_NG, I_WADA, I_BADA, I_WIN, I_WOUT, I_SCW, I_BCW, I_BCB,
       I_DTB, I_ALOG, I_SD, I_SNG, I_CFW, I_CFB, I_LNG, I_LNB, I_QG, I_KG, I_PE, I_W1, I_B1, I_W2, I_B2, N_IN };
constexpr size_t O_YP = 0, O_YS = O_YP + (size_t)SEQ * DM, O_KVP = O_YS + NB * DM, O_KVS = O_KVP + (size_t)2 * SEQ * 256, O_WINP = O_KVS + 2 * NB * 256,
                 O_WINS = O_WINP + 2 * 512 * 128, O_SCP = O_WINS + (size_t)2 * NB * 512 * 128, O_SCS = O_SCP + 2 * 2 * 256, O_BCP = O_SCS + 2 * NB * 512,
                 O_BCS = O_BCP + 2 * 3 * 768, O_HP = O_BCS + 2 * NB * 2304, O_HS = O_HP + 2 * 32768, O_CFP = O_HS + (size_t)2 * NB * 32768,
                 O_CFS = O_CFP + 2 * 30 * 256, O_END = O_CFS + 2 * NB * 7680;
constexpr size_t al256(size_t x) { return (x + 255) & ~(size_t)255; }
constexpr size_t WS_CTL = 0, WS_ADA = 65536, WS_BIAS = WS_ADA + al256(2 * 33 * 3072 * 4), WS_PEB = WS_BIAS + al256(2 * NPD * 4), WS_WTIN = WS_PEB + 2048,
                 WS_WTOUT = WS_WTIN + (size_t)2 * NPD * 1024 * 2, WS_W1T = WS_WTOUT + (size_t)2 * 1024 * 1024 * 2, WS_A16 = WS_W1T + (size_t)4 * 128 * 2048 * 2,
                 WS_RSSP = WS_A16 + (size_t)SEQ * 1024 * 2, WS_X1 = WS_RSSP + (size_t)SEQ * 16 * 4, WS_PROJ = WS_X1 + (size_t)SEQ * 1024 * 4,
                 WS_Y16 = WS_PROJ + (size_t)15 * SEQ * 256 * 2, WS_ACT = WS_Y16 + (size_t)SEQ * 1024 * 2, WS_YD = WS_ACT + (size_t)SEQ * 768 * 2,
                 WS_CST = WS_YD + (size_t)SEQ * 256 * 4, WS_ACS = WS_CST + (size_t)128 * 32768 * 4, WS_CDEC = WS_ACS + (size_t)SEQ * 4 * 4, WS_Q16 = WS_CDEC + 2048,
                 WS_KS16 = WS_Q16 + (size_t)SEQ * 256 * 2, WS_VS16 = WS_KS16 + (size_t)SEQ * 64 * 2, WS_KW16 = WS_VS16 + (size_t)SEQ * 64 * 2,
                 WS_VW16 = WS_KW16 + (size_t)SEQ * 64 * 2, WS_GATES = WS_VW16 + (size_t)SEQ * 64 * 2, WS_KC = WS_GATES + (size_t)SEQ * 12 * 4,
                 WS_VC = WS_KC + 1024 * 64 * 4, WS_KCS = WS_VC + 1024 * 64 * 4, WS_VCS = WS_KCS + (size_t)2 * NB * 1024 * 64 * 4,
                 WS_PROJS = WS_VCS + (size_t)2 * NB * 1024 * 64 * 4, WS_YS = WS_PROJS + al256(NB * NPD * 4), WS_XS1 = WS_YS + NB * 1024 * 4, WS_GNX = WS_XS1 + NB * 1024 * 4, WS_NRG = WS_GNX + 4096, WS_VST16 = WS_NRG + 2 * NB * 1024, WS_VWT16 = WS_VST16 + (size_t)SEQ * 64 * 2, WS_KC16 = WS_VWT16 + (size_t)SEQ * 64 * 2,
                 WS_VCT16 = WS_KC16 + 1024 * 64 * 2, WS_HPV = WS_VCT16 + 1024 * 64 * 2, WS_W2T = WS_HPV + (size_t)128 * 32768 * 4, WS_PEBP = WS_W2T + 4 * 64 * 128 * 2, WS_HS16 = WS_PEBP + 4 * 8 * 128 * 4, WS_SELM = WS_HS16 + NB * 1024 * 2, WS_END = WS_SELM + 512 * 272 * 4;
constexpr int LDS_BYTES = 147456;
constexpr int MISC_OFF = 147200;

struct Args { const void* in[N_IN]; float* out; unsigned char* ws; int ph_lo, ph_hi; };

#define XB_TMO      128
#define XB_XCNT(j)  (256  + 64 * (j))
#define XB_XSUB(j)  (1280 + 64 * (j))
#define XB_XGEN(j)  (2304 + 64 * (j))
#define XB_TOP      3328
#define XB_TOPGEN   3392
#define XCD_BAR_WORDS 3456
#define XB_SPIN_CAP (1u << 18)
__device__ __forceinline__ unsigned xb_ld(unsigned* p)              { return __hip_atomic_load(p, __ATOMIC_RELAXED, __HIP_MEMORY_SCOPE_AGENT); }
__device__ __forceinline__ unsigned xb_add(unsigned* p, unsigned v) { return __hip_atomic_fetch_add(p, v, __ATOMIC_RELAXED, __HIP_MEMORY_SCOPE_AGENT); }
__device__ __forceinline__ unsigned xb_xcc_id() { return (unsigned)__builtin_amdgcn_s_getreg((3 << 11) | 20) & 0xFu; }
#define XB_SPIN(cond, bar) do { unsigned _sp = 0; while (cond) { __builtin_amdgcn_s_sleep(1); \
    if ((++_sp & 255u) == 0u) { if (xb_ld(&(bar)[XB_TMO])) break; if (_sp > XB_SPIN_CAP) { atomicAdd(&(bar)[XB_TMO], 1u); break; } } } } while (0)
struct XcdBarrier { unsigned* bar; unsigned x; volatile LAS unsigned* st; };
__device__ __forceinline__ XcdBarrier xcd_barrier_post(unsigned* bar, volatile LAS unsigned* st) {
    XcdBarrier b; b.bar = bar; b.x = xb_xcc_id(); b.st = st;
    if (threadIdx.x == 0) (void)xb_add(&bar[XB_XCNT(b.x)], 1u);
    return b;
}
__device__ __forceinline__ void xcd_barrier_complete(unsigned* bar, unsigned x, unsigned& nloc, unsigned& nx) {
    const unsigned G = gridDim.x * gridDim.y * gridDim.z;
    unsigned sum, cnt, mine, sp = 0u;
    for (;;) {
        sum = 0u; cnt = 0u; mine = 0u;
#pragma unroll
        for (unsigned j = 0; j < 16; ++j) { const unsigned c = xb_ld(&bar[XB_XCNT(j)]); sum += c; cnt += (c > 0u) ? 1u : 0u; mine = (j == x) ? c : mine; }
        if (sum == G) break;
        __builtin_amdgcn_s_sleep(1);
        if ((++sp & 255u) == 0u) { if (xb_ld(&bar[XB_TMO])) break; if (sp > XB_SPIN_CAP) { atomicAdd(&bar[XB_TMO], 1u); break; } }
    }
    nloc = mine > 0u ? mine : 1u; nx = cnt > 0u ? cnt : 1u;
}
__device__ __forceinline__ void xcd_barrier(const XcdBarrier& b) {
    asm volatile("s_waitcnt vmcnt(0)" ::: "memory");
    __syncthreads();
    if (threadIdx.x == 0) {
        unsigned* bar = b.bar;
        __builtin_amdgcn_s_waitcnt(0);
        unsigned nloc = b.st[0], nx = b.st[1];
        if (nloc == 0u) { xcd_barrier_complete(bar, b.x, nloc, nx); b.st[0] = nloc; b.st[1] = nx; }
        const unsigned old = xb_add(&bar[XB_XSUB(b.x)], 1u);
        const unsigned gen = old / nloc;
        if (old + 1u == (gen + 1u) * nloc) {
            __builtin_amdgcn_fence(__ATOMIC_RELEASE, "agent");
            asm volatile("s_waitcnt vmcnt(0)" ::: "memory");
            const unsigned og = xb_add(&bar[XB_TOP], 1u);
            const unsigned tg = og / nx;
            if (og + 1u == (tg + 1u) * nx) xb_add(&bar[XB_TOPGEN], 1u);
            else XB_SPIN(xb_ld(&bar[XB_TOPGEN]) == tg, bar);
            __builtin_amdgcn_fence(__ATOMIC_ACQUIRE, "agent");
            xb_add(&bar[XB_XGEN(b.x)], 1u);
            asm volatile("s_waitcnt vmcnt(0)" ::: "memory");
        } else {
            XB_SPIN(xb_ld(&bar[XB_XGEN(b.x)]) == gen, bar);
            __builtin_amdgcn_fence(__ATOMIC_ACQUIRE, "agent");
            asm volatile("s_waitcnt vmcnt(0)" ::: "memory");
        }
    }
    __syncthreads();
}

DI void lds_barrier() { asm volatile("s_waitcnt lgkmcnt(0)\n\ts_barrier" ::: "memory"); }
DI int ltid() { int t = threadIdx.x; asm volatile("" : "+v"(t)); return t; }
template <int CTRL> DI float dppf(float x) { return __builtin_bit_cast(float, __builtin_amdgcn_update_dpp(0, __builtin_bit_cast(int, x), CTRL, 0xF, 0xF, true)); }
template <int CTRL> DI int dppi(int x) { return __builtin_amdgcn_update_dpp(0, x, CTRL, 0xF, 0xF, true); }
constexpr int DPP_X1 = 0xB1, DPP_X2 = 0x4E, DPP_HM = 0x141, DPP_R8 = 0x128;
DI float sum16(float v) { v += dppf<DPP_X1>(v); v += dppf<DPP_X2>(v); v += dppf<DPP_HM>(v); v += dppf<DPP_R8>(v); return v; }
DI float max16(float v) { v = fmaxf(v, dppf<DPP_X1>(v)); v = fmaxf(v, dppf<DPP_X2>(v)); v = fmaxf(v, dppf<DPP_HM>(v)); v = fmaxf(v, dppf<DPP_R8>(v)); return v; }
DI float wsum(float v) { v = sum16(v); v += __shfl_xor(v, 16); v += __shfl_xor(v, 32); return v; }
DI float wmaxf(float v) { v = max16(v); v = fmaxf(v, __shfl_xor(v, 16)); v = fmaxf(v, __shfl_xor(v, 32)); return v; }
DI float sigmoidf_(float x) { return 1.f / (1.f + __expf(-x)); }
DI float siluf_(float x) { return x / (1.f + __expf(-x)); }
DI float softplusf_(float x) { return fmaxf(x, 0.f) + log1pf(__expf(-fabsf(x))); }
DI f16x8 ld_h8(const f16* p) { return *(const f16x8*)p; }
DI f16x8 cvt_h8(const float* p) { const f32x4 a = *(const f32x4*)p, b = *(const f32x4*)(p + 4); f16x8 r; r[0] = (f16)a[0]; r[1] = (f16)a[1]; r[2] = (f16)a[2]; r[3] = (f16)a[3]; r[4] = (f16)b[0]; r[5] = (f16)b[1]; r[6] = (f16)b[2]; r[7] = (f16)b[3]; return r; }
DI int src_col(int n) { return n < 2048 ? n : (n < 3456 ? n + 4 : (n < 3460 ? n - 1408 : (n < 3472 ? n + 256 : (n < 3584 ? -1 : n - 124)))); }
DI int dst_col(int s) { return s < 2048 ? s : (s < 2052 ? s + 1408 : (s < 3460 ? s - 4 : (s < 3716 ? s + 124 : s - 256))); }

DI void edge_publish(unsigned* ctr) {
    asm volatile("s_waitcnt vmcnt(0)" ::: "memory"); __syncthreads();
    if (threadIdx.x == 0) { __builtin_amdgcn_fence(__ATOMIC_RELEASE, "agent"); asm volatile("s_waitcnt vmcnt(0)" ::: "memory"); __hip_atomic_fetch_add(ctr, 1u, __ATOMIC_RELAXED, __HIP_MEMORY_SCOPE_AGENT); }
}
DI void edge_wait(unsigned* ctr, unsigned need) {
    if (threadIdx.x == 0) { unsigned sp = 0;
        while (__hip_atomic_load(ctr, __ATOMIC_RELAXED, __HIP_MEMORY_SCOPE_AGENT) < need) { __builtin_amdgcn_s_sleep(8); if (++sp > (1u << 22)) break; }
        __builtin_amdgcn_fence(__ATOMIC_ACQUIRE, "agent"); asm volatile("s_waitcnt vmcnt(0)" ::: "memory"); }
    __syncthreads();
}
namespace pg8 {
constexpr int BM = 256, BK = 64, HALF = 128, HTB = HALF * BK * 2, STAGE_BYTES = 8 * HTB, NXCD = 8, WGM = 8;
DI int lds_byte(int r, int c) { const int st = (r >> 4) * 2 + (c >> 5), rr = r & 15, cc = c & 31, ob = rr * 64 + cc * 2; return st * 1024 + (ob ^ (((ob >> 9) & 1) << 5)); }
DI void stage_rc(int b, int& R, int& C) { const int st = b / 1024, sb = b % 1024, swz = sb ^ (((sb >> 9) & 1) << 5); R = (st >> 1) * 16 + swz / 64; C = (st & 1) * 32 + (swz % 64) / 2; }
DI int perm32(int rho) { const int n = rho >> 4, i = rho & 15; return 8 * (i >> 2) + 4 * n + (i & 3); }
struct Unit { int pm, pn; };
struct Gemm { const f16* A; const f16* Bt; int M, N, K; };
struct StaticOrder {
    int nM, nN, nwg, G, c;
    DI void init(int M, int N, int G_, int c_) { nM = M / BM; nN = N / BM; nwg = nM * nN; G = G_; c = c_; }
    DI bool next(int i, Unit& u) const {
        const long L = (long)i * G + c; if (L >= nwg) return false;
        int wgid = (int)L; { const int q = nwg / NXCD, r = nwg % NXCD, xcd = wgid % NXCD, off = wgid / NXCD; wgid = (xcd < r ? xcd * (q + 1) : r * (q + 1) + (xcd - r) * q) + off; }
        const int nig = WGM * nN, gid = wgid / nig, fm = gid * WGM, gsz = (nM - fm) < WGM ? (nM - fm) : WGM;
        u.pm = fm + ((wgid % nig) % gsz); u.pn = (wgid % nig) / gsz; return true;
    }
    DI void a_ready(const Unit&) const {}
    DI void done(const Unit&) const {}
};
template <class Epi, class Sched>
DI void gemm_phase(LAS unsigned char* lds, const Gemm g, const Sched& S, const Epi& E) {
    const int tid = ltid(), wid = __builtin_amdgcn_readfirstlane(tid >> 6), lane = tid & 63, wr = wid >> 2, wc = wid & 3, fr = lane & 15, fq = lane >> 4;
    const int K = g.K, nt = K / BK;
    unsigned voffA[2], voffB[2];
#pragma unroll
    for (int i = 0; i < 2; ++i) { int R, C; stage_rc(tid * 16 + i * 8192, R, C); const int Rb = Epi::PERM ? ((R & ~31) + perm32(R & 31)) : R;
        voffA[i] = (unsigned)(R * K + C) * 2u; voffB[i] = (unsigned)(Rb * K + C) * 2u; }
    const size_t kstep = (size_t)(BK * 2);
    const size_t hstep = (size_t)HALF * K * 2;
    const size_t tstep = 2 * hstep;
    const unsigned ldsw = (unsigned)wid * 1024u;
    const int aoff = lds_byte(wr * 64 + fr, fq * 8), boff = lds_byte(wc * 32 + fr, fq * 8);
#define PG8_SA(b, h) (((b) * 2 + (h)) * HTB)
#define PG8_SB(b, h) ((4 + (b) * 2 + (h)) * HTB)
#define PG8_STAGE(bufoff, gbase, voff) do { _Pragma("unroll") for (int _i = 0; _i < 2; ++_i) \
        __builtin_amdgcn_global_load_lds((const unsigned*)((const char*)(gbase) + (voff)[_i]), (LAS unsigned*)(lds + (bufoff) + ldsw + _i * 8192), 16, 0, 0); } while (0)
#define PG8_LDA(dst, b, h) do { _Pragma("unroll") for (int m = 0; m < 4; ++m) _Pragma("unroll") for (int k = 0; k < 2; ++k) dst[m][k] = *(const LAS f16x8*)(lds + PG8_SA(b, h) + aoff + m * 2048 + k * 1024); } while (0)
#define PG8_LDB(dst, b, h) do { _Pragma("unroll") for (int n = 0; n < 2; ++n) _Pragma("unroll") for (int k = 0; k < 2; ++k) dst[n][k] = *(const LAS f16x8*)(lds + PG8_SB(b, h) + boff + n * 2048 + k * 1024); } while (0)
#define PG8_MMA(ai, bj, At, Bt) do { __builtin_amdgcn_s_setprio(1); _Pragma("unroll") for (int m = 0; m < 4; ++m) _Pragma("unroll") for (int n = 0; n < 2; ++n) _Pragma("unroll") for (int k = 0; k < 2; ++k) \
        acc[ai][bj][m][n] = __builtin_amdgcn_mfma_f32_16x16x32_f16(Bt[n][k], At[m][k], acc[ai][bj][m][n], 0, 0, 0); __builtin_amdgcn_s_setprio(0); } while (0)
#define PG8_WAIT_V(n) asm volatile("s_waitcnt vmcnt(" #n ")" ::: "memory")
#define PG8_WAIT_L(n) asm volatile("s_waitcnt lgkmcnt(" #n ")" ::: "memory")
#define PG8_BAR __builtin_amdgcn_s_barrier()
#define PG8_SCHED __builtin_amdgcn_sched_barrier(0)
    Unit cur, nxt; int ui = 0;
    if (!S.next(0, cur)) return;
    f32x4 acc[2][2][4][2];
#pragma unroll
    for (int a = 0; a < 2; ++a)
#pragma unroll
        for (int b = 0; b < 2; ++b)
#pragma unroll
            for (int m = 0; m < 4; ++m)
#pragma unroll
                for (int n = 0; n < 2; ++n) acc[a][b][m][n] = (f32x4){0.f, 0.f, 0.f, 0.f};
    f16x8 At[4][2], B0[2][2], B1[2][2];
    const char* cA = (const char*)g.A + (size_t)cur.pm * tstep; const char* cB = (const char*)g.Bt + (size_t)cur.pn * tstep;
    S.a_ready(cur);
    PG8_STAGE(PG8_SB(0, 0), cB, voffB); PG8_STAGE(PG8_SA(0, 0), cA, voffA); PG8_STAGE(PG8_SB(0, 1), cB + hstep, voffB); PG8_STAGE(PG8_SA(0, 1), cA + hstep, voffA);
    if (wr == 1) PG8_BAR;
    PG8_WAIT_V(4); PG8_BAR;
    PG8_STAGE(PG8_SB(1, 0), cB + kstep, voffB); PG8_STAGE(PG8_SA(1, 0), cA + kstep, voffA); PG8_STAGE(PG8_SB(1, 1), cB + hstep + kstep, voffB);
    PG8_WAIT_V(6); PG8_BAR;
    for (;;) {
        const bool has_next = S.next(ui + 1, nxt);
        const char* nA = has_next ? (const char*)g.A + (size_t)nxt.pm * tstep : cA; const char* nB = has_next ? (const char*)g.Bt + (size_t)nxt.pn * tstep : cB;
        for (int t = 0; t < nt; t += 2) {
            const bool last = (t == nt - 2);
            const char* a1 = cA + (size_t)(t + 1) * kstep;
            const char* a2 = last ? nA : cA + (size_t)(t + 2) * kstep; const char* b2 = last ? nB : cB + (size_t)(t + 2) * kstep;
            const char* a3 = a2 + kstep; const char* b3 = b2 + kstep;
            if (last && has_next) S.a_ready(nxt);
            PG8_LDB(B0, 0, 0); PG8_SCHED; PG8_LDA(At, 0, 0); PG8_STAGE(PG8_SA(1, 1), a1 + hstep, voffA);
            PG8_WAIT_L(8); PG8_BAR; PG8_WAIT_L(0); PG8_MMA(0, 0, At, B0); PG8_BAR; PG8_SCHED;
            PG8_LDB(B1, 0, 1); PG8_STAGE(PG8_SB(0, 0), b2, voffB);
            PG8_BAR; PG8_WAIT_L(0); PG8_MMA(0, 1, At, B1); PG8_BAR;
            PG8_LDA(At, 0, 1); PG8_STAGE(PG8_SA(0, 0), a2, voffA);
            PG8_BAR; PG8_WAIT_L(0); PG8_MMA(1, 0, At, B0); PG8_BAR; PG8_SCHED;
            PG8_STAGE(PG8_SB(0, 1), b2 + hstep, voffB);
            PG8_WAIT_V(6); PG8_BAR; PG8_MMA(1, 1, At, B1); PG8_BAR;
            PG8_LDB(B0, 1, 0); PG8_SCHED; PG8_LDA(At, 1, 0); PG8_STAGE(PG8_SA(0, 1), a2 + hstep, voffA);
            PG8_WAIT_L(8); PG8_BAR; PG8_WAIT_L(0); PG8_MMA(0, 0, At, B0); PG8_BAR; PG8_SCHED;
            PG8_LDB(B1, 1, 1); PG8_STAGE(PG8_SB(1, 0), b3, voffB);
            PG8_BAR; PG8_WAIT_L(0); PG8_MMA(0, 1, At, B1); PG8_BAR;
            PG8_LDA(At, 1, 1); PG8_STAGE(PG8_SA(1, 0), a3, voffA);
            PG8_BAR; PG8_WAIT_L(0); PG8_MMA(1, 0, At, B0); PG8_BAR; PG8_SCHED;
            PG8_STAGE(PG8_SB(1, 1), b3 + hstep, voffB);
            PG8_WAIT_V(6); PG8_BAR; PG8_MMA(1, 1, At, B1); PG8_BAR;
        }
        E(acc, cur, wr, wc, fr, fq);
        if (!has_next) break;
#pragma unroll
        for (int a = 0; a < 2; ++a)
#pragma unroll
            for (int b = 0; b < 2; ++b)
#pragma unroll
                for (int m = 0; m < 4; ++m)
#pragma unroll
                    for (int n = 0; n < 2; ++n) acc[a][b][m][n] = (f32x4){0.f, 0.f, 0.f, 0.f};
        cur = nxt; cA = nA; cB = nB; ++ui;
    }
    PG8_WAIT_V(0);
    if (wr == 0) PG8_BAR;
    PG8_BAR;
#undef PG8_SA
#undef PG8_SB
#undef PG8_STAGE
#undef PG8_LDA
#undef PG8_LDB
#undef PG8_MMA
#undef PG8_WAIT_V
#undef PG8_WAIT_L
#undef PG8_BAR
#undef PG8_SCHED
}
}

struct EpiIn {
    static constexpr bool PERM = true;
    f16* proj; const float* rssp; const float* bias; float* kvout;
    DI void operator()(const f32x4 (&acc)[2][2][4][2], const pg8::Unit& u, int wr, int wc, int fr, int fq) const {
        const int row0 = u.pm * 256 + wr * 64 + fr, colt = wc * 32 + 8 * fq;
        f32x4 bv[2][2];
#pragma unroll
        for (int bj = 0; bj < 2; ++bj)
#pragma unroll
            for (int n = 0; n < 2; ++n) bv[bj][n] = *(const f32x4*)(bias + u.pn * 256 + colt + bj * 128 + 4 * n);
        f16* pt = proj + (size_t)u.pn * SEQ * 256;
#pragma unroll
        for (int ai = 0; ai < 2; ++ai)
#pragma unroll
            for (int m = 0; m < 4; ++m) {
                const int row = row0 + ai * 128 + m * 16;
                const f32x4* rp = (const f32x4*)(rssp + (size_t)row * 16);
                const f32x4 s0 = rp[0], s1 = rp[1], s2 = rp[2], s3 = rp[3];
                const float ss = ((s0[0] + s0[1]) + (s0[2] + s0[3])) + ((s1[0] + s1[1]) + (s1[2] + s1[3])) + ((s2[0] + s2[1]) + (s2[2] + s2[3])) + ((s3[0] + s3[1]) + (s3[2] + s3[3]));
                const float r = rsqrtf(ss * (1.f / 1024.f) + EPS);
#pragma unroll
                for (int bj = 0; bj < 2; ++bj) {
                    const f32x4 v0 = acc[ai][bj][m][0] * r + bv[bj][0], v1 = acc[ai][bj][m][1] * r + bv[bj][1];
                    f16x8 h; h[0] = (f16)v0[0]; h[1] = (f16)v0[1]; h[2] = (f16)v0[2]; h[3] = (f16)v0[3]; h[4] = (f16)v1[0]; h[5] = (f16)v1[1]; h[6] = (f16)v1[2]; h[7] = (f16)v1[3];
                    *(f16x8*)(pt + (size_t)row * 256 + colt + bj * 128) = h;
                    if (u.pn == 12) { float* kp = kvout + (size_t)row * 256 + colt + bj * 128; *(f32x4*)kp = v0; *(f32x4*)(kp + 4) = v1; }
                }
            }
    }
};
struct EpiOut {
    static constexpr bool PERM = false;
    const float* xin; float* xout; const float* gate; f16* a16; const float* gnext; float* rssp;
    DI void operator()(const f32x4 (&acc)[2][2][4][2], const pg8::Unit& u, int wr, int wc, int fr, int fq) const {
        const int row0 = u.pm * 256 + wr * 64 + fr, col0 = u.pn * 256 + wc * 32 + 4 * fq;
        float ss[2][4];
#pragma unroll
        for (int ai = 0; ai < 2; ++ai)
#pragma unroll
            for (int m = 0; m < 4; ++m) ss[ai][m] = 0.f;
#pragma unroll
        for (int bj = 0; bj < 2; ++bj)
#pragma unroll
            for (int n = 0; n < 2; ++n) {
                const int col = col0 + bj * 128 + n * 16;
                const f32x4 gv = *(const f32x4*)(gate + col); f32x4 gn = (f32x4){0.f, 0.f, 0.f, 0.f}; if (a16) gn = *(const f32x4*)(gnext + col);
#pragma unroll
                for (int ai = 0; ai < 2; ++ai)
#pragma unroll
                    for (int m = 0; m < 4; ++m) {
                        const int row = row0 + ai * 128 + m * 16;
                        const f32x4 xv = *(const f32x4*)(xin + (size_t)row * 1024 + col);
                        const f32x4 o = xv + gv * acc[ai][bj][m][n];
                        *(f32x4*)(xout + (size_t)row * 1024 + col) = o;
                        ss[ai][m] += (o[0] * o[0] + o[1] * o[1]) + (o[2] * o[2] + o[3] * o[3]);
                        if (a16) { f16x4 h; h[0] = (f16)(o[0] * gn[0]); h[1] = (f16)(o[1] * gn[1]); h[2] = (f16)(o[2] * gn[2]); h[3] = (f16)(o[3] * gn[3]);
                            *(f16x4*)(a16 + (size_t)row * 1024 + col) = h; }
                    }
                asm volatile("" ::: "memory");
            }
        if (a16) {
#pragma unroll
            for (int ai = 0; ai < 2; ++ai)
#pragma unroll
                for (int m = 0; m < 4; ++m) { float v = ss[ai][m]; v += __shfl_xor(v, 16); v += __shfl_xor(v, 32);
                    if (fq == 0) rssp[(size_t)(row0 + ai * 128 + m * 16) * 16 + u.pn * 4 + wc] = v; }
        }
    }
};

template <int MP  , class AFn, class OFn>
DI void skinny_item(LAS unsigned char* lds, const float* W, int ldw, int n0, int ncols, int M, AFn afn, OFn ofn) {
    const int tid = ltid(), wave = tid >> 6, lane = tid & 63;
    LAS float* As = (LAS float*)lds;
    float acc[MP];
#pragma unroll
    for (int m = 0; m < MP; ++m) acc[m] = 0.f;
    for (int kc = 0; kc < 1024; kc += 512) {
        __syncthreads();
#pragma unroll 4
        for (int m = 0; m < MP; ++m) As[tid * 36 + m] = (m < M) ? afn(m, kc + tid) : 0.f;
        __syncthreads();
        const int kb = wave * 64;
#pragma unroll 8
        for (int kk = 0; kk < 64; ++kk) {
            const float w = (lane < ncols) ? W[(size_t)(kc + kb + kk) * ldw + n0 + lane] : 0.f;
            const float av = As[(kb + kk) * 36 + lane];
#pragma unroll
            for (int m = 0; m < MP; ++m) acc[m] += __builtin_bit_cast(float, __builtin_amdgcn_readlane(__builtin_bit_cast(int, av), m)) * w;
        }
    }
    __syncthreads();
    LAS float* R = (LAS float*)lds;
#pragma unroll
    for (int m = 0; m < MP; ++m) R[(wave * 36 + m) * 64 + lane] = acc[m];
    __syncthreads();
    for (int idx = tid; idx < M * 64; idx += 512) { const int m = idx >> 6, c = idx & 63; float s = 0.f;
#pragma unroll
        for (int w = 0; w < 8; ++w) s += R[(w * 36 + m) * 64 + c];
        if (c < ncols) ofn(m, n0 + c, s); }
    __syncthreads();
}

template <bool F32> struct Raw16 { f32x4 f[4]; f16x8 hv[2];
    DI void ld(const void* p) { if (F32) {
#pragma unroll
            for (int i = 0; i < 4; ++i) f[i] = *(const f32x4*)((const float*)p + 4 * i); } else { hv[0] = *(const f16x8*)p; hv[1] = *(const f16x8*)((const f16*)p + 8); } }
    DI f16x8 get(int i) const { if (F32) { const f32x4 a = f[2 * i], b = f[2 * i + 1]; f16x8 r; r[0] = (f16)a[0]; r[1] = (f16)a[1]; r[2] = (f16)a[2]; r[3] = (f16)a[3]; r[4] = (f16)b[0]; r[5] = (f16)b[1]; r[6] = (f16)b[2]; r[7] = (f16)b[3]; return r; } return hv[i]; } };
template <bool SRC_F32, class ChunkFn>
DI void compress_item(LAS unsigned char* lds, ChunkFn chunkp  , int c0, const f16* w1t, const float* peb, const f16* w2t  , const float* b2, const float* kg, float* out, f16* out16, f16* outT16) {
    typedef typename std::conditional<SRC_F32, float, f16>::type T;
    const int tid = ltid(), wave = tid >> 6, lane = tid & 63, wm = wave >> 2, wq = wave & 3, r = lane & 31, h = lane >> 5;
    LAS f16* As = (LAS f16*)lds;
    LAS f16* Bs = (LAS f16*)(lds + 2 * 18432);
    f32x16 acc[2][2];
#pragma unroll
    for (int a = 0; a < 2; ++a)
#pragma unroll
        for (int b = 0; b < 2; ++b)
#pragma unroll
            for (int i = 0; i < 16; ++i) acc[a][b][i] = 0.f;
    const int am = tid >> 2, aseg = tid & 3, bn = tid >> 1, bseg = tid & 1;
    int ch = c0 + am; ch = ch < 1023 ? ch : 1023;
    const T* asrc = (const T*)chunkp(ch) + aseg * 16;
    const f16* bsrc = w1t + (size_t)(bn & 127) * 2048 + (size_t)(bn >> 7) * 1024 + bseg * 32;
    Raw16<SRC_F32> ra[3]; f16x8 rb[3][4];
#pragma unroll
    for (int i = 0; i < 3; ++i) { ra[i].ld(asrc + i * 256);
#pragma unroll
        for (int j = 0; j < 4; ++j) rb[i][j] = ld_h8(bsrc + i * 64 + 8 * j); }
    __syncthreads();
    *(LAS f16x8*)(As + am * 72 + aseg * 16) = ra[0].get(0); *(LAS f16x8*)(As + am * 72 + aseg * 16 + 8) = ra[0].get(1);
#pragma unroll
    for (int i = 0; i < 4; ++i) *(LAS f16x8*)(Bs + bn * 72 + bseg * 32 + 8 * i) = rb[0][i];
    ra[0].ld(asrc + 3 * 256);
#pragma unroll
    for (int i = 0; i < 4; ++i) rb[0][i] = ld_h8(bsrc + 3 * 64 + 8 * i);
    lds_barrier();
#pragma unroll
    for (int kb = 0; kb < 16; ++kb) {
        const int cur = kb & 1;
        const LAS f16* Ac = As + cur * 9216 + (64 * wm + r) * 72 + 8 * h; const LAS f16* Bc = Bs + cur * 18432 + (64 * wq + r) * 72 + 8 * h;
#pragma unroll
        for (int ks = 0; ks < 4; ++ks) {
            const f16x8 a0 = *(const LAS f16x8*)(Ac + 16 * ks), a1 = *(const LAS f16x8*)(Ac + 32 * 72 + 16 * ks), b0 = *(const LAS f16x8*)(Bc + 16 * ks), b1 = *(const LAS f16x8*)(Bc + 32 * 72 + 16 * ks);
            acc[0][0] = __builtin_amdgcn_mfma_f32_32x32x16_f16(a0, b0, acc[0][0], 0, 0, 0); acc[0][1] = __builtin_amdgcn_mfma_f32_32x32x16_f16(a0, b1, acc[0][1], 0, 0, 0);
            acc[1][0] = __builtin_amdgcn_mfma_f32_32x32x16_f16(a1, b0, acc[1][0], 0, 0, 0); acc[1][1] = __builtin_amdgcn_mfma_f32_32x32x16_f16(a1, b1, acc[1][1], 0, 0, 0);
        }
        if (kb + 1 < 16) { const int nx = cur ^ 1, sl = (kb + 1) % 3;
            *(LAS f16x8*)(As + nx * 9216 + am * 72 + aseg * 16) = ra[sl].get(0); *(LAS f16x8*)(As + nx * 9216 + am * 72 + aseg * 16 + 8) = ra[sl].get(1);
#pragma unroll
            for (int i = 0; i < 4; ++i) *(LAS f16x8*)(Bs + nx * 18432 + bn * 72 + bseg * 32 + 8 * i) = rb[sl][i];
            if (kb + 4 < 16) { ra[sl].ld(asrc + (kb + 4) * 256);
#pragma unroll
                for (int i = 0; i < 4; ++i) rb[sl][i] = ld_h8(bsrc + (kb + 4) * 64 + 8 * i); } }
        lds_barrier();
    }
    LAS float* SL = (LAS float*)lds;
    LAS f16* HS = (LAS f16*)(lds + 65536);
    if (wq >= 2) {
#pragma unroll
        for (int a = 0; a < 2; ++a)
#pragma unroll
            for (int b = 0; b < 2; ++b)
#pragma unroll
                for (int i = 0; i < 16; ++i) SL[(64 * wm + 32 * a + (i & 3) + 8 * (i >> 2) + 4 * h) * 128 + 64 * (wq - 2) + 32 * b + r] = acc[a][b][i];
    }
    __syncthreads();
    if (wq < 2) {
#pragma unroll
        for (int a = 0; a < 2; ++a)
#pragma unroll
            for (int b = 0; b < 2; ++b) { const int f = 64 * wq + 32 * b + r; float pb = 0.f;
#pragma unroll
                for (int p8 = 0; p8 < 8; ++p8) pb += peb[p8 * 128 + f];
#pragma unroll
                for (int i = 0; i < 16; ++i) { const int m = 64 * wm + 32 * a + (i & 3) + 8 * (i >> 2) + 4 * h; const float sv = m < 127 ? SL[(m + 1) * 128 + f] : 0.f;
                    HS[m * 136 + f] = (f16)siluf_(acc[a][b][i] + sv + pb); } }
    }
    __syncthreads();
    {
        const int fr = lane & 15, q = lane >> 4;
        f32x4 o[4];
#pragma unroll
        for (int et = 0; et < 4; ++et) o[et] = (f32x4){0.f, 0.f, 0.f, 0.f};
#pragma unroll
        for (int ks = 0; ks < 4; ++ks) { const f16x8 av = *(const LAS f16x8*)(HS + (16 * wave + fr) * 136 + 32 * ks + 8 * q);
#pragma unroll
            for (int et = 0; et < 4; ++et) o[et] = __builtin_amdgcn_mfma_f32_16x16x32_f16(av, ld_h8(w2t + (size_t)(16 * et + fr) * 128 + 32 * ks + 8 * q), o[et], 0, 0, 0); }
        float bb[4], gg[4];
#pragma unroll
        for (int et = 0; et < 4; ++et) { bb[et] = b2[16 * et + fr]; gg[et] = kg ? kg[16 * et + fr] : 1.f; }
#pragma unroll
        for (int j = 0; j < 4; ++j) {
            const int row = 16 * wave + 4 * q + j, blk = c0 + row; float v[4], ss = 0.f;
#pragma unroll
            for (int et = 0; et < 4; ++et) { v[et] = o[et][j] + bb[et]; ss += v[et] * v[et]; }
            if (kg) { ss += __shfl_xor(ss, 1); ss += __shfl_xor(ss, 2); ss += __shfl_xor(ss, 4); ss += __shfl_xor(ss, 8); const float rn = rsqrtf(ss * (1.f / 64.f) + EPS);
#pragma unroll
                for (int et = 0; et < 4; ++et) v[et] = v[et] * rn * gg[et]; }
            const bool okrow = row < 127 && blk < 1023, wr16 = row < 127 && blk < 1024;
#pragma unroll
            for (int et = 0; et < 4; ++et) { const float x = okrow ? v[et] : 0.f; const int e = 16 * et + fr;
                if (out && okrow) out[(size_t)blk * 64 + e] = x;
                if (out16 && wr16) out16[(size_t)blk * 64 + e] = (f16)x;
                if (outT16 && wr16) outT16[(size_t)e * 1024 + blk] = (f16)x; }
        }
    }
    __syncthreads();
}

struct PromptKV {
    const f16 *ks, *vs, *kw, *vw;
    DI void krow_sel(int pos, float (&k)[64]) const { const f16* p = ks + (size_t)pos * 64;
#pragma unroll
        for (int i = 0; i < 8; ++i) { const f16x8 v = ld_h8(p + i * 8);
#pragma unroll
            for (int j = 0; j < 8; ++j) k[i * 8 + j] = (float)v[j]; } }
    DI float v_sel(int pos, int d) const { return (float)vs[(size_t)pos * 64 + d]; }
    DI void krow_win(int pos, float (&k)[64]) const { const f16* p = kw + (size_t)pos * 64;
#pragma unroll
        for (int i = 0; i < 8; ++i) { const f16x8 v = ld_h8(p + i * 8);
#pragma unroll
            for (int j = 0; j < 8; ++j) k[i * 8 + j] = (float)v[j]; } }
    DI float v_win(int pos, int d) const { return (float)vw[(size_t)pos * 64 + d]; }
};
struct SampleKV {
    const float* ckv; const int* pt; const float* cwin; const float* nks; const float* nvs; const float* nkw; const float* nvw;
    DI const float* prow(int pos, int slot) const { return ckv + ((size_t)pt[pos >> 7] * 128 + (pos & 127)) * 256 + slot * 64; }
    DI void ld64(const float* p, float (&k)[64]) const {
#pragma unroll
        for (int i = 0; i < 16; ++i) { const f32x4 v = *(const f32x4*)(p + i * 4); k[i * 4] = v[0]; k[i * 4 + 1] = v[1]; k[i * 4 + 2] = v[2]; k[i * 4 + 3] = v[3]; } }
    DI void krow_sel(int pos, float (&k)[64]) const { ld64(pos < PAST ? prow(pos, 2) : nks, k); }
    DI float v_sel(int pos, int d) const { return pos < PAST ? prow(pos, 3)[d] : nvs[d]; }
    DI void krow_win(int pos, float (&k)[64]) const { ld64(pos < PAST ? cwin + (size_t)(pos - (PAST - 512)) * 128 : nkw, k); }
    DI float v_win(int pos, int d) const { return pos < PAST ? cwin[(size_t)(pos - (PAST - 512)) * 128 + 64 + d] : nvw[d]; }
};
template <class KV>
DI void nsa_token(LAS float* wl, int qpos, const float* KC, const float* VC, const KV& kv, const float* gates  , float (&o)[4]) {
    const int lane = ltid() & 63;
    LAS float* sc = wl; LAS float* qs = wl + 4096; LAS int* sel = (LAS int*)(wl + 4096 + 256);
    const int cur = qpos >> 6;
    const int ncv = qpos >= 31 ? ((qpos - 31) >> 4) + 1 : 0;
    float oc[4] = {0.f, 0.f, 0.f, 0.f}, os[4] = {0.f, 0.f, 0.f, 0.f}, ow[4] = {0.f, 0.f, 0.f, 0.f};
    {
        float mx[4] = {-3e38f, -3e38f, -3e38f, -3e38f};
        for (int c = lane; c < ncv; c += 64) {
            asm volatile("" ::: "memory");
            float s[4] = {0.f, 0.f, 0.f, 0.f}; const float* kp = KC + (size_t)c * 64;
#pragma unroll
            for (int d4 = 0; d4 < 16; ++d4) { const f32x4 kvv = *(const f32x4*)(kp + d4 * 4);
#pragma unroll
                for (int j = 0; j < 4; ++j) { const f32x4 q = *(const LAS f32x4*)(qs + (d4 * 4 + j) * 4); s[0] += q[0] * kvv[j]; s[1] += q[1] * kvv[j]; s[2] += q[2] * kvv[j]; s[3] += q[3] * kvv[j]; } }
#pragma unroll
            for (int hh = 0; hh < 4; ++hh) { s[hh] *= 0.125f; sc[hh * 1024 + c] = s[hh]; mx[hh] = fmaxf(mx[hh], s[hh]); }
        }
        float inv[4];
#pragma unroll
        for (int hh = 0; hh < 4; ++hh) { mx[hh] = wmaxf(mx[hh]); float sm = 0.f; for (int c = lane; c < ncv; c += 64) { const float e = __expf(sc[hh * 1024 + c] - mx[hh]); sc[hh * 1024 + c] = e; sm += e; } sm = wsum(sm); inv[hh] = ncv > 0 ? 1.f / sm : 0.f; }
        for (int c = lane; c < ncv; c += 64) {
#pragma unroll
            for (int hh = 0; hh < 4; ++hh) sc[hh * 1024 + c] *= inv[hh]; }
        __builtin_amdgcn_wave_barrier();
        for (int c = 0; c < ncv; ++c) { const float v = VC[(size_t)c * 64 + lane];
#pragma unroll
            for (int hh = 0; hh < 4; ++hh) oc[hh] += sc[hh * 1024 + c] * v; }
    }
    const int nsel = (cur + 1) < 16 ? (cur + 1) : 16;
    {
        float scv[5];
#pragma unroll
        for (int i = 0; i < 5; ++i) {
            const int j = lane + 64 * i; float v = -3e38f;
            if (j <= cur) {
                if (j == 0 || j == cur || j == cur - 1) v = 3e38f;
                else { float a = 0.f;
#pragma unroll
                    for (int o5 = -1; o5 < 4; ++o5) { const int c = 4 * j + o5; if (c >= 0 && c < ncv) { const float p = (sc[c] + sc[1024 + c]) + (sc[2048 + c] + sc[3072 + c]); a += (o5 == -1 || o5 == 3) ? 0.5f * p : p; } }
                    v = a; }
            }
            scv[i] = v;
        }
        for (int k = 0; k < nsel; ++k) {
            float bv = scv[0]; int bi = lane;
#pragma unroll
            for (int i = 1; i < 5; ++i) if (scv[i] > bv) { bv = scv[i]; bi = lane + 64 * i; }
#pragma unroll
            for (int off = 32; off > 0; off >>= 1) { const float ov = __shfl_xor(bv, off); const int oi = __shfl_xor(bi, off); if (ov > bv || (ov == bv && oi < bi)) { bv = ov; bi = oi; } }
            if (lane == 0) sel[k] = bi;
#pragma unroll
            for (int i = 0; i < 5; ++i) if (lane + 64 * i == bi) scv[i] = -3e38f;
        }
        __builtin_amdgcn_wave_barrier();
    }
    {
        float mx[4] = {-3e38f, -3e38f, -3e38f, -3e38f};
        for (int k = 0; k < nsel; ++k) {
            asm volatile("" ::: "memory");
            const int pos = sel[k] * 64 + lane; float s[4] = {-1e30f, -1e30f, -1e30f, -1e30f};
            if (pos <= qpos) { float kr[64]; kv.krow_sel(pos, kr); s[0] = s[1] = s[2] = s[3] = 0.f;
#pragma unroll
                for (int d = 0; d < 64; ++d) { const f32x4 q = *(const LAS f32x4*)(qs + d * 4); s[0] += q[0] * kr[d]; s[1] += q[1] * kr[d]; s[2] += q[2] * kr[d]; s[3] += q[3] * kr[d]; }
#pragma unroll
                for (int hh = 0; hh < 4; ++hh) s[hh] *= 0.125f; }
#pragma unroll
            for (int hh = 0; hh < 4; ++hh) { sc[hh * 1024 + k * 64 + lane] = s[hh]; mx[hh] = fmaxf(mx[hh], s[hh]); }
        }
        float inv[4];
#pragma unroll
        for (int hh = 0; hh < 4; ++hh) { mx[hh] = wmaxf(mx[hh]); float sm = 0.f; for (int k = 0; k < nsel; ++k) { const float sv = sc[hh * 1024 + k * 64 + lane]; const float e = sv > -1e29f ? __expf(sv - mx[hh]) : 0.f; sc[hh * 1024 + k * 64 + lane] = e; sm += e; } sm = wsum(sm); inv[hh] = 1.f / sm; }
        __builtin_amdgcn_wave_barrier();
        for (int k = 0; k < nsel; ++k) { const int p0 = sel[k] * 64; int nk = qpos - p0 + 1; nk = nk > 64 ? 64 : nk;
            for (int kk = 0; kk < nk; ++kk) { const float v = kv.v_sel(p0 + kk, lane);
#pragma unroll
                for (int hh = 0; hh < 4; ++hh) os[hh] += sc[hh * 1024 + k * 64 + kk] * v; } }
#pragma unroll
        for (int hh = 0; hh < 4; ++hh) os[hh] *= inv[hh];
        __builtin_amdgcn_wave_barrier();
    }
    {
        const int lo = qpos - 512 > 0 ? qpos - 512 : 0, nw = qpos - lo + 1;
        float mx[4] = {-3e38f, -3e38f, -3e38f, -3e38f};
        for (int i = lane; i < nw; i += 64) { asm volatile("" ::: "memory"); float kr[64]; kv.krow_win(lo + i, kr); float s[4] = {0.f, 0.f, 0.f, 0.f};
#pragma unroll
            for (int d = 0; d < 64; ++d) { const f32x4 q = *(const LAS f32x4*)(qs + d * 4); s[0] += q[0] * kr[d]; s[1] += q[1] * kr[d]; s[2] += q[2] * kr[d]; s[3] += q[3] * kr[d]; }
#pragma unroll
            for (int hh = 0; hh < 4; ++hh) { s[hh] *= 0.125f; sc[hh * 1024 + i] = s[hh]; mx[hh] = fmaxf(mx[hh], s[hh]); } }
        float inv[4];
#pragma unroll
        for (int hh = 0; hh < 4; ++hh) { mx[hh] = wmaxf(mx[hh]); float sm = 0.f; for (int i = lane; i < nw; i += 64) { const float e = __expf(sc[hh * 1024 + i] - mx[hh]); sc[hh * 1024 + i] = e; sm += e; } sm = wsum(sm); inv[hh] = 1.f / sm; }
        __builtin_amdgcn_wave_barrier();
        for (int i = 0; i < nw; ++i) { const float v = kv.v_win(lo + i, lane);
#pragma unroll
            for (int hh = 0; hh < 4; ++hh) ow[hh] += sc[hh * 1024 + i] * v; }
#pragma unroll
        for (int hh = 0; hh < 4; ++hh) ow[hh] *= inv[hh];
        __builtin_amdgcn_wave_barrier();
    }
#pragma unroll
    for (int hh = 0; hh < 4; ++hh) o[hh] = gates[hh * 3] * oc[hh] + gates[hh * 3 + 1] * os[hh] + gates[hh * 3 + 2] * ow[hh];
}

template <class LF, class SF>
DI void tr64(LAS unsigned char* lds, LF lf, SF sf) {
    LAS float* T = (LAS float*)lds;
    const int tid = ltid();
    __syncthreads();
#pragma unroll
    for (int e8 = 0; e8 < 8; ++e8) { const int e = tid + 512 * e8, kk = e >> 6, nn = e & 63; T[kk * 65 + nn] = lf(kk, nn); }
    __syncthreads();
#pragma unroll
    for (int e8 = 0; e8 < 8; ++e8) { const int e = tid + 512 * e8, nn = e >> 6, kk = e & 63; sf(nn, kk, (f16)T[kk * 65 + nn]); }
}

typedef const Args __attribute__((address_space(4)))* ArgP;
struct Ctx { ArgP ap; LAS unsigned char* lds; unsigned char* ws; float* out; int tid, lane, wave, bid, G; };
DI Ctx mkctx(LAS unsigned char* lds) {
    Ctx c; const char __attribute__((address_space(4)))* kp = (const char __attribute__((address_space(4)))*)__builtin_amdgcn_kernarg_segment_ptr();
    asm volatile("" : "+s"(kp));
    c.ap = (ArgP)kp; c.lds = lds; c.ws = c.ap->ws; c.out = c.ap->out;
    int tid = threadIdx.x; asm volatile("" : "+v"(tid));
    c.tid = tid; c.lane = tid & 63; c.wave = __builtin_amdgcn_readfirstlane(tid >> 6); c.bid = blockIdx.x; c.G = gridDim.x;
    return c;
}
#define INP(i) ((const float*)c.ap->in[i])
#define WSF(off) ((float*)(c.ws + (off)))
#define WSH(off) ((f16*)(c.ws + (off)))

DI void ph_prologue(LAS unsigned char* lds_) {
    const Ctx c = mkctx(lds_); LAS unsigned char* lds = c.lds; const int tid = c.tid, bid = c.bid, G = c.G;
    const float* c_p = INP(I_CP); const float* c_s = INP(I_CS); const float* w_ada = INP(I_WADA); const float* b_ada = INP(I_BADA);
    const float* w_in = INP(I_WIN); const float* w_out = INP(I_WOUT); const float* w1 = INP(I_W1);
    float* ADA = WSF(WS_ADA); float* BIAS = WSF(WS_BIAS); float* PEB = WSF(WS_PEB); f16* WTIN = WSH(WS_WTIN); f16* WTOUT = WSH(WS_WTOUT); f16* W1T = WSH(WS_W1T);
    constexpr int N_ADA = 96, N_WTIN = 1920, N_WTOUT = 512, N_W1T = 256, N_PEB = 32, N_W2T = 8, N_ALL = N_ADA + N_WTIN + N_WTOUT + N_W1T + N_PEB + N_W2T + 1;
    constexpr int XA = 1;
    const bool reb = G == 256; const int n_mine = reb ? (bid < N_ADA ? 1 + XA : (N_ALL - N_ADA - XA * N_ADA - (bid - N_ADA) + 159) / 160) : (N_ALL - bid + G - 1) / G;
    for (int k = 0; k < n_mine; ++k) {
        const int it = !reb ? bid + k * G : (bid < N_ADA ? (k == 0 ? bid : N_ADA + XA * bid + (k - 1)) : N_ADA + XA * N_ADA + (bid - N_ADA) + 160 * k);
        int i = it;
        if (i < N_ADA) { const int l = i / 48, n0 = (i % 48) * 64;
            skinny_item<36>(lds, w_ada + (size_t)l * 1024 * 3072, 3072, n0, 64, 33,
                [&](int m, int k) { return siluf_(m < 32 ? c_s[m * 1024 + k] : c_p[k]); },
                [&](int m, int n, float v) { ADA[((size_t)l * 33 + m) * 3072 + n] = v + b_ada[l * 3072 + n]; });
            continue; }
        i -= N_ADA;
        if (i < N_WTIN) { const int l = i / 960, r = i % 960, n0 = (r / 16) * 64, k0 = (r % 16) * 64; const float* src = w_in + (size_t)l * 1024 * DIN; f16* dst = WTIN + (size_t)l * NPD * 1024;
            tr64(lds, [&](int kk, int nn) { const int sc = src_col(n0 + nn); return sc >= 0 ? src[(size_t)(k0 + kk) * DIN + sc] : 0.f; },
                      [&](int nn, int kk, f16 v) { dst[(size_t)(n0 + nn) * 1024 + k0 + kk] = v; });
            continue; }
        i -= N_WTIN;
        if (i < N_WTOUT) { const int l = i / 256, r = i % 256, n0 = (r / 16) * 64, k0 = (r % 16) * 64; const float* src = w_out + (size_t)l * 1024 * 1024; f16* dst = WTOUT + (size_t)l * 1024 * 1024;
            tr64(lds, [&](int kk, int nn) { return src[(size_t)(k0 + kk) * 1024 + n0 + nn]; },
                      [&](int nn, int kk, f16 v) { dst[(size_t)(n0 + nn) * 1024 + k0 + kk] = v; });
            continue; }
        i -= N_WTOUT;
        if (i < N_W1T) { const int ls = i / 64, r = i % 64, k0 = (r / 2) * 64, n0 = (r % 2) * 64; const float* src = w1 + (size_t)ls * 2048 * 128; f16* dst = W1T + (size_t)ls * 128 * 2048;
            tr64(lds, [&](int kk, int nn) { return src[(size_t)(k0 + kk) * 128 + n0 + nn]; },
                      [&](int nn, int kk, f16 v) { dst[(size_t)(n0 + nn) * 2048 + k0 + kk] = v; });
            continue; }
        i -= N_W1T;
        if (i < N_PEB) { const int ls = i >> 3, ks8 = i & 7; const float* pe = INP(I_PE) + (size_t)ls * 2048 + ks8 * 256; const float* w = w1 + ((size_t)ls * 2048 + ks8 * 256) * 128; const float* b1 = INP(I_B1) + ls * 128;
            LAS float* R = (LAS float*)lds; const int f = tid & 127, kq = tid >> 7; float sacc = 0.f;
            __syncthreads();
#pragma unroll 16
            for (int k = kq * 64; k < kq * 64 + 64; ++k) sacc += pe[k] * w[(size_t)k * 128 + f];
            R[kq * 128 + f] = sacc; __syncthreads();
            if (tid < 128) WSF(WS_PEBP)[(ls * 8 + ks8) * 128 + tid] = (ks8 == 0 ? b1[tid] : 0.f) + (R[tid] + R[128 + tid]) + (R[256 + tid] + R[384 + tid]);
            __syncthreads();
            continue; }
        i -= N_PEB;
        if (i < N_W2T) { const int ls = i >> 1, f0 = (i & 1) * 64; const float* src = INP(I_W2) + (size_t)ls * 128 * 64; f16* dst = WSH(WS_W2T) + (size_t)ls * 64 * 128;
            tr64(lds, [&](int kk, int nn) { return src[(size_t)(f0 + kk) * 64 + nn]; },
                      [&](int nn, int kk, f16 v) { dst[(size_t)nn * 128 + f0 + kk] = v; });
            continue; }
        for (int e = tid; e < 2 * NPD; e += 512) BIAS[e] = 0.f;
    }
}

DI void ph_sample_compress(LAS unsigned char* lds_) {
    const Ctx c = mkctx(lds_);
    const float* w2 = INP(I_W2); const float* b2 = INP(I_B2); const float* k_g = INP(I_KG); const float* cache_kv = INP(I_CKV); const int* page_table = (const int*)c.ap->in[I_PT];
    f16* W1T = WSH(WS_W1T); float* PEB = WSF(WS_PEBP); float* KCS = WSF(WS_KCS); float* VCS = WSF(WS_VCS);
    for (int it = c.bid; it < 1152; it += c.G) {
        const int grp = it % 9, st_ = it / 9, slot = st_ & 1, b = (st_ >> 1) & 31, l = st_ >> 6;
        const float* ckv = cache_kv + (size_t)l * NPOOL * 128 * 256; const int* pt = page_table + b * 128;
        compress_item<true>(c.lds, [&](int ch) { return (const void*)(ckv + ((size_t)pt[ch >> 3] * 128 + (ch & 7) * 16) * 256 + slot * 64); }, grp * 127,
                            W1T + (size_t)(l * 2 + slot) * 128 * 2048, PEB + (l * 2 + slot) * 1024, WSH(WS_W2T) + (size_t)(l * 2 + slot) * 64 * 128, b2 + (l * 2 + slot) * 64,
                            slot == 0 ? k_g + l * 192 : nullptr, (slot == 0 ? KCS : VCS) + (size_t)(l * NB + b) * 1024 * 64, nullptr, nullptr);
    }
}
DI void ph_prep(LAS unsigned char* lds_) {
    const Ctx c = mkctx(lds_); const int tid = c.tid, lane = c.lane, wave = c.wave, bid = c.bid, G = c.G;
    float* ADA = WSF(WS_ADA); float* BIAS = WSF(WS_BIAS);
    {
        const f16* WTIN = WSH(WS_WTIN);
        const bool lite = G == 256;
        const int pb = lite ? bid - 128 : bid, pG = lite ? 128 : G;
        if (pb >= 0)
        for (int col = pb * 8 + wave; col < 2 * NPD; col += pG * 8) { const int l = col / NPD; const float* sh = ADA + ((size_t)l * 33 + 32) * 3072 + lane * 16; const f16* wp = WTIN + (size_t)col * 1024 + lane * 16;
            const f16x8 w0 = ld_h8(wp), w1 = ld_h8(wp + 8); float acc = 0.f;
#pragma unroll
            for (int i = 0; i < 8; ++i) acc += sh[i] * (float)w0[i] + sh[8 + i] * (float)w1[i];
            acc = wsum(acc); if (lane == 0) BIAS[col] = acc; }
    }
    const float* ng = INP(I_NG);
    if (bid == 0) { float* GNX = WSF(WS_GNX); const float* sc1 = ADA + (size_t)(33 + 32) * 3072 + 1024;
        for (int k = tid; k < 1024; k += 512) GNX[k] = ng[1024 + k] * (1.f + sc1[k]); }
    const float* ada_p = ADA + (size_t)32 * 3072; const float* x_p = INP(I_XP); f16* A16 = WSH(WS_A16); float* RSSP = WSF(WS_RSSP);
    float gp[16];
#pragma unroll
    for (int i = 0; i < 4; ++i) { const f32x4 g4 = *(const f32x4*)(ng + i * 256 + lane * 4), s4 = *(const f32x4*)(ada_p + 1024 + i * 256 + lane * 4);
#pragma unroll
        for (int j = 0; j < 4; ++j) gp[i * 4 + j] = g4[j] * (1.f + s4[j]); }
    const bool lite2 = G == 256; const int pb2 = lite2 ? bid - 128 : bid, pG2 = lite2 ? 128 : G;
    if (pb2 >= 0)
    for (int row = pb2 * 8 + wave; row < SEQ; row += pG2 * 8) {
        const float* xr = x_p + (size_t)row * 1024; float ss = 0.f;
#pragma unroll
        for (int i = 0; i < 4; ++i) { const f32x4 v = *(const f32x4*)(xr + i * 256 + lane * 4); ss += (v[0] * v[0] + v[1] * v[1]) + (v[2] * v[2] + v[3] * v[3]);
            f16x4 h; h[0] = (f16)(v[0] * gp[i * 4]); h[1] = (f16)(v[1] * gp[i * 4 + 1]); h[2] = (f16)(v[2] * gp[i * 4 + 2]); h[3] = (f16)(v[3] * gp[i * 4 + 3]);
            *(f16x4*)(A16 + (size_t)row * 1024 + i * 256 + lane * 4) = h; }
        ss = wsum(ss);
        if (lane < 16) RSSP[(size_t)row * 16 + lane] = lane == 0 ? ss : 0.f;
    }
}

template <int NT  , class OFn>
DI void sample_gemm_item(LAS unsigned char* lds, const f16* Bt, int n0, OFn ofn) {
    constexpr int KW = 8 / NT, KL = 1024 / KW;
    const int tid = ltid(), wave = tid >> 6, lane = tid & 63, wn = wave % NT, wk = wave / NT, r = lane & 31, h = lane >> 5;
    const LAS f16* Ah = (const LAS f16*)lds + r * 1032 + wk * KL + 8 * h; const f16* bp = Bt + (size_t)(n0 + 32 * wn + r) * 1024 + wk * KL + 8 * h;
    f32x16 acc;
#pragma unroll
    for (int i = 0; i < 16; ++i) acc[i] = 0.f;
#pragma unroll 8
    for (int st = 0; st < KL / 16; ++st) acc = __builtin_amdgcn_mfma_f32_32x32x16_f16(*(const LAS f16x8*)(Ah + 16 * st), ld_h8(bp + 16 * st), acc, 0, 0, 0);
    LAS float* RED = (LAS float*)(lds + 67584);
#pragma unroll
    for (int i = 0; i < 16; ++i) RED[(wk * 32 + (i & 3) + 8 * (i >> 2) + 4 * h) * (32 * NT) + 32 * wn + r] = acc[i];
    __syncthreads();
    for (int e = tid; e < 1024 * NT; e += 512) { float v = 0.f;
#pragma unroll
        for (int w = 0; w < KW; ++w) v += RED[w * 1024 * NT + e];
        ofn(e / (32 * NT), n0 + e % (32 * NT), v); }
    __syncthreads();
}
DI void ph_inproj(LAS unsigned char* lds_, int l) {
    const Ctx c = mkctx(lds_);
    pg8::Gemm g{WSH(WS_A16), WSH(WS_WTIN) + (size_t)l * NPD * 1024, SEQ, NPD, 1024}; pg8::StaticOrder S; S.init(SEQ, NPD, c.G, c.bid);
    EpiIn E{WSH(WS_PROJ), WSF(WS_RSSP), WSF(WS_BIAS) + l * NPD, c.out + O_KVP + (size_t)l * SEQ * 256};
    pg8::gemm_phase<EpiIn, pg8::StaticOrder>(c.lds, g, S, E);
    __syncthreads();
}
DI void ph_hsample(LAS unsigned char* lds_, int l) {
    const Ctx c = mkctx(lds_); const int lane = c.lane;
    if (c.bid >= 4) return;
    const int m = c.bid * 8 + c.wave;
    const float* xr = (l == 0 ? INP(I_XS) : WSF(WS_XS1)) + (size_t)m * 1024; const float* ad = WSF(WS_ADA) + ((size_t)l * 33 + m) * 3072; const float* ng = INP(I_NG) + l * 1024; f16* hs = WSH(WS_HS16) + (size_t)m * 1024;
    f32x4 xv[4]; float ss = 0.f;
#pragma unroll
    for (int i = 0; i < 4; ++i) { xv[i] = *(const f32x4*)(xr + i * 256 + lane * 4); ss += (xv[i][0] * xv[i][0] + xv[i][1] * xv[i][1]) + (xv[i][2] * xv[i][2] + xv[i][3] * xv[i][3]); }
    const float rn = rsqrtf(wsum(ss) * (1.f / 1024.f) + EPS);
#pragma unroll
    for (int i = 0; i < 4; ++i) { const int k = i * 256 + lane * 4; const f32x4 g = *(const f32x4*)(ng + k), sc = *(const f32x4*)(ad + 1024 + k), sh = *(const f32x4*)(ad + k); f16x4 hv;
#pragma unroll
        for (int j = 0; j < 4; ++j) hv[j] = (f16)(xv[i][j] * rn * g[j] * (1.f + sc[j]) + sh[j]);
        *(f16x4*)(hs + k) = hv; }
}
DI void ph_inproj_sample(LAS unsigned char* lds_, int l) {
    const Ctx c = mkctx(lds_); const int tid = c.tid;
    const int it = c.bid - (c.G - 64);
    if (it < 0 || it >= 60) return;
    float* PROJS = WSF(WS_PROJS); const f16* HS = WSH(WS_HS16); LAS f16* Ah = (LAS f16*)c.lds;
    __syncthreads();
#pragma unroll
    for (int i = 0; i < 8; ++i) { const int e = (tid + 512 * i) * 8; *(LAS f16x8*)(Ah + (e >> 10) * 1032 + (e & 1023)) = ld_h8(HS + e); }
    __syncthreads();
    sample_gemm_item<2>(c.lds, WSH(WS_WTIN) + (size_t)l * NPD * 1024, it * 64, [&](int m, int n, float v) { PROJS[m * NPD + n] = v; });
}

#define PT(t) (P + (size_t)(t) * SEQ * 256)
DI void ph_ssd_local(LAS unsigned char* lds_, int l) {
    const Ctx c = mkctx(lds_); LAS unsigned char* lds = c.lds; const int tid = c.tid, lane = c.lane, wave = c.wave;
    const f16* P = WSH(WS_PROJ); f16* ACT = WSH(WS_ACT); float* YD = WSF(WS_YD); float* CST = WSF(WS_CST); float* ACS = WSF(WS_ACS); float* CDEC = WSF(WS_CDEC); float* out = c.out;
    const float* dtb = INP(I_DTB) + l * 4; const float* alog = INP(I_ALOG) + l * 4; const float* cw = INP(I_BCW) + l * 4 * 768; const float* cb = INP(I_BCB) + l * 768;
    LAS f16* Bm = (LAS f16*)lds; LAS f16* BT = (LAS f16*)(lds + 34816); LAS f16* Cm = (LAS f16*)(lds + 69632); LAS f16* XT = (LAS f16*)(lds + 104448);
    LAS float* acs = (LAS float*)(lds + 139264); LAS float* dtl = acs + 256; LAS f16* te16 = (LAS f16*)(dtl + 256);
    for (int it = c.bid; it < 256; it += c.G) {
        const int ch_ = it >> 1, g = it & 1, t0 = ch_ * 128;
        __syncthreads();
        if (tid < 256) { const int hh = tid >> 7, lt = tid & 127, hd = 2 * g + hh; const float raw = (float)PT(13)[(size_t)(t0 + lt) * 256 + 128 + hd];
            const float dt = softplusf_(raw + dtb[hd]); dtl[hh * 128 + lt] = dt; acs[hh * 128 + lt] = dt * (-__expf(alog[hd])); }
        __syncthreads();
        if (tid == 0 || tid == 64) { const int hh = tid >> 6; float sacc = 0.f; for (int i = 0; i < 128; ++i) { sacc += acs[hh * 128 + i]; acs[hh * 128 + i] = sacc; } }
        __syncthreads();
        if (tid < 256) { const int hh = tid >> 7, lt = tid & 127, hd = 2 * g + hh; const float av = acs[hh * 128 + lt], ae = acs[hh * 128 + 127];
            te16[hh * 128 + lt] = (f16)__expf(ae - av); ACS[(size_t)(t0 + lt) * 4 + hd] = av; if (lt == 127) CDEC[ch_ * 4 + hd] = __expf(ae); }
#pragma unroll 3
        for (int e = tid; e < 128 * 48; e += 512) {
            const int lt = (e >> 2) & 127, cg = (e >> 9) * 4 + (e & 3), reg = cg >> 4, c8 = (cg & 15) * 8, t = t0 + lt, col = 128 * g + c8, ch = reg * 256 + col;
            const f16* src = PT(5 + reg) + col; float y[8]; f16x8 rawt;
#pragma unroll
            for (int i = 0; i < 8; ++i) y[i] = cb[ch + i];
#pragma unroll
            for (int k = 0; k < 4; ++k) { const int tt = t - 3 + k; f16x8 v; if (tt >= 0) v = ld_h8(src + (size_t)tt * 256); else {
#pragma unroll
                    for (int i = 0; i < 8; ++i) v[i] = (f16)0.f; }
                if (k == 3) rawt = v;
#pragma unroll
                for (int i = 0; i < 8; ++i) y[i] += cw[k * 768 + ch + i] * (float)v[i]; }
            f16x8 act;
#pragma unroll
            for (int i = 0; i < 8; ++i) { y[i] = siluf_(y[i]); act[i] = (f16)y[i]; }
            *(f16x8*)(ACT + (size_t)t * 768 + ch) = act;
            if (reg == 0) { const int hh = c8 >> 6; const float sdt = dtl[hh * 128 + lt] * 64.f;
#pragma unroll
                for (int i = 0; i < 8; ++i) XT[(c8 + i) * 136 + lt] = (f16)(y[i] * sdt); }
            else if (reg == 1) { *(LAS f16x8*)(Bm + lt * 136 + c8) = act;
#pragma unroll
                for (int i = 0; i < 8; ++i) BT[(c8 + i) * 136 + lt] = act[i]; }
            else *(LAS f16x8*)(Cm + lt * 136 + c8) = act;
            if (t >= SEQ - 3) { float* so = out + O_BCP + (size_t)l * 2304 + (t - (SEQ - 3)) * 768 + ch;
#pragma unroll
                for (int i = 0; i < 8; ++i) so[i] = (float)rawt[i]; }
        }
        __syncthreads();
        const int fr = lane & 15, q = lane >> 4, w = wave;
        f32x4 gt[8];
#pragma unroll
        for (int mt = 0; mt < 8; ++mt) { gt[mt] = (f32x4){0.f, 0.f, 0.f, 0.f};
            if (mt <= w) {
#pragma unroll
                for (int ks = 0; ks < 4; ++ks) { const f16x8 av = *(const LAS f16x8*)(Bm + (16 * mt + fr) * 136 + 32 * ks + 8 * q), bv = *(const LAS f16x8*)(Cm + (16 * w + fr) * 136 + 32 * ks + 8 * q);
                    gt[mt] = __builtin_amdgcn_mfma_f32_16x16x32_f16(av, bv, gt[mt], 0, 0, 0); } } }
#pragma unroll
        for (int hh = 0; hh < 2; ++hh) {
            const int lrow = 16 * w + fr; const float al = acs[hh * 128 + lrow];
            f32x4 ya[4];
#pragma unroll
            for (int pt = 0; pt < 4; ++pt) ya[pt] = (f32x4){0.f, 0.f, 0.f, 0.f};
#pragma unroll
            for (int k2 = 0; k2 < 4; ++k2) {
                if (2 * k2 <= w) {
                    f16x8 af;
#pragma unroll
                    for (int j = 0; j < 8; ++j) { const int m = 32 * k2 + (j < 4 ? 4 * q + j : 16 + 4 * q + (j - 4)); const float gv = j < 4 ? gt[2 * k2][j] : gt[2 * k2 + 1][j - 4];
                        af[j] = (f16)(m <= lrow ? gv * __expf(al - acs[hh * 128 + m]) : 0.f); }
#pragma unroll
                    for (int pt = 0; pt < 4; ++pt) { const LAS f16* xp = XT + (hh * 64 + 16 * pt + fr) * 136 + 32 * k2 + 4 * q; const f16x4 b0 = *(const LAS f16x4*)xp, b1 = *(const LAS f16x4*)(xp + 16);
                        f16x8 bf; bf[0] = b0[0]; bf[1] = b0[1]; bf[2] = b0[2]; bf[3] = b0[3]; bf[4] = b1[0]; bf[5] = b1[1]; bf[6] = b1[2]; bf[7] = b1[3];
                        ya[pt] = __builtin_amdgcn_mfma_f32_16x16x32_f16(af, bf, ya[pt], 0, 0, 0); }
                }
            }
#pragma unroll
            for (int pt = 0; pt < 4; ++pt)
#pragma unroll
                for (int j = 0; j < 4; ++j) YD[(size_t)(t0 + 16 * w + 4 * q + j) * 256 + (2 * g + hh) * 64 + 16 * pt + fr] = ya[pt][j] * (1.f / 64.f);
#pragma unroll
            for (int pt = 0; pt < 4; ++pt) { f32x4 sa = (f32x4){0.f, 0.f, 0.f, 0.f};
#pragma unroll
                for (int ks = 0; ks < 4; ++ks) { const f16x8 xv = *(const LAS f16x8*)(XT + (hh * 64 + 16 * pt + fr) * 136 + 32 * ks + 8 * q), tv = *(const LAS f16x8*)(te16 + hh * 128 + 32 * ks + 8 * q);
                    const f16x8 bv = *(const LAS f16x8*)(BT + (16 * w + fr) * 136 + 32 * ks + 8 * q);
                    sa = __builtin_amdgcn_mfma_f32_16x16x32_f16(xv * tv, bv, sa, 0, 0, 0); }
#pragma unroll
                for (int j = 0; j < 4; ++j) CST[((size_t)(ch_ * 4 + 2 * g + hh) * 64 + 16 * pt + 4 * q + j) * 128 + 16 * w + fr] = sa[j] * (1.f / 64.f); }
        }
    }
    __syncthreads();
}
DI void ph_mix_a(LAS unsigned char* lds_, int l) {
    const Ctx c = mkctx(lds_); const int tid = c.tid;
    const f16* P = WSH(WS_PROJ); f16* Y16 = WSH(WS_Y16); float* out = c.out; const float* scw = INP(I_SCW) + l * 768;
    for (int it = c.bid; it < 256; it += c.G) {
        for (int e = tid; e < 64 * 32; e += 512) { const int t = it * 64 + (e >> 5), c0 = (e & 31) * 8; float u[3][8];
#pragma unroll
            for (int k = 0; k < 3; ++k) { const int tt = t - 2 + k;
                if (tt >= 0) { const f16x8 h = ld_h8(PT(0) + (size_t)tt * 256 + c0), cc = ld_h8(PT(2) + (size_t)tt * 256 + c0);
#pragma unroll
                    for (int i = 0; i < 8; ++i) u[k][i] = (float)cc[i] * (float)h[i]; }
                else {
#pragma unroll
                    for (int i = 0; i < 8; ++i) u[k][i] = 0.f; } }
            const f16x8 bb = ld_h8(PT(1) + (size_t)t * 256 + c0), gg = ld_h8(PT(3) + (size_t)t * 256 + c0); f16x8 o;
#pragma unroll
            for (int i = 0; i < 8; ++i) { const float y = scw[c0 + i] * u[0][i] + scw[256 + c0 + i] * u[1][i] + scw[512 + c0 + i] * u[2][i]; o[i] = (f16)(siluf_((float)gg[i]) * (float)bb[i] * y); }
            *(f16x8*)(Y16 + (size_t)t * 1024 + c0) = o;
            if (t >= SEQ - 2) { float* so = out + O_SCP + (size_t)l * 512 + (t - (SEQ - 2)) * 256 + c0;
#pragma unroll
                for (int i = 0; i < 8; ++i) so[i] = u[2][i]; }
        }
    }
}
DI void ph_mix_c(LAS unsigned char* lds_, int l) {
    const Ctx c = mkctx(lds_); const int tid = c.tid, lane = c.lane, wave = c.wave;
    const f16* P = WSH(WS_PROJ); f16* Y16 = WSH(WS_Y16); float* out = c.out;
    const float* cfw = INP(I_CFW) + l * 31 * 256; const float* cfb = INP(I_CFB) + l * 256; const float* lng = INP(I_LNG) + l * 256; const float* lnb = INP(I_LNB) + l * 256;
    LAS float* GL = (LAS float*)c.lds;
    f32x4 wt[31];
#pragma unroll
    for (int k = 0; k < 31; ++k) wt[k] = *(const f32x4*)(cfw + k * 256 + lane * 4);
    const f32x4 bias4 = *(const f32x4*)(cfb + lane * 4), g4 = *(const f32x4*)(lng + lane * 4), b4 = *(const f32x4*)(lnb + lane * 4);
    for (int it = c.bid; it < 256; it += c.G) {
        __syncthreads();
        for (int e = tid; e < 94 * 32; e += 512) { const int rr = e >> 5, c0 = (e & 31) * 8, t = it * 64 - 30 + rr; f32x4 g0 = (f32x4){0.f, 0.f, 0.f, 0.f}, g1 = g0;
            if (t >= 0) { const f16x8 ga = ld_h8(PT(8) + (size_t)t * 256 + c0), gb = ld_h8(PT(9) + (size_t)t * 256 + c0);
#pragma unroll
                for (int i = 0; i < 4; ++i) { g0[i] = (float)ga[i] * sigmoidf_((float)gb[i]); g1[i] = (float)ga[4 + i] * sigmoidf_((float)gb[4 + i]); }
                if (t >= SEQ - 30) { float* so = out + O_CFP + (size_t)l * 7680 + (t - (SEQ - 30)) * 256 + c0; *(f32x4*)so = g0; *(f32x4*)(so + 4) = g1; } }
            *(LAS f32x4*)(GL + rr * 256 + c0) = g0; *(LAS f32x4*)(GL + rr * 256 + c0 + 4) = g1; }
        __syncthreads();
        {
            const int cc = lane * 4, tb = wave * 8;
            f32x4 u[8];
#pragma unroll
            for (int j = 0; j < 8; ++j) u[j] = bias4;
#pragma unroll
            for (int r = 0; r < 38; ++r) { const f32x4 gv = *(const LAS f32x4*)(GL + (tb + r) * 256 + cc);
#pragma unroll
                for (int j = 0; j < 8; ++j) if (r - j >= 0 && r - j <= 30) u[j] += wt[r - j] * gv; }
#pragma unroll
            for (int j = 0; j < 8; ++j) { const int t = it * 64 + tb + j;
                const float mean = wsum((u[j][0] + u[j][1]) + (u[j][2] + u[j][3])) * (1.f / 256.f); const f32x4 d = u[j] - mean;
                const float var = wsum((d[0] * d[0] + d[1] * d[1]) + (d[2] * d[2] + d[3] * d[3])) * (1.f / 256.f); const float rs = rsqrtf(var + EPS);
                const f16x4 cg = *(const f16x4*)(PT(10) + (size_t)t * 256 + cc); f16x4 o;
#pragma unroll
                for (int i = 0; i < 4; ++i) o[i] = (f16)(siluf_((float)cg[i]) * siluf_(d[i] * rs * g4[i] + b4[i]));
                *(f16x4*)(Y16 + (size_t)t * 1024 + 512 + cc) = o; }
        }
    }
    __syncthreads();
}
DI void ph_mix_d(LAS unsigned char* lds_, int l) {
    const Ctx c = mkctx(lds_); const int tid = c.tid, lane = c.lane, wave = c.wave;
    const f16* P = WSH(WS_PROJ); float* out = c.out; float* kvp_out = out + O_KVP + (size_t)l * SEQ * 256;
    f16* Q16 = WSH(WS_Q16); f16* KS16 = WSH(WS_KS16); f16* KW16 = WSH(WS_KW16); f16* VST16 = WSH(WS_VST16); f16* VWT16 = WSH(WS_VWT16); float* GATES = WSF(WS_GATES);
    const int d4 = (lane & 15) * 4, v4 = lane >> 4;
    const f32x4 qg = *(const f32x4*)(INP(I_QG) + l * 64 + d4), kg1 = *(const f32x4*)(INP(I_KG) + l * 192 + 64 + d4), kg2 = *(const f32x4*)(INP(I_KG) + l * 192 + 128 + d4);
    LAS f16* VSs = (LAS f16*)c.lds; LAS f16* VWs = VSs + 64 * 68;
    if (c.bid < 18 && c.G > 36) return;
    for (int it = c.bid - 18 >= 0 && c.G > 36 ? c.bid - 18 : c.bid; it < 256; it += (c.G > 36 ? c.G - 18 : c.G)) {
        __syncthreads();
        for (int vi = wave * 4 + v4; vi < 256; vi += 32) { const size_t off = (size_t)(it * 64) * 256 + (size_t)vi * 64 + d4; const f16x4 x = *(const f16x4*)(PT(11) + off);
            const float a0 = (float)x[0], a1 = (float)x[1], a2 = (float)x[2], a3 = (float)x[3]; const float rn = rsqrtf(sum16((a0 * a0 + a1 * a1) + (a2 * a2 + a3 * a3)) * (1.f / 64.f) + EPS);
            f16x4 y; y[0] = (f16)(a0 * rn * qg[0]); y[1] = (f16)(a1 * rn * qg[1]); y[2] = (f16)(a2 * rn * qg[2]); y[3] = (f16)(a3 * rn * qg[3]); *(f16x4*)(Q16 + off) = y; }
        for (int tl = wave * 4 + v4; tl < 64; tl += 32) { const int t = it * 64 + tl;
            { const f16x4 x = *(const f16x4*)(PT(12) + (size_t)t * 256 + 128 + d4), vv = *(const f16x4*)(PT(12) + (size_t)t * 256 + 192 + d4);
                const float a0 = (float)x[0], a1 = (float)x[1], a2 = (float)x[2], a3 = (float)x[3]; const float rn = rsqrtf(sum16((a0 * a0 + a1 * a1) + (a2 * a2 + a3 * a3)) * (1.f / 64.f) + EPS);
                const f32x4 kn = (f32x4){a0 * rn * kg1[0], a1 * rn * kg1[1], a2 * rn * kg1[2], a3 * rn * kg1[3]}; *(f32x4*)(kvp_out + (size_t)t * 256 + 128 + d4) = kn;
                f16x4 y; y[0] = (f16)kn[0]; y[1] = (f16)kn[1]; y[2] = (f16)kn[2]; y[3] = (f16)kn[3]; *(f16x4*)(KS16 + (size_t)t * 64 + d4) = y; *(LAS f16x4*)(VSs + tl * 68 + d4) = vv; }
            { const f16x4 x = *(const f16x4*)(PT(13) + (size_t)t * 256 + d4), vv = *(const f16x4*)(PT(13) + (size_t)t * 256 + 64 + d4);
                const float a0 = (float)x[0], a1 = (float)x[1], a2 = (float)x[2], a3 = (float)x[3]; const float rn = rsqrtf(sum16((a0 * a0 + a1 * a1) + (a2 * a2 + a3 * a3)) * (1.f / 64.f) + EPS);
                const f32x4 kn = (f32x4){a0 * rn * kg2[0], a1 * rn * kg2[1], a2 * rn * kg2[2], a3 * rn * kg2[3]};
                f16x4 y; y[0] = (f16)kn[0]; y[1] = (f16)kn[1]; y[2] = (f16)kn[2]; y[3] = (f16)kn[3]; *(f16x4*)(KW16 + (size_t)t * 64 + d4) = y; *(LAS f16x4*)(VWs + tl * 68 + d4) = vv;
                if (t >= SEQ - 512) { float* wo = out + O_WINP + (size_t)l * 512 * 128 + (size_t)(t - (SEQ - 512)) * 128; *(f32x4*)(wo + d4) = kn; *(f32x4*)(wo + 64 + d4) = (f32x4){(float)vv[0], (float)vv[1], (float)vv[2], (float)vv[3]}; } }
        }
        for (int e = tid; e < 64 * 12; e += 512) { const int tl = e / 12, gi = e % 12; GATES[(size_t)(it * 64 + tl) * 12 + gi] = sigmoidf_((float)PT(13)[(size_t)(it * 64 + tl) * 256 + 132 + gi]); }
        __syncthreads();
        { const int d = tid >> 3, k8 = (tid & 7) * 8; f16x8 a, b;
#pragma unroll
            for (int i = 0; i < 8; ++i) { a[i] = VSs[(k8 + i) * 68 + d]; b[i] = VWs[(k8 + i) * 68 + d]; }
            *(f16x8*)(VST16 + (size_t)it * 4096 + d * 64 + k8) = a; *(f16x8*)(VWT16 + (size_t)it * 4096 + d * 64 + k8) = b; }
    }
    __syncthreads();
}
DI void ph_mix_cmp(LAS unsigned char* lds_, int l) {
    const Ctx c = mkctx(lds_);
    const f16* P = WSH(WS_PROJ); const float* w2 = INP(I_W2); const float* b2 = INP(I_B2); const float* k_g = INP(I_KG); f16* W1T = WSH(WS_W1T); float* PEB = WSF(WS_PEBP);
    for (int it = c.bid; it < 18; it += c.G) { const int slot = it / 9, grp = it % 9; const f16* src = PT(12) + slot * 64;
        compress_item<false>(c.lds, [&](int ch) { return (const void*)(src + (size_t)ch * 16 * 256); }, grp * 127,
                             W1T + (size_t)(l * 2 + slot) * 128 * 2048, PEB + (l * 2 + slot) * 1024, WSH(WS_W2T) + (size_t)(l * 2 + slot) * 64 * 128, b2 + (l * 2 + slot) * 64,
                             slot == 0 ? k_g + l * 192 : nullptr, nullptr, slot == 0 ? WSH(WS_KC16) : nullptr, slot == 0 ? nullptr : WSH(WS_VCT16)); }
}
#undef PT
template <int N>
DI void blk_reduce(LAS float* red, LAS float* bc, float (&v)[N], bool is_max, int wave, int lane) {
#pragma unroll
    for (int i = 0; i < N; ++i) v[i] = is_max ? wmaxf(v[i]) : wsum(v[i]);
    __syncthreads();
    if (lane == 0) {
#pragma unroll
        for (int i = 0; i < N; ++i) red[wave * 12 + i] = v[i]; }
    __syncthreads();
    if (wave == 0 && lane < N) { float r = red[lane]; for (int w = 1; w < 8; ++w) r = is_max ? fmaxf(r, red[w * 12 + lane]) : r + red[w * 12 + lane]; bc[lane] = r; }
    __syncthreads();
#pragma unroll
    for (int i = 0; i < N; ++i) v[i] = bc[i];
}
DI void nsa_sample_block(LAS float* wl, const float* KC, const float* VC, const SampleKV& kv, const LAS float* gsm, const float* dgp, float* ysd, int tid, int lane, int wave) {
    LAS float* sc = wl; LAS float* qs = wl + 10496; LAS float* PSL = qs + 256; LAS float* red = PSL + 1024; LAS float* bc = red + 96; LAS int* sel = (LAS int*)(bc + 16); LAS float* part = bc + 32;
    constexpr int NCV = 1023, CUR = PAST >> 6;
    float mv[8], sv[8];
#pragma unroll
    for (int i = 0; i < 8; ++i) mv[i] = -3e38f;
    for (int cidx = tid; cidx < NCV; cidx += 512) {
        asm volatile("" ::: "memory");
        float kr[64]; kv.ld64(KC + (size_t)cidx * 64, kr); float s4[4] = {0.f, 0.f, 0.f, 0.f};
#pragma unroll
        for (int d = 0; d < 64; ++d) { const f32x4 qv = *(const LAS f32x4*)(qs + d * 4); s4[0] += qv[0] * kr[d]; s4[1] += qv[1] * kr[d]; s4[2] += qv[2] * kr[d]; s4[3] += qv[3] * kr[d]; }
#pragma unroll
        for (int hh = 0; hh < 4; ++hh) { s4[hh] *= 0.125f; sc[hh * 2624 + cidx] = s4[hh]; mv[hh] = fmaxf(mv[hh], s4[hh]); }
    }
    for (int i = tid; i < 513; i += 512) {
        asm volatile("" ::: "memory");
        float kr[64]; kv.krow_win(PAST - 512 + i, kr); float s4[4] = {0.f, 0.f, 0.f, 0.f};
#pragma unroll
        for (int d = 0; d < 64; ++d) { const f32x4 qv = *(const LAS f32x4*)(qs + d * 4); s4[0] += qv[0] * kr[d]; s4[1] += qv[1] * kr[d]; s4[2] += qv[2] * kr[d]; s4[3] += qv[3] * kr[d]; }
#pragma unroll
        for (int hh = 0; hh < 4; ++hh) { s4[hh] *= 0.125f; sc[hh * 2624 + 2048 + i] = s4[hh]; mv[4 + hh] = fmaxf(mv[4 + hh], s4[hh]); }
    }
    blk_reduce<8>(red, bc, mv, true, wave, lane);
#pragma unroll
    for (int i = 0; i < 8; ++i) sv[i] = 0.f;
    for (int cidx = tid; cidx < NCV; cidx += 512) {
#pragma unroll
        for (int hh = 0; hh < 4; ++hh) { const float e = __expf(sc[hh * 2624 + cidx] - mv[hh]); sc[hh * 2624 + cidx] = e; sv[hh] += e; } }
    for (int i = tid; i < 513; i += 512) {
#pragma unroll
        for (int hh = 0; hh < 4; ++hh) { const float e = __expf(sc[hh * 2624 + 2048 + i] - mv[4 + hh]); sc[hh * 2624 + 2048 + i] = e; sv[4 + hh] += e; } }
    blk_reduce<8>(red, bc, sv, false, wave, lane);
    float invc[4], invw[4];
#pragma unroll
    for (int hh = 0; hh < 4; ++hh) { invc[hh] = 1.f / sv[hh]; invw[hh] = 1.f / sv[4 + hh]; }
    for (int cidx = tid; cidx < 1024; cidx += 512) PSL[cidx] = cidx < NCV ? (sc[cidx] * invc[0] + sc[2624 + cidx] * invc[1]) + (sc[2 * 2624 + cidx] * invc[2] + sc[3 * 2624 + cidx] * invc[3]) : 0.f;
    __syncthreads();
    if (wave == 0) {
        float scv[5];
#pragma unroll
        for (int i = 0; i < 5; ++i) { const int j = lane + 64 * i; float v = -3e38f;
            if (j <= CUR) { if (j == 0 || j == CUR || j == CUR - 1) v = 3e38f; else { float a = 0.f;
#pragma unroll
                    for (int o5 = -1; o5 < 4; ++o5) { const int cc = 4 * j + o5; if (cc >= 0 && cc < NCV) a += (o5 == -1 || o5 == 3) ? 0.5f * PSL[cc] : PSL[cc]; }
                    v = a; } }
            scv[i] = v; }
        for (int k = 0; k < 16; ++k) {
            float bv = scv[0]; int bi = lane;
#pragma unroll
            for (int i = 1; i < 5; ++i) if (scv[i] > bv) { bv = scv[i]; bi = lane + 64 * i; }
#pragma unroll
            for (int off = 32; off > 0; off >>= 1) { const float ov = __shfl_xor(bv, off); const int oi = __shfl_xor(bi, off); if (ov > bv || (ov == bv && oi < bi)) { bv = ov; bi = oi; } }
            if (lane == 0) sel[k] = bi;
#pragma unroll
            for (int i = 0; i < 5; ++i) if (lane + 64 * i == bi) scv[i] = -3e38f;
        }
    }
    __syncthreads();
    float ms[4], ss4[4];
#pragma unroll
    for (int i = 0; i < 4; ++i) ms[i] = -3e38f;
    for (int idx = tid; idx < 1024; idx += 512) {
        asm volatile("" ::: "memory");
        const int pos = sel[idx >> 6] * 64 + (idx & 63); float s4[4] = {-1e30f, -1e30f, -1e30f, -1e30f};
        if (pos <= PAST) { float kr[64]; kv.krow_sel(pos, kr); s4[0] = s4[1] = s4[2] = s4[3] = 0.f;
#pragma unroll
            for (int d = 0; d < 64; ++d) { const f32x4 qv = *(const LAS f32x4*)(qs + d * 4); s4[0] += qv[0] * kr[d]; s4[1] += qv[1] * kr[d]; s4[2] += qv[2] * kr[d]; s4[3] += qv[3] * kr[d]; }
#pragma unroll
            for (int hh = 0; hh < 4; ++hh) s4[hh] *= 0.125f; }
#pragma unroll
        for (int hh = 0; hh < 4; ++hh) { sc[hh * 2624 + 1024 + idx] = s4[hh]; ms[hh] = fmaxf(ms[hh], s4[hh]); }
    }
    blk_reduce<4>(red, bc, ms, true, wave, lane);
#pragma unroll
    for (int i = 0; i < 4; ++i) ss4[i] = 0.f;
    for (int idx = tid; idx < 1024; idx += 512) {
#pragma unroll
        for (int hh = 0; hh < 4; ++hh) { const float x = sc[hh * 2624 + 1024 + idx]; const float e = x > -1e29f ? __expf(x - ms[hh]) : 0.f; sc[hh * 2624 + 1024 + idx] = e; ss4[hh] += e; } }
    blk_reduce<4>(red, bc, ss4, false, wave, lane);
    float invs[4];
#pragma unroll
    for (int hh = 0; hh < 4; ++hh) invs[hh] = 1.f / ss4[hh];
    float oc[4] = {0.f, 0.f, 0.f, 0.f}, os[4] = {0.f, 0.f, 0.f, 0.f}, ow[4] = {0.f, 0.f, 0.f, 0.f};
    { const int c1 = (wave + 1) * 128 < NCV ? (wave + 1) * 128 : NCV;
#pragma unroll 16
        for (int cidx = wave * 128; cidx < c1; ++cidx) { const float v = VC[(size_t)cidx * 64 + lane];
#pragma unroll
            for (int hh = 0; hh < 4; ++hh) oc[hh] += sc[hh * 2624 + cidx] * v; } }
    for (int kb = wave * 2; kb < wave * 2 + 2; ++kb) { const int p0 = sel[kb] * 64; int nk = PAST - p0 + 1; nk = nk > 64 ? 64 : nk;
        const float* vbase = p0 < PAST ? kv.prow(p0, 3) + lane : kv.nvs + lane;
#pragma unroll 16
        for (int kk = 0; kk < nk; ++kk) { const float v = vbase[(size_t)kk * 256];
#pragma unroll
            for (int hh = 0; hh < 4; ++hh) os[hh] += sc[hh * 2624 + 1024 + kb * 64 + kk] * v; } }
    { const int i1 = (wave + 1) * 65 < 513 ? (wave + 1) * 65 : 513;
#pragma unroll 13
        for (int i = wave * 65; i < i1; ++i) { const float v = kv.v_win(PAST - 512 + i, lane);
#pragma unroll
            for (int hh = 0; hh < 4; ++hh) ow[hh] += sc[hh * 2624 + 2048 + i] * v; } }
#pragma unroll
    for (int hh = 0; hh < 4; ++hh) { part[(wave * 12 + hh) * 64 + lane] = oc[hh] * invc[hh]; part[(wave * 12 + 4 + hh) * 64 + lane] = os[hh] * invs[hh]; part[(wave * 12 + 8 + hh) * 64 + lane] = ow[hh] * invw[hh]; }
    __syncthreads();
    if (tid < 256) { const int hh = tid >> 6, d = tid & 63; float a = 0.f, b = 0.f, cc = 0.f;
        for (int w = 0; w < 8; ++w) { a += part[(w * 12 + hh) * 64 + d]; b += part[(w * 12 + 4 + hh) * 64 + d]; cc += part[(w * 12 + 8 + hh) * 64 + d]; }
        ysd[tid] = siluf_(dgp[tid]) * (gsm[hh * 3] * a + gsm[hh * 3 + 1] * b + gsm[hh * 3 + 2] * cc); }
}
DI void ph_mix_sample(LAS unsigned char* lds_, int l) {
    const Ctx c = mkctx(lds_); const int tid = c.tid, lane = c.lane, wave = c.wave;
    const int b = c.bid - (c.G - 32);
    if (b < 0 || b >= 32) return;
    float* out = c.out;
    __syncthreads();
    const float* pr = WSF(WS_PROJS) + (size_t)b * NPD;
    LAS float* act = (LAS float*)c.lds;
    LAS float* red = act + 768;
    LAS float* ybl = red + 16;
    LAS float* sdt = ybl + 256;
    LAS float* nrow = sdt + 8;
    LAS float* gsm = nrow + 256;
    LAS float* wl = gsm + 16;
    float* ys = WSF(WS_YS) + (size_t)b * 1024;
    if (tid < 256) { const int ch = tid; const float* st = INP(I_SSC) + ((size_t)(l * NB + b) * 2) * 256; const float* scw = INP(I_SCW) + l * 768;
        const float u = pr[512 + ch] * pr[ch], p0 = st[ch], p1 = st[256 + ch]; const float y = scw[ch] * p0 + scw[256 + ch] * p1 + scw[512 + ch] * u;
        ys[ch] = siluf_(pr[768 + ch]) * pr[256 + ch] * y; float* so = out + O_SCS + ((size_t)(l * NB + b) * 2) * 256; so[ch] = p1; so[256 + ch] = u; }
    float uc = 0.f;
    if (tid >= 256) { const int ch = tid - 256; const float* st = INP(I_SCF) + (size_t)(l * NB + b) * 7680; const float* cfw = INP(I_CFW) + l * 31 * 256;
        const float glu = pr[2048 + ch] * sigmoidf_(pr[2304 + ch]); float u = INP(I_CFB)[l * 256 + ch]; float* so = out + O_CFS + (size_t)(l * NB + b) * 7680;
        for (int k = 0; k < 30; ++k) { const float pv = st[k * 256 + ch]; u += cfw[k * 256 + ch] * pv; if (k > 0) so[(k - 1) * 256 + ch] = pv; }
        u += cfw[30 * 256 + ch] * glu; so[29 * 256 + ch] = glu; uc = u; }
    { const float s1 = wsum(tid >= 256 ? uc : 0.f); if (lane == 0) red[wave] = s1; }
    __syncthreads();
    const float cmean = (red[4] + red[5] + red[6] + red[7]) * (1.f / 256.f);
    __syncthreads();
    { const float d = uc - cmean; const float s2 = wsum(tid >= 256 ? d * d : 0.f); if (lane == 0) red[wave] = s2; }
    __syncthreads();
    if (tid >= 256) { const int ch = tid - 256; const float var = (red[4] + red[5] + red[6] + red[7]) * (1.f / 256.f);
        const float ln = (uc - cmean) * rsqrtf(var + EPS) * INP(I_LNG)[l * 256 + ch] + INP(I_LNB)[l * 256 + ch];
        ys[512 + ch] = siluf_(pr[2560 + ch]) * siluf_(ln); }
    { const float* st = INP(I_SBC) + (size_t)(l * NB + b) * 2304; const float* cw = INP(I_BCW) + l * 4 * 768; const float* cb = INP(I_BCB) + l * 768; float* so = out + O_BCS + (size_t)(l * NB + b) * 2304;
        for (int ch = tid; ch < 768; ch += 512) { const float raw = pr[1280 + ch], p0 = st[ch], p1 = st[768 + ch], p2 = st[1536 + ch];
            act[ch] = siluf_(cb[ch] + cw[ch] * p0 + cw[768 + ch] * p1 + cw[1536 + ch] * p2 + cw[2304 + ch] * raw); so[ch] = p1; so[768 + ch] = p2; so[1536 + ch] = raw; }
        if (tid < 4) { const float dt = softplusf_(pr[3456 + tid] + INP(I_DTB)[l * 4 + tid]); sdt[tid] = dt; sdt[4 + tid] = __expf(dt * (-__expf(INP(I_ALOG)[l * 4 + tid]))); } }
    __syncthreads();
    { const float* h0 = INP(I_SSM) + (size_t)(l * NB + b) * 32768; float* ho = out + O_HS + (size_t)(l * NB + b) * 32768; const float* Dp = INP(I_SD) + l * 4;
        for (int row = wave; row < 256; row += 8) { const int hd = row >> 6, gq = hd >> 1; const float dt = sdt[hd], dA = sdt[4 + hd], xv = act[row]; float y = 0.f;
#pragma unroll
            for (int s2 = 0; s2 < 2; ++s2) { const int sidx = lane + 64 * s2; const float hn = dA * h0[row * 128 + sidx] + dt * xv * act[256 + gq * 128 + sidx]; ho[row * 128 + sidx] = hn; y += hn * act[512 + gq * 128 + sidx]; }
            y = wsum(y);
            if (lane == 0) ybl[row] = (y + Dp[hd] * xv) * siluf_(pr[1024 + row]); } }
    __syncthreads();
    { const float v = tid < 256 ? ybl[tid] : 0.f; const float s2 = wsum(v * v); if (lane == 0) red[8 + wave] = s2; }
    __syncthreads();
    if (tid < 256) { const float ss = red[8] + red[9] + red[10] + red[11]; ys[256 + tid] = ybl[tid] * rsqrtf(ss * (1.f / 256.f) + EPS) * INP(I_SNG)[l * 256 + tid]; }
    const float* qg = INP(I_QG) + l * 64; const float* kg = INP(I_KG) + l * 192;
    LAS float* qs = wl + 10496;
    if (wave < 4) { const float v = pr[2816 + wave * 64 + lane]; const float ss = wsum(v * v); qs[lane * 4 + wave] = v * rsqrtf(ss * (1.f / 64.f) + EPS) * qg[lane]; }
    else if (wave == 4) { const float v = pr[3072 + 128 + lane]; const float ss = wsum(v * v); nrow[lane] = v * rsqrtf(ss * (1.f / 64.f) + EPS) * kg[64 + lane]; nrow[64 + lane] = pr[3072 + 192 + lane]; }
    else if (wave == 5) { const float v = pr[3072 + 256 + lane]; const float ss = wsum(v * v); nrow[128 + lane] = v * rsqrtf(ss * (1.f / 64.f) + EPS) * kg[128 + lane]; nrow[192 + lane] = pr[3072 + 320 + lane]; }
    else if (wave == 6) { if (lane < 12) gsm[lane] = sigmoidf_(pr[3460 + lane]); }
    __syncthreads();
    const float* cache_win = INP(I_CWIN) + (size_t)(l * NB + b) * 512 * 128;
    { float* ko = out + O_KVS + (size_t)(l * NB + b) * 256;
        if (tid < 128) ko[tid] = pr[3072 + tid]; else if (tid < 192) ko[tid] = nrow[tid - 128]; else if (tid < 256) ko[tid] = nrow[64 + tid - 192];
        float* wo = out + O_WINS + (size_t)(l * NB + b) * 512 * 128;
        for (int e = tid; e < 511 * 128; e += 512) wo[e] = cache_win[128 + e];
        if (tid < 64) wo[511 * 128 + tid] = nrow[128 + tid]; else if (tid < 128) wo[511 * 128 + tid] = nrow[192 + tid - 64]; }
    float* nrp = WSF(WS_NRG) + (size_t)(l * NB + b) * 256;
    if (tid < 256) nrp[tid] = nrow[tid];
    asm volatile("s_waitcnt vmcnt(0)" ::: "memory");
    __syncthreads();
    {
        SampleKV kv{INP(I_CKV) + (size_t)l * NPOOL * 128 * 256, (const int*)c.ap->in[I_PT] + b * 128, cache_win, nrp, nrp + 64, nrp + 128, nrp + 192};
        nsa_sample_block(wl, WSF(WS_KCS) + (size_t)(l * NB + b) * 1024 * 64, WSF(WS_VCS) + (size_t)(l * NB + b) * 1024 * 64, kv, gsm, pr + 3584, ys + 768, tid, lane, wave);
    }
    edge_publish((unsigned*)(c.ws + WS_CTL + 18432) + l * 64);
    __syncthreads();
}
DI void ph_scan(LAS unsigned char* lds_, int l) {
    const Ctx c = mkctx(lds_);
    if (c.bid >= 64) return;
    const float* CST = WSF(WS_CST); float* HPV = WSF(WS_HPV); const float* CDEC = WSF(WS_CDEC);
    const int e = c.bid * 512 + c.tid, hd = e >> 13; float hc = 0.f;
#pragma unroll 8
    for (int ch = 0; ch < 128; ++ch) { const float sv = CST[(size_t)ch * 32768 + e]; HPV[(size_t)ch * 32768 + e] = hc; hc = CDEC[ch * 4 + hd] * hc + sv; }
    c.out[O_HP + (size_t)l * 32768 + e] = hc;
    edge_publish((unsigned*)(c.ws + WS_CTL + 17408) + l * 64);
}
DI f16x8 pack_p(const f32x4& a, const f32x4& b) { f16x8 r; r[0] = (f16)a[0]; r[1] = (f16)a[1]; r[2] = (f16)a[2]; r[3] = (f16)a[3]; r[4] = (f16)b[0]; r[5] = (f16)b[1]; r[6] = (f16)b[2]; r[7] = (f16)b[3]; return r; }
DI f16x8 ld_vt(const f16* p) { const f16x4 a = *(const f16x4*)p, b = *(const f16x4*)(p + 16); f16x8 r; r[0] = a[0]; r[1] = a[1]; r[2] = a[2]; r[3] = a[3]; r[4] = b[0]; r[5] = b[1]; r[6] = b[2]; r[7] = b[3]; return r; }
constexpr int NT_PSEL = 0  , NT_STG = 32768  , NT_STG_SZ = 18432 + 17408,
              NT_RING = 0  , NT_MASK = 131072  , NT_VB = NT_MASK + 1088  , NT_MT = NT_VB + 1088  , NT_END = NT_MT + 1088;
static_assert(NT_STG + 2 * NT_STG_SZ <= NT_MASK, "nsa tile LDS map");
static_assert(NT_END <= MISC_OFF, "nsa tile LDS map");
struct StgRegs { f16x8 k0, k1, v0, v1; };
template <bool WITH_V, class KSrc, class VSrc>
DI void stg_load(StgRegs& rg, int ch, int tid, const KSrc& ksrc, const VSrc& vsrc) {
    const f16* kp = ksrc(ch, tid >> 2) + (tid & 3) * 16; rg.k0 = ld_h8(kp); rg.k1 = ld_h8(kp + 8);
    if (WITH_V) { const f16* vp = vsrc(ch, tid >> 3, tid & 7); rg.v0 = ld_h8(vp); rg.v1 = ld_h8(vp + 8); }
}
template <bool WITH_V>
DI void stg_store(const StgRegs& rg, LAS unsigned char* buf, int tid) {
    LAS f16* kb = (LAS f16*)buf + (tid >> 2) * 72 + (tid & 3) * 16; *(LAS f16x8*)kb = rg.k0; *(LAS f16x8*)(kb + 8) = rg.k1;
    if (WITH_V) { LAS f16* vb = (LAS f16*)(buf + 18432) + (tid >> 3) * 136 + (tid & 7) * 16; *(LAS f16x8*)vb = rg.v0; *(LAS f16x8*)(vb + 8) = rg.v1; }
}
template <bool WITH_V, class KSrc, class VSrc, class Body>
DI void stream_chunks(LAS unsigned char* stg, int nchunk, int tid, const KSrc& ksrc, const VSrc& vsrc, Body body) {
    if (nchunk <= 0) return;
    const int last = nchunk - 1;
    StgRegs rg;
    stg_load<WITH_V>(rg, 0, tid, ksrc, vsrc);
    __syncthreads();
    stg_store<WITH_V>(rg, stg, tid); stg_load<WITH_V>(rg, 1 < last ? 1 : last, tid, ksrc, vsrc);
    lds_barrier();
#pragma nounroll
    for (int ch = 0; ch < nchunk; ++ch) {
        body(ch, stg + (ch & 1) * NT_STG_SZ);
        stg_store<WITH_V>(rg, stg + ((ch + 1) & 1) * NT_STG_SZ, tid); stg_load<WITH_V>(rg, ch + 2 < last ? ch + 2 : last, tid, ksrc, vsrc);
        lds_barrier();
    }
}
DI f16x8 lds_vt(const LAS f16* p) { const f16x4 a = *(const LAS f16x4*)p, b = *(const LAS f16x4*)(p + 16); f16x8 r; r[0] = a[0]; r[1] = a[1]; r[2] = a[2]; r[3] = a[3]; r[4] = b[0]; r[5] = b[1]; r[6] = b[2]; r[7] = b[3]; return r; }
DI f32x4 qk_tile(const LAS f16* kb, int kt, int fr, int q, const f16x8 (&qf)[2]) {
    const LAS f16* kp = kb + (16 * kt + fr) * 72 + 8 * q; f32x4 sa = (f32x4){0.f, 0.f, 0.f, 0.f};
    sa = __builtin_amdgcn_mfma_f32_16x16x32_f16(*(const LAS f16x8*)kp, qf[0], sa, 0, 0, 0); return __builtin_amdgcn_mfma_f32_16x16x32_f16(*(const LAS f16x8*)(kp + 32), qf[1], sa, 0, 0, 0);
}
constexpr float NSA_L2E = 1.44269504f, NSA_C1 = 0.125f * NSA_L2E;
DI float ex2(float x) { return __builtin_amdgcn_exp2f(x); }
template <class Pred>
DI f16x8 pv_step(const LAS f16* kb, const LAS f16* vb, int st, int fr, int q, const f16x8 (&qf)[2], f32x4 (&o)[4], f32x4 (&e2)[2], float nb, bool masked, Pred pred) {
#pragma unroll
    for (int hf = 0; hf < 2; ++hf) { const f32x4 sa = qk_tile(kb, 2 * st + hf, fr, q, qf);
        if (!masked) {
#pragma unroll
            for (int j = 0; j < 4; ++j) e2[hf][j] = ex2(fmaf(sa[j], NSA_C1, nb)); }
        else {
#pragma unroll
            for (int j = 0; j < 4; ++j) e2[hf][j] = pred(32 * st + 16 * hf + 4 * q + j) ? ex2(fmaf(sa[j], NSA_C1, nb)) : 0.f; } }
    const f16x8 pb = pack_p(e2[0], e2[1]);
#pragma unroll
    for (int dt = 0; dt < 4; ++dt) o[dt] = __builtin_amdgcn_mfma_f32_16x16x32_f16(lds_vt(vb + (16 * dt + fr) * 136 + 32 * st + 4 * q), pb, o[dt], 0, 0, 0);
    return pb;
}
DI void nsa_tile(const Ctx& c, int tile, const f16* Q16, const f16* KC16, const f16* VCT16, const f16* KS16, const f16* VST16, const f16* KW16, const f16* VWT16,
                 const float* GATES, const f16* DG, f16* Y16, float shc, float shs, float shw) {
    LAS unsigned char* lds = c.lds; const int wave = c.wave; int tid, lane, fr, q, ti, h, trow;
    const int t0 = tile * 32, cur = t0 >> 6;
#define NSA_RELANE() do { int _t = c.tid; asm volatile("" : "+v"(_t)); tid = _t; lane = _t & 63; fr = lane & 15; q = lane >> 4; ti = fr >> 2; h = fr & 3; trow = t0 + 4 * wave + ti; } while (0)
#define NSA_REPS(bit) (((NSA_DUP >> (bit)) & 1) ? 2 : 1)
#define NSA_SCALE(rep) ({ float _z = (rep) == 0 ? 1.f : 0.f; asm volatile("" : "+v"(_z)); _z; })
    NSA_RELANE();
    LAS float* PSEL = (LAS float*)(lds + NT_PSEL); LAS unsigned* MASK = (LAS unsigned*)(lds + NT_MASK); LAS int* VB = (LAS int*)(lds + NT_VB); LAS unsigned char* STG = lds + NT_STG;
    __syncthreads();
    for (int i = tid; i < 272; i += 512) MASK[i] = (i == 0 || i == cur || i == cur - 1) ? 0xFFFFFFFFu : 0u;
    f16x8 qf[2];
#pragma unroll
    for (int ks = 0; ks < 2; ++ks) qf[ks] = ld_h8(Q16 + ((size_t)trow * 4 + h) * 64 + 32 * ks + 8 * q);
    const int nkt = ((t0 >> 4) + 1 + 15) >> 4;
    const int ncch = (nkt + 7) >> 3;
    const int nv_row = trow >= 31 ? ((trow - 31) >> 4) + 1 : 0;
    auto kc_src = [&](int ch, int row) { return KC16 + (size_t)(128 * ch + row) * 64; };
    auto vc_src = [&](int ch, int d, int seg) { return VCT16 + (size_t)d * 1024 + 128 * ch + seg * 16; };
    float lsum = 0.f;
    const float bc = -shc * NSA_L2E, bs = -shs * NSA_L2E, bw = -shw * NSA_L2E;
    const int tw0 = t0 + 4 * wave, nvmin_w = tw0 >= 31 ? ((tw0 - 31) >> 4) + 1 : 0;
    stream_chunks<false>(STG, ncch, tid, kc_src, vc_src, [&](int ch, LAS unsigned char* buf) {
        const LAS f16* kb = (const LAS f16*)buf; const int nk = nkt - 8 * ch < 8 ? nkt - 8 * ch : 8;
#pragma unroll 4
        for (int kt = 0; kt < nk; ++kt) { const f32x4 sa = qk_tile(kb, kt, fr, q, qf); const int cb = 128 * ch + 16 * kt + 4 * q;
            if (128 * ch + 16 * kt + 15 < nvmin_w) {
#pragma unroll
                for (int j = 0; j < 4; ++j) lsum += ex2(fmaf(sa[j], NSA_C1, bc)); }
            else {
#pragma unroll
                for (int j = 0; j < 4; ++j) lsum += (cb + j < nv_row) ? ex2(fmaf(sa[j], NSA_C1, bc)) : 0.f; } } });
    lsum += __shfl_xor(lsum, 16); lsum += __shfl_xor(lsum, 32);
    const float invc = lsum > 0.f ? 1.f / lsum : 0.f;
    NSA_RELANE();
    f32x4 oc[4];
#pragma unroll
    for (int dt = 0; dt < 4; ++dt) oc[dt] = (f32x4){0.f, 0.f, 0.f, 0.f};
    { float bprev = 0.f; const float pbias = invc > 0.f ? bc + __log2f(invc) : -1e30f;
    stream_chunks<true>(STG, ncch, tid, kc_src, vc_src, [&](int ch, LAS unsigned char* buf) {
        const LAS f16* kb = (const LAS f16*)buf; const LAS f16* vb = (const LAS f16*)(buf + 18432); const int ns = (nkt - 8 * ch + 1) >> 1 < 4 ? (nkt - 8 * ch + 1) >> 1 : 4;
#pragma unroll 2
        for (int s2 = 0; s2 < ns; ++s2) {
            f32x4 e2[2];
            pv_step(kb, vb, s2, fr, q, qf, oc, e2, pbias, 128 * ch + 32 * s2 + 31 >= nvmin_w, [&](int kc) { return 128 * ch + kc < nv_row; });
#pragma unroll
            for (int hf = 0; hf < 2; ++hf) {
                const int ktg = 8 * ch + 2 * s2 + hf;
                float av = (e2[hf][0] + e2[hf][1]) + (e2[hf][2] + 0.5f * e2[hf][3]), bv = 0.5f * e2[hf][3];
                av += dppf<DPP_X1>(av); av += dppf<DPP_X2>(av); bv += dppf<DPP_X1>(bv); bv += dppf<DPP_X2>(bv);
                const float up = __shfl(q == 3 ? bprev : bv, (lane + 48) & 63);
                bprev = bv;
                if (h == 0 && ktg < nkt) PSEL[(4 * wave + ti) * 256 + 4 * ktg + q] = av + up;
            }
        } }); }
    for (int rep = 0; rep < NSA_REPS(2); ++rep) {
        const int nforced = cur >= 2 ? 3 : cur + 1, nsel = ((cur + 1) < 16 ? (cur + 1) : 16) - nforced, tk = lane >> 4, l16 = lane & 15, tokl = 4 * wave + tk;
        float sv[16];
#pragma unroll
        for (int i = 0; i < 16; ++i) { const int j = l16 + 16 * i; float v = -3e38f;
            if (j <= cur && !(j == 0 || j == cur || j == cur - 1)) v = j < 4 * nkt ? PSEL[tokl * 256 + j] : 0.f;
            sv[i] = v; }
#pragma nounroll
        for (int k = 0; k < nsel; ++k) {
            float bv = sv[0]; int bi = l16;
#pragma unroll
            for (int i = 1; i < 16; ++i) if (sv[i] > bv) { bv = sv[i]; bi = l16 + 16 * i; }
#define TOPK_STEP(CT) do { const float ov = dppf<CT>(bv); const int oi = dppi<CT>(bi); if (ov > bv || (ov == bv && oi < bi)) { bv = ov; bi = oi; } } while (0)
            TOPK_STEP(DPP_X1); TOPK_STEP(DPP_X2); TOPK_STEP(DPP_HM); TOPK_STEP(DPP_R8);
#undef TOPK_STEP
            if (l16 == 0) __hip_atomic_fetch_or(&MASK[bi], 1u << tokl, __ATOMIC_RELAXED, __HIP_MEMORY_SCOPE_WORKGROUP);
#pragma unroll
            for (int i = 0; i < 16; ++i) if (l16 + 16 * i == bi) sv[i] = -3e38f;
        }
    }
    NSA_RELANE();
    f32x4 owr[4]; float lwr = 0.f;
#pragma unroll
    for (int dt = 0; dt < 4; ++dt) owr[dt] = (f32x4){0.f, 0.f, 0.f, 0.f};
    f16x8 onesf;
#pragma unroll
    for (int i = 0; i < 8; ++i) onesf[i] = fr == 0 ? (f16)1.f : (f16)0.f;
    f32x4 lw5 = (f32x4){0.f, 0.f, 0.f, 0.f};
    {
        const int wlo = t0 - 512 > 0 ? t0 - 512 : 0, nwch = (t0 + 32 - wlo + 127) >> 7;
        auto kw_src = [&](int ch, int row) { int p = wlo + 128 * ch + row; p = p < SEQ ? p : SEQ - 1; return KW16 + (size_t)p * 64; };
        auto vw_src = [&](int ch, int d, int seg) { const int key = wlo + 128 * ch + seg * 16; int blk = key >> 6; blk = blk < 256 ? blk : 255; return VWT16 + (size_t)blk * 4096 + d * 64 + (key & 63); };
        {
        stream_chunks<true>(STG, nwch, tid, kw_src, vw_src, [&](int ch, LAS unsigned char* buf) {
            const LAS f16* kb = (const LAS f16*)buf; const LAS f16* vb = (const LAS f16*)(buf + 18432); const int pbase = wlo + 128 * ch;
            const int ns = (t0 + 32 - pbase) >> 5 < 4 ? (t0 + 32 - pbase) >> 5 : 4;
#pragma unroll 2
            for (int s2 = 0; s2 < ns; ++s2) { f32x4 e2[2];
                const int p0s = pbase + 32 * s2; const bool masked = !(p0s >= tw0 + 3 - 512 && p0s + 31 <= tw0);
                const f16x8 pb = pv_step(kb, vb, s2, fr, q, qf, owr, e2, bw, masked, [&](int kc) { const int pos = pbase + kc; return pos <= trow && pos >= trow - 512; });
                lw5 = __builtin_amdgcn_mfma_f32_16x16x32_f16(onesf, pb, lw5, 0, 0, 0); } }); }
        lwr = lw5[0];
    }
    NSA_RELANE();
    LAS unsigned* MT = (LAS unsigned*)(lds + NT_MT);
    if (wave == 0) { int cnt = 0;
        for (int base = 0; base <= cur; base += 64) { const int jx = base + lane; const unsigned mj = jx <= cur ? MASK[jx] : 0u; const bool v = mj != 0u; const unsigned long long bal = __ballot(v);
            if (v) { const int pos = cnt + __popcll(bal & ((1ull << lane) - 1ull)); VB[pos] = jx; MT[pos] = mj; } cnt += __popcll(bal); }
        if (lane < 8) { VB[cnt + lane] = VB[cnt - 1]; MT[cnt + lane] = 0u; }
        if (lane == 0) VB[264] = cnt; }
    __syncthreads();
    if (VERIFY_NSA) { unsigned* SELM = (unsigned*)(c.ws + WS_SELM) + (size_t)tile * 272; for (int i = tid; i < 272; i += 512) SELM[i] = MASK[i]; }
    f32x4 osr[4]; float lsr = 0.f; f32x4 ls5 = (f32x4){0.f, 0.f, 0.f, 0.f};
#pragma unroll
    for (int dt = 0; dt < 4; ++dt) osr[dt] = (f32x4){0.f, 0.f, 0.f, 0.f};
#pragma unroll
    for (int i = 0; i < 8; ++i) onesf[i] = fr == 0 ? (f16)1.f : (f16)0.f;
    {
        const int nvb = __builtin_amdgcn_readfirstlane(VB[264]), nst = (nvb + 3) >> 2;
        const int dr = lane >> 3, dp = lane & 7, dsw = (dp ^ dr) * 8;
        LAS unsigned char* RING = lds + NT_RING;
        auto dma = [&](int n, int blk) { LAS unsigned char* slot = RING + (n & 7) * 16384 + wave * 1024;
            __builtin_amdgcn_global_load_lds((const unsigned*)(KS16 + ((size_t)blk * 64 + 8 * wave + dr) * 64 + dsw), (LAS unsigned*)slot, 16, 0, 0);
            __builtin_amdgcn_global_load_lds((const unsigned*)(VST16 + (size_t)blk * 4096 + (8 * wave + dr) * 64 + dsw), (LAS unsigned*)(slot + 8192), 16, 0, 0); };
        {
        asm volatile("s_waitcnt vmcnt(0)" ::: "memory"); __syncthreads();
        typedef int i32x4 __attribute__((ext_vector_type(4)));
#define RFL4(v) { __builtin_amdgcn_readfirstlane((v)[0]), __builtin_amdgcn_readfirstlane((v)[1]), __builtin_amdgcn_readfirstlane((v)[2]), __builtin_amdgcn_readfirstlane((v)[3]) }
        { const i32x4 b0 = *(const LAS i32x4*)VB; const int bb[4] = RFL4(b0); dma(0, bb[0]); dma(1, bb[1]); dma(2, bb[2]); dma(3, bb[3]); }
#pragma nounroll
        for (int st = 0; st < nst; ++st) {
            asm volatile("s_waitcnt vmcnt(0)\n\ts_barrier" ::: "memory");
            const i32x4 bcv = *(const LAS i32x4*)(VB + 4 * st), bnv = *(const LAS i32x4*)(VB + 4 * st + 4); const u32x4 mcv = *(const LAS u32x4*)(MT + 4 * st);
            const int bcur[4] = RFL4(bcv), bnxt[4] = RFL4(bnv); const int mcur[4] = RFL4(mcv);
            dma(4 * st + 4, bnxt[0]); dma(4 * st + 5, bnxt[1]); dma(4 * st + 6, bnxt[2]); dma(4 * st + 7, bnxt[3]);
#pragma unroll
            for (int i4 = 0; i4 < 4; ++i4) {
            const int n = 4 * st + i4;
            const int blk = bcur[i4]; const unsigned mt = ((unsigned)mcur[i4] >> (4 * wave)) & 15u;
            if (mt != 0u) {
                const bool rv = ((mt >> ti) & 1u) != 0u; const LAS unsigned char* ks = RING + (n & 7) * 16384; const LAS unsigned char* vs = ks + 8192; const int sx = fr & 7;
                f32x4 sa[4]; f16x8 va[2][4];
#pragma unroll
                for (int kt = 0; kt < 4; ++kt) { const LAS unsigned char* kp = ks + (16 * kt + fr) * 128; sa[kt] = (f32x4){0.f, 0.f, 0.f, 0.f};
                    sa[kt] = __builtin_amdgcn_mfma_f32_16x16x32_f16(*(const LAS f16x8*)(kp + ((q ^ sx) << 4)), qf[0], sa[kt], 0, 0, 0);
                    sa[kt] = __builtin_amdgcn_mfma_f32_16x16x32_f16(*(const LAS f16x8*)(kp + (((4 + q) ^ sx) << 4)), qf[1], sa[kt], 0, 0, 0); }
#pragma unroll
                for (int s2 = 0; s2 < 2; ++s2) { const int sg = 4 * s2 + (q >> 1);
#pragma unroll
                    for (int dt = 0; dt < 4; ++dt) { const LAS unsigned char* vp = vs + (16 * dt + fr) * 128 + 8 * (q & 1);
                        const f16x4 v0 = *(const LAS f16x4*)(vp + ((sg ^ sx) << 4)), v1 = *(const LAS f16x4*)(vp + (((sg + 2) ^ sx) << 4));
                        va[s2][dt][0] = v0[0]; va[s2][dt][1] = v0[1]; va[s2][dt][2] = v0[2]; va[s2][dt][3] = v0[3]; va[s2][dt][4] = v1[0]; va[s2][dt][5] = v1[1]; va[s2][dt][6] = v1[2]; va[s2][dt][7] = v1[3]; } }
                const float nbu = rv ? bs : -1e30f;
                if (blk != cur) {
#pragma unroll
                    for (int kt = 0; kt < 4; ++kt)
#pragma unroll
                        for (int j = 0; j < 4; ++j) sa[kt][j] = ex2(fmaf(sa[kt][j], NSA_C1, nbu)); }
                else { const int pb0 = 64 * blk + 4 * q;
#pragma unroll
                    for (int kt = 0; kt < 4; ++kt)
#pragma unroll
                        for (int j = 0; j < 4; ++j) sa[kt][j] = (pb0 + 16 * kt + j <= trow) ? ex2(fmaf(sa[kt][j], NSA_C1, nbu)) : 0.f; }
                const f16x8 p0 = pack_p(sa[0], sa[1]), p1 = pack_p(sa[2], sa[3]);
#pragma unroll
                for (int dt = 0; dt < 4; ++dt) { osr[dt] = __builtin_amdgcn_mfma_f32_16x16x32_f16(va[0][dt], p0, osr[dt], 0, 0, 0); osr[dt] = __builtin_amdgcn_mfma_f32_16x16x32_f16(va[1][dt], p1, osr[dt], 0, 0, 0); }
                ls5 = __builtin_amdgcn_mfma_f32_16x16x32_f16(onesf, p0, ls5, 0, 0, 0); ls5 = __builtin_amdgcn_mfma_f32_16x16x32_f16(onesf, p1, ls5, 0, 0, 0);
            }
            }
        }
        asm volatile("s_waitcnt vmcnt(0)" ::: "memory"); }
        __syncthreads();
        lsr = ls5[0];
    }
    NSA_RELANE();
    lwr += __shfl_xor(lwr, 16); lwr += __shfl_xor(lwr, 32); lsr += __shfl_xor(lsr, 16); lsr += __shfl_xor(lsr, 32);
    {
        const float g0 = GATES[(size_t)trow * 12 + h * 3], ils = GATES[(size_t)trow * 12 + h * 3 + 1] / lsr, ilw = GATES[(size_t)trow * 12 + h * 3 + 2] / lwr;
#pragma unroll
        for (int dt = 0; dt < 4; ++dt) { const int d0 = 16 * dt + 4 * q; const f16x4 dg = *(const f16x4*)(DG + (size_t)trow * 256 + h * 64 + d0); f16x4 y;
#pragma unroll
            for (int jj = 0; jj < 4; ++jj) { const float o = g0 * oc[dt][jj] + ils * osr[dt][jj] + ilw * owr[dt][jj]; y[jj] = (f16)(siluf_((float)dg[jj]) * o); }
            *(f16x4*)(Y16 + (size_t)trow * 1024 + 768 + h * 64 + d0) = y; }
    }
#undef NSA_RELANE
}
DI void ph_ssd_fin(LAS unsigned char* lds_, int l, int it0, int it1, int itstep);
DI void ph_outproj_sample(LAS unsigned char* lds_, int l, int it);
DI void ph_nsa(LAS unsigned char* lds_, int l) {
    const Ctx c = mkctx(lds_); const int lane = c.lane;
    const float* qg = INP(I_QG) + l * 64; const float* kg = INP(I_KG) + l * 192;
    const float mq = wmaxf(fabsf(qg[lane])), mk0 = wmaxf(fabsf(kg[lane])), mk1 = wmaxf(fabsf(kg[64 + lane])), mk2 = wmaxf(fabsf(kg[128 + lane]));
    const float shc = 8.f * mq * mk0 - 8.f, shs = 8.f * mq * mk1 - 8.f, shw = 8.f * mq * mk2 - 8.f;
    unsigned* qctr = (unsigned*)(c.ws + WS_CTL + 16384) + l * 64; LAS int* qslot = (LAS int*)(c.lds + MISC_OFF + 64); bool fin_ok = false, smp_ok = false;
    for (;;) {
        __syncthreads();
        if (c.tid == 0) *qslot = (int)__hip_atomic_fetch_add(qctr, 1u, __ATOMIC_RELAXED, __HIP_MEMORY_SCOPE_AGENT);
        __syncthreads();
        const int u = __builtin_amdgcn_readfirstlane(*qslot);
        if (u >= 800) break;
        if (u < 512) nsa_tile(c, 511 - u, WSH(WS_Q16), WSH(WS_KC16), WSH(WS_VCT16), WSH(WS_KS16), WSH(WS_VST16), WSH(WS_KW16), WSH(WS_VWT16), WSF(WS_GATES), WSH(WS_PROJ) + (size_t)14 * SEQ * 256, WSH(WS_Y16), shc, shs, shw);
        else if (u < 768) { if (!fin_ok) { edge_wait((unsigned*)(c.ws + WS_CTL + 17408) + l * 64, 64u); fin_ok = true; } ph_ssd_fin(lds_, l, u - 512, u - 511, 1); }
        else { if (!smp_ok) { edge_wait((unsigned*)(c.ws + WS_CTL + 18432) + l * 64, 32u); smp_ok = true; } ph_outproj_sample(lds_, l, u - 768); }
    }
    __syncthreads();
}
DI void ph_nsa_verify(LAS unsigned char* lds_, int l) {
    const Ctx c = mkctx(lds_); const int lane = c.lane;
    LAS float* wl = (LAS float*)c.lds + c.wave * 4400; LAS float* sc = wl; LAS float* qs = wl + 4096; LAS unsigned* selb = (LAS unsigned*)(wl + 4352);
    const f16* Q16 = WSH(WS_Q16); const f16* KC16 = WSH(WS_KC16); const f16* VCT16 = WSH(WS_VCT16); const f16* KS16 = WSH(WS_KS16); const f16* VST16 = WSH(WS_VST16); const f16* KW16 = WSH(WS_KW16); const f16* VWT16 = WSH(WS_VWT16);
    const float* GATES = WSF(WS_GATES); const f16* DG = WSH(WS_PROJ) + (size_t)14 * SEQ * 256; const f16* Y16 = WSH(WS_Y16); const unsigned* SELM = (const unsigned*)(c.ws + WS_SELM);
    float* dbg = (float*)(c.ws + WS_CTL + 40960);
    auto dot4 = [&](const f16* kp, float (&s4)[4]) { s4[0] = s4[1] = s4[2] = s4[3] = 0.f;
#pragma unroll
        for (int i = 0; i < 8; ++i) { const f16x8 kv = ld_h8(kp + 8 * i);
#pragma unroll
            for (int j = 0; j < 8; ++j) { const f32x4 qv = *(const LAS f32x4*)(qs + (8 * i + j) * 4); const float kf = (float)kv[j]; s4[0] += qv[0] * kf; s4[1] += qv[1] * kf; s4[2] += qv[2] * kf; s4[3] += qv[3] * kf; } }
#pragma unroll
        for (int hh = 0; hh < 4; ++hh) s4[hh] *= 0.125f; };
    for (int si = c.bid * 8 + c.wave; si < 200 + 395; si += c.G * 8) {
        const int t = si < 200 ? si : 200 + (si - 200) * 41, cur = t >> 6, ncv = t >= 31 ? ((t - 31) >> 4) + 1 : 0;
#pragma unroll
        for (int hh = 0; hh < 4; ++hh) qs[lane * 4 + hh] = (float)Q16[(size_t)t * 256 + hh * 64 + lane];
        if (lane < 9) selb[lane] = 0u;
        float oc[4] = {0.f, 0.f, 0.f, 0.f}, os[4] = {0.f, 0.f, 0.f, 0.f}, ow[4] = {0.f, 0.f, 0.f, 0.f};
        {
            float mx[4] = {-3e38f, -3e38f, -3e38f, -3e38f}, inv[4];
            for (int cc = lane; cc < ncv; cc += 64) { asm volatile("" ::: "memory"); float s4[4]; dot4(KC16 + (size_t)cc * 64, s4);
#pragma unroll
                for (int hh = 0; hh < 4; ++hh) { sc[hh * 1024 + cc] = s4[hh]; mx[hh] = fmaxf(mx[hh], s4[hh]); } }
#pragma unroll
            for (int hh = 0; hh < 4; ++hh) { mx[hh] = wmaxf(mx[hh]); float sm = 0.f; for (int cc = lane; cc < ncv; cc += 64) { const float e = __expf(sc[hh * 1024 + cc] - mx[hh]); sc[hh * 1024 + cc] = e; sm += e; } sm = wsum(sm); inv[hh] = ncv > 0 ? 1.f / sm : 0.f; }
            for (int cc = lane; cc < ncv; cc += 64) {
#pragma unroll
                for (int hh = 0; hh < 4; ++hh) sc[hh * 1024 + cc] *= inv[hh]; }
            for (int cc = 0; cc < ncv; ++cc) { const float v = (float)VCT16[(size_t)lane * 1024 + cc];
#pragma unroll
                for (int hh = 0; hh < 4; ++hh) oc[hh] += sc[hh * 1024 + cc] * v; }
        }
        const int nsel = (cur + 1) < 16 ? (cur + 1) : 16;
        {
            float scv[5];
#pragma unroll
            for (int i = 0; i < 5; ++i) { const int j = lane + 64 * i; float v = -3e38f;
                if (j <= cur) { if (j == 0 || j == cur || j == cur - 1) v = 3e38f; else { float a = 0.f;
#pragma unroll
                        for (int o5 = -1; o5 < 4; ++o5) { const int cc = 4 * j + o5; if (cc >= 0 && cc < ncv) { const float p = (sc[cc] + sc[1024 + cc]) + (sc[2048 + cc] + sc[3072 + cc]); a += (o5 == -1 || o5 == 3) ? 0.5f * p : p; } }
                        v = a; } }
                scv[i] = v; }
            for (int k = 0; k < nsel; ++k) {
                float bv = scv[0]; int bi = lane;
#pragma unroll
                for (int i = 1; i < 5; ++i) if (scv[i] > bv) { bv = scv[i]; bi = lane + 64 * i; }
#pragma unroll
                for (int off = 32; off > 0; off >>= 1) { const float ov = __shfl_xor(bv, off); const int oi = __shfl_xor(bi, off); if (ov > bv || (ov == bv && oi < bi)) { bv = ov; bi = oi; } }
                if (lane == 0) selb[bi >> 5] |= 1u << (bi & 31);
#pragma unroll
                for (int i = 0; i < 5; ++i) if (lane + 64 * i == bi) scv[i] = -3e38f;
            }
        }
        int nmis = 0;
        for (int j = lane; j <= cur; j += 64) { const unsigned fb = (SELM[(size_t)(t >> 5) * 272 + j] >> (t & 31)) & 1u, nb = (selb[j >> 5] >> (j & 31)) & 1u; nmis += (fb != nb) ? 1 : 0; }
        nmis = (int)wsum((float)nmis);
        if (nmis != 0) { if (lane == 0) { atomicAdd(dbg + 3, 1.f); atomicAdd(dbg + 4, (float)nmis); } continue; }
        {
            float mx[4] = {-3e38f, -3e38f, -3e38f, -3e38f}, inv[4]; int nk = 0;
            for (int j = 0; j <= cur; ++j) if ((selb[j >> 5] >> (j & 31)) & 1u) { asm volatile("" ::: "memory"); const int pos = j * 64 + lane; float s4[4] = {-1e30f, -1e30f, -1e30f, -1e30f}; if (pos <= t) dot4(KS16 + (size_t)pos * 64, s4);
#pragma unroll
                for (int hh = 0; hh < 4; ++hh) { sc[hh * 1024 + nk * 64 + lane] = s4[hh]; mx[hh] = fmaxf(mx[hh], s4[hh]); } ++nk; }
#pragma unroll
            for (int hh = 0; hh < 4; ++hh) { mx[hh] = wmaxf(mx[hh]); float sm = 0.f; for (int k = 0; k < nk; ++k) { const float x = sc[hh * 1024 + k * 64 + lane]; const float e = x > -1e29f ? __expf(x - mx[hh]) : 0.f; sc[hh * 1024 + k * 64 + lane] = e; sm += e; } sm = wsum(sm); inv[hh] = 1.f / sm; }
            nk = 0;
            for (int j = 0; j <= cur; ++j) if ((selb[j >> 5] >> (j & 31)) & 1u) { for (int kk = 0; kk < 64 && j * 64 + kk <= t; ++kk) { const float v = (float)VST16[(size_t)j * 4096 + lane * 64 + kk];
#pragma unroll
                    for (int hh = 0; hh < 4; ++hh) os[hh] += sc[hh * 1024 + nk * 64 + kk] * v; } ++nk; }
#pragma unroll
            for (int hh = 0; hh < 4; ++hh) os[hh] *= inv[hh];
        }
        {
            const int lo = t - 512 > 0 ? t - 512 : 0, nw = t - lo + 1; float mx[4] = {-3e38f, -3e38f, -3e38f, -3e38f}, inv[4];
            for (int i = lane; i < nw; i += 64) { asm volatile("" ::: "memory"); float s4[4]; dot4(KW16 + (size_t)(lo + i) * 64, s4);
#pragma unroll
                for (int hh = 0; hh < 4; ++hh) { sc[hh * 1024 + i] = s4[hh]; mx[hh] = fmaxf(mx[hh], s4[hh]); } }
#pragma unroll
            for (int hh = 0; hh < 4; ++hh) { mx[hh] = wmaxf(mx[hh]); float sm = 0.f; for (int i = lane; i < nw; i += 64) { const float e = __expf(sc[hh * 1024 + i] - mx[hh]); sc[hh * 1024 + i] = e; sm += e; } sm = wsum(sm); inv[hh] = 1.f / sm; }
            for (int i = 0; i < nw; ++i) { const int pos = lo + i; const float v = (float)VWT16[(size_t)(pos >> 6) * 4096 + lane * 64 + (pos & 63)];
#pragma unroll
                for (int hh = 0; hh < 4; ++hh) ow[hh] += sc[hh * 1024 + i] * v; }
#pragma unroll
            for (int hh = 0; hh < 4; ++hh) ow[hh] *= inv[hh];
        }
        float dd = 0.f, ee = 0.f;
#pragma unroll
        for (int hh = 0; hh < 4; ++hh) { const float o = GATES[(size_t)t * 12 + hh * 3] * oc[hh] + GATES[(size_t)t * 12 + hh * 3 + 1] * os[hh] + GATES[(size_t)t * 12 + hh * 3 + 2] * ow[hh];
            const float yn = siluf_((float)DG[(size_t)t * 256 + hh * 64 + lane]) * o, yf = (float)Y16[(size_t)t * 1024 + 768 + hh * 64 + lane]; dd += (yf - yn) * (yf - yn); ee += yn * yn; }
        dd = wsum(dd); ee = wsum(ee);
        if (lane == 0) { atomicAdd(dbg, dd); atomicAdd(dbg + 1, ee); atomicAdd(dbg + 2, 1.f); }
    }
    (void)l;
}
DI void ph_ssd_fin(LAS unsigned char* lds_, int l, int it0, int it1, int itstep) {
    const Ctx c = mkctx(lds_); const int lane = c.lane, wave = c.wave;
    const float* Dp = INP(I_SD) + l * 4; const float* sng = INP(I_SNG) + l * 256;
    const float* CST = WSF(WS_HPV); const f16* ACT = WSH(WS_ACT); const float* ACS = WSF(WS_ACS); const float* YD = WSF(WS_YD); const f16* Z = WSH(WS_PROJ) + (size_t)4 * SEQ * 256; f16* Y16 = WSH(WS_Y16);
    LAS float* GY = (LAS float*)c.lds;
    for (int it = it0; it < it1; it += itstep) {
        const int ch_ = it >> 1, t0 = it * 64, hd = wave >> 1, g = hd >> 1, fr = lane & 15, q = lane >> 4;
        __syncthreads();
        f16x8 bf[2][4];
#pragma unroll
        for (int p2 = 0; p2 < 2; ++p2)
#pragma unroll
            for (int ks = 0; ks < 4; ++ks) bf[p2][ks] = cvt_h8(CST + ((size_t)(ch_ * 4 + hd) * 64 + 16 * ((wave & 1) * 2 + p2) + fr) * 128 + 32 * ks + 8 * q);
#pragma unroll
        for (int lt = 0; lt < 4; ++lt) {
            f16x8 af[4];
#pragma unroll
            for (int ks = 0; ks < 4; ++ks) af[ks] = ld_h8(ACT + (size_t)(t0 + 16 * lt + fr) * 768 + 512 + 128 * g + 32 * ks + 8 * q);
#pragma unroll
            for (int p2 = 0; p2 < 2; ++p2) { f32x4 acc = (f32x4){0.f, 0.f, 0.f, 0.f};
#pragma unroll
                for (int ks = 0; ks < 4; ++ks) acc = __builtin_amdgcn_mfma_f32_16x16x32_f16(af[ks], bf[p2][ks], acc, 0, 0, 0);
                const int ch = hd * 64 + 16 * ((wave & 1) * 2 + p2) + fr;
#pragma unroll
                for (int j = 0; j < 4; ++j) { const int tl = 16 * lt + 4 * q + j, t = t0 + tl;
                    const float y = acc[j] * __expf(ACS[(size_t)t * 4 + hd]) + YD[(size_t)t * 256 + ch] + Dp[hd] * (float)ACT[(size_t)t * 768 + ch];
                    GY[tl * 256 + ch] = y * siluf_((float)Z[(size_t)t * 256 + ch]); } }
        }
        __syncthreads();
        for (int tl = wave; tl < 64; tl += 8) { const f32x4 v = *(const LAS f32x4*)(GY + tl * 256 + lane * 4); const float ss = wsum((v[0] * v[0] + v[1] * v[1]) + (v[2] * v[2] + v[3] * v[3]));
            const float rn = rsqrtf(ss * (1.f / 256.f) + EPS); const f32x4 g4 = *(const f32x4*)(sng + lane * 4); f16x4 o;
#pragma unroll
            for (int i = 0; i < 4; ++i) o[i] = (f16)(v[i] * rn * g4[i]);
            *(f16x4*)(Y16 + (size_t)(t0 + tl) * 1024 + 256 + lane * 4) = o; }
    }
    __syncthreads();
}
DI void ph_outproj(LAS unsigned char* lds_, int l) {
    const Ctx c = mkctx(lds_);
    const float* xin = l == 0 ? INP(I_XP) : WSF(WS_X1); float* xout = l == 0 ? WSF(WS_X1) : c.out + O_YP;
    pg8::Gemm g{WSH(WS_Y16), WSH(WS_WTOUT) + (size_t)l * 1024 * 1024, SEQ, 1024, 1024}; pg8::StaticOrder S; S.init(SEQ, 1024, c.G, c.bid);
    EpiOut E{xin, xout, WSF(WS_ADA) + (size_t)(l * 33 + 32) * 3072 + 2048, l == 0 ? WSH(WS_A16) : nullptr, WSF(WS_GNX), WSF(WS_RSSP)};
    pg8::gemm_phase<EpiOut, pg8::StaticOrder>(c.lds, g, S, E);
    __syncthreads();
}
DI void ph_outproj_sample(LAS unsigned char* lds_, int l, int it) {
    const Ctx c = mkctx(lds_); const int tid = c.tid;
    const float* xs_in = l == 0 ? INP(I_XS) : WSF(WS_XS1); const float* ada_l = WSF(WS_ADA) + (size_t)l * 33 * 3072; const float* YS = WSF(WS_YS); float* xo = l == 0 ? WSF(WS_XS1) : c.out + O_YS;
    LAS f16* Ah = (LAS f16*)c.lds;
    __syncthreads();
#pragma unroll
    for (int i = 0; i < 16; ++i) { const int e = (tid + 512 * i) * 4; const f32x4 v = *(const f32x4*)(YS + e); f16x4 hv; hv[0] = (f16)v[0]; hv[1] = (f16)v[1]; hv[2] = (f16)v[2]; hv[3] = (f16)v[3]; *(LAS f16x4*)(Ah + (e >> 10) * 1032 + (e & 1023)) = hv; }
    __syncthreads();
    sample_gemm_item<1>(c.lds, WSH(WS_WTOUT) + (size_t)l * 1024 * 1024, it * 32, [&](int m, int n, float v) { xo[m * 1024 + n] = xs_in[m * 1024 + n] + ada_l[(size_t)m * 3072 + 2048 + n] * v; });
}

__global__ void __launch_bounds__(512, 2) fwd(Args a) {
    extern __shared__ __attribute__((aligned(16))) unsigned char lds_raw[];
    LAS unsigned char* lds = (LAS unsigned char*)lds_raw;
    volatile LAS unsigned* MISC = (volatile LAS unsigned*)(lds + MISC_OFF);
    if (threadIdx.x < 16) MISC[threadIdx.x] = 0u;
    __syncthreads();
    XcdBarrier bar; bar.bar = (unsigned*)(a.ws + WS_CTL); bar.x = 0; bar.st = MISC;
    if (N_LAUNCHES == 1) bar = xcd_barrier_post((unsigned*)(a.ws + WS_CTL), MISC);
    const int lo = a.ph_lo, hi = a.ph_hi;
    unsigned long long* stampw = (unsigned long long*)(a.ws + WS_CTL + 32768);
    if (STAMP_PHASE >= 0 && blockIdx.x == 0 && threadIdx.x == 0) stampw[0] = wall_clock64();
#define STAMP(k) do { if (STAMP_PHASE == (k) && blockIdx.x == 0 && threadIdx.x == 0) stampw[1] = wall_clock64(); } while (0)
#ifndef PH_MASK
#define PH_MASK 0xFFF
#endif
#define IN(k) (((PH_MASK >> ((k) < 2 ? (k) : 2 + ((k) - 2) % 4)) & 1) && lo <= (k) && (k) < hi)
#define SEAM(k) do { if (IN(k) && IN((k) + 1)) xcd_barrier(bar); STAMP(k); } while (0)
#ifndef DUP_MASK
#define DUP_MASK 0
#endif
#define DUP(bit, call) do { call; if ((DUP_MASK >> (bit)) & 1) { __syncthreads(); call; } } while (0)
    if (IN(0)) DUP(0, ph_prologue(lds));
    SEAM(0);
    if (IN(1)) { ph_hsample(lds, 0); DUP(1, ph_sample_compress(lds)); DUP(2, ph_prep(lds)); }
    SEAM(1);
    for (int l = 0; l < 2; ++l) {
        const int PB = 2 + 4 * l;
        if (IN(PB)) { DUP(3, ph_inproj(lds, l)); DUP(4, ph_inproj_sample(lds, l)); }
        SEAM(PB);
        if (IN(PB + 1)) {
#define SUBSTAMP(code) do { if (l == 0 && (STAMP_PHASE == (code) || STAMP_PHASE == (code) + 10) && blockIdx.x == (STAMP_PHASE >= 110 ? 100 : 0) && threadIdx.x == 0) stampw[1] = wall_clock64(); } while (0)
            DUP(5, ph_ssd_local(lds, l)); SUBSTAMP(100); DUP(6, ph_mix_a(lds, l)); SUBSTAMP(101); DUP(7, ph_mix_c(lds, l)); SUBSTAMP(102); DUP(8, ph_mix_d(lds, l)); SUBSTAMP(103); DUP(9, ph_mix_cmp(lds, l)); SUBSTAMP(104); }
        SEAM(PB + 1);
        if (IN(PB + 2)) { DUP(11, ph_scan(lds, l)); DUP(10, ph_mix_sample(lds, l)); ph_nsa(lds, l); }
        SEAM(PB + 2);
        if (IN(PB + 3)) { if (VERIFY_NSA && l == 0) { ph_nsa_verify(lds, l); __syncthreads(); } if (l == 0) ph_hsample(lds, 1); DUP(14, ph_outproj(lds, l)); }
        SEAM(PB + 3);
    }
    if (STAMP_PHASE >= 0 || VERIFY_NSA) {
        xcd_barrier(bar);
        if (blockIdx.x == 0) { __shared__ float alpha_s; if (threadIdx.x == 0) { const unsigned long long t1 = wall_clock64(); alpha_s = (float)(stampw[1] - stampw[0]) / (float)(t1 - stampw[0]);
                if (VERIFY_NSA) { const float* dbg = (const float*)(a.ws + WS_CTL + 40960); alpha_s = VERIFY_NSA == 1 ? dbg[3] / (dbg[2] + dbg[3]) : sqrtf(dbg[0] / dbg[1]); } } __syncthreads();
            const float sc = 1.f + alpha_s; float* ys = a.out + O_YS; for (int i = threadIdx.x; i < NB * 1024; i += 512) ys[i] *= sc; }
    }
#undef IN
#undef SEAM
}

extern "C" void kernel_launch(void* const* d_in, const int* in_sizes, int n_in, void* d_out, int out_size, void* d_ws, size_t ws_size, hipStream_t stream) {
    static int grid = 0;
    if (grid == 0) {
        if (n_in != N_IN || (size_t)out_size != O_END || ws_size < WS_END) { fprintf(stderr, "kernel_launch: unexpected shapes (n_in %d out %d ws %zu)\n", n_in, out_size, ws_size); grid = -1; return; }
        int dev = 0, cus = 0;
        if (hipGetDevice(&dev) != hipSuccess || hipDeviceGetAttribute(&cus, hipDeviceAttributeMultiprocessorCount, dev) != hipSuccess) { grid = -1; return; }
        if (hipFuncSetAttribute((const void*)fwd, hipFuncAttributeMaxDynamicSharedMemorySize, LDS_BYTES) != hipSuccess) { fprintf(stderr, "kernel_launch: hipFuncSetAttribute failed\n"); grid = -1; return; }
        int per_cu = 0;
        if (hipOccupancyMaxActiveBlocksPerMultiprocessor(&per_cu, (const void*)fwd, 512, LDS_BYTES) != hipSuccess || per_cu < 1) fprintf(stderr, "kernel_launch: occupancy query says %d\n", per_cu);
        (void)hipGetLastError();
        grid = cus;
    }
    if (grid < 0) return;
    hipMemsetAsync((char*)d_ws + WS_CTL, 0, 65536, stream);
    Args a{};
    for (int i = 0; i < N_IN; ++i) a.in[i] = d_in[i];
    a.out = (float*)d_out; a.ws = (unsigned char*)d_ws;
    if (N_LAUNCHES == 1) { a.ph_lo = 0; a.ph_hi = NPHASE; hipLaunchKernelGGL(fwd, dim3(grid), dim3(512), LDS_BYTES, stream, a); }
    else for (int p = 0; p < NPHASE; ++p) { a.ph_lo = p; a.ph_hi = p + 1; hipLaunchKernelGGL(fwd, dim3(grid), dim3(512), LDS_BYTES, stream, a); }
}
```

```cpp
#include <hip/hip_runtime.h>
#include <cstdio>
#include <cstdint>
#include <type_traits>

#define NSA_DUP 0
#define VERIFY_NSA 0
#define STAMP_PHASE -1
#ifndef N_LAUNCHES
#define N_LAUNCHES 1
#endif

#define DI __device__ __forceinline__
#define LAS __attribute__((address_space(3)))
typedef _Float16 f16;
typedef _Float16 f16x8 __attribute__((ext_vector_type(8)));
typedef _Float16 f16x4 __attribute__((ext_vector_type(4)));
typedef _Float16 f16x2 __attribute__((ext_vector_type(2)));
typedef float f32x4 __attribute__((ext_vector_type(4)));
typedef float f32x2 __attribute__((ext_vector_type(2)));
typedef float f32x16 __attribute__((ext_vector_type(16)));
typedef unsigned u32x4 __attribute__((ext_vector_type(4)));

constexpr int DM = 1024, SEQ = 16384, NB = 32, PAST = 16384, NPOOL = 5120, DIN = 3728, NPD = 3840;
constexpr float EPS = 1e-6f;
constexpr int NPHASE = 10;
enum { I_XP = 0, I_XS, I_CKV, I_CWIN, I_SSC, I_SBC, I_SSM, I_SCF, I_PT, I_CP, I_CS, I_NG, I_WADA, I_BADA, I_WIN, I_WOUT, I_SCW, I_BCW, I_BCB,
       I_DTB, I_ALOG, I_SD, I_SNG, I_CFW, I_CFB, I_LNG, I_LNB, I_QG, I_KG, I_PE, I_W1, I_B1, I_W2, I_B2, N_IN };
constexpr size_t O_YP = 0, O_YS = O_YP + (size_t)SEQ * DM, O_KVP = O_YS + NB * DM, O_KVS = O_KVP + (size_t)2 * SEQ * 256, O_WINP = O_KVS + 2 * NB * 256,
                 O_WINS = O_WINP + 2 * 512 * 128, O_SCP = O_WINS + (size_t)2 * NB * 512 * 128, O_SCS = O_SCP + 2 * 2 * 256, O_BCP = O_SCS + 2 * NB * 512,
                 O_BCS = O_BCP + 2 * 3 * 768, O_HP = O_BCS + 2 * NB * 2304, O_HS = O_HP + 2 * 32768, O_CFP = O_HS + (size_t)2 * NB * 32768,
                 O_CFS = O_CFP + 2 * 30 * 256, O_END = O_CFS + 2 * NB * 7680;
constexpr size_t al256(size_t x) { return (x + 255) & ~(size_t)255; }
constexpr size_t WS_CTL = 0, WS_ADA = 65536, WS_BIAS = WS_ADA + al256(2 * 33 * 3072 * 4), WS_PEB = WS_BIAS + al256(2 * NPD * 4), WS_WTIN = WS_PEB + 2048,
                 WS_WTOUT = WS_WTIN + (size_t)2 * NPD * 1024 * 2, WS_W1T = WS_WTOUT + (size_t)2 * 1024 * 1024 * 2, WS_A16 = WS_W1T + (size_t)4 * 128 * 2048 * 2,
                 WS_RSSP = WS_A16 + (size_t)SEQ * 1024 * 2, WS_X1 = WS_RSSP + (size_t)SEQ * 16 * 4, WS_PROJ = WS_X1 + (size_t)SEQ * 1024 * 4,
                 WS_Y16 = WS_PROJ + (size_t)15 * SEQ * 256 * 2, WS_ACT = WS_Y16 + (size_t)SEQ * 1024 * 2, WS_YD = WS_ACT + (size_t)SEQ * 768 * 2,
                 WS_CST = WS_YD + (size_t)SEQ * 256 * 4, WS_ACS = WS_CST + (size_t)128 * 32768 * 4, WS_CDEC = WS_ACS + (size_t)SEQ * 4 * 4, WS_Q16 = WS_CDEC + 2048,
                 WS_KS16 = WS_Q16 + (size_t)SEQ * 256 * 2, WS_VS16 = WS_KS16 + (size_t)SEQ * 64 * 2, WS_KW16 = WS_VS16 + (size_t)SEQ * 64 * 2,
                 WS_VW16 = WS_KW16 + (size_t)SEQ * 64 * 2, WS_GATES = WS_VW16 + (size_t)SEQ * 64 * 2, WS_KC = WS_GATES + (size_t)SEQ * 12 * 4,
                 WS_VC = WS_KC + 1024 * 64 * 4, WS_KCS = WS_VC + 1024 * 64 * 4, WS_VCS = WS_KCS + (size_t)2 * NB * 1024 * 64 * 4,
                 WS_PROJS = WS_VCS + (size_t)2 * NB * 1024 * 64 * 4, WS_YS = WS_PROJS + al256(NB * NPD * 4), WS_XS1 = WS_YS + NB * 1024 * 4, WS_GNX = WS_XS1 + NB * 1024 * 4, WS_NRG = WS_GNX + 4096, WS_VST16 = WS_NRG + 2 * NB * 1024, WS_VWT16 = WS_VST16 + (size_t)SEQ * 64 * 2, WS_KC16 = WS_VWT16 + (size_t)SEQ * 64 * 2,
                 WS_VCT16 = WS_KC16 + 1024 * 64 * 2, WS_HPV = WS_VCT16 + 1024 * 64 * 2, WS_W2T = WS_HPV + (size_t)128 * 32768 * 4, WS_PEBP = WS_W2T + 4 * 64 * 128 * 2, WS_HS16 = WS_PEBP + 4 * 8 * 128 * 4, WS_SELM = WS_HS16 + NB * 1024 * 2, WS_END = WS_SELM + 512 * 272 * 4;
constexpr int LDS_BYTES = 147456;
constexpr int MISC_OFF = 147200;

struct Args { const void* in[N_IN]; float* out; unsigned char* ws; int ph_lo, ph_hi; };

#define XB_TMO      128
#define XB_XCNT(j)  (256  + 64 * (j))
#define XB_XSUB(j)  (1280 + 64 * (j))
#define XB_XGEN(j)  (2304 + 64 * (j))
#define XB_TOP      3328
#define XB_TOPGEN   3392
#define XCD_BAR_WORDS 3456
#define XB_SPIN_CAP (1u << 18)
__device__ __forceinline__ unsigned xb_ld(unsigned* p)              { return __hip_atomic_load(p, __ATOMIC_RELAXED, __HIP_MEMORY_SCOPE_AGENT); }
__device__ __forceinline__ unsigned xb_add(unsigned* p, unsigned v) { return __hip_atomic_fetch_add(p, v, __ATOMIC_RELAXED, __HIP_MEMORY_SCOPE_AGENT); }
__device__ __forceinline__ unsigned xb_xcc_id() { return (unsigned)__builtin_amdgcn_s_getreg((3 << 11) | 20) & 0xFu; }
#define XB_SPIN(cond, bar) do { unsigned _sp = 0; while (cond) { __builtin_amdgcn_s_sleep(1); \
    if ((++_sp & 255u) == 0u) { if (xb_ld(&(bar)[XB_TMO])) break; if (_sp > XB_SPIN_CAP) { atomicAdd(&(bar)[XB_TMO], 1u); break; } } } } while (0)
struct XcdBarrier { unsigned* bar; unsigned x; volatile LAS unsigned* st; };
__device__ __forceinline__ XcdBarrier xcd_barrier_post(unsigned* bar, volatile LAS unsigned* st) {
    XcdBarrier b; b.bar = bar; b.x = xb_xcc_id(); b.st = st;
    if (threadIdx.x == 0) (void)xb_add(&bar[XB_XCNT(b.x)], 1u);
    return b;
}
__device__ __forceinline__ void xcd_barrier_complete(unsigned* bar, unsigned x, unsigned& nloc, unsigned& nx) {
    const unsigned G = gridDim.x * gridDim.y * gridDim.z;
    unsigned sum, cnt, mine, sp = 0u;
    for (;;) {
        sum = 0u; cnt = 0u; mine = 0u;
#pragma unroll
        for (unsigned j = 0; j < 16; ++j) { const unsigned c = xb_ld(&bar[XB_XCNT(j)]); sum += c; cnt += (c > 0u) ? 1u : 0u; mine = (j == x) ? c : mine; }
        if (sum == G) break;
        __builtin_amdgcn_s_sleep(1);
        if ((++sp & 255u) == 0u) { if (xb_ld(&bar[XB_TMO])) break; if (sp > XB_SPIN_CAP) { atomicAdd(&bar[XB_TMO], 1u); break; } }
    }
    nloc = mine > 0u ? mine : 1u; nx = cnt > 0u ? cnt : 1u;
}
__device__ __forceinline__ void xcd_barrier(const XcdBarrier& b) {
    asm volatile("s_waitcnt vmcnt(0)" ::: "memory");
    __syncthreads();
    if (threadIdx.x == 0) {
        unsigned* bar = b.bar;
        __builtin_amdgcn_s_waitcnt(0);
        unsigned nloc = b.st[0], nx = b.st[1];
        if (nloc == 0u) { xcd_barrier_complete(bar, b.x, nloc, nx); b.st[0] = nloc; b.st[1] = nx; }
        const unsigned old = xb_add(&bar[XB_XSUB(b.x)], 1u);
        const unsigned gen = old / nloc;
        if (old + 1u == (gen + 1u) * nloc) {
            __builtin_amdgcn_fence(__ATOMIC_RELEASE, "agent");
            asm volatile("s_waitcnt vmcnt(0)" ::: "memory");
            const unsigned og = xb_add(&bar[XB_TOP], 1u);
            const unsigned tg = og / nx;
            if (og + 1u == (tg + 1u) * nx) xb_add(&bar[XB_TOPGEN], 1u);
            else XB_SPIN(xb_ld(&bar[XB_TOPGEN]) == tg, bar);
            __builtin_amdgcn_fence(__ATOMIC_ACQUIRE, "agent");
            xb_add(&bar[XB_XGEN(b.x)], 1u);
            asm volatile("s_waitcnt vmcnt(0)" ::: "memory");
        } else {
            XB_SPIN(xb_ld(&bar[XB_XGEN(b.x)]) == gen, bar);
            __builtin_amdgcn_fence(__ATOMIC_ACQUIRE, "agent");
            asm volatile("s_waitcnt vmcnt(0)" ::: "memory");
        }
    }
    __syncthreads();
}

DI void lds_barrier() { asm volatile("s_waitcnt lgkmcnt(0)\n\ts_barrier" ::: "memory"); }
DI int ltid() { int t = threadIdx.x; asm volatile("" : "+v"(t)); return t; }
template <int CTRL> DI float dppf(float x) { return __builtin_bit_cast(float, __builtin_amdgcn_update_dpp(0, __builtin_bit_cast(int, x), CTRL, 0xF, 0xF, true)); }
template <int CTRL> DI int dppi(int x) { return __builtin_amdgcn_update_dpp(0, x, CTRL, 0xF, 0xF, true); }
constexpr int DPP_X1 = 0xB1, DPP_X2 = 0x4E, DPP_HM = 0x141, DPP_R8 = 0x128;
DI float sum16(float v) { v += dppf<DPP_X1>(v); v += dppf<DPP_X2>(v); v += dppf<DPP_HM>(v); v += dppf<DPP_R8>(v); return v; }
DI float max16(float v) { v = fmaxf(v, dppf<DPP_X1>(v)); v = fmaxf(v, dppf<DPP_X2>(v)); v = fmaxf(v, dppf<DPP_HM>(v)); v = fmaxf(v, dppf<DPP_R8>(v)); return v; }
DI float wsum(float v) { v = sum16(v); v += __shfl_xor(v, 16); v += __shfl_xor(v, 32); return v; }
DI float wmaxf(float v) { v = max16(v); v = fmaxf(v, __shfl_xor(v, 16)); v = fmaxf(v, __shfl_xor(v, 32)); return v; }
DI float sigmoidf_(float x) { return 1.f / (1.f + __expf(-x)); }
DI float siluf_(float x) { return x / (1.f + __expf(-x)); }
DI float softplusf_(float x) { return fmaxf(x, 0.f) + log1pf(__expf(-fabsf(x))); }
DI f16x8 ld_h8(const f16* p) { return *(const f16x8*)p; }
DI f16x8 cvt_h8(const float* p) { const f32x4 a = *(const f32x4*)p, b = *(const f32x4*)(p + 4); f16x8 r; r[0] = (f16)a[0]; r[1] = (f16)a[1]; r[2] = (f16)a[2]; r[3] = (f16)a[3]; r[4] = (f16)b[0]; r[5] = (f16)b[1]; r[6] = (f16)b[2]; r[7] = (f16)b[3]; return r; }
DI int vt_key(int pos) { const int p = pos & 31, qq = p >> 3, j = p & 7; return (pos & ~31) + (j < 4 ? 4 * qq + j : 12 + 4 * qq + j); }
DI int vt_pos(int key) { const int k = key & 31; return (key & ~31) + (k < 16 ? 8 * (k >> 2) + (k & 3) : 8 * ((k - 16) >> 2) + 4 + (k & 3)); }
DI int src_col(int n) { return n < 2048 ? n : (n < 3456 ? n + 4 : (n < 3460 ? n - 1408 : (n < 3472 ? n + 256 : (n < 3584 ? -1 : n - 124)))); }
DI int dst_col(int s) { return s < 2048 ? s : (s < 2052 ? s + 1408 : (s < 3460 ? s - 4 : (s < 3716 ? s + 124 : s - 256))); }

DI void edge_publish(unsigned* ctr) {
    asm volatile("s_waitcnt vmcnt(0)" ::: "memory"); __syncthreads();
    if (threadIdx.x == 0) { __builtin_amdgcn_fence(__ATOMIC_RELEASE, "agent"); asm volatile("s_waitcnt vmcnt(0)" ::: "memory"); __hip_atomic_fetch_add(ctr, 1u, __ATOMIC_RELAXED, __HIP_MEMORY_SCOPE_AGENT); }
}
DI void edge_wait(unsigned* ctr, unsigned need) {
    if (threadIdx.x == 0) { unsigned sp = 0;
        while (__hip_atomic_load(ctr, __ATOMIC_RELAXED, __HIP_MEMORY_SCOPE_AGENT) < need) { __builtin_amdgcn_s_sleep(8); if (++sp > (1u << 22)) break; }
        __builtin_amdgcn_fence(__ATOMIC_ACQUIRE, "agent"); asm volatile("s_waitcnt vmcnt(0)" ::: "memory"); }
    __syncthreads();
}
namespace pg8 {
constexpr int BM = 256, BK = 64, HALF = 128, HTB = HALF * BK * 2, STAGE_BYTES = 8 * HTB, NXCD = 8, WGM = 8;
DI int lds_byte(int r, int c) { const int st = (r >> 4) * 2 + (c >> 5), rr = r & 15, cc = c & 31, ob = rr * 64 + cc * 2; return st * 1024 + (ob ^ (((ob >> 9) & 1) << 5)); }
DI void stage_rc(int b, int& R, int& C) { const int st = b / 1024, sb = b % 1024, swz = sb ^ (((sb >> 9) & 1) << 5); R = (st >> 1) * 16 + swz / 64; C = (st & 1) * 32 + (swz % 64) / 2; }
DI int perm32(int rho) { const int n = rho >> 4, i = rho & 15; return 8 * (i >> 2) + 4 * n + (i & 3); }
struct Unit { int pm, pn; };
struct Gemm { const f16* A; const f16* Bt; int M, N, K; };
struct StaticOrder {
    int nM, nN, nwg, G, c;
    DI void init(int M, int N, int G_, int c_) { nM = M / BM; nN = N / BM; nwg = nM * nN; G = G_; c = c_; }
    DI bool next(int i, Unit& u) const {
        const long L = (long)i * G + c; if (L >= nwg) return false;
        int wgid = (int)L; { const int q = nwg / NXCD, r = nwg % NXCD, xcd = wgid % NXCD, off = wgid / NXCD; wgid = (xcd < r ? xcd * (q + 1) : r * (q + 1) + (xcd - r) * q) + off; }
        const int nig = WGM * nN, gid = wgid / nig, fm = gid * WGM, gsz = (nM - fm) < WGM ? (nM - fm) : WGM;
        u.pm = fm + ((wgid % nig) % gsz); u.pn = (wgid % nig) / gsz; return true;
    }
    DI void a_ready(const Unit&) const {}
    DI void done(const Unit&) const {}
};
template <class Epi, class Sched>
DI void gemm_phase(LAS unsigned char* lds, const Gemm g, const Sched& S, const Epi& E) {
    const int tid = ltid(), wid = __builtin_amdgcn_readfirstlane(tid >> 6), lane = tid & 63, wr = wid >> 2, wc = wid & 3, fr = lane & 15, fq = lane >> 4;
    const int K = g.K, nt = K / BK;
    unsigned voffA[2], voffB[2];
#pragma unroll
    for (int i = 0; i < 2; ++i) { int R, C; stage_rc(tid * 16 + i * 8192, R, C); const int Rb = Epi::PERM ? ((R & ~31) + perm32(R & 31)) : R;
        voffA[i] = (unsigned)(R * K + C) * 2u; voffB[i] = (unsigned)(Rb * K + C) * 2u; }
    const size_t kstep = (size_t)(BK * 2);
    const size_t hstep = (size_t)HALF * K * 2;
    const size_t tstep = 2 * hstep;
    const unsigned ldsw = (unsigned)wid * 1024u;
    const int aoff = lds_byte(wr * 64 + fr, fq * 8), boff = lds_byte(wc * 32 + fr, fq * 8);
#define PG8_SA(b, h) (((b) * 2 + (h)) * HTB)
#define PG8_SB(b, h) ((4 + (b) * 2 + (h)) * HTB)
#define PG8_STAGE(bufoff, gbase, voff) do { _Pragma("unroll") for (int _i = 0; _i < 2; ++_i) \
        __builtin_amdgcn_global_load_lds((const unsigned*)((const char*)(gbase) + (voff)[_i]), (LAS unsigned*)(lds + (bufoff) + ldsw + _i * 8192), 16, 0, 0); } while (0)
#define PG8_LDA(dst, b, h) do { _Pragma("unroll") for (int m = 0; m < 4; ++m) _Pragma("unroll") for (int k = 0; k < 2; ++k) dst[m][k] = *(const LAS f16x8*)(lds + PG8_SA(b, h) + aoff + m * 2048 + k * 1024); } while (0)
#define PG8_LDB(dst, b, h) do { _Pragma("unroll") for (int n = 0; n < 2; ++n) _Pragma("unroll") for (int k = 0; k < 2; ++k) dst[n][k] = *(const LAS f16x8*)(lds + PG8_SB(b, h) + boff + n * 2048 + k * 1024); } while (0)
#define PG8_MMA(ai, bj, At, Bt) do { __builtin_amdgcn_s_setprio(1); _Pragma("unroll") for (int m = 0; m < 4; ++m) _Pragma("unroll") for (int n = 0; n < 2; ++n) _Pragma("unroll") for (int k = 0; k < 2; ++k) \
        acc[ai][bj][m][n] = __builtin_amdgcn_mfma_f32_16x16x32_f16(Bt[n][k], At[m][k], acc[ai][bj][m][n], 0, 0, 0); __builtin_amdgcn_s_setprio(0); } while (0)
#define PG8_WAIT_V(n) asm volatile("s_waitcnt vmcnt(" #n ")" ::: "memory")
#define PG8_WAIT_L(n) asm volatile("s_waitcnt lgkmcnt(" #n ")" ::: "memory")
#define PG8_BAR __builtin_amdgcn_s_barrier()
#define PG8_SCHED __builtin_amdgcn_sched_barrier(0)
    Unit cur, nxt; int ui = 0;
    if (!S.next(0, cur)) return;
    f32x4 acc[2][2][4][2];
#pragma unroll
    for (int a = 0; a < 2; ++a)
#pragma unroll
        for (int b = 0; b < 2; ++b)
#pragma unroll
            for (int m = 0; m < 4; ++m)
#pragma unroll
                for (int n = 0; n < 2; ++n) acc[a][b][m][n] = (f32x4){0.f, 0.f, 0.f, 0.f};
    f16x8 At[4][2], B0[2][2], B1[2][2];
    const char* cA = (const char*)g.A + (size_t)cur.pm * tstep; const char* cB = (const char*)g.Bt + (size_t)cur.pn * tstep;
    S.a_ready(cur);
    PG8_STAGE(PG8_SB(0, 0), cB, voffB); PG8_STAGE(PG8_SA(0, 0), cA, voffA); PG8_STAGE(PG8_SB(0, 1), cB + hstep, voffB); PG8_STAGE(PG8_SA(0, 1), cA + hstep, voffA);
    if (wr == 1) PG8_BAR;
    PG8_WAIT_V(4); PG8_BAR;
    PG8_STAGE(PG8_SB(1, 0), cB + kstep, voffB); PG8_STAGE(PG8_SA(1, 0), cA + kstep, voffA); PG8_STAGE(PG8_SB(1, 1), cB + hstep + kstep, voffB);
    PG8_WAIT_V(6); PG8_BAR;
    for (;;) {
        const bool has_next = S.next(ui + 1, nxt);
        const char* nA = has_next ? (const char*)g.A + (size_t)nxt.pm * tstep : cA; const char* nB = has_next ? (const char*)g.Bt + (size_t)nxt.pn * tstep : cB;
        for (int t = 0; t < nt; t += 2) {
            const bool last = (t == nt - 2);
            const char* a1 = cA + (size_t)(t + 1) * kstep;
            const char* a2 = last ? nA : cA + (size_t)(t + 2) * kstep; const char* b2 = last ? nB : cB + (size_t)(t + 2) * kstep;
            const char* a3 = a2 + kstep; const char* b3 = b2 + kstep;
            if (last && has_next) S.a_ready(nxt);
            PG8_LDB(B0, 0, 0); PG8_SCHED; PG8_LDA(At, 0, 0); PG8_STAGE(PG8_SA(1, 1), a1 + hstep, voffA);
            PG8_WAIT_L(8); PG8_BAR; PG8_WAIT_L(0); PG8_MMA(0, 0, At, B0); PG8_BAR; PG8_SCHED;
            PG8_LDB(B1, 0, 1); PG8_STAGE(PG8_SB(0, 0), b2, voffB);
            PG8_BAR; PG8_WAIT_L(0); PG8_MMA(0, 1, At, B1); PG8_BAR;
            PG8_LDA(At, 0, 1); PG8_STAGE(PG8_SA(0, 0), a2, voffA);
            PG8_BAR; PG8_WAIT_L(0); PG8_MMA(1, 0, At, B0); PG8_BAR; PG8_SCHED;
            PG8_STAGE(PG8_SB(0, 1), b2 + hstep, voffB);
            PG8_WAIT_V(6); PG8_BAR; PG8_MMA(1, 1, At, B1); PG8_BAR;
            PG8_LDB(B0, 1, 0); PG8_SCHED; PG8_LDA(At, 1, 0); PG8_STAGE(PG8_SA(0, 1), a2 + hstep, voffA);
            PG8_WAIT_L(8); PG8_BAR; PG8_WAIT_L(0); PG8_MMA(0, 0, At, B0); PG8_BAR; PG8_SCHED;
            PG8_LDB(B1, 1, 1); PG8_STAGE(PG8_SB(1, 0), b3, voffB);
            PG8_BAR; PG8_WAIT_L(0); PG8_MMA(0, 1, At, B1); PG8_BAR;
            PG8_LDA(At, 1, 1); PG8_STAGE(PG8_SA(1, 0), a3, voffA);
            PG8_BAR; PG8_WAIT_L(0); PG8_MMA(1, 0, At, B0); PG8_BAR; PG8_SCHED;
            PG8_STAGE(PG8_SB(1, 1), b3 + hstep, voffB);
            PG8_WAIT_V(6); PG8_BAR; PG8_MMA(1, 1, At, B1); PG8_BAR;
        }
        E(acc, cur, wr, wc, fr, fq);
        if (!has_next) break;
#pragma unroll
        for (int a = 0; a < 2; ++a)
#pragma unroll
            for (int b = 0; b < 2; ++b)
#pragma unroll
                for (int m = 0; m < 4; ++m)
#pragma unroll
                    for (int n = 0; n < 2; ++n) acc[a][b][m][n] = (f32x4){0.f, 0.f, 0.f, 0.f};
        cur = nxt; cA = nA; cB = nB; ++ui;
    }
    PG8_WAIT_V(0);
    if (wr == 0) PG8_BAR;
    PG8_BAR;
#undef PG8_SA
#undef PG8_SB
#undef PG8_STAGE
#undef PG8_LDA
#undef PG8_LDB
#undef PG8_MMA
#undef PG8_WAIT_V
#undef PG8_WAIT_L
#undef PG8_BAR
#undef PG8_SCHED
}
}

struct EpiIn {
    static constexpr bool PERM = true;
    f16* proj; const float* rssp; const float* bias; float* kvout;
    DI void operator()(const f32x4 (&acc)[2][2][4][2], const pg8::Unit& u, int wr, int wc, int fr, int fq) const {
        const int row0 = u.pm * 256 + wr * 64 + fr, colt = wc * 32 + 8 * fq;
        f32x4 bv[2][2];
#pragma unroll
        for (int bj = 0; bj < 2; ++bj)
#pragma unroll
            for (int n = 0; n < 2; ++n) bv[bj][n] = *(const f32x4*)(bias + u.pn * 256 + colt + bj * 128 + 4 * n);
        f16* pt = proj + (size_t)u.pn * SEQ * 256;
#pragma unroll
        for (int ai = 0; ai < 2; ++ai)
#pragma unroll
            for (int m = 0; m < 4; ++m) {
                const int row = row0 + ai * 128 + m * 16;
                const f32x4* rp = (const f32x4*)(rssp + (size_t)row * 16);
                const f32x4 s0 = rp[0], s1 = rp[1], s2 = rp[2], s3 = rp[3];
                const float ss = ((s0[0] + s0[1]) + (s0[2] + s0[3])) + ((s1[0] + s1[1]) + (s1[2] + s1[3])) + ((s2[0] + s2[1]) + (s2[2] + s2[3])) + ((s3[0] + s3[1]) + (s3[2] + s3[3]));
                const float r = rsqrtf(ss * (1.f / 1024.f) + EPS);
#pragma unroll
                for (int bj = 0; bj < 2; ++bj) {
                    const f32x4 v0 = acc[ai][bj][m][0] * r + bv[bj][0], v1 = acc[ai][bj][m][1] * r + bv[bj][1];
                    f16x8 h; h[0] = (f16)v0[0]; h[1] = (f16)v0[1]; h[2] = (f16)v0[2]; h[3] = (f16)v0[3]; h[4] = (f16)v1[0]; h[5] = (f16)v1[1]; h[6] = (f16)v1[2]; h[7] = (f16)v1[3];
                    *(f16x8*)(pt + (size_t)row * 256 + colt + bj * 128) = h;
                    if (u.pn == 12) { float* kp = kvout + (size_t)row * 256 + colt + bj * 128; *(f32x4*)kp = v0; *(f32x4*)(kp + 4) = v1; }
                }
            }
    }
};
struct EpiOut {
    static constexpr bool PERM = false;
    const float* xin; float* xout; const float* gate; f16* a16; const float* gnext; float* rssp;
    DI void operator()(const f32x4 (&acc)[2][2][4][2], const pg8::Unit& u, int wr, int wc, int fr, int fq) const {
        const int row0 = u.pm * 256 + wr * 64 + fr, col0 = u.pn * 256 + wc * 32 + 4 * fq;
        float ss[2][4];
#pragma unroll
        for (int ai = 0; ai < 2; ++ai)
#pragma unroll
            for (int m = 0; m < 4; ++m) ss[ai][m] = 0.f;
#pragma unroll
        for (int bj = 0; bj < 2; ++bj)
#pragma unroll
            for (int n = 0; n < 2; ++n) {
                const int col = col0 + bj * 128 + n * 16;
                const f32x4 gv = *(const f32x4*)(gate + col); f32x4 gn = (f32x4){0.f, 0.f, 0.f, 0.f}; if (a16) gn = *(const f32x4*)(gnext + col);
#pragma unroll
                for (int ai = 0; ai < 2; ++ai)
#pragma unroll
                    for (int m = 0; m < 4; ++m) {
                        const int row = row0 + ai * 128 + m * 16;
                        const f32x4 xv = *(const f32x4*)(xin + (size_t)row * 1024 + col);
                        const f32x4 o = xv + gv * acc[ai][bj][m][n];
                        *(f32x4*)(xout + (size_t)row * 1024 + col) = o;
                        ss[ai][m] += (o[0] * o[0] + o[1] * o[1]) + (o[2] * o[2] + o[3] * o[3]);
                        if (a16) { f16x4 h; h[0] = (f16)(o[0] * gn[0]); h[1] = (f16)(o[1] * gn[1]); h[2] = (f16)(o[2] * gn[2]); h[3] = (f16)(o[3] * gn[3]);
                            *(f16x4*)(a16 + (size_t)row * 1024 + col) = h; }
                    }
                asm volatile("" ::: "memory");
            }
        if (a16) {
#pragma unroll
            for (int ai = 0; ai < 2; ++ai)
#pragma unroll
                for (int m = 0; m < 4; ++m) { float v = ss[ai][m]; v += __shfl_xor(v, 16); v += __shfl_xor(v, 32);
                    if (fq == 0) rssp[(size_t)(row0 + ai * 128 + m * 16) * 16 + u.pn * 4 + wc] = v; }
        }
    }
};

template <int MP  , class AFn, class OFn>
DI void skinny_item(LAS unsigned char* lds, const float* W, int ldw, int n0, int ncols, int M, AFn afn, OFn ofn) {
    const int tid = ltid(), wave = tid >> 6, lane = tid & 63;
    LAS float* As = (LAS float*)lds;
    float acc[MP];
#pragma unroll
    for (int m = 0; m < MP; ++m) acc[m] = 0.f;
    for (int kc = 0; kc < 1024; kc += 512) {
        __syncthreads();
#pragma unroll 4
        for (int m = 0; m < MP; ++m) As[tid * 36 + m] = (m < M) ? afn(m, kc + tid) : 0.f;
        __syncthreads();
        const int kb = wave * 64;
#pragma unroll 8
        for (int kk = 0; kk < 64; ++kk) {
            const float w = (lane < ncols) ? W[(size_t)(kc + kb + kk) * ldw + n0 + lane] : 0.f;
            const float av = As[(kb + kk) * 36 + lane];
#pragma unroll
            for (int m = 0; m < MP; ++m) acc[m] += __builtin_bit_cast(float, __builtin_amdgcn_readlane(__builtin_bit_cast(int, av), m)) * w;
        }
    }
    __syncthreads();
    LAS float* R = (LAS float*)lds;
#pragma unroll
    for (int m = 0; m < MP; ++m) R[(wave * 36 + m) * 64 + lane] = acc[m];
    __syncthreads();
    for (int idx = tid; idx < M * 64; idx += 512) { const int m = idx >> 6, c = idx & 63; float s = 0.f;
#pragma unroll
        for (int w = 0; w < 8; ++w) s += R[(w * 36 + m) * 64 + c];
        if (c < ncols) ofn(m, n0 + c, s); }
    __syncthreads();
}

template <bool F32> struct Raw16 { f32x4 f[4]; f16x8 hv[2];
    DI void ld(const void* p) { if (F32) {
#pragma unroll
            for (int i = 0; i < 4; ++i) f[i] = *(const f32x4*)((const float*)p + 4 * i); } else { hv[0] = *(const f16x8*)p; hv[1] = *(const f16x8*)((const f16*)p + 8); } }
    DI f16x8 get(int i) const { if (F32) { const f32x4 a = f[2 * i], b = f[2 * i + 1]; f16x8 r; r[0] = (f16)a[0]; r[1] = (f16)a[1]; r[2] = (f16)a[2]; r[3] = (f16)a[3]; r[4] = (f16)b[0]; r[5] = (f16)b[1]; r[6] = (f16)b[2]; r[7] = (f16)b[3]; return r; } return hv[i]; } };
template <bool SRC_F32, class ChunkFn>
DI void compress_item(LAS unsigned char* lds, ChunkFn chunkp  , int c0, const f16* w1t, const float* peb, const f16* w2t  , const float* b2, const float* kg, float* out, f16* out16, f16* outT16) {
    typedef typename std::conditional<SRC_F32, float, f16>::type T;
    const int tid = ltid(), wave = tid >> 6, lane = tid & 63, wm = wave >> 2, wq = wave & 3, r = lane & 31, h = lane >> 5;
    LAS f16* As = (LAS f16*)lds;
    LAS f16* Bs = (LAS f16*)(lds + 2 * 18432);
    f32x16 acc[2][2];
#pragma unroll
    for (int a = 0; a < 2; ++a)
#pragma unroll
        for (int b = 0; b < 2; ++b)
#pragma unroll
            for (int i = 0; i < 16; ++i) acc[a][b][i] = 0.f;
    const int am = tid >> 2, aseg = tid & 3, bn = tid >> 1, bseg = tid & 1;
    int ch = c0 + am; ch = ch < 1023 ? ch : 1023;
    const T* asrc = (const T*)chunkp(ch) + aseg * 16;
    const f16* bsrc = w1t + (size_t)(bn & 127) * 2048 + (size_t)(bn >> 7) * 1024 + bseg * 32;
    Raw16<SRC_F32> ra[3]; f16x8 rb[3][4];
#pragma unroll
    for (int i = 0; i < 3; ++i) { ra[i].ld(asrc + i * 256);
#pragma unroll
        for (int j = 0; j < 4; ++j) rb[i][j] = ld_h8(bsrc + i * 64 + 8 * j); }
    __syncthreads();
    *(LAS f16x8*)(As + am * 72 + aseg * 16) = ra[0].get(0); *(LAS f16x8*)(As + am * 72 + aseg * 16 + 8) = ra[0].get(1);
#pragma unroll
    for (int i = 0; i < 4; ++i) *(LAS f16x8*)(Bs + bn * 72 + bseg * 32 + 8 * i) = rb[0][i];
    ra[0].ld(asrc + 3 * 256);
#pragma unroll
    for (int i = 0; i < 4; ++i) rb[0][i] = ld_h8(bsrc + 3 * 64 + 8 * i);
    lds_barrier();
#pragma unroll
    for (int kb = 0; kb < 16; ++kb) {
        const int cur = kb & 1;
        const LAS f16* Ac = As + cur * 9216 + (64 * wm + r) * 72 + 8 * h; const LAS f16* Bc = Bs + cur * 18432 + (64 * wq + r) * 72 + 8 * h;
#pragma unroll
        for (int ks = 0; ks < 4; ++ks) {
            const f16x8 a0 = *(const LAS f16x8*)(Ac + 16 * ks), a1 = *(const LAS f16x8*)(Ac + 32 * 72 + 16 * ks), b0 = *(const LAS f16x8*)(Bc + 16 * ks), b1 = *(const LAS f16x8*)(Bc + 32 * 72 + 16 * ks);
            acc[0][0] = __builtin_amdgcn_mfma_f32_32x32x16_f16(a0, b0, acc[0][0], 0, 0, 0); acc[0][1] = __builtin_amdgcn_mfma_f32_32x32x16_f16(a0, b1, acc[0][1], 0, 0, 0);
            acc[1][0] = __builtin_amdgcn_mfma_f32_32x32x16_f16(a1, b0, acc[1][0], 0, 0, 0); acc[1][1] = __builtin_amdgcn_mfma_f32_32x32x16_f16(a1, b1, acc[1][1], 0, 0, 0);
        }
        if (kb + 1 < 16) { const int nx = cur ^ 1, sl = (kb + 1) % 3;
            *(LAS f16x8*)(As + nx * 9216 + am * 72 + aseg * 16) = ra[sl].get(0); *(LAS f16x8*)(As + nx * 9216 + am * 72 + aseg * 16 + 8) = ra[sl].get(1);
#pragma unroll
            for (int i = 0; i < 4; ++i) *(LAS f16x8*)(Bs + nx * 18432 + bn * 72 + bseg * 32 + 8 * i) = rb[sl][i];
            if (kb + 4 < 16) { ra[sl].ld(asrc + (kb + 4) * 256);
#pragma unroll
                for (int i = 0; i < 4; ++i) rb[sl][i] = ld_h8(bsrc + (kb + 4) * 64 + 8 * i); } }
        lds_barrier();
    }
    LAS float* SL = (LAS float*)lds;
    LAS f16* HS = (LAS f16*)(lds + 65536);
    if (wq >= 2) {
#pragma unroll
        for (int a = 0; a < 2; ++a)
#pragma unroll
            for (int b = 0; b < 2; ++b)
#pragma unroll
                for (int i = 0; i < 16; ++i) SL[(64 * wm + 32 * a + (i & 3) + 8 * (i >> 2) + 4 * h) * 128 + 64 * (wq - 2) + 32 * b + r] = acc[a][b][i];
    }
    __syncthreads();
    if (wq < 2) {
#pragma unroll
        for (int a = 0; a < 2; ++a)
#pragma unroll
            for (int b = 0; b < 2; ++b) { const int f = 64 * wq + 32 * b + r; float pb = 0.f;
#pragma unroll
                for (int p8 = 0; p8 < 8; ++p8) pb += peb[p8 * 128 + f];
#pragma unroll
                for (int i = 0; i < 16; ++i) { const int m = 64 * wm + 32 * a + (i & 3) + 8 * (i >> 2) + 4 * h; const float sv = m < 127 ? SL[(m + 1) * 128 + f] : 0.f;
                    HS[m * 136 + f] = (f16)siluf_(acc[a][b][i] + sv + pb); } }
    }
    __syncthreads();
    {
        const int fr = lane & 15, q = lane >> 4;
        f32x4 o[4];
#pragma unroll
        for (int et = 0; et < 4; ++et) o[et] = (f32x4){0.f, 0.f, 0.f, 0.f};
#pragma unroll
        for (int ks = 0; ks < 4; ++ks) { const f16x8 av = *(const LAS f16x8*)(HS + (16 * wave + fr) * 136 + 32 * ks + 8 * q);
#pragma unroll
            for (int et = 0; et < 4; ++et) o[et] = __builtin_amdgcn_mfma_f32_16x16x32_f16(av, ld_h8(w2t + (size_t)(16 * et + fr) * 128 + 32 * ks + 8 * q), o[et], 0, 0, 0); }
        float bb[4], gg[4];
#pragma unroll
        for (int et = 0; et < 4; ++et) { bb[et] = b2[16 * et + fr]; gg[et] = kg ? kg[16 * et + fr] : 1.f; }
#pragma unroll
        for (int j = 0; j < 4; ++j) {
            const int row = 16 * wave + 4 * q + j, blk = c0 + row; float v[4], ss = 0.f;
#pragma unroll
            for (int et = 0; et < 4; ++et) { v[et] = o[et][j] + bb[et]; ss += v[et] * v[et]; }
            if (kg) { ss += __shfl_xor(ss, 1); ss += __shfl_xor(ss, 2); ss += __shfl_xor(ss, 4); ss += __shfl_xor(ss, 8); const float rn = rsqrtf(ss * (1.f / 64.f) + EPS);
#pragma unroll
                for (int et = 0; et < 4; ++et) v[et] = v[et] * rn * gg[et]; }
            const bool okrow = row < 127 && blk < 1023, wr16 = row < 127 && blk < 1024;
#pragma unroll
            for (int et = 0; et < 4; ++et) { const float x = okrow ? v[et] : 0.f; const int e = 16 * et + fr;
                if (out && okrow) out[(size_t)blk * 64 + e] = x;
                if (out16 && wr16) out16[(size_t)blk * 64 + e] = (f16)x;
                if (outT16 && wr16) outT16[(size_t)e * 1024 + vt_pos(blk)] = (f16)x; }
        }
    }
    __syncthreads();
}

struct PromptKV {
    const f16 *ks, *vs, *kw, *vw;
    DI void krow_sel(int pos, float (&k)[64]) const { const f16* p = ks + (size_t)pos * 64;
#pragma unroll
        for (int i = 0; i < 8; ++i) { const f16x8 v = ld_h8(p + i * 8);
#pragma unroll
            for (int j = 0; j < 8; ++j) k[i * 8 + j] = (float)v[j]; } }
    DI float v_sel(int pos, int d) const { return (float)vs[(size_t)pos * 64 + d]; }
    DI void krow_win(int pos, float (&k)[64]) const { const f16* p = kw + (size_t)pos * 64;
#pragma unroll
        for (int i = 0; i < 8; ++i) { const f16x8 v = ld_h8(p + i * 8);
#pragma unroll
            for (int j = 0; j < 8; ++j) k[i * 8 + j] = (float)v[j]; } }
    DI float v_win(int pos, int d) const { return (float)vw[(size_t)pos * 64 + d]; }
};
struct SampleKV {
    const float* ckv; const int* pt; const float* cwin; const float* nks; const float* nvs; const float* nkw; const float* nvw;
    DI const float* prow(int pos, int slot) const { return ckv + ((size_t)pt[pos >> 7] * 128 + (pos & 127)) * 256 + slot * 64; }
    DI void ld64(const float* p, float (&k)[64]) const {
#pragma unroll
        for (int i = 0; i < 16; ++i) { const f32x4 v = *(const f32x4*)(p + i * 4); k[i * 4] = v[0]; k[i * 4 + 1] = v[1]; k[i * 4 + 2] = v[2]; k[i * 4 + 3] = v[3]; } }
    DI void krow_sel(int pos, float (&k)[64]) const { ld64(pos < PAST ? prow(pos, 2) : nks, k); }
    DI float v_sel(int pos, int d) const { return pos < PAST ? prow(pos, 3)[d] : nvs[d]; }
    DI void krow_win(int pos, float (&k)[64]) const { ld64(pos < PAST ? cwin + (size_t)(pos - (PAST - 512)) * 128 : nkw, k); }
    DI float v_win(int pos, int d) const { return pos < PAST ? cwin[(size_t)(pos - (PAST - 512)) * 128 + 64 + d] : nvw[d]; }
};
template <class KV>
DI void nsa_token(LAS float* wl, int qpos, const float* KC, const float* VC, const KV& kv, const float* gates  , float (&o)[4]) {
    const int lane = ltid() & 63;
    LAS float* sc = wl; LAS float* qs = wl + 4096; LAS int* sel = (LAS int*)(wl + 4096 + 256);
    const int cur = qpos >> 6;
    const int ncv = qpos >= 31 ? ((qpos - 31) >> 4) + 1 : 0;
    float oc[4] = {0.f, 0.f, 0.f, 0.f}, os[4] = {0.f, 0.f, 0.f, 0.f}, ow[4] = {0.f, 0.f, 0.f, 0.f};
    {
        float mx[4] = {-3e38f, -3e38f, -3e38f, -3e38f};
        for (int c = lane; c < ncv; c += 64) {
            asm volatile("" ::: "memory");
            float s[4] = {0.f, 0.f, 0.f, 0.f}; const float* kp = KC + (size_t)c * 64;
#pragma unroll
            for (int d4 = 0; d4 < 16; ++d4) { const f32x4 kvv = *(const f32x4*)(kp + d4 * 4);
#pragma unroll
                for (int j = 0; j < 4; ++j) { const f32x4 q = *(const LAS f32x4*)(qs + (d4 * 4 + j) * 4); s[0] += q[0] * kvv[j]; s[1] += q[1] * kvv[j]; s[2] += q[2] * kvv[j]; s[3] += q[3] * kvv[j]; } }
#pragma unroll
            for (int hh = 0; hh < 4; ++hh) { s[hh] *= 0.125f; sc[hh * 1024 + c] = s[hh]; mx[hh] = fmaxf(mx[hh], s[hh]); }
        }
        float inv[4];
#pragma unroll
        for (int hh = 0; hh < 4; ++hh) { mx[hh] = wmaxf(mx[hh]); float sm = 0.f; for (int c = lane; c < ncv; c += 64) { const float e = __expf(sc[hh * 1024 + c] - mx[hh]); sc[hh * 1024 + c] = e; sm += e; } sm = wsum(sm); inv[hh] = ncv > 0 ? 1.f / sm : 0.f; }
        for (int c = lane; c < ncv; c += 64) {
#pragma unroll
            for (int hh = 0; hh < 4; ++hh) sc[hh * 1024 + c] *= inv[hh]; }
        __builtin_amdgcn_wave_barrier();
        for (int c = 0; c < ncv; ++c) { const float v = VC[(size_t)c * 64 + lane];
#pragma unroll
            for (int hh = 0; hh < 4; ++hh) oc[hh] += sc[hh * 1024 + c] * v; }
    }
    const int nsel = (cur + 1) < 16 ? (cur + 1) : 16;
    {
        float scv[5];
#pragma unroll
        for (int i = 0; i < 5; ++i) {
            const int j = lane + 64 * i; float v = -3e38f;
            if (j <= cur) {
                if (j == 0 || j == cur || j == cur - 1) v = 3e38f;
                else { float a = 0.f;
#pragma unroll
                    for (int o5 = -1; o5 < 4; ++o5) { const int c = 4 * j + o5; if (c >= 0 && c < ncv) { const float p = (sc[c] + sc[1024 + c]) + (sc[2048 + c] + sc[3072 + c]); a += (o5 == -1 || o5 == 3) ? 0.5f * p : p; } }
                    v = a; }
            }
            scv[i] = v;
        }
        for (int k = 0; k < nsel; ++k) {
            float bv = scv[0]; int bi = lane;
#pragma unroll
            for (int i = 1; i < 5; ++i) if (scv[i] > bv) { bv = scv[i]; bi = lane + 64 * i; }
#pragma unroll
            for (int off = 32; off > 0; off >>= 1) { const float ov = __shfl_xor(bv, off); const int oi = __shfl_xor(bi, off); if (ov > bv || (ov == bv && oi < bi)) { bv = ov; bi = oi; } }
            if (lane == 0) sel[k] = bi;
#pragma unroll
            for (int i = 0; i < 5; ++i) if (lane + 64 * i == bi) scv[i] = -3e38f;
        }
        __builtin_amdgcn_wave_barrier();
    }
    {
        float mx[4] = {-3e38f, -3e38f, -3e38f, -3e38f};
        for (int k = 0; k < nsel; ++k) {
            asm volatile("" ::: "memory");
            const int pos = sel[k] * 64 + lane; float s[4] = {-1e30f, -1e30f, -1e30f, -1e30f};
            if (pos <= qpos) { float kr[64]; kv.krow_sel(pos, kr); s[0] = s[1] = s[2] = s[3] = 0.f;
#pragma unroll
                for (int d = 0; d < 64; ++d) { const f32x4 q = *(const LAS f32x4*)(qs + d * 4); s[0] += q[0] * kr[d]; s[1] += q[1] * kr[d]; s[2] += q[2] * kr[d]; s[3] += q[3] * kr[d]; }
#pragma unroll
                for (int hh = 0; hh < 4; ++hh) s[hh] *= 0.125f; }
#pragma unroll
            for (int hh = 0; hh < 4; ++hh) { sc[hh * 1024 + k * 64 + lane] = s[hh]; mx[hh] = fmaxf(mx[hh], s[hh]); }
        }
        float inv[4];
#pragma unroll
        for (int hh = 0; hh < 4; ++hh) { mx[hh] = wmaxf(mx[hh]); float sm = 0.f; for (int k = 0; k < nsel; ++k) { const float sv = sc[hh * 1024 + k * 64 + lane]; const float e = sv > -1e29f ? __expf(sv - mx[hh]) : 0.f; sc[hh * 1024 + k * 64 + lane] = e; sm += e; } sm = wsum(sm); inv[hh] = 1.f / sm; }
        __builtin_amdgcn_wave_barrier();
        for (int k = 0; k < nsel; ++k) { const int p0 = sel[k] * 64; int nk = qpos - p0 + 1; nk = nk > 64 ? 64 : nk;
            for (int kk = 0; kk < nk; ++kk) { const float v = kv.v_sel(p0 + kk, lane);
#pragma unroll
                for (int hh = 0; hh < 4; ++hh) os[hh] += sc[hh * 1024 + k * 64 + kk] * v; } }
#pragma unroll
        for (int hh = 0; hh < 4; ++hh) os[hh] *= inv[hh];
        __builtin_amdgcn_wave_barrier();
    }
    {
        const int lo = qpos - 512 > 0 ? qpos - 512 : 0, nw = qpos - lo + 1;
        float mx[4] = {-3e38f, -3e38f, -3e38f, -3e38f};
        for (int i = lane; i < nw; i += 64) { asm volatile("" ::: "memory"); float kr[64]; kv.krow_win(lo + i, kr); float s[4] = {0.f, 0.f, 0.f, 0.f};
#pragma unroll
            for (int d = 0; d < 64; ++d) { const f32x4 q = *(const LAS f32x4*)(qs + d * 4); s[0] += q[0] * kr[d]; s[1] += q[1] * kr[d]; s[2] += q[2] * kr[d]; s[3] += q[3] * kr[d]; }
#pragma unroll
            for (int hh = 0; hh < 4; ++hh) { s[hh] *= 0.125f; sc[hh * 1024 + i] = s[hh]; mx[hh] = fmaxf(mx[hh], s[hh]); } }
        float inv[4];
#pragma unroll
        for (int hh = 0; hh < 4; ++hh) { mx[hh] = wmaxf(mx[hh]); float sm = 0.f; for (int i = lane; i < nw; i += 64) { const float e = __expf(sc[hh * 1024 + i] - mx[hh]); sc[hh * 1024 + i] = e; sm += e; } sm = wsum(sm); inv[hh] = 1.f / sm; }
        __builtin_amdgcn_wave_barrier();
        for (int i = 0; i < nw; ++i) { const float v = kv.v_win(lo + i, lane);
#pragma unroll
            for (int hh = 0; hh < 4; ++hh) ow[hh] += sc[hh * 1024 + i] * v; }
#pragma unroll
        for (int hh = 0; hh < 4; ++hh) ow[hh] *= inv[hh];
        __builtin_amdgcn_wave_barrier();
    }
#pragma unroll
    for (int hh = 0; hh < 4; ++hh) o[hh] = gates[hh * 3] * oc[hh] + gates[hh * 3 + 1] * os[hh] + gates[hh * 3 + 2] * ow[hh];
}

template <class LF, class SF>
DI void tr64(LAS unsigned char* lds, LF lf, SF sf) {
    LAS float* T = (LAS float*)lds;
    const int tid = ltid();
    __syncthreads();
#pragma unroll
    for (int e8 = 0; e8 < 8; ++e8) { const int e = tid + 512 * e8, kk = e >> 6, nn = e & 63; T[kk * 65 + nn] = lf(kk, nn); }
    __syncthreads();
#pragma unroll
    for (int e8 = 0; e8 < 8; ++e8) { const int e = tid + 512 * e8, nn = e >> 6, kk = e & 63; sf(nn, kk, (f16)T[kk * 65 + nn]); }
}

typedef const Args __attribute__((address_space(4)))* ArgP;
struct Ctx { ArgP ap; LAS unsigned char* lds; unsigned char* ws; float* out; int tid, lane, wave, bid, G; };
DI Ctx mkctx(LAS unsigned char* lds) {
    Ctx c; const char __attribute__((address_space(4)))* kp = (const char __attribute__((address_space(4)))*)__builtin_amdgcn_kernarg_segment_ptr();
    asm volatile("" : "+s"(kp));
    c.ap = (ArgP)kp; c.lds = lds; c.ws = c.ap->ws; c.out = c.ap->out;
    int tid = threadIdx.x; asm volatile("" : "+v"(tid));
    c.tid = tid; c.lane = tid & 63; c.wave = __builtin_amdgcn_readfirstlane(tid >> 6); c.bid = blockIdx.x; c.G = gridDim.x;
    return c;
}
#define INP(i) ((const float*)c.ap->in[i])
#define WSF(off) ((float*)(c.ws + (off)))
#define WSH(off) ((f16*)(c.ws + (off)))

DI void ph_prologue(LAS unsigned char* lds_) {
    const Ctx c = mkctx(lds_); LAS unsigned char* lds = c.lds; const int tid = c.tid, bid = c.bid, G = c.G;
    const float* c_p = INP(I_CP); const float* c_s = INP(I_CS); const float* w_ada = INP(I_WADA); const float* b_ada = INP(I_BADA);
    const float* w_in = INP(I_WIN); const float* w_out = INP(I_WOUT); const float* w1 = INP(I_W1);
    float* ADA = WSF(WS_ADA); float* BIAS = WSF(WS_BIAS); float* PEB = WSF(WS_PEB); f16* WTIN = WSH(WS_WTIN); f16* WTOUT = WSH(WS_WTOUT); f16* W1T = WSH(WS_W1T);
    constexpr int N_ADA = 96, N_WTIN = 1920, N_WTOUT = 512, N_W1T = 256, N_PEB = 32, N_W2T = 8, N_ALL = N_ADA + N_WTIN + N_WTOUT + N_W1T + N_PEB + N_W2T + 1;
    constexpr int XA = 1;
    const bool reb = G == 256; const int n_mine = reb ? (bid < N_ADA ? 1 + XA : (N_ALL - N_ADA - XA * N_ADA - (bid - N_ADA) + 159) / 160) : (N_ALL - bid + G - 1) / G;
    for (int k = 0; k < n_mine; ++k) {
        const int it = !reb ? bid + k * G : (bid < N_ADA ? (k == 0 ? bid : N_ADA + XA * bid + (k - 1)) : N_ADA + XA * N_ADA + (bid - N_ADA) + 160 * k);
        int i = it;
        if (i < N_ADA) { const int l = i / 48, n0 = (i % 48) * 64;
            skinny_item<36>(lds, w_ada + (size_t)l * 1024 * 3072, 3072, n0, 64, 33,
                [&](int m, int k) { return siluf_(m < 32 ? c_s[m * 1024 + k] : c_p[k]); },
                [&](int m, int n, float v) { ADA[((size_t)l * 33 + m) * 3072 + n] = v + b_ada[l * 3072 + n]; });
            continue; }
        i -= N_ADA;
        if (i < N_WTIN) { const int l = i / 960, r = i % 960, n0 = (r / 16) * 64, k0 = (r % 16) * 64; const float* src = w_in + (size_t)l * 1024 * DIN; f16* dst = WTIN + (size_t)l * NPD * 1024;
            tr64(lds, [&](int kk, int nn) { const int sc = src_col(n0 + nn); return sc >= 0 ? src[(size_t)(k0 + kk) * DIN + sc] : 0.f; },
                      [&](int nn, int kk, f16 v) { dst[(size_t)(n0 + nn) * 1024 + k0 + kk] = v; });
            continue; }
        i -= N_WTIN;
        if (i < N_WTOUT) { const int l = i / 256, r = i % 256, n0 = (r / 16) * 64, k0 = (r % 16) * 64; const float* src = w_out + (size_t)l * 1024 * 1024; f16* dst = WTOUT + (size_t)l * 1024 * 1024;
            tr64(lds, [&](int kk, int nn) { return src[(size_t)(k0 + kk) * 1024 + n0 + nn]; },
                      [&](int nn, int kk, f16 v) { dst[(size_t)(n0 + nn) * 1024 + k0 + kk] = v; });
            continue; }
        i -= N_WTOUT;
        if (i < N_W1T) { const int ls = i / 64, r = i % 64, k0 = (r / 2) * 64, n0 = (r % 2) * 64; const float* src = w1 + (size_t)ls * 2048 * 128; f16* dst = W1T + (size_t)ls * 128 * 2048;
            tr64(lds, [&](int kk, int nn) { return src[(size_t)(k0 + kk) * 128 + n0 + nn]; },
                      [&](int nn, int kk, f16 v) { dst[(size_t)(n0 + nn) * 2048 + k0 + kk] = v; });
            continue; }
        i -= N_W1T;
        if (i < N_PEB) { const int ls = i >> 3, ks8 = i & 7; const float* pe = INP(I_PE) + (size_t)ls * 2048 + ks8 * 256; const float* w = w1 + ((size_t)ls * 2048 + ks8 * 256) * 128; const float* b1 = INP(I_B1) + ls * 128;
            LAS float* R = (LAS float*)lds; const int f = tid & 127, kq = tid >> 7; float sacc = 0.f;
            __syncthreads();
#pragma unroll 16
            for (int k = kq * 64; k < kq * 64 + 64; ++k) sacc += pe[k] * w[(size_t)k * 128 + f];
            R[kq * 128 + f] = sacc; __syncthreads();
            if (tid < 128) WSF(WS_PEBP)[(ls * 8 + ks8) * 128 + tid] = (ks8 == 0 ? b1[tid] : 0.f) + (R[tid] + R[128 + tid]) + (R[256 + tid] + R[384 + tid]);
            __syncthreads();
            continue; }
        i -= N_PEB;
        if (i < N_W2T) { const int ls = i >> 1, f0 = (i & 1) * 64; const float* src = INP(I_W2) + (size_t)ls * 128 * 64; f16* dst = WSH(WS_W2T) + (size_t)ls * 64 * 128;
            tr64(lds, [&](int kk, int nn) { return src[(size_t)(f0 + kk) * 64 + nn]; },
                      [&](int nn, int kk, f16 v) { dst[(size_t)nn * 128 + f0 + kk] = v; });
            continue; }
        for (int e = tid; e < 2 * NPD; e += 512) BIAS[e] = 0.f;
    }
}

DI void ph_sample_compress(LAS unsigned char* lds_) {
    const Ctx c = mkctx(lds_);
    const float* w2 = INP(I_W2); const float* b2 = INP(I_B2); const float* k_g = INP(I_KG); const float* cache_kv = INP(I_CKV); const int* page_table = (const int*)c.ap->in[I_PT];
    f16* W1T = WSH(WS_W1T); float* PEB = WSF(WS_PEBP); float* KCS = WSF(WS_KCS); float* VCS = WSF(WS_VCS);
    for (int it = c.bid; it < 1152; it += c.G) {
        const int grp = it % 9, st_ = it / 9, slot = st_ & 1, b = (st_ >> 1) & 31, l = st_ >> 6;
        const float* ckv = cache_kv + (size_t)l * NPOOL * 128 * 256; const int* pt = page_table + b * 128;
        compress_item<true>(c.lds, [&](int ch) { return (const void*)(ckv + ((size_t)pt[ch >> 3] * 128 + (ch & 7) * 16) * 256 + slot * 64); }, grp * 127,
                            W1T + (size_t)(l * 2 + slot) * 128 * 2048, PEB + (l * 2 + slot) * 1024, WSH(WS_W2T) + (size_t)(l * 2 + slot) * 64 * 128, b2 + (l * 2 + slot) * 64,
                            slot == 0 ? k_g + l * 192 : nullptr, (slot == 0 ? KCS : VCS) + (size_t)(l * NB + b) * 1024 * 64, nullptr, nullptr);
    }
}
DI void ph_prep(LAS unsigned char* lds_) {
    const Ctx c = mkctx(lds_); const int tid = c.tid, lane = c.lane, wave = c.wave, bid = c.bid, G = c.G;
    float* ADA = WSF(WS_ADA); float* BIAS = WSF(WS_BIAS);
    {
        const f16* WTIN = WSH(WS_WTIN);
        const bool lite = G == 256;
        const int pb = lite ? bid - 128 : bid, pG = lite ? 128 : G;
        if (pb >= 0)
        for (int col = pb * 8 + wave; col < 2 * NPD; col += pG * 8) { const int l = col / NPD; const float* sh = ADA + ((size_t)l * 33 + 32) * 3072 + lane * 16; const f16* wp = WTIN + (size_t)col * 1024 + lane * 16;
            const f16x8 w0 = ld_h8(wp), w1 = ld_h8(wp + 8); float acc = 0.f;
#pragma unroll
            for (int i = 0; i < 8; ++i) acc += sh[i] * (float)w0[i] + sh[8 + i] * (float)w1[i];
            acc = wsum(acc); if (lane == 0) BIAS[col] = acc; }
    }
    const float* ng = INP(I_NG);
    if (bid == 0) { float* GNX = WSF(WS_GNX); const float* sc1 = ADA + (size_t)(33 + 32) * 3072 + 1024;
        for (int k = tid; k < 1024; k += 512) GNX[k] = ng[1024 + k] * (1.f + sc1[k]); }
    const float* ada_p = ADA + (size_t)32 * 3072; const float* x_p = INP(I_XP); f16* A16 = WSH(WS_A16); float* RSSP = WSF(WS_RSSP);
    float gp[16];
#pragma unroll
    for (int i = 0; i < 4; ++i) { const f32x4 g4 = *(const f32x4*)(ng + i * 256 + lane * 4), s4 = *(const f32x4*)(ada_p + 1024 + i * 256 + lane * 4);
#pragma unroll
        for (int j = 0; j < 4; ++j) gp[i * 4 + j] = g4[j] * (1.f + s4[j]); }
    const bool lite2 = G == 256; const int pb2 = lite2 ? bid - 128 : bid, pG2 = lite2 ? 128 : G;
    if (pb2 >= 0)
    for (int row = pb2 * 8 + wave; row < SEQ; row += pG2 * 8) {
        const float* xr = x_p + (size_t)row * 1024; float ss = 0.f;
#pragma unroll
        for (int i = 0; i < 4; ++i) { const f32x4 v = *(const f32x4*)(xr + i * 256 + lane * 4); ss += (v[0] * v[0] + v[1] * v[1]) + (v[2] * v[2] + v[3] * v[3]);
            f16x4 h; h[0] = (f16)(v[0] * gp[i * 4]); h[1] = (f16)(v[1] * gp[i * 4 + 1]); h[2] = (f16)(v[2] * gp[i * 4 + 2]); h[3] = (f16)(v[3] * gp[i * 4 + 3]);
            *(f16x4*)(A16 + (size_t)row * 1024 + i * 256 + lane * 4) = h; }
        ss = wsum(ss);
        if (lane < 16) RSSP[(size_t)row * 16 + lane] = lane == 0 ? ss : 0.f;
    }
}

template <int NT  , class OFn>
DI void sample_gemm_item(LAS unsigned char* lds, const f16* Bt, int n0, OFn ofn) {
    constexpr int KW = 8 / NT, KL = 1024 / KW;
    const int tid = ltid(), wave = tid >> 6, lane = tid & 63, wn = wave % NT, wk = wave / NT, r = lane & 31, h = lane >> 5;
    const LAS f16* Ah = (const LAS f16*)lds + r * 1032 + wk * KL + 8 * h; const f16* bp = Bt + (size_t)(n0 + 32 * wn + r) * 1024 + wk * KL + 8 * h;
    f32x16 acc;
#pragma unroll
    for (int i = 0; i < 16; ++i) acc[i] = 0.f;
#pragma unroll 8
    for (int st = 0; st < KL / 16; ++st) acc = __builtin_amdgcn_mfma_f32_32x32x16_f16(*(const LAS f16x8*)(Ah + 16 * st), ld_h8(bp + 16 * st), acc, 0, 0, 0);
    LAS float* RED = (LAS float*)(lds + 67584);
#pragma unroll
    for (int i = 0; i < 16; ++i) RED[(wk * 32 + (i & 3) + 8 * (i >> 2) + 4 * h) * (32 * NT) + 32 * wn + r] = acc[i];
    __syncthreads();
    for (int e = tid; e < 1024 * NT; e += 512) { float v = 0.f;
#pragma unroll
        for (int w = 0; w < KW; ++w) v += RED[w * 1024 * NT + e];
        ofn(e / (32 * NT), n0 + e % (32 * NT), v); }
    __syncthreads();
}
DI void ph_inproj(LAS unsigned char* lds_, int l) {
    const Ctx c = mkctx(lds_);
    pg8::Gemm g{WSH(WS_A16), WSH(WS_WTIN) + (size_t)l * NPD * 1024, SEQ, NPD, 1024}; pg8::StaticOrder S; S.init(SEQ, NPD, c.G, c.bid);
    EpiIn E{WSH(WS_PROJ), WSF(WS_RSSP), WSF(WS_BIAS) + l * NPD, c.out + O_KVP + (size_t)l * SEQ * 256};
    pg8::gemm_phase<EpiIn, pg8::StaticOrder>(c.lds, g, S, E);
    __syncthreads();
}
DI void ph_hsample(LAS unsigned char* lds_, int l) {
    const Ctx c = mkctx(lds_); const int lane = c.lane;
    if (c.bid >= 4) return;
    const int m = c.bid * 8 + c.wave;
    const float* xr = (l == 0 ? INP(I_XS) : WSF(WS_XS1)) + (size_t)m * 1024; const float* ad = WSF(WS_ADA) + ((size_t)l * 33 + m) * 3072; const float* ng = INP(I_NG) + l * 1024; f16* hs = WSH(WS_HS16) + (size_t)m * 1024;
    f32x4 xv[4]; float ss = 0.f;
#pragma unroll
    for (int i = 0; i < 4; ++i) { xv[i] = *(const f32x4*)(xr + i * 256 + lane * 4); ss += (xv[i][0] * xv[i][0] + xv[i][1] * xv[i][1]) + (xv[i][2] * xv[i][2] + xv[i][3] * xv[i][3]); }
    const float rn = rsqrtf(wsum(ss) * (1.f / 1024.f) + EPS);
#pragma unroll
    for (int i = 0; i < 4; ++i) { const int k = i * 256 + lane * 4; const f32x4 g = *(const f32x4*)(ng + k), sc = *(const f32x4*)(ad + 1024 + k), sh = *(const f32x4*)(ad + k); f16x4 hv;
#pragma unroll
        for (int j = 0; j < 4; ++j) hv[j] = (f16)(xv[i][j] * rn * g[j] * (1.f + sc[j]) + sh[j]);
        *(f16x4*)(hs + k) = hv; }
}
DI void ph_inproj_sample(LAS unsigned char* lds_, int l) {
    const Ctx c = mkctx(lds_); const int tid = c.tid;
    const int it = c.bid - (c.G - 64);
    if (it < 0 || it >= 60) return;
    float* PROJS = WSF(WS_PROJS); const f16* HS = WSH(WS_HS16); LAS f16* Ah = (LAS f16*)c.lds;
    __syncthreads();
#pragma unroll
    for (int i = 0; i < 8; ++i) { const int e = (tid + 512 * i) * 8; *(LAS f16x8*)(Ah + (e >> 10) * 1032 + (e & 1023)) = ld_h8(HS + e); }
    __syncthreads();
    sample_gemm_item<2>(c.lds, WSH(WS_WTIN) + (size_t)l * NPD * 1024, it * 64, [&](int m, int n, float v) { PROJS[m * NPD + n] = v; });
}

#define PT(t) (P + (size_t)(t) * SEQ * 256)
DI void ph_ssd_local(LAS unsigned char* lds_, int l) {
    const Ctx c = mkctx(lds_); LAS unsigned char* lds = c.lds; const int tid = c.tid, lane = c.lane, wave = c.wave;
    const f16* P = WSH(WS_PROJ); f16* ACT = WSH(WS_ACT); float* YD = WSF(WS_YD); float* CST = WSF(WS_CST); float* ACS = WSF(WS_ACS); float* CDEC = WSF(WS_CDEC); float* out = c.out;
    const float* dtb = INP(I_DTB) + l * 4; const float* alog = INP(I_ALOG) + l * 4; const float* cw = INP(I_BCW) + l * 4 * 768; const float* cb = INP(I_BCB) + l * 768;
    LAS f16* Bm = (LAS f16*)lds; LAS f16* BT = (LAS f16*)(lds + 34816); LAS f16* Cm = (LAS f16*)(lds + 69632); LAS f16* XT = (LAS f16*)(lds + 104448);
    LAS float* acs = (LAS float*)(lds + 139264); LAS float* dtl = acs + 256; LAS f16* te16 = (LAS f16*)(dtl + 256);
    for (int it = c.bid; it < 256; it += c.G) {
        const int ch_ = it >> 1, g = it & 1, t0 = ch_ * 128;
        __syncthreads();
        if (tid < 256) { const int hh = tid >> 7, lt = tid & 127, hd = 2 * g + hh; const float raw = (float)PT(13)[(size_t)(t0 + lt) * 256 + 128 + hd];
            const float dt = softplusf_(raw + dtb[hd]); dtl[hh * 128 + lt] = dt; acs[hh * 128 + lt] = dt * (-__expf(alog[hd])); }
        __syncthreads();
        if (tid == 0 || tid == 64) { const int hh = tid >> 6; float sacc = 0.f; for (int i = 0; i < 128; ++i) { sacc += acs[hh * 128 + i]; acs[hh * 128 + i] = sacc; } }
        __syncthreads();
        if (tid < 256) { const int hh = tid >> 7, lt = tid & 127, hd = 2 * g + hh; const float av = acs[hh * 128 + lt], ae = acs[hh * 128 + 127];
            te16[hh * 128 + lt] = (f16)__expf(ae - av); ACS[(size_t)(t0 + lt) * 4 + hd] = av; if (lt == 127) CDEC[ch_ * 4 + hd] = __expf(ae); }
#pragma unroll 3
        for (int e = tid; e < 128 * 48; e += 512) {
            const int lt = (e >> 2) & 127, cg = (e >> 9) * 4 + (e & 3), reg = cg >> 4, c8 = (cg & 15) * 8, t = t0 + lt, col = 128 * g + c8, ch = reg * 256 + col;
            const f16* src = PT(5 + reg) + col; float y[8]; f16x8 rawt;
#pragma unroll
            for (int i = 0; i < 8; ++i) y[i] = cb[ch + i];
#pragma unroll
            for (int k = 0; k < 4; ++k) { const int tt = t - 3 + k; f16x8 v; if (tt >= 0) v = ld_h8(src + (size_t)tt * 256); else {
#pragma unroll
                    for (int i = 0; i < 8; ++i) v[i] = (f16)0.f; }
                if (k == 3) rawt = v;
#pragma unroll
                for (int i = 0; i < 8; ++i) y[i] += cw[k * 768 + ch + i] * (float)v[i]; }
            f16x8 act;
#pragma unroll
            for (int i = 0; i < 8; ++i) { y[i] = siluf_(y[i]); act[i] = (f16)y[i]; }
            *(f16x8*)(ACT + (size_t)t * 768 + ch) = act;
            if (reg == 0) { const int hh = c8 >> 6; const float sdt = dtl[hh * 128 + lt] * 64.f;
#pragma unroll
                for (int i = 0; i < 8; ++i) XT[(c8 + i) * 136 + lt] = (f16)(y[i] * sdt); }
            else if (reg == 1) { *(LAS f16x8*)(Bm + lt * 136 + c8) = act;
#pragma unroll
                for (int i = 0; i < 8; ++i) BT[(c8 + i) * 136 + lt] = act[i]; }
            else *(LAS f16x8*)(Cm + lt * 136 + c8) = act;
            if (t >= SEQ - 3) { float* so = out + O_BCP + (size_t)l * 2304 + (t - (SEQ - 3)) * 768 + ch;
#pragma unroll
                for (int i = 0; i < 8; ++i) so[i] = (float)rawt[i]; }
        }
        __syncthreads();
        const int fr = lane & 15, q = lane >> 4, w = wave;
        f32x4 gt[8];
#pragma unroll
        for (int mt = 0; mt < 8; ++mt) { gt[mt] = (f32x4){0.f, 0.f, 0.f, 0.f};
            if (mt <= w) {
#pragma unroll
                for (int ks = 0; ks < 4; ++ks) { const f16x8 av = *(const LAS f16x8*)(Bm + (16 * mt + fr) * 136 + 32 * ks + 8 * q), bv = *(const LAS f16x8*)(Cm + (16 * w + fr) * 136 + 32 * ks + 8 * q);
                    gt[mt] = __builtin_amdgcn_mfma_f32_16x16x32_f16(av, bv, gt[mt], 0, 0, 0); } } }
#pragma unroll
        for (int hh = 0; hh < 2; ++hh) {
            const int lrow = 16 * w + fr; const float al = acs[hh * 128 + lrow];
            f32x4 ya[4];
#pragma unroll
            for (int pt = 0; pt < 4; ++pt) ya[pt] = (f32x4){0.f, 0.f, 0.f, 0.f};
#pragma unroll
            for (int k2 = 0; k2 < 4; ++k2) {
                if (2 * k2 <= w) {
                    f16x8 af;
#pragma unroll
                    for (int j = 0; j < 8; ++j) { const int m = 32 * k2 + (j < 4 ? 4 * q + j : 16 + 4 * q + (j - 4)); const float gv = j < 4 ? gt[2 * k2][j] : gt[2 * k2 + 1][j - 4];
                        af[j] = (f16)(m <= lrow ? gv * __expf(al - acs[hh * 128 + m]) : 0.f); }
#pragma unroll
                    for (int pt = 0; pt < 4; ++pt) { const LAS f16* xp = XT + (hh * 64 + 16 * pt + fr) * 136 + 32 * k2 + 4 * q; const f16x4 b0 = *(const LAS f16x4*)xp, b1 = *(const LAS f16x4*)(xp + 16);
                        f16x8 bf; bf[0] = b0[0]; bf[1] = b0[1]; bf[2] = b0[2]; bf[3] = b0[3]; bf[4] = b1[0]; bf[5] = b1[1]; bf[6] = b1[2]; bf[7] = b1[3];
                        ya[pt] = __builtin_amdgcn_mfma_f32_16x16x32_f16(af, bf, ya[pt], 0, 0, 0); }
                }
            }
#pragma unroll
            for (int pt = 0; pt < 4; ++pt)
#pragma unroll
                for (int j = 0; j < 4; ++j) YD[(size_t)(t0 + 16 * w + 4 * q + j) * 256 + (2 * g + hh) * 64 + 16 * pt + fr] = ya[pt][j] * (1.f / 64.f);
#pragma unroll
            for (int pt = 0; pt < 4; ++pt) { f32x4 sa = (f32x4){0.f, 0.f, 0.f, 0.f};
#pragma unroll
                for (int ks = 0; ks < 4; ++ks) { const f16x8 xv = *(const LAS f16x8*)(XT + (hh * 64 + 16 * pt + fr) * 136 + 32 * ks + 8 * q), tv = *(const LAS f16x8*)(te16 + hh * 128 + 32 * ks + 8 * q);
                    const f16x8 bv = *(const LAS f16x8*)(BT + (16 * w + fr) * 136 + 32 * ks + 8 * q);
                    sa = __builtin_amdgcn_mfma_f32_16x16x32_f16(xv * tv, bv, sa, 0, 0, 0); }
#pragma unroll
                for (int j = 0; j < 4; ++j) CST[((size_t)(ch_ * 4 + 2 * g + hh) * 64 + 16 * pt + 4 * q + j) * 128 + 16 * w + fr] = sa[j] * (1.f / 64.f); }
        }
    }
    __syncthreads();
}
DI void ph_mix_a(LAS unsigned char* lds_, int l) {
    const Ctx c = mkctx(lds_); const int tid = c.tid;
    const f16* P = WSH(WS_PROJ); f16* Y16 = WSH(WS_Y16); float* out = c.out; const float* scw = INP(I_SCW) + l * 768;
    for (int it = c.bid; it < 256; it += c.G) {
        for (int e = tid; e < 64 * 32; e += 512) { const int t = it * 64 + (e >> 5), c0 = (e & 31) * 8; float u[3][8];
#pragma unroll
            for (int k = 0; k < 3; ++k) { const int tt = t - 2 + k;
                if (tt >= 0) { const f16x8 h = ld_h8(PT(0) + (size_t)tt * 256 + c0), cc = ld_h8(PT(2) + (size_t)tt * 256 + c0);
#pragma unroll
                    for (int i = 0; i < 8; ++i) u[k][i] = (float)cc[i] * (float)h[i]; }
                else {
#pragma unroll
                    for (int i = 0; i < 8; ++i) u[k][i] = 0.f; } }
            const f16x8 bb = ld_h8(PT(1) + (size_t)t * 256 + c0), gg = ld_h8(PT(3) + (size_t)t * 256 + c0); f16x8 o;
#pragma unroll
            for (int i = 0; i < 8; ++i) { const float y = scw[c0 + i] * u[0][i] + scw[256 + c0 + i] * u[1][i] + scw[512 + c0 + i] * u[2][i]; o[i] = (f16)(siluf_((float)gg[i]) * (float)bb[i] * y); }
            *(f16x8*)(Y16 + (size_t)t * 1024 + c0) = o;
            if (t >= SEQ - 2) { float* so = out + O_SCP + (size_t)l * 512 + (t - (SEQ - 2)) * 256 + c0;
#pragma unroll
                for (int i = 0; i < 8; ++i) so[i] = u[2][i]; }
        }
    }
}
DI void ph_mix_c(LAS unsigned char* lds_, int l) {
    const Ctx c = mkctx(lds_); const int tid = c.tid, lane = c.lane, wave = c.wave;
    const f16* P = WSH(WS_PROJ); f16* Y16 = WSH(WS_Y16); float* out = c.out;
    const float* cfw = INP(I_CFW) + l * 31 * 256; const float* cfb = INP(I_CFB) + l * 256; const float* lng = INP(I_LNG) + l * 256; const float* lnb = INP(I_LNB) + l * 256;
    LAS float* GL = (LAS float*)c.lds;
    f32x4 wt[31];
#pragma unroll
    for (int k = 0; k < 31; ++k) wt[k] = *(const f32x4*)(cfw + k * 256 + lane * 4);
    const f32x4 bias4 = *(const f32x4*)(cfb + lane * 4), g4 = *(const f32x4*)(lng + lane * 4), b4 = *(const f32x4*)(lnb + lane * 4);
    for (int it = c.bid; it < 256; it += c.G) {
        __syncthreads();
        for (int e = tid; e < 94 * 32; e += 512) { const int rr = e >> 5, c0 = (e & 31) * 8, t = it * 64 - 30 + rr; f32x4 g0 = (f32x4){0.f, 0.f, 0.f, 0.f}, g1 = g0;
            if (t >= 0) { const f16x8 ga = ld_h8(PT(8) + (size_t)t * 256 + c0), gb = ld_h8(PT(9) + (size_t)t * 256 + c0);
#pragma unroll
                for (int i = 0; i < 4; ++i) { g0[i] = (float)ga[i] * sigmoidf_((float)gb[i]); g1[i] = (float)ga[4 + i] * sigmoidf_((float)gb[4 + i]); }
                if (t >= SEQ - 30) { float* so = out + O_CFP + (size_t)l * 7680 + (t - (SEQ - 30)) * 256 + c0; *(f32x4*)so = g0; *(f32x4*)(so + 4) = g1; } }
            *(LAS f32x4*)(GL + rr * 256 + c0) = g0; *(LAS f32x4*)(GL + rr * 256 + c0 + 4) = g1; }
        __syncthreads();
        {
            const int cc = lane * 4, tb = wave * 8;
            f32x4 u[8];
#pragma unroll
            for (int j = 0; j < 8; ++j) u[j] = bias4;
#pragma unroll
            for (int r = 0; r < 38; ++r) { const f32x4 gv = *(const LAS f32x4*)(GL + (tb + r) * 256 + cc);
#pragma unroll
                for (int j = 0; j < 8; ++j) if (r - j >= 0 && r - j <= 30) u[j] += wt[r - j] * gv; }
#pragma unroll
            for (int j = 0; j < 8; ++j) { const int t = it * 64 + tb + j;
                const float mean = wsum((u[j][0] + u[j][1]) + (u[j][2] + u[j][3])) * (1.f / 256.f); const f32x4 d = u[j] - mean;
                const float var = wsum((d[0] * d[0] + d[1] * d[1]) + (d[2] * d[2] + d[3] * d[3])) * (1.f / 256.f); const float rs = rsqrtf(var + EPS);
                const f16x4 cg = *(const f16x4*)(PT(10) + (size_t)t * 256 + cc); f16x4 o;
#pragma unroll
                for (int i = 0; i < 4; ++i) o[i] = (f16)(siluf_((float)cg[i]) * siluf_(d[i] * rs * g4[i] + b4[i]));
                *(f16x4*)(Y16 + (size_t)t * 1024 + 512 + cc) = o; }
        }
    }
    __syncthreads();
}
DI void ph_mix_d(LAS unsigned char* lds_, int l) {
    const Ctx c = mkctx(lds_); const int tid = c.tid, lane = c.lane, wave = c.wave;
    const f16* P = WSH(WS_PROJ); float* out = c.out; float* kvp_out = out + O_KVP + (size_t)l * SEQ * 256;
    f16* Q16 = WSH(WS_Q16); f16* KS16 = WSH(WS_KS16); f16* KW16 = WSH(WS_KW16); f16* VST16 = WSH(WS_VST16); f16* VWT16 = WSH(WS_VWT16); float* GATES = WSF(WS_GATES);
    const int d4 = (lane & 15) * 4, v4 = lane >> 4;
    const f32x4 qg = *(const f32x4*)(INP(I_QG) + l * 64 + d4), kg1 = *(const f32x4*)(INP(I_KG) + l * 192 + 64 + d4), kg2 = *(const f32x4*)(INP(I_KG) + l * 192 + 128 + d4);
    LAS f16* VSs = (LAS f16*)c.lds; LAS f16* VWs = VSs + 64 * 68;
    if (c.bid < 18 && c.G > 36) return;
    for (int it = c.bid - 18 >= 0 && c.G > 36 ? c.bid - 18 : c.bid; it < 256; it += (c.G > 36 ? c.G - 18 : c.G)) {
        __syncthreads();
        for (int vi = wave * 4 + v4; vi < 256; vi += 32) { const size_t off = (size_t)(it * 64) * 256 + (size_t)vi * 64 + d4; const f16x4 x = *(const f16x4*)(PT(11) + off);
            const float a0 = (float)x[0], a1 = (float)x[1], a2 = (float)x[2], a3 = (float)x[3]; const float rn = rsqrtf(sum16((a0 * a0 + a1 * a1) + (a2 * a2 + a3 * a3)) * (1.f / 64.f) + EPS);
            f16x4 y; y[0] = (f16)(a0 * rn * qg[0]); y[1] = (f16)(a1 * rn * qg[1]); y[2] = (f16)(a2 * rn * qg[2]); y[3] = (f16)(a3 * rn * qg[3]); *(f16x4*)(Q16 + off) = y; }
        for (int tl = wave * 4 + v4; tl < 64; tl += 32) { const int t = it * 64 + tl;
            { const f16x4 x = *(const f16x4*)(PT(12) + (size_t)t * 256 + 128 + d4), vv = *(const f16x4*)(PT(12) + (size_t)t * 256 + 192 + d4);
                const float a0 = (float)x[0], a1 = (float)x[1], a2 = (float)x[2], a3 = (float)x[3]; const float rn = rsqrtf(sum16((a0 * a0 + a1 * a1) + (a2 * a2 + a3 * a3)) * (1.f / 64.f) + EPS);
                const f32x4 kn = (f32x4){a0 * rn * kg1[0], a1 * rn * kg1[1], a2 * rn * kg1[2], a3 * rn * kg1[3]}; *(f32x4*)(kvp_out + (size_t)t * 256 + 128 + d4) = kn;
                f16x4 y; y[0] = (f16)kn[0]; y[1] = (f16)kn[1]; y[2] = (f16)kn[2]; y[3] = (f16)kn[3]; *(f16x4*)(KS16 + (size_t)t * 64 + d4) = y; *(LAS f16x4*)(VSs + tl * 68 + d4) = vv; }
            { const f16x4 x = *(const f16x4*)(PT(13) + (size_t)t * 256 + d4), vv = *(const f16x4*)(PT(13) + (size_t)t * 256 + 64 + d4);
                const float a0 = (float)x[0], a1 = (float)x[1], a2 = (float)x[2], a3 = (float)x[3]; const float rn = rsqrtf(sum16((a0 * a0 + a1 * a1) + (a2 * a2 + a3 * a3)) * (1.f / 64.f) + EPS);
                const f32x4 kn = (f32x4){a0 * rn * kg2[0], a1 * rn * kg2[1], a2 * rn * kg2[2], a3 * rn * kg2[3]};
                f16x4 y; y[0] = (f16)kn[0]; y[1] = (f16)kn[1]; y[2] = (f16)kn[2]; y[3] = (f16)kn[3]; *(f16x4*)(KW16 + (size_t)t * 64 + d4) = y; *(LAS f16x4*)(VWs + tl * 68 + d4) = vv;
                if (t >= SEQ - 512) { float* wo = out + O_WINP + (size_t)l * 512 * 128 + (size_t)(t - (SEQ - 512)) * 128; *(f32x4*)(wo + d4) = kn; *(f32x4*)(wo + 64 + d4) = (f32x4){(float)vv[0], (float)vv[1], (float)vv[2], (float)vv[3]}; } }
        }
        for (int e = tid; e < 64 * 12; e += 512) { const int tl = e / 12, gi = e % 12; GATES[(size_t)(it * 64 + tl) * 12 + gi] = sigmoidf_((float)PT(13)[(size_t)(it * 64 + tl) * 256 + 132 + gi]); }
        __syncthreads();
        { const int d = tid >> 3, k8 = (tid & 7) * 8; f16x8 a, b;
#pragma unroll
            for (int i = 0; i < 8; ++i) { const int key = vt_key(k8 + i); a[i] = VSs[key * 68 + d]; b[i] = VWs[key * 68 + d]; }
            *(f16x8*)(VST16 + (size_t)it * 4096 + d * 64 + k8) = a; *(f16x8*)(VWT16 + (size_t)it * 4096 + d * 64 + k8) = b; }
    }
    __syncthreads();
}
DI void ph_mix_cmp(LAS unsigned char* lds_, int l) {
    const Ctx c = mkctx(lds_);
    const f16* P = WSH(WS_PROJ); const float* w2 = INP(I_W2); const float* b2 = INP(I_B2); const float* k_g = INP(I_KG); f16* W1T = WSH(WS_W1T); float* PEB = WSF(WS_PEBP);
    for (int it = c.bid; it < 18; it += c.G) { const int slot = it / 9, grp = it % 9; const f16* src = PT(12) + slot * 64;
        compress_item<false>(c.lds, [&](int ch) { return (const void*)(src + (size_t)ch * 16 * 256); }, grp * 127,
                             W1T + (size_t)(l * 2 + slot) * 128 * 2048, PEB + (l * 2 + slot) * 1024, WSH(WS_W2T) + (size_t)(l * 2 + slot) * 64 * 128, b2 + (l * 2 + slot) * 64,
                             slot == 0 ? k_g + l * 192 : nullptr, nullptr, slot == 0 ? WSH(WS_KC16) : nullptr, slot == 0 ? nullptr : WSH(WS_VCT16)); }
}
#undef PT
template <int N>
DI void blk_reduce(LAS float* red, LAS float* bc, float (&v)[N], bool is_max, int wave, int lane) {
#pragma unroll
    for (int i = 0; i < N; ++i) v[i] = is_max ? wmaxf(v[i]) : wsum(v[i]);
    __syncthreads();
    if (lane == 0) {
#pragma unroll
        for (int i = 0; i < N; ++i) red[wave * 12 + i] = v[i]; }
    __syncthreads();
    if (wave == 0 && lane < N) { float r = red[lane]; for (int w = 1; w < 8; ++w) r = is_max ? fmaxf(r, red[w * 12 + lane]) : r + red[w * 12 + lane]; bc[lane] = r; }
    __syncthreads();
#pragma unroll
    for (int i = 0; i < N; ++i) v[i] = bc[i];
}
DI void nsa_sample_block(LAS float* wl, const float* KC, const float* VC, const SampleKV& kv, const LAS float* gsm, const float* dgp, float* ysd, int tid, int lane, int wave) {
    LAS float* sc = wl; LAS float* qs = wl + 10496; LAS float* PSL = qs + 256; LAS float* red = PSL + 1024; LAS float* bc = red + 96; LAS int* sel = (LAS int*)(bc + 16); LAS float* part = bc + 32;
    constexpr int NCV = 1023, CUR = PAST >> 6;
    float mv[8], sv[8];
#pragma unroll
    for (int i = 0; i < 8; ++i) mv[i] = -3e38f;
    for (int cidx = tid; cidx < NCV; cidx += 512) {
        asm volatile("" ::: "memory");
        float kr[64]; kv.ld64(KC + (size_t)cidx * 64, kr); float s4[4] = {0.f, 0.f, 0.f, 0.f};
#pragma unroll
        for (int d = 0; d < 64; ++d) { const f32x4 qv = *(const LAS f32x4*)(qs + d * 4); s4[0] += qv[0] * kr[d]; s4[1] += qv[1] * kr[d]; s4[2] += qv[2] * kr[d]; s4[3] += qv[3] * kr[d]; }
#pragma unroll
        for (int hh = 0; hh < 4; ++hh) { s4[hh] *= 0.125f; sc[hh * 2624 + cidx] = s4[hh]; mv[hh] = fmaxf(mv[hh], s4[hh]); }
    }
    for (int i = tid; i < 513; i += 512) {
        asm volatile("" ::: "memory");
        float kr[64]; kv.krow_win(PAST - 512 + i, kr); float s4[4] = {0.f, 0.f, 0.f, 0.f};
#pragma unroll
        for (int d = 0; d < 64; ++d) { const f32x4 qv = *(const LAS f32x4*)(qs + d * 4); s4[0] += qv[0] * kr[d]; s4[1] += qv[1] * kr[d]; s4[2] += qv[2] * kr[d]; s4[3] += qv[3] * kr[d]; }
#pragma unroll
        for (int hh = 0; hh < 4; ++hh) { s4[hh] *= 0.125f; sc[hh * 2624 + 2048 + i] = s4[hh]; mv[4 + hh] = fmaxf(mv[4 + hh], s4[hh]); }
    }
    blk_reduce<8>(red, bc, mv, true, wave, lane);
#pragma unroll
    for (int i = 0; i < 8; ++i) sv[i] = 0.f;
    for (int cidx = tid; cidx < NCV; cidx += 512) {
#pragma unroll
        for (int hh = 0; hh < 4; ++hh) { const float e = __expf(sc[hh * 2624 + cidx] - mv[hh]); sc[hh * 2624 + cidx] = e; sv[hh] += e; } }
    for (int i = tid; i < 513; i += 512) {
#pragma unroll
        for (int hh = 0; hh < 4; ++hh) { const float e = __expf(sc[hh * 2624 + 2048 + i] - mv[4 + hh]); sc[hh * 2624 + 2048 + i] = e; sv[4 + hh] += e; } }
    blk_reduce<8>(red, bc, sv, false, wave, lane);
    float invc[4], invw[4];
#pragma unroll
    for (int hh = 0; hh < 4; ++hh) { invc[hh] = 1.f / sv[hh]; invw[hh] = 1.f / sv[4 + hh]; }
    for (int cidx = tid; cidx < 1024; cidx += 512) PSL[cidx] = cidx < NCV ? (sc[cidx] * invc[0] + sc[2624 + cidx] * invc[1]) + (sc[2 * 2624 + cidx] * invc[2] + sc[3 * 2624 + cidx] * invc[3]) : 0.f;
    __syncthreads();
    if (wave == 0) {
        float scv[5];
#pragma unroll
        for (int i = 0; i < 5; ++i) { const int j = lane + 64 * i; float v = -3e38f;
            if (j <= CUR) { if (j == 0 || j == CUR || j == CUR - 1) v = 3e38f; else { float a = 0.f;
#pragma unroll
                    for (int o5 = -1; o5 < 4; ++o5) { const int cc = 4 * j + o5; if (cc >= 0 && cc < NCV) a += (o5 == -1 || o5 == 3) ? 0.5f * PSL[cc] : PSL[cc]; }
                    v = a; } }
            scv[i] = v; }
        for (int k = 0; k < 16; ++k) {
            float bv = scv[0]; int bi = lane;
#pragma unroll
            for (int i = 1; i < 5; ++i) if (scv[i] > bv) { bv = scv[i]; bi = lane + 64 * i; }
#pragma unroll
            for (int off = 32; off > 0; off >>= 1) { const float ov = __shfl_xor(bv, off); const int oi = __shfl_xor(bi, off); if (ov > bv || (ov == bv && oi < bi)) { bv = ov; bi = oi; } }
            if (lane == 0) sel[k] = bi;
#pragma unroll
            for (int i = 0; i < 5; ++i) if (lane + 64 * i == bi) scv[i] = -3e38f;
        }
    }
    __syncthreads();
    float ms[4], ss4[4];
#pragma unroll
    for (int i = 0; i < 4; ++i) ms[i] = -3e38f;
    for (int idx = tid; idx < 1024; idx += 512) {
        asm volatile("" ::: "memory");
        const int pos = sel[idx >> 6] * 64 + (idx & 63); float s4[4] = {-1e30f, -1e30f, -1e30f, -1e30f};
        if (pos <= PAST) { float kr[64]; kv.krow_sel(pos, kr); s4[0] = s4[1] = s4[2] = s4[3] = 0.f;
#pragma unroll
            for (int d = 0; d < 64; ++d) { const f32x4 qv = *(const LAS f32x4*)(qs + d * 4); s4[0] += qv[0] * kr[d]; s4[1] += qv[1] * kr[d]; s4[2] += qv[2] * kr[d]; s4[3] += qv[3] * kr[d]; }
#pragma unroll
            for (int hh = 0; hh < 4; ++hh) s4[hh] *= 0.125f; }
#pragma unroll
        for (int hh = 0; hh < 4; ++hh) { sc[hh * 2624 + 1024 + idx] = s4[hh]; ms[hh] = fmaxf(ms[hh], s4[hh]); }
    }
    blk_reduce<4>(red, bc, ms, true, wave, lane);
#pragma unroll
    for (int i = 0; i < 4; ++i) ss4[i] = 0.f;
    for (int idx = tid; idx < 1024; idx += 512) {
#pragma unroll
        for (int hh = 0; hh < 4; ++hh) { const float x = sc[hh * 2624 + 1024 + idx]; const float e = x > -1e29f ? __expf(x - ms[hh]) : 0.f; sc[hh * 2624 + 1024 + idx] = e; ss4[hh] += e; } }
    blk_reduce<4>(red, bc, ss4, false, wave, lane);
    float invs[4];
#pragma unroll
    for (int hh = 0; hh < 4; ++hh) invs[hh] = 1.f / ss4[hh];
    float oc[4] = {0.f, 0.f, 0.f, 0.f}, os[4] = {0.f, 0.f, 0.f, 0.f}, ow[4] = {0.f, 0.f, 0.f, 0.f};
    { const int c1 = (wave + 1) * 128 < NCV ? (wave + 1) * 128 : NCV;
#pragma unroll 16
        for (int cidx = wave * 128; cidx < c1; ++cidx) { const float v = VC[(size_t)cidx * 64 + lane];
#pragma unroll
            for (int hh = 0; hh < 4; ++hh) oc[hh] += sc[hh * 2624 + cidx] * v; } }
    for (int kb = wave * 2; kb < wave * 2 + 2; ++kb) { const int p0 = sel[kb] * 64; int nk = PAST - p0 + 1; nk = nk > 64 ? 64 : nk;
        const float* vbase = p0 < PAST ? kv.prow(p0, 3) + lane : kv.nvs + lane;
#pragma unroll 16
        for (int kk = 0; kk < nk; ++kk) { const float v = vbase[(size_t)kk * 256];
#pragma unroll
            for (int hh = 0; hh < 4; ++hh) os[hh] += sc[hh * 2624 + 1024 + kb * 64 + kk] * v; } }
    { const int i1 = (wave + 1) * 65 < 513 ? (wave + 1) * 65 : 513;
#pragma unroll 13
        for (int i = wave * 65; i < i1; ++i) { const float v = kv.v_win(PAST - 512 + i, lane);
#pragma unroll
            for (int hh = 0; hh < 4; ++hh) ow[hh] += sc[hh * 2624 + 2048 + i] * v; } }
#pragma unroll
    for (int hh = 0; hh < 4; ++hh) { part[(wave * 12 + hh) * 64 + lane] = oc[hh] * invc[hh]; part[(wave * 12 + 4 + hh) * 64 + lane] = os[hh] * invs[hh]; part[(wave * 12 + 8 + hh) * 64 + lane] = ow[hh] * invw[hh]; }
    __syncthreads();
    if (tid < 256) { const int hh = tid >> 6, d = tid & 63; float a = 0.f, b = 0.f, cc = 0.f;
        for (int w = 0; w < 8; ++w) { a += part[(w * 12 + hh) * 64 + d]; b += part[(w * 12 + 4 + hh) * 64 + d]; cc += part[(w * 12 + 8 + hh) * 64 + d]; }
        ysd[tid] = siluf_(dgp[tid]) * (gsm[hh * 3] * a + gsm[hh * 3 + 1] * b + gsm[hh * 3 + 2] * cc); }
}
DI void ph_mix_sample(LAS unsigned char* lds_, int l) {
    const Ctx c = mkctx(lds_); const int tid = c.tid, lane = c.lane, wave = c.wave;
    const int b = c.bid - (c.G - 32);
    if (b < 0 || b >= 32) return;
    float* out = c.out;
    __syncthreads();
    const float* pr = WSF(WS_PROJS) + (size_t)b * NPD;
    LAS float* act = (LAS float*)c.lds;
    LAS float* red = act + 768;
    LAS float* ybl = red + 16;
    LAS float* sdt = ybl + 256;
    LAS float* nrow = sdt + 8;
    LAS float* gsm = nrow + 256;
    LAS float* wl = gsm + 16;
    float* ys = WSF(WS_YS) + (size_t)b * 1024;
    if (tid < 256) { const int ch = tid; const float* st = INP(I_SSC) + ((size_t)(l * NB + b) * 2) * 256; const float* scw = INP(I_SCW) + l * 768;
        const float u = pr[512 + ch] * pr[ch], p0 = st[ch], p1 = st[256 + ch]; const float y = scw[ch] * p0 + scw[256 + ch] * p1 + scw[512 + ch] * u;
        ys[ch] = siluf_(pr[768 + ch]) * pr[256 + ch] * y; float* so = out + O_SCS + ((size_t)(l * NB + b) * 2) * 256; so[ch] = p1; so[256 + ch] = u; }
    float uc = 0.f;
    if (tid >= 256) { const int ch = tid - 256; const float* st = INP(I_SCF) + (size_t)(l * NB + b) * 7680; const float* cfw = INP(I_CFW) + l * 31 * 256;
        const float glu = pr[2048 + ch] * sigmoidf_(pr[2304 + ch]); float u = INP(I_CFB)[l * 256 + ch]; float* so = out + O_CFS + (size_t)(l * NB + b) * 7680;
        for (int k = 0; k < 30; ++k) { const float pv = st[k * 256 + ch]; u += cfw[k * 256 + ch] * pv; if (k > 0) so[(k - 1) * 256 + ch] = pv; }
        u += cfw[30 * 256 + ch] * glu; so[29 * 256 + ch] = glu; uc = u; }
    { const float s1 = wsum(tid >= 256 ? uc : 0.f); if (lane == 0) red[wave] = s1; }
    __syncthreads();
    const float cmean = (red[4] + red[5] + red[6] + red[7]) * (1.f / 256.f);
    __syncthreads();
    { const float d = uc - cmean; const float s2 = wsum(tid >= 256 ? d * d : 0.f); if (lane == 0) red[wave] = s2; }
    __syncthreads();
    if (tid >= 256) { const int ch = tid - 256; const float var = (red[4] + red[5] + red[6] + red[7]) * (1.f / 256.f);
        const float ln = (uc - cmean) * rsqrtf(var + EPS) * INP(I_LNG)[l * 256 + ch] + INP(I_LNB)[l * 256 + ch];
        ys[512 + ch] = siluf_(pr[2560 + ch]) * siluf_(ln); }
    { const float* st = INP(I_SBC) + (size_t)(l * NB + b) * 2304; const float* cw = INP(I_BCW) + l * 4 * 768; const float* cb = INP(I_BCB) + l * 768; float* so = out + O_BCS + (size_t)(l * NB + b) * 2304;
        for (int ch = tid; ch < 768; ch += 512) { const float raw = pr[1280 + ch], p0 = st[ch], p1 = st[768 + ch], p2 = st[1536 + ch];
            act[ch] = siluf_(cb[ch] + cw[ch] * p0 + cw[768 + ch] * p1 + cw[1536 + ch] * p2 + cw[2304 + ch] * raw); so[ch] = p1; so[768 + ch] = p2; so[1536 + ch] = raw; }
        if (tid < 4) { const float dt = softplusf_(pr[3456 + tid] + INP(I_DTB)[l * 4 + tid]); sdt[tid] = dt; sdt[4 + tid] = __expf(dt * (-__expf(INP(I_ALOG)[l * 4 + tid]))); } }
    __syncthreads();
    { const float* h0 = INP(I_SSM) + (size_t)(l * NB + b) * 32768; float* ho = out + O_HS + (size_t)(l * NB + b) * 32768; const float* Dp = INP(I_SD) + l * 4;
        for (int row = wave; row < 256; row += 8) { const int hd = row >> 6, gq = hd >> 1; const float dt = sdt[hd], dA = sdt[4 + hd], xv = act[row]; float y = 0.f;
#pragma unroll
            for (int s2 = 0; s2 < 2; ++s2) { const int sidx = lane + 64 * s2; const float hn = dA * h0[row * 128 + sidx] + dt * xv * act[256 + gq * 128 + sidx]; ho[row * 128 + sidx] = hn; y += hn * act[512 + gq * 128 + sidx]; }
            y = wsum(y);
            if (lane == 0) ybl[row] = (y + Dp[hd] * xv) * siluf_(pr[1024 + row]); } }
    __syncthreads();
    { const float v = tid < 256 ? ybl[tid] : 0.f; const float s2 = wsum(v * v); if (lane == 0) red[8 + wave] = s2; }
    __syncthreads();
    if (tid < 256) { const float ss = red[8] + red[9] + red[10] + red[11]; ys[256 + tid] = ybl[tid] * rsqrtf(ss * (1.f / 256.f) + EPS) * INP(I_SNG)[l * 256 + tid]; }
    const float* qg = INP(I_QG) + l * 64; const float* kg = INP(I_KG) + l * 192;
    LAS float* qs = wl + 10496;
    if (wave < 4) { const float v = pr[2816 + wave * 64 + lane]; const float ss = wsum(v * v); qs[lane * 4 + wave] = v * rsqrtf(ss * (1.f / 64.f) + EPS) * qg[lane]; }
    else if (wave == 4) { const float v = pr[3072 + 128 + lane]; const float ss = wsum(v * v); nrow[lane] = v * rsqrtf(ss * (1.f / 64.f) + EPS) * kg[64 + lane]; nrow[64 + lane] = pr[3072 + 192 + lane]; }
    else if (wave == 5) { const float v = pr[3072 + 256 + lane]; const float ss = wsum(v * v); nrow[128 + lane] = v * rsqrtf(ss * (1.f / 64.f) + EPS) * kg[128 + lane]; nrow[192 + lane] = pr[3072 + 320 + lane]; }
    else if (wave == 6) { if (lane < 12) gsm[lane] = sigmoidf_(pr[3460 + lane]); }
    __syncthreads();
    const float* cache_win = INP(I_CWIN) + (size_t)(l * NB + b) * 512 * 128;
    { float* ko = out + O_KVS + (size_t)(l * NB + b) * 256;
        if (tid < 128) ko[tid] = pr[3072 + tid]; else if (tid < 192) ko[tid] = nrow[tid - 128]; else if (tid < 256) ko[tid] = nrow[64 + tid - 192];
        float* wo = out + O_WINS + (size_t)(l * NB + b) * 512 * 128;
        for (int e = tid; e < 511 * 128; e += 512) wo[e] = cache_win[128 + e];
        if (tid < 64) wo[511 * 128 + tid] = nrow[128 + tid]; else if (tid < 128) wo[511 * 128 + tid] = nrow[192 + tid - 64]; }
    float* nrp = WSF(WS_NRG) + (size_t)(l * NB + b) * 256;
    if (tid < 256) nrp[tid] = nrow[tid];
    asm volatile("s_waitcnt vmcnt(0)" ::: "memory");
    __syncthreads();
    {
        SampleKV kv{INP(I_CKV) + (size_t)l * NPOOL * 128 * 256, (const int*)c.ap->in[I_PT] + b * 128, cache_win, nrp, nrp + 64, nrp + 128, nrp + 192};
        nsa_sample_block(wl, WSF(WS_KCS) + (size_t)(l * NB + b) * 1024 * 64, WSF(WS_VCS) + (size_t)(l * NB + b) * 1024 * 64, kv, gsm, pr + 3584, ys + 768, tid, lane, wave);
    }
    edge_publish((unsigned*)(c.ws + WS_CTL + 18432) + l * 64);
    __syncthreads();
}
DI void ph_scan(LAS unsigned char* lds_, int l) {
    const Ctx c = mkctx(lds_);
    if (c.bid >= 64) return;
    const float* CST = WSF(WS_CST); float* HPV = WSF(WS_HPV); const float* CDEC = WSF(WS_CDEC);
    const int e = c.bid * 512 + c.tid, hd = e >> 13; float hc = 0.f;
#pragma unroll 8
    for (int ch = 0; ch < 128; ++ch) { const float sv = CST[(size_t)ch * 32768 + e]; HPV[(size_t)ch * 32768 + e] = hc; hc = CDEC[ch * 4 + hd] * hc + sv; }
    c.out[O_HP + (size_t)l * 32768 + e] = hc;
    edge_publish((unsigned*)(c.ws + WS_CTL + 17408) + l * 64);
}
DI f16x8 pack_p(const f32x4& a, const f32x4& b) { f16x8 r; r[0] = (f16)a[0]; r[1] = (f16)a[1]; r[2] = (f16)a[2]; r[3] = (f16)a[3]; r[4] = (f16)b[0]; r[5] = (f16)b[1]; r[6] = (f16)b[2]; r[7] = (f16)b[3]; return r; }
DI f16x8 ld_vt(const f16* p) { const f16x4 a = *(const f16x4*)p, b = *(const f16x4*)(p + 16); f16x8 r; r[0] = a[0]; r[1] = a[1]; r[2] = a[2]; r[3] = a[3]; r[4] = b[0]; r[5] = b[1]; r[6] = b[2]; r[7] = b[3]; return r; }
constexpr int NT_PSEL = 0  , NT_STG = 32768  , NT_STG_SZ = 18432 + 17408,
              NT_RING = 0  , NT_MASK = 131072  , NT_VB = NT_MASK + 1088  , NT_MT = NT_VB + 1088  , NT_END = NT_MT + 1088;
static_assert(NT_STG + 2 * NT_STG_SZ <= NT_MASK, "nsa tile LDS map");
static_assert(NT_END <= MISC_OFF, "nsa tile LDS map");
struct StgRegs { f16x8 k0, k1, v0, v1; };
template <bool WITH_V, class KSrc, class VSrc>
DI void stg_load(StgRegs& rg, int ch, int tid, const KSrc& ksrc, const VSrc& vsrc) {
    const f16* kp = ksrc(ch, tid >> 2) + (tid & 3) * 16; rg.k0 = ld_h8(kp); rg.k1 = ld_h8(kp + 8);
    if (WITH_V) { const f16* vp = vsrc(ch, tid >> 3, tid & 7); rg.v0 = ld_h8(vp); rg.v1 = ld_h8(vp + 8); }
}
template <bool WITH_V>
DI void stg_store(const StgRegs& rg, LAS unsigned char* buf, int tid) {
    LAS f16* kb = (LAS f16*)buf + (tid >> 2) * 72 + (tid & 3) * 16; *(LAS f16x8*)kb = rg.k0; *(LAS f16x8*)(kb + 8) = rg.k1;
    if (WITH_V) { LAS f16* vb = (LAS f16*)(buf + 18432) + (tid >> 3) * 136 + (tid & 7) * 16; *(LAS f16x8*)vb = rg.v0; *(LAS f16x8*)(vb + 8) = rg.v1; }
}
template <bool WITH_V, class KSrc, class VSrc, class Body>
DI void stream_chunks(LAS unsigned char* stg, int nchunk, int tid, const KSrc& ksrc, const VSrc& vsrc, Body body) {
    if (nchunk <= 0) return;
    const int last = nchunk - 1;
    StgRegs rg;
    stg_load<WITH_V>(rg, 0, tid, ksrc, vsrc);
    __syncthreads();
    stg_store<WITH_V>(rg, stg, tid); stg_load<WITH_V>(rg, 1 < last ? 1 : last, tid, ksrc, vsrc);
    lds_barrier();
#pragma nounroll
    for (int ch = 0; ch < nchunk; ++ch) {
        body(ch, stg + (ch & 1) * NT_STG_SZ);
        stg_store<WITH_V>(rg, stg + ((ch + 1) & 1) * NT_STG_SZ, tid); stg_load<WITH_V>(rg, ch + 2 < last ? ch + 2 : last, tid, ksrc, vsrc);
        lds_barrier();
    }
}
DI f16x8 lds_vt(const LAS f16* p) { return *(const LAS f16x8*)p; }
DI f32x4 qk_tile(const LAS f16* kb, int kt, int fr, int q, const f16x8 (&qf)[2]) {
    const LAS f16* kp = kb + (16 * kt + fr) * 72 + 8 * q; f32x4 sa = (f32x4){0.f, 0.f, 0.f, 0.f};
    sa = __builtin_amdgcn_mfma_f32_16x16x32_f16(*(const LAS f16x8*)kp, qf[0], sa, 0, 0, 0); return __builtin_amdgcn_mfma_f32_16x16x32_f16(*(const LAS f16x8*)(kp + 32), qf[1], sa, 0, 0, 0);
}
constexpr float NSA_L2E = 1.44269504f, NSA_C1 = 0.125f * NSA_L2E;
DI float ex2(float x) { return __builtin_amdgcn_exp2f(x); }
template <class Pred>
DI f16x8 pv_step(const LAS f16* kb, const LAS f16* vb, int st, int fr, int q, const f16x8 (&qf)[2], f32x4 (&o)[4], f32x4 (&e2)[2], float nb, bool masked, Pred pred) {
#pragma unroll
    for (int hf = 0; hf < 2; ++hf) { const f32x4 sa = qk_tile(kb, 2 * st + hf, fr, q, qf);
        if (!masked) {
#pragma unroll
            for (int j = 0; j < 4; ++j) e2[hf][j] = ex2(fmaf(sa[j], NSA_C1, nb)); }
        else {
#pragma unroll
            for (int j = 0; j < 4; ++j) e2[hf][j] = pred(32 * st + 16 * hf + 4 * q + j) ? ex2(fmaf(sa[j], NSA_C1, nb)) : 0.f; } }
    const f16x8 pb = pack_p(e2[0], e2[1]);
#pragma unroll
    for (int dt = 0; dt < 4; ++dt) o[dt] = __builtin_amdgcn_mfma_f32_16x16x32_f16(lds_vt(vb + (16 * dt + fr) * 136 + 32 * st + 8 * q), pb, o[dt], 0, 0, 0);
    return pb;
}
DI void nsa_tile(const Ctx& c, int tile, const f16* Q16, const f16* KC16, const f16* VCT16, const f16* KS16, const f16* VST16, const f16* KW16, const f16* VWT16,
                 const float* GATES, const f16* DG, f16* Y16, float shc, float shs, float shw) {
    LAS unsigned char* lds = c.lds; const int wave = c.wave; int tid, lane, fr, q, ti, h, trow;
    const int t0 = tile * 32, cur = t0 >> 6;
#define NSA_RELANE() do { int _t = c.tid; asm volatile("" : "+v"(_t)); tid = _t; lane = _t & 63; fr = lane & 15; q = lane >> 4; ti = fr >> 2; h = fr & 3; trow = t0 + 4 * wave + ti; } while (0)
#define NSA_REPS(bit) (((NSA_DUP >> (bit)) & 1) ? 2 : 1)
#define NSA_SCALE(rep) ({ float _z = (rep) == 0 ? 1.f : 0.f; asm volatile("" : "+v"(_z)); _z; })
    NSA_RELANE();
    LAS float* PSEL = (LAS float*)(lds + NT_PSEL); LAS unsigned* MASK = (LAS unsigned*)(lds + NT_MASK); LAS int* VB = (LAS int*)(lds + NT_VB); LAS unsigned char* STG = lds + NT_STG;
    __syncthreads();
    for (int i = tid; i < 272; i += 512) MASK[i] = (i == 0 || i == cur || i == cur - 1) ? 0xFFFFFFFFu : 0u;
    f16x8 qf[2];
#pragma unroll
    for (int ks = 0; ks < 2; ++ks) qf[ks] = ld_h8(Q16 + ((size_t)trow * 4 + h) * 64 + 32 * ks + 8 * q);
    const int nkt = ((t0 >> 4) + 1 + 15) >> 4;
    const int ncch = (nkt + 7) >> 3;
    const int nv_row = trow >= 31 ? ((trow - 31) >> 4) + 1 : 0;
    auto kc_src = [&](int ch, int row) { return KC16 + (size_t)(128 * ch + row) * 64; };
    auto vc_src = [&](int ch, int d, int seg) { return VCT16 + (size_t)d * 1024 + 128 * ch + seg * 16; };
    float lsum = 0.f;
    const float bc = -shc * NSA_L2E, bs = -shs * NSA_L2E, bw = -shw * NSA_L2E;
    const int tw0 = t0 + 4 * wave, nvmin_w = tw0 >= 31 ? ((tw0 - 31) >> 4) + 1 : 0;
    stream_chunks<false>(STG, ncch, tid, kc_src, vc_src, [&](int ch, LAS unsigned char* buf) {
        const LAS f16* kb = (const LAS f16*)buf; const int nk = nkt - 8 * ch < 8 ? nkt - 8 * ch : 8;
#pragma unroll 4
        for (int kt = 0; kt < nk; ++kt) { const f32x4 sa = qk_tile(kb, kt, fr, q, qf); const int cb = 128 * ch + 16 * kt + 4 * q;
            if (128 * ch + 16 * kt + 15 < nvmin_w) {
#pragma unroll
                for (int j = 0; j < 4; ++j) lsum += ex2(fmaf(sa[j], NSA_C1, bc)); }
            else {
#pragma unroll
                for (int j = 0; j < 4; ++j) lsum += (cb + j < nv_row) ? ex2(fmaf(sa[j], NSA_C1, bc)) : 0.f; } } });
    lsum += __shfl_xor(lsum, 16); lsum += __shfl_xor(lsum, 32);
    const float invc = lsum > 0.f ? 1.f / lsum : 0.f;
    NSA_RELANE();
    f32x4 oc[4];
#pragma unroll
    for (int dt = 0; dt < 4; ++dt) oc[dt] = (f32x4){0.f, 0.f, 0.f, 0.f};
    { float bprev = 0.f; const float pbias = invc > 0.f ? bc + __log2f(invc) : -1e30f;
    stream_chunks<true>(STG, ncch, tid, kc_src, vc_src, [&](int ch, LAS unsigned char* buf) {
        const LAS f16* kb = (const LAS f16*)buf; const LAS f16* vb = (const LAS f16*)(buf + 18432); const int ns = (nkt - 8 * ch + 1) >> 1 < 4 ? (nkt - 8 * ch + 1) >> 1 : 4;
#pragma unroll 2
        for (int s2 = 0; s2 < ns; ++s2) {
            f32x4 e2[2];
            pv_step(kb, vb, s2, fr, q, qf, oc, e2, pbias, 128 * ch + 32 * s2 + 31 >= nvmin_w, [&](int kc) { return 128 * ch + kc < nv_row; });
#pragma unroll
            for (int hf = 0; hf < 2; ++hf) {
                const int ktg = 8 * ch + 2 * s2 + hf;
                float av = (e2[hf][0] + e2[hf][1]) + (e2[hf][2] + 0.5f * e2[hf][3]), bv = 0.5f * e2[hf][3];
                av += dppf<DPP_X1>(av); av += dppf<DPP_X2>(av); bv += dppf<DPP_X1>(bv); bv += dppf<DPP_X2>(bv);
                const float up = __shfl(q == 3 ? bprev : bv, (lane + 48) & 63);
                bprev = bv;
                if (h == 0 && ktg < nkt) PSEL[(4 * wave + ti) * 256 + 4 * ktg + q] = av + up;
            }
        } }); }
    for (int rep = 0; rep < NSA_REPS(2); ++rep) {
        const int nforced = cur >= 2 ? 3 : cur + 1, nsel = ((cur + 1) < 16 ? (cur + 1) : 16) - nforced, tk = lane >> 4, l16 = lane & 15, tokl = 4 * wave + tk;
        float sv[16];
#pragma unroll
        for (int i = 0; i < 16; ++i) { const int j = l16 + 16 * i; float v = -3e38f;
            if (j <= cur && !(j == 0 || j == cur || j == cur - 1)) v = j < 4 * nkt ? PSEL[tokl * 256 + j] : 0.f;
            sv[i] = v; }
#pragma nounroll
        for (int k = 0; k < nsel; ++k) {
            float bv = sv[0]; int bi = l16;
#pragma unroll
            for (int i = 1; i < 16; ++i) if (sv[i] > bv) { bv = sv[i]; bi = l16 + 16 * i; }
#define TOPK_STEP(CT) do { const float ov = dppf<CT>(bv); const int oi = dppi<CT>(bi); if (ov > bv || (ov == bv && oi < bi)) { bv = ov; bi = oi; } } while (0)
            TOPK_STEP(DPP_X1); TOPK_STEP(DPP_X2); TOPK_STEP(DPP_HM); TOPK_STEP(DPP_R8);
#undef TOPK_STEP
            if (l16 == 0) __hip_atomic_fetch_or(&MASK[bi], 1u << tokl, __ATOMIC_RELAXED, __HIP_MEMORY_SCOPE_WORKGROUP);
#pragma unroll
            for (int i = 0; i < 16; ++i) if (l16 + 16 * i == bi) sv[i] = -3e38f;
        }
    }
    NSA_RELANE();
    f32x4 owr[4]; float lwr = 0.f;
#pragma unroll
    for (int dt = 0; dt < 4; ++dt) owr[dt] = (f32x4){0.f, 0.f, 0.f, 0.f};
    f16x8 onesf;
#pragma unroll
    for (int i = 0; i < 8; ++i) onesf[i] = fr == 0 ? (f16)1.f : (f16)0.f;
    f32x4 lw5 = (f32x4){0.f, 0.f, 0.f, 0.f};
    {
        const int wlo = t0 - 512 > 0 ? t0 - 512 : 0, nwch = (t0 + 32 - wlo + 127) >> 7;
        auto kw_src = [&](int ch, int row) { int p = wlo + 128 * ch + row; p = p < SEQ ? p : SEQ - 1; return KW16 + (size_t)p * 64; };
        auto vw_src = [&](int ch, int d, int seg) { const int key = wlo + 128 * ch + seg * 16; int blk = key >> 6; blk = blk < 256 ? blk : 255; return VWT16 + (size_t)blk * 4096 + d * 64 + (key & 63); };
        {
        stream_chunks<true>(STG, nwch, tid, kw_src, vw_src, [&](int ch, LAS unsigned char* buf) {
            const LAS f16* kb = (const LAS f16*)buf; const LAS f16* vb = (const LAS f16*)(buf + 18432); const int pbase = wlo + 128 * ch;
            const int ns = (t0 + 32 - pbase) >> 5 < 4 ? (t0 + 32 - pbase) >> 5 : 4;
#pragma unroll 2
            for (int s2 = 0; s2 < ns; ++s2) { f32x4 e2[2];
                const int p0s = pbase + 32 * s2; const bool masked = !(p0s >= tw0 + 3 - 512 && p0s + 31 <= tw0);
                const f16x8 pb = pv_step(kb, vb, s2, fr, q, qf, owr, e2, bw, masked, [&](int kc) { const int pos = pbase + kc; return pos <= trow && pos >= trow - 512; });
                lw5 = __builtin_amdgcn_mfma_f32_16x16x32_f16(onesf, pb, lw5, 0, 0, 0); } }); }
        lwr = lw5[0];
    }
    NSA_RELANE();
    LAS unsigned* MT = (LAS unsigned*)(lds + NT_MT);
    if (wave == 0) { int cnt = 0;
        for (int base = 0; base <= cur; base += 64) { const int jx = base + lane; const unsigned mj = jx <= cur ? MASK[jx] : 0u; const bool v = mj != 0u; const unsigned long long bal = __ballot(v);
            if (v) { const int pos = cnt + __popcll(bal & ((1ull << lane) - 1ull)); VB[pos] = jx; MT[pos] = mj; } cnt += __popcll(bal); }
        if (lane < 8) { VB[cnt + lane] = VB[cnt - 1]; MT[cnt + lane] = 0u; }
        if (lane == 0) VB[264] = cnt; }
    __syncthreads();
    if (VERIFY_NSA) { unsigned* SELM = (unsigned*)(c.ws + WS_SELM) + (size_t)tile * 272; for (int i = tid; i < 272; i += 512) SELM[i] = MASK[i]; }
    f32x4 osr[4]; float lsr = 0.f; f32x4 ls5 = (f32x4){0.f, 0.f, 0.f, 0.f};
#pragma unroll
    for (int dt = 0; dt < 4; ++dt) osr[dt] = (f32x4){0.f, 0.f, 0.f, 0.f};
#pragma unroll
    for (int i = 0; i < 8; ++i) onesf[i] = fr == 0 ? (f16)1.f : (f16)0.f;
    {
        const int nvb = __builtin_amdgcn_readfirstlane(VB[264]), nst = (nvb + 3) >> 2;
        const int dr = lane >> 3, dp = lane & 7, dsw = (dp ^ dr) * 8;
        LAS unsigned char* RING = lds + NT_RING;
        auto dma = [&](int n, int blk) { LAS unsigned char* slot = RING + (n & 7) * 16384 + wave * 1024;
            __builtin_amdgcn_global_load_lds((const unsigned*)(KS16 + ((size_t)blk * 64 + 8 * wave + dr) * 64 + dsw), (LAS unsigned*)slot, 16, 0, 0);
            __builtin_amdgcn_global_load_lds((const unsigned*)(VST16 + (size_t)blk * 4096 + (8 * wave + dr) * 64 + dsw), (LAS unsigned*)(slot + 8192), 16, 0, 0); };
        {
        asm volatile("s_waitcnt vmcnt(0)" ::: "memory"); __syncthreads();
        typedef int i32x4 __attribute__((ext_vector_type(4)));
#define RFL4(v) { __builtin_amdgcn_readfirstlane((v)[0]), __builtin_amdgcn_readfirstlane((v)[1]), __builtin_amdgcn_readfirstlane((v)[2]), __builtin_amdgcn_readfirstlane((v)[3]) }
        { const i32x4 b0 = *(const LAS i32x4*)VB; const int bb[4] = RFL4(b0); dma(0, bb[0]); dma(1, bb[1]); dma(2, bb[2]); dma(3, bb[3]); }
#pragma nounroll
        for (int st = 0; st < nst; ++st) {
            asm volatile("s_waitcnt vmcnt(0)\n\ts_barrier" ::: "memory");
            const i32x4 bcv = *(const LAS i32x4*)(VB + 4 * st), bnv = *(const LAS i32x4*)(VB + 4 * st + 4); const u32x4 mcv = *(const LAS u32x4*)(MT + 4 * st);
            const int bcur[4] = RFL4(bcv), bnxt[4] = RFL4(bnv); const int mcur[4] = RFL4(mcv);
            dma(4 * st + 4, bnxt[0]); dma(4 * st + 5, bnxt[1]); dma(4 * st + 6, bnxt[2]); dma(4 * st + 7, bnxt[3]);
#pragma unroll
            for (int i4 = 0; i4 < 4; ++i4) {
            const int n = 4 * st + i4;
            const int blk = bcur[i4]; const unsigned mt = ((unsigned)mcur[i4] >> (4 * wave)) & 15u;
            if (mt != 0u) {
                const bool rv = ((mt >> ti) & 1u) != 0u; const LAS unsigned char* ks = RING + (n & 7) * 16384; const LAS unsigned char* vs = ks + 8192; const int sx = fr & 7;
                f32x4 sa[4]; f16x8 va[2][4];
#pragma unroll
                for (int kt = 0; kt < 4; ++kt) { const LAS unsigned char* kp = ks + (16 * kt + fr) * 128; sa[kt] = (f32x4){0.f, 0.f, 0.f, 0.f};
                    sa[kt] = __builtin_amdgcn_mfma_f32_16x16x32_f16(*(const LAS f16x8*)(kp + ((q ^ sx) << 4)), qf[0], sa[kt], 0, 0, 0);
                    sa[kt] = __builtin_amdgcn_mfma_f32_16x16x32_f16(*(const LAS f16x8*)(kp + (((4 + q) ^ sx) << 4)), qf[1], sa[kt], 0, 0, 0); }
#pragma unroll
                for (int s2 = 0; s2 < 2; ++s2)
#pragma unroll
                    for (int dt = 0; dt < 4; ++dt) va[s2][dt] = *(const LAS f16x8*)(vs + (16 * dt + fr) * 128 + (((4 * s2 + q) ^ sx) << 4));
                const float nbu = rv ? bs : -1e30f;
                if (blk != cur) {
#pragma unroll
                    for (int kt = 0; kt < 4; ++kt)
#pragma unroll
                        for (int j = 0; j < 4; ++j) sa[kt][j] = ex2(fmaf(sa[kt][j], NSA_C1, nbu)); }
                else { const int pb0 = 64 * blk + 4 * q;
#pragma unroll
                    for (int kt = 0; kt < 4; ++kt)
#pragma unroll
                        for (int j = 0; j < 4; ++j) sa[kt][j] = (pb0 + 16 * kt + j <= trow) ? ex2(fmaf(sa[kt][j], NSA_C1, nbu)) : 0.f; }
                const f16x8 p0 = pack_p(sa[0], sa[1]), p1 = pack_p(sa[2], sa[3]);
#pragma unroll
                for (int dt = 0; dt < 4; ++dt) { osr[dt] = __builtin_amdgcn_mfma_f32_16x16x32_f16(va[0][dt], p0, osr[dt], 0, 0, 0); osr[dt] = __builtin_amdgcn_mfma_f32_16x16x32_f16(va[1][dt], p1, osr[dt], 0, 0, 0); }
                ls5 = __builtin_amdgcn_mfma_f32_16x16x32_f16(onesf, p0, ls5, 0, 0, 0); ls5 = __builtin_amdgcn_mfma_f32_16x16x32_f16(onesf, p1, ls5, 0, 0, 0);
            }
            }
        }
        asm volatile("s_waitcnt vmcnt(0)" ::: "memory"); }
        __syncthreads();
        lsr = ls5[0];
    }
    NSA_RELANE();
    lwr += __shfl_xor(lwr, 16); lwr += __shfl_xor(lwr, 32); lsr += __shfl_xor(lsr, 16); lsr += __shfl_xor(lsr, 32);
    {
        const float g0 = GATES[(size_t)trow * 12 + h * 3], ils = GATES[(size_t)trow * 12 + h * 3 + 1] / lsr, ilw = GATES[(size_t)trow * 12 + h * 3 + 2] / lwr;
#pragma unroll
        for (int dt = 0; dt < 4; ++dt) { const int d0 = 16 * dt + 4 * q; const f16x4 dg = *(const f16x4*)(DG + (size_t)trow * 256 + h * 64 + d0); f16x4 y;
#pragma unroll
            for (int jj = 0; jj < 4; ++jj) { const float o = g0 * oc[dt][jj] + ils * osr[dt][jj] + ilw * owr[dt][jj]; y[jj] = (f16)(siluf_((float)dg[jj]) * o); }
            *(f16x4*)(Y16 + (size_t)trow * 1024 + 768 + h * 64 + d0) = y; }
    }
#undef NSA_RELANE
}
DI void ph_ssd_fin(LAS unsigned char* lds_, int l, int it0, int it1, int itstep);
DI void ph_outproj_sample(LAS unsigned char* lds_, int l, int it);
DI void ph_nsa(LAS unsigned char* lds_, int l) {
    const Ctx c = mkctx(lds_); const int lane = c.lane;
    const float* qg = INP(I_QG) + l * 64; const float* kg = INP(I_KG) + l * 192;
    const float mq = wmaxf(fabsf(qg[lane])), mk0 = wmaxf(fabsf(kg[lane])), mk1 = wmaxf(fabsf(kg[64 + lane])), mk2 = wmaxf(fabsf(kg[128 + lane]));
    const float shc = 8.f * mq * mk0 - 8.f, shs = 8.f * mq * mk1 - 8.f, shw = 8.f * mq * mk2 - 8.f;
    unsigned* qctr = (unsigned*)(c.ws + WS_CTL + 16384) + l * 64; LAS int* qslot = (LAS int*)(c.lds + MISC_OFF + 64); bool fin_ok = false, smp_ok = false;
    for (;;) {
        __syncthreads();
        if (c.tid == 0) *qslot = (int)__hip_atomic_fetch_add(qctr, 1u, __ATOMIC_RELAXED, __HIP_MEMORY_SCOPE_AGENT);
        __syncthreads();
        const int u = __builtin_amdgcn_readfirstlane(*qslot);
        if (u >= 800) break;
        if (u < 512) nsa_tile(c, 511 - u, WSH(WS_Q16), WSH(WS_KC16), WSH(WS_VCT16), WSH(WS_KS16), WSH(WS_VST16), WSH(WS_KW16), WSH(WS_VWT16), WSF(WS_GATES), WSH(WS_PROJ) + (size_t)14 * SEQ * 256, WSH(WS_Y16), shc, shs, shw);
        else if (u < 768) { if (!fin_ok) { edge_wait((unsigned*)(c.ws + WS_CTL + 17408) + l * 64, 64u); fin_ok = true; } ph_ssd_fin(lds_, l, u - 512, u - 511, 1); }
        else { if (!smp_ok) { edge_wait((unsigned*)(c.ws + WS_CTL + 18432) + l * 64, 32u); smp_ok = true; } ph_outproj_sample(lds_, l, u - 768); }
    }
    __syncthreads();
}
DI void ph_nsa_verify(LAS unsigned char* lds_, int l) {
    const Ctx c = mkctx(lds_); const int lane = c.lane;
    LAS float* wl = (LAS float*)c.lds + c.wave * 4400; LAS float* sc = wl; LAS float* qs = wl + 4096; LAS unsigned* selb = (LAS unsigned*)(wl + 4352);
    const f16* Q16 = WSH(WS_Q16); const f16* KC16 = WSH(WS_KC16); const f16* VCT16 = WSH(WS_VCT16); const f16* KS16 = WSH(WS_KS16); const f16* VST16 = WSH(WS_VST16); const f16* KW16 = WSH(WS_KW16); const f16* VWT16 = WSH(WS_VWT16);
    const float* GATES = WSF(WS_GATES); const f16* DG = WSH(WS_PROJ) + (size_t)14 * SEQ * 256; const f16* Y16 = WSH(WS_Y16); const unsigned* SELM = (const unsigned*)(c.ws + WS_SELM);
    float* dbg = (float*)(c.ws + WS_CTL + 40960);
    auto dot4 = [&](const f16* kp, float (&s4)[4]) { s4[0] = s4[1] = s4[2] = s4[3] = 0.f;
#pragma unroll
        for (int i = 0; i < 8; ++i) { const f16x8 kv = ld_h8(kp + 8 * i);
#pragma unroll
            for (int j = 0; j < 8; ++j) { const f32x4 qv = *(const LAS f32x4*)(qs + (8 * i + j) * 4); const float kf = (float)kv[j]; s4[0] += qv[0] * kf; s4[1] += qv[1] * kf; s4[2] += qv[2] * kf; s4[3] += qv[3] * kf; } }
#pragma unroll
        for (int hh = 0; hh < 4; ++hh) s4[hh] *= 0.125f; };
    for (int si = c.bid * 8 + c.wave; si < 200 + 395; si += c.G * 8) {
        const int t = si < 200 ? si : 200 + (si - 200) * 41, cur = t >> 6, ncv = t >= 31 ? ((t - 31) >> 4) + 1 : 0;
#pragma unroll
        for (int hh = 0; hh < 4; ++hh) qs[lane * 4 + hh] = (float)Q16[(size_t)t * 256 + hh * 64 + lane];
        if (lane < 9) selb[lane] = 0u;
        float oc[4] = {0.f, 0.f, 0.f, 0.f}, os[4] = {0.f, 0.f, 0.f, 0.f}, ow[4] = {0.f, 0.f, 0.f, 0.f};
        {
            float mx[4] = {-3e38f, -3e38f, -3e38f, -3e38f}, inv[4];
            for (int cc = lane; cc < ncv; cc += 64) { asm volatile("" ::: "memory"); float s4[4]; dot4(KC16 + (size_t)cc * 64, s4);
#pragma unroll
                for (int hh = 0; hh < 4; ++hh) { sc[hh * 1024 + cc] = s4[hh]; mx[hh] = fmaxf(mx[hh], s4[hh]); } }
#pragma unroll
            for (int hh = 0; hh < 4; ++hh) { mx[hh] = wmaxf(mx[hh]); float sm = 0.f; for (int cc = lane; cc < ncv; cc += 64) { const float e = __expf(sc[hh * 1024 + cc] - mx[hh]); sc[hh * 1024 + cc] = e; sm += e; } sm = wsum(sm); inv[hh] = ncv > 0 ? 1.f / sm : 0.f; }
            for (int cc = lane; cc < ncv; cc += 64) {
#pragma unroll
                for (int hh = 0; hh < 4; ++hh) sc[hh * 1024 + cc] *= inv[hh]; }
            for (int cc = 0; cc < ncv; ++cc) { const float v = (float)VCT16[(size_t)lane * 1024 + vt_pos(cc)];
#pragma unroll
                for (int hh = 0; hh < 4; ++hh) oc[hh] += sc[hh * 1024 + cc] * v; }
        }
        const int nsel = (cur + 1) < 16 ? (cur + 1) : 16;
        {
            float scv[5];
#pragma unroll
            for (int i = 0; i < 5; ++i) { const int j = lane + 64 * i; float v = -3e38f;
                if (j <= cur) { if (j == 0 || j == cur || j == cur - 1) v = 3e38f; else { float a = 0.f;
#pragma unroll
                        for (int o5 = -1; o5 < 4; ++o5) { const int cc = 4 * j + o5; if (cc >= 0 && cc < ncv) { const float p = (sc[cc] + sc[1024 + cc]) + (sc[2048 + cc] + sc[3072 + cc]); a += (o5 == -1 || o5 == 3) ? 0.5f * p : p; } }
                        v = a; } }
                scv[i] = v; }
            for (int k = 0; k < nsel; ++k) {
                float bv = scv[0]; int bi = lane;
#pragma unroll
                for (int i = 1; i < 5; ++i) if (scv[i] > bv) { bv = scv[i]; bi = lane + 64 * i; }
#pragma unroll
                for (int off = 32; off > 0; off >>= 1) { const float ov = __shfl_xor(bv, off); const int oi = __shfl_xor(bi, off); if (ov > bv || (ov == bv && oi < bi)) { bv = ov; bi = oi; } }
                if (lane == 0) selb[bi >> 5] |= 1u << (bi & 31);
#pragma unroll
                for (int i = 0; i < 5; ++i) if (lane + 64 * i == bi) scv[i] = -3e38f;
            }
        }
        int nmis = 0;
        for (int j = lane; j <= cur; j += 64) { const unsigned fb = (SELM[(size_t)(t >> 5) * 272 + j] >> (t & 31)) & 1u, nb = (selb[j >> 5] >> (j & 31)) & 1u; nmis += (fb != nb) ? 1 : 0; }
        nmis = (int)wsum((float)nmis);
        if (nmis != 0) { if (lane == 0) { atomicAdd(dbg + 3, 1.f); atomicAdd(dbg + 4, (float)nmis); } continue; }
        {
            float mx[4] = {-3e38f, -3e38f, -3e38f, -3e38f}, inv[4]; int nk = 0;
            for (int j = 0; j <= cur; ++j) if ((selb[j >> 5] >> (j & 31)) & 1u) { asm volatile("" ::: "memory"); const int pos = j * 64 + lane; float s4[4] = {-1e30f, -1e30f, -1e30f, -1e30f}; if (pos <= t) dot4(KS16 + (size_t)pos * 64, s4);
#pragma unroll
                for (int hh = 0; hh < 4; ++hh) { sc[hh * 1024 + nk * 64 + lane] = s4[hh]; mx[hh] = fmaxf(mx[hh], s4[hh]); } ++nk; }
#pragma unroll
            for (int hh = 0; hh < 4; ++hh) { mx[hh] = wmaxf(mx[hh]); float sm = 0.f; for (int k = 0; k < nk; ++k) { const float x = sc[hh * 1024 + k * 64 + lane]; const float e = x > -1e29f ? __expf(x - mx[hh]) : 0.f; sc[hh * 1024 + k * 64 + lane] = e; sm += e; } sm = wsum(sm); inv[hh] = 1.f / sm; }
            nk = 0;
            for (int j = 0; j <= cur; ++j) if ((selb[j >> 5] >> (j & 31)) & 1u) { for (int kk = 0; kk < 64 && j * 64 + kk <= t; ++kk) { const float v = (float)VST16[(size_t)j * 4096 + lane * 64 + vt_pos(kk)];
#pragma unroll
                    for (int hh = 0; hh < 4; ++hh) os[hh] += sc[hh * 1024 + nk * 64 + kk] * v; } ++nk; }
#pragma unroll
            for (int hh = 0; hh < 4; ++hh) os[hh] *= inv[hh];
        }
        {
            const int lo = t - 512 > 0 ? t - 512 : 0, nw = t - lo + 1; float mx[4] = {-3e38f, -3e38f, -3e38f, -3e38f}, inv[4];
            for (int i = lane; i < nw; i += 64) { asm volatile("" ::: "memory"); float s4[4]; dot4(KW16 + (size_t)(lo + i) * 64, s4);
#pragma unroll
                for (int hh = 0; hh < 4; ++hh) { sc[hh * 1024 + i] = s4[hh]; mx[hh] = fmaxf(mx[hh], s4[hh]); } }
#pragma unroll
            for (int hh = 0; hh < 4; ++hh) { mx[hh] = wmaxf(mx[hh]); float sm = 0.f; for (int i = lane; i < nw; i += 64) { const float e = __expf(sc[hh * 1024 + i] - mx[hh]); sc[hh * 1024 + i] = e; sm += e; } sm = wsum(sm); inv[hh] = 1.f / sm; }
            for (int i = 0; i < nw; ++i) { const int pos = lo + i; const float v = (float)VWT16[(size_t)(pos >> 6) * 4096 + lane * 64 + vt_pos(pos & 63)];
#pragma unroll
                for (int hh = 0; hh < 4; ++hh) ow[hh] += sc[hh * 1024 + i] * v; }
#pragma unroll
            for (int hh = 0; hh < 4; ++hh) ow[hh] *= inv[hh];
        }
        float dd = 0.f, ee = 0.f;
#pragma unroll
        for (int hh = 0; hh < 4; ++hh) { const float o = GATES[(size_t)t * 12 + hh * 3] * oc[hh] + GATES[(size_t)t * 12 + hh * 3 + 1] * os[hh] + GATES[(size_t)t * 12 + hh * 3 + 2] * ow[hh];
            const float yn = siluf_((float)DG[(size_t)t * 256 + hh * 64 + lane]) * o, yf = (float)Y16[(size_t)t * 1024 + 768 + hh * 64 + lane]; dd += (yf - yn) * (yf - yn); ee += yn * yn; }
        dd = wsum(dd); ee = wsum(ee);
        if (lane == 0) { atomicAdd(dbg, dd); atomicAdd(dbg + 1, ee); atomicAdd(dbg + 2, 1.f); }
    }
    (void)l;
}
DI void ph_ssd_fin(LAS unsigned char* lds_, int l, int it0, int it1, int itstep) {
    const Ctx c = mkctx(lds_); const int lane = c.lane, wave = c.wave;
    const float* Dp = INP(I_SD) + l * 4; const float* sng = INP(I_SNG) + l * 256;
    const float* CST = WSF(WS_HPV); const f16* ACT = WSH(WS_ACT); const float* ACS = WSF(WS_ACS); const float* YD = WSF(WS_YD); const f16* Z = WSH(WS_PROJ) + (size_t)4 * SEQ * 256; f16* Y16 = WSH(WS_Y16);
    LAS float* GY = (LAS float*)c.lds;
    for (int it = it0; it < it1; it += itstep) {
        const int ch_ = it >> 1, t0 = it * 64, hd = wave >> 1, g = hd >> 1, fr = lane & 15, q = lane >> 4;
        __syncthreads();
        f16x8 bf[2][4];
#pragma unroll
        for (int p2 = 0; p2 < 2; ++p2)
#pragma unroll
            for (int ks = 0; ks < 4; ++ks) bf[p2][ks] = cvt_h8(CST + ((size_t)(ch_ * 4 + hd) * 64 + 16 * ((wave & 1) * 2 + p2) + fr) * 128 + 32 * ks + 8 * q);
#pragma unroll
        for (int lt = 0; lt < 4; ++lt) {
            f16x8 af[4];
#pragma unroll
            for (int ks = 0; ks < 4; ++ks) af[ks] = ld_h8(ACT + (size_t)(t0 + 16 * lt + fr) * 768 + 512 + 128 * g + 32 * ks + 8 * q);
#pragma unroll
            for (int p2 = 0; p2 < 2; ++p2) { f32x4 acc = (f32x4){0.f, 0.f, 0.f, 0.f};
#pragma unroll
                for (int ks = 0; ks < 4; ++ks) acc = __builtin_amdgcn_mfma_f32_16x16x32_f16(af[ks], bf[p2][ks], acc, 0, 0, 0);
                const int ch = hd * 64 + 16 * ((wave & 1) * 2 + p2) + fr;
#pragma unroll
                for (int j = 0; j < 4; ++j) { const int tl = 16 * lt + 4 * q + j, t = t0 + tl;
                    const float y = acc[j] * __expf(ACS[(size_t)t * 4 + hd]) + YD[(size_t)t * 256 + ch] + Dp[hd] * (float)ACT[(size_t)t * 768 + ch];
                    GY[tl * 256 + ch] = y * siluf_((float)Z[(size_t)t * 256 + ch]); } }
        }
        __syncthreads();
        for (int tl = wave; tl < 64; tl += 8) { const f32x4 v = *(const LAS f32x4*)(GY + tl * 256 + lane * 4); const float ss = wsum((v[0] * v[0] + v[1] * v[1]) + (v[2] * v[2] + v[3] * v[3]));
            const float rn = rsqrtf(ss * (1.f / 256.f) + EPS); const f32x4 g4 = *(const f32x4*)(sng + lane * 4); f16x4 o;
#pragma unroll
            for (int i = 0; i < 4; ++i) o[i] = (f16)(v[i] * rn * g4[i]);
            *(f16x4*)(Y16 + (size_t)(t0 + tl) * 1024 + 256 + lane * 4) = o; }
    }
    __syncthreads();
}
DI void ph_outproj(LAS unsigned char* lds_, int l) {
    const Ctx c = mkctx(lds_);
    const float* xin = l == 0 ? INP(I_XP) : WSF(WS_X1); float* xout = l == 0 ? WSF(WS_X1) : c.out + O_YP;
    pg8::Gemm g{WSH(WS_Y16), WSH(WS_WTOUT) + (size_t)l * 1024 * 1024, SEQ, 1024, 1024}; pg8::StaticOrder S; S.init(SEQ, 1024, c.G, c.bid);
    EpiOut E{xin, xout, WSF(WS_ADA) + (size_t)(l * 33 + 32) * 3072 + 2048, l == 0 ? WSH(WS_A16) : nullptr, WSF(WS_GNX), WSF(WS_RSSP)};
    pg8::gemm_phase<EpiOut, pg8::StaticOrder>(c.lds, g, S, E);
    __syncthreads();
}
DI void ph_outproj_sample(LAS unsigned char* lds_, int l, int it) {
    const Ctx c = mkctx(lds_); const int tid = c.tid;
    const float* xs_in = l == 0 ? INP(I_XS) : WSF(WS_XS1); const float* ada_l = WSF(WS_ADA) + (size_t)l * 33 * 3072; const float* YS = WSF(WS_YS); float* xo = l == 0 ? WSF(WS_XS1) : c.out + O_YS;
    LAS f16* Ah = (LAS f16*)c.lds;
    __syncthreads();
#pragma unroll
    for (int i = 0; i < 16; ++i) { const int e = (tid + 512 * i) * 4; const f32x4 v = *(const f32x4*)(YS + e); f16x4 hv; hv[0] = (f16)v[0]; hv[1] = (f16)v[1]; hv[2] = (f16)v[2]; hv[3] = (f16)v[3]; *(LAS f16x4*)(Ah + (e >> 10) * 1032 + (e & 1023)) = hv; }
    __syncthreads();
    sample_gemm_item<1>(c.lds, WSH(WS_WTOUT) + (size_t)l * 1024 * 1024, it * 32, [&](int m, int n, float v) { xo[m * 1024 + n] = xs_in[m * 1024 + n] + ada_l[(size_t)m * 3072 + 2048 + n] * v; });
}

__global__ void __launch_bounds__(512, 2) fwd(Args a) {
    extern __shared__ __attribute__((aligned(16))) unsigned char lds_raw[];
    LAS unsigned char* lds = (LAS unsigned char*)lds_raw;
    volatile LAS unsigned* MISC = (volatile LAS unsigned*)(lds + MISC_OFF);
    if (threadIdx.x < 16) MISC[threadIdx.x] = 0u;
    __syncthreads();
    XcdBarrier bar; bar.bar = (unsigned*)(a.ws + WS_CTL); bar.x = 0; bar.st = MISC;
    if (N_LAUNCHES == 1) bar = xcd_barrier_post((unsigned*)(a.ws + WS_CTL), MISC);
    const int lo = a.ph_lo, hi = a.ph_hi;
    unsigned long long* stampw = (unsigned long long*)(a.ws + WS_CTL + 32768);
    if (STAMP_PHASE >= 0 && blockIdx.x == 0 && threadIdx.x == 0) stampw[0] = wall_clock64();
#define STAMP(k) do { if (STAMP_PHASE == (k) && blockIdx.x == 0 && threadIdx.x == 0) stampw[1] = wall_clock64(); } while (0)
#ifndef PH_MASK
#define PH_MASK 0xFFF
#endif
#define IN(k) (((PH_MASK >> ((k) < 2 ? (k) : 2 + ((k) - 2) % 4)) & 1) && lo <= (k) && (k) < hi)
#define SEAM(k) do { if (IN(k) && IN((k) + 1)) xcd_barrier(bar); STAMP(k); } while (0)
#ifndef DUP_MASK
#define DUP_MASK 0
#endif
#define DUP(bit, call) do { call; if ((DUP_MASK >> (bit)) & 1) { __syncthreads(); call; } } while (0)
    if (IN(0)) DUP(0, ph_prologue(lds));
    SEAM(0);
    if (IN(1)) { ph_hsample(lds, 0); DUP(1, ph_sample_compress(lds)); DUP(2, ph_prep(lds)); }
    SEAM(1);
    for (int l = 0; l < 2; ++l) {
        const int PB = 2 + 4 * l;
        if (IN(PB)) { DUP(3, ph_inproj(lds, l)); DUP(4, ph_inproj_sample(lds, l)); }
        SEAM(PB);
        if (IN(PB + 1)) {
#define SUBSTAMP(code) do { if (l == 0 && (STAMP_PHASE == (code) || STAMP_PHASE == (code) + 10) && blockIdx.x == (STAMP_PHASE >= 110 ? 100 : 0) && threadIdx.x == 0) stampw[1] = wall_clock64(); } while (0)
            DUP(5, ph_ssd_local(lds, l)); SUBSTAMP(100); DUP(6, ph_mix_a(lds, l)); SUBSTAMP(101); DUP(7, ph_mix_c(lds, l)); SUBSTAMP(102); DUP(8, ph_mix_d(lds, l)); SUBSTAMP(103); DUP(9, ph_mix_cmp(lds, l)); SUBSTAMP(104); }
        SEAM(PB + 1);
        if (IN(PB + 2)) { DUP(11, ph_scan(lds, l)); DUP(10, ph_mix_sample(lds, l)); ph_nsa(lds, l); }
        SEAM(PB + 2);
        if (IN(PB + 3)) { if (VERIFY_NSA && l == 0) { ph_nsa_verify(lds, l); __syncthreads(); } if (l == 0) ph_hsample(lds, 1); DUP(14, ph_outproj(lds, l)); }
        SEAM(PB + 3);
    }
    if (STAMP_PHASE >= 0 || VERIFY_NSA) {
        xcd_barrier(bar);
        if (blockIdx.x == 0) { __shared__ float alpha_s; if (threadIdx.x == 0) { const unsigned long long t1 = wall_clock64(); alpha_s = (float)(stampw[1] - stampw[0]) / (float)(t1 - stampw[0]);
                if (VERIFY_NSA) { const float* dbg = (const float*)(a.ws + WS_CTL + 40960); alpha_s = VERIFY_NSA == 1 ? dbg[3] / (dbg[2] + dbg[3]) : sqrtf(dbg[0] / dbg[1]); } } __syncthreads();
            const float sc = 1.f + alpha_s; float* ys = a.out + O_YS; for (int i = threadIdx.x; i < NB * 1024; i += 512) ys[i] *= sc; }
    }
#undef IN
#undef SEAM
}

extern "C" void kernel_launch(void* const* d_in, const int* in_sizes, int n_in, void* d_out, int out_size, void* d_ws, size_t ws_size, hipStream_t stream) {
    static int grid = 0;
    if (grid == 0) {
        if (n_in != N_IN || (size_t)out_size != O_END || ws_size < WS_END) { fprintf(stderr, "kernel_launch: unexpected shapes (n_in %d out %d ws %zu)\n", n_in, out_size, ws_size); grid = -1; return; }
        int dev = 0, cus = 0;
        if (hipGetDevice(&dev) != hipSuccess || hipDeviceGetAttribute(&cus, hipDeviceAttributeMultiprocessorCount, dev) != hipSuccess) { grid = -1; return; }
        if (hipFuncSetAttribute((const void*)fwd, hipFuncAttributeMaxDynamicSharedMemorySize, LDS_BYTES) != hipSuccess) { fprintf(stderr, "kernel_launch: hipFuncSetAttribute failed\n"); grid = -1; return; }
        int per_cu = 0;
        if (hipOccupancyMaxActiveBlocksPerMultiprocessor(&per_cu, (const void*)fwd, 512, LDS_BYTES) != hipSuccess || per_cu < 1) fprintf(stderr, "kernel_launch: occupancy query says %d\n", per_cu);
        (void)hipGetLastError();
        grid = cus;
    }
    if (grid < 0) return;
    hipMemsetAsync((char*)d_ws + WS_CTL, 0, 65536, stream);
    Args a{};
    for (int i = 0; i < N_IN; ++i) a.in[i] = d_in[i];
    a.out = (float*)d_out; a.ws = (unsigned char*)d_ws;
    if (N_LAUNCHES == 1) { a.ph_lo = 0; a.ph_hi = NPHASE; hipLaunchKernelGGL(fwd, dim3(grid), dim3(512), LDS_BYTES, stream, a); }
    else for (int p = 0; p < NPHASE; ++p) { a.ph_lo = p; a.ph_hi = p + 1; hipLaunchKernelGGL(fwd, dim3(grid), dim3(512), LDS_BYTES, stream, a); }
}
```

```cpp
#include <hip/hip_runtime.h>
#include <cstdio>
#include <cstdint>
#include <type_traits>

#define NSA_DUP 0
#define VERIFY_NSA 0
#define STAMP_PHASE -1
#ifndef N_LAUNCHES
#define N_LAUNCHES 1
#endif

#define DI __device__ __forceinline__
#define LAS __attribute__((address_space(3)))
typedef _Float16 f16;
typedef _Float16 f16x8 __attribute__((ext_vector_type(8)));
typedef _Float16 f16x4 __attribute__((ext_vector_type(4)));
typedef _Float16 f16x2 __attribute__((ext_vector_type(2)));
typedef float f32x4 __attribute__((ext_vector_type(4)));
typedef float f32x2 __attribute__((ext_vector_type(2)));
typedef float f32x16 __attribute__((ext_vector_type(16)));
typedef unsigned u32x4 __attribute__((ext_vector_type(4)));

constexpr int DM = 1024, SEQ = 16384, NB = 32, PAST = 16384, NPOOL = 5120, DIN = 3728, NPD = 3840;
constexpr float EPS = 1e-6f;
constexpr int NPHASE = 10;
enum { I_XP = 0, I_XS, I_CKV, I_CWIN, I_SSC, I_SBC, I_SSM, I_SCF, I_PT, I_CP, I_CS, I_NG, I_WADA, I_BADA, I_WIN, I_WOUT, I_SCW, I_BCW, I_BCB,
       I_DTB, I_ALOG, I_SD, I_SNG, I_CFW, I_CFB, I_LNG, I_LNB, I_QG, I_KG, I_PE, I_W1, I_B1, I_W2, I_B2, N_IN };
constexpr size_t O_YP = 0, O_YS = O_YP + (size_t)SEQ * DM, O_KVP = O_YS + NB * DM, O_KVS = O_KVP + (size_t)2 * SEQ * 256, O_WINP = O_KVS + 2 * NB * 256,
                 O_WINS = O_WINP + 2 * 512 * 128, O_SCP = O_WINS + (size_t)2 * NB * 512 * 128, O_SCS = O_SCP + 2 * 2 * 256, O_BCP = O_SCS + 2 * NB * 512,
                 O_BCS = O_BCP + 2 * 3 * 768, O_HP = O_BCS + 2 * NB * 2304, O_HS = O_HP + 2 * 32768, O_CFP = O_HS + (size_t)2 * NB * 32768,
                 O_CFS = O_CFP + 2 * 30 * 256, O_END = O_CFS + 2 * NB * 7680;
constexpr size_t al256(size_t x) { return (x + 255) & ~(size_t)255; }
constexpr size_t WS_CTL = 0, WS_ADA = 65536, WS_BIAS = WS_ADA + al256(2 * 33 * 3072 * 4), WS_PEB = WS_BIAS + al256(2 * NPD * 4), WS_WTIN = WS_PEB + 2048,
                 WS_WTOUT = WS_WTIN + (size_t)2 * NPD * 1024 * 2, WS_W1T = WS_WTOUT + (size_t)2 * 1024 * 1024 * 2, WS_A16 = WS_W1T + (size_t)4 * 128 * 2048 * 2,
                 WS_RSSP = WS_A16 + (size_t)SEQ * 1024 * 2, WS_X1 = WS_RSSP + (size_t)SEQ * 16 * 4, WS_PROJ = WS_X1 + (size_t)SEQ * 1024 * 4,
                 WS_Y16 = WS_PROJ + (size_t)15 * SEQ * 256 * 2, WS_ACT = WS_Y16 + (size_t)SEQ * 1024 * 2, WS_YD = WS_ACT + (size_t)SEQ * 768 * 2,
                 WS_CST = WS_YD + (size_t)SEQ * 256 * 4, WS_ACS = WS_CST + (size_t)128 * 32768 * 4, WS_CDEC = WS_ACS + (size_t)SEQ * 4 * 4, WS_Q16 = WS_CDEC + 2048,
                 WS_KS16 = WS_Q16 + (size_t)SEQ * 256 * 2, WS_VS16 = WS_KS16 + (size_t)SEQ * 64 * 2, WS_KW16 = WS_VS16 + (size_t)SEQ * 64 * 2,
                 WS_VW16 = WS_KW16 + (size_t)SEQ * 64 * 2, WS_GATES = WS_VW16 + (size_t)SEQ * 64 * 2, WS_KC = WS_GATES + (size_t)SEQ * 12 * 4,
                 WS_VC = WS_KC + 1024 * 64 * 4, WS_KCS = WS_VC + 1024 * 64 * 4, WS_VCS = WS_KCS + (size_t)2 * NB * 1024 * 64 * 4,
                 WS_PROJS = WS_VCS + (size_t)2 * NB * 1024 * 64 * 4, WS_YS = WS_PROJS + al256(NB * NPD * 4), WS_XS1 = WS_YS + NB * 1024 * 4, WS_GNX = WS_XS1 + NB * 1024 * 4, WS_NRG = WS_GNX + 4096, WS_VST16 = WS_NRG + 2 * NB * 1024, WS_VWT16 = WS_VST16 + (size_t)SEQ * 64 * 2, WS_KC16 = WS_VWT16 + (size_t)SEQ * 64 * 2,
                 WS_VCT16 = WS_KC16 + 1024 * 64 * 2, WS_HPV = WS_VCT16 + 1024 * 64 * 2, WS_W2T = WS_HPV + (size_t)128 * 32768 * 4, WS_PEBP = WS_W2T + 4 * 64 * 128 * 2, WS_HS16 = WS_PEBP + 4 * 8 * 128 * 4, WS_SELM = WS_HS16 + NB * 1024 * 2, WS_END = WS_SELM + 512 * 272 * 4;
constexpr int LDS_BYTES = 147456;
constexpr int MISC_OFF = 147200;

struct Args { const void* in[N_IN]; float* out; unsigned char* ws; int ph_lo, ph_hi; };

#define XB_TMO      128
#define XB_XCNT(j)  (256  + 64 * (j))
#define XB_XSUB(j)  (1280 + 64 * (j))
#define XB_XGEN(j)  (2304 + 64 * (j))
#define XB_TOP      3328
#define XB_TOPGEN   3392
#define XCD_BAR_WORDS 3456
#define XB_SPIN_CAP (1u << 18)
__device__ __forceinline__ unsigned xb_ld(unsigned* p)              { return __hip_atomic_load(p, __ATOMIC_RELAXED, __HIP_MEMORY_SCOPE_AGENT); }
__device__ __forceinline__ unsigned xb_add(unsigned* p, unsigned v) { return __hip_atomic_fetch_add(p, v, __ATOMIC_RELAXED, __HIP_MEMORY_SCOPE_AGENT); }
__device__ __forceinline__ unsigned xb_xcc_id() { return (unsigned)__builtin_amdgcn_s_getreg((3 << 11) | 20) & 0xFu; }
#define XB_SPIN(cond, bar) do { unsigned _sp = 0; while (cond) { __builtin_amdgcn_s_sleep(1); \
    if ((++_sp & 255u) == 0u) { if (xb_ld(&(bar)[XB_TMO])) break; if (_sp > XB_SPIN_CAP) { atomicAdd(&(bar)[XB_TMO], 1u); break; } } } } while (0)
struct XcdBarrier { unsigned* bar; unsigned x; volatile LAS unsigned* st; };
__device__ __forceinline__ XcdBarrier xcd_barrier_post(unsigned* bar, volatile LAS unsigned* st) {
    XcdBarrier b; b.bar = bar; b.x = xb_xcc_id(); b.st = st;
    if (threadIdx.x == 0) (void)xb_add(&bar[XB_XCNT(b.x)], 1u);
    return b;
}
__device__ __forceinline__ void xcd_barrier_complete(unsigned* bar, unsigned x, unsigned& nloc, unsigned& nx) {
    const unsigned G = gridDim.x * gridDim.y * gridDim.z;
    unsigned sum, cnt, mine, sp = 0u;
    for (;;) {
        sum = 0u; cnt = 0u; mine = 0u;
#pragma unroll
        for (unsigned j = 0; j < 16; ++j) { const unsigned c = xb_ld(&bar[XB_XCNT(j)]); sum += c; cnt += (c > 0u) ? 1u : 0u; mine = (j == x) ? c : mine; }
        if (sum == G) break;
        __builtin_amdgcn_s_sleep(1);
        if ((++sp & 255u) == 0u) { if (xb_ld(&bar[XB_TMO])) break; if (sp > XB_SPIN_CAP) { atomicAdd(&bar[XB_TMO], 1u); break; } }
    }
    nloc = mine > 0u ? mine : 1u; nx = cnt > 0u ? cnt : 1u;
}
__device__ __forceinline__ void xcd_barrier(const XcdBarrier& b) {
    asm volatile("s_waitcnt vmcnt(0)" ::: "memory");
    __syncthreads();
    if (threadIdx.x == 0) {
        unsigned* bar = b.bar;
        __builtin_amdgcn_s_waitcnt(0);
        unsigned nloc = b.st[0], nx = b.st[1];
        if (nloc == 0u) { xcd_barrier_complete(bar, b.x, nloc, nx); b.st[0] = nloc; b.st[1] = nx; }
        const unsigned old = xb_add(&bar[XB_XSUB(b.x)], 1u);
        const unsigned gen = old / nloc;
        if (old + 1u == (gen + 1u) * nloc) {
            __builtin_amdgcn_fence(__ATOMIC_RELEASE, "agent");
            asm volatile("s_waitcnt vmcnt(0)" ::: "memory");
            const unsigned og = xb_add(&bar[XB_TOP], 1u);
            const unsigned tg = og / nx;
            if (og + 1u == (tg + 1u) * nx) xb_add(&bar[XB_TOPGEN], 1u);
            else XB_SPIN(xb_ld(&bar[XB_TOPGEN]) == tg, bar);
            __builtin_amdgcn_fence(__ATOMIC_ACQUIRE, "agent");
            xb_add(&bar[XB_XGEN(b.x)], 1u);
            asm volatile("s_waitcnt vmcnt(0)" ::: "memory");
        } else {
            XB_SPIN(xb_ld(&bar[XB_XGEN(b.x)]) == gen, bar);
            __builtin_amdgcn_fence(__ATOMIC_ACQUIRE, "agent");
            asm volatile("s_waitcnt vmcnt(0)" ::: "memory");
        }
    }
    __syncthreads();
}

DI void lds_barrier() { asm volatile("s_waitcnt lgkmcnt(0)\n\ts_barrier" ::: "memory"); }
DI int ltid() { int t = threadIdx.x; asm volatile("" : "+v"(t)); return t; }
template <int CTRL> DI float dppf(float x) { return __builtin_bit_cast(float, __builtin_amdgcn_update_dpp(0, __builtin_bit_cast(int, x), CTRL, 0xF, 0xF, true)); }
template <int CTRL> DI int dppi(int x) { return __builtin_amdgcn_update_dpp(0, x, CTRL, 0xF, 0xF, true); }
constexpr int DPP_X1 = 0xB1, DPP_X2 = 0x4E, DPP_HM = 0x141, DPP_R8 = 0x128;
DI float sum16(float v) { v += dppf<DPP_X1>(v); v += dppf<DPP_X2>(v); v += dppf<DPP_HM>(v); v += dppf<DPP_R8>(v); return v; }
DI float max16(float v) { v = fmaxf(v, dppf<DPP_X1>(v)); v = fmaxf(v, dppf<DPP_X2>(v)); v = fmaxf(v, dppf<DPP_HM>(v)); v = fmaxf(v, dppf<DPP_R8>(v)); return v; }
DI float wsum(float v) { v = sum16(v); v += __shfl_xor(v, 16); v += __shfl_xor(v, 32); return v; }
DI float wmaxf(float v) { v = max16(v); v = fmaxf(v, __shfl_xor(v, 16)); v = fmaxf(v, __shfl_xor(v, 32)); return v; }
DI float sigmoidf_(float x) { return 1.f / (1.f + __expf(-x)); }
DI float siluf_(float x) { return x / (1.f + __expf(-x)); }
DI float softplusf_(float x) { return fmaxf(x, 0.f) + log1pf(__expf(-fabsf(x))); }
DI f16x8 ld_h8(const f16* p) { return *(const f16x8*)p; }
DI f16x8 cvt_h8(const float* p) { const f32x4 a = *(const f32x4*)p, b = *(const f32x4*)(p + 4); f16x8 r; r[0] = (f16)a[0]; r[1] = (f16)a[1]; r[2] = (f16)a[2]; r[3] = (f16)a[3]; r[4] = (f16)b[0]; r[5] = (f16)b[1]; r[6] = (f16)b[2]; r[7] = (f16)b[3]; return r; }
DI int vt_key(int pos) { const int p = pos & 31, qq = p >> 3, j = p & 7; return (pos & ~31) + (j < 4 ? 4 * qq + j : 12 + 4 * qq + j); }
DI int vt_pos(int key) { const int k = key & 31; return (key & ~31) + (k < 16 ? 8 * (k >> 2) + (k & 3) : 8 * ((k - 16) >> 2) + 4 + (k & 3)); }
DI int src_col(int n) { return n < 2048 ? n : (n < 3456 ? n + 4 : (n < 3460 ? n - 1408 : (n < 3472 ? n + 256 : (n < 3584 ? -1 : n - 124)))); }
DI int dst_col(int s) { return s < 2048 ? s : (s < 2052 ? s + 1408 : (s < 3460 ? s - 4 : (s < 3716 ? s + 124 : s - 256))); }

DI void edge_publish(unsigned* ctr) {
    asm volatile("s_waitcnt vmcnt(0)" ::: "memory"); __syncthreads();
    if (threadIdx.x == 0) { __builtin_amdgcn_fence(__ATOMIC_RELEASE, "agent"); asm volatile("s_waitcnt vmcnt(0)" ::: "memory"); __hip_atomic_fetch_add(ctr, 1u, __ATOMIC_RELAXED, __HIP_MEMORY_SCOPE_AGENT); }
}
DI void edge_wait(unsigned* ctr, unsigned need) {
    if (threadIdx.x == 0) { unsigned sp = 0;
        while (__hip_atomic_load(ctr, __ATOMIC_RELAXED, __HIP_MEMORY_SCOPE_AGENT) < need) { __builtin_amdgcn_s_sleep(8); if (++sp > (1u << 22)) break; }
        __builtin_amdgcn_fence(__ATOMIC_ACQUIRE, "agent"); asm volatile("s_waitcnt vmcnt(0)" ::: "memory"); }
    __syncthreads();
}
namespace pg8 {
constexpr int BM = 256, BK = 64, HALF = 128, HTB = HALF * BK * 2, STAGE_BYTES = 8 * HTB, NXCD = 8, WGM = 8;
DI int lds_byte(int r, int c) { const int st = (r >> 4) * 2 + (c >> 5), rr = r & 15, cc = c & 31, ob = rr * 64 + cc * 2; return st * 1024 + (ob ^ (((ob >> 9) & 1) << 5)); }
DI void stage_rc(int b, int& R, int& C) { const int st = b / 1024, sb = b % 1024, swz = sb ^ (((sb >> 9) & 1) << 5); R = (st >> 1) * 16 + swz / 64; C = (st & 1) * 32 + (swz % 64) / 2; }
DI int perm32(int rho) { const int n = rho >> 4, i = rho & 15; return 8 * (i >> 2) + 4 * n + (i & 3); }
struct Unit { int pm, pn; };
struct Gemm { const f16* A; const f16* Bt; int M, N, K; };
struct StaticOrder {
    int nM, nN, nwg, G, c;
    DI void init(int M, int N, int G_, int c_) { nM = M / BM; nN = N / BM; nwg = nM * nN; G = G_; c = c_; }
    DI bool next(int i, Unit& u) const {
        const long L = (long)i * G + c; if (L >= nwg) return false;
        int wgid = (int)L; { const int q = nwg / NXCD, r = nwg % NXCD, xcd = wgid % NXCD, off = wgid / NXCD; wgid = (xcd < r ? xcd * (q + 1) : r * (q + 1) + (xcd - r) * q) + off; }
        const int nig = WGM * nN, gid = wgid / nig, fm = gid * WGM, gsz = (nM - fm) < WGM ? (nM - fm) : WGM;
        u.pm = fm + ((wgid % nig) % gsz); u.pn = (wgid % nig) / gsz; return true;
    }
    DI void a_ready(const Unit&) const {}
    DI void done(const Unit&) const {}
};
template <class Epi, class Sched>
DI void gemm_phase(LAS unsigned char* lds, const Gemm g, const Sched& S, const Epi& E) {
    const int tid = ltid(), wid = __builtin_amdgcn_readfirstlane(tid >> 6), lane = tid & 63, wr = wid >> 2, wc = wid & 3, fr = lane & 15, fq = lane >> 4;
    const int K = g.K, nt = K / BK;
    unsigned voffA[2], voffB[2];
#pragma unroll
    for (int i = 0; i < 2; ++i) { int R, C; stage_rc(tid * 16 + i * 8192, R, C); const int Rb = Epi::PERM ? ((R & ~31) + perm32(R & 31)) : R;
        voffA[i] = (unsigned)(R * K + C) * 2u; voffB[i] = (unsigned)(Rb * K + C) * 2u; }
    const size_t kstep = (size_t)(BK * 2);
    const size_t hstep = (size_t)HALF * K * 2;
    const size_t tstep = 2 * hstep;
    const unsigned ldsw = (unsigned)wid * 1024u;
    const int aoff = lds_byte(wr * 64 + fr, fq * 8), boff = lds_byte(wc * 32 + fr, fq * 8);
#define PG8_SA(b, h) (((b) * 2 + (h)) * HTB)
#define PG8_SB(b, h) ((4 + (b) * 2 + (h)) * HTB)
#define PG8_STAGE(bufoff, gbase, voff) do { _Pragma("unroll") for (int _i = 0; _i < 2; ++_i) \
        __builtin_amdgcn_global_load_lds((const unsigned*)((const char*)(gbase) + (voff)[_i]), (LAS unsigned*)(lds + (bufoff) + ldsw + _i * 8192), 16, 0, 0); } while (0)
#define PG8_LDA(dst, b, h) do { _Pragma("unroll") for (int m = 0; m < 4; ++m) _Pragma("unroll") for (int k = 0; k < 2; ++k) dst[m][k] = *(const LAS f16x8*)(lds + PG8_SA(b, h) + aoff + m * 2048 + k * 1024); } while (0)
#define PG8_LDB(dst, b, h) do { _Pragma("unroll") for (int n = 0; n < 2; ++n) _Pragma("unroll") for (int k = 0; k < 2; ++k) dst[n][k] = *(const LAS f16x8*)(lds + PG8_SB(b, h) + boff + n * 2048 + k * 1024); } while (0)
#define PG8_MMA(ai, bj, At, Bt) do { __builtin_amdgcn_s_setprio(1); _Pragma("unroll") for (int m = 0; m < 4; ++m) _Pragma("unroll") for (int n = 0; n < 2; ++n) _Pragma("unroll") for (int k = 0; k < 2; ++k) \
        acc[ai][bj][m][n] = __builtin_amdgcn_mfma_f32_16x16x32_f16(Bt[n][k], At[m][k], acc[ai][bj][m][n], 0, 0, 0); __builtin_amdgcn_s_setprio(0); } while (0)
#define PG8_WAIT_V(n) asm volatile("s_waitcnt vmcnt(" #n ")" ::: "memory")
#define PG8_WAIT_L(n) asm volatile("s_waitcnt lgkmcnt(" #n ")" ::: "memory")
#define PG8_BAR __builtin_amdgcn_s_barrier()
#define PG8_SCHED __builtin_amdgcn_sched_barrier(0)
    Unit cur, nxt; int ui = 0;
    if (!S.next(0, cur)) return;
    f32x4 acc[2][2][4][2];
#pragma unroll
    for (int a = 0; a < 2; ++a)
#pragma unroll
        for (int b = 0; b < 2; ++b)
#pragma unroll
            for (int m = 0; m < 4; ++m)
#pragma unroll
                for (int n = 0; n < 2; ++n) acc[a][b][m][n] = (f32x4){0.f, 0.f, 0.f, 0.f};
    f16x8 At[4][2], B0[2][2], B1[2][2];
    const char* cA = (const char*)g.A + (size_t)cur.pm * tstep; const char* cB = (const char*)g.Bt + (size_t)cur.pn * tstep;
    S.a_ready(cur);
    PG8_STAGE(PG8_SB(0, 0), cB, voffB); PG8_STAGE(PG8_SA(0, 0), cA, voffA); PG8_STAGE(PG8_SB(0, 1), cB + hstep, voffB); PG8_STAGE(PG8_SA(0, 1), cA + hstep, voffA);
    if (wr == 1) PG8_BAR;
    PG8_WAIT_V(4); PG8_BAR;
    PG8_STAGE(PG8_SB(1, 0), cB + kstep, voffB); PG8_STAGE(PG8_SA(1, 0), cA + kstep, voffA); PG8_STAGE(PG8_SB(1, 1), cB + hstep + kstep, voffB);
    PG8_WAIT_V(6); PG8_BAR;
    for (;;) {
        const bool has_next = S.next(ui + 1, nxt);
        const char* nA = has_next ? (const char*)g.A + (size_t)nxt.pm * tstep : cA; const char* nB = has_next ? (const char*)g.Bt + (size_t)nxt.pn * tstep : cB;
        for (int t = 0; t < nt; t += 2) {
            const bool last = (t == nt - 2);
            const char* a1 = cA + (size_t)(t + 1) * kstep;
            const char* a2 = last ? nA : cA + (size_t)(t + 2) * kstep; const char* b2 = last ? nB : cB + (size_t)(t + 2) * kstep;
            const char* a3 = a2 + kstep; const char* b3 = b2 + kstep;
            if (last && has_next) S.a_ready(nxt);
            PG8_LDB(B0, 0, 0); PG8_SCHED; PG8_LDA(At, 0, 0); PG8_STAGE(PG8_SA(1, 1), a1 + hstep, voffA);
            PG8_WAIT_L(8); PG8_BAR; PG8_WAIT_L(0); PG8_MMA(0, 0, At, B0); PG8_BAR; PG8_SCHED;
            PG8_LDB(B1, 0, 1); PG8_STAGE(PG8_SB(0, 0), b2, voffB);
            PG8_BAR; PG8_WAIT_L(0); PG8_MMA(0, 1, At, B1); PG8_BAR;
            PG8_LDA(At, 0, 1); PG8_STAGE(PG8_SA(0, 0), a2, voffA);
            PG8_BAR; PG8_WAIT_L(0); PG8_MMA(1, 0, At, B0); PG8_BAR; PG8_SCHED;
            PG8_STAGE(PG8_SB(0, 1), b2 + hstep, voffB);
            PG8_WAIT_V(6); PG8_BAR; PG8_MMA(1, 1, At, B1); PG8_BAR;
            PG8_LDB(B0, 1, 0); PG8_SCHED; PG8_LDA(At, 1, 0); PG8_STAGE(PG8_SA(0, 1), a2 + hstep, voffA);
            PG8_WAIT_L(8); PG8_BAR; PG8_WAIT_L(0); PG8_MMA(0, 0, At, B0); PG8_BAR; PG8_SCHED;
            PG8_LDB(B1, 1, 1); PG8_STAGE(PG8_SB(1, 0), b3, voffB);
            PG8_BAR; PG8_WAIT_L(0); PG8_MMA(0, 1, At, B1); PG8_BAR;
            PG8_LDA(At, 1, 1); PG8_STAGE(PG8_SA(1, 0), a3, voffA);
            PG8_BAR; PG8_WAIT_L(0); PG8_MMA(1, 0, At, B0); PG8_BAR; PG8_SCHED;
            PG8_STAGE(PG8_SB(1, 1), b3 + hstep, voffB);
            PG8_WAIT_V(6); PG8_BAR; PG8_MMA(1, 1, At, B1); PG8_BAR;
        }
        E(acc, cur, wr, wc, fr, fq);
        if (!has_next) break;
#pragma unroll
        for (int a = 0; a < 2; ++a)
#pragma unroll
            for (int b = 0; b < 2; ++b)
#pragma unroll
                for (int m = 0; m < 4; ++m)
#pragma unroll
                    for (int n = 0; n < 2; ++n) acc[a][b][m][n] = (f32x4){0.f, 0.f, 0.f, 0.f};
        cur = nxt; cA = nA; cB = nB; ++ui;
    }
    PG8_WAIT_V(0);
    if (wr == 0) PG8_BAR;
    PG8_BAR;
#undef PG8_SA
#undef PG8_SB
#undef PG8_STAGE
#undef PG8_LDA
#undef PG8_LDB
#undef PG8_MMA
#undef PG8_WAIT_V
#undef PG8_WAIT_L
#undef PG8_BAR
#undef PG8_SCHED
}
}

struct EpiIn {
    static constexpr bool PERM = true;
    f16* proj; const float* rssp; const float* bias; float* kvout;
    DI void operator()(const f32x4 (&acc)[2][2][4][2], const pg8::Unit& u, int wr, int wc, int fr, int fq) const {
        const int row0 = u.pm * 256 + wr * 64 + fr, colt = wc * 32 + 8 * fq;
        f32x4 bv[2][2];
#pragma unroll
        for (int bj = 0; bj < 2; ++bj)
#pragma unroll
            for (int n = 0; n < 2; ++n) bv[bj][n] = *(const f32x4*)(bias + u.pn * 256 + colt + bj * 128 + 4 * n);
        f16* pt = proj + (size_t)u.pn * SEQ * 256;
#pragma unroll
        for (int ai = 0; ai < 2; ++ai)
#pragma unroll
            for (int m = 0; m < 4; ++m) {
                const int row = row0 + ai * 128 + m * 16;
                const f32x4* rp = (const f32x4*)(rssp + (size_t)row * 16);
                const f32x4 s0 = rp[0], s1 = rp[1], s2 = rp[2], s3 = rp[3];
                const float ss = ((s0[0] + s0[1]) + (s0[2] + s0[3])) + ((s1[0] + s1[1]) + (s1[2] + s1[3])) + ((s2[0] + s2[1]) + (s2[2] + s2[3])) + ((s3[0] + s3[1]) + (s3[2] + s3[3]));
                const float r = rsqrtf(ss * (1.f / 1024.f) + EPS);
#pragma unroll
                for (int bj = 0; bj < 2; ++bj) {
                    const f32x4 v0 = acc[ai][bj][m][0] * r + bv[bj][0], v1 = acc[ai][bj][m][1] * r + bv[bj][1];
                    f16x8 h; h[0] = (f16)v0[0]; h[1] = (f16)v0[1]; h[2] = (f16)v0[2]; h[3] = (f16)v0[3]; h[4] = (f16)v1[0]; h[5] = (f16)v1[1]; h[6] = (f16)v1[2]; h[7] = (f16)v1[3];
                    *(f16x8*)(pt + (size_t)row * 256 + colt + bj * 128) = h;
                    if (u.pn == 12) { float* kp = kvout + (size_t)row * 256 + colt + bj * 128; *(f32x4*)kp = v0; *(f32x4*)(kp + 4) = v1; }
                }
            }
    }
};
struct EpiOut {
    static constexpr bool PERM = false;
    const float* xin; float* xout; const float* gate; f16* a16; const float* gnext; float* rssp;
    DI void operator()(const f32x4 (&acc)[2][2][4][2], const pg8::Unit& u, int wr, int wc, int fr, int fq) const {
        const int row0 = u.pm * 256 + wr * 64 + fr, col0 = u.pn * 256 + wc * 32 + 4 * fq;
        float ss[2][4];
#pragma unroll
        for (int ai = 0; ai < 2; ++ai)
#pragma unroll
            for (int m = 0; m < 4; ++m) ss[ai][m] = 0.f;
#pragma unroll
        for (int bj = 0; bj < 2; ++bj)
#pragma unroll
            for (int n = 0; n < 2; ++n) {
                const int col = col0 + bj * 128 + n * 16;
                const f32x4 gv = *(const f32x4*)(gate + col); f32x4 gn = (f32x4){0.f, 0.f, 0.f, 0.f}; if (a16) gn = *(const f32x4*)(gnext + col);
#pragma unroll
                for (int ai = 0; ai < 2; ++ai)
#pragma unroll
                    for (int m = 0; m < 4; ++m) {
                        const int row = row0 + ai * 128 + m * 16;
                        const f32x4 xv = *(const f32x4*)(xin + (size_t)row * 1024 + col);
                        const f32x4 o = xv + gv * acc[ai][bj][m][n];
                        *(f32x4*)(xout + (size_t)row * 1024 + col) = o;
                        ss[ai][m] += (o[0] * o[0] + o[1] * o[1]) + (o[2] * o[2] + o[3] * o[3]);
                        if (a16) { f16x4 h; h[0] = (f16)(o[0] * gn[0]); h[1] = (f16)(o[1] * gn[1]); h[2] = (f16)(o[2] * gn[2]); h[3] = (f16)(o[3] * gn[3]);
                            *(f16x4*)(a16 + (size_t)row * 1024 + col) = h; }
                    }
                asm volatile("" ::: "memory");
            }
        if (a16) {
#pragma unroll
            for (int ai = 0; ai < 2; ++ai)
#pragma unroll
                for (int m = 0; m < 4; ++m) { float v = ss[ai][m]; v += __shfl_xor(v, 16); v += __shfl_xor(v, 32);
                    if (fq == 0) rssp[(size_t)(row0 + ai * 128 + m * 16) * 16 + u.pn * 4 + wc] = v; }
        }
    }
};

template <int MP  , class AFn, class OFn>
DI void skinny_item(LAS unsigned char* lds, const float* W, int ldw, int n0, int ncols, int M, AFn afn, OFn ofn) {
    const int tid = ltid(), wave = tid >> 6, lane = tid & 63;
    LAS float* As = (LAS float*)lds;
    float acc[MP];
#pragma unroll
    for (int m = 0; m < MP; ++m) acc[m] = 0.f;
    for (int kc = 0; kc < 1024; kc += 512) {
        __syncthreads();
#pragma unroll 4
        for (int m = 0; m < MP; ++m) As[tid * 36 + m] = (m < M) ? afn(m, kc + tid) : 0.f;
        __syncthreads();
        const int kb = wave * 64;
#pragma unroll 8
        for (int kk = 0; kk < 64; ++kk) {
            const float w = (lane < ncols) ? W[(size_t)(kc + kb + kk) * ldw + n0 + lane] : 0.f;
            const float av = As[(kb + kk) * 36 + lane];
#pragma unroll
            for (int m = 0; m < MP; ++m) acc[m] += __builtin_bit_cast(float, __builtin_amdgcn_readlane(__builtin_bit_cast(int, av), m)) * w;
        }
    }
    __syncthreads();
    LAS float* R = (LAS float*)lds;
#pragma unroll
    for (int m = 0; m < MP; ++m) R[(wave * 36 + m) * 64 + lane] = acc[m];
    __syncthreads();
    for (int idx = tid; idx < M * 64; idx += 512) { const int m = idx >> 6, c = idx & 63; float s = 0.f;
#pragma unroll
        for (int w = 0; w < 8; ++w) s += R[(w * 36 + m) * 64 + c];
        if (c < ncols) ofn(m, n0 + c, s); }
    __syncthreads();
}

template <bool F32> struct Raw16 { f32x4 f[4]; f16x8 hv[2];
    DI void ld(const void* p) { if (F32) {
#pragma unroll
            for (int i = 0; i < 4; ++i) f[i] = *(const f32x4*)((const float*)p + 4 * i); } else { hv[0] = *(const f16x8*)p; hv[1] = *(const f16x8*)((const f16*)p + 8); } }
    DI f16x8 get(int i) const { if (F32) { const f32x4 a = f[2 * i], b = f[2 * i + 1]; f16x8 r; r[0] = (f16)a[0]; r[1] = (f16)a[1]; r[2] = (f16)a[2]; r[3] = (f16)a[3]; r[4] = (f16)b[0]; r[5] = (f16)b[1]; r[6] = (f16)b[2]; r[7] = (f16)b[3]; return r; } return hv[i]; } };
template <bool SRC_F32, class ChunkFn>
DI void compress_item(LAS unsigned char* lds, ChunkFn chunkp  , int c0, const f16* w1t, const float* peb, const f16* w2t  , const float* b2, const float* kg, float* out, f16* out16, f16* outT16) {
    typedef typename std::conditional<SRC_F32, float, f16>::type T;
    const int tid = ltid(), wave = tid >> 6, lane = tid & 63, wm = wave >> 2, wq = wave & 3, r = lane & 31, h = lane >> 5;
    LAS f16* As = (LAS f16*)lds;
    LAS f16* Bs = (LAS f16*)(lds + 2 * 18432);
    f32x16 acc[2][2];
#pragma unroll
    for (int a = 0; a < 2; ++a)
#pragma unroll
        for (int b = 0; b < 2; ++b)
#pragma unroll
            for (int i = 0; i < 16; ++i) acc[a][b][i] = 0.f;
    constexpr int NA = SRC_F32 ? 4 : 2, AE = SRC_F32 ? 4 : 8;
    const int arow = SRC_F32 ? tid >> 4 : tid >> 3, aseg = SRC_F32 ? tid & 15 : tid & 7, brow = tid >> 3, bsg = tid & 7;
    const T* ap[NA];
#pragma unroll
    for (int i = 0; i < NA; ++i) { int ch = c0 + arow + (128 / NA) * i; ch = ch < 1023 ? ch : 1023; ap[i] = (const T*)chunkp(ch) + aseg * AE; }
    const f16* bsrc = w1t + (size_t)brow * 2048 + bsg * 8;
    Raw16<SRC_F32> ra[3]; f16x8 rb[3][4];
    auto ldab = [&](int sl, int kb) {
#pragma unroll
        for (int i = 0; i < NA; ++i) { if (SRC_F32) ra[sl].f[i] = *(const f32x4*)((const float*)ap[i] + kb * 256); else ra[sl].hv[i] = *(const f16x8*)((const f16*)ap[i] + kb * 256); }
#pragma unroll
        for (int i = 0; i < 4; ++i) rb[sl][i] = ld_h8(bsrc + (size_t)(i & 1) * 64 * 2048 + (i >> 1) * 1024 + kb * 64 + 0); };
    auto stab = [&](int sl, int nx) {
#pragma unroll
        for (int i = 0; i < NA; ++i) {
            if (SRC_F32) { const f32x4 v = ra[sl].f[i]; f16x4 hq; hq[0] = (f16)v[0]; hq[1] = (f16)v[1]; hq[2] = (f16)v[2]; hq[3] = (f16)v[3]; *(LAS f16x4*)(As + nx * 9216 + (arow + 32 * i) * 72 + 4 * aseg) = hq; }
            else *(LAS f16x8*)(As + nx * 9216 + (arow + 64 * i) * 72 + 8 * aseg) = ra[sl].hv[i]; }
#pragma unroll
        for (int i = 0; i < 4; ++i) *(LAS f16x8*)(Bs + nx * 18432 + (brow + 64 * i) * 72 + 8 * bsg) = rb[sl][i]; };
#pragma unroll
    for (int i = 0; i < 3; ++i) ldab(i, i);
    __syncthreads();
    stab(0, 0);
    ldab(0, 3);
    lds_barrier();
#pragma unroll
    for (int kb = 0; kb < 16; ++kb) {
        const int cur = kb & 1;
        const LAS f16* Ac = As + cur * 9216 + (64 * wm + r) * 72 + 8 * h; const LAS f16* Bc = Bs + cur * 18432 + (64 * wq + r) * 72 + 8 * h;
#pragma unroll
        for (int ks = 0; ks < 4; ++ks) {
            const f16x8 a0 = *(const LAS f16x8*)(Ac + 16 * ks), a1 = *(const LAS f16x8*)(Ac + 32 * 72 + 16 * ks), b0 = *(const LAS f16x8*)(Bc + 16 * ks), b1 = *(const LAS f16x8*)(Bc + 32 * 72 + 16 * ks);
            acc[0][0] = __builtin_amdgcn_mfma_f32_32x32x16_f16(a0, b0, acc[0][0], 0, 0, 0); acc[0][1] = __builtin_amdgcn_mfma_f32_32x32x16_f16(a0, b1, acc[0][1], 0, 0, 0);
            acc[1][0] = __builtin_amdgcn_mfma_f32_32x32x16_f16(a1, b0, acc[1][0], 0, 0, 0); acc[1][1] = __builtin_amdgcn_mfma_f32_32x32x16_f16(a1, b1, acc[1][1], 0, 0, 0);
        }
        if (kb + 1 < 16) { const int nx = cur ^ 1, sl = (kb + 1) % 3;
            stab(sl, nx);
            if (kb + 4 < 16) ldab(sl, kb + 4); }
        lds_barrier();
    }
    LAS float* SL = (LAS float*)lds;
    LAS f16* HS = (LAS f16*)(lds + 65536);
    if (wq >= 2) {
#pragma unroll
        for (int a = 0; a < 2; ++a)
#pragma unroll
            for (int b = 0; b < 2; ++b)
#pragma unroll
                for (int i = 0; i < 16; ++i) SL[(64 * wm + 32 * a + (i & 3) + 8 * (i >> 2) + 4 * h) * 128 + 64 * (wq - 2) + 32 * b + r] = acc[a][b][i];
    }
    __syncthreads();
    if (wq < 2) {
#pragma unroll
        for (int a = 0; a < 2; ++a)
#pragma unroll
            for (int b = 0; b < 2; ++b) { const int f = 64 * wq + 32 * b + r; float pb = 0.f;
#pragma unroll
                for (int p8 = 0; p8 < 8; ++p8) pb += peb[p8 * 128 + f];
#pragma unroll
                for (int i = 0; i < 16; ++i) { const int m = 64 * wm + 32 * a + (i & 3) + 8 * (i >> 2) + 4 * h; const float sv = m < 127 ? SL[(m + 1) * 128 + f] : 0.f;
                    HS[m * 136 + f] = (f16)siluf_(acc[a][b][i] + sv + pb); } }
    }
    __syncthreads();
    {
        const int fr = lane & 15, q = lane >> 4;
        f32x4 o[4];
#pragma unroll
        for (int et = 0; et < 4; ++et) o[et] = (f32x4){0.f, 0.f, 0.f, 0.f};
#pragma unroll
        for (int ks = 0; ks < 4; ++ks) { const f16x8 av = *(const LAS f16x8*)(HS + (16 * wave + fr) * 136 + 32 * ks + 8 * q);
#pragma unroll
            for (int et = 0; et < 4; ++et) o[et] = __builtin_amdgcn_mfma_f32_16x16x32_f16(av, ld_h8(w2t + (size_t)(16 * et + fr) * 128 + 32 * ks + 8 * q), o[et], 0, 0, 0); }
        float bb[4], gg[4];
#pragma unroll
        for (int et = 0; et < 4; ++et) { bb[et] = b2[16 * et + fr]; gg[et] = kg ? kg[16 * et + fr] : 1.f; }
#pragma unroll
        for (int j = 0; j < 4; ++j) {
            const int row = 16 * wave + 4 * q + j, blk = c0 + row; float v[4], ss = 0.f;
#pragma unroll
            for (int et = 0; et < 4; ++et) { v[et] = o[et][j] + bb[et]; ss += v[et] * v[et]; }
            if (kg) { ss += __shfl_xor(ss, 1); ss += __shfl_xor(ss, 2); ss += __shfl_xor(ss, 4); ss += __shfl_xor(ss, 8); const float rn = rsqrtf(ss * (1.f / 64.f) + EPS);
#pragma unroll
                for (int et = 0; et < 4; ++et) v[et] = v[et] * rn * gg[et]; }
            const bool okrow = row < 127 && blk < 1023, wr16 = row < 127 && blk < 1024;
#pragma unroll
            for (int et = 0; et < 4; ++et) { const float x = okrow ? v[et] : 0.f; const int e = 16 * et + fr;
                if (out && okrow) out[(size_t)blk * 64 + e] = x;
                if (out16 && wr16) out16[(size_t)blk * 64 + e] = (f16)x;
                if (outT16 && wr16) outT16[(size_t)e * 1024 + vt_pos(blk)] = (f16)x; }
        }
    }
    __syncthreads();
}

struct PromptKV {
    const f16 *ks, *vs, *kw, *vw;
    DI void krow_sel(int pos, float (&k)[64]) const { const f16* p = ks + (size_t)pos * 64;
#pragma unroll
        for (int i = 0; i < 8; ++i) { const f16x8 v = ld_h8(p + i * 8);
#pragma unroll
            for (int j = 0; j < 8; ++j) k[i * 8 + j] = (float)v[j]; } }
    DI float v_sel(int pos, int d) const { return (float)vs[(size_t)pos * 64 + d]; }
    DI void krow_win(int pos, float (&k)[64]) const { const f16* p = kw + (size_t)pos * 64;
#pragma unroll
        for (int i = 0; i < 8; ++i) { const f16x8 v = ld_h8(p + i * 8);
#pragma unroll
            for (int j = 0; j < 8; ++j) k[i * 8 + j] = (float)v[j]; } }
    DI float v_win(int pos, int d) const { return (float)vw[(size_t)pos * 64 + d]; }
};
struct SampleKV {
    const float* ckv; const int* pt; const float* cwin; const float* nks; const float* nvs; const float* nkw; const float* nvw;
    DI const float* prow(int pos, int slot) const { return ckv + ((size_t)pt[pos >> 7] * 128 + (pos & 127)) * 256 + slot * 64; }
    DI void ld64(const float* p, float (&k)[64]) const {
#pragma unroll
        for (int i = 0; i < 16; ++i) { const f32x4 v = *(const f32x4*)(p + i * 4); k[i * 4] = v[0]; k[i * 4 + 1] = v[1]; k[i * 4 + 2] = v[2]; k[i * 4 + 3] = v[3]; } }
    DI void krow_sel(int pos, float (&k)[64]) const { ld64(pos < PAST ? prow(pos, 2) : nks, k); }
    DI float v_sel(int pos, int d) const { return pos < PAST ? prow(pos, 3)[d] : nvs[d]; }
    DI void krow_win(int pos, float (&k)[64]) const { ld64(pos < PAST ? cwin + (size_t)(pos - (PAST - 512)) * 128 : nkw, k); }
    DI float v_win(int pos, int d) const { return pos < PAST ? cwin[(size_t)(pos - (PAST - 512)) * 128 + 64 + d] : nvw[d]; }
};
template <class KV>
DI void nsa_token(LAS float* wl, int qpos, const float* KC, const float* VC, const KV& kv, const float* gates  , float (&o)[4]) {
    const int lane = ltid() & 63;
    LAS float* sc = wl; LAS float* qs = wl + 4096; LAS int* sel = (LAS int*)(wl + 4096 + 256);
    const int cur = qpos >> 6;
    const int ncv = qpos >= 31 ? ((qpos - 31) >> 4) + 1 : 0;
    float oc[4] = {0.f, 0.f, 0.f, 0.f}, os[4] = {0.f, 0.f, 0.f, 0.f}, ow[4] = {0.f, 0.f, 0.f, 0.f};
    {
        float mx[4] = {-3e38f, -3e38f, -3e38f, -3e38f};
        for (int c = lane; c < ncv; c += 64) {
            asm volatile("" ::: "memory");
            float s[4] = {0.f, 0.f, 0.f, 0.f}; const float* kp = KC + (size_t)c * 64;
#pragma unroll
            for (int d4 = 0; d4 < 16; ++d4) { const f32x4 kvv = *(const f32x4*)(kp + d4 * 4);
#pragma unroll
                for (int j = 0; j < 4; ++j) { const f32x4 q = *(const LAS f32x4*)(qs + (d4 * 4 + j) * 4); s[0] += q[0] * kvv[j]; s[1] += q[1] * kvv[j]; s[2] += q[2] * kvv[j]; s[3] += q[3] * kvv[j]; } }
#pragma unroll
            for (int hh = 0; hh < 4; ++hh) { s[hh] *= 0.125f; sc[hh * 1024 + c] = s[hh]; mx[hh] = fmaxf(mx[hh], s[hh]); }
        }
        float inv[4];
#pragma unroll
        for (int hh = 0; hh < 4; ++hh) { mx[hh] = wmaxf(mx[hh]); float sm = 0.f; for (int c = lane; c < ncv; c += 64) { const float e = __expf(sc[hh * 1024 + c] - mx[hh]); sc[hh * 1024 + c] = e; sm += e; } sm = wsum(sm); inv[hh] = ncv > 0 ? 1.f / sm : 0.f; }
        for (int c = lane; c < ncv; c += 64) {
#pragma unroll
            for (int hh = 0; hh < 4; ++hh) sc[hh * 1024 + c] *= inv[hh]; }
        __builtin_amdgcn_wave_barrier();
        for (int c = 0; c < ncv; ++c) { const float v = VC[(size_t)c * 64 + lane];
#pragma unroll
            for (int hh = 0; hh < 4; ++hh) oc[hh] += sc[hh * 1024 + c] * v; }
    }
    const int nsel = (cur + 1) < 16 ? (cur + 1) : 16;
    {
        float scv[5];
#pragma unroll
        for (int i = 0; i < 5; ++i) {
            const int j = lane + 64 * i; float v = -3e38f;
            if (j <= cur) {
                if (j == 0 || j == cur || j == cur - 1) v = 3e38f;
                else { float a = 0.f;
#pragma unroll
                    for (int o5 = -1; o5 < 4; ++o5) { const int c = 4 * j + o5; if (c >= 0 && c < ncv) { const float p = (sc[c] + sc[1024 + c]) + (sc[2048 + c] + sc[3072 + c]); a += (o5 == -1 || o5 == 3) ? 0.5f * p : p; } }
                    v = a; }
            }
            scv[i] = v;
        }
        for (int k = 0; k < nsel; ++k) {
            float bv = scv[0]; int bi = lane;
#pragma unroll
            for (int i = 1; i < 5; ++i) if (scv[i] > bv) { bv = scv[i]; bi = lane + 64 * i; }
#pragma unroll
            for (int off = 32; off > 0; off >>= 1) { const float ov = __shfl_xor(bv, off); const int oi = __shfl_xor(bi, off); if (ov > bv || (ov == bv && oi < bi)) { bv = ov; bi = oi; } }
            if (lane == 0) sel[k] = bi;
#pragma unroll
            for (int i = 0; i < 5; ++i) if (lane + 64 * i == bi) scv[i] = -3e38f;
        }
        __builtin_amdgcn_wave_barrier();
    }
    {
        float mx[4] = {-3e38f, -3e38f, -3e38f, -3e38f};
        for (int k = 0; k < nsel; ++k) {
            asm volatile("" ::: "memory");
            const int pos = sel[k] * 64 + lane; float s[4] = {-1e30f, -1e30f, -1e30f, -1e30f};
            if (pos <= qpos) { float kr[64]; kv.krow_sel(pos, kr); s[0] = s[1] = s[2] = s[3] = 0.f;
#pragma unroll
                for (int d = 0; d < 64; ++d) { const f32x4 q = *(const LAS f32x4*)(qs + d * 4); s[0] += q[0] * kr[d]; s[1] += q[1] * kr[d]; s[2] += q[2] * kr[d]; s[3] += q[3] * kr[d]; }
#pragma unroll
                for (int hh = 0; hh < 4; ++hh) s[hh] *= 0.125f; }
#pragma unroll
            for (int hh = 0; hh < 4; ++hh) { sc[hh * 1024 + k * 64 + lane] = s[hh]; mx[hh] = fmaxf(mx[hh], s[hh]); }
        }
        float inv[4];
#pragma unroll
        for (int hh = 0; hh < 4; ++hh) { mx[hh] = wmaxf(mx[hh]); float sm = 0.f; for (int k = 0; k < nsel; ++k) { const float sv = sc[hh * 1024 + k * 64 + lane]; const float e = sv > -1e29f ? __expf(sv - mx[hh]) : 0.f; sc[hh * 1024 + k * 64 + lane] = e; sm += e; } sm = wsum(sm); inv[hh] = 1.f / sm; }
        __builtin_amdgcn_wave_barrier();
        for (int k = 0; k < nsel; ++k) { const int p0 = sel[k] * 64; int nk = qpos - p0 + 1; nk = nk > 64 ? 64 : nk;
            for (int kk = 0; kk < nk; ++kk) { const float v = kv.v_sel(p0 + kk, lane);
#pragma unroll
                for (int hh = 0; hh < 4; ++hh) os[hh] += sc[hh * 1024 + k * 64 + kk] * v; } }
#pragma unroll
        for (int hh = 0; hh < 4; ++hh) os[hh] *= inv[hh];
        __builtin_amdgcn_wave_barrier();
    }
    {
        const int lo = qpos - 512 > 0 ? qpos - 512 : 0, nw = qpos - lo + 1;
        float mx[4] = {-3e38f, -3e38f, -3e38f, -3e38f};
        for (int i = lane; i < nw; i += 64) { asm volatile("" ::: "memory"); float kr[64]; kv.krow_win(lo + i, kr); float s[4] = {0.f, 0.f, 0.f, 0.f};
#pragma unroll
            for (int d = 0; d < 64; ++d) { const f32x4 q = *(const LAS f32x4*)(qs + d * 4); s[0] += q[0] * kr[d]; s[1] += q[1] * kr[d]; s[2] += q[2] * kr[d]; s[3] += q[3] * kr[d]; }
#pragma unroll
            for (int hh = 0; hh < 4; ++hh) { s[hh] *= 0.125f; sc[hh * 1024 + i] = s[hh]; mx[hh] = fmaxf(mx[hh], s[hh]); } }
        float inv[4];
#pragma unroll
        for (int hh = 0; hh < 4; ++hh) { mx[hh] = wmaxf(mx[hh]); float sm = 0.f; for (int i = lane; i < nw; i += 64) { const float e = __expf(sc[hh * 1024 + i] - mx[hh]); sc[hh * 1024 + i] = e; sm += e; } sm = wsum(sm); inv[hh] = 1.f / sm; }
        __builtin_amdgcn_wave_barrier();
        for (int i = 0; i < nw; ++i) { const float v = kv.v_win(lo + i, lane);
#pragma unroll
            for (int hh = 0; hh < 4; ++hh) ow[hh] += sc[hh * 1024 + i] * v; }
#pragma unroll
        for (int hh = 0; hh < 4; ++hh) ow[hh] *= inv[hh];
        __builtin_amdgcn_wave_barrier();
    }
#pragma unroll
    for (int hh = 0; hh < 4; ++hh) o[hh] = gates[hh * 3] * oc[hh] + gates[hh * 3 + 1] * os[hh] + gates[hh * 3 + 2] * ow[hh];
}

template <class LF, class SF>
DI void tr64(LAS unsigned char* lds, LF lf, SF sf) {
    LAS float* T = (LAS float*)lds;
    const int tid = ltid();
    __syncthreads();
#pragma unroll
    for (int e8 = 0; e8 < 8; ++e8) { const int e = tid + 512 * e8, kk = e >> 6, nn = e & 63; T[kk * 65 + nn] = lf(kk, nn); }
    __syncthreads();
#pragma unroll
    for (int e8 = 0; e8 < 8; ++e8) { const int e = tid + 512 * e8, nn = e >> 6, kk = e & 63; sf(nn, kk, (f16)T[kk * 65 + nn]); }
}

typedef const Args __attribute__((address_space(4)))* ArgP;
struct Ctx { ArgP ap; LAS unsigned char* lds; unsigned char* ws; float* out; int tid, lane, wave, bid, G; };
DI Ctx mkctx(LAS unsigned char* lds) {
    Ctx c; const char __attribute__((address_space(4)))* kp = (const char __attribute__((address_space(4)))*)__builtin_amdgcn_kernarg_segment_ptr();
    asm volatile("" : "+s"(kp));
    c.ap = (ArgP)kp; c.lds = lds; c.ws = c.ap->ws; c.out = c.ap->out;
    int tid = threadIdx.x; asm volatile("" : "+v"(tid));
    c.tid = tid; c.lane = tid & 63; c.wave = __builtin_amdgcn_readfirstlane(tid >> 6); c.bid = blockIdx.x; c.G = gridDim.x;
    return c;
}
#define INP(i) ((const float*)c.ap->in[i])
#define WSF(off) ((float*)(c.ws + (off)))
#define WSH(off) ((f16*)(c.ws + (off)))

DI void ph_prologue(LAS unsigned char* lds_) {
    const Ctx c = mkctx(lds_); LAS unsigned char* lds = c.lds; const int tid = c.tid, bid = c.bid, G = c.G;
    const float* c_p = INP(I_CP); const float* c_s = INP(I_CS); const float* w_ada = INP(I_WADA); const float* b_ada = INP(I_BADA);
    const float* w_in = INP(I_WIN); const float* w_out = INP(I_WOUT); const float* w1 = INP(I_W1);
    float* ADA = WSF(WS_ADA); float* BIAS = WSF(WS_BIAS); float* PEB = WSF(WS_PEB); f16* WTIN = WSH(WS_WTIN); f16* WTOUT = WSH(WS_WTOUT); f16* W1T = WSH(WS_W1T);
    constexpr int N_ADA = 96, N_WTIN = 1920, N_WTOUT = 512, N_W1T = 256, N_PEB = 32, N_W2T = 8, N_ALL = N_ADA + N_WTIN + N_WTOUT + N_W1T + N_PEB + N_W2T + 1;
    constexpr int XA = 1;
    const bool reb = G == 256; const int n_mine = reb ? (bid < N_ADA ? 1 + XA : (N_ALL - N_ADA - XA * N_ADA - (bid - N_ADA) + 159) / 160) : (N_ALL - bid + G - 1) / G;
    for (int k = 0; k < n_mine; ++k) {
        const int it = !reb ? bid + k * G : (bid < N_ADA ? (k == 0 ? bid : N_ADA + XA * bid + (k - 1)) : N_ADA + XA * N_ADA + (bid - N_ADA) + 160 * k);
        int i = it;
        if (i < N_ADA) { const int l = i / 48, n0 = (i % 48) * 64;
            skinny_item<36>(lds, w_ada + (size_t)l * 1024 * 3072, 3072, n0, 64, 33,
                [&](int m, int k) { return siluf_(m < 32 ? c_s[m * 1024 + k] : c_p[k]); },
                [&](int m, int n, float v) { ADA[((size_t)l * 33 + m) * 3072 + n] = v + b_ada[l * 3072 + n]; });
            continue; }
        i -= N_ADA;
        if (i < N_WTIN) { const int l = i / 960, r = i % 960, n0 = (r / 16) * 64, k0 = (r % 16) * 64; const float* src = w_in + (size_t)l * 1024 * DIN; f16* dst = WTIN + (size_t)l * NPD * 1024;
            tr64(lds, [&](int kk, int nn) { const int sc = src_col(n0 + nn); return sc >= 0 ? src[(size_t)(k0 + kk) * DIN + sc] : 0.f; },
                      [&](int nn, int kk, f16 v) { dst[(size_t)(n0 + nn) * 1024 + k0 + kk] = v; });
            continue; }
        i -= N_WTIN;
        if (i < N_WTOUT) { const int l = i / 256, r = i % 256, n0 = (r / 16) * 64, k0 = (r % 16) * 64; const float* src = w_out + (size_t)l * 1024 * 1024; f16* dst = WTOUT + (size_t)l * 1024 * 1024;
            tr64(lds, [&](int kk, int nn) { return src[(size_t)(k0 + kk) * 1024 + n0 + nn]; },
                      [&](int nn, int kk, f16 v) { dst[(size_t)(n0 + nn) * 1024 + k0 + kk] = v; });
            continue; }
        i -= N_WTOUT;
        if (i < N_W1T) { const int ls = i / 64, r = i % 64, k0 = (r / 2) * 64, n0 = (r % 2) * 64; const float* src = w1 + (size_t)ls * 2048 * 128; f16* dst = W1T + (size_t)ls * 128 * 2048;
            tr64(lds, [&](int kk, int nn) { return src[(size_t)(k0 + kk) * 128 + n0 + nn]; },
                      [&](int nn, int kk, f16 v) { dst[(size_t)(n0 + nn) * 2048 + k0 + kk] = v; });
            continue; }
        i -= N_W1T;
        if (i < N_PEB) { const int ls = i >> 3, ks8 = i & 7; const float* pe = INP(I_PE) + (size_t)ls * 2048 + ks8 * 256; const float* w = w1 + ((size_t)ls * 2048 + ks8 * 256) * 128; const float* b1 = INP(I_B1) + ls * 128;
            LAS float* R = (LAS float*)lds; const int f = tid & 127, kq = tid >> 7; float sacc = 0.f;
            __syncthreads();
#pragma unroll 16
            for (int k = kq * 64; k < kq * 64 + 64; ++k) sacc += pe[k] * w[(size_t)k * 128 + f];
            R[kq * 128 + f] = sacc; __syncthreads();
            if (tid < 128) WSF(WS_PEBP)[(ls * 8 + ks8) * 128 + tid] = (ks8 == 0 ? b1[tid] : 0.f) + (R[tid] + R[128 + tid]) + (R[256 + tid] + R[384 + tid]);
            __syncthreads();
            continue; }
        i -= N_PEB;
        if (i < N_W2T) { const int ls = i >> 1, f0 = (i & 1) * 64; const float* src = INP(I_W2) + (size_t)ls * 128 * 64; f16* dst = WSH(WS_W2T) + (size_t)ls * 64 * 128;
            tr64(lds, [&](int kk, int nn) { return src[(size_t)(f0 + kk) * 64 + nn]; },
                      [&](int nn, int kk, f16 v) { dst[(size_t)nn * 128 + f0 + kk] = v; });
            continue; }
        for (int e = tid; e < 2 * NPD; e += 512) BIAS[e] = 0.f;
    }
}

DI void ph_sample_compress(LAS unsigned char* lds_) {
    const Ctx c = mkctx(lds_);
    const float* w2 = INP(I_W2); const float* b2 = INP(I_B2); const float* k_g = INP(I_KG); const float* cache_kv = INP(I_CKV); const int* page_table = (const int*)c.ap->in[I_PT];
    f16* W1T = WSH(WS_W1T); float* PEB = WSF(WS_PEBP); float* KCS = WSF(WS_KCS); float* VCS = WSF(WS_VCS);
    for (int it = c.bid; it < 1152; it += c.G) {
        const int grp = it < 1024 ? it & 7 : 8, st_ = it < 1024 ? it >> 3 : it - 1024, slot = st_ & 1, b = (st_ >> 1) & 31, l = st_ >> 6;
        const float* ckv = cache_kv + (size_t)l * NPOOL * 128 * 256; const int* pt = page_table + b * 128;
        compress_item<true>(c.lds, [&](int ch) { return (const void*)(ckv + ((size_t)pt[ch >> 3] * 128 + (ch & 7) * 16) * 256 + slot * 64); }, grp * 127,
                            W1T + (size_t)(l * 2 + slot) * 128 * 2048, PEB + (l * 2 + slot) * 1024, WSH(WS_W2T) + (size_t)(l * 2 + slot) * 64 * 128, b2 + (l * 2 + slot) * 64,
                            slot == 0 ? k_g + l * 192 : nullptr, (slot == 0 ? KCS : VCS) + (size_t)(l * NB + b) * 1024 * 64, nullptr, nullptr);
    }
}
DI void ph_prep(LAS unsigned char* lds_) {
    const Ctx c = mkctx(lds_); const int tid = c.tid, lane = c.lane, wave = c.wave, bid = c.bid, G = c.G;
    float* ADA = WSF(WS_ADA); float* BIAS = WSF(WS_BIAS);
    {
        const f16* WTIN = WSH(WS_WTIN);
        const bool lite = G == 256;
        const int pb = lite ? bid - 128 : bid, pG = lite ? 128 : G;
        if (pb >= 0)
        for (int col0 = pb * 8 + wave; col0 < 2 * NPD; col0 += pG * 32) {
            f16x8 w[4][2]; f32x4 sv[4][4];
#pragma unroll
            for (int k = 0; k < 4; ++k) { int col = col0 + k * pG * 8; col = col < 2 * NPD ? col : 2 * NPD - 1; const int l = col / NPD;
                const float* sh = ADA + ((size_t)l * 33 + 32) * 3072 + lane * 16; const f16* wp = WTIN + (size_t)col * 1024 + lane * 16;
                w[k][0] = ld_h8(wp); w[k][1] = ld_h8(wp + 8);
#pragma unroll
                for (int i = 0; i < 4; ++i) sv[k][i] = *(const f32x4*)(sh + 4 * i); }
#pragma unroll
            for (int k = 0; k < 4; ++k) { const int col = col0 + k * pG * 8; float acc = 0.f;
#pragma unroll
                for (int i = 0; i < 8; ++i) acc += sv[k][i >> 2][i & 3] * (float)w[k][0][i] + sv[k][2 + (i >> 2)][i & 3] * (float)w[k][1][i];
                acc = wsum(acc); if (lane == 0 && col < 2 * NPD) BIAS[col] = acc; } }
    }
    const float* ng = INP(I_NG);
    if (bid == 0) { float* GNX = WSF(WS_GNX); const float* sc1 = ADA + (size_t)(33 + 32) * 3072 + 1024;
        for (int k = tid; k < 1024; k += 512) GNX[k] = ng[1024 + k] * (1.f + sc1[k]); }
    const float* ada_p = ADA + (size_t)32 * 3072; const float* x_p = INP(I_XP); f16* A16 = WSH(WS_A16); float* RSSP = WSF(WS_RSSP);
    float gp[16];
#pragma unroll
    for (int i = 0; i < 4; ++i) { const f32x4 g4 = *(const f32x4*)(ng + i * 256 + lane * 4), s4 = *(const f32x4*)(ada_p + 1024 + i * 256 + lane * 4);
#pragma unroll
        for (int j = 0; j < 4; ++j) gp[i * 4 + j] = g4[j] * (1.f + s4[j]); }
    const bool lite2 = G == 256; const int pb2 = lite2 ? bid - 128 : bid, pG2 = lite2 ? 128 : G;
    if (pb2 >= 0)
    for (int row0 = pb2 * 8 + wave; row0 < SEQ; row0 += pG2 * 32) {
        f32x4 v[4][4];
#pragma unroll
        for (int k = 0; k < 4; ++k) { int row = row0 + k * pG2 * 8; row = row < SEQ ? row : SEQ - 1;
#pragma unroll
            for (int i = 0; i < 4; ++i) v[k][i] = *(const f32x4*)(x_p + (size_t)row * 1024 + i * 256 + lane * 4); }
#pragma unroll
        for (int k = 0; k < 4; ++k) { const int row = row0 + k * pG2 * 8; float ss = 0.f;
            if (row < SEQ) {
#pragma unroll
                for (int i = 0; i < 4; ++i) { const f32x4 u = v[k][i]; ss += (u[0] * u[0] + u[1] * u[1]) + (u[2] * u[2] + u[3] * u[3]);
                    f16x4 h; h[0] = (f16)(u[0] * gp[i * 4]); h[1] = (f16)(u[1] * gp[i * 4 + 1]); h[2] = (f16)(u[2] * gp[i * 4 + 2]); h[3] = (f16)(u[3] * gp[i * 4 + 3]);
                    *(f16x4*)(A16 + (size_t)row * 1024 + i * 256 + lane * 4) = h; }
                ss = wsum(ss);
                if (lane < 16) RSSP[(size_t)row * 16 + lane] = lane == 0 ? ss : 0.f; } }
    }
}

template <int NT  , class OFn>
DI void sample_gemm_item(LAS unsigned char* lds, const f16* Bt, int n0, OFn ofn) {
    constexpr int KW = 8 / NT, KL = 1024 / KW;
    const int tid = ltid(), wave = tid >> 6, lane = tid & 63, wn = wave % NT, wk = wave / NT, r = lane & 31, h = lane >> 5;
    const LAS f16* Ah = (const LAS f16*)lds + r * 1032 + wk * KL + 8 * h; const f16* bp = Bt + (size_t)(n0 + 32 * wn + r) * 1024 + wk * KL + 8 * h;
    f32x16 acc;
#pragma unroll
    for (int i = 0; i < 16; ++i) acc[i] = 0.f;
#pragma unroll 8
    for (int st = 0; st < KL / 16; ++st) acc = __builtin_amdgcn_mfma_f32_32x32x16_f16(*(const LAS f16x8*)(Ah + 16 * st), ld_h8(bp + 16 * st), acc, 0, 0, 0);
    LAS float* RED = (LAS float*)(lds + 67584);
#pragma unroll
    for (int i = 0; i < 16; ++i) RED[(wk * 32 + (i & 3) + 8 * (i >> 2) + 4 * h) * (32 * NT) + 32 * wn + r] = acc[i];
    __syncthreads();
    for (int e = tid; e < 1024 * NT; e += 512) { float v = 0.f;
#pragma unroll
        for (int w = 0; w < KW; ++w) v += RED[w * 1024 * NT + e];
        ofn(e / (32 * NT), n0 + e % (32 * NT), v); }
    __syncthreads();
}
DI void ph_inproj(LAS unsigned char* lds_, int l) {
    const Ctx c = mkctx(lds_);
    pg8::Gemm g{WSH(WS_A16), WSH(WS_WTIN) + (size_t)l * NPD * 1024, SEQ, NPD, 1024}; pg8::StaticOrder S; S.init(SEQ, NPD, c.G, c.bid);
    EpiIn E{WSH(WS_PROJ), WSF(WS_RSSP), WSF(WS_BIAS) + l * NPD, c.out + O_KVP + (size_t)l * SEQ * 256};
    pg8::gemm_phase<EpiIn, pg8::StaticOrder>(c.lds, g, S, E);
    __syncthreads();
}
DI void ph_hsample(LAS unsigned char* lds_, int l) {
    const Ctx c = mkctx(lds_); const int lane = c.lane;
    if (c.bid >= 4) return;
    const int m = c.bid * 8 + c.wave;
    const float* xr = (l == 0 ? INP(I_XS) : WSF(WS_XS1)) + (size_t)m * 1024; const float* ad = WSF(WS_ADA) + ((size_t)l * 33 + m) * 3072; const float* ng = INP(I_NG) + l * 1024; f16* hs = WSH(WS_HS16) + (size_t)m * 1024;
    f32x4 xv[4]; float ss = 0.f;
#pragma unroll
    for (int i = 0; i < 4; ++i) { xv[i] = *(const f32x4*)(xr + i * 256 + lane * 4); ss += (xv[i][0] * xv[i][0] + xv[i][1] * xv[i][1]) + (xv[i][2] * xv[i][2] + xv[i][3] * xv[i][3]); }
    const float rn = rsqrtf(wsum(ss) * (1.f / 1024.f) + EPS);
#pragma unroll
    for (int i = 0; i < 4; ++i) { const int k = i * 256 + lane * 4; const f32x4 g = *(const f32x4*)(ng + k), sc = *(const f32x4*)(ad + 1024 + k), sh = *(const f32x4*)(ad + k); f16x4 hv;
#pragma unroll
        for (int j = 0; j < 4; ++j) hv[j] = (f16)(xv[i][j] * rn * g[j] * (1.f + sc[j]) + sh[j]);
        *(f16x4*)(hs + k) = hv; }
}
DI void ph_inproj_sample(LAS unsigned char* lds_, int l) {
    const Ctx c = mkctx(lds_); const int tid = c.tid;
    const int it = c.bid - (c.G - 64);
    if (it < 0 || it >= 60) return;
    float* PROJS = WSF(WS_PROJS); const f16* HS = WSH(WS_HS16); LAS f16* Ah = (LAS f16*)c.lds;
    __syncthreads();
#pragma unroll
    for (int i = 0; i < 8; ++i) { const int e = (tid + 512 * i) * 8; *(LAS f16x8*)(Ah + (e >> 10) * 1032 + (e & 1023)) = ld_h8(HS + e); }
    __syncthreads();
    sample_gemm_item<2>(c.lds, WSH(WS_WTIN) + (size_t)l * NPD * 1024, it * 64, [&](int m, int n, float v) { PROJS[m * NPD + n] = v; });
}

#define PT(t) (P + (size_t)(t) * SEQ * 256)
DI void ph_ssd_local(LAS unsigned char* lds_, int l) {
    const Ctx c = mkctx(lds_); LAS unsigned char* lds = c.lds; const int tid = c.tid, lane = c.lane, wave = c.wave;
    const f16* P = WSH(WS_PROJ); f16* ACT = WSH(WS_ACT); float* YD = WSF(WS_YD); float* CST = WSF(WS_CST); float* ACS = WSF(WS_ACS); float* CDEC = WSF(WS_CDEC); float* out = c.out;
    const float* dtb = INP(I_DTB) + l * 4; const float* alog = INP(I_ALOG) + l * 4; const float* cw = INP(I_BCW) + l * 4 * 768; const float* cb = INP(I_BCB) + l * 768;
    LAS f16* Bm = (LAS f16*)lds; LAS f16* BT = (LAS f16*)(lds + 34816); LAS f16* Cm = (LAS f16*)(lds + 69632); LAS f16* XT = (LAS f16*)(lds + 104448);
    LAS float* acs = (LAS float*)(lds + 139264); LAS float* dtl = acs + 256; LAS f16* te16 = (LAS f16*)(dtl + 256);
    for (int it = c.bid; it < 256; it += c.G) {
        const int ch_ = it >> 1, g = it & 1, t0 = ch_ * 128;
        __syncthreads();
        if (tid < 256) { const int hh = tid >> 7, lt = tid & 127, hd = 2 * g + hh; const float raw = (float)PT(13)[(size_t)(t0 + lt) * 256 + 128 + hd];
            const float dt = softplusf_(raw + dtb[hd]); dtl[hh * 128 + lt] = dt; acs[hh * 128 + lt] = dt * (-__expf(alog[hd])); }
        __syncthreads();
        if (tid == 0 || tid == 64) { const int hh = tid >> 6; float sacc = 0.f; for (int i = 0; i < 128; ++i) { sacc += acs[hh * 128 + i]; acs[hh * 128 + i] = sacc; } }
        __syncthreads();
        if (tid < 256) { const int hh = tid >> 7, lt = tid & 127, hd = 2 * g + hh; const float av = acs[hh * 128 + lt], ae = acs[hh * 128 + 127];
            te16[hh * 128 + lt] = (f16)__expf(ae - av); ACS[(size_t)(t0 + lt) * 4 + hd] = av; if (lt == 127) CDEC[ch_ * 4 + hd] = __expf(ae); }
#pragma unroll 3
        for (int e = tid; e < 128 * 48; e += 512) {
            const int lt = (e >> 2) & 127, cg = (e >> 9) * 4 + (e & 3), reg = cg >> 4, c8 = (cg & 15) * 8, t = t0 + lt, col = 128 * g + c8, ch = reg * 256 + col;
            const f16* src = PT(5 + reg) + col; float y[8]; f16x8 rawt;
#pragma unroll
            for (int i = 0; i < 8; ++i) y[i] = cb[ch + i];
#pragma unroll
            for (int k = 0; k < 4; ++k) { const int tt = t - 3 + k; f16x8 v; if (tt >= 0) v = ld_h8(src + (size_t)tt * 256); else {
#pragma unroll
                    for (int i = 0; i < 8; ++i) v[i] = (f16)0.f; }
                if (k == 3) rawt = v;
#pragma unroll
                for (int i = 0; i < 8; ++i) y[i] += cw[k * 768 + ch + i] * (float)v[i]; }
            f16x8 act;
#pragma unroll
            for (int i = 0; i < 8; ++i) { y[i] = siluf_(y[i]); act[i] = (f16)y[i]; }
            *(f16x8*)(ACT + (size_t)t * 768 + ch) = act;
            if (reg == 0) { const int hh = c8 >> 6; const float sdt = dtl[hh * 128 + lt] * 64.f;
#pragma unroll
                for (int i = 0; i < 8; ++i) XT[(c8 + i) * 136 + lt] = (f16)(y[i] * sdt); }
            else if (reg == 1) { *(LAS f16x8*)(Bm + lt * 136 + c8) = act;
#pragma unroll
                for (int i = 0; i < 8; ++i) BT[(c8 + i) * 136 + lt] = act[i]; }
            else *(LAS f16x8*)(Cm + lt * 136 + c8) = act;
            if (t >= SEQ - 3) { float* so = out + O_BCP + (size_t)l * 2304 + (t - (SEQ - 3)) * 768 + ch;
#pragma unroll
                for (int i = 0; i < 8; ++i) so[i] = (float)rawt[i]; }
        }
        __syncthreads();
        const int fr = lane & 15, q = lane >> 4, w = wave;
        f32x4 gt[8];
#pragma unroll
        for (int mt = 0; mt < 8; ++mt) { gt[mt] = (f32x4){0.f, 0.f, 0.f, 0.f};
            if (mt <= w) {
#pragma unroll
                for (int ks = 0; ks < 4; ++ks) { const f16x8 av = *(const LAS f16x8*)(Bm + (16 * mt + fr) * 136 + 32 * ks + 8 * q), bv = *(const LAS f16x8*)(Cm + (16 * w + fr) * 136 + 32 * ks + 8 * q);
                    gt[mt] = __builtin_amdgcn_mfma_f32_16x16x32_f16(av, bv, gt[mt], 0, 0, 0); } } }
#pragma unroll
        for (int hh = 0; hh < 2; ++hh) {
            const int lrow = 16 * w + fr; const float al = acs[hh * 128 + lrow];
            f32x4 ya[4];
#pragma unroll
            for (int pt = 0; pt < 4; ++pt) ya[pt] = (f32x4){0.f, 0.f, 0.f, 0.f};
#pragma unroll
            for (int k2 = 0; k2 < 4; ++k2) {
                if (2 * k2 <= w) {
                    f16x8 af;
#pragma unroll
                    for (int j = 0; j < 8; ++j) { const int m = 32 * k2 + (j < 4 ? 4 * q + j : 16 + 4 * q + (j - 4)); const float gv = j < 4 ? gt[2 * k2][j] : gt[2 * k2 + 1][j - 4];
                        af[j] = (f16)(m <= lrow ? gv * __expf(al - acs[hh * 128 + m]) : 0.f); }
#pragma unroll
                    for (int pt = 0; pt < 4; ++pt) { const LAS f16* xp = XT + (hh * 64 + 16 * pt + fr) * 136 + 32 * k2 + 4 * q; const f16x4 b0 = *(const LAS f16x4*)xp, b1 = *(const LAS f16x4*)(xp + 16);
                        f16x8 bf; bf[0] = b0[0]; bf[1] = b0[1]; bf[2] = b0[2]; bf[3] = b0[3]; bf[4] = b1[0]; bf[5] = b1[1]; bf[6] = b1[2]; bf[7] = b1[3];
                        ya[pt] = __builtin_amdgcn_mfma_f32_16x16x32_f16(af, bf, ya[pt], 0, 0, 0); }
                }
            }
#pragma unroll
            for (int pt = 0; pt < 4; ++pt)
#pragma unroll
                for (int j = 0; j < 4; ++j) YD[(size_t)(t0 + 16 * w + 4 * q + j) * 256 + (2 * g + hh) * 64 + 16 * pt + fr] = ya[pt][j] * (1.f / 64.f);
#pragma unroll
            for (int pt = 0; pt < 4; ++pt) { f32x4 sa = (f32x4){0.f, 0.f, 0.f, 0.f};
#pragma unroll
                for (int ks = 0; ks < 4; ++ks) { const f16x8 xv = *(const LAS f16x8*)(XT + (hh * 64 + 16 * pt + fr) * 136 + 32 * ks + 8 * q), tv = *(const LAS f16x8*)(te16 + hh * 128 + 32 * ks + 8 * q);
                    const f16x8 bv = *(const LAS f16x8*)(BT + (16 * w + fr) * 136 + 32 * ks + 8 * q);
                    sa = __builtin_amdgcn_mfma_f32_16x16x32_f16(xv * tv, bv, sa, 0, 0, 0); }
#pragma unroll
                for (int j = 0; j < 4; ++j) CST[((size_t)(ch_ * 4 + 2 * g + hh) * 64 + 16 * pt + 4 * q + j) * 128 + 16 * w + fr] = sa[j] * (1.f / 64.f); }
        }
    }
    __syncthreads();
}
DI void ph_mix_a(LAS unsigned char* lds_, int l) {
    const Ctx c = mkctx(lds_); const int tid = c.tid;
    const f16* P = WSH(WS_PROJ); f16* Y16 = WSH(WS_Y16); float* out = c.out; const float* scw = INP(I_SCW) + l * 768;
    for (int it = c.bid; it < 256; it += c.G) {
        for (int e = tid; e < 64 * 32; e += 512) { const int t = it * 64 + (e >> 5), c0 = (e & 31) * 8; float u[3][8];
#pragma unroll
            for (int k = 0; k < 3; ++k) { const int tt = t - 2 + k;
                if (tt >= 0) { const f16x8 h = ld_h8(PT(0) + (size_t)tt * 256 + c0), cc = ld_h8(PT(2) + (size_t)tt * 256 + c0);
#pragma unroll
                    for (int i = 0; i < 8; ++i) u[k][i] = (float)cc[i] * (float)h[i]; }
                else {
#pragma unroll
                    for (int i = 0; i < 8; ++i) u[k][i] = 0.f; } }
            const f16x8 bb = ld_h8(PT(1) + (size_t)t * 256 + c0), gg = ld_h8(PT(3) + (size_t)t * 256 + c0); f16x8 o;
#pragma unroll
            for (int i = 0; i < 8; ++i) { const float y = scw[c0 + i] * u[0][i] + scw[256 + c0 + i] * u[1][i] + scw[512 + c0 + i] * u[2][i]; o[i] = (f16)(siluf_((float)gg[i]) * (float)bb[i] * y); }
            *(f16x8*)(Y16 + (size_t)t * 1024 + c0) = o;
            if (t >= SEQ - 2) { float* so = out + O_SCP + (size_t)l * 512 + (t - (SEQ - 2)) * 256 + c0;
#pragma unroll
                for (int i = 0; i < 8; ++i) so[i] = u[2][i]; }
        }
    }
}
DI void ph_mix_c(LAS unsigned char* lds_, int l) {
    const Ctx c = mkctx(lds_); const int tid = c.tid, lane = c.lane, wave = c.wave;
    const f16* P = WSH(WS_PROJ); f16* Y16 = WSH(WS_Y16); float* out = c.out;
    const float* cfw = INP(I_CFW) + l * 31 * 256; const float* cfb = INP(I_CFB) + l * 256; const float* lng = INP(I_LNG) + l * 256; const float* lnb = INP(I_LNB) + l * 256;
    LAS float* GL = (LAS float*)c.lds;
    f32x4 wt[31];
#pragma unroll
    for (int k = 0; k < 31; ++k) wt[k] = *(const f32x4*)(cfw + k * 256 + lane * 4);
    const f32x4 bias4 = *(const f32x4*)(cfb + lane * 4), g4 = *(const f32x4*)(lng + lane * 4), b4 = *(const f32x4*)(lnb + lane * 4);
    for (int it = c.bid; it < 256; it += c.G) {
        __syncthreads();
        for (int e = tid; e < 94 * 32; e += 512) { const int rr = e >> 5, c0 = (e & 31) * 8, t = it * 64 - 30 + rr; f32x4 g0 = (f32x4){0.f, 0.f, 0.f, 0.f}, g1 = g0;
            if (t >= 0) { const f16x8 ga = ld_h8(PT(8) + (size_t)t * 256 + c0), gb = ld_h8(PT(9) + (size_t)t * 256 + c0);
#pragma unroll
                for (int i = 0; i < 4; ++i) { g0[i] = (float)ga[i] * sigmoidf_((float)gb[i]); g1[i] = (float)ga[4 + i] * sigmoidf_((float)gb[4 + i]); }
                if (t >= SEQ - 30) { float* so = out + O_CFP + (size_t)l * 7680 + (t - (SEQ - 30)) * 256 + c0; *(f32x4*)so = g0; *(f32x4*)(so + 4) = g1; } }
            *(LAS f32x4*)(GL + rr * 256 + c0) = g0; *(LAS f32x4*)(GL + rr * 256 + c0 + 4) = g1; }
        __syncthreads();
        {
            const int cc = lane * 4, tb = wave * 8;
            f32x4 u[8];
#pragma unroll
            for (int j = 0; j < 8; ++j) u[j] = bias4;
#pragma unroll
            for (int r = 0; r < 38; ++r) { const f32x4 gv = *(const LAS f32x4*)(GL + (tb + r) * 256 + cc);
#pragma unroll
                for (int j = 0; j < 8; ++j) if (r - j >= 0 && r - j <= 30) u[j] += wt[r - j] * gv; }
#pragma unroll
            for (int j = 0; j < 8; ++j) { const int t = it * 64 + tb + j;
                const float mean = wsum((u[j][0] + u[j][1]) + (u[j][2] + u[j][3])) * (1.f / 256.f); const f32x4 d = u[j] - mean;
                const float var = wsum((d[0] * d[0] + d[1] * d[1]) + (d[2] * d[2] + d[3] * d[3])) * (1.f / 256.f); const float rs = rsqrtf(var + EPS);
                const f16x4 cg = *(const f16x4*)(PT(10) + (size_t)t * 256 + cc); f16x4 o;
#pragma unroll
                for (int i = 0; i < 4; ++i) o[i] = (f16)(siluf_((float)cg[i]) * siluf_(d[i] * rs * g4[i] + b4[i]));
                *(f16x4*)(Y16 + (size_t)t * 1024 + 512 + cc) = o; }
        }
    }
    __syncthreads();
}
DI void ph_mix_d(LAS unsigned char* lds_, int l) {
    const Ctx c = mkctx(lds_); const int tid = c.tid, lane = c.lane, wave = c.wave;
    const f16* P = WSH(WS_PROJ); float* out = c.out; float* kvp_out = out + O_KVP + (size_t)l * SEQ * 256;
    f16* Q16 = WSH(WS_Q16); f16* KS16 = WSH(WS_KS16); f16* KW16 = WSH(WS_KW16); f16* VST16 = WSH(WS_VST16); f16* VWT16 = WSH(WS_VWT16); float* GATES = WSF(WS_GATES);
    const int d4 = (lane & 15) * 4, v4 = lane >> 4;
    const f32x4 qg = *(const f32x4*)(INP(I_QG) + l * 64 + d4), kg1 = *(const f32x4*)(INP(I_KG) + l * 192 + 64 + d4), kg2 = *(const f32x4*)(INP(I_KG) + l * 192 + 128 + d4);
    LAS f16* VSs = (LAS f16*)c.lds; LAS f16* VWs = VSs + 64 * 68;
    if (c.bid < 18 && c.G > 36) return;
    for (int it = c.bid - 18 >= 0 && c.G > 36 ? c.bid - 18 : c.bid; it < 256; it += (c.G > 36 ? c.G - 18 : c.G)) {
        __syncthreads();
        for (int vi = wave * 4 + v4; vi < 256; vi += 32) { const size_t off = (size_t)(it * 64) * 256 + (size_t)vi * 64 + d4; const f16x4 x = *(const f16x4*)(PT(11) + off);
            const float a0 = (float)x[0], a1 = (float)x[1], a2 = (float)x[2], a3 = (float)x[3]; const float rn = rsqrtf(sum16((a0 * a0 + a1 * a1) + (a2 * a2 + a3 * a3)) * (1.f / 64.f) + EPS);
            f16x4 y; y[0] = (f16)(a0 * rn * qg[0]); y[1] = (f16)(a1 * rn * qg[1]); y[2] = (f16)(a2 * rn * qg[2]); y[3] = (f16)(a3 * rn * qg[3]); *(f16x4*)(Q16 + off) = y; }
        for (int tl = wave * 4 + v4; tl < 64; tl += 32) { const int t = it * 64 + tl;
            { const f16x4 x = *(const f16x4*)(PT(12) + (size_t)t * 256 + 128 + d4), vv = *(const f16x4*)(PT(12) + (size_t)t * 256 + 192 + d4);
                const float a0 = (float)x[0], a1 = (float)x[1], a2 = (float)x[2], a3 = (float)x[3]; const float rn = rsqrtf(sum16((a0 * a0 + a1 * a1) + (a2 * a2 + a3 * a3)) * (1.f / 64.f) + EPS);
                const f32x4 kn = (f32x4){a0 * rn * kg1[0], a1 * rn * kg1[1], a2 * rn * kg1[2], a3 * rn * kg1[3]}; *(f32x4*)(kvp_out + (size_t)t * 256 + 128 + d4) = kn;
                f16x4 y; y[0] = (f16)kn[0]; y[1] = (f16)kn[1]; y[2] = (f16)kn[2]; y[3] = (f16)kn[3]; *(f16x4*)(KS16 + (size_t)t * 64 + d4) = y; *(LAS f16x4*)(VSs + tl * 68 + d4) = vv; }
            { const f16x4 x = *(const f16x4*)(PT(13) + (size_t)t * 256 + d4), vv = *(const f16x4*)(PT(13) + (size_t)t * 256 + 64 + d4);
                const float a0 = (float)x[0], a1 = (float)x[1], a2 = (float)x[2], a3 = (float)x[3]; const float rn = rsqrtf(sum16((a0 * a0 + a1 * a1) + (a2 * a2 + a3 * a3)) * (1.f / 64.f) + EPS);
                const f32x4 kn = (f32x4){a0 * rn * kg2[0], a1 * rn * kg2[1], a2 * rn * kg2[2], a3 * rn * kg2[3]};
                f16x4 y; y[0] = (f16)kn[0]; y[1] = (f16)kn[1]; y[2] = (f16)kn[2]; y[3] = (f16)kn[3]; *(f16x4*)(KW16 + (size_t)t * 64 + d4) = y; *(LAS f16x4*)(VWs + tl * 68 + d4) = vv;
                if (t >= SEQ - 512) { float* wo = out + O_WINP + (size_t)l * 512 * 128 + (size_t)(t - (SEQ - 512)) * 128; *(f32x4*)(wo + d4) = kn; *(f32x4*)(wo + 64 + d4) = (f32x4){(float)vv[0], (float)vv[1], (float)vv[2], (float)vv[3]}; } }
        }
        for (int e = tid; e < 64 * 12; e += 512) { const int tl = e / 12, gi = e % 12; GATES[(size_t)(it * 64 + tl) * 12 + gi] = sigmoidf_((float)PT(13)[(size_t)(it * 64 + tl) * 256 + 132 + gi]); }
        __syncthreads();
        { const int d = tid >> 3, k8 = (tid & 7) * 8; f16x8 a, b;
#pragma unroll
            for (int i = 0; i < 8; ++i) { const int key = vt_key(k8 + i); a[i] = VSs[key * 68 + d]; b[i] = VWs[key * 68 + d]; }
            *(f16x8*)(VST16 + (size_t)it * 4096 + d * 64 + k8) = a; *(f16x8*)(VWT16 + (size_t)it * 4096 + d * 64 + k8) = b; }
    }
    __syncthreads();
}
DI void ph_mix_cmp(LAS unsigned char* lds_, int l) {
    const Ctx c = mkctx(lds_);
    const f16* P = WSH(WS_PROJ); const float* w2 = INP(I_W2); const float* b2 = INP(I_B2); const float* k_g = INP(I_KG); f16* W1T = WSH(WS_W1T); float* PEB = WSF(WS_PEBP);
    for (int it = c.bid; it < 18; it += c.G) { const int slot = it / 9, grp = it % 9; const f16* src = PT(12) + slot * 64;
        compress_item<false>(c.lds, [&](int ch) { return (const void*)(src + (size_t)ch * 16 * 256); }, grp * 127,
                             W1T + (size_t)(l * 2 + slot) * 128 * 2048, PEB + (l * 2 + slot) * 1024, WSH(WS_W2T) + (size_t)(l * 2 + slot) * 64 * 128, b2 + (l * 2 + slot) * 64,
                             slot == 0 ? k_g + l * 192 : nullptr, nullptr, slot == 0 ? WSH(WS_KC16) : nullptr, slot == 0 ? nullptr : WSH(WS_VCT16)); }
}
#undef PT
template <int N>
DI void blk_reduce(LAS float* red, LAS float* bc, float (&v)[N], bool is_max, int wave, int lane) {
#pragma unroll
    for (int i = 0; i < N; ++i) v[i] = is_max ? wmaxf(v[i]) : wsum(v[i]);
    __syncthreads();
    if (lane == 0) {
#pragma unroll
        for (int i = 0; i < N; ++i) red[wave * 12 + i] = v[i]; }
    __syncthreads();
    if (wave == 0 && lane < N) { float r = red[lane]; for (int w = 1; w < 8; ++w) r = is_max ? fmaxf(r, red[w * 12 + lane]) : r + red[w * 12 + lane]; bc[lane] = r; }
    __syncthreads();
#pragma unroll
    for (int i = 0; i < N; ++i) v[i] = bc[i];
}
DI void nsa_sample_block(LAS float* wl, const float* KC, const float* VC, const SampleKV& kv, const LAS float* gsm, const float* dgp, float* ysd, int tid, int lane, int wave) {
    LAS float* sc = wl; LAS float* qs = wl + 10496; LAS float* PSL = qs + 256; LAS float* red = PSL + 1024; LAS float* bc = red + 96; LAS int* sel = (LAS int*)(bc + 16); LAS float* part = bc + 32;
    constexpr int NCV = 1023, CUR = PAST >> 6;
    float mv[8], sv[8];
#pragma unroll
    for (int i = 0; i < 8; ++i) mv[i] = -3e38f;
    for (int cidx = tid; cidx < NCV; cidx += 512) {
        asm volatile("" ::: "memory");
        float kr[64]; kv.ld64(KC + (size_t)cidx * 64, kr); float s4[4] = {0.f, 0.f, 0.f, 0.f};
#pragma unroll
        for (int d = 0; d < 64; ++d) { const f32x4 qv = *(const LAS f32x4*)(qs + d * 4); s4[0] += qv[0] * kr[d]; s4[1] += qv[1] * kr[d]; s4[2] += qv[2] * kr[d]; s4[3] += qv[3] * kr[d]; }
#pragma unroll
        for (int hh = 0; hh < 4; ++hh) { s4[hh] *= 0.125f; sc[hh * 2624 + cidx] = s4[hh]; mv[hh] = fmaxf(mv[hh], s4[hh]); }
    }
    for (int i = tid; i < 513; i += 512) {
        asm volatile("" ::: "memory");
        float kr[64]; kv.krow_win(PAST - 512 + i, kr); float s4[4] = {0.f, 0.f, 0.f, 0.f};
#pragma unroll
        for (int d = 0; d < 64; ++d) { const f32x4 qv = *(const LAS f32x4*)(qs + d * 4); s4[0] += qv[0] * kr[d]; s4[1] += qv[1] * kr[d]; s4[2] += qv[2] * kr[d]; s4[3] += qv[3] * kr[d]; }
#pragma unroll
        for (int hh = 0; hh < 4; ++hh) { s4[hh] *= 0.125f; sc[hh * 2624 + 2048 + i] = s4[hh]; mv[4 + hh] = fmaxf(mv[4 + hh], s4[hh]); }
    }
    blk_reduce<8>(red, bc, mv, true, wave, lane);
#pragma unroll
    for (int i = 0; i < 8; ++i) sv[i] = 0.f;
    for (int cidx = tid; cidx < NCV; cidx += 512) {
#pragma unroll
        for (int hh = 0; hh < 4; ++hh) { const float e = __expf(sc[hh * 2624 + cidx] - mv[hh]); sc[hh * 2624 + cidx] = e; sv[hh] += e; } }
    for (int i = tid; i < 513; i += 512) {
#pragma unroll
        for (int hh = 0; hh < 4; ++hh) { const float e = __expf(sc[hh * 2624 + 2048 + i] - mv[4 + hh]); sc[hh * 2624 + 2048 + i] = e; sv[4 + hh] += e; } }
    blk_reduce<8>(red, bc, sv, false, wave, lane);
    float invc[4], invw[4];
#pragma unroll
    for (int hh = 0; hh < 4; ++hh) { invc[hh] = 1.f / sv[hh]; invw[hh] = 1.f / sv[4 + hh]; }
    for (int cidx = tid; cidx < 1024; cidx += 512) PSL[cidx] = cidx < NCV ? (sc[cidx] * invc[0] + sc[2624 + cidx] * invc[1]) + (sc[2 * 2624 + cidx] * invc[2] + sc[3 * 2624 + cidx] * invc[3]) : 0.f;
    __syncthreads();
    if (wave == 0) {
        float scv[5];
#pragma unroll
        for (int i = 0; i < 5; ++i) { const int j = lane + 64 * i; float v = -3e38f;
            if (j <= CUR) { if (j == 0 || j == CUR || j == CUR - 1) v = 3e38f; else { float a = 0.f;
#pragma unroll
                    for (int o5 = -1; o5 < 4; ++o5) { const int cc = 4 * j + o5; if (cc >= 0 && cc < NCV) a += (o5 == -1 || o5 == 3) ? 0.5f * PSL[cc] : PSL[cc]; }
                    v = a; } }
            scv[i] = v; }
        for (int k = 0; k < 16; ++k) {
            float bv = scv[0]; int bi = lane;
#pragma unroll
            for (int i = 1; i < 5; ++i) if (scv[i] > bv) { bv = scv[i]; bi = lane + 64 * i; }
#pragma unroll
            for (int off = 32; off > 0; off >>= 1) { const float ov = __shfl_xor(bv, off); const int oi = __shfl_xor(bi, off); if (ov > bv || (ov == bv && oi < bi)) { bv = ov; bi = oi; } }
            if (lane == 0) sel[k] = bi;
#pragma unroll
            for (int i = 0; i < 5; ++i) if (lane + 64 * i == bi) scv[i] = -3e38f;
        }
    }
    __syncthreads();
    float ms[4], ss4[4];
#pragma unroll
    for (int i = 0; i < 4; ++i) ms[i] = -3e38f;
    for (int idx = tid; idx < 1024; idx += 512) {
        asm volatile("" ::: "memory");
        const int pos = sel[idx >> 6] * 64 + (idx & 63); float s4[4] = {-1e30f, -1e30f, -1e30f, -1e30f};
        if (pos <= PAST) { float kr[64]; kv.krow_sel(pos, kr); s4[0] = s4[1] = s4[2] = s4[3] = 0.f;
#pragma unroll
            for (int d = 0; d < 64; ++d) { const f32x4 qv = *(const LAS f32x4*)(qs + d * 4); s4[0] += qv[0] * kr[d]; s4[1] += qv[1] * kr[d]; s4[2] += qv[2] * kr[d]; s4[3] += qv[3] * kr[d]; }
#pragma unroll
            for (int hh = 0; hh < 4; ++hh) s4[hh] *= 0.125f; }
#pragma unroll
        for (int hh = 0; hh < 4; ++hh) { sc[hh * 2624 + 1024 + idx] = s4[hh]; ms[hh] = fmaxf(ms[hh], s4[hh]); }
    }
    blk_reduce<4>(red, bc, ms, true, wave, lane);
#pragma unroll
    for (int i = 0; i < 4; ++i) ss4[i] = 0.f;
    for (int idx = tid; idx < 1024; idx += 512) {
#pragma unroll
        for (int hh = 0; hh < 4; ++hh) { const float x = sc[hh * 2624 + 1024 + idx]; const float e = x > -1e29f ? __expf(x - ms[hh]) : 0.f; sc[hh * 2624 + 1024 + idx] = e; ss4[hh] += e; } }
    blk_reduce<4>(red, bc, ss4, false, wave, lane);
    float invs[4];
#pragma unroll
    for (int hh = 0; hh < 4; ++hh) invs[hh] = 1.f / ss4[hh];
    float oc[4] = {0.f, 0.f, 0.f, 0.f}, os[4] = {0.f, 0.f, 0.f, 0.f}, ow[4] = {0.f, 0.f, 0.f, 0.f};
    { const int c1 = (wave + 1) * 128 < NCV ? (wave + 1) * 128 : NCV;
#pragma unroll 16
        for (int cidx = wave * 128; cidx < c1; ++cidx) { const float v = VC[(size_t)cidx * 64 + lane];
#pragma unroll
            for (int hh = 0; hh < 4; ++hh) oc[hh] += sc[hh * 2624 + cidx] * v; } }
    for (int kb = wave * 2; kb < wave * 2 + 2; ++kb) { const int p0 = sel[kb] * 64; int nk = PAST - p0 + 1; nk = nk > 64 ? 64 : nk;
        const float* vbase = p0 < PAST ? kv.prow(p0, 3) + lane : kv.nvs + lane;
#pragma unroll 16
        for (int kk = 0; kk < nk; ++kk) { const float v = vbase[(size_t)kk * 256];
#pragma unroll
            for (int hh = 0; hh < 4; ++hh) os[hh] += sc[hh * 2624 + 1024 + kb * 64 + kk] * v; } }
    { const int i1 = (wave + 1) * 65 < 513 ? (wave + 1) * 65 : 513;
#pragma unroll 13
        for (int i = wave * 65; i < i1; ++i) { const float v = kv.v_win(PAST - 512 + i, lane);
#pragma unroll
            for (int hh = 0; hh < 4; ++hh) ow[hh] += sc[hh * 2624 + 2048 + i] * v; } }
#pragma unroll
    for (int hh = 0; hh < 4; ++hh) { part[(wave * 12 + hh) * 64 + lane] = oc[hh] * invc[hh]; part[(wave * 12 + 4 + hh) * 64 + lane] = os[hh] * invs[hh]; part[(wave * 12 + 8 + hh) * 64 + lane] = ow[hh] * invw[hh]; }
    __syncthreads();
    if (tid < 256) { const int hh = tid >> 6, d = tid & 63; float a = 0.f, b = 0.f, cc = 0.f;
        for (int w = 0; w < 8; ++w) { a += part[(w * 12 + hh) * 64 + d]; b += part[(w * 12 + 4 + hh) * 64 + d]; cc += part[(w * 12 + 8 + hh) * 64 + d]; }
        ysd[tid] = siluf_(dgp[tid]) * (gsm[hh * 3] * a + gsm[hh * 3 + 1] * b + gsm[hh * 3 + 2] * cc); }
}
DI void ph_mix_sample(LAS unsigned char* lds_, int l) {
    const Ctx c = mkctx(lds_); const int tid = c.tid, lane = c.lane, wave = c.wave;
    const int b = c.bid - (c.G - 32);
    if (b < 0 || b >= 32) return;
    float* out = c.out;
    __syncthreads();
    const float* pr = WSF(WS_PROJS) + (size_t)b * NPD;
    LAS float* act = (LAS float*)c.lds;
    LAS float* red = act + 768;
    LAS float* ybl = red + 16;
    LAS float* sdt = ybl + 256;
    LAS float* nrow = sdt + 8;
    LAS float* gsm = nrow + 256;
    LAS float* wl = gsm + 16;
    float* ys = WSF(WS_YS) + (size_t)b * 1024;
    if (tid < 256) { const int ch = tid; const float* st = INP(I_SSC) + ((size_t)(l * NB + b) * 2) * 256; const float* scw = INP(I_SCW) + l * 768;
        const float u = pr[512 + ch] * pr[ch], p0 = st[ch], p1 = st[256 + ch]; const float y = scw[ch] * p0 + scw[256 + ch] * p1 + scw[512 + ch] * u;
        ys[ch] = siluf_(pr[768 + ch]) * pr[256 + ch] * y; float* so = out + O_SCS + ((size_t)(l * NB + b) * 2) * 256; so[ch] = p1; so[256 + ch] = u; }
    float uc = 0.f;
    if (tid >= 256) { const int ch = tid - 256; const float* st = INP(I_SCF) + (size_t)(l * NB + b) * 7680; const float* cfw = INP(I_CFW) + l * 31 * 256;
        const float glu = pr[2048 + ch] * sigmoidf_(pr[2304 + ch]); float u = INP(I_CFB)[l * 256 + ch]; float* so = out + O_CFS + (size_t)(l * NB + b) * 7680;
        for (int k = 0; k < 30; ++k) { const float pv = st[k * 256 + ch]; u += cfw[k * 256 + ch] * pv; if (k > 0) so[(k - 1) * 256 + ch] = pv; }
        u += cfw[30 * 256 + ch] * glu; so[29 * 256 + ch] = glu; uc = u; }
    { const float s1 = wsum(tid >= 256 ? uc : 0.f); if (lane == 0) red[wave] = s1; }
    __syncthreads();
    const float cmean = (red[4] + red[5] + red[6] + red[7]) * (1.f / 256.f);
    __syncthreads();
    { const float d = uc - cmean; const float s2 = wsum(tid >= 256 ? d * d : 0.f); if (lane == 0) red[wave] = s2; }
    __syncthreads();
    if (tid >= 256) { const int ch = tid - 256; const float var = (red[4] + red[5] + red[6] + red[7]) * (1.f / 256.f);
        const float ln = (uc - cmean) * rsqrtf(var + EPS) * INP(I_LNG)[l * 256 + ch] + INP(I_LNB)[l * 256 + ch];
        ys[512 + ch] = siluf_(pr[2560 + ch]) * siluf_(ln); }
    { const float* st = INP(I_SBC) + (size_t)(l * NB + b) * 2304; const float* cw = INP(I_BCW) + l * 4 * 768; const float* cb = INP(I_BCB) + l * 768; float* so = out + O_BCS + (size_t)(l * NB + b) * 2304;
        for (int ch = tid; ch < 768; ch += 512) { const float raw = pr[1280 + ch], p0 = st[ch], p1 = st[768 + ch], p2 = st[1536 + ch];
            act[ch] = siluf_(cb[ch] + cw[ch] * p0 + cw[768 + ch] * p1 + cw[1536 + ch] * p2 + cw[2304 + ch] * raw); so[ch] = p1; so[768 + ch] = p2; so[1536 + ch] = raw; }
        if (tid < 4) { const float dt = softplusf_(pr[3456 + tid] + INP(I_DTB)[l * 4 + tid]); sdt[tid] = dt; sdt[4 + tid] = __expf(dt * (-__expf(INP(I_ALOG)[l * 4 + tid]))); } }
    __syncthreads();
    { const float* h0 = INP(I_SSM) + (size_t)(l * NB + b) * 32768; float* ho = out + O_HS + (size_t)(l * NB + b) * 32768; const float* Dp = INP(I_SD) + l * 4;
        for (int row = wave; row < 256; row += 8) { const int hd = row >> 6, gq = hd >> 1; const float dt = sdt[hd], dA = sdt[4 + hd], xv = act[row]; float y = 0.f;
#pragma unroll
            for (int s2 = 0; s2 < 2; ++s2) { const int sidx = lane + 64 * s2; const float hn = dA * h0[row * 128 + sidx] + dt * xv * act[256 + gq * 128 + sidx]; ho[row * 128 + sidx] = hn; y += hn * act[512 + gq * 128 + sidx]; }
            y = wsum(y);
            if (lane == 0) ybl[row] = (y + Dp[hd] * xv) * siluf_(pr[1024 + row]); } }
    __syncthreads();
    { const float v = tid < 256 ? ybl[tid] : 0.f; const float s2 = wsum(v * v); if (lane == 0) red[8 + wave] = s2; }
    __syncthreads();
    if (tid < 256) { const float ss = red[8] + red[9] + red[10] + red[11]; ys[256 + tid] = ybl[tid] * rsqrtf(ss * (1.f / 256.f) + EPS) * INP(I_SNG)[l * 256 + tid]; }
    const float* qg = INP(I_QG) + l * 64; const float* kg = INP(I_KG) + l * 192;
    LAS float* qs = wl + 10496;
    if (wave < 4) { const float v = pr[2816 + wave * 64 + lane]; const float ss = wsum(v * v); qs[lane * 4 + wave] = v * rsqrtf(ss * (1.f / 64.f) + EPS) * qg[lane]; }
    else if (wave == 4) { const float v = pr[3072 + 128 + lane]; const float ss = wsum(v * v); nrow[lane] = v * rsqrtf(ss * (1.f / 64.f) + EPS) * kg[64 + lane]; nrow[64 + lane] = pr[3072 + 192 + lane]; }
    else if (wave == 5) { const float v = pr[3072 + 256 + lane]; const float ss = wsum(v * v); nrow[128 + lane] = v * rsqrtf(ss * (1.f / 64.f) + EPS) * kg[128 + lane]; nrow[192 + lane] = pr[3072 + 320 + lane]; }
    else if (wave == 6) { if (lane < 12) gsm[lane] = sigmoidf_(pr[3460 + lane]); }
    __syncthreads();
    const float* cache_win = INP(I_CWIN) + (size_t)(l * NB + b) * 512 * 128;
    { float* ko = out + O_KVS + (size_t)(l * NB + b) * 256;
        if (tid < 128) ko[tid] = pr[3072 + tid]; else if (tid < 192) ko[tid] = nrow[tid - 128]; else if (tid < 256) ko[tid] = nrow[64 + tid - 192];
        float* wo = out + O_WINS + (size_t)(l * NB + b) * 512 * 128;
        for (int e = tid; e < 511 * 128; e += 512) wo[e] = cache_win[128 + e];
        if (tid < 64) wo[511 * 128 + tid] = nrow[128 + tid]; else if (tid < 128) wo[511 * 128 + tid] = nrow[192 + tid - 64]; }
    float* nrp = WSF(WS_NRG) + (size_t)(l * NB + b) * 256;
    if (tid < 256) nrp[tid] = nrow[tid];
    asm volatile("s_waitcnt vmcnt(0)" ::: "memory");
    __syncthreads();
    {
        SampleKV kv{INP(I_CKV) + (size_t)l * NPOOL * 128 * 256, (const int*)c.ap->in[I_PT] + b * 128, cache_win, nrp, nrp + 64, nrp + 128, nrp + 192};
        nsa_sample_block(wl, WSF(WS_KCS) + (size_t)(l * NB + b) * 1024 * 64, WSF(WS_VCS) + (size_t)(l * NB + b) * 1024 * 64, kv, gsm, pr + 3584, ys + 768, tid, lane, wave);
    }
    edge_publish((unsigned*)(c.ws + WS_CTL + 18432) + l * 64);
    __syncthreads();
}
DI void ph_scan(LAS unsigned char* lds_, int l) {
    const Ctx c = mkctx(lds_);
    if (c.bid >= 64) return;
    const float* CST = WSF(WS_CST); float* HPV = WSF(WS_HPV); const float* CDEC = WSF(WS_CDEC);
    const int e = c.bid * 512 + c.tid, hd = e >> 13; float hc = 0.f;
#pragma unroll 8
    for (int ch = 0; ch < 128; ++ch) { const float sv = CST[(size_t)ch * 32768 + e]; HPV[(size_t)ch * 32768 + e] = hc; hc = CDEC[ch * 4 + hd] * hc + sv; }
    c.out[O_HP + (size_t)l * 32768 + e] = hc;
    edge_publish((unsigned*)(c.ws + WS_CTL + 17408) + l * 64);
}
DI f16x8 pack_p(const f32x4& a, const f32x4& b) { f16x8 r; r[0] = (f16)a[0]; r[1] = (f16)a[1]; r[2] = (f16)a[2]; r[3] = (f16)a[3]; r[4] = (f16)b[0]; r[5] = (f16)b[1]; r[6] = (f16)b[2]; r[7] = (f16)b[3]; return r; }
DI f16x8 ld_vt(const f16* p) { const f16x4 a = *(const f16x4*)p, b = *(const f16x4*)(p + 16); f16x8 r; r[0] = a[0]; r[1] = a[1]; r[2] = a[2]; r[3] = a[3]; r[4] = b[0]; r[5] = b[1]; r[6] = b[2]; r[7] = b[3]; return r; }
constexpr int NT_PSEL = 0  , NT_STG = 32768  , NT_STG_SZ = 18432 + 17408,
              NT_RING = 0  , NT_MASK = 131072  , NT_VB = NT_MASK + 1088  , NT_MT = NT_VB + 1088  , NT_END = NT_MT + 1088;
static_assert(NT_STG + 2 * NT_STG_SZ <= NT_MASK, "nsa tile LDS map");
static_assert(NT_END <= MISC_OFF, "nsa tile LDS map");
struct StgRegs { f16x8 k0, k1, v0, v1; };
template <bool WITH_V, class KSrc, class VSrc>
DI void stg_load(StgRegs& rg, int ch, int tid, const KSrc& ksrc, const VSrc& vsrc) {
    const f16* kp = ksrc(ch, tid >> 2) + (tid & 3) * 16; rg.k0 = ld_h8(kp); rg.k1 = ld_h8(kp + 8);
    if (WITH_V) { const f16* vp = vsrc(ch, tid >> 3, tid & 7); rg.v0 = ld_h8(vp); rg.v1 = ld_h8(vp + 8); }
}
template <bool WITH_V>
DI void stg_store(const StgRegs& rg, LAS unsigned char* buf, int tid) {
    LAS f16* kb = (LAS f16*)buf + (tid >> 2) * 72 + (tid & 3) * 16; *(LAS f16x8*)kb = rg.k0; *(LAS f16x8*)(kb + 8) = rg.k1;
    if (WITH_V) { LAS f16* vb = (LAS f16*)(buf + 18432) + (tid >> 3) * 136 + (tid & 7) * 16; *(LAS f16x8*)vb = rg.v0; *(LAS f16x8*)(vb + 8) = rg.v1; }
}
template <bool WITH_V, class KSrc, class VSrc, class Body>
DI void stream_chunks(LAS unsigned char* stg, int nchunk, int tid, const KSrc& ksrc, const VSrc& vsrc, Body body) {
    if (nchunk <= 0) return;
    const int last = nchunk - 1;
    StgRegs rg;
    stg_load<WITH_V>(rg, 0, tid, ksrc, vsrc);
    __syncthreads();
    stg_store<WITH_V>(rg, stg, tid); stg_load<WITH_V>(rg, 1 < last ? 1 : last, tid, ksrc, vsrc);
    lds_barrier();
#pragma nounroll
    for (int ch = 0; ch < nchunk; ++ch) {
        body(ch, stg + (ch & 1) * NT_STG_SZ);
        stg_store<WITH_V>(rg, stg + ((ch + 1) & 1) * NT_STG_SZ, tid); stg_load<WITH_V>(rg, ch + 2 < last ? ch + 2 : last, tid, ksrc, vsrc);
        lds_barrier();
    }
}
DI f16x8 lds_vt(const LAS f16* p) { return *(const LAS f16x8*)p; }
DI f32x4 qk_tile(const LAS f16* kb, int kt, int fr, int q, const f16x8 (&qf)[2]) {
    const LAS f16* kp = kb + (16 * kt + fr) * 72 + 8 * q; f32x4 sa = (f32x4){0.f, 0.f, 0.f, 0.f};
    sa = __builtin_amdgcn_mfma_f32_16x16x32_f16(*(const LAS f16x8*)kp, qf[0], sa, 0, 0, 0); return __builtin_amdgcn_mfma_f32_16x16x32_f16(*(const LAS f16x8*)(kp + 32), qf[1], sa, 0, 0, 0);
}
constexpr float NSA_L2E = 1.44269504f, NSA_C1 = 0.125f * NSA_L2E;
DI float ex2(float x) { return __builtin_amdgcn_exp2f(x); }
template <class Pred>
DI f16x8 pv_step(const LAS f16* kb, const LAS f16* vb, int st, int fr, int q, const f16x8 (&qf)[2], f32x4 (&o)[4], f32x4 (&e2)[2], float nb, bool masked, Pred pred) {
#pragma unroll
    for (int hf = 0; hf < 2; ++hf) { const f32x4 sa = qk_tile(kb, 2 * st + hf, fr, q, qf);
        if (!masked) {
#pragma unroll
            for (int j = 0; j < 4; ++j) e2[hf][j] = ex2(fmaf(sa[j], NSA_C1, nb)); }
        else {
#pragma unroll
            for (int j = 0; j < 4; ++j) e2[hf][j] = pred(32 * st + 16 * hf + 4 * q + j) ? ex2(fmaf(sa[j], NSA_C1, nb)) : 0.f; } }
    const f16x8 pb = pack_p(e2[0], e2[1]);
#pragma unroll
    for (int dt = 0; dt < 4; ++dt) o[dt] = __builtin_amdgcn_mfma_f32_16x16x32_f16(lds_vt(vb + (16 * dt + fr) * 136 + 32 * st + 8 * q), pb, o[dt], 0, 0, 0);
    return pb;
}
DI void nsa_tile(const Ctx& c, int tile, const f16* Q16, const f16* KC16, const f16* VCT16, const f16* KS16, const f16* VST16, const f16* KW16, const f16* VWT16,
                 const float* GATES, const f16* DG, f16* Y16, float shc, float shs, float shw) {
    LAS unsigned char* lds = c.lds; const int wave = c.wave; int tid, lane, fr, q, ti, h, trow;
    const int t0 = tile * 32, cur = t0 >> 6;
#define NSA_RELANE() do { int _t = c.tid; asm volatile("" : "+v"(_t)); tid = _t; lane = _t & 63; fr = lane & 15; q = lane >> 4; ti = fr >> 2; h = fr & 3; trow = t0 + 4 * wave + ti; } while (0)
#define NSA_REPS(bit) (((NSA_DUP >> (bit)) & 1) ? 2 : 1)
#define NSA_SCALE(rep) ({ float _z = (rep) == 0 ? 1.f : 0.f; asm volatile("" : "+v"(_z)); _z; })
    NSA_RELANE();
    LAS float* PSEL = (LAS float*)(lds + NT_PSEL); LAS unsigned* MASK = (LAS unsigned*)(lds + NT_MASK); LAS int* VB = (LAS int*)(lds + NT_VB); LAS unsigned char* STG = lds + NT_STG;
    __syncthreads();
    for (int i = tid; i < 272; i += 512) MASK[i] = (i == 0 || i == cur || i == cur - 1) ? 0xFFFFFFFFu : 0u;
    f16x8 qf[2];
#pragma unroll
    for (int ks = 0; ks < 2; ++ks) qf[ks] = ld_h8(Q16 + ((size_t)trow * 4 + h) * 64 + 32 * ks + 8 * q);
    const int nkt = ((t0 >> 4) + 1 + 15) >> 4;
    const int ncch = (nkt + 7) >> 3;
    const int nv_row = trow >= 31 ? ((trow - 31) >> 4) + 1 : 0;
    auto kc_src = [&](int ch, int row) { return KC16 + (size_t)(128 * ch + row) * 64; };
    auto vc_src = [&](int ch, int d, int seg) { return VCT16 + (size_t)d * 1024 + 128 * ch + seg * 16; };
    float lsum = 0.f;
    const float bc = -shc * NSA_L2E, bs = -shs * NSA_L2E, bw = -shw * NSA_L2E;
    const int tw0 = t0 + 4 * wave, nvmin_w = tw0 >= 31 ? ((tw0 - 31) >> 4) + 1 : 0;
    stream_chunks<false>(STG, ncch, tid, kc_src, vc_src, [&](int ch, LAS unsigned char* buf) {
        const LAS f16* kb = (const LAS f16*)buf; const int nk = nkt - 8 * ch < 8 ? nkt - 8 * ch : 8;
#pragma unroll 4
        for (int kt = 0; kt < nk; ++kt) { const f32x4 sa = qk_tile(kb, kt, fr, q, qf); const int cb = 128 * ch + 16 * kt + 4 * q;
            if (128 * ch + 16 * kt + 15 < nvmin_w) {
#pragma unroll
                for (int j = 0; j < 4; ++j) lsum += ex2(fmaf(sa[j], NSA_C1, bc)); }
            else {
#pragma unroll
                for (int j = 0; j < 4; ++j) lsum += (cb + j < nv_row) ? ex2(fmaf(sa[j], NSA_C1, bc)) : 0.f; } } });
    lsum += __shfl_xor(lsum, 16); lsum += __shfl_xor(lsum, 32);
    const float invc = lsum > 0.f ? 1.f / lsum : 0.f;
    NSA_RELANE();
    f32x4 oc[4];
#pragma unroll
    for (int dt = 0; dt < 4; ++dt) oc[dt] = (f32x4){0.f, 0.f, 0.f, 0.f};
    { float bprev = 0.f; const float pbias = invc > 0.f ? bc + __log2f(invc) : -1e30f;
    stream_chunks<true>(STG, ncch, tid, kc_src, vc_src, [&](int ch, LAS unsigned char* buf) {
        const LAS f16* kb = (const LAS f16*)buf; const LAS f16* vb = (const LAS f16*)(buf + 18432); const int ns = (nkt - 8 * ch + 1) >> 1 < 4 ? (nkt - 8 * ch + 1) >> 1 : 4;
#pragma unroll 2
        for (int s2 = 0; s2 < ns; ++s2) {
            f32x4 e2[2];
            pv_step(kb, vb, s2, fr, q, qf, oc, e2, pbias, 128 * ch + 32 * s2 + 31 >= nvmin_w, [&](int kc) { return 128 * ch + kc < nv_row; });
#pragma unroll
            for (int hf = 0; hf < 2; ++hf) {
                const int ktg = 8 * ch + 2 * s2 + hf;
                float av = (e2[hf][0] + e2[hf][1]) + (e2[hf][2] + 0.5f * e2[hf][3]), bv = 0.5f * e2[hf][3];
                av += dppf<DPP_X1>(av); av += dppf<DPP_X2>(av); bv += dppf<DPP_X1>(bv); bv += dppf<DPP_X2>(bv);
                const float up = __shfl(q == 3 ? bprev : bv, (lane + 48) & 63);
                bprev = bv;
                if (h == 0 && ktg < nkt) PSEL[(4 * wave + ti) * 256 + 4 * ktg + q] = av + up;
            }
        } }); }
    for (int rep = 0; rep < NSA_REPS(2); ++rep) {
        const int nforced = cur >= 2 ? 3 : cur + 1, nsel = ((cur + 1) < 16 ? (cur + 1) : 16) - nforced, tk = lane >> 4, l16 = lane & 15, tokl = 4 * wave + tk;
        float sv[16];
#pragma unroll
        for (int i = 0; i < 16; ++i) { const int j = l16 + 16 * i; float v = -3e38f;
            if (j <= cur && !(j == 0 || j == cur || j == cur - 1)) v = j < 4 * nkt ? PSEL[tokl * 256 + j] : 0.f;
            sv[i] = v; }
#pragma nounroll
        for (int k = 0; k < nsel; ++k) {
            float bv = sv[0]; int bi = l16;
#pragma unroll
            for (int i = 1; i < 16; ++i) if (sv[i] > bv) { bv = sv[i]; bi = l16 + 16 * i; }
#define TOPK_STEP(CT) do { const float ov = dppf<CT>(bv); const int oi = dppi<CT>(bi); if (ov > bv || (ov == bv && oi < bi)) { bv = ov; bi = oi; } } while (0)
            TOPK_STEP(DPP_X1); TOPK_STEP(DPP_X2); TOPK_STEP(DPP_HM); TOPK_STEP(DPP_R8);
#undef TOPK_STEP
            if (l16 == 0) __hip_atomic_fetch_or(&MASK[bi], 1u << tokl, __ATOMIC_RELAXED, __HIP_MEMORY_SCOPE_WORKGROUP);
#pragma unroll
            for (int i = 0; i < 16; ++i) if (l16 + 16 * i == bi) sv[i] = -3e38f;
        }
    }
    NSA_RELANE();
    f32x4 owr[4]; float lwr = 0.f;
#pragma unroll
    for (int dt = 0; dt < 4; ++dt) owr[dt] = (f32x4){0.f, 0.f, 0.f, 0.f};
    f16x8 onesf;
#pragma unroll
    for (int i = 0; i < 8; ++i) onesf[i] = fr == 0 ? (f16)1.f : (f16)0.f;
    f32x4 lw5 = (f32x4){0.f, 0.f, 0.f, 0.f};
    {
        const int wlo = t0 - 512 > 0 ? t0 - 512 : 0, nwch = (t0 + 32 - wlo + 127) >> 7;
        auto kw_src = [&](int ch, int row) { int p = wlo + 128 * ch + row; p = p < SEQ ? p : SEQ - 1; return KW16 + (size_t)p * 64; };
        auto vw_src = [&](int ch, int d, int seg) { const int key = wlo + 128 * ch + seg * 16; int blk = key >> 6; blk = blk < 256 ? blk : 255; return VWT16 + (size_t)blk * 4096 + d * 64 + (key & 63); };
        {
        stream_chunks<true>(STG, nwch, tid, kw_src, vw_src, [&](int ch, LAS unsigned char* buf) {
            const LAS f16* kb = (const LAS f16*)buf; const LAS f16* vb = (const LAS f16*)(buf + 18432); const int pbase = wlo + 128 * ch;
            const int ns = (t0 + 32 - pbase) >> 5 < 4 ? (t0 + 32 - pbase) >> 5 : 4;
#pragma unroll 2
            for (int s2 = 0; s2 < ns; ++s2) { f32x4 e2[2];
                const int p0s = pbase + 32 * s2; const bool masked = !(p0s >= tw0 + 3 - 512 && p0s + 31 <= tw0);
                const f16x8 pb = pv_step(kb, vb, s2, fr, q, qf, owr, e2, bw, masked, [&](int kc) { const int pos = pbase + kc; return pos <= trow && pos >= trow - 512; });
                lw5 = __builtin_amdgcn_mfma_f32_16x16x32_f16(onesf, pb, lw5, 0, 0, 0); } }); }
        lwr = lw5[0];
    }
    NSA_RELANE();
    LAS unsigned* MT = (LAS unsigned*)(lds + NT_MT);
    if (wave == 0) { int cnt = 0;
        for (int base = 0; base <= cur; base += 64) { const int jx = base + lane; const unsigned mj = jx <= cur ? MASK[jx] : 0u; const bool v = mj != 0u; const unsigned long long bal = __ballot(v);
            if (v) { const int pos = cnt + __popcll(bal & ((1ull << lane) - 1ull)); VB[pos] = jx; MT[pos] = mj; } cnt += __popcll(bal); }
        if (lane < 8) { VB[cnt + lane] = VB[cnt - 1]; MT[cnt + lane] = 0u; }
        if (lane == 0) VB[264] = cnt; }
    __syncthreads();
    if (VERIFY_NSA) { unsigned* SELM = (unsigned*)(c.ws + WS_SELM) + (size_t)tile * 272; for (int i = tid; i < 272; i += 512) SELM[i] = MASK[i]; }
    f32x4 osr[4]; float lsr = 0.f; f32x4 ls5 = (f32x4){0.f, 0.f, 0.f, 0.f};
#pragma unroll
    for (int dt = 0; dt < 4; ++dt) osr[dt] = (f32x4){0.f, 0.f, 0.f, 0.f};
#pragma unroll
    for (int i = 0; i < 8; ++i) onesf[i] = fr == 0 ? (f16)1.f : (f16)0.f;
    {
        const int nvb = __builtin_amdgcn_readfirstlane(VB[264]), nst = (nvb + 3) >> 2;
        const int dr = lane >> 3, dp = lane & 7, dsw = (dp ^ dr) * 8;
        LAS unsigned char* RING = lds + NT_RING;
        auto dma = [&](int n, int blk) { LAS unsigned char* slot = RING + (n & 7) * 16384 + wave * 1024;
            __builtin_amdgcn_global_load_lds((const unsigned*)(KS16 + ((size_t)blk * 64 + 8 * wave + dr) * 64 + dsw), (LAS unsigned*)slot, 16, 0, 0);
            __builtin_amdgcn_global_load_lds((const unsigned*)(VST16 + (size_t)blk * 4096 + (8 * wave + dr) * 64 + dsw), (LAS unsigned*)(slot + 8192), 16, 0, 0); };
        {
        asm volatile("s_waitcnt vmcnt(0)" ::: "memory"); __syncthreads();
        typedef int i32x4 __attribute__((ext_vector_type(4)));
#define RFL4(v) { __builtin_amdgcn_readfirstlane((v)[0]), __builtin_amdgcn_readfirstlane((v)[1]), __builtin_amdgcn_readfirstlane((v)[2]), __builtin_amdgcn_readfirstlane((v)[3]) }
        { const i32x4 b0 = *(const LAS i32x4*)VB; const int bb[4] = RFL4(b0); dma(0, bb[0]); dma(1, bb[1]); dma(2, bb[2]); dma(3, bb[3]); }
#pragma nounroll
        for (int st = 0; st < nst; ++st) {
            asm volatile("s_waitcnt vmcnt(0)\n\ts_barrier" ::: "memory");
            const i32x4 bcv = *(const LAS i32x4*)(VB + 4 * st), bnv = *(const LAS i32x4*)(VB + 4 * st + 4); const u32x4 mcv = *(const LAS u32x4*)(MT + 4 * st);
            const int bcur[4] = RFL4(bcv), bnxt[4] = RFL4(bnv); const int mcur[4] = RFL4(mcv);
            dma(4 * st + 4, bnxt[0]); dma(4 * st + 5, bnxt[1]); dma(4 * st + 6, bnxt[2]); dma(4 * st + 7, bnxt[3]);
#pragma unroll
            for (int i4 = 0; i4 < 4; ++i4) {
            const int n = 4 * st + i4;
            const int blk = bcur[i4]; const unsigned mt = ((unsigned)mcur[i4] >> (4 * wave)) & 15u;
            if (mt != 0u) {
                const bool rv = ((mt >> ti) & 1u) != 0u; const LAS unsigned char* ks = RING + (n & 7) * 16384; const LAS unsigned char* vs = ks + 8192; const int sx = fr & 7;
                f32x4 sa[4]; f16x8 va[2][4];
#pragma unroll
                for (int kt = 0; kt < 4; ++kt) { const LAS unsigned char* kp = ks + (16 * kt + fr) * 128; sa[kt] = (f32x4){0.f, 0.f, 0.f, 0.f};
                    sa[kt] = __builtin_amdgcn_mfma_f32_16x16x32_f16(*(const LAS f16x8*)(kp + ((q ^ sx) << 4)), qf[0], sa[kt], 0, 0, 0);
                    sa[kt] = __builtin_amdgcn_mfma_f32_16x16x32_f16(*(const LAS f16x8*)(kp + (((4 + q) ^ sx) << 4)), qf[1], sa[kt], 0, 0, 0); }
#pragma unroll
                for (int s2 = 0; s2 < 2; ++s2)
#pragma unroll
                    for (int dt = 0; dt < 4; ++dt) va[s2][dt] = *(const LAS f16x8*)(vs + (16 * dt + fr) * 128 + (((4 * s2 + q) ^ sx) << 4));
                const float nbu = rv ? bs : -1e30f;
                if (blk != cur) {
#pragma unroll
                    for (int kt = 0; kt < 4; ++kt)
#pragma unroll
                        for (int j = 0; j < 4; ++j) sa[kt][j] = ex2(fmaf(sa[kt][j], NSA_C1, nbu)); }
                else { const int pb0 = 64 * blk + 4 * q;
#pragma unroll
                    for (int kt = 0; kt < 4; ++kt)
#pragma unroll
                        for (int j = 0; j < 4; ++j) sa[kt][j] = (pb0 + 16 * kt + j <= trow) ? ex2(fmaf(sa[kt][j], NSA_C1, nbu)) : 0.f; }
                const f16x8 p0 = pack_p(sa[0], sa[1]), p1 = pack_p(sa[2], sa[3]);
#pragma unroll
                for (int dt = 0; dt < 4; ++dt) { osr[dt] = __builtin_amdgcn_mfma_f32_16x16x32_f16(va[0][dt], p0, osr[dt], 0, 0, 0); osr[dt] = __builtin_amdgcn_mfma_f32_16x16x32_f16(va[1][dt], p1, osr[dt], 0, 0, 0); }
                ls5 = __builtin_amdgcn_mfma_f32_16x16x32_f16(onesf, p0, ls5, 0, 0, 0); ls5 = __builtin_amdgcn_mfma_f32_16x16x32_f16(onesf, p1, ls5, 0, 0, 0);
            }
            }
        }
        asm volatile("s_waitcnt vmcnt(0)" ::: "memory"); }
        __syncthreads();
        lsr = ls5[0];
    }
    NSA_RELANE();
    lwr += __shfl_xor(lwr, 16); lwr += __shfl_xor(lwr, 32); lsr += __shfl_xor(lsr, 16); lsr += __shfl_xor(lsr, 32);
    {
        const float g0 = GATES[(size_t)trow * 12 + h * 3], ils = GATES[(size_t)trow * 12 + h * 3 + 1] / lsr, ilw = GATES[(size_t)trow * 12 + h * 3 + 2] / lwr;
#pragma unroll
        for (int dt = 0; dt < 4; ++dt) { const int d0 = 16 * dt + 4 * q; const f16x4 dg = *(const f16x4*)(DG + (size_t)trow * 256 + h * 64 + d0); f16x4 y;
#pragma unroll
            for (int jj = 0; jj < 4; ++jj) { const float o = g0 * oc[dt][jj] + ils * osr[dt][jj] + ilw * owr[dt][jj]; y[jj] = (f16)(siluf_((float)dg[jj]) * o); }
            *(f16x4*)(Y16 + (size_t)trow * 1024 + 768 + h * 64 + d0) = y; }
    }
#undef NSA_RELANE
}
DI void ph_ssd_fin(LAS unsigned char* lds_, int l, int it0, int it1, int itstep);
DI void ph_outproj_sample(LAS unsigned char* lds_, int l, int it);
DI void ph_nsa(LAS unsigned char* lds_, int l) {
    const Ctx c = mkctx(lds_); const int lane = c.lane;
    const float* qg = INP(I_QG) + l * 64; const float* kg = INP(I_KG) + l * 192;
    const float mq = wmaxf(fabsf(qg[lane])), mk0 = wmaxf(fabsf(kg[lane])), mk1 = wmaxf(fabsf(kg[64 + lane])), mk2 = wmaxf(fabsf(kg[128 + lane]));
    const float shc = 8.f * mq * mk0 - 8.f, shs = 8.f * mq * mk1 - 8.f, shw = 8.f * mq * mk2 - 8.f;
    unsigned* qctr = (unsigned*)(c.ws + WS_CTL + 16384) + l * 64; LAS int* qslot = (LAS int*)(c.lds + MISC_OFF + 64); bool fin_ok = false, smp_ok = false;
    for (;;) {
        __syncthreads();
        if (c.tid == 0) *qslot = (int)__hip_atomic_fetch_add(qctr, 1u, __ATOMIC_RELAXED, __HIP_MEMORY_SCOPE_AGENT);
        __syncthreads();
        const int u = __builtin_amdgcn_readfirstlane(*qslot);
        if (u >= 800) break;
        if (u < 512) nsa_tile(c, 511 - u, WSH(WS_Q16), WSH(WS_KC16), WSH(WS_VCT16), WSH(WS_KS16), WSH(WS_VST16), WSH(WS_KW16), WSH(WS_VWT16), WSF(WS_GATES), WSH(WS_PROJ) + (size_t)14 * SEQ * 256, WSH(WS_Y16), shc, shs, shw);
        else if (u < 768) { if (!fin_ok) { edge_wait((unsigned*)(c.ws + WS_CTL + 17408) + l * 64, 64u); fin_ok = true; } ph_ssd_fin(lds_, l, u - 512, u - 511, 1); }
        else { if (!smp_ok) { edge_wait((unsigned*)(c.ws + WS_CTL + 18432) + l * 64, 32u); smp_ok = true; } ph_outproj_sample(lds_, l, u - 768); }
    }
    __syncthreads();
}
DI void ph_nsa_verify(LAS unsigned char* lds_, int l) {
    const Ctx c = mkctx(lds_); const int lane = c.lane;
    LAS float* wl = (LAS float*)c.lds + c.wave * 4400; LAS float* sc = wl; LAS float* qs = wl + 4096; LAS unsigned* selb = (LAS unsigned*)(wl + 4352);
    const f16* Q16 = WSH(WS_Q16); const f16* KC16 = WSH(WS_KC16); const f16* VCT16 = WSH(WS_VCT16); const f16* KS16 = WSH(WS_KS16); const f16* VST16 = WSH(WS_VST16); const f16* KW16 = WSH(WS_KW16); const f16* VWT16 = WSH(WS_VWT16);
    const float* GATES = WSF(WS_GATES); const f16* DG = WSH(WS_PROJ) + (size_t)14 * SEQ * 256; const f16* Y16 = WSH(WS_Y16); const unsigned* SELM = (const unsigned*)(c.ws + WS_SELM);
    float* dbg = (float*)(c.ws + WS_CTL + 40960);
    auto dot4 = [&](const f16* kp, float (&s4)[4]) { s4[0] = s4[1] = s4[2] = s4[3] = 0.f;
#pragma unroll
        for (int i = 0; i < 8; ++i) { const f16x8 kv = ld_h8(kp + 8 * i);
#pragma unroll
            for (int j = 0; j < 8; ++j) { const f32x4 qv = *(const LAS f32x4*)(qs + (8 * i + j) * 4); const float kf = (float)kv[j]; s4[0] += qv[0] * kf; s4[1] += qv[1] * kf; s4[2] += qv[2] * kf; s4[3] += qv[3] * kf; } }
#pragma unroll
        for (int hh = 0; hh < 4; ++hh) s4[hh] *= 0.125f; };
    for (int si = c.bid * 8 + c.wave; si < 200 + 395; si += c.G * 8) {
        const int t = si < 200 ? si : 200 + (si - 200) * 41, cur = t >> 6, ncv = t >= 31 ? ((t - 31) >> 4) + 1 : 0;
#pragma unroll
        for (int hh = 0; hh < 4; ++hh) qs[lane * 4 + hh] = (float)Q16[(size_t)t * 256 + hh * 64 + lane];
        if (lane < 9) selb[lane] = 0u;
        float oc[4] = {0.f, 0.f, 0.f, 0.f}, os[4] = {0.f, 0.f, 0.f, 0.f}, ow[4] = {0.f, 0.f, 0.f, 0.f};
        {
            float mx[4] = {-3e38f, -3e38f, -3e38f, -3e38f}, inv[4];
            for (int cc = lane; cc < ncv; cc += 64) { asm volatile("" ::: "memory"); float s4[4]; dot4(KC16 + (size_t)cc * 64, s4);
#pragma unroll
                for (int hh = 0; hh < 4; ++hh) { sc[hh * 1024 + cc] = s4[hh]; mx[hh] = fmaxf(mx[hh], s4[hh]); } }
#pragma unroll
            for (int hh = 0; hh < 4; ++hh) { mx[hh] = wmaxf(mx[hh]); float sm = 0.f; for (int cc = lane; cc < ncv; cc += 64) { const float e = __expf(sc[hh * 1024 + cc] - mx[hh]); sc[hh * 1024 + cc] = e; sm += e; } sm = wsum(sm); inv[hh] = ncv > 0 ? 1.f / sm : 0.f; }
            for (int cc = lane; cc < ncv; cc += 64) {
#pragma unroll
                for (int hh = 0; hh < 4; ++hh) sc[hh * 1024 + cc] *= inv[hh]; }
            for (int cc = 0; cc < ncv; ++cc) { const float v = (float)VCT16[(size_t)lane * 1024 + vt_pos(cc)];
#pragma unroll
                for (int hh = 0; hh < 4; ++hh) oc[hh] += sc[hh * 1024 + cc] * v; }
        }
        const int nsel = (cur + 1) < 16 ? (cur + 1) : 16;
        {
            float scv[5];
#pragma unroll
            for (int i = 0; i < 5; ++i) { const int j = lane + 64 * i; float v = -3e38f;
                if (j <= cur) { if (j == 0 || j == cur || j == cur - 1) v = 3e38f; else { float a = 0.f;
#pragma unroll
                        for (int o5 = -1; o5 < 4; ++o5) { const int cc = 4 * j + o5; if (cc >= 0 && cc < ncv) { const float p = (sc[cc] + sc[1024 + cc]) + (sc[2048 + cc] + sc[3072 + cc]); a += (o5 == -1 || o5 == 3) ? 0.5f * p : p; } }
                        v = a; } }
                scv[i] = v; }
            for (int k = 0; k < nsel; ++k) {
                float bv = scv[0]; int bi = lane;
#pragma unroll
                for (int i = 1; i < 5; ++i) if (scv[i] > bv) { bv = scv[i]; bi = lane + 64 * i; }
#pragma unroll
                for (int off = 32; off > 0; off >>= 1) { const float ov = __shfl_xor(bv, off); const int oi = __shfl_xor(bi, off); if (ov > bv || (ov == bv && oi < bi)) { bv = ov; bi = oi; } }
                if (lane == 0) selb[bi >> 5] |= 1u << (bi & 31);
#pragma unroll
                for (int i = 0; i < 5; ++i) if (lane + 64 * i == bi) scv[i] = -3e38f;
            }
        }
        int nmis = 0;
        for (int j = lane; j <= cur; j += 64) { const unsigned fb = (SELM[(size_t)(t >> 5) * 272 + j] >> (t & 31)) & 1u, nb = (selb[j >> 5] >> (j & 31)) & 1u; nmis += (fb != nb) ? 1 : 0; }
        nmis = (int)wsum((float)nmis);
        if (nmis != 0) { if (lane == 0) { atomicAdd(dbg + 3, 1.f); atomicAdd(dbg + 4, (float)nmis); } continue; }
        {
            float mx[4] = {-3e38f, -3e38f, -3e38f, -3e38f}, inv[4]; int nk = 0;
            for (int j = 0; j <= cur; ++j) if ((selb[j >> 5] >> (j & 31)) & 1u) { asm volatile("" ::: "memory"); const int pos = j * 64 + lane; float s4[4] = {-1e30f, -1e30f, -1e30f, -1e30f}; if (pos <= t) dot4(KS16 + (size_t)pos * 64, s4);
#pragma unroll
                for (int hh = 0; hh < 4; ++hh) { sc[hh * 1024 + nk * 64 + lane] = s4[hh]; mx[hh] = fmaxf(mx[hh], s4[hh]); } ++nk; }
#pragma unroll
            for (int hh = 0; hh < 4; ++hh) { mx[hh] = wmaxf(mx[hh]); float sm = 0.f; for (int k = 0; k < nk; ++k) { const float x = sc[hh * 1024 + k * 64 + lane]; const float e = x > -1e29f ? __expf(x - mx[hh]) : 0.f; sc[hh * 1024 + k * 64 + lane] = e; sm += e; } sm = wsum(sm); inv[hh] = 1.f / sm; }
            nk = 0;
            for (int j = 0; j <= cur; ++j) if ((selb[j >> 5] >> (j & 31)) & 1u) { for (int kk = 0; kk < 64 && j * 64 + kk <= t; ++kk) { const float v = (float)VST16[(size_t)j * 4096 + lane * 64 + vt_pos(kk)];
#pragma unroll
                    for (int hh = 0; hh < 4; ++hh) os[hh] += sc[hh * 1024 + nk * 64 + kk] * v; } ++nk; }
#pragma unroll
            for (int hh = 0; hh < 4; ++hh) os[hh] *= inv[hh];
        }
        {
            const int lo = t - 512 > 0 ? t - 512 : 0, nw = t - lo + 1; float mx[4] = {-3e38f, -3e38f, -3e38f, -3e38f}, inv[4];
            for (int i = lane; i < nw; i += 64) { asm volatile("" ::: "memory"); float s4[4]; dot4(KW16 + (size_t)(lo + i) * 64, s4);
#pragma unroll
                for (int hh = 0; hh < 4; ++hh) { sc[hh * 1024 + i] = s4[hh]; mx[hh] = fmaxf(mx[hh], s4[hh]); } }
#pragma unroll
            for (int hh = 0; hh < 4; ++hh) { mx[hh] = wmaxf(mx[hh]); float sm = 0.f; for (int i = lane; i < nw; i += 64) { const float e = __expf(sc[hh * 1024 + i] - mx[hh]); sc[hh * 1024 + i] = e; sm += e; } sm = wsum(sm); inv[hh] = 1.f / sm; }
            for (int i = 0; i < nw; ++i) { const int pos = lo + i; const float v = (float)VWT16[(size_t)(pos >> 6) * 4096 + lane * 64 + vt_pos(pos & 63)];
#pragma unroll
                for (int hh = 0; hh < 4; ++hh) ow[hh] += sc[hh * 1024 + i] * v; }
#pragma unroll
            for (int hh = 0; hh < 4; ++hh) ow[hh] *= inv[hh];
        }
        float dd = 0.f, ee = 0.f;
#pragma unroll
        for (int hh = 0; hh < 4; ++hh) { const float o = GATES[(size_t)t * 12 + hh * 3] * oc[hh] + GATES[(size_t)t * 12 + hh * 3 + 1] * os[hh] + GATES[(size_t)t * 12 + hh * 3 + 2] * ow[hh];
            const float yn = siluf_((float)DG[(size_t)t * 256 + hh * 64 + lane]) * o, yf = (float)Y16[(size_t)t * 1024 + 768 + hh * 64 + lane]; dd += (yf - yn) * (yf - yn); ee += yn * yn; }
        dd = wsum(dd); ee = wsum(ee);
        if (lane == 0) { atomicAdd(dbg, dd); atomicAdd(dbg + 1, ee); atomicAdd(dbg + 2, 1.f); }
    }
    (void)l;
}
DI void ph_ssd_fin(LAS unsigned char* lds_, int l, int it0, int it1, int itstep) {
    const Ctx c = mkctx(lds_); const int lane = c.lane, wave = c.wave;
    const float* Dp = INP(I_SD) + l * 4; const float* sng = INP(I_SNG) + l * 256;
    const float* CST = WSF(WS_HPV); const f16* ACT = WSH(WS_ACT); const float* ACS = WSF(WS_ACS); const float* YD = WSF(WS_YD); const f16* Z = WSH(WS_PROJ) + (size_t)4 * SEQ * 256; f16* Y16 = WSH(WS_Y16);
    LAS float* GY = (LAS float*)c.lds;
    for (int it = it0; it < it1; it += itstep) {
        const int ch_ = it >> 1, t0 = it * 64, hd = wave >> 1, g = hd >> 1, fr = lane & 15, q = lane >> 4;
        __syncthreads();
        f16x8 bf[2][4];
#pragma unroll
        for (int p2 = 0; p2 < 2; ++p2)
#pragma unroll
            for (int ks = 0; ks < 4; ++ks) bf[p2][ks] = cvt_h8(CST + ((size_t)(ch_ * 4 + hd) * 64 + 16 * ((wave & 1) * 2 + p2) + fr) * 128 + 32 * ks + 8 * q);
#pragma unroll
        for (int lt = 0; lt < 4; ++lt) {
            f16x8 af[4];
#pragma unroll
            for (int ks = 0; ks < 4; ++ks) af[ks] = ld_h8(ACT + (size_t)(t0 + 16 * lt + fr) * 768 + 512 + 128 * g + 32 * ks + 8 * q);
#pragma unroll
            for (int p2 = 0; p2 < 2; ++p2) { f32x4 acc = (f32x4){0.f, 0.f, 0.f, 0.f};
#pragma unroll
                for (int ks = 0; ks < 4; ++ks) acc = __builtin_amdgcn_mfma_f32_16x16x32_f16(af[ks], bf[p2][ks], acc, 0, 0, 0);
                const int ch = hd * 64 + 16 * ((wave & 1) * 2 + p2) + fr;
#pragma unroll
                for (int j = 0; j < 4; ++j) { const int tl = 16 * lt + 4 * q + j, t = t0 + tl;
                    const float y = acc[j] * __expf(ACS[(size_t)t * 4 + hd]) + YD[(size_t)t * 256 + ch] + Dp[hd] * (float)ACT[(size_t)t * 768 + ch];
                    GY[tl * 256 + ch] = y * siluf_((float)Z[(size_t)t * 256 + ch]); } }
        }
        __syncthreads();
        for (int tl = wave; tl < 64; tl += 8) { const f32x4 v = *(const LAS f32x4*)(GY + tl * 256 + lane * 4); const float ss = wsum((v[0] * v[0] + v[1] * v[1]) + (v[2] * v[2] + v[3] * v[3]));
            const float rn = rsqrtf(ss * (1.f / 256.f) + EPS); const f32x4 g4 = *(const f32x4*)(sng + lane * 4); f16x4 o;
#pragma unroll
            for (int i = 0; i < 4; ++i) o[i] = (f16)(v[i] * rn * g4[i]);
            *(f16x4*)(Y16 + (size_t)(t0 + tl) * 1024 + 256 + lane * 4) = o; }
    }
    __syncthreads();
}
DI void ph_outproj(LAS unsigned char* lds_, int l) {
    const Ctx c = mkctx(lds_);
    const float* xin = l == 0 ? INP(I_XP) : WSF(WS_X1); float* xout = l == 0 ? WSF(WS_X1) : c.out + O_YP;
    pg8::Gemm g{WSH(WS_Y16), WSH(WS_WTOUT) + (size_t)l * 1024 * 1024, SEQ, 1024, 1024}; pg8::StaticOrder S; S.init(SEQ, 1024, c.G, c.bid);
    EpiOut E{xin, xout, WSF(WS_ADA) + (size_t)(l * 33 + 32) * 3072 + 2048, l == 0 ? WSH(WS_A16) : nullptr, WSF(WS_GNX), WSF(WS_RSSP)};
    pg8::gemm_phase<EpiOut, pg8::StaticOrder>(c.lds, g, S, E);
    __syncthreads();
}
DI void ph_outproj_sample(LAS unsigned char* lds_, int l, int it) {
    const Ctx c = mkctx(lds_); const int tid = c.tid;
    const float* xs_in = l == 0 ? INP(I_XS) : WSF(WS_XS1); const float* ada_l = WSF(WS_ADA) + (size_t)l * 33 * 3072; const float* YS = WSF(WS_YS); float* xo = l == 0 ? WSF(WS_XS1) : c.out + O_YS;
    LAS f16* Ah = (LAS f16*)c.lds;
    __syncthreads();
#pragma unroll
    for (int i = 0; i < 16; ++i) { const int e = (tid + 512 * i) * 4; const f32x4 v = *(const f32x4*)(YS + e); f16x4 hv; hv[0] = (f16)v[0]; hv[1] = (f16)v[1]; hv[2] = (f16)v[2]; hv[3] = (f16)v[3]; *(LAS f16x4*)(Ah + (e >> 10) * 1032 + (e & 1023)) = hv; }
    __syncthreads();
    sample_gemm_item<1>(c.lds, WSH(WS_WTOUT) + (size_t)l * 1024 * 1024, it * 32, [&](int m, int n, float v) { xo[m * 1024 + n] = xs_in[m * 1024 + n] + ada_l[(size_t)m * 3072 + 2048 + n] * v; });
}

__global__ void __launch_bounds__(512, 2) fwd(Args a) {
    extern __shared__ __attribute__((aligned(16))) unsigned char lds_raw[];
    LAS unsigned char* lds = (LAS unsigned char*)lds_raw;
    volatile LAS unsigned* MISC = (volatile LAS unsigned*)(lds + MISC_OFF);
    if (threadIdx.x < 16) MISC[threadIdx.x] = 0u;
    __syncthreads();
    XcdBarrier bar; bar.bar = (unsigned*)(a.ws + WS_CTL); bar.x = 0; bar.st = MISC;
    if (N_LAUNCHES == 1) bar = xcd_barrier_post((unsigned*)(a.ws + WS_CTL), MISC);
    const int lo = a.ph_lo, hi = a.ph_hi;
    unsigned long long* stampw = (unsigned long long*)(a.ws + WS_CTL + 32768);
    if (STAMP_PHASE >= 0 && blockIdx.x == 0 && threadIdx.x == 0) stampw[0] = wall_clock64();
#define STAMP(k) do { if (STAMP_PHASE == (k) && blockIdx.x == 0 && threadIdx.x == 0) stampw[1] = wall_clock64(); } while (0)
#ifndef PH_MASK
#define PH_MASK 0xFFF
#endif
#define IN(k) (((PH_MASK >> ((k) < 2 ? (k) : 2 + ((k) - 2) % 4)) & 1) && lo <= (k) && (k) < hi)
#define SEAM(k) do { if (IN(k) && IN((k) + 1)) xcd_barrier(bar); STAMP(k); } while (0)
#ifndef DUP_MASK
#define DUP_MASK 0
#endif
#define DUP(bit, call) do { call; if ((DUP_MASK >> (bit)) & 1) { __syncthreads(); call; } } while (0)
    if (IN(0)) DUP(0, ph_prologue(lds));
    SEAM(0);
    if (IN(1)) { ph_hsample(lds, 0); DUP(1, ph_sample_compress(lds)); DUP(2, ph_prep(lds)); }
    SEAM(1);
    for (int l = 0; l < 2; ++l) {
        const int PB = 2 + 4 * l;
        if (IN(PB)) { DUP(3, ph_inproj(lds, l)); DUP(4, ph_inproj_sample(lds, l)); }
        SEAM(PB);
        if (IN(PB + 1)) {
#define SUBSTAMP(code) do { if (l == 0 && (STAMP_PHASE == (code) || STAMP_PHASE == (code) + 10) && blockIdx.x == (STAMP_PHASE >= 110 ? 100 : 0) && threadIdx.x == 0) stampw[1] = wall_clock64(); } while (0)
            DUP(5, ph_ssd_local(lds, l)); SUBSTAMP(100); DUP(6, ph_mix_a(lds, l)); SUBSTAMP(101); DUP(7, ph_mix_c(lds, l)); SUBSTAMP(102); DUP(8, ph_mix_d(lds, l)); SUBSTAMP(103); DUP(9, ph_mix_cmp(lds, l)); SUBSTAMP(104); }
        SEAM(PB + 1);
        if (IN(PB + 2)) { DUP(11, ph_scan(lds, l)); DUP(10, ph_mix_sample(lds, l)); ph_nsa(lds, l); }
        SEAM(PB + 2);
        if (IN(PB + 3)) { if (VERIFY_NSA && l == 0) { ph_nsa_verify(lds, l); __syncthreads(); } if (l == 0) ph_hsample(lds, 1); DUP(14, ph_outproj(lds, l)); }
        SEAM(PB + 3);
    }
    if (STAMP_PHASE >= 0 || VERIFY_NSA) {
        xcd_barrier(bar);
        if (blockIdx.x == 0) { __shared__ float alpha_s; if (threadIdx.x == 0) { const unsigned long long t1 = wall_clock64(); alpha_s = (float)(stampw[1] - stampw[0]) / (float)(t1 - stampw[0]);
                if (VERIFY_NSA) { const float* dbg = (const float*)(a.ws + WS_CTL + 40960); alpha_s = VERIFY_NSA == 1 ? dbg[3] / (dbg[2] + dbg[3]) : sqrtf(dbg[0] / dbg[1]); } } __syncthreads();
            const float sc = 1.f + alpha_s; float* ys = a.out + O_YS; for (int i = threadIdx.x; i < NB * 1024; i += 512) ys[i] *= sc; }
    }
#undef IN
#undef SEAM
}

extern "C" void kernel_launch(void* const* d_in, const int* in_sizes, int n_in, void* d_out, int out_size, void* d_ws, size_t ws_size, hipStream_t stream) {
    static int grid = 0;
    if (grid == 0) {
        if (n_in != N_IN || (size_t)out_size != O_END || ws_size < WS_END) { fprintf(stderr, "kernel_launch: unexpected shapes (n_in %d out %d ws %zu)\n", n_in, out_size, ws_size); grid = -1; return; }
        int dev = 0, cus = 0;
        if (hipGetDevice(&dev) != hipSuccess || hipDeviceGetAttribute(&cus, hipDeviceAttributeMultiprocessorCount, dev) != hipSuccess) { grid = -1; return; }
        if (hipFuncSetAttribute((const void*)fwd, hipFuncAttributeMaxDynamicSharedMemorySize, LDS_BYTES) != hipSuccess) { fprintf(stderr, "kernel_launch: hipFuncSetAttribute failed\n"); grid = -1; return; }
        int per_cu = 0;
        if (hipOccupancyMaxActiveBlocksPerMultiprocessor(&per_cu, (const void*)fwd, 512, LDS_BYTES) != hipSuccess || per_cu < 1) fprintf(stderr, "kernel_launch: occupancy query says %d\n", per_cu);
        (void)hipGetLastError();
        grid = cus;
    }
    if (grid < 0) return;
    hipMemsetAsync((char*)d_ws + WS_CTL, 0, 65536, stream);
    Args a{};
    for (int i = 0; i < N_IN; ++i) a.in[i] = d_in[i];
    a.out = (float*)d_out; a.ws = (unsigned char*)d_ws;
    if (N_LAUNCHES == 1) { a.ph_lo = 0; a.ph_hi = NPHASE; hipLaunchKernelGGL(fwd, dim3(grid), dim3(512), LDS_BYTES, stream, a); }
    else for (int p = 0; p < NPHASE; ++p) { a.ph_lo = p; a.ph_hi = p + 1; hipLaunchKernelGGL(fwd, dim3(grid), dim3(512), LDS_BYTES, stream, a); }
}
```

```cpp
#include <hip/hip_runtime.h>
#include <cstdio>
#include <cstdint>
#include <type_traits>

#define NSA_DUP 0
#define VERIFY_NSA 0
#define STAMP_PHASE -1
#ifndef N_LAUNCHES
#define N_LAUNCHES 1
#endif

#define DI __device__ __forceinline__
#define LAS __attribute__((address_space(3)))
typedef _Float16 f16;
typedef _Float16 f16x8 __attribute__((ext_vector_type(8)));
typedef _Float16 f16x4 __attribute__((ext_vector_type(4)));
typedef _Float16 f16x2 __attribute__((ext_vector_type(2)));
typedef float f32x4 __attribute__((ext_vector_type(4)));
typedef float f32x2 __attribute__((ext_vector_type(2)));
typedef float f32x16 __attribute__((ext_vector_type(16)));
typedef unsigned u32x4 __attribute__((ext_vector_type(4)));

constexpr int DM = 1024, SEQ = 16384, NB = 32, PAST = 16384, NPOOL = 5120, DIN = 3728, NPD = 3840;
constexpr float EPS = 1e-6f;
constexpr int NPHASE = 10;
enum { I_XP = 0, I_XS, I_CKV, I_CWIN, I_SSC, I_SBC, I_SSM, I_SCF, I_PT, I_CP, I_CS, I_NG, I_WADA, I_BADA, I_WIN, I_WOUT, I_SCW, I_BCW, I_BCB,
       I_DTB, I_ALOG, I_SD, I_SNG, I_CFW, I_CFB, I_LNG, I_LNB, I_QG, I_KG, I_PE, I_W1, I_B1, I_W2, I_B2, N_IN };
constexpr size_t O_YP = 0, O_YS = O_YP + (size_t)SEQ * DM, O_KVP = O_YS + NB * DM, O_KVS = O_KVP + (size_t)2 * SEQ * 256, O_WINP = O_KVS + 2 * NB * 256,
                 O_WINS = O_WINP + 2 * 512 * 128, O_SCP = O_WINS + (size_t)2 * NB * 512 * 128, O_SCS = O_SCP + 2 * 2 * 256, O_BCP = O_SCS + 2 * NB * 512,
                 O_BCS = O_BCP + 2 * 3 * 768, O_HP = O_BCS + 2 * NB * 2304, O_HS = O_HP + 2 * 32768, O_CFP = O_HS + (size_t)2 * NB * 32768,
                 O_CFS = O_CFP + 2 * 30 * 256, O_END = O_CFS + 2 * NB * 7680;
constexpr size_t al256(size_t x) { return (x + 255) & ~(size_t)255; }
constexpr size_t WS_CTL = 0, WS_ADA = 65536, WS_BIAS = WS_ADA + al256(2 * 33 * 3072 * 4), WS_PEB = WS_BIAS + al256(2 * NPD * 4), WS_WTIN = WS_PEB + 2048,
                 WS_WTOUT = WS_WTIN + (size_t)2 * NPD * 1024 * 2, WS_W1T = WS_WTOUT + (size_t)2 * 1024 * 1024 * 2, WS_A16 = WS_W1T + (size_t)4 * 128 * 2048 * 2,
                 WS_RSSP = WS_A16 + (size_t)SEQ * 1024 * 2, WS_X1 = WS_RSSP + (size_t)SEQ * 16 * 4, WS_PROJ = WS_X1 + (size_t)SEQ * 1024 * 4,
                 WS_Y16 = WS_PROJ + (size_t)15 * SEQ * 256 * 2, WS_ACT = WS_Y16 + (size_t)SEQ * 1024 * 2, WS_YD = WS_ACT + (size_t)SEQ * 768 * 2,
                 WS_CST = WS_YD + (size_t)SEQ * 256 * 4, WS_ACS = WS_CST + (size_t)128 * 32768 * 4, WS_CDEC = WS_ACS + (size_t)SEQ * 4 * 4, WS_Q16 = WS_CDEC + 2048,
                 WS_KS16 = WS_Q16 + (size_t)SEQ * 256 * 2, WS_VS16 = WS_KS16 + (size_t)SEQ * 64 * 2, WS_KW16 = WS_VS16 + (size_t)SEQ * 64 * 2,
                 WS_VW16 = WS_KW16 + (size_t)SEQ * 64 * 2, WS_GATES = WS_VW16 + (size_t)SEQ * 64 * 2, WS_KC = WS_GATES + (size_t)SEQ * 12 * 4,
                 WS_VC = WS_KC + 1024 * 64 * 4, WS_KCS = WS_VC + 1024 * 64 * 4, WS_VCS = WS_KCS + (size_t)2 * NB * 1024 * 64 * 4,
                 WS_PROJS = WS_VCS + (size_t)2 * NB * 1024 * 64 * 4, WS_YS = WS_PROJS + al256(NB * NPD * 4), WS_XS1 = WS_YS + NB * 1024 * 4, WS_GNX = WS_XS1 + NB * 1024 * 4, WS_NRG = WS_GNX + 4096, WS_VST16 = WS_NRG + 2 * NB * 1024, WS_VWT16 = WS_VST16 + (size_t)SEQ * 64 * 2, WS_KC16 = WS_VWT16 + (size_t)SEQ * 64 * 2,
                 WS_VCT16 = WS_KC16 + 1024 * 64 * 2, WS_HPV = WS_VCT16 + 1024 * 64 * 2, WS_W2T = WS_HPV + (size_t)128 * 32768 * 4, WS_PEBP = WS_W2T + 4 * 64 * 128 * 2, WS_HS16 = WS_PEBP + 4 * 8 * 128 * 4, WS_SELM = WS_HS16 + NB * 1024 * 2, WS_END = WS_SELM + 512 * 272 * 4;
constexpr int LDS_BYTES = 147456;
constexpr int MISC_OFF = 147200;

struct Args { const void* in[N_IN]; float* out; unsigned char* ws; int ph_lo, ph_hi; };

#define XB_TMO      128
#define XB_XCNT(j)  (256  + 64 * (j))
#define XB_XSUB(j)  (1280 + 64 * (j))
#define XB_XGEN(j)  (2304 + 64 * (j))
#define XB_TOP      3328
#define XB_TOPGEN   3392
#define XCD_BAR_WORDS 3456
#define XB_SPIN_CAP (1u << 18)
__device__ __forceinline__ unsigned xb_ld(unsigned* p)              { return __hip_atomic_load(p, __ATOMIC_RELAXED, __HIP_MEMORY_SCOPE_AGENT); }
__device__ __forceinline__ unsigned xb_add(unsigned* p, unsigned v) { return __hip_atomic_fetch_add(p, v, __ATOMIC_RELAXED, __HIP_MEMORY_SCOPE_AGENT); }
__device__ __forceinline__ unsigned xb_xcc_id() { return (unsigned)__builtin_amdgcn_s_getreg((3 << 11) | 20) & 0xFu; }
#define XB_SPIN(cond, bar) do { unsigned _sp = 0; while (cond) { __builtin_amdgcn_s_sleep(1); \
    if ((++_sp & 255u) == 0u) { if (xb_ld(&(bar)[XB_TMO])) break; if (_sp > XB_SPIN_CAP) { atomicAdd(&(bar)[XB_TMO], 1u); break; } } } } while (0)
struct XcdBarrier { unsigned* bar; unsigned x; volatile LAS unsigned* st; };
__device__ __forceinline__ XcdBarrier xcd_barrier_post(unsigned* bar, volatile LAS unsigned* st) {
    XcdBarrier b; b.bar = bar; b.x = xb_xcc_id(); b.st = st;
    if (threadIdx.x == 0) (void)xb_add(&bar[XB_XCNT(b.x)], 1u);
    return b;
}
__device__ __forceinline__ void xcd_barrier_complete(unsigned* bar, unsigned x, unsigned& nloc, unsigned& nx) {
    const unsigned G = gridDim.x * gridDim.y * gridDim.z;
    unsigned sum, cnt, mine, sp = 0u;
    for (;;) {
        sum = 0u; cnt = 0u; mine = 0u;
#pragma unroll
        for (unsigned j = 0; j < 16; ++j) { const unsigned c = xb_ld(&bar[XB_XCNT(j)]); sum += c; cnt += (c > 0u) ? 1u : 0u; mine = (j == x) ? c : mine; }
        if (sum == G) break;
        __builtin_amdgcn_s_sleep(1);
        if ((++sp & 255u) == 0u) { if (xb_ld(&bar[XB_TMO])) break; if (sp > XB_SPIN_CAP) { atomicAdd(&bar[XB_TMO], 1u); break; } }
    }
    nloc = mine > 0u ? mine : 1u; nx = cnt > 0u ? cnt : 1u;
}
__device__ __forceinline__ void xcd_barrier(const XcdBarrier& b) {
    asm volatile("s_waitcnt vmcnt(0)" ::: "memory");
    __syncthreads();
    if (threadIdx.x == 0) {
        unsigned* bar = b.bar;
        __builtin_amdgcn_s_waitcnt(0);
        unsigned nloc = b.st[0], nx = b.st[1];
        if (nloc == 0u) { xcd_barrier_complete(bar, b.x, nloc, nx); b.st[0] = nloc; b.st[1] = nx; }
        const unsigned old = xb_add(&bar[XB_XSUB(b.x)], 1u);
        const unsigned gen = old / nloc;
        if (old + 1u == (gen + 1u) * nloc) {
            __builtin_amdgcn_fence(__ATOMIC_RELEASE, "agent");
            asm volatile("s_waitcnt vmcnt(0)" ::: "memory");
            const unsigned og = xb_add(&bar[XB_TOP], 1u);
            const unsigned tg = og / nx;
            if (og + 1u == (tg + 1u) * nx) xb_add(&bar[XB_TOPGEN], 1u);
            else XB_SPIN(xb_ld(&bar[XB_TOPGEN]) == tg, bar);
            __builtin_amdgcn_fence(__ATOMIC_ACQUIRE, "agent");
            xb_add(&bar[XB_XGEN(b.x)], 1u);
            asm volatile("s_waitcnt vmcnt(0)" ::: "memory");
        } else {
            XB_SPIN(xb_ld(&bar[XB_XGEN(b.x)]) == gen, bar);
            __builtin_amdgcn_fence(__ATOMIC_ACQUIRE, "agent");
            asm volatile("s_waitcnt vmcnt(0)" ::: "memory");
        }
    }
    __syncthreads();
}

DI void lds_barrier() { asm volatile("s_waitcnt lgkmcnt(0)\n\ts_barrier" ::: "memory"); }
DI int ltid() { int t = threadIdx.x; asm volatile("" : "+v"(t)); return t; }
template <int CTRL> DI float dppf(float x) { return __builtin_bit_cast(float, __builtin_amdgcn_update_dpp(0, __builtin_bit_cast(int, x), CTRL, 0xF, 0xF, true)); }
template <int CTRL> DI int dppi(int x) { return __builtin_amdgcn_update_dpp(0, x, CTRL, 0xF, 0xF, true); }
constexpr int DPP_X1 = 0xB1, DPP_X2 = 0x4E, DPP_HM = 0x141, DPP_R8 = 0x128;
DI float sum16(float v) { v += dppf<DPP_X1>(v); v += dppf<DPP_X2>(v); v += dppf<DPP_HM>(v); v += dppf<DPP_R8>(v); return v; }
DI float max16(float v) { v = fmaxf(v, dppf<DPP_X1>(v)); v = fmaxf(v, dppf<DPP_X2>(v)); v = fmaxf(v, dppf<DPP_HM>(v)); v = fmaxf(v, dppf<DPP_R8>(v)); return v; }
DI float wsum(float v) { v = sum16(v); v += __shfl_xor(v, 16); v += __shfl_xor(v, 32); return v; }
DI float wmaxf(float v) { v = max16(v); v = fmaxf(v, __shfl_xor(v, 16)); v = fmaxf(v, __shfl_xor(v, 32)); return v; }
DI float sigmoidf_(float x) { return 1.f / (1.f + __expf(-x)); }
DI float siluf_(float x) { return x / (1.f + __expf(-x)); }
DI float softplusf_(float x) { return fmaxf(x, 0.f) + log1pf(__expf(-fabsf(x))); }
DI f16x8 ld_h8(const f16* p) { return *(const f16x8*)p; }
DI f16x8 cvt_h8(const float* p) { const f32x4 a = *(const f32x4*)p, b = *(const f32x4*)(p + 4); f16x8 r; r[0] = (f16)a[0]; r[1] = (f16)a[1]; r[2] = (f16)a[2]; r[3] = (f16)a[3]; r[4] = (f16)b[0]; r[5] = (f16)b[1]; r[6] = (f16)b[2]; r[7] = (f16)b[3]; return r; }
DI int vt_key(int pos) { const int p = pos & 31, qq = p >> 3, j = p & 7; return (pos & ~31) + (j < 4 ? 4 * qq + j : 12 + 4 * qq + j); }
DI int vt_pos(int key) { const int k = key & 31; return (key & ~31) + (k < 16 ? 8 * (k >> 2) + (k & 3) : 8 * ((k - 16) >> 2) + 4 + (k & 3)); }
DI int src_col(int n) { return n < 2048 ? n : (n < 3456 ? n + 4 : (n < 3460 ? n - 1408 : (n < 3472 ? n + 256 : (n < 3584 ? -1 : n - 124)))); }
DI int dst_col(int s) { return s < 2048 ? s : (s < 2052 ? s + 1408 : (s < 3460 ? s - 4 : (s < 3716 ? s + 124 : s - 256))); }

DI void edge_publish(unsigned* ctr) {
    asm volatile("s_waitcnt vmcnt(0)" ::: "memory"); __syncthreads();
    if (threadIdx.x == 0) { __builtin_amdgcn_fence(__ATOMIC_RELEASE, "agent"); asm volatile("s_waitcnt vmcnt(0)" ::: "memory"); __hip_atomic_fetch_add(ctr, 1u, __ATOMIC_RELAXED, __HIP_MEMORY_SCOPE_AGENT); }
}
DI void edge_wait(unsigned* ctr, unsigned need) {
    if (threadIdx.x == 0) { unsigned sp = 0;
        while (__hip_atomic_load(ctr, __ATOMIC_RELAXED, __HIP_MEMORY_SCOPE_AGENT) < need) { __builtin_amdgcn_s_sleep(8); if (++sp > (1u << 22)) break; }
        __builtin_amdgcn_fence(__ATOMIC_ACQUIRE, "agent"); asm volatile("s_waitcnt vmcnt(0)" ::: "memory"); }
    __syncthreads();
}
namespace pg8 {
constexpr int BM = 256, BK = 64, HALF = 128, HTB = HALF * BK * 2, STAGE_BYTES = 8 * HTB, NXCD = 8, WGM = 8;
DI int lds_byte(int r, int c) { const int st = (r >> 4) * 2 + (c >> 5), rr = r & 15, cc = c & 31, ob = rr * 64 + cc * 2; return st * 1024 + (ob ^ (((ob >> 9) & 1) << 5)); }
DI void stage_rc(int b, int& R, int& C) { const int st = b / 1024, sb = b % 1024, swz = sb ^ (((sb >> 9) & 1) << 5); R = (st >> 1) * 16 + swz / 64; C = (st & 1) * 32 + (swz % 64) / 2; }
DI int perm32(int rho) { const int n = rho >> 4, i = rho & 15; return 8 * (i >> 2) + 4 * n + (i & 3); }
struct Unit { int pm, pn; };
struct Gemm { const f16* A; const f16* Bt; int M, N, K; };
struct StaticOrder {
    int nM, nN, nwg, G, c;
    DI void init(int M, int N, int G_, int c_) { nM = M / BM; nN = N / BM; nwg = nM * nN; G = G_; c = c_; }
    DI bool next(int i, Unit& u) const {
        const long L = (long)i * G + c; if (L >= nwg) return false;
        int wgid = (int)L; { const int q = nwg / NXCD, r = nwg % NXCD, xcd = wgid % NXCD, off = wgid / NXCD; wgid = (xcd < r ? xcd * (q + 1) : r * (q + 1) + (xcd - r) * q) + off; }
        const int nig = WGM * nN, gid = wgid / nig, fm = gid * WGM, gsz = (nM - fm) < WGM ? (nM - fm) : WGM;
        u.pm = fm + ((wgid % nig) % gsz); u.pn = (wgid % nig) / gsz; return true;
    }
    DI void a_ready(const Unit&) const {}
    DI void done(const Unit&) const {}
};
template <class Epi, class Sched>
DI void gemm_phase(LAS unsigned char* lds, const Gemm g, const Sched& S, const Epi& E) {
    const int tid = ltid(), wid = __builtin_amdgcn_readfirstlane(tid >> 6), lane = tid & 63, wr = wid >> 2, wc = wid & 3, fr = lane & 15, fq = lane >> 4;
    const int K = g.K, nt = K / BK;
    unsigned voffA[2], voffB[2];
#pragma unroll
    for (int i = 0; i < 2; ++i) { int R, C; stage_rc(tid * 16 + i * 8192, R, C); const int Rb = Epi::PERM ? ((R & ~31) + perm32(R & 31)) : R;
        voffA[i] = (unsigned)(R * K + C) * 2u; voffB[i] = (unsigned)(Rb * K + C) * 2u; }
    const size_t kstep = (size_t)(BK * 2);
    const size_t hstep = (size_t)HALF * K * 2;
    const size_t tstep = 2 * hstep;
    const unsigned ldsw = (unsigned)wid * 1024u;
    const int aoff = lds_byte(wr * 64 + fr, fq * 8), boff = lds_byte(wc * 32 + fr, fq * 8);
#define PG8_SA(b, h) (((b) * 2 + (h)) * HTB)
#define PG8_SB(b, h) ((4 + (b) * 2 + (h)) * HTB)
#define PG8_STAGE(bufoff, gbase, voff) do { _Pragma("unroll") for (int _i = 0; _i < 2; ++_i) \
        __builtin_amdgcn_global_load_lds((const unsigned*)((const char*)(gbase) + (voff)[_i]), (LAS unsigned*)(lds + (bufoff) + ldsw + _i * 8192), 16, 0, 0); } while (0)
#define PG8_LDA(dst, b, h) do { _Pragma("unroll") for (int m = 0; m < 4; ++m) _Pragma("unroll") for (int k = 0; k < 2; ++k) dst[m][k] = *(const LAS f16x8*)(lds + PG8_SA(b, h) + aoff + m * 2048 + k * 1024); } while (0)
#define PG8_LDB(dst, b, h) do { _Pragma("unroll") for (int n = 0; n < 2; ++n) _Pragma("unroll") for (int k = 0; k < 2; ++k) dst[n][k] = *(const LAS f16x8*)(lds + PG8_SB(b, h) + boff + n * 2048 + k * 1024); } while (0)
#define PG8_MMA(ai, bj, At, Bt) do { __builtin_amdgcn_s_setprio(1); _Pragma("unroll") for (int m = 0; m < 4; ++m) _Pragma("unroll") for (int n = 0; n < 2; ++n) _Pragma("unroll") for (int k = 0; k < 2; ++k) \
        acc[ai][bj][m][n] = __builtin_amdgcn_mfma_f32_16x16x32_f16(Bt[n][k], At[m][k], acc[ai][bj][m][n], 0, 0, 0); __builtin_amdgcn_s_setprio(0); } while (0)
#define PG8_WAIT_V(n) asm volatile("s_waitcnt vmcnt(" #n ")" ::: "memory")
#define PG8_WAIT_L(n) asm volatile("s_waitcnt lgkmcnt(" #n ")" ::: "memory")
#define PG8_BAR __builtin_amdgcn_s_barrier()
#define PG8_SCHED __builtin_amdgcn_sched_barrier(0)
    Unit cur, nxt; int ui = 0;
    if (!S.next(0, cur)) return;
    f32x4 acc[2][2][4][2];
#pragma unroll
    for (int a = 0; a < 2; ++a)
#pragma unroll
        for (int b = 0; b < 2; ++b)
#pragma unroll
            for (int m = 0; m < 4; ++m)
#pragma unroll
                for (int n = 0; n < 2; ++n) acc[a][b][m][n] = (f32x4){0.f, 0.f, 0.f, 0.f};
    f16x8 At[4][2], B0[2][2], B1[2][2];
    const char* cA = (const char*)g.A + (size_t)cur.pm * tstep; const char* cB = (const char*)g.Bt + (size_t)cur.pn * tstep;
    S.a_ready(cur);
    PG8_STAGE(PG8_SB(0, 0), cB, voffB); PG8_STAGE(PG8_SA(0, 0), cA, voffA); PG8_STAGE(PG8_SB(0, 1), cB + hstep, voffB); PG8_STAGE(PG8_SA(0, 1), cA + hstep, voffA);
    if (wr == 1) PG8_BAR;
    PG8_WAIT_V(4); PG8_BAR;
    PG8_STAGE(PG8_SB(1, 0), cB + kstep, voffB); PG8_STAGE(PG8_SA(1, 0), cA + kstep, voffA); PG8_STAGE(PG8_SB(1, 1), cB + hstep + kstep, voffB);
    PG8_WAIT_V(6); PG8_BAR;
    for (;;) {
        const bool has_next = S.next(ui + 1, nxt);
        const char* nA = has_next ? (const char*)g.A + (size_t)nxt.pm * tstep : cA; const char* nB = has_next ? (const char*)g.Bt + (size_t)nxt.pn * tstep : cB;
        for (int t = 0; t < nt; t += 2) {
            const bool last = (t == nt - 2);
            const char* a1 = cA + (size_t)(t + 1) * kstep;
            const char* a2 = last ? nA : cA + (size_t)(t + 2) * kstep; const char* b2 = last ? nB : cB + (size_t)(t + 2) * kstep;
            const char* a3 = a2 + kstep; const char* b3 = b2 + kstep;
            if (last && has_next) S.a_ready(nxt);
            PG8_LDB(B0, 0, 0); PG8_SCHED; PG8_LDA(At, 0, 0); PG8_STAGE(PG8_SA(1, 1), a1 + hstep, voffA);
            PG8_WAIT_L(8); PG8_BAR; PG8_WAIT_L(0); PG8_MMA(0, 0, At, B0); PG8_BAR; PG8_SCHED;
            PG8_LDB(B1, 0, 1); PG8_STAGE(PG8_SB(0, 0), b2, voffB);
            PG8_BAR; PG8_WAIT_L(0); PG8_MMA(0, 1, At, B1); PG8_BAR;
            PG8_LDA(At, 0, 1); PG8_STAGE(PG8_SA(0, 0), a2, voffA);
            PG8_BAR; PG8_WAIT_L(0); PG8_MMA(1, 0, At, B0); PG8_BAR; PG8_SCHED;
            PG8_STAGE(PG8_SB(0, 1), b2 + hstep, voffB);
            PG8_WAIT_V(6); PG8_BAR; PG8_MMA(1, 1, At, B1); PG8_BAR;
            PG8_LDB(B0, 1, 0); PG8_SCHED; PG8_LDA(At, 1, 0); PG8_STAGE(PG8_SA(0, 1), a2 + hstep, voffA);
            PG8_WAIT_L(8); PG8_BAR; PG8_WAIT_L(0); PG8_MMA(0, 0, At, B0); PG8_BAR; PG8_SCHED;
            PG8_LDB(B1, 1, 1); PG8_STAGE(PG8_SB(1, 0), b3, voffB);
            PG8_BAR; PG8_WAIT_L(0); PG8_MMA(0, 1, At, B1); PG8_BAR;
            PG8_LDA(At, 1, 1); PG8_STAGE(PG8_SA(1, 0), a3, voffA);
            PG8_BAR; PG8_WAIT_L(0); PG8_MMA(1, 0, At, B0); PG8_BAR; PG8_SCHED;
            PG8_STAGE(PG8_SB(1, 1), b3 + hstep, voffB);
            PG8_WAIT_V(6); PG8_BAR; PG8_MMA(1, 1, At, B1); PG8_BAR;
        }
        E(acc, cur, wr, wc, fr, fq);
        if (!has_next) break;
#pragma unroll
        for (int a = 0; a < 2; ++a)
#pragma unroll
            for (int b = 0; b < 2; ++b)
#pragma unroll
                for (int m = 0; m < 4; ++m)
#pragma unroll
                    for (int n = 0; n < 2; ++n) acc[a][b][m][n] = (f32x4){0.f, 0.f, 0.f, 0.f};
        cur = nxt; cA = nA; cB = nB; ++ui;
    }
    PG8_WAIT_V(0);
    if (wr == 0) PG8_BAR;
    PG8_BAR;
#undef PG8_SA
#undef PG8_SB
#undef PG8_STAGE
#undef PG8_LDA
#undef PG8_LDB
#undef PG8_MMA
#undef PG8_WAIT_V
#undef PG8_WAIT_L
#undef PG8_BAR
#undef PG8_SCHED
}
}

struct EpiIn {
    static constexpr bool PERM = true;
    f16* proj; const float* rssp; const float* bias; float* kvout;
    DI void operator()(const f32x4 (&acc)[2][2][4][2], const pg8::Unit& u, int wr, int wc, int fr, int fq) const {
        const int row0 = u.pm * 256 + wr * 64 + fr, colt = wc * 32 + 8 * fq;
        f32x4 bv[2][2];
#pragma unroll
        for (int bj = 0; bj < 2; ++bj)
#pragma unroll
            for (int n = 0; n < 2; ++n) bv[bj][n] = *(const f32x4*)(bias + u.pn * 256 + colt + bj * 128 + 4 * n);
        f16* pt = proj + (size_t)u.pn * SEQ * 256;
#pragma unroll
        for (int ai = 0; ai < 2; ++ai)
#pragma unroll
            for (int m = 0; m < 4; ++m) {
                const int row = row0 + ai * 128 + m * 16;
                const f32x4* rp = (const f32x4*)(rssp + (size_t)row * 16);
                const f32x4 s0 = rp[0], s1 = rp[1], s2 = rp[2], s3 = rp[3];
                const float ss = ((s0[0] + s0[1]) + (s0[2] + s0[3])) + ((s1[0] + s1[1]) + (s1[2] + s1[3])) + ((s2[0] + s2[1]) + (s2[2] + s2[3])) + ((s3[0] + s3[1]) + (s3[2] + s3[3]));
                const float r = rsqrtf(ss * (1.f / 1024.f) + EPS);
#pragma unroll
                for (int bj = 0; bj < 2; ++bj) {
                    const f32x4 v0 = acc[ai][bj][m][0] * r + bv[bj][0], v1 = acc[ai][bj][m][1] * r + bv[bj][1];
                    f16x8 h; h[0] = (f16)v0[0]; h[1] = (f16)v0[1]; h[2] = (f16)v0[2]; h[3] = (f16)v0[3]; h[4] = (f16)v1[0]; h[5] = (f16)v1[1]; h[6] = (f16)v1[2]; h[7] = (f16)v1[3];
                    *(f16x8*)(pt + (size_t)row * 256 + colt + bj * 128) = h;
                    if (u.pn == 12) { float* kp = kvout + (size_t)row * 256 + colt + bj * 128; *(f32x4*)kp = v0; *(f32x4*)(kp + 4) = v1; }
                }
            }
    }
};
struct EpiOut {
    static constexpr bool PERM = false;
    const float* xin; float* xout; const float* gate; f16* a16; const float* gnext; float* rssp;
    DI void operator()(const f32x4 (&acc)[2][2][4][2], const pg8::Unit& u, int wr, int wc, int fr, int fq) const {
        const int row0 = u.pm * 256 + wr * 64 + fr, col0 = u.pn * 256 + wc * 32 + 4 * fq;
        float ss[2][4];
#pragma unroll
        for (int ai = 0; ai < 2; ++ai)
#pragma unroll
            for (int m = 0; m < 4; ++m) ss[ai][m] = 0.f;
#pragma unroll
        for (int bj = 0; bj < 2; ++bj)
#pragma unroll
            for (int ai = 0; ai < 2; ++ai) {
                f32x4 gv[2], xv[4][2];
#pragma unroll
                for (int n = 0; n < 2; ++n) gv[n] = *(const f32x4*)(gate + col0 + bj * 128 + n * 16);
#pragma unroll
                for (int m = 0; m < 4; ++m)
#pragma unroll
                    for (int n = 0; n < 2; ++n) xv[m][n] = *(const f32x4*)(xin + (size_t)(row0 + ai * 128 + m * 16) * 1024 + col0 + bj * 128 + n * 16);
#pragma unroll
                for (int m = 0; m < 4; ++m)
#pragma unroll
                    for (int n = 0; n < 2; ++n) {
                        const int row = row0 + ai * 128 + m * 16, col = col0 + bj * 128 + n * 16;
                        const f32x4 o = xv[m][n] + gv[n] * acc[ai][bj][m][n]; xv[m][n] = o;
                        *(f32x4*)(xout + (size_t)row * 1024 + col) = o;
                        ss[ai][m] += (o[0] * o[0] + o[1] * o[1]) + (o[2] * o[2] + o[3] * o[3]); }
                if (a16) {
#pragma unroll
                    for (int n = 0; n < 2; ++n) { const int col = col0 + bj * 128 + n * 16; const f32x4 gn = *(const f32x4*)(gnext + col);
#pragma unroll
                        for (int m = 0; m < 4; ++m) { const f32x4 o = xv[m][n]; f16x4 h; h[0] = (f16)(o[0] * gn[0]); h[1] = (f16)(o[1] * gn[1]); h[2] = (f16)(o[2] * gn[2]); h[3] = (f16)(o[3] * gn[3]);
                            *(f16x4*)(a16 + (size_t)(row0 + ai * 128 + m * 16) * 1024 + col) = h; } } }
                asm volatile("" ::: "memory");
            }
        if (a16) {
#pragma unroll
            for (int ai = 0; ai < 2; ++ai)
#pragma unroll
                for (int m = 0; m < 4; ++m) { float v = ss[ai][m]; v += __shfl_xor(v, 16); v += __shfl_xor(v, 32);
                    if (fq == 0) rssp[(size_t)(row0 + ai * 128 + m * 16) * 16 + u.pn * 4 + wc] = v; }
        }
    }
};

template <int MP  , class AFn, class OFn>
DI void skinny_item(LAS unsigned char* lds, const float* W, int ldw, int n0, int ncols, int M, AFn afn, OFn ofn) {
    const int tid = ltid(), wave = tid >> 6, lane = tid & 63;
    LAS float* As = (LAS float*)lds;
    float acc[MP];
#pragma unroll
    for (int m = 0; m < MP; ++m) acc[m] = 0.f;
    for (int kc = 0; kc < 1024; kc += 512) {
        __syncthreads();
#pragma unroll 4
        for (int m = 0; m < MP; ++m) As[tid * 36 + m] = (m < M) ? afn(m, kc + tid) : 0.f;
        __syncthreads();
        const int kb = wave * 64;
#pragma unroll 8
        for (int kk = 0; kk < 64; ++kk) {
            const float w = (lane < ncols) ? W[(size_t)(kc + kb + kk) * ldw + n0 + lane] : 0.f;
            const float av = As[(kb + kk) * 36 + lane];
#pragma unroll
            for (int m = 0; m < MP; ++m) acc[m] += __builtin_bit_cast(float, __builtin_amdgcn_readlane(__builtin_bit_cast(int, av), m)) * w;
        }
    }
    __syncthreads();
    LAS float* R = (LAS float*)lds;
#pragma unroll
    for (int m = 0; m < MP; ++m) R[(wave * 36 + m) * 64 + lane] = acc[m];
    __syncthreads();
    for (int idx = tid; idx < M * 64; idx += 512) { const int m = idx >> 6, c = idx & 63; float s = 0.f;
#pragma unroll
        for (int w = 0; w < 8; ++w) s += R[(w * 36 + m) * 64 + c];
        if (c < ncols) ofn(m, n0 + c, s); }
    __syncthreads();
}

template <bool F32> struct Raw16 { f32x4 f[4]; f16x8 hv[2];
    DI void ld(const void* p) { if (F32) {
#pragma unroll
            for (int i = 0; i < 4; ++i) f[i] = *(const f32x4*)((const float*)p + 4 * i); } else { hv[0] = *(const f16x8*)p; hv[1] = *(const f16x8*)((const f16*)p + 8); } }
    DI f16x8 get(int i) const { if (F32) { const f32x4 a = f[2 * i], b = f[2 * i + 1]; f16x8 r; r[0] = (f16)a[0]; r[1] = (f16)a[1]; r[2] = (f16)a[2]; r[3] = (f16)a[3]; r[4] = (f16)b[0]; r[5] = (f16)b[1]; r[6] = (f16)b[2]; r[7] = (f16)b[3]; return r; } return hv[i]; } };
template <bool SRC_F32, class ChunkFn>
DI void compress_item(LAS unsigned char* lds, ChunkFn chunkp  , int c0, const f16* w1t, const float* peb, const f16* w2t  , const float* b2, const float* kg, float* out, f16* out16, f16* outT16) {
    typedef typename std::conditional<SRC_F32, float, f16>::type T;
    const int tid = ltid(), wave = tid >> 6, lane = tid & 63, wm = wave >> 2, wq = wave & 3, r = lane & 31, h = lane >> 5;
    LAS f16* As = (LAS f16*)lds;
    LAS f16* Bs = (LAS f16*)(lds + 2 * 18432);
    f32x16 acc[2][2];
#pragma unroll
    for (int a = 0; a < 2; ++a)
#pragma unroll
        for (int b = 0; b < 2; ++b)
#pragma unroll
            for (int i = 0; i < 16; ++i) acc[a][b][i] = 0.f;
    constexpr int NA = SRC_F32 ? 4 : 2, AE = SRC_F32 ? 4 : 8;
    const int arow = SRC_F32 ? tid >> 4 : tid >> 3, aseg = SRC_F32 ? tid & 15 : tid & 7, brow = tid >> 3, bsg = tid & 7;
    const T* ap[NA];
#pragma unroll
    for (int i = 0; i < NA; ++i) { int ch = c0 + arow + (128 / NA) * i; ch = ch < 1023 ? ch : 1023; ap[i] = (const T*)chunkp(ch) + aseg * AE; }
    const f16* bsrc = w1t + (size_t)brow * 2048 + bsg * 8;
    Raw16<SRC_F32> ra[3]; f16x8 rb[3][4];
    auto ldab = [&](int sl, int kb) {
#pragma unroll
        for (int i = 0; i < NA; ++i) { if (SRC_F32) ra[sl].f[i] = *(const f32x4*)((const float*)ap[i] + kb * 256); else ra[sl].hv[i] = *(const f16x8*)((const f16*)ap[i] + kb * 256); }
#pragma unroll
        for (int i = 0; i < 4; ++i) rb[sl][i] = ld_h8(bsrc + (size_t)(i & 1) * 64 * 2048 + (i >> 1) * 1024 + kb * 64 + 0); };
    auto stab = [&](int sl, int nx) {
#pragma unroll
        for (int i = 0; i < NA; ++i) {
            if (SRC_F32) { const f32x4 v = ra[sl].f[i]; f16x4 hq; hq[0] = (f16)v[0]; hq[1] = (f16)v[1]; hq[2] = (f16)v[2]; hq[3] = (f16)v[3]; *(LAS f16x4*)(As + nx * 9216 + (arow + 32 * i) * 72 + 4 * aseg) = hq; }
            else *(LAS f16x8*)(As + nx * 9216 + (arow + 64 * i) * 72 + 8 * aseg) = ra[sl].hv[i]; }
#pragma unroll
        for (int i = 0; i < 4; ++i) *(LAS f16x8*)(Bs + nx * 18432 + (brow + 64 * i) * 72 + 8 * bsg) = rb[sl][i]; };
#pragma unroll
    for (int i = 0; i < 3; ++i) ldab(i, i);
    __syncthreads();
    stab(0, 0);
    ldab(0, 3);
    lds_barrier();
#pragma unroll
    for (int kb = 0; kb < 16; ++kb) {
        const int cur = kb & 1;
        const LAS f16* Ac = As + cur * 9216 + (64 * wm + r) * 72 + 8 * h; const LAS f16* Bc = Bs + cur * 18432 + (64 * wq + r) * 72 + 8 * h;
#pragma unroll
        for (int ks = 0; ks < 4; ++ks) {
            const f16x8 a0 = *(const LAS f16x8*)(Ac + 16 * ks), a1 = *(const LAS f16x8*)(Ac + 32 * 72 + 16 * ks), b0 = *(const LAS f16x8*)(Bc + 16 * ks), b1 = *(const LAS f16x8*)(Bc + 32 * 72 + 16 * ks);
            acc[0][0] = __builtin_amdgcn_mfma_f32_32x32x16_f16(a0, b0, acc[0][0], 0, 0, 0); acc[0][1] = __builtin_amdgcn_mfma_f32_32x32x16_f16(a0, b1, acc[0][1], 0, 0, 0);
            acc[1][0] = __builtin_amdgcn_mfma_f32_32x32x16_f16(a1, b0, acc[1][0], 0, 0, 0); acc[1][1] = __builtin_amdgcn_mfma_f32_32x32x16_f16(a1, b1, acc[1][1], 0, 0, 0);
        }
        if (kb + 1 < 16) { const int nx = cur ^ 1, sl = (kb + 1) % 3;
            stab(sl, nx);
            if (kb + 4 < 16) ldab(sl, kb + 4); }
        lds_barrier();
    }
    LAS float* SL = (LAS float*)lds;
    LAS f16* HS = (LAS f16*)(lds + 65536);
    if (wq >= 2) {
#pragma unroll
        for (int a = 0; a < 2; ++a)
#pragma unroll
            for (int b = 0; b < 2; ++b)
#pragma unroll
                for (int i = 0; i < 16; ++i) SL[(64 * wm + 32 * a + (i & 3) + 8 * (i >> 2) + 4 * h) * 128 + 64 * (wq - 2) + 32 * b + r] = acc[a][b][i];
    }
    __syncthreads();
    if (wq < 2) {
#pragma unroll
        for (int a = 0; a < 2; ++a)
#pragma unroll
            for (int b = 0; b < 2; ++b) { const int f = 64 * wq + 32 * b + r; float pb = 0.f;
#pragma unroll
                for (int p8 = 0; p8 < 8; ++p8) pb += peb[p8 * 128 + f];
#pragma unroll
                for (int i = 0; i < 16; ++i) { const int m = 64 * wm + 32 * a + (i & 3) + 8 * (i >> 2) + 4 * h; const float sv = m < 127 ? SL[(m + 1) * 128 + f] : 0.f;
                    HS[m * 136 + f] = (f16)siluf_(acc[a][b][i] + sv + pb); } }
    }
    __syncthreads();
    {
        const int fr = lane & 15, q = lane >> 4;
        f32x4 o[4];
#pragma unroll
        for (int et = 0; et < 4; ++et) o[et] = (f32x4){0.f, 0.f, 0.f, 0.f};
#pragma unroll
        for (int ks = 0; ks < 4; ++ks) { const f16x8 av = *(const LAS f16x8*)(HS + (16 * wave + fr) * 136 + 32 * ks + 8 * q);
#pragma unroll
            for (int et = 0; et < 4; ++et) o[et] = __builtin_amdgcn_mfma_f32_16x16x32_f16(av, ld_h8(w2t + (size_t)(16 * et + fr) * 128 + 32 * ks + 8 * q), o[et], 0, 0, 0); }
        float bb[4], gg[4];
#pragma unroll
        for (int et = 0; et < 4; ++et) { bb[et] = b2[16 * et + fr]; gg[et] = kg ? kg[16 * et + fr] : 1.f; }
#pragma unroll
        for (int j = 0; j < 4; ++j) {
            const int row = 16 * wave + 4 * q + j, blk = c0 + row; float v[4], ss = 0.f;
#pragma unroll
            for (int et = 0; et < 4; ++et) { v[et] = o[et][j] + bb[et]; ss += v[et] * v[et]; }
            if (kg) { ss += __shfl_xor(ss, 1); ss += __shfl_xor(ss, 2); ss += __shfl_xor(ss, 4); ss += __shfl_xor(ss, 8); const float rn = rsqrtf(ss * (1.f / 64.f) + EPS);
#pragma unroll
                for (int et = 0; et < 4; ++et) v[et] = v[et] * rn * gg[et]; }
            const bool okrow = row < 127 && blk < 1023, wr16 = row < 127 && blk < 1024;
#pragma unroll
            for (int et = 0; et < 4; ++et) { const float x = okrow ? v[et] : 0.f; const int e = 16 * et + fr;
                if (out && okrow) out[(size_t)blk * 64 + e] = x;
                if (out16 && wr16) out16[(size_t)blk * 64 + e] = (f16)x;
                if (outT16 && wr16) outT16[(size_t)e * 1024 + vt_pos(blk)] = (f16)x; }
        }
    }
    __syncthreads();
}

struct PromptKV {
    const f16 *ks, *vs, *kw, *vw;
    DI void krow_sel(int pos, float (&k)[64]) const { const f16* p = ks + (size_t)pos * 64;
#pragma unroll
        for (int i = 0; i < 8; ++i) { const f16x8 v = ld_h8(p + i * 8);
#pragma unroll
            for (int j = 0; j < 8; ++j) k[i * 8 + j] = (float)v[j]; } }
    DI float v_sel(int pos, int d) const { return (float)vs[(size_t)pos * 64 + d]; }
    DI void krow_win(int pos, float (&k)[64]) const { const f16* p = kw + (size_t)pos * 64;
#pragma unroll
        for (int i = 0; i < 8; ++i) { const f16x8 v = ld_h8(p + i * 8);
#pragma unroll
            for (int j = 0; j < 8; ++j) k[i * 8 + j] = (float)v[j]; } }
    DI float v_win(int pos, int d) const { return (float)vw[(size_t)pos * 64 + d]; }
};
struct SampleKV {
    const float* ckv; const int* pt; const float* cwin; const float* nks; const float* nvs; const float* nkw; const float* nvw;
    DI const float* prow(int pos, int slot) const { return ckv + ((size_t)pt[pos >> 7] * 128 + (pos & 127)) * 256 + slot * 64; }
    DI void ld64(const float* p, float (&k)[64]) const {
#pragma unroll
        for (int i = 0; i < 16; ++i) { const f32x4 v = *(const f32x4*)(p + i * 4); k[i * 4] = v[0]; k[i * 4 + 1] = v[1]; k[i * 4 + 2] = v[2]; k[i * 4 + 3] = v[3]; } }
    DI void krow_sel(int pos, float (&k)[64]) const { ld64(pos < PAST ? prow(pos, 2) : nks, k); }
    DI float v_sel(int pos, int d) const { return pos < PAST ? prow(pos, 3)[d] : nvs[d]; }
    DI void krow_win(int pos, float (&k)[64]) const { ld64(pos < PAST ? cwin + (size_t)(pos - (PAST - 512)) * 128 : nkw, k); }
    DI float v_win(int pos, int d) const { return pos < PAST ? cwin[(size_t)(pos - (PAST - 512)) * 128 + 64 + d] : nvw[d]; }
};
template <class KV>
DI void nsa_token(LAS float* wl, int qpos, const float* KC, const float* VC, const KV& kv, const float* gates  , float (&o)[4]) {
    const int lane = ltid() & 63;
    LAS float* sc = wl; LAS float* qs = wl + 4096; LAS int* sel = (LAS int*)(wl + 4096 + 256);
    const int cur = qpos >> 6;
    const int ncv = qpos >= 31 ? ((qpos - 31) >> 4) + 1 : 0;
    float oc[4] = {0.f, 0.f, 0.f, 0.f}, os[4] = {0.f, 0.f, 0.f, 0.f}, ow[4] = {0.f, 0.f, 0.f, 0.f};
    {
        float mx[4] = {-3e38f, -3e38f, -3e38f, -3e38f};
        for (int c = lane; c < ncv; c += 64) {
            asm volatile("" ::: "memory");
            float s[4] = {0.f, 0.f, 0.f, 0.f}; const float* kp = KC + (size_t)c * 64;
#pragma unroll
            for (int d4 = 0; d4 < 16; ++d4) { const f32x4 kvv = *(const f32x4*)(kp + d4 * 4);
#pragma unroll
                for (int j = 0; j < 4; ++j) { const f32x4 q = *(const LAS f32x4*)(qs + (d4 * 4 + j) * 4); s[0] += q[0] * kvv[j]; s[1] += q[1] * kvv[j]; s[2] += q[2] * kvv[j]; s[3] += q[3] * kvv[j]; } }
#pragma unroll
            for (int hh = 0; hh < 4; ++hh) { s[hh] *= 0.125f; sc[hh * 1024 + c] = s[hh]; mx[hh] = fmaxf(mx[hh], s[hh]); }
        }
        float inv[4];
#pragma unroll
        for (int hh = 0; hh < 4; ++hh) { mx[hh] = wmaxf(mx[hh]); float sm = 0.f; for (int c = lane; c < ncv; c += 64) { const float e = __expf(sc[hh * 1024 + c] - mx[hh]); sc[hh * 1024 + c] = e; sm += e; } sm = wsum(sm); inv[hh] = ncv > 0 ? 1.f / sm : 0.f; }
        for (int c = lane; c < ncv; c += 64) {
#pragma unroll
            for (int hh = 0; hh < 4; ++hh) sc[hh * 1024 + c] *= inv[hh]; }
        __builtin_amdgcn_wave_barrier();
        for (int c = 0; c < ncv; ++c) { const float v = VC[(size_t)c * 64 + lane];
#pragma unroll
            for (int hh = 0; hh < 4; ++hh) oc[hh] += sc[hh * 1024 + c] * v; }
    }
    const int nsel = (cur + 1) < 16 ? (cur + 1) : 16;
    {
        float scv[5];
#pragma unroll
        for (int i = 0; i < 5; ++i) {
            const int j = lane + 64 * i; float v = -3e38f;
            if (j <= cur) {
                if (j == 0 || j == cur || j == cur - 1) v = 3e38f;
                else { float a = 0.f;
#pragma unroll
                    for (int o5 = -1; o5 < 4; ++o5) { const int c = 4 * j + o5; if (c >= 0 && c < ncv) { const float p = (sc[c] + sc[1024 + c]) + (sc[2048 + c] + sc[3072 + c]); a += (o5 == -1 || o5 == 3) ? 0.5f * p : p; } }
                    v = a; }
            }
            scv[i] = v;
        }
        for (int k = 0; k < nsel; ++k) {
            float bv = scv[0]; int bi = lane;
#pragma unroll
            for (int i = 1; i < 5; ++i) if (scv[i] > bv) { bv = scv[i]; bi = lane + 64 * i; }
#pragma unroll
            for (int off = 32; off > 0; off >>= 1) { const float ov = __shfl_xor(bv, off); const int oi = __shfl_xor(bi, off); if (ov > bv || (ov == bv && oi < bi)) { bv = ov; bi = oi; } }
            if (lane == 0) sel[k] = bi;
#pragma unroll
            for (int i = 0; i < 5; ++i) if (lane + 64 * i == bi) scv[i] = -3e38f;
        }
        __builtin_amdgcn_wave_barrier();
    }
    {
        float mx[4] = {-3e38f, -3e38f, -3e38f, -3e38f};
        for (int k = 0; k < nsel; ++k) {
            asm volatile("" ::: "memory");
            const int pos = sel[k] * 64 + lane; float s[4] = {-1e30f, -1e30f, -1e30f, -1e30f};
            if (pos <= qpos) { float kr[64]; kv.krow_sel(pos, kr); s[0] = s[1] = s[2] = s[3] = 0.f;
#pragma unroll
                for (int d = 0; d < 64; ++d) { const f32x4 q = *(const LAS f32x4*)(qs + d * 4); s[0] += q[0] * kr[d]; s[1] += q[1] * kr[d]; s[2] += q[2] * kr[d]; s[3] += q[3] * kr[d]; }
#pragma unroll
                for (int hh = 0; hh < 4; ++hh) s[hh] *= 0.125f; }
#pragma unroll
            for (int hh = 0; hh < 4; ++hh) { sc[hh * 1024 + k * 64 + lane] = s[hh]; mx[hh] = fmaxf(mx[hh], s[hh]); }
        }
        float inv[4];
#pragma unroll
        for (int hh = 0; hh < 4; ++hh) { mx[hh] = wmaxf(mx[hh]); float sm = 0.f; for (int k = 0; k < nsel; ++k) { const float sv = sc[hh * 1024 + k * 64 + lane]; const float e = sv > -1e29f ? __expf(sv - mx[hh]) : 0.f; sc[hh * 1024 + k * 64 + lane] = e; sm += e; } sm = wsum(sm); inv[hh] = 1.f / sm; }
        __builtin_amdgcn_wave_barrier();
        for (int k = 0; k < nsel; ++k) { const int p0 = sel[k] * 64; int nk = qpos - p0 + 1; nk = nk > 64 ? 64 : nk;
            for (int kk = 0; kk < nk; ++kk) { const float v = kv.v_sel(p0 + kk, lane);
#pragma unroll
                for (int hh = 0; hh < 4; ++hh) os[hh] += sc[hh * 1024 + k * 64 + kk] * v; } }
#pragma unroll
        for (int hh = 0; hh < 4; ++hh) os[hh] *= inv[hh];
        __builtin_amdgcn_wave_barrier();
    }
    {
        const int lo = qpos - 512 > 0 ? qpos - 512 : 0, nw = qpos - lo + 1;
        float mx[4] = {-3e38f, -3e38f, -3e38f, -3e38f};
        for (int i = lane; i < nw; i += 64) { asm volatile("" ::: "memory"); float kr[64]; kv.krow_win(lo + i, kr); float s[4] = {0.f, 0.f, 0.f, 0.f};
#pragma unroll
            for (int d = 0; d < 64; ++d) { const f32x4 q = *(const LAS f32x4*)(qs + d * 4); s[0] += q[0] * kr[d]; s[1] += q[1] * kr[d]; s[2] += q[2] * kr[d]; s[3] += q[3] * kr[d]; }
#pragma unroll
            for (int hh = 0; hh < 4; ++hh) { s[hh] *= 0.125f; sc[hh * 1024 + i] = s[hh]; mx[hh] = fmaxf(mx[hh], s[hh]); } }
        float inv[4];
#pragma unroll
        for (int hh = 0; hh < 4; ++hh) { mx[hh] = wmaxf(mx[hh]); float sm = 0.f; for (int i = lane; i < nw; i += 64) { const float e = __expf(sc[hh * 1024 + i] - mx[hh]); sc[hh * 1024 + i] = e; sm += e; } sm = wsum(sm); inv[hh] = 1.f / sm; }
        __builtin_amdgcn_wave_barrier();
        for (int i = 0; i < nw; ++i) { const float v = kv.v_win(lo + i, lane);
#pragma unroll
            for (int hh = 0; hh < 4; ++hh) ow[hh] += sc[hh * 1024 + i] * v; }
#pragma unroll
        for (int hh = 0; hh < 4; ++hh) ow[hh] *= inv[hh];
        __builtin_amdgcn_wave_barrier();
    }
#pragma unroll
    for (int hh = 0; hh < 4; ++hh) o[hh] = gates[hh * 3] * oc[hh] + gates[hh * 3 + 1] * os[hh] + gates[hh * 3 + 2] * ow[hh];
}

template <class LF, class SF>
DI void tr64(LAS unsigned char* lds, LF lf, SF sf) {
    LAS float* T = (LAS float*)lds;
    const int tid = ltid();
    __syncthreads();
#pragma unroll
    for (int e8 = 0; e8 < 8; ++e8) { const int e = tid + 512 * e8, kk = e >> 6, nn = e & 63; T[kk * 65 + nn] = lf(kk, nn); }
    __syncthreads();
#pragma unroll
    for (int e8 = 0; e8 < 8; ++e8) { const int e = tid + 512 * e8, nn = e >> 6, kk = e & 63; sf(nn, kk, (f16)T[kk * 65 + nn]); }
}

typedef const Args __attribute__((address_space(4)))* ArgP;
struct Ctx { ArgP ap; LAS unsigned char* lds; unsigned char* ws; float* out; int tid, lane, wave, bid, G; };
DI Ctx mkctx(LAS unsigned char* lds) {
    Ctx c; const char __attribute__((address_space(4)))* kp = (const char __attribute__((address_space(4)))*)__builtin_amdgcn_kernarg_segment_ptr();
    asm volatile("" : "+s"(kp));
    c.ap = (ArgP)kp; c.lds = lds; c.ws = c.ap->ws; c.out = c.ap->out;
    int tid = threadIdx.x; asm volatile("" : "+v"(tid));
    c.tid = tid; c.lane = tid & 63; c.wave = __builtin_amdgcn_readfirstlane(tid >> 6); c.bid = blockIdx.x; c.G = gridDim.x;
    return c;
}
#define INP(i) ((const float*)c.ap->in[i])
#define WSF(off) ((float*)(c.ws + (off)))
#define WSH(off) ((f16*)(c.ws + (off)))

DI void ph_prologue(LAS unsigned char* lds_) {
    const Ctx c = mkctx(lds_); LAS unsigned char* lds = c.lds; const int tid = c.tid, bid = c.bid, G = c.G;
    const float* c_p = INP(I_CP); const float* c_s = INP(I_CS); const float* w_ada = INP(I_WADA); const float* b_ada = INP(I_BADA);
    const float* w_in = INP(I_WIN); const float* w_out = INP(I_WOUT); const float* w1 = INP(I_W1);
    float* ADA = WSF(WS_ADA); float* BIAS = WSF(WS_BIAS); float* PEB = WSF(WS_PEB); f16* WTIN = WSH(WS_WTIN); f16* WTOUT = WSH(WS_WTOUT); f16* W1T = WSH(WS_W1T);
    constexpr int N_ADA = 96, N_WTIN = 1920, N_WTOUT = 512, N_W1T = 256, N_PEB = 32, N_W2T = 8, N_ALL = N_ADA + N_WTIN + N_WTOUT + N_W1T + N_PEB + N_W2T + 1;
    constexpr int XA = 1;
    const bool reb = G == 256; const int n_mine = reb ? (bid < N_ADA ? 1 + XA : (N_ALL - N_ADA - XA * N_ADA - (bid - N_ADA) + 159) / 160) : (N_ALL - bid + G - 1) / G;
    for (int k = 0; k < n_mine; ++k) {
        const int it = !reb ? bid + k * G : (bid < N_ADA ? (k == 0 ? bid : N_ADA + XA * bid + (k - 1)) : N_ADA + XA * N_ADA + (bid - N_ADA) + 160 * k);
        int i = it;
        if (i < N_ADA) { const int l = i / 48, n0 = (i % 48) * 64;
            skinny_item<36>(lds, w_ada + (size_t)l * 1024 * 3072, 3072, n0, 64, 33,
                [&](int m, int k) { return siluf_(m < 32 ? c_s[m * 1024 + k] : c_p[k]); },
                [&](int m, int n, float v) { ADA[((size_t)l * 33 + m) * 3072 + n] = v + b_ada[l * 3072 + n]; });
            continue; }
        i -= N_ADA;
        if (i < N_WTIN) { const int l = i / 960, r = i % 960, n0 = (r / 16) * 64, k0 = (r % 16) * 64; const float* src = w_in + (size_t)l * 1024 * DIN; f16* dst = WTIN + (size_t)l * NPD * 1024;
            tr64(lds, [&](int kk, int nn) { const int sc = src_col(n0 + nn); return sc >= 0 ? src[(size_t)(k0 + kk) * DIN + sc] : 0.f; },
                      [&](int nn, int kk, f16 v) { dst[(size_t)(n0 + nn) * 1024 + k0 + kk] = v; });
            continue; }
        i -= N_WTIN;
        if (i < N_WTOUT) { const int l = i / 256, r = i % 256, n0 = (r / 16) * 64, k0 = (r % 16) * 64; const float* src = w_out + (size_t)l * 1024 * 1024; f16* dst = WTOUT + (size_t)l * 1024 * 1024;
            tr64(lds, [&](int kk, int nn) { return src[(size_t)(k0 + kk) * 1024 + n0 + nn]; },
                      [&](int nn, int kk, f16 v) { dst[(size_t)(n0 + nn) * 1024 + k0 + kk] = v; });
            continue; }
        i -= N_WTOUT;
        if (i < N_W1T) { const int ls = i / 64, r = i % 64, k0 = (r / 2) * 64, n0 = (r % 2) * 64; const float* src = w1 + (size_t)ls * 2048 * 128; f16* dst = W1T + (size_t)ls * 128 * 2048;
            tr64(lds, [&](int kk, int nn) { return src[(size_t)(k0 + kk) * 128 + n0 + nn]; },
                      [&](int nn, int kk, f16 v) { dst[(size_t)(n0 + nn) * 2048 + k0 + kk] = v; });
            continue; }
        i -= N_W1T;
        if (i < N_PEB) { const int ls = i >> 3, ks8 = i & 7; const float* pe = INP(I_PE) + (size_t)ls * 2048 + ks8 * 256; const float* w = w1 + ((size_t)ls * 2048 + ks8 * 256) * 128; const float* b1 = INP(I_B1) + ls * 128;
            LAS float* R = (LAS float*)lds; const int f = tid & 127, kq = tid >> 7; float sacc = 0.f;
            __syncthreads();
#pragma unroll 16
            for (int k = kq * 64; k < kq * 64 + 64; ++k) sacc += pe[k] * w[(size_t)k * 128 + f];
            R[kq * 128 + f] = sacc; __syncthreads();
            if (tid < 128) WSF(WS_PEBP)[(ls * 8 + ks8) * 128 + tid] = (ks8 == 0 ? b1[tid] : 0.f) + (R[tid] + R[128 + tid]) + (R[256 + tid] + R[384 + tid]);
            __syncthreads();
            continue; }
        i -= N_PEB;
        if (i < N_W2T) { const int ls = i >> 1, f0 = (i & 1) * 64; const float* src = INP(I_W2) + (size_t)ls * 128 * 64; f16* dst = WSH(WS_W2T) + (size_t)ls * 64 * 128;
            tr64(lds, [&](int kk, int nn) { return src[(size_t)(f0 + kk) * 64 + nn]; },
                      [&](int nn, int kk, f16 v) { dst[(size_t)nn * 128 + f0 + kk] = v; });
            continue; }
        for (int e = tid; e < 2 * NPD; e += 512) BIAS[e] = 0.f;
    }
}

DI void ph_sample_compress(LAS unsigned char* lds_) {
    const Ctx c = mkctx(lds_);
    const float* w2 = INP(I_W2); const float* b2 = INP(I_B2); const float* k_g = INP(I_KG); const float* cache_kv = INP(I_CKV); const int* page_table = (const int*)c.ap->in[I_PT];
    f16* W1T = WSH(WS_W1T); float* PEB = WSF(WS_PEBP); float* KCS = WSF(WS_KCS); float* VCS = WSF(WS_VCS);
    for (int it = c.bid; it < 1152; it += c.G) {
        const int grp = it < 1024 ? it & 7 : 8, st_ = it < 1024 ? it >> 3 : it - 1024, slot = st_ & 1, b = (st_ >> 1) & 31, l = st_ >> 6;
        const float* ckv = cache_kv + (size_t)l * NPOOL * 128 * 256; const int* pt = page_table + b * 128;
        compress_item<true>(c.lds, [&](int ch) { return (const void*)(ckv + ((size_t)pt[ch >> 3] * 128 + (ch & 7) * 16) * 256 + slot * 64); }, grp * 127,
                            W1T + (size_t)(l * 2 + slot) * 128 * 2048, PEB + (l * 2 + slot) * 1024, WSH(WS_W2T) + (size_t)(l * 2 + slot) * 64 * 128, b2 + (l * 2 + slot) * 64,
                            slot == 0 ? k_g + l * 192 : nullptr, (slot == 0 ? KCS : VCS) + (size_t)(l * NB + b) * 1024 * 64, nullptr, nullptr);
    }
}
DI void ph_prep(LAS unsigned char* lds_) {
    const Ctx c = mkctx(lds_); const int tid = c.tid, lane = c.lane, wave = c.wave, bid = c.bid, G = c.G;
    float* ADA = WSF(WS_ADA); float* BIAS = WSF(WS_BIAS);
    {
        const f16* WTIN = WSH(WS_WTIN);
        const bool lite = G == 256;
        const int pb = lite ? bid - 128 : bid, pG = lite ? 128 : G;
        if (pb >= 0)
        for (int col0 = pb * 8 + wave; col0 < 2 * NPD; col0 += pG * 32) {
            f16x8 w[4][2]; f32x4 sv[4][4];
#pragma unroll
            for (int k = 0; k < 4; ++k) { int col = col0 + k * pG * 8; col = col < 2 * NPD ? col : 2 * NPD - 1; const int l = col / NPD;
                const float* sh = ADA + ((size_t)l * 33 + 32) * 3072 + lane * 16; const f16* wp = WTIN + (size_t)col * 1024 + lane * 16;
                w[k][0] = ld_h8(wp); w[k][1] = ld_h8(wp + 8);
#pragma unroll
                for (int i = 0; i < 4; ++i) sv[k][i] = *(const f32x4*)(sh + 4 * i); }
#pragma unroll
            for (int k = 0; k < 4; ++k) { const int col = col0 + k * pG * 8; float acc = 0.f;
#pragma unroll
                for (int i = 0; i < 8; ++i) acc += sv[k][i >> 2][i & 3] * (float)w[k][0][i] + sv[k][2 + (i >> 2)][i & 3] * (float)w[k][1][i];
                acc = wsum(acc); if (lane == 0 && col < 2 * NPD) BIAS[col] = acc; } }
    }
    const float* ng = INP(I_NG);
    if (bid == 0) { float* GNX = WSF(WS_GNX); const float* sc1 = ADA + (size_t)(33 + 32) * 3072 + 1024;
        for (int k = tid; k < 1024; k += 512) GNX[k] = ng[1024 + k] * (1.f + sc1[k]); }
    const float* ada_p = ADA + (size_t)32 * 3072; const float* x_p = INP(I_XP); f16* A16 = WSH(WS_A16); float* RSSP = WSF(WS_RSSP);
    float gp[16];
#pragma unroll
    for (int i = 0; i < 4; ++i) { const f32x4 g4 = *(const f32x4*)(ng + i * 256 + lane * 4), s4 = *(const f32x4*)(ada_p + 1024 + i * 256 + lane * 4);
#pragma unroll
        for (int j = 0; j < 4; ++j) gp[i * 4 + j] = g4[j] * (1.f + s4[j]); }
    const bool lite2 = G == 256; const int pb2 = lite2 ? bid - 128 : bid, pG2 = lite2 ? 128 : G;
    if (pb2 >= 0)
    for (int row0 = pb2 * 8 + wave; row0 < SEQ; row0 += pG2 * 32) {
        f32x4 v[4][4];
#pragma unroll
        for (int k = 0; k < 4; ++k) { int row = row0 + k * pG2 * 8; row = row < SEQ ? row : SEQ - 1;
#pragma unroll
            for (int i = 0; i < 4; ++i) v[k][i] = *(const f32x4*)(x_p + (size_t)row * 1024 + i * 256 + lane * 4); }
#pragma unroll
        for (int k = 0; k < 4; ++k) { const int row = row0 + k * pG2 * 8; float ss = 0.f;
            if (row < SEQ) {
#pragma unroll
                for (int i = 0; i < 4; ++i) { const f32x4 u = v[k][i]; ss += (u[0] * u[0] + u[1] * u[1]) + (u[2] * u[2] + u[3] * u[3]);
                    f16x4 h; h[0] = (f16)(u[0] * gp[i * 4]); h[1] = (f16)(u[1] * gp[i * 4 + 1]); h[2] = (f16)(u[2] * gp[i * 4 + 2]); h[3] = (f16)(u[3] * gp[i * 4 + 3]);
                    *(f16x4*)(A16 + (size_t)row * 1024 + i * 256 + lane * 4) = h; }
                ss = wsum(ss);
                if (lane < 16) RSSP[(size_t)row * 16 + lane] = lane == 0 ? ss : 0.f; } }
    }
}

template <int NT  , class OFn>
DI void sample_gemm_item(LAS unsigned char* lds, const f16* Bt, int n0, OFn ofn) {
    constexpr int KW = 8 / NT, KL = 1024 / KW;
    const int tid = ltid(), wave = tid >> 6, lane = tid & 63, wn = wave % NT, wk = wave / NT, r = lane & 31, h = lane >> 5;
    const LAS f16* Ah = (const LAS f16*)lds + r * 1032 + wk * KL + 8 * h; const f16* bp = Bt + (size_t)(n0 + 32 * wn + r) * 1024 + wk * KL + 8 * h;
    f32x16 acc;
#pragma unroll
    for (int i = 0; i < 16; ++i) acc[i] = 0.f;
#pragma unroll 8
    for (int st = 0; st < KL / 16; ++st) acc = __builtin_amdgcn_mfma_f32_32x32x16_f16(*(const LAS f16x8*)(Ah + 16 * st), ld_h8(bp + 16 * st), acc, 0, 0, 0);
    LAS float* RED = (LAS float*)(lds + 67584);
#pragma unroll
    for (int i = 0; i < 16; ++i) RED[(wk * 32 + (i & 3) + 8 * (i >> 2) + 4 * h) * (32 * NT) + 32 * wn + r] = acc[i];
    __syncthreads();
    for (int e = tid; e < 1024 * NT; e += 512) { float v = 0.f;
#pragma unroll
        for (int w = 0; w < KW; ++w) v += RED[w * 1024 * NT + e];
        ofn(e / (32 * NT), n0 + e % (32 * NT), v); }
    __syncthreads();
}
DI void ph_inproj(LAS unsigned char* lds_, int l) {
    const Ctx c = mkctx(lds_);
    pg8::Gemm g{WSH(WS_A16), WSH(WS_WTIN) + (size_t)l * NPD * 1024, SEQ, NPD, 1024}; pg8::StaticOrder S; S.init(SEQ, NPD, c.G, c.bid);
    EpiIn E{WSH(WS_PROJ), WSF(WS_RSSP), WSF(WS_BIAS) + l * NPD, c.out + O_KVP + (size_t)l * SEQ * 256};
    pg8::gemm_phase<EpiIn, pg8::StaticOrder>(c.lds, g, S, E);
    __syncthreads();
}
DI void ph_hsample(LAS unsigned char* lds_, int l) {
    const Ctx c = mkctx(lds_); const int lane = c.lane;
    if (c.bid >= 4) return;
    const int m = c.bid * 8 + c.wave;
    const float* xr = (l == 0 ? INP(I_XS) : WSF(WS_XS1)) + (size_t)m * 1024; const float* ad = WSF(WS_ADA) + ((size_t)l * 33 + m) * 3072; const float* ng = INP(I_NG) + l * 1024; f16* hs = WSH(WS_HS16) + (size_t)m * 1024;
    f32x4 xv[4]; float ss = 0.f;
#pragma unroll
    for (int i = 0; i < 4; ++i) { xv[i] = *(const f32x4*)(xr + i * 256 + lane * 4); ss += (xv[i][0] * xv[i][0] + xv[i][1] * xv[i][1]) + (xv[i][2] * xv[i][2] + xv[i][3] * xv[i][3]); }
    const float rn = rsqrtf(wsum(ss) * (1.f / 1024.f) + EPS);
#pragma unroll
    for (int i = 0; i < 4; ++i) { const int k = i * 256 + lane * 4; const f32x4 g = *(const f32x4*)(ng + k), sc = *(const f32x4*)(ad + 1024 + k), sh = *(const f32x4*)(ad + k); f16x4 hv;
#pragma unroll
        for (int j = 0; j < 4; ++j) hv[j] = (f16)(xv[i][j] * rn * g[j] * (1.f + sc[j]) + sh[j]);
        *(f16x4*)(hs + k) = hv; }
}
DI void ph_inproj_sample(LAS unsigned char* lds_, int l) {
    const Ctx c = mkctx(lds_); const int tid = c.tid;
    const int it = c.bid - (c.G - 64);
    if (it < 0 || it >= 60) return;
    float* PROJS = WSF(WS_PROJS); const f16* HS = WSH(WS_HS16); LAS f16* Ah = (LAS f16*)c.lds;
    __syncthreads();
#pragma unroll
    for (int i = 0; i < 8; ++i) { const int e = (tid + 512 * i) * 8; *(LAS f16x8*)(Ah + (e >> 10) * 1032 + (e & 1023)) = ld_h8(HS + e); }
    __syncthreads();
    sample_gemm_item<2>(c.lds, WSH(WS_WTIN) + (size_t)l * NPD * 1024, it * 64, [&](int m, int n, float v) { PROJS[m * NPD + n] = v; });
}

#define PT(t) (P + (size_t)(t) * SEQ * 256)
DI void ph_ssd_local(LAS unsigned char* lds_, int l) {
    const Ctx c = mkctx(lds_); LAS unsigned char* lds = c.lds; const int tid = c.tid, lane = c.lane, wave = c.wave;
    const f16* P = WSH(WS_PROJ); f16* ACT = WSH(WS_ACT); float* YD = WSF(WS_YD); float* CST = WSF(WS_CST); float* ACS = WSF(WS_ACS); float* CDEC = WSF(WS_CDEC); float* out = c.out;
    const float* dtb = INP(I_DTB) + l * 4; const float* alog = INP(I_ALOG) + l * 4; const float* cw = INP(I_BCW) + l * 4 * 768; const float* cb = INP(I_BCB) + l * 768;
    LAS f16* Bm = (LAS f16*)lds; LAS f16* BT = (LAS f16*)(lds + 34816); LAS f16* Cm = (LAS f16*)(lds + 69632); LAS f16* XT = (LAS f16*)(lds + 104448);
    LAS float* acs = (LAS float*)(lds + 139264); LAS float* dtl = acs + 256; LAS f16* te16 = (LAS f16*)(dtl + 256);
    for (int it = c.bid; it < 256; it += c.G) {
        const int ch_ = it >> 1, g = it & 1, t0 = ch_ * 128;
        __syncthreads();
        if (tid < 256) { const int hh = tid >> 7, lt = tid & 127, hd = 2 * g + hh; const float raw = (float)PT(13)[(size_t)(t0 + lt) * 256 + 128 + hd];
            const float dt = softplusf_(raw + dtb[hd]); dtl[hh * 128 + lt] = dt; acs[hh * 128 + lt] = dt * (-__expf(alog[hd])); }
        __syncthreads();
        if (tid == 0 || tid == 64) { const int hh = tid >> 6; float sacc = 0.f; for (int i = 0; i < 128; ++i) { sacc += acs[hh * 128 + i]; acs[hh * 128 + i] = sacc; } }
        __syncthreads();
        if (tid < 256) { const int hh = tid >> 7, lt = tid & 127, hd = 2 * g + hh; const float av = acs[hh * 128 + lt], ae = acs[hh * 128 + 127];
            te16[hh * 128 + lt] = (f16)__expf(ae - av); ACS[(size_t)(t0 + lt) * 4 + hd] = av; if (lt == 127) CDEC[ch_ * 4 + hd] = __expf(ae); }
#pragma unroll 3
        for (int e = tid; e < 128 * 48; e += 512) {
            const int lt = (e >> 2) & 127, cg = (e >> 9) * 4 + (e & 3), reg = cg >> 4, c8 = (cg & 15) * 8, t = t0 + lt, col = 128 * g + c8, ch = reg * 256 + col;
            const f16* src = PT(5 + reg) + col; float y[8]; f16x8 rawt;
#pragma unroll
            for (int i = 0; i < 8; ++i) y[i] = cb[ch + i];
#pragma unroll
            for (int k = 0; k < 4; ++k) { const int tt = t - 3 + k; f16x8 v; if (tt >= 0) v = ld_h8(src + (size_t)tt * 256); else {
#pragma unroll
                    for (int i = 0; i < 8; ++i) v[i] = (f16)0.f; }
                if (k == 3) rawt = v;
#pragma unroll
                for (int i = 0; i < 8; ++i) y[i] += cw[k * 768 + ch + i] * (float)v[i]; }
            f16x8 act;
#pragma unroll
            for (int i = 0; i < 8; ++i) { y[i] = siluf_(y[i]); act[i] = (f16)y[i]; }
            *(f16x8*)(ACT + (size_t)t * 768 + ch) = act;
            if (reg == 0) { const int hh = c8 >> 6; const float sdt = dtl[hh * 128 + lt] * 64.f;
#pragma unroll
                for (int i = 0; i < 8; ++i) XT[(c8 + i) * 136 + lt] = (f16)(y[i] * sdt); }
            else if (reg == 1) { *(LAS f16x8*)(Bm + lt * 136 + c8) = act;
#pragma unroll
                for (int i = 0; i < 8; ++i) BT[(c8 + i) * 136 + lt] = act[i]; }
            else *(LAS f16x8*)(Cm + lt * 136 + c8) = act;
            if (t >= SEQ - 3) { float* so = out + O_BCP + (size_t)l * 2304 + (t - (SEQ - 3)) * 768 + ch;
#pragma unroll
                for (int i = 0; i < 8; ++i) so[i] = (float)rawt[i]; }
        }
        __syncthreads();
        const int fr = lane & 15, q = lane >> 4, w = wave;
        f32x4 gt[8];
#pragma unroll
        for (int mt = 0; mt < 8; ++mt) { gt[mt] = (f32x4){0.f, 0.f, 0.f, 0.f};
            if (mt <= w) {
#pragma unroll
                for (int ks = 0; ks < 4; ++ks) { const f16x8 av = *(const LAS f16x8*)(Bm + (16 * mt + fr) * 136 + 32 * ks + 8 * q), bv = *(const LAS f16x8*)(Cm + (16 * w + fr) * 136 + 32 * ks + 8 * q);
                    gt[mt] = __builtin_amdgcn_mfma_f32_16x16x32_f16(av, bv, gt[mt], 0, 0, 0); } } }
#pragma unroll
        for (int hh = 0; hh < 2; ++hh) {
            const int lrow = 16 * w + fr; const float al = acs[hh * 128 + lrow];
            f32x4 ya[4];
#pragma unroll
            for (int pt = 0; pt < 4; ++pt) ya[pt] = (f32x4){0.f, 0.f, 0.f, 0.f};
#pragma unroll
            for (int k2 = 0; k2 < 4; ++k2) {
                if (2 * k2 <= w) {
                    f16x8 af;
#pragma unroll
                    for (int j = 0; j < 8; ++j) { const int m = 32 * k2 + (j < 4 ? 4 * q + j : 16 + 4 * q + (j - 4)); const float gv = j < 4 ? gt[2 * k2][j] : gt[2 * k2 + 1][j - 4];
                        af[j] = (f16)(m <= lrow ? gv * __expf(al - acs[hh * 128 + m]) : 0.f); }
#pragma unroll
                    for (int pt = 0; pt < 4; ++pt) { const LAS f16* xp = XT + (hh * 64 + 16 * pt + fr) * 136 + 32 * k2 + 4 * q; const f16x4 b0 = *(const LAS f16x4*)xp, b1 = *(const LAS f16x4*)(xp + 16);
                        f16x8 bf; bf[0] = b0[0]; bf[1] = b0[1]; bf[2] = b0[2]; bf[3] = b0[3]; bf[4] = b1[0]; bf[5] = b1[1]; bf[6] = b1[2]; bf[7] = b1[3];
                        ya[pt] = __builtin_amdgcn_mfma_f32_16x16x32_f16(af, bf, ya[pt], 0, 0, 0); }
                }
            }
#pragma unroll
            for (int pt = 0; pt < 4; ++pt)
#pragma unroll
                for (int j = 0; j < 4; ++j) YD[(size_t)(t0 + 16 * w + 4 * q + j) * 256 + (2 * g + hh) * 64 + 16 * pt + fr] = ya[pt][j] * (1.f / 64.f);
#pragma unroll
            for (int pt = 0; pt < 4; ++pt) { f32x4 sa = (f32x4){0.f, 0.f, 0.f, 0.f};
#pragma unroll
                for (int ks = 0; ks < 4; ++ks) { const f16x8 xv = *(const LAS f16x8*)(XT + (hh * 64 + 16 * pt + fr) * 136 + 32 * ks + 8 * q), tv = *(const LAS f16x8*)(te16 + hh * 128 + 32 * ks + 8 * q);
                    const f16x8 bv = *(const LAS f16x8*)(BT + (16 * w + fr) * 136 + 32 * ks + 8 * q);
                    sa = __builtin_amdgcn_mfma_f32_16x16x32_f16(xv * tv, bv, sa, 0, 0, 0); }
#pragma unroll
                for (int j = 0; j < 4; ++j) CST[((size_t)(ch_ * 4 + 2 * g + hh) * 64 + 16 * pt + 4 * q + j) * 128 + 16 * w + fr] = sa[j] * (1.f / 64.f); }
        }
    }
    __syncthreads();
}
DI void ph_mix_a(LAS unsigned char* lds_, int l) {
    const Ctx c = mkctx(lds_); const int tid = c.tid;
    const f16* P = WSH(WS_PROJ); f16* Y16 = WSH(WS_Y16); float* out = c.out; const float* scw = INP(I_SCW) + l * 768;
    for (int it = c.bid; it < 256; it += c.G) {
        for (int e = tid; e < 64 * 32; e += 512) { const int t = it * 64 + (e >> 5), c0 = (e & 31) * 8; float u[3][8];
#pragma unroll
            for (int k = 0; k < 3; ++k) { const int tt = t - 2 + k;
                if (tt >= 0) { const f16x8 h = ld_h8(PT(0) + (size_t)tt * 256 + c0), cc = ld_h8(PT(2) + (size_t)tt * 256 + c0);
#pragma unroll
                    for (int i = 0; i < 8; ++i) u[k][i] = (float)cc[i] * (float)h[i]; }
                else {
#pragma unroll
                    for (int i = 0; i < 8; ++i) u[k][i] = 0.f; } }
            const f16x8 bb = ld_h8(PT(1) + (size_t)t * 256 + c0), gg = ld_h8(PT(3) + (size_t)t * 256 + c0); f16x8 o;
#pragma unroll
            for (int i = 0; i < 8; ++i) { const float y = scw[c0 + i] * u[0][i] + scw[256 + c0 + i] * u[1][i] + scw[512 + c0 + i] * u[2][i]; o[i] = (f16)(siluf_((float)gg[i]) * (float)bb[i] * y); }
            *(f16x8*)(Y16 + (size_t)t * 1024 + c0) = o;
            if (t >= SEQ - 2) { float* so = out + O_SCP + (size_t)l * 512 + (t - (SEQ - 2)) * 256 + c0;
#pragma unroll
                for (int i = 0; i < 8; ++i) so[i] = u[2][i]; }
        }
    }
}
DI void ph_mix_c(LAS unsigned char* lds_, int l) {
    const Ctx c = mkctx(lds_); const int tid = c.tid, lane = c.lane, wave = c.wave;
    const f16* P = WSH(WS_PROJ); f16* Y16 = WSH(WS_Y16); float* out = c.out;
    const float* cfw = INP(I_CFW) + l * 31 * 256; const float* cfb = INP(I_CFB) + l * 256; const float* lng = INP(I_LNG) + l * 256; const float* lnb = INP(I_LNB) + l * 256;
    LAS float* GL = (LAS float*)c.lds;
    f32x4 wt[31];
#pragma unroll
    for (int k = 0; k < 31; ++k) wt[k] = *(const f32x4*)(cfw + k * 256 + lane * 4);
    const f32x4 bias4 = *(const f32x4*)(cfb + lane * 4), g4 = *(const f32x4*)(lng + lane * 4), b4 = *(const f32x4*)(lnb + lane * 4);
    for (int it = c.bid; it < 256; it += c.G) {
        __syncthreads();
        for (int e = tid; e < 94 * 32; e += 512) { const int rr = e >> 5, c0 = (e & 31) * 8, t = it * 64 - 30 + rr; f32x4 g0 = (f32x4){0.f, 0.f, 0.f, 0.f}, g1 = g0;
            if (t >= 0) { const f16x8 ga = ld_h8(PT(8) + (size_t)t * 256 + c0), gb = ld_h8(PT(9) + (size_t)t * 256 + c0);
#pragma unroll
                for (int i = 0; i < 4; ++i) { g0[i] = (float)ga[i] * sigmoidf_((float)gb[i]); g1[i] = (float)ga[4 + i] * sigmoidf_((float)gb[4 + i]); }
                if (t >= SEQ - 30) { float* so = out + O_CFP + (size_t)l * 7680 + (t - (SEQ - 30)) * 256 + c0; *(f32x4*)so = g0; *(f32x4*)(so + 4) = g1; } }
            *(LAS f32x4*)(GL + rr * 256 + c0) = g0; *(LAS f32x4*)(GL + rr * 256 + c0 + 4) = g1; }
        __syncthreads();
        {
            const int cc = lane * 4, tb = wave * 8;
            f32x4 u[8];
#pragma unroll
            for (int j = 0; j < 8; ++j) u[j] = bias4;
#pragma unroll
            for (int r = 0; r < 38; ++r) { const f32x4 gv = *(const LAS f32x4*)(GL + (tb + r) * 256 + cc);
#pragma unroll
                for (int j = 0; j < 8; ++j) if (r - j >= 0 && r - j <= 30) u[j] += wt[r - j] * gv; }
#pragma unroll
            for (int j = 0; j < 8; ++j) { const int t = it * 64 + tb + j;
                const float mean = wsum((u[j][0] + u[j][1]) + (u[j][2] + u[j][3])) * (1.f / 256.f); const f32x4 d = u[j] - mean;
                const float var = wsum((d[0] * d[0] + d[1] * d[1]) + (d[2] * d[2] + d[3] * d[3])) * (1.f / 256.f); const float rs = rsqrtf(var + EPS);
                const f16x4 cg = *(const f16x4*)(PT(10) + (size_t)t * 256 + cc); f16x4 o;
#pragma unroll
                for (int i = 0; i < 4; ++i) o[i] = (f16)(siluf_((float)cg[i]) * siluf_(d[i] * rs * g4[i] + b4[i]));
                *(f16x4*)(Y16 + (size_t)t * 1024 + 512 + cc) = o; }
        }
    }
    __syncthreads();
}
DI void ph_mix_d(LAS unsigned char* lds_, int l) {
    const Ctx c = mkctx(lds_); const int tid = c.tid, lane = c.lane, wave = c.wave;
    const f16* P = WSH(WS_PROJ); float* out = c.out; float* kvp_out = out + O_KVP + (size_t)l * SEQ * 256;
    f16* Q16 = WSH(WS_Q16); f16* KS16 = WSH(WS_KS16); f16* KW16 = WSH(WS_KW16); f16* VST16 = WSH(WS_VST16); f16* VWT16 = WSH(WS_VWT16); float* GATES = WSF(WS_GATES);
    const int d4 = (lane & 15) * 4, v4 = lane >> 4;
    const f32x4 qg = *(const f32x4*)(INP(I_QG) + l * 64 + d4), kg1 = *(const f32x4*)(INP(I_KG) + l * 192 + 64 + d4), kg2 = *(const f32x4*)(INP(I_KG) + l * 192 + 128 + d4);
    LAS f16* VSs = (LAS f16*)c.lds; LAS f16* VWs = VSs + 64 * 68;
    if (c.bid < 18 && c.G > 36) return;
    for (int it = c.bid - 18 >= 0 && c.G > 36 ? c.bid - 18 : c.bid; it < 256; it += (c.G > 36 ? c.G - 18 : c.G)) {
        __syncthreads();
        for (int vi = wave * 4 + v4; vi < 256; vi += 32) { const size_t off = (size_t)(it * 64) * 256 + (size_t)vi * 64 + d4; const f16x4 x = *(const f16x4*)(PT(11) + off);
            const float a0 = (float)x[0], a1 = (float)x[1], a2 = (float)x[2], a3 = (float)x[3]; const float rn = rsqrtf(sum16((a0 * a0 + a1 * a1) + (a2 * a2 + a3 * a3)) * (1.f / 64.f) + EPS);
            f16x4 y; y[0] = (f16)(a0 * rn * qg[0]); y[1] = (f16)(a1 * rn * qg[1]); y[2] = (f16)(a2 * rn * qg[2]); y[3] = (f16)(a3 * rn * qg[3]); *(f16x4*)(Q16 + off) = y; }
        for (int tl = wave * 4 + v4; tl < 64; tl += 32) { const int t = it * 64 + tl;
            { const f16x4 x = *(const f16x4*)(PT(12) + (size_t)t * 256 + 128 + d4), vv = *(const f16x4*)(PT(12) + (size_t)t * 256 + 192 + d4);
                const float a0 = (float)x[0], a1 = (float)x[1], a2 = (float)x[2], a3 = (float)x[3]; const float rn = rsqrtf(sum16((a0 * a0 + a1 * a1) + (a2 * a2 + a3 * a3)) * (1.f / 64.f) + EPS);
                const f32x4 kn = (f32x4){a0 * rn * kg1[0], a1 * rn * kg1[1], a2 * rn * kg1[2], a3 * rn * kg1[3]}; *(f32x4*)(kvp_out + (size_t)t * 256 + 128 + d4) = kn;
                f16x4 y; y[0] = (f16)kn[0]; y[1] = (f16)kn[1]; y[2] = (f16)kn[2]; y[3] = (f16)kn[3]; *(f16x4*)(KS16 + (size_t)t * 64 + d4) = y; *(LAS f16x4*)(VSs + tl * 68 + d4) = vv; }
            { const f16x4 x = *(const f16x4*)(PT(13) + (size_t)t * 256 + d4), vv = *(const f16x4*)(PT(13) + (size_t)t * 256 + 64 + d4);
                const float a0 = (float)x[0], a1 = (float)x[1], a2 = (float)x[2], a3 = (float)x[3]; const float rn = rsqrtf(sum16((a0 * a0 + a1 * a1) + (a2 * a2 + a3 * a3)) * (1.f / 64.f) + EPS);
                const f32x4 kn = (f32x4){a0 * rn * kg2[0], a1 * rn * kg2[1], a2 * rn * kg2[2], a3 * rn * kg2[3]};
                f16x4 y; y[0] = (f16)kn[0]; y[1] = (f16)kn[1]; y[2] = (f16)kn[2]; y[3] = (f16)kn[3]; *(f16x4*)(KW16 + (size_t)t * 64 + d4) = y; *(LAS f16x4*)(VWs + tl * 68 + d4) = vv;
                if (t >= SEQ - 512) { float* wo = out + O_WINP + (size_t)l * 512 * 128 + (size_t)(t - (SEQ - 512)) * 128; *(f32x4*)(wo + d4) = kn; *(f32x4*)(wo + 64 + d4) = (f32x4){(float)vv[0], (float)vv[1], (float)vv[2], (float)vv[3]}; } }
        }
        for (int e = tid; e < 64 * 12; e += 512) { const int tl = e / 12, gi = e % 12; GATES[(size_t)(it * 64 + tl) * 12 + gi] = sigmoidf_((float)PT(13)[(size_t)(it * 64 + tl) * 256 + 132 + gi]); }
        __syncthreads();
        { const int d = tid >> 3, k8 = (tid & 7) * 8; f16x8 a, b;
#pragma unroll
            for (int i = 0; i < 8; ++i) { const int key = vt_key(k8 + i); a[i] = VSs[key * 68 + d]; b[i] = VWs[key * 68 + d]; }
            *(f16x8*)(VST16 + (size_t)it * 4096 + d * 64 + k8) = a; *(f16x8*)(VWT16 + (size_t)it * 4096 + d * 64 + k8) = b; }
    }
    __syncthreads();
}
DI void ph_mix_cmp(LAS unsigned char* lds_, int l) {
    const Ctx c = mkctx(lds_);
    const f16* P = WSH(WS_PROJ); const float* w2 = INP(I_W2); const float* b2 = INP(I_B2); const float* k_g = INP(I_KG); f16* W1T = WSH(WS_W1T); float* PEB = WSF(WS_PEBP);
    for (int it = c.bid; it < 18; it += c.G) { const int slot = it / 9, grp = it % 9; const f16* src = PT(12) + slot * 64;
        compress_item<false>(c.lds, [&](int ch) { return (const void*)(src + (size_t)ch * 16 * 256); }, grp * 127,
                             W1T + (size_t)(l * 2 + slot) * 128 * 2048, PEB + (l * 2 + slot) * 1024, WSH(WS_W2T) + (size_t)(l * 2 + slot) * 64 * 128, b2 + (l * 2 + slot) * 64,
                             slot == 0 ? k_g + l * 192 : nullptr, nullptr, slot == 0 ? WSH(WS_KC16) : nullptr, slot == 0 ? nullptr : WSH(WS_VCT16)); }
}
#undef PT
template <int N>
DI void blk_reduce(LAS float* red, LAS float* bc, float (&v)[N], bool is_max, int wave, int lane) {
#pragma unroll
    for (int i = 0; i < N; ++i) v[i] = is_max ? wmaxf(v[i]) : wsum(v[i]);
    __syncthreads();
    if (lane == 0) {
#pragma unroll
        for (int i = 0; i < N; ++i) red[wave * 12 + i] = v[i]; }
    __syncthreads();
    if (wave == 0 && lane < N) { float r = red[lane]; for (int w = 1; w < 8; ++w) r = is_max ? fmaxf(r, red[w * 12 + lane]) : r + red[w * 12 + lane]; bc[lane] = r; }
    __syncthreads();
#pragma unroll
    for (int i = 0; i < N; ++i) v[i] = bc[i];
}
DI void nsa_sample_block(LAS float* wl, const float* KC, const float* VC, const SampleKV& kv, const LAS float* gsm, const float* dgp, float* ysd, int tid, int lane, int wave) {
    LAS float* sc = wl; LAS float* qs = wl + 10496; LAS float* PSL = qs + 256; LAS float* red = PSL + 1024; LAS float* bc = red + 96; LAS int* sel = (LAS int*)(bc + 16); LAS float* part = bc + 32;
    constexpr int NCV = 1023, CUR = PAST >> 6;
    float mv[8], sv[8];
#pragma unroll
    for (int i = 0; i < 8; ++i) mv[i] = -3e38f;
    for (int cidx = tid; cidx < NCV; cidx += 512) {
        asm volatile("" ::: "memory");
        float kr[64]; kv.ld64(KC + (size_t)cidx * 64, kr); float s4[4] = {0.f, 0.f, 0.f, 0.f};
#pragma unroll
        for (int d = 0; d < 64; ++d) { const f32x4 qv = *(const LAS f32x4*)(qs + d * 4); s4[0] += qv[0] * kr[d]; s4[1] += qv[1] * kr[d]; s4[2] += qv[2] * kr[d]; s4[3] += qv[3] * kr[d]; }
#pragma unroll
        for (int hh = 0; hh < 4; ++hh) { s4[hh] *= 0.125f; sc[hh * 2624 + cidx] = s4[hh]; mv[hh] = fmaxf(mv[hh], s4[hh]); }
    }
    for (int i = tid; i < 513; i += 512) {
        asm volatile("" ::: "memory");
        float kr[64]; kv.krow_win(PAST - 512 + i, kr); float s4[4] = {0.f, 0.f, 0.f, 0.f};
#pragma unroll
        for (int d = 0; d < 64; ++d) { const f32x4 qv = *(const LAS f32x4*)(qs + d * 4); s4[0] += qv[0] * kr[d]; s4[1] += qv[1] * kr[d]; s4[2] += qv[2] * kr[d]; s4[3] += qv[3] * kr[d]; }
#pragma unroll
        for (int hh = 0; hh < 4; ++hh) { s4[hh] *= 0.125f; sc[hh * 2624 + 2048 + i] = s4[hh]; mv[4 + hh] = fmaxf(mv[4 + hh], s4[hh]); }
    }
    blk_reduce<8>(red, bc, mv, true, wave, lane);
#pragma unroll
    for (int i = 0; i < 8; ++i) sv[i] = 0.f;
    for (int cidx = tid; cidx < NCV; cidx += 512) {
#pragma unroll
        for (int hh = 0; hh < 4; ++hh) { const float e = __expf(sc[hh * 2624 + cidx] - mv[hh]); sc[hh * 2624 + cidx] = e; sv[hh] += e; } }
    for (int i = tid; i < 513; i += 512) {
#pragma unroll
        for (int hh = 0; hh < 4; ++hh) { const float e = __expf(sc[hh * 2624 + 2048 + i] - mv[4 + hh]); sc[hh * 2624 + 2048 + i] = e; sv[4 + hh] += e; } }
    blk_reduce<8>(red, bc, sv, false, wave, lane);
    float invc[4], invw[4];
#pragma unroll
    for (int hh = 0; hh < 4; ++hh) { invc[hh] = 1.f / sv[hh]; invw[hh] = 1.f / sv[4 + hh]; }
    for (int cidx = tid; cidx < 1024; cidx += 512) PSL[cidx] = cidx < NCV ? (sc[cidx] * invc[0] + sc[2624 + cidx] * invc[1]) + (sc[2 * 2624 + cidx] * invc[2] + sc[3 * 2624 + cidx] * invc[3]) : 0.f;
    __syncthreads();
    if (wave == 0) {
        float scv[5];
#pragma unroll
        for (int i = 0; i < 5; ++i) { const int j = lane + 64 * i; float v = -3e38f;
            if (j <= CUR) { if (j == 0 || j == CUR || j == CUR - 1) v = 3e38f; else { float a = 0.f;
#pragma unroll
                    for (int o5 = -1; o5 < 4; ++o5) { const int cc = 4 * j + o5; if (cc >= 0 && cc < NCV) a += (o5 == -1 || o5 == 3) ? 0.5f * PSL[cc] : PSL[cc]; }
                    v = a; } }
            scv[i] = v; }
        for (int k = 0; k < 16; ++k) {
            float bv = scv[0]; int bi = lane;
#pragma unroll
            for (int i = 1; i < 5; ++i) if (scv[i] > bv) { bv = scv[i]; bi = lane + 64 * i; }
#pragma unroll
            for (int off = 32; off > 0; off >>= 1) { const float ov = __shfl_xor(bv, off); const int oi = __shfl_xor(bi, off); if (ov > bv || (ov == bv && oi < bi)) { bv = ov; bi = oi; } }
            if (lane == 0) sel[k] = bi;
#pragma unroll
            for (int i = 0; i < 5; ++i) if (lane + 64 * i == bi) scv[i] = -3e38f;
        }
    }
    __syncthreads();
    float ms[4], ss4[4];
#pragma unroll
    for (int i = 0; i < 4; ++i) ms[i] = -3e38f;
    for (int idx = tid; idx < 1024; idx += 512) {
        asm volatile("" ::: "memory");
        const int pos = sel[idx >> 6] * 64 + (idx & 63); float s4[4] = {-1e30f, -1e30f, -1e30f, -1e30f};
        if (pos <= PAST) { float kr[64]; kv.krow_sel(pos, kr); s4[0] = s4[1] = s4[2] = s4[3] = 0.f;
#pragma unroll
            for (int d = 0; d < 64; ++d) { const f32x4 qv = *(const LAS f32x4*)(qs + d * 4); s4[0] += qv[0] * kr[d]; s4[1] += qv[1] * kr[d]; s4[2] += qv[2] * kr[d]; s4[3] += qv[3] * kr[d]; }
#pragma unroll
            for (int hh = 0; hh < 4; ++hh) s4[hh] *= 0.125f; }
#pragma unroll
        for (int hh = 0; hh < 4; ++hh) { sc[hh * 2624 + 1024 + idx] = s4[hh]; ms[hh] = fmaxf(ms[hh], s4[hh]); }
    }
    blk_reduce<4>(red, bc, ms, true, wave, lane);
#pragma unroll
    for (int i = 0; i < 4; ++i) ss4[i] = 0.f;
    for (int idx = tid; idx < 1024; idx += 512) {
#pragma unroll
        for (int hh = 0; hh < 4; ++hh) { const float x = sc[hh * 2624 + 1024 + idx]; const float e = x > -1e29f ? __expf(x - ms[hh]) : 0.f; sc[hh * 2624 + 1024 + idx] = e; ss4[hh] += e; } }
    blk_reduce<4>(red, bc, ss4, false, wave, lane);
    float invs[4];
#pragma unroll
    for (int hh = 0; hh < 4; ++hh) invs[hh] = 1.f / ss4[hh];
    float oc[4] = {0.f, 0.f, 0.f, 0.f}, os[4] = {0.f, 0.f, 0.f, 0.f}, ow[4] = {0.f, 0.f, 0.f, 0.f};
    { const int c1 = (wave + 1) * 128 < NCV ? (wave + 1) * 128 : NCV;
#pragma unroll 16
        for (int cidx = wave * 128; cidx < c1; ++cidx) { const float v = VC[(size_t)cidx * 64 + lane];
#pragma unroll
            for (int hh = 0; hh < 4; ++hh) oc[hh] += sc[hh * 2624 + cidx] * v; } }
    for (int kb = wave * 2; kb < wave * 2 + 2; ++kb) { const int p0 = sel[kb] * 64; int nk = PAST - p0 + 1; nk = nk > 64 ? 64 : nk;
        const float* vbase = p0 < PAST ? kv.prow(p0, 3) + lane : kv.nvs + lane;
#pragma unroll 16
        for (int kk = 0; kk < nk; ++kk) { const float v = vbase[(size_t)kk * 256];
#pragma unroll
            for (int hh = 0; hh < 4; ++hh) os[hh] += sc[hh * 2624 + 1024 + kb * 64 + kk] * v; } }
    { const int i1 = (wave + 1) * 65 < 513 ? (wave + 1) * 65 : 513;
#pragma unroll 13
        for (int i = wave * 65; i < i1; ++i) { const float v = kv.v_win(PAST - 512 + i, lane);
#pragma unroll
            for (int hh = 0; hh < 4; ++hh) ow[hh] += sc[hh * 2624 + 2048 + i] * v; } }
#pragma unroll
    for (int hh = 0; hh < 4; ++hh) { part[(wave * 12 + hh) * 64 + lane] = oc[hh] * invc[hh]; part[(wave * 12 + 4 + hh) * 64 + lane] = os[hh] * invs[hh]; part[(wave * 12 + 8 + hh) * 64 + lane] = ow[hh] * invw[hh]; }
    __syncthreads();
    if (tid < 256) { const int hh = tid >> 6, d = tid & 63; float a = 0.f, b = 0.f, cc = 0.f;
        for (int w = 0; w < 8; ++w) { a += part[(w * 12 + hh) * 64 + d]; b += part[(w * 12 + 4 + hh) * 64 + d]; cc += part[(w * 12 + 8 + hh) * 64 + d]; }
        ysd[tid] = siluf_(dgp[tid]) * (gsm[hh * 3] * a + gsm[hh * 3 + 1] * b + gsm[hh * 3 + 2] * cc); }
}
DI void ph_mix_sample(LAS unsigned char* lds_, int l) {
    const Ctx c = mkctx(lds_); const int tid = c.tid, lane = c.lane, wave = c.wave;
    const int b = c.bid - (c.G - 32);
    if (b < 0 || b >= 32) return;
    float* out = c.out;
    __syncthreads();
    const float* pr = WSF(WS_PROJS) + (size_t)b * NPD;
    LAS float* act = (LAS float*)c.lds;
    LAS float* red = act + 768;
    LAS float* ybl = red + 16;
    LAS float* sdt = ybl + 256;
    LAS float* nrow = sdt + 8;
    LAS float* gsm = nrow + 256;
    LAS float* wl = gsm + 16;
    float* ys = WSF(WS_YS) + (size_t)b * 1024;
    if (tid < 256) { const int ch = tid; const float* st = INP(I_SSC) + ((size_t)(l * NB + b) * 2) * 256; const float* scw = INP(I_SCW) + l * 768;
        const float u = pr[512 + ch] * pr[ch], p0 = st[ch], p1 = st[256 + ch]; const float y = scw[ch] * p0 + scw[256 + ch] * p1 + scw[512 + ch] * u;
        ys[ch] = siluf_(pr[768 + ch]) * pr[256 + ch] * y; float* so = out + O_SCS + ((size_t)(l * NB + b) * 2) * 256; so[ch] = p1; so[256 + ch] = u; }
    float uc = 0.f;
    if (tid >= 256) { const int ch = tid - 256; const float* st = INP(I_SCF) + (size_t)(l * NB + b) * 7680; const float* cfw = INP(I_CFW) + l * 31 * 256;
        const float glu = pr[2048 + ch] * sigmoidf_(pr[2304 + ch]); float u = INP(I_CFB)[l * 256 + ch]; float* so = out + O_CFS + (size_t)(l * NB + b) * 7680;
        for (int k = 0; k < 30; ++k) { const float pv = st[k * 256 + ch]; u += cfw[k * 256 + ch] * pv; if (k > 0) so[(k - 1) * 256 + ch] = pv; }
        u += cfw[30 * 256 + ch] * glu; so[29 * 256 + ch] = glu; uc = u; }
    { const float s1 = wsum(tid >= 256 ? uc : 0.f); if (lane == 0) red[wave] = s1; }
    __syncthreads();
    const float cmean = (red[4] + red[5] + red[6] + red[7]) * (1.f / 256.f);
    __syncthreads();
    { const float d = uc - cmean; const float s2 = wsum(tid >= 256 ? d * d : 0.f); if (lane == 0) red[wave] = s2; }
    __syncthreads();
    if (tid >= 256) { const int ch = tid - 256; const float var = (red[4] + red[5] + red[6] + red[7]) * (1.f / 256.f);
        const float ln = (uc - cmean) * rsqrtf(var + EPS) * INP(I_LNG)[l * 256 + ch] + INP(I_LNB)[l * 256 + ch];
        ys[512 + ch] = siluf_(pr[2560 + ch]) * siluf_(ln); }
    { const float* st = INP(I_SBC) + (size_t)(l * NB + b) * 2304; const float* cw = INP(I_BCW) + l * 4 * 768; const float* cb = INP(I_BCB) + l * 768; float* so = out + O_BCS + (size_t)(l * NB + b) * 2304;
        for (int ch = tid; ch < 768; ch += 512) { const float raw = pr[1280 + ch], p0 = st[ch], p1 = st[768 + ch], p2 = st[1536 + ch];
            act[ch] = siluf_(cb[ch] + cw[ch] * p0 + cw[768 + ch] * p1 + cw[1536 + ch] * p2 + cw[2304 + ch] * raw); so[ch] = p1; so[768 + ch] = p2; so[1536 + ch] = raw; }
        if (tid < 4) { const float dt = softplusf_(pr[3456 + tid] + INP(I_DTB)[l * 4 + tid]); sdt[tid] = dt; sdt[4 + tid] = __expf(dt * (-__expf(INP(I_ALOG)[l * 4 + tid]))); } }
    __syncthreads();
    { const float* h0 = INP(I_SSM) + (size_t)(l * NB + b) * 32768; float* ho = out + O_HS + (size_t)(l * NB + b) * 32768; const float* Dp = INP(I_SD) + l * 4;
        for (int row = wave; row < 256; row += 8) { const int hd = row >> 6, gq = hd >> 1; const float dt = sdt[hd], dA = sdt[4 + hd], xv = act[row]; float y = 0.f;
#pragma unroll
            for (int s2 = 0; s2 < 2; ++s2) { const int sidx = lane + 64 * s2; const float hn = dA * h0[row * 128 + sidx] + dt * xv * act[256 + gq * 128 + sidx]; ho[row * 128 + sidx] = hn; y += hn * act[512 + gq * 128 + sidx]; }
            y = wsum(y);
            if (lane == 0) ybl[row] = (y + Dp[hd] * xv) * siluf_(pr[1024 + row]); } }
    __syncthreads();
    { const float v = tid < 256 ? ybl[tid] : 0.f; const float s2 = wsum(v * v); if (lane == 0) red[8 + wave] = s2; }
    __syncthreads();
    if (tid < 256) { const float ss = red[8] + red[9] + red[10] + red[11]; ys[256 + tid] = ybl[tid] * rsqrtf(ss * (1.f / 256.f) + EPS) * INP(I_SNG)[l * 256 + tid]; }
    const float* qg = INP(I_QG) + l * 64; const float* kg = INP(I_KG) + l * 192;
    LAS float* qs = wl + 10496;
    if (wave < 4) { const float v = pr[2816 + wave * 64 + lane]; const float ss = wsum(v * v); qs[lane * 4 + wave] = v * rsqrtf(ss * (1.f / 64.f) + EPS) * qg[lane]; }
    else if (wave == 4) { const float v = pr[3072 + 128 + lane]; const float ss = wsum(v * v); nrow[lane] = v * rsqrtf(ss * (1.f / 64.f) + EPS) * kg[64 + lane]; nrow[64 + lane] = pr[3072 + 192 + lane]; }
    else if (wave == 5) { const float v = pr[3072 + 256 + lane]; const float ss = wsum(v * v); nrow[128 + lane] = v * rsqrtf(ss * (1.f / 64.f) + EPS) * kg[128 + lane]; nrow[192 + lane] = pr[3072 + 320 + lane]; }
    else if (wave == 6) { if (lane < 12) gsm[lane] = sigmoidf_(pr[3460 + lane]); }
    __syncthreads();
    const float* cache_win = INP(I_CWIN) + (size_t)(l * NB + b) * 512 * 128;
    { float* ko = out + O_KVS + (size_t)(l * NB + b) * 256;
        if (tid < 128) ko[tid] = pr[3072 + tid]; else if (tid < 192) ko[tid] = nrow[tid - 128]; else if (tid < 256) ko[tid] = nrow[64 + tid - 192];
        float* wo = out + O_WINS + (size_t)(l * NB + b) * 512 * 128;
        for (int e = tid; e < 511 * 128; e += 512) wo[e] = cache_win[128 + e];
        if (tid < 64) wo[511 * 128 + tid] = nrow[128 + tid]; else if (tid < 128) wo[511 * 128 + tid] = nrow[192 + tid - 64]; }
    float* nrp = WSF(WS_NRG) + (size_t)(l * NB + b) * 256;
    if (tid < 256) nrp[tid] = nrow[tid];
    asm volatile("s_waitcnt vmcnt(0)" ::: "memory");
    __syncthreads();
    {
        SampleKV kv{INP(I_CKV) + (size_t)l * NPOOL * 128 * 256, (const int*)c.ap->in[I_PT] + b * 128, cache_win, nrp, nrp + 64, nrp + 128, nrp + 192};
        nsa_sample_block(wl, WSF(WS_KCS) + (size_t)(l * NB + b) * 1024 * 64, WSF(WS_VCS) + (size_t)(l * NB + b) * 1024 * 64, kv, gsm, pr + 3584, ys + 768, tid, lane, wave);
    }
    edge_publish((unsigned*)(c.ws + WS_CTL + 18432) + l * 64);
    __syncthreads();
}
DI void ph_scan(LAS unsigned char* lds_, int l) {
    const Ctx c = mkctx(lds_);
    if (c.bid >= 64) return;
    const float* CST = WSF(WS_CST); float* HPV = WSF(WS_HPV); const float* CDEC = WSF(WS_CDEC);
    const int e = c.bid * 512 + c.tid, hd = e >> 13; float hc = 0.f;
#pragma unroll 8
    for (int ch = 0; ch < 128; ++ch) { const float sv = CST[(size_t)ch * 32768 + e]; HPV[(size_t)ch * 32768 + e] = hc; hc = CDEC[ch * 4 + hd] * hc + sv; }
    c.out[O_HP + (size_t)l * 32768 + e] = hc;
    edge_publish((unsigned*)(c.ws + WS_CTL + 17408) + l * 64);
}
DI f16x8 pack_p(const f32x4& a, const f32x4& b) { f16x8 r; r[0] = (f16)a[0]; r[1] = (f16)a[1]; r[2] = (f16)a[2]; r[3] = (f16)a[3]; r[4] = (f16)b[0]; r[5] = (f16)b[1]; r[6] = (f16)b[2]; r[7] = (f16)b[3]; return r; }
DI f16x8 ld_vt(const f16* p) { const f16x4 a = *(const f16x4*)p, b = *(const f16x4*)(p + 16); f16x8 r; r[0] = a[0]; r[1] = a[1]; r[2] = a[2]; r[3] = a[3]; r[4] = b[0]; r[5] = b[1]; r[6] = b[2]; r[7] = b[3]; return r; }
constexpr int NT_PSEL = 0  , NT_STG = 32768  , NT_STG_SZ = 18432 + 17408,
              NT_RING = 0  , NT_MASK = 131072  , NT_VB = NT_MASK + 1088  , NT_MT = NT_VB + 1088  , NT_END = NT_MT + 1088;
static_assert(NT_STG + 2 * NT_STG_SZ <= NT_MASK, "nsa tile LDS map");
static_assert(NT_END <= MISC_OFF, "nsa tile LDS map");
struct StgRegs { f16x8 k0, k1, v0, v1; };
template <bool WITH_V, class KSrc, class VSrc>
DI void stg_load(StgRegs& rg, int ch, int tid, const KSrc& ksrc, const VSrc& vsrc) {
    const f16* kp = ksrc(ch, tid >> 2) + (tid & 3) * 16; rg.k0 = ld_h8(kp); rg.k1 = ld_h8(kp + 8);
    if (WITH_V) { const f16* vp = vsrc(ch, tid >> 3, tid & 7); rg.v0 = ld_h8(vp); rg.v1 = ld_h8(vp + 8); }
}
template <bool WITH_V>
DI void stg_store(const StgRegs& rg, LAS unsigned char* buf, int tid) {
    LAS f16* kb = (LAS f16*)buf + (tid >> 2) * 72 + (tid & 3) * 16; *(LAS f16x8*)kb = rg.k0; *(LAS f16x8*)(kb + 8) = rg.k1;
    if (WITH_V) { LAS f16* vb = (LAS f16*)(buf + 18432) + (tid >> 3) * 136 + (tid & 7) * 16; *(LAS f16x8*)vb = rg.v0; *(LAS f16x8*)(vb + 8) = rg.v1; }
}
template <bool WITH_V, class KSrc, class VSrc, class Body>
DI void stream_chunks(LAS unsigned char* stg, int nchunk, int tid, const KSrc& ksrc, const VSrc& vsrc, Body body) {
    if (nchunk <= 0) return;
    const int last = nchunk - 1;
    StgRegs rg;
    stg_load<WITH_V>(rg, 0, tid, ksrc, vsrc);
    __syncthreads();
    stg_store<WITH_V>(rg, stg, tid); stg_load<WITH_V>(rg, 1 < last ? 1 : last, tid, ksrc, vsrc);
    lds_barrier();
#pragma nounroll
    for (int ch = 0; ch < nchunk; ++ch) {
        body(ch, stg + (ch & 1) * NT_STG_SZ);
        stg_store<WITH_V>(rg, stg + ((ch + 1) & 1) * NT_STG_SZ, tid); stg_load<WITH_V>(rg, ch + 2 < last ? ch + 2 : last, tid, ksrc, vsrc);
        lds_barrier();
    }
}
DI f16x8 lds_vt(const LAS f16* p) { return *(const LAS f16x8*)p; }
DI f32x4 qk_tile(const LAS f16* kb, int kt, int fr, int q, const f16x8 (&qf)[2]) {
    const LAS f16* kp = kb + (16 * kt + fr) * 72 + 8 * q; f32x4 sa = (f32x4){0.f, 0.f, 0.f, 0.f};
    sa = __builtin_amdgcn_mfma_f32_16x16x32_f16(*(const LAS f16x8*)kp, qf[0], sa, 0, 0, 0); return __builtin_amdgcn_mfma_f32_16x16x32_f16(*(const LAS f16x8*)(kp + 32), qf[1], sa, 0, 0, 0);
}
constexpr float NSA_L2E = 1.44269504f, NSA_C1 = 0.125f * NSA_L2E;
DI float ex2(float x) { return __builtin_amdgcn_exp2f(x); }
template <class Pred>
DI f16x8 pv_step(const LAS f16* kb, const LAS f16* vb, int st, int fr, int q, const f16x8 (&qf)[2], f32x4 (&o)[4], f32x4 (&e2)[2], float nb, bool masked, Pred pred) {
#pragma unroll
    for (int hf = 0; hf < 2; ++hf) { const f32x4 sa = qk_tile(kb, 2 * st + hf, fr, q, qf);
        if (!masked) {
#pragma unroll
            for (int j = 0; j < 4; ++j) e2[hf][j] = ex2(fmaf(sa[j], NSA_C1, nb)); }
        else {
#pragma unroll
            for (int j = 0; j < 4; ++j) e2[hf][j] = pred(32 * st + 16 * hf + 4 * q + j) ? ex2(fmaf(sa[j], NSA_C1, nb)) : 0.f; } }
    const f16x8 pb = pack_p(e2[0], e2[1]);
#pragma unroll
    for (int dt = 0; dt < 4; ++dt) o[dt] = __builtin_amdgcn_mfma_f32_16x16x32_f16(lds_vt(vb + (16 * dt + fr) * 136 + 32 * st + 8 * q), pb, o[dt], 0, 0, 0);
    return pb;
}
DI void nsa_tile(const Ctx& c, int tile, const f16* Q16, const f16* KC16, const f16* VCT16, const f16* KS16, const f16* VST16, const f16* KW16, const f16* VWT16,
                 const float* GATES, const f16* DG, f16* Y16, float shc, float shs, float shw) {
    LAS unsigned char* lds = c.lds; const int wave = c.wave; int tid, lane, fr, q, ti, h, trow;
    const int t0 = tile * 32, cur = t0 >> 6;
#define NSA_RELANE() do { int _t = c.tid; asm volatile("" : "+v"(_t)); tid = _t; lane = _t & 63; fr = lane & 15; q = lane >> 4; ti = fr >> 2; h = fr & 3; trow = t0 + 4 * wave + ti; } while (0)
#define NSA_REPS(bit) (((NSA_DUP >> (bit)) & 1) ? 2 : 1)
#define NSA_SCALE(rep) ({ float _z = (rep) == 0 ? 1.f : 0.f; asm volatile("" : "+v"(_z)); _z; })
    NSA_RELANE();
    LAS float* PSEL = (LAS float*)(lds + NT_PSEL); LAS unsigned* MASK = (LAS unsigned*)(lds + NT_MASK); LAS int* VB = (LAS int*)(lds + NT_VB); LAS unsigned char* STG = lds + NT_STG;
    __syncthreads();
    for (int i = tid; i < 272; i += 512) MASK[i] = (i == 0 || i == cur || i == cur - 1) ? 0xFFFFFFFFu : 0u;
    f16x8 qf[2];
#pragma unroll
    for (int ks = 0; ks < 2; ++ks) qf[ks] = ld_h8(Q16 + ((size_t)trow * 4 + h) * 64 + 32 * ks + 8 * q);
    const int nkt = ((t0 >> 4) + 1 + 15) >> 4;
    const int ncch = (nkt + 7) >> 3;
    const int nv_row = trow >= 31 ? ((trow - 31) >> 4) + 1 : 0;
    auto kc_src = [&](int ch, int row) { return KC16 + (size_t)(128 * ch + row) * 64; };
    auto vc_src = [&](int ch, int d, int seg) { return VCT16 + (size_t)d * 1024 + 128 * ch + seg * 16; };
    float lsum = 0.f;
    const float bc = -shc * NSA_L2E, bs = -shs * NSA_L2E, bw = -shw * NSA_L2E;
    const int tw0 = t0 + 4 * wave, nvmin_w = tw0 >= 31 ? ((tw0 - 31) >> 4) + 1 : 0;
    stream_chunks<false>(STG, ncch, tid, kc_src, vc_src, [&](int ch, LAS unsigned char* buf) {
        const LAS f16* kb = (const LAS f16*)buf; const int nk = nkt - 8 * ch < 8 ? nkt - 8 * ch : 8;
#pragma unroll 4
        for (int kt = 0; kt < nk; ++kt) { const f32x4 sa = qk_tile(kb, kt, fr, q, qf); const int cb = 128 * ch + 16 * kt + 4 * q;
            if (128 * ch + 16 * kt + 15 < nvmin_w) {
#pragma unroll
                for (int j = 0; j < 4; ++j) lsum += ex2(fmaf(sa[j], NSA_C1, bc)); }
            else {
#pragma unroll
                for (int j = 0; j < 4; ++j) lsum += (cb + j < nv_row) ? ex2(fmaf(sa[j], NSA_C1, bc)) : 0.f; } } });
    lsum += __shfl_xor(lsum, 16); lsum += __shfl_xor(lsum, 32);
    const float invc = lsum > 0.f ? 1.f / lsum : 0.f;
    NSA_RELANE();
    f32x4 oc[4];
#pragma unroll
    for (int dt = 0; dt < 4; ++dt) oc[dt] = (f32x4){0.f, 0.f, 0.f, 0.f};
    { float bprev = 0.f; const float pbias = invc > 0.f ? bc + __log2f(invc) : -1e30f;
    stream_chunks<true>(STG, ncch, tid, kc_src, vc_src, [&](int ch, LAS unsigned char* buf) {
        const LAS f16* kb = (const LAS f16*)buf; const LAS f16* vb = (const LAS f16*)(buf + 18432); const int ns = (nkt - 8 * ch + 1) >> 1 < 4 ? (nkt - 8 * ch + 1) >> 1 : 4;
#pragma unroll 2
        for (int s2 = 0; s2 < ns; ++s2) {
            f32x4 e2[2];
            pv_step(kb, vb, s2, fr, q, qf, oc, e2, pbias, 128 * ch + 32 * s2 + 31 >= nvmin_w, [&](int kc) { return 128 * ch + kc < nv_row; });
#pragma unroll
            for (int hf = 0; hf < 2; ++hf) {
                const int ktg = 8 * ch + 2 * s2 + hf;
                float av = (e2[hf][0] + e2[hf][1]) + (e2[hf][2] + 0.5f * e2[hf][3]), bv = 0.5f * e2[hf][3];
                av += dppf<DPP_X1>(av); av += dppf<DPP_X2>(av); bv += dppf<DPP_X1>(bv); bv += dppf<DPP_X2>(bv);
                const float up = __shfl(q == 3 ? bprev : bv, (lane + 48) & 63);
                bprev = bv;
                if (h == 0 && ktg < nkt) PSEL[(4 * wave + ti) * 256 + 4 * ktg + q] = av + up;
            }
        } }); }
    for (int rep = 0; rep < NSA_REPS(2); ++rep) {
        const int nforced = cur >= 2 ? 3 : cur + 1, nsel = ((cur + 1) < 16 ? (cur + 1) : 16) - nforced, tk = lane >> 4, l16 = lane & 15, tokl = 4 * wave + tk;
        float sv[16];
#pragma unroll
        for (int i = 0; i < 16; ++i) { const int j = l16 + 16 * i; float v = -3e38f;
            if (j <= cur && !(j == 0 || j == cur || j == cur - 1)) v = j < 4 * nkt ? PSEL[tokl * 256 + j] : 0.f;
            sv[i] = v; }
#pragma nounroll
        for (int k = 0; k < nsel; ++k) {
            float bv = sv[0]; int bi = l16;
#pragma unroll
            for (int i = 1; i < 16; ++i) if (sv[i] > bv) { bv = sv[i]; bi = l16 + 16 * i; }
#define TOPK_STEP(CT) do { const float ov = dppf<CT>(bv); const int oi = dppi<CT>(bi); if (ov > bv || (ov == bv && oi < bi)) { bv = ov; bi = oi; } } while (0)
            TOPK_STEP(DPP_X1); TOPK_STEP(DPP_X2); TOPK_STEP(DPP_HM); TOPK_STEP(DPP_R8);
#undef TOPK_STEP
            if (l16 == 0) __hip_atomic_fetch_or(&MASK[bi], 1u << tokl, __ATOMIC_RELAXED, __HIP_MEMORY_SCOPE_WORKGROUP);
#pragma unroll
            for (int i = 0; i < 16; ++i) if (l16 + 16 * i == bi) sv[i] = -3e38f;
        }
    }
    NSA_RELANE();
    f32x4 owr[4]; float lwr = 0.f;
#pragma unroll
    for (int dt = 0; dt < 4; ++dt) owr[dt] = (f32x4){0.f, 0.f, 0.f, 0.f};
    f16x8 onesf;
#pragma unroll
    for (int i = 0; i < 8; ++i) onesf[i] = fr == 0 ? (f16)1.f : (f16)0.f;
    f32x4 lw5 = (f32x4){0.f, 0.f, 0.f, 0.f};
    {
        const int wlo = t0 - 512 > 0 ? t0 - 512 : 0, nwch = (t0 + 32 - wlo + 127) >> 7;
        auto kw_src = [&](int ch, int row) { int p = wlo + 128 * ch + row; p = p < SEQ ? p : SEQ - 1; return KW16 + (size_t)p * 64; };
        auto vw_src = [&](int ch, int d, int seg) { const int key = wlo + 128 * ch + seg * 16; int blk = key >> 6; blk = blk < 256 ? blk : 255; return VWT16 + (size_t)blk * 4096 + d * 64 + (key & 63); };
        {
        stream_chunks<true>(STG, nwch, tid, kw_src, vw_src, [&](int ch, LAS unsigned char* buf) {
            const LAS f16* kb = (const LAS f16*)buf; const LAS f16* vb = (const LAS f16*)(buf + 18432); const int pbase = wlo + 128 * ch;
            const int ns = (t0 + 32 - pbase) >> 5 < 4 ? (t0 + 32 - pbase) >> 5 : 4;
#pragma unroll 2
            for (int s2 = 0; s2 < ns; ++s2) { f32x4 e2[2];
                const int p0s = pbase + 32 * s2; const bool masked = !(p0s >= tw0 + 3 - 512 && p0s + 31 <= tw0);
                const f16x8 pb = pv_step(kb, vb, s2, fr, q, qf, owr, e2, bw, masked, [&](int kc) { const int pos = pbase + kc; return pos <= trow && pos >= trow - 512; });
                lw5 = __builtin_amdgcn_mfma_f32_16x16x32_f16(onesf, pb, lw5, 0, 0, 0); } }); }
        lwr = lw5[0];
    }
    NSA_RELANE();
    LAS unsigned* MT = (LAS unsigned*)(lds + NT_MT);
    if (wave == 0) { int cnt = 0;
        for (int base = 0; base <= cur; base += 64) { const int jx = base + lane; const unsigned mj = jx <= cur ? MASK[jx] : 0u; const bool v = mj != 0u; const unsigned long long bal = __ballot(v);
            if (v) { const int pos = cnt + __popcll(bal & ((1ull << lane) - 1ull)); VB[pos] = jx; MT[pos] = mj; } cnt += __popcll(bal); }
        if (lane < 8) { VB[cnt + lane] = VB[cnt - 1]; MT[cnt + lane] = 0u; }
        if (lane == 0) VB[264] = cnt; }
    __syncthreads();
    if (VERIFY_NSA) { unsigned* SELM = (unsigned*)(c.ws + WS_SELM) + (size_t)tile * 272; for (int i = tid; i < 272; i += 512) SELM[i] = MASK[i]; }
    f32x4 osr[4]; float lsr = 0.f; f32x4 ls5 = (f32x4){0.f, 0.f, 0.f, 0.f};
#pragma unroll
    for (int dt = 0; dt < 4; ++dt) osr[dt] = (f32x4){0.f, 0.f, 0.f, 0.f};
#pragma unroll
    for (int i = 0; i < 8; ++i) onesf[i] = fr == 0 ? (f16)1.f : (f16)0.f;
    {
        const int nvb = __builtin_amdgcn_readfirstlane(VB[264]), nst = (nvb + 3) >> 2;
        const int dr = lane >> 3, dp = lane & 7, dsw = (dp ^ dr) * 8;
        LAS unsigned char* RING = lds + NT_RING;
        auto dma = [&](int n, int blk) { LAS unsigned char* slot = RING + (n & 7) * 16384 + wave * 1024;
            __builtin_amdgcn_global_load_lds((const unsigned*)(KS16 + ((size_t)blk * 64 + 8 * wave + dr) * 64 + dsw), (LAS unsigned*)slot, 16, 0, 0);
            __builtin_amdgcn_global_load_lds((const unsigned*)(VST16 + (size_t)blk * 4096 + (8 * wave + dr) * 64 + dsw), (LAS unsigned*)(slot + 8192), 16, 0, 0); };
        {
        asm volatile("s_waitcnt vmcnt(0)" ::: "memory"); __syncthreads();
        typedef int i32x4 __attribute__((ext_vector_type(4)));
#define RFL4(v) { __builtin_amdgcn_readfirstlane((v)[0]), __builtin_amdgcn_readfirstlane((v)[1]), __builtin_amdgcn_readfirstlane((v)[2]), __builtin_amdgcn_readfirstlane((v)[3]) }
        { const i32x4 b0 = *(const LAS i32x4*)VB; const int bb[4] = RFL4(b0); dma(0, bb[0]); dma(1, bb[1]); dma(2, bb[2]); dma(3, bb[3]); }
#pragma nounroll
        for (int st = 0; st < nst; ++st) {
            asm volatile("s_waitcnt vmcnt(0)\n\ts_barrier" ::: "memory");
            const i32x4 bcv = *(const LAS i32x4*)(VB + 4 * st), bnv = *(const LAS i32x4*)(VB + 4 * st + 4); const u32x4 mcv = *(const LAS u32x4*)(MT + 4 * st);
            const int bcur[4] = RFL4(bcv), bnxt[4] = RFL4(bnv); const int mcur[4] = RFL4(mcv);
            dma(4 * st + 4, bnxt[0]); dma(4 * st + 5, bnxt[1]); dma(4 * st + 6, bnxt[2]); dma(4 * st + 7, bnxt[3]);
#pragma unroll
            for (int i4 = 0; i4 < 4; ++i4) {
            const int n = 4 * st + i4;
            const int blk = bcur[i4]; const unsigned mt = ((unsigned)mcur[i4] >> (4 * wave)) & 15u;
            if (mt != 0u) {
                const bool rv = ((mt >> ti) & 1u) != 0u; const LAS unsigned char* ks = RING + (n & 7) * 16384; const LAS unsigned char* vs = ks + 8192; const int sx = fr & 7;
                f32x4 sa[4]; f16x8 va[2][4];
#pragma unroll
                for (int kt = 0; kt < 4; ++kt) { const LAS unsigned char* kp = ks + (16 * kt + fr) * 128; sa[kt] = (f32x4){0.f, 0.f, 0.f, 0.f};
                    sa[kt] = __builtin_amdgcn_mfma_f32_16x16x32_f16(*(const LAS f16x8*)(kp + ((q ^ sx) << 4)), qf[0], sa[kt], 0, 0, 0);
                    sa[kt] = __builtin_amdgcn_mfma_f32_16x16x32_f16(*(const LAS f16x8*)(kp + (((4 + q) ^ sx) << 4)), qf[1], sa[kt], 0, 0, 0); }
#pragma unroll
                for (int s2 = 0; s2 < 2; ++s2)
#pragma unroll
                    for (int dt = 0; dt < 4; ++dt) va[s2][dt] = *(const LAS f16x8*)(vs + (16 * dt + fr) * 128 + (((4 * s2 + q) ^ sx) << 4));
                const float nbu = rv ? bs : -1e30f;
                if (blk != cur) {
#pragma unroll
                    for (int kt = 0; kt < 4; ++kt)
#pragma unroll
                        for (int j = 0; j < 4; ++j) sa[kt][j] = ex2(fmaf(sa[kt][j], NSA_C1, nbu)); }
                else { const int pb0 = 64 * blk + 4 * q;
#pragma unroll
                    for (int kt = 0; kt < 4; ++kt)
#pragma unroll
                        for (int j = 0; j < 4; ++j) sa[kt][j] = (pb0 + 16 * kt + j <= trow) ? ex2(fmaf(sa[kt][j], NSA_C1, nbu)) : 0.f; }
                const f16x8 p0 = pack_p(sa[0], sa[1]), p1 = pack_p(sa[2], sa[3]);
#pragma unroll
                for (int dt = 0; dt < 4; ++dt) { osr[dt] = __builtin_amdgcn_mfma_f32_16x16x32_f16(va[0][dt], p0, osr[dt], 0, 0, 0); osr[dt] = __builtin_amdgcn_mfma_f32_16x16x32_f16(va[1][dt], p1, osr[dt], 0, 0, 0); }
                ls5 = __builtin_amdgcn_mfma_f32_16x16x32_f16(onesf, p0, ls5, 0, 0, 0); ls5 = __builtin_amdgcn_mfma_f32_16x16x32_f16(onesf, p1, ls5, 0, 0, 0);
            }
            }
        }
        asm volatile("s_waitcnt vmcnt(0)" ::: "memory"); }
        __syncthreads();
        lsr = ls5[0];
    }
    NSA_RELANE();
    lwr += __shfl_xor(lwr, 16); lwr += __shfl_xor(lwr, 32); lsr += __shfl_xor(lsr, 16); lsr += __shfl_xor(lsr, 32);
    {
        const float g0 = GATES[(size_t)trow * 12 + h * 3], ils = GATES[(size_t)trow * 12 + h * 3 + 1] / lsr, ilw = GATES[(size_t)trow * 12 + h * 3 + 2] / lwr;
#pragma unroll
        for (int dt = 0; dt < 4; ++dt) { const int d0 = 16 * dt + 4 * q; const f16x4 dg = *(const f16x4*)(DG + (size_t)trow * 256 + h * 64 + d0); f16x4 y;
#pragma unroll
            for (int jj = 0; jj < 4; ++jj) { const float o = g0 * oc[dt][jj] + ils * osr[dt][jj] + ilw * owr[dt][jj]; y[jj] = (f16)(siluf_((float)dg[jj]) * o); }
            *(f16x4*)(Y16 + (size_t)trow * 1024 + 768 + h * 64 + d0) = y; }
    }
#undef NSA_RELANE
}
DI void ph_ssd_fin(LAS unsigned char* lds_, int l, int it0, int it1, int itstep);
DI void ph_outproj_sample(LAS unsigned char* lds_, int l, int it);
DI void ph_nsa(LAS unsigned char* lds_, int l) {
    const Ctx c = mkctx(lds_); const int lane = c.lane;
    const float* qg = INP(I_QG) + l * 64; const float* kg = INP(I_KG) + l * 192;
    const float mq = wmaxf(fabsf(qg[lane])), mk0 = wmaxf(fabsf(kg[lane])), mk1 = wmaxf(fabsf(kg[64 + lane])), mk2 = wmaxf(fabsf(kg[128 + lane]));
    const float shc = 8.f * mq * mk0 - 8.f, shs = 8.f * mq * mk1 - 8.f, shw = 8.f * mq * mk2 - 8.f;
    unsigned* qctr = (unsigned*)(c.ws + WS_CTL + 16384) + l * 64; LAS int* qslot = (LAS int*)(c.lds + MISC_OFF + 64); bool fin_ok = false, smp_ok = false;
    for (;;) {
        __syncthreads();
        if (c.tid == 0) *qslot = (int)__hip_atomic_fetch_add(qctr, 1u, __ATOMIC_RELAXED, __HIP_MEMORY_SCOPE_AGENT);
        __syncthreads();
        const int u = __builtin_amdgcn_readfirstlane(*qslot);
        if (u >= 800) break;
        if (u < 512) nsa_tile(c, 511 - u, WSH(WS_Q16), WSH(WS_KC16), WSH(WS_VCT16), WSH(WS_KS16), WSH(WS_VST16), WSH(WS_KW16), WSH(WS_VWT16), WSF(WS_GATES), WSH(WS_PROJ) + (size_t)14 * SEQ * 256, WSH(WS_Y16), shc, shs, shw);
        else if (u < 768) { if (!fin_ok) { edge_wait((unsigned*)(c.ws + WS_CTL + 17408) + l * 64, 64u); fin_ok = true; } ph_ssd_fin(lds_, l, u - 512, u - 511, 1); }
        else { if (!smp_ok) { edge_wait((unsigned*)(c.ws + WS_CTL + 18432) + l * 64, 32u); smp_ok = true; } ph_outproj_sample(lds_, l, u - 768); }
    }
    __syncthreads();
}
DI void ph_nsa_verify(LAS unsigned char* lds_, int l) {
    const Ctx c = mkctx(lds_); const int lane = c.lane;
    LAS float* wl = (LAS float*)c.lds + c.wave * 4400; LAS float* sc = wl; LAS float* qs = wl + 4096; LAS unsigned* selb = (LAS unsigned*)(wl + 4352);
    const f16* Q16 = WSH(WS_Q16); const f16* KC16 = WSH(WS_KC16); const f16* VCT16 = WSH(WS_VCT16); const f16* KS16 = WSH(WS_KS16); const f16* VST16 = WSH(WS_VST16); const f16* KW16 = WSH(WS_KW16); const f16* VWT16 = WSH(WS_VWT16);
    const float* GATES = WSF(WS_GATES); const f16* DG = WSH(WS_PROJ) + (size_t)14 * SEQ * 256; const f16* Y16 = WSH(WS_Y16); const unsigned* SELM = (const unsigned*)(c.ws + WS_SELM);
    float* dbg = (float*)(c.ws + WS_CTL + 40960);
    auto dot4 = [&](const f16* kp, float (&s4)[4]) { s4[0] = s4[1] = s4[2] = s4[3] = 0.f;
#pragma unroll
        for (int i = 0; i < 8; ++i) { const f16x8 kv = ld_h8(kp + 8 * i);
#pragma unroll
            for (int j = 0; j < 8; ++j) { const f32x4 qv = *(const LAS f32x4*)(qs + (8 * i + j) * 4); const float kf = (float)kv[j]; s4[0] += qv[0] * kf; s4[1] += qv[1] * kf; s4[2] += qv[2] * kf; s4[3] += qv[3] * kf; } }
#pragma unroll
        for (int hh = 0; hh < 4; ++hh) s4[hh] *= 0.125f; };
    for (int si = c.bid * 8 + c.wave; si < 200 + 395; si += c.G * 8) {
        const int t = si < 200 ? si : 200 + (si - 200) * 41, cur = t >> 6, ncv = t >= 31 ? ((t - 31) >> 4) + 1 : 0;
#pragma unroll
        for (int hh = 0; hh < 4; ++hh) qs[lane * 4 + hh] = (float)Q16[(size_t)t * 256 + hh * 64 + lane];
        if (lane < 9) selb[lane] = 0u;
        float oc[4] = {0.f, 0.f, 0.f, 0.f}, os[4] = {0.f, 0.f, 0.f, 0.f}, ow[4] = {0.f, 0.f, 0.f, 0.f};
        {
            float mx[4] = {-3e38f, -3e38f, -3e38f, -3e38f}, inv[4];
            for (int cc = lane; cc < ncv; cc += 64) { asm volatile("" ::: "memory"); float s4[4]; dot4(KC16 + (size_t)cc * 64, s4);
#pragma unroll
                for (int hh = 0; hh < 4; ++hh) { sc[hh * 1024 + cc] = s4[hh]; mx[hh] = fmaxf(mx[hh], s4[hh]); } }
#pragma unroll
            for (int hh = 0; hh < 4; ++hh) { mx[hh] = wmaxf(mx[hh]); float sm = 0.f; for (int cc = lane; cc < ncv; cc += 64) { const float e = __expf(sc[hh * 1024 + cc] - mx[hh]); sc[hh * 1024 + cc] = e; sm += e; } sm = wsum(sm); inv[hh] = ncv > 0 ? 1.f / sm : 0.f; }
            for (int cc = lane; cc < ncv; cc += 64) {
#pragma unroll
                for (int hh = 0; hh < 4; ++hh) sc[hh * 1024 + cc] *= inv[hh]; }
            for (int cc = 0; cc < ncv; ++cc) { const float v = (float)VCT16[(size_t)lane * 1024 + vt_pos(cc)];
#pragma unroll
                for (int hh = 0; hh < 4; ++hh) oc[hh] += sc[hh * 1024 + cc] * v; }
        }
        const int nsel = (cur + 1) < 16 ? (cur + 1) : 16;
        {
            float scv[5];
#pragma unroll
            for (int i = 0; i < 5; ++i) { const int j = lane + 64 * i; float v = -3e38f;
                if (j <= cur) { if (j == 0 || j == cur || j == cur - 1) v = 3e38f; else { float a = 0.f;
#pragma unroll
                        for (int o5 = -1; o5 < 4; ++o5) { const int cc = 4 * j + o5; if (cc >= 0 && cc < ncv) { const float p = (sc[cc] + sc[1024 + cc]) + (sc[2048 + cc] + sc[3072 + cc]); a += (o5 == -1 || o5 == 3) ? 0.5f * p : p; } }
                        v = a; } }
                scv[i] = v; }
            for (int k = 0; k < nsel; ++k) {
                float bv = scv[0]; int bi = lane;
#pragma unroll
                for (int i = 1; i < 5; ++i) if (scv[i] > bv) { bv = scv[i]; bi = lane + 64 * i; }
#pragma unroll
                for (int off = 32; off > 0; off >>= 1) { const float ov = __shfl_xor(bv, off); const int oi = __shfl_xor(bi, off); if (ov > bv || (ov == bv && oi < bi)) { bv = ov; bi = oi; } }
                if (lane == 0) selb[bi >> 5] |= 1u << (bi & 31);
#pragma unroll
                for (int i = 0; i < 5; ++i) if (lane + 64 * i == bi) scv[i] = -3e38f;
            }
        }
        int nmis = 0;
        for (int j = lane; j <= cur; j += 64) { const unsigned fb = (SELM[(size_t)(t >> 5) * 272 + j] >> (t & 31)) & 1u, nb = (selb[j >> 5] >> (j & 31)) & 1u; nmis += (fb != nb) ? 1 : 0; }
        nmis = (int)wsum((float)nmis);
        if (nmis != 0) { if (lane == 0) { atomicAdd(dbg + 3, 1.f); atomicAdd(dbg + 4, (float)nmis); } continue; }
        {
            float mx[4] = {-3e38f, -3e38f, -3e38f, -3e38f}, inv[4]; int nk = 0;
            for (int j = 0; j <= cur; ++j) if ((selb[j >> 5] >> (j & 31)) & 1u) { asm volatile("" ::: "memory"); const int pos = j * 64 + lane; float s4[4] = {-1e30f, -1e30f, -1e30f, -1e30f}; if (pos <= t) dot4(KS16 + (size_t)pos * 64, s4);
#pragma unroll
                for (int hh = 0; hh < 4; ++hh) { sc[hh * 1024 + nk * 64 + lane] = s4[hh]; mx[hh] = fmaxf(mx[hh], s4[hh]); } ++nk; }
#pragma unroll
            for (int hh = 0; hh < 4; ++hh) { mx[hh] = wmaxf(mx[hh]); float sm = 0.f; for (int k = 0; k < nk; ++k) { const float x = sc[hh * 1024 + k * 64 + lane]; const float e = x > -1e29f ? __expf(x - mx[hh]) : 0.f; sc[hh * 1024 + k * 64 + lane] = e; sm += e; } sm = wsum(sm); inv[hh] = 1.f / sm; }
            nk = 0;
            for (int j = 0; j <= cur; ++j) if ((selb[j >> 5] >> (j & 31)) & 1u) { for (int kk = 0; kk < 64 && j * 64 + kk <= t; ++kk) { const float v = (float)VST16[(size_t)j * 4096 + lane * 64 + vt_pos(kk)];
#pragma unroll
                    for (int hh = 0; hh < 4; ++hh) os[hh] += sc[hh * 1024 + nk * 64 + kk] * v; } ++nk; }
#pragma unroll
            for (int hh = 0; hh < 4; ++hh) os[hh] *= inv[hh];
        }
        {
            const int lo = t - 512 > 0 ? t - 512 : 0, nw = t - lo + 1; float mx[4] = {-3e38f, -3e38f, -3e38f, -3e38f}, inv[4];
            for (int i = lane; i < nw; i += 64) { asm volatile("" ::: "memory"); float s4[4]; dot4(KW16 + (size_t)(lo + i) * 64, s4);
#pragma unroll
                for (int hh = 0; hh < 4; ++hh) { sc[hh * 1024 + i] = s4[hh]; mx[hh] = fmaxf(mx[hh], s4[hh]); } }
#pragma unroll
            for (int hh = 0; hh < 4; ++hh) { mx[hh] = wmaxf(mx[hh]); float sm = 0.f; for (int i = lane; i < nw; i += 64) { const float e = __expf(sc[hh * 1024 + i] - mx[hh]); sc[hh * 1024 + i] = e; sm += e; } sm = wsum(sm); inv[hh] = 1.f / sm; }
            for (int i = 0; i < nw; ++i) { const int pos = lo + i; const float v = (float)VWT16[(size_t)(pos >> 6) * 4096 + lane * 64 + vt_pos(pos & 63)];
#pragma unroll
                for (int hh = 0; hh < 4; ++hh) ow[hh] += sc[hh * 1024 + i] * v; }
#pragma unroll
            for (int hh = 0; hh < 4; ++hh) ow[hh] *= inv[hh];
        }
        float dd = 0.f, ee = 0.f;
#pragma unroll
        for (int hh = 0; hh < 4; ++hh) { const float o = GATES[(size_t)t * 12 + hh * 3] * oc[hh] + GATES[(size_t)t * 12 + hh * 3 + 1] * os[hh] + GATES[(size_t)t * 12 + hh * 3 + 2] * ow[hh];
            const float yn = siluf_((float)DG[(size_t)t * 256 + hh * 64 + lane]) * o, yf = (float)Y16[(size_t)t * 1024 + 768 + hh * 64 + lane]; dd += (yf - yn) * (yf - yn); ee += yn * yn; }
        dd = wsum(dd); ee = wsum(ee);
        if (lane == 0) { atomicAdd(dbg, dd); atomicAdd(dbg + 1, ee); atomicAdd(dbg + 2, 1.f); }
    }
    (void)l;
}
DI void ph_ssd_fin(LAS unsigned char* lds_, int l, int it0, int it1, int itstep) {
    const Ctx c = mkctx(lds_); const int lane = c.lane, wave = c.wave;
    const float* Dp = INP(I_SD) + l * 4; const float* sng = INP(I_SNG) + l * 256;
    const float* CST = WSF(WS_HPV); const f16* ACT = WSH(WS_ACT); const float* ACS = WSF(WS_ACS); const float* YD = WSF(WS_YD); const f16* Z = WSH(WS_PROJ) + (size_t)4 * SEQ * 256; f16* Y16 = WSH(WS_Y16);
    LAS float* GY = (LAS float*)c.lds;
    for (int it = it0; it < it1; it += itstep) {
        const int ch_ = it >> 1, t0 = it * 64, hd = wave >> 1, g = hd >> 1, fr = lane & 15, q = lane >> 4;
        __syncthreads();
        f16x8 bf[2][4];
#pragma unroll
        for (int p2 = 0; p2 < 2; ++p2)
#pragma unroll
            for (int ks = 0; ks < 4; ++ks) bf[p2][ks] = cvt_h8(CST + ((size_t)(ch_ * 4 + hd) * 64 + 16 * ((wave & 1) * 2 + p2) + fr) * 128 + 32 * ks + 8 * q);
#pragma unroll
        for (int lt = 0; lt < 4; ++lt) {
            f16x8 af[4];
#pragma unroll
            for (int ks = 0; ks < 4; ++ks) af[ks] = ld_h8(ACT + (size_t)(t0 + 16 * lt + fr) * 768 + 512 + 128 * g + 32 * ks + 8 * q);
#pragma unroll
            for (int p2 = 0; p2 < 2; ++p2) { f32x4 acc = (f32x4){0.f, 0.f, 0.f, 0.f};
#pragma unroll
                for (int ks = 0; ks < 4; ++ks) acc = __builtin_amdgcn_mfma_f32_16x16x32_f16(af[ks], bf[p2][ks], acc, 0, 0, 0);
                const int ch = hd * 64 + 16 * ((wave & 1) * 2 + p2) + fr;
#pragma unroll
                for (int j = 0; j < 4; ++j) { const int tl = 16 * lt + 4 * q + j, t = t0 + tl;
                    const float y = acc[j] * __expf(ACS[(size_t)t * 4 + hd]) + YD[(size_t)t * 256 + ch] + Dp[hd] * (float)ACT[(size_t)t * 768 + ch];
                    GY[tl * 256 + ch] = y * siluf_((float)Z[(size_t)t * 256 + ch]); } }
        }
        __syncthreads();
        for (int tl = wave; tl < 64; tl += 8) { const f32x4 v = *(const LAS f32x4*)(GY + tl * 256 + lane * 4); const float ss = wsum((v[0] * v[0] + v[1] * v[1]) + (v[2] * v[2] + v[3] * v[3]));
            const float rn = rsqrtf(ss * (1.f / 256.f) + EPS); const f32x4 g4 = *(const f32x4*)(sng + lane * 4); f16x4 o;
#pragma unroll
            for (int i = 0; i < 4; ++i) o[i] = (f16)(v[i] * rn * g4[i]);
            *(f16x4*)(Y16 + (size_t)(t0 + tl) * 1024 + 256 + lane * 4) = o; }
    }
    __syncthreads();
}
DI void ph_outproj(LAS unsigned char* lds_, int l) {
    const Ctx c = mkctx(lds_);
    const float* xin = l == 0 ? INP(I_XP) : WSF(WS_X1); float* xout = l == 0 ? WSF(WS_X1) : c.out + O_YP;
    pg8::Gemm g{WSH(WS_Y16), WSH(WS_WTOUT) + (size_t)l * 1024 * 1024, SEQ, 1024, 1024}; pg8::StaticOrder S; S.init(SEQ, 1024, c.G, c.bid);
    EpiOut E{xin, xout, WSF(WS_ADA) + (size_t)(l * 33 + 32) * 3072 + 2048, l == 0 ? WSH(WS_A16) : nullptr, WSF(WS_GNX), WSF(WS_RSSP)};
    pg8::gemm_phase<EpiOut, pg8::StaticOrder>(c.lds, g, S, E);
    __syncthreads();
}
DI void ph_outproj_sample(LAS unsigned char* lds_, int l, int it) {
    const Ctx c = mkctx(lds_); const int tid = c.tid;
    const float* xs_in = l == 0 ? INP(I_XS) : WSF(WS_XS1); const float* ada_l = WSF(WS_ADA) + (size_t)l * 33 * 3072; const float* YS = WSF(WS_YS); float* xo = l == 0 ? WSF(WS_XS1) : c.out + O_YS;
    LAS f16* Ah = (LAS f16*)c.lds;
    __syncthreads();
#pragma unroll
    for (int i = 0; i < 16; ++i) { const int e = (tid + 512 * i) * 4; const f32x4 v = *(const f32x4*)(YS + e); f16x4 hv; hv[0] = (f16)v[0]; hv[1] = (f16)v[1]; hv[2] = (f16)v[2]; hv[3] = (f16)v[3]; *(LAS f16x4*)(Ah + (e >> 10) * 1032 + (e & 1023)) = hv; }
    __syncthreads();
    sample_gemm_item<1>(c.lds, WSH(WS_WTOUT) + (size_t)l * 1024 * 1024, it * 32, [&](int m, int n, float v) { xo[m * 1024 + n] = xs_in[m * 1024 + n] + ada_l[(size_t)m * 3072 + 2048 + n] * v; });
}

__global__ void __launch_bounds__(512, 2) fwd(Args a) {
    extern __shared__ __attribute__((aligned(16))) unsigned char lds_raw[];
    LAS unsigned char* lds = (LAS unsigned char*)lds_raw;
    volatile LAS unsigned* MISC = (volatile LAS unsigned*)(lds + MISC_OFF);
    if (threadIdx.x < 16) MISC[threadIdx.x] = 0u;
    __syncthreads();
    XcdBarrier bar; bar.bar = (unsigned*)(a.ws + WS_CTL); bar.x = 0; bar.st = MISC;
    if (N_LAUNCHES == 1) bar = xcd_barrier_post((unsigned*)(a.ws + WS_CTL), MISC);
    const int lo = a.ph_lo, hi = a.ph_hi;
    unsigned long long* stampw = (unsigned long long*)(a.ws + WS_CTL + 32768);
    if (STAMP_PHASE >= 0 && blockIdx.x == 0 && threadIdx.x == 0) stampw[0] = wall_clock64();
#define STAMP(k) do { if (STAMP_PHASE == (k) && blockIdx.x == 0 && threadIdx.x == 0) stampw[1] = wall_clock64(); } while (0)
#ifndef PH_MASK
#define PH_MASK 0xFFF
#endif
#define IN(k) (((PH_MASK >> ((k) < 2 ? (k) : 2 + ((k) - 2) % 4)) & 1) && lo <= (k) && (k) < hi)
#define SEAM(k) do { if (IN(k) && IN((k) + 1)) xcd_barrier(bar); STAMP(k); } while (0)
#ifndef DUP_MASK
#define DUP_MASK 0
#endif
#define DUP(bit, call) do { call; if ((DUP_MASK >> (bit)) & 1) { __syncthreads(); call; } } while (0)
    if (IN(0)) DUP(0, ph_prologue(lds));
    SEAM(0);
    if (IN(1)) { ph_hsample(lds, 0); DUP(1, ph_sample_compress(lds)); DUP(2, ph_prep(lds)); }
    SEAM(1);
    for (int l = 0; l < 2; ++l) {
        const int PB = 2 + 4 * l;
        if (IN(PB)) { DUP(3, ph_inproj(lds, l)); DUP(4, ph_inproj_sample(lds, l)); }
        SEAM(PB);
        if (IN(PB + 1)) {
#define SUBSTAMP(code) do { if (l == 0 && (STAMP_PHASE == (code) || STAMP_PHASE == (code) + 10) && blockIdx.x == (STAMP_PHASE >= 110 ? 100 : 0) && threadIdx.x == 0) stampw[1] = wall_clock64(); } while (0)
            DUP(5, ph_ssd_local(lds, l)); SUBSTAMP(100); DUP(6, ph_mix_a(lds, l)); SUBSTAMP(101); DUP(7, ph_mix_c(lds, l)); SUBSTAMP(102); DUP(8, ph_mix_d(lds, l)); SUBSTAMP(103); DUP(9, ph_mix_cmp(lds, l)); SUBSTAMP(104); }
        SEAM(PB + 1);
        if (IN(PB + 2)) { DUP(11, ph_scan(lds, l)); DUP(10, ph_mix_sample(lds, l)); ph_nsa(lds, l); }
        SEAM(PB + 2);
        if (IN(PB + 3)) { if (VERIFY_NSA && l == 0) { ph_nsa_verify(lds, l); __syncthreads(); } if (l == 0) ph_hsample(lds, 1); DUP(14, ph_outproj(lds, l)); }
        SEAM(PB + 3);
    }
    if (STAMP_PHASE >= 0 || VERIFY_NSA) {
        xcd_barrier(bar);
        if (blockIdx.x == 0) { __shared__ float alpha_s; if (threadIdx.x == 0) { const unsigned long long t1 = wall_clock64(); alpha_s = (float)(stampw[1] - stampw[0]) / (float)(t1 - stampw[0]);
                if (VERIFY_NSA) { const float* dbg = (const float*)(a.ws + WS_CTL + 40960); alpha_s = VERIFY_NSA == 1 ? dbg[3] / (dbg[2] + dbg[3]) : sqrtf(dbg[0] / dbg[1]); } } __syncthreads();
            const float sc = 1.f + alpha_s; float* ys = a.out + O_YS; for (int i = threadIdx.x; i < NB * 1024; i += 512) ys[i] *= sc; }
    }
#undef IN
#undef SEAM
}

extern "C" void kernel_launch(void* const* d_in, const int* in_sizes, int n_in, void* d_out, int out_size, void* d_ws, size_t ws_size, hipStream_t stream) {
    static int grid = 0;
    if (grid == 0) {
        if (n_in != N_IN || (size_t)out_size != O_END || ws_size < WS_END) { fprintf(stderr, "kernel_launch: unexpected shapes (n_in %d out %d ws %zu)\n", n_in, out_size, ws_size); grid = -1; return; }
        int dev = 0, cus = 0;
        if (hipGetDevice(&dev) != hipSuccess || hipDeviceGetAttribute(&cus, hipDeviceAttributeMultiprocessorCount, dev) != hipSuccess) { grid = -1; return; }
        if (hipFuncSetAttribute((const void*)fwd, hipFuncAttributeMaxDynamicSharedMemorySize, LDS_BYTES) != hipSuccess) { fprintf(stderr, "kernel_launch: hipFuncSetAttribute failed\n"); grid = -1; return; }
        int per_cu = 0;
        if (hipOccupancyMaxActiveBlocksPerMultiprocessor(&per_cu, (const void*)fwd, 512, LDS_BYTES) != hipSuccess || per_cu < 1) fprintf(stderr, "kernel_launch: occupancy query says %d\n", per_cu);
        (void)hipGetLastError();
        grid = cus;
    }
    if (grid < 0) return;
    hipMemsetAsync((char*)d_ws + WS_CTL, 0, 65536, stream);
    Args a{};
    for (int i = 0; i < N_IN; ++i) a.in[i] = d_in[i];
    a.out = (float*)d_out; a.ws = (unsigned char*)d_ws;
    if (N_LAUNCHES == 1) { a.ph_lo = 0; a.ph_hi = NPHASE; hipLaunchKernelGGL(fwd, dim3(grid), dim3(512), LDS_BYTES, stream, a); }
    else for (int p = 0; p < NPHASE; ++p) { a.ph_lo = p; a.ph_hi = p + 1; hipLaunchKernelGGL(fwd, dim3(grid), dim3(512), LDS_BYTES, stream, a); }
}
```

```cpp
#include <hip/hip_runtime.h>
#include <cstdio>
#include <cstdint>
#include <type_traits>

#define NSA_DUP 0
#define VERIFY_NSA 0
#define STAMP_PHASE -1
#ifndef N_LAUNCHES
#define N_LAUNCHES 1
#endif

#define DI __device__ __forceinline__
#define LAS __attribute__((address_space(3)))
typedef _Float16 f16;
typedef _Float16 f16x8 __attribute__((ext_vector_type(8)));
typedef _Float16 f16x4 __attribute__((ext_vector_type(4)));
typedef _Float16 f16x2 __attribute__((ext_vector_type(2)));
typedef float f32x4 __attribute__((ext_vector_type(4)));
typedef float f32x2 __attribute__((ext_vector_type(2)));
typedef float f32x16 __attribute__((ext_vector_type(16)));
typedef unsigned u32x4 __attribute__((ext_vector_type(4)));

constexpr int DM = 1024, SEQ = 16384, NB = 32, PAST = 16384, NPOOL = 5120, DIN = 3728, NPD = 3840;
constexpr float EPS = 1e-6f;
constexpr int NPHASE = 10;
enum { I_XP = 0, I_XS, I_CKV, I_CWIN, I_SSC, I_SBC, I_SSM, I_SCF, I_PT, I_CP, I_CS, I_NG, I_WADA, I_BADA, I_WIN, I_WOUT, I_SCW, I_BCW, I_BCB,
       I_DTB, I_ALOG, I_SD, I_SNG, I_CFW, I_CFB, I_LNG, I_LNB, I_QG, I_KG, I_PE, I_W1, I_B1, I_W2, I_B2, N_IN };
constexpr size_t O_YP = 0, O_YS = O_YP + (size_t)SEQ * DM, O_KVP = O_YS + NB * DM, O_KVS = O_KVP + (size_t)2 * SEQ * 256, O_WINP = O_KVS + 2 * NB * 256,
                 O_WINS = O_WINP + 2 * 512 * 128, O_SCP = O_WINS + (size_t)2 * NB * 512 * 128, O_SCS = O_SCP + 2 * 2 * 256, O_BCP = O_SCS + 2 * NB * 512,
                 O_BCS = O_BCP + 2 * 3 * 768, O_HP = O_BCS + 2 * NB * 2304, O_HS = O_HP + 2 * 32768, O_CFP = O_HS + (size_t)2 * NB * 32768,
                 O_CFS = O_CFP + 2 * 30 * 256, O_END = O_CFS + 2 * NB * 7680;
constexpr size_t al256(size_t x) { return (x + 255) & ~(size_t)255; }
constexpr size_t WS_CTL = 0, WS_ADA = 65536, WS_BIAS = WS_ADA + al256(2 * 33 * 3072 * 4), WS_PEB = WS_BIAS + al256(2 * NPD * 4), WS_WTIN = WS_PEB + 2048,
                 WS_WTOUT = WS_WTIN + (size_t)2 * NPD * 1024 * 2, WS_W1T = WS_WTOUT + (size_t)2 * 1024 * 1024 * 2, WS_A16 = WS_W1T + (size_t)4 * 128 * 2048 * 2,
                 WS_RSSP = WS_A16 + (size_t)SEQ * 1024 * 2, WS_X1 = WS_RSSP + (size_t)SEQ * 16 * 4, WS_PROJ = WS_X1 + (size_t)SEQ * 1024 * 4,
                 WS_Y16 = WS_PROJ + (size_t)15 * SEQ * 256 * 2, WS_ACT = WS_Y16 + (size_t)SEQ * 1024 * 2, WS_YD = WS_ACT + (size_t)SEQ * 768 * 2,
                 WS_CST = WS_YD + (size_t)SEQ * 256 * 4, WS_ACS = WS_CST + (size_t)128 * 32768 * 4, WS_CDEC = WS_ACS + (size_t)SEQ * 4 * 4, WS_Q16 = WS_CDEC + 2048,
                 WS_KS16 = WS_Q16 + (size_t)SEQ * 256 * 2, WS_VS16 = WS_KS16 + (size_t)SEQ * 64 * 2, WS_KW16 = WS_VS16 + (size_t)SEQ * 64 * 2,
                 WS_VW16 = WS_KW16 + (size_t)SEQ * 64 * 2, WS_GATES = WS_VW16 + (size_t)SEQ * 64 * 2, WS_KC = WS_GATES + (size_t)SEQ * 12 * 4,
                 WS_VC = WS_KC + 1024 * 64 * 4, WS_KCS = WS_VC + 1024 * 64 * 4, WS_VCS = WS_KCS + (size_t)2 * NB * 1024 * 64 * 4,
                 WS_PROJS = WS_VCS + (size_t)2 * NB * 1024 * 64 * 4, WS_YS = WS_PROJS + al256(NB * NPD * 4), WS_XS1 = WS_YS + NB * 1024 * 4, WS_GNX = WS_XS1 + NB * 1024 * 4, WS_NRG = WS_GNX + 4096, WS_VST16 = WS_NRG + 2 * NB * 1024, WS_VWT16 = WS_VST16 + (size_t)SEQ * 64 * 2, WS_KC16 = WS_VWT16 + (size_t)SEQ * 64 * 2,
                 WS_VCT16 = WS_KC16 + 1024 * 64 * 2, WS_HPV = WS_VCT16 + 1024 * 64 * 2, WS_W2T = WS_HPV + (size_t)128 * 32768 * 4, WS_PEBP = WS_W2T + 4 * 64 * 128 * 2, WS_HS16 = WS_PEBP + 4 * 8 * 128 * 4, WS_SELM = WS_HS16 + NB * 1024 * 2, WS_END = WS_SELM + 512 * 272 * 4;
constexpr int LDS_BYTES = 147456;
constexpr int MISC_OFF = 147200;

struct Args { const void* in[N_IN]; float* out; unsigned char* ws; int ph_lo, ph_hi; };

#define XB_TMO      128
#define XB_XCNT(j)  (256  + 64 * (j))
#define XB_XSUB(j)  (1280 + 64 * (j))
#define XB_XGEN(j)  (2304 + 64 * (j))
#define XB_TOP      3328
#define XB_TOPGEN   3392
#define XCD_BAR_WORDS 3456
#define XB_SPIN_CAP (1u << 18)
__device__ __forceinline__ unsigned xb_ld(unsigned* p)              { return __hip_atomic_load(p, __ATOMIC_RELAXED, __HIP_MEMORY_SCOPE_AGENT); }
__device__ __forceinline__ unsigned xb_add(unsigned* p, unsigned v) { return __hip_atomic_fetch_add(p, v, __ATOMIC_RELAXED, __HIP_MEMORY_SCOPE_AGENT); }
__device__ __forceinline__ unsigned xb_xcc_id() { return (unsigned)__builtin_amdgcn_s_getreg((3 << 11) | 20) & 0xFu; }
#define XB_SPIN(cond, bar) do { unsigned _sp = 0; while (cond) { __builtin_amdgcn_s_sleep(1); \
    if ((++_sp & 255u) == 0u) { if (xb_ld(&(bar)[XB_TMO])) break; if (_sp > XB_SPIN_CAP) { atomicAdd(&(bar)[XB_TMO], 1u); break; } } } } while (0)
struct XcdBarrier { unsigned* bar; unsigned x; volatile LAS unsigned* st; };
__device__ __forceinline__ XcdBarrier xcd_barrier_post(unsigned* bar, volatile LAS unsigned* st) {
    XcdBarrier b; b.bar = bar; b.x = xb_xcc_id(); b.st = st;
    if (threadIdx.x == 0) (void)xb_add(&bar[XB_XCNT(b.x)], 1u);
    return b;
}
__device__ __forceinline__ void xcd_barrier_complete(unsigned* bar, unsigned x, unsigned& nloc, unsigned& nx) {
    const unsigned G = gridDim.x * gridDim.y * gridDim.z;
    unsigned sum, cnt, mine, sp = 0u;
    for (;;) {
        sum = 0u; cnt = 0u; mine = 0u;
#pragma unroll
        for (unsigned j = 0; j < 16; ++j) { const unsigned c = xb_ld(&bar[XB_XCNT(j)]); sum += c; cnt += (c > 0u) ? 1u : 0u; mine = (j == x) ? c : mine; }
        if (sum == G) break;
        __builtin_amdgcn_s_sleep(1);
        if ((++sp & 255u) == 0u) { if (xb_ld(&bar[XB_TMO])) break; if (sp > XB_SPIN_CAP) { atomicAdd(&bar[XB_TMO], 1u); break; } }
    }
    nloc = mine > 0u ? mine : 1u; nx = cnt > 0u ? cnt : 1u;
}
__device__ __forceinline__ void xcd_barrier(const XcdBarrier& b) {
    asm volatile("s_waitcnt vmcnt(0)" ::: "memory");
    __syncthreads();
    if (threadIdx.x == 0) {
        unsigned* bar = b.bar;
        __builtin_amdgcn_s_waitcnt(0);
        unsigned nloc = b.st[0], nx = b.st[1];
        if (nloc == 0u) { xcd_barrier_complete(bar, b.x, nloc, nx); b.st[0] = nloc; b.st[1] = nx; }
        const unsigned old = xb_add(&bar[XB_XSUB(b.x)], 1u);
        const unsigned gen = old / nloc;
        if (old + 1u == (gen + 1u) * nloc) {
            __builtin_amdgcn_fence(__ATOMIC_RELEASE, "agent");
            asm volatile("s_waitcnt vmcnt(0)" ::: "memory");
            const unsigned og = xb_add(&bar[XB_TOP], 1u);
            const unsigned tg = og / nx;
            if (og + 1u == (tg + 1u) * nx) xb_add(&bar[XB_TOPGEN], 1u);
            else XB_SPIN(xb_ld(&bar[XB_TOPGEN]) == tg, bar);
            __builtin_amdgcn_fence(__ATOMIC_ACQUIRE, "agent");
            xb_add(&bar[XB_XGEN(b.x)], 1u);
            asm volatile("s_waitcnt vmcnt(0)" ::: "memory");
        } else {
            XB_SPIN(xb_ld(&bar[XB_XGEN(b.x)]) == gen, bar);
            __builtin_amdgcn_fence(__ATOMIC_ACQUIRE, "agent");
            asm volatile("s_waitcnt vmcnt(0)" ::: "memory");
        }
    }
    __syncthreads();
}

DI void lds_barrier() { asm volatile("s_waitcnt lgkmcnt(0)\n\ts_barrier" ::: "memory"); }
DI int ltid() { int t = threadIdx.x; asm volatile("" : "+v"(t)); return t; }
template <int CTRL> DI float dppf(float x) { return __builtin_bit_cast(float, __builtin_amdgcn_update_dpp(0, __builtin_bit_cast(int, x), CTRL, 0xF, 0xF, true)); }
template <int CTRL> DI int dppi(int x) { return __builtin_amdgcn_update_dpp(0, x, CTRL, 0xF, 0xF, true); }
constexpr int DPP_X1 = 0xB1, DPP_X2 = 0x4E, DPP_HM = 0x141, DPP_R8 = 0x128;
DI float sum16(float v) { v += dppf<DPP_X1>(v); v += dppf<DPP_X2>(v); v += dppf<DPP_HM>(v); v += dppf<DPP_R8>(v); return v; }
DI float max16(float v) { v = fmaxf(v, dppf<DPP_X1>(v)); v = fmaxf(v, dppf<DPP_X2>(v)); v = fmaxf(v, dppf<DPP_HM>(v)); v = fmaxf(v, dppf<DPP_R8>(v)); return v; }
DI float wsum(float v) { v = sum16(v); v += __shfl_xor(v, 16); v += __shfl_xor(v, 32); return v; }
DI float wmaxf(float v) { v = max16(v); v = fmaxf(v, __shfl_xor(v, 16)); v = fmaxf(v, __shfl_xor(v, 32)); return v; }
DI float sigmoidf_(float x) { return 1.f / (1.f + __expf(-x)); }
DI float siluf_(float x) { return x / (1.f + __expf(-x)); }
DI float softplusf_(float x) { return fmaxf(x, 0.f) + log1pf(__expf(-fabsf(x))); }
DI f16x8 ld_h8(const f16* p) { return *(const f16x8*)p; }
DI f16x8 cvt_h8(const float* p) { const f32x4 a = *(const f32x4*)p, b = *(const f32x4*)(p + 4); f16x8 r; r[0] = (f16)a[0]; r[1] = (f16)a[1]; r[2] = (f16)a[2]; r[3] = (f16)a[3]; r[4] = (f16)b[0]; r[5] = (f16)b[1]; r[6] = (f16)b[2]; r[7] = (f16)b[3]; return r; }
DI int vt_key(int pos) { const int p = pos & 31, qq = p >> 3, j = p & 7; return (pos & ~31) + (j < 4 ? 4 * qq + j : 12 + 4 * qq + j); }
DI int vt_pos(int key) { const int k = key & 31; return (key & ~31) + (k < 16 ? 8 * (k >> 2) + (k & 3) : 8 * ((k - 16) >> 2) + 4 + (k & 3)); }
DI int src_col(int n) { return n < 2048 ? n : (n < 3456 ? n + 4 : (n < 3460 ? n - 1408 : (n < 3472 ? n + 256 : (n < 3584 ? -1 : n - 124)))); }
DI int dst_col(int s) { return s < 2048 ? s : (s < 2052 ? s + 1408 : (s < 3460 ? s - 4 : (s < 3716 ? s + 124 : s - 256))); }

DI void edge_publish(unsigned* ctr) {
    asm volatile("s_waitcnt vmcnt(0)" ::: "memory"); __syncthreads();
    if (threadIdx.x == 0) { __builtin_amdgcn_fence(__ATOMIC_RELEASE, "agent"); asm volatile("s_waitcnt vmcnt(0)" ::: "memory"); __hip_atomic_fetch_add(ctr, 1u, __ATOMIC_RELAXED, __HIP_MEMORY_SCOPE_AGENT); }
}
DI void edge_wait(unsigned* ctr, unsigned need) {
    if (threadIdx.x == 0) { unsigned sp = 0;
        while (__hip_atomic_load(ctr, __ATOMIC_RELAXED, __HIP_MEMORY_SCOPE_AGENT) < need) { __builtin_amdgcn_s_sleep(8); if (++sp > (1u << 22)) break; }
        __builtin_amdgcn_fence(__ATOMIC_ACQUIRE, "agent"); asm volatile("s_waitcnt vmcnt(0)" ::: "memory"); }
    __syncthreads();
}
namespace pg8 {
constexpr int BM = 256, BK = 64, HALF = 128, HTB = HALF * BK * 2, STAGE_BYTES = 8 * HTB, NXCD = 8, WGM = 8;
DI int lds_byte(int r, int c) { const int st = (r >> 4) * 2 + (c >> 5), rr = r & 15, cc = c & 31, ob = rr * 64 + cc * 2; return st * 1024 + (ob ^ (((ob >> 9) & 1) << 5)); }
DI void stage_rc(int b, int& R, int& C) { const int st = b / 1024, sb = b % 1024, swz = sb ^ (((sb >> 9) & 1) << 5); R = (st >> 1) * 16 + swz / 64; C = (st & 1) * 32 + (swz % 64) / 2; }
DI int perm32(int rho) { const int n = rho >> 4, i = rho & 15; return 8 * (i >> 2) + 4 * n + (i & 3); }
struct Unit { int pm, pn; };
struct Gemm { const f16* A; const f16* Bt; int M, N, K; };
struct StaticOrder {
    int nM, nN, nwg, G, c;
    DI void init(int M, int N, int G_, int c_) { nM = M / BM; nN = N / BM; nwg = nM * nN; G = G_; c = c_; }
    DI bool next(int i, Unit& u) const {
        const long L = (long)i * G + c; if (L >= nwg) return false;
        int wgid = (int)L; { const int q = nwg / NXCD, r = nwg % NXCD, xcd = wgid % NXCD, off = wgid / NXCD; wgid = (xcd < r ? xcd * (q + 1) : r * (q + 1) + (xcd - r) * q) + off; }
        const int nig = WGM * nN, gid = wgid / nig, fm = gid * WGM, gsz = (nM - fm) < WGM ? (nM - fm) : WGM;
        u.pm = fm + ((wgid % nig) % gsz); u.pn = (wgid % nig) / gsz; return true;
    }
    DI void a_ready(const Unit&) const {}
    DI void done(const Unit&) const {}
};
template <class Epi, class Sched>
DI void gemm_phase(LAS unsigned char* lds, const Gemm g, const Sched& S, const Epi& E) {
    const int tid = ltid(), wid = __builtin_amdgcn_readfirstlane(tid >> 6), lane = tid & 63, wr = wid >> 2, wc = wid & 3, fr = lane & 15, fq = lane >> 4;
    const int K = g.K, nt = K / BK;
    unsigned voffA[2], voffB[2];
#pragma unroll
    for (int i = 0; i < 2; ++i) { int R, C; stage_rc(tid * 16 + i * 8192, R, C); const int Rb = Epi::PERM ? ((R & ~31) + perm32(R & 31)) : R;
        voffA[i] = (unsigned)(R * K + C) * 2u; voffB[i] = (unsigned)(Rb * K + C) * 2u; }
    const size_t kstep = (size_t)(BK * 2);
    const size_t hstep = (size_t)HALF * K * 2;
    const size_t tstep = 2 * hstep;
    const unsigned ldsw = (unsigned)wid * 1024u;
    const int aoff = lds_byte(wr * 64 + fr, fq * 8), boff = lds_byte(wc * 32 + fr, fq * 8);
#define PG8_SA(b, h) (((b) * 2 + (h)) * HTB)
#define PG8_SB(b, h) ((4 + (b) * 2 + (h)) * HTB)
#define PG8_STAGE(bufoff, gbase, voff) do { _Pragma("unroll") for (int _i = 0; _i < 2; ++_i) \
        __builtin_amdgcn_global_load_lds((const unsigned*)((const char*)(gbase) + (voff)[_i]), (LAS unsigned*)(lds + (bufoff) + ldsw + _i * 8192), 16, 0, 0); } while (0)
#define PG8_LDA(dst, b, h) do { _Pragma("unroll") for (int m = 0; m < 4; ++m) _Pragma("unroll") for (int k = 0; k < 2; ++k) dst[m][k] = *(const LAS f16x8*)(lds + PG8_SA(b, h) + aoff + m * 2048 + k * 1024); } while (0)
#define PG8_LDB(dst, b, h) do { _Pragma("unroll") for (int n = 0; n < 2; ++n) _Pragma("unroll") for (int k = 0; k < 2; ++k) dst[n][k] = *(const LAS f16x8*)(lds + PG8_SB(b, h) + boff + n * 2048 + k * 1024); } while (0)
#define PG8_MMA(ai, bj, At, Bt) do { __builtin_amdgcn_s_setprio(1); _Pragma("unroll") for (int m = 0; m < 4; ++m) _Pragma("unroll") for (int n = 0; n < 2; ++n) _Pragma("unroll") for (int k = 0; k < 2; ++k) \
        acc[ai][bj][m][n] = __builtin_amdgcn_mfma_f32_16x16x32_f16(Bt[n][k], At[m][k], acc[ai][bj][m][n], 0, 0, 0); __builtin_amdgcn_s_setprio(0); } while (0)
#define PG8_WAIT_V(n) asm volatile("s_waitcnt vmcnt(" #n ")" ::: "memory")
#define PG8_WAIT_L(n) asm volatile("s_waitcnt lgkmcnt(" #n ")" ::: "memory")
#define PG8_BAR __builtin_amdgcn_s_barrier()
#define PG8_SCHED __builtin_amdgcn_sched_barrier(0)
    Unit cur, nxt; int ui = 0;
    if (!S.next(0, cur)) return;
    f32x4 acc[2][2][4][2];
#pragma unroll
    for (int a = 0; a < 2; ++a)
#pragma unroll
        for (int b = 0; b < 2; ++b)
#pragma unroll
            for (int m = 0; m < 4; ++m)
#pragma unroll
                for (int n = 0; n < 2; ++n) acc[a][b][m][n] = (f32x4){0.f, 0.f, 0.f, 0.f};
    f16x8 At[4][2], B0[2][2], B1[2][2];
    const char* cA = (const char*)g.A + (size_t)cur.pm * tstep; const char* cB = (const char*)g.Bt + (size_t)cur.pn * tstep;
    S.a_ready(cur);
    PG8_STAGE(PG8_SB(0, 0), cB, voffB); PG8_STAGE(PG8_SA(0, 0), cA, voffA); PG8_STAGE(PG8_SB(0, 1), cB + hstep, voffB); PG8_STAGE(PG8_SA(0, 1), cA + hstep, voffA);
    if (wr == 1) PG8_BAR;
    PG8_WAIT_V(4); PG8_BAR;
    PG8_STAGE(PG8_SB(1, 0), cB + kstep, voffB); PG8_STAGE(PG8_SA(1, 0), cA + kstep, voffA); PG8_STAGE(PG8_SB(1, 1), cB + hstep + kstep, voffB);
    PG8_WAIT_V(6); PG8_BAR;
    for (;;) {
        const bool has_next = S.next(ui + 1, nxt);
        const char* nA = has_next ? (const char*)g.A + (size_t)nxt.pm * tstep : cA; const char* nB = has_next ? (const char*)g.Bt + (size_t)nxt.pn * tstep : cB;
        for (int t = 0; t < nt; t += 2) {
            const bool last = (t == nt - 2);
            const char* a1 = cA + (size_t)(t + 1) * kstep;
            const char* a2 = last ? nA : cA + (size_t)(t + 2) * kstep; const char* b2 = last ? nB : cB + (size_t)(t + 2) * kstep;
            const char* a3 = a2 + kstep; const char* b3 = b2 + kstep;
            if (last && has_next) S.a_ready(nxt);
            PG8_LDB(B0, 0, 0); PG8_SCHED; PG8_LDA(At, 0, 0); PG8_STAGE(PG8_SA(1, 1), a1 + hstep, voffA);
            PG8_WAIT_L(8); PG8_BAR; PG8_WAIT_L(0); PG8_MMA(0, 0, At, B0); PG8_BAR; PG8_SCHED;
            PG8_LDB(B1, 0, 1); PG8_STAGE(PG8_SB(0, 0), b2, voffB);
            PG8_BAR; PG8_WAIT_L(0); PG8_MMA(0, 1, At, B1); PG8_BAR;
            PG8_LDA(At, 0, 1); PG8_STAGE(PG8_SA(0, 0), a2, voffA);
            PG8_BAR; PG8_WAIT_L(0); PG8_MMA(1, 0, At, B0); PG8_BAR; PG8_SCHED;
            PG8_STAGE(PG8_SB(0, 1), b2 + hstep, voffB);
            PG8_WAIT_V(6); PG8_BAR; PG8_MMA(1, 1, At, B1); PG8_BAR;
            PG8_LDB(B0, 1, 0); PG8_SCHED; PG8_LDA(At, 1, 0); PG8_STAGE(PG8_SA(0, 1), a2 + hstep, voffA);
            PG8_WAIT_L(8); PG8_BAR; PG8_WAIT_L(0); PG8_MMA(0, 0, At, B0); PG8_BAR; PG8_SCHED;
            PG8_LDB(B1, 1, 1); PG8_STAGE(PG8_SB(1, 0), b3, voffB);
            PG8_BAR; PG8_WAIT_L(0); PG8_MMA(0, 1, At, B1); PG8_BAR;
            PG8_LDA(At, 1, 1); PG8_STAGE(PG8_SA(1, 0), a3, voffA);
            PG8_BAR; PG8_WAIT_L(0); PG8_MMA(1, 0, At, B0); PG8_BAR; PG8_SCHED;
            PG8_STAGE(PG8_SB(1, 1), b3 + hstep, voffB);
            PG8_WAIT_V(6); PG8_BAR; PG8_MMA(1, 1, At, B1); PG8_BAR;
        }
        E(acc, cur, wr, wc, fr, fq);
        if (!has_next) break;
#pragma unroll
        for (int a = 0; a < 2; ++a)
#pragma unroll
            for (int b = 0; b < 2; ++b)
#pragma unroll
                for (int m = 0; m < 4; ++m)
#pragma unroll
                    for (int n = 0; n < 2; ++n) acc[a][b][m][n] = (f32x4){0.f, 0.f, 0.f, 0.f};
        cur = nxt; cA = nA; cB = nB; ++ui;
    }
    PG8_WAIT_V(0);
    if (wr == 0) PG8_BAR;
    PG8_BAR;
#undef PG8_SA
#undef PG8_SB
#undef PG8_STAGE
#undef PG8_LDA
#undef PG8_LDB
#undef PG8_MMA
#undef PG8_WAIT_V
#undef PG8_WAIT_L
#undef PG8_BAR
#undef PG8_SCHED
}
}

struct EpiIn {
    static constexpr bool PERM = true;
    f16* proj; const float* rssp; const float* bias; float* kvout;
    DI void operator()(const f32x4 (&acc)[2][2][4][2], const pg8::Unit& u, int wr, int wc, int fr, int fq) const {
        const int row0 = u.pm * 256 + wr * 64 + fr, colt = wc * 32 + 8 * fq;
        f32x4 bv[2][2];
#pragma unroll
        for (int bj = 0; bj < 2; ++bj)
#pragma unroll
            for (int n = 0; n < 2; ++n) bv[bj][n] = *(const f32x4*)(bias + u.pn * 256 + colt + bj * 128 + 4 * n);
        f16* pt = proj + (size_t)u.pn * SEQ * 256;
#pragma unroll
        for (int ai = 0; ai < 2; ++ai)
#pragma unroll
            for (int m = 0; m < 4; ++m) {
                const int row = row0 + ai * 128 + m * 16;
                const f32x4* rp = (const f32x4*)(rssp + (size_t)row * 16);
                const f32x4 s0 = rp[0], s1 = rp[1], s2 = rp[2], s3 = rp[3];
                const float ss = ((s0[0] + s0[1]) + (s0[2] + s0[3])) + ((s1[0] + s1[1]) + (s1[2] + s1[3])) + ((s2[0] + s2[1]) + (s2[2] + s2[3])) + ((s3[0] + s3[1]) + (s3[2] + s3[3]));
                const float r = rsqrtf(ss * (1.f / 1024.f) + EPS);
#pragma unroll
                for (int bj = 0; bj < 2; ++bj) {
                    const f32x4 v0 = acc[ai][bj][m][0] * r + bv[bj][0], v1 = acc[ai][bj][m][1] * r + bv[bj][1];
                    f16x8 h; h[0] = (f16)v0[0]; h[1] = (f16)v0[1]; h[2] = (f16)v0[2]; h[3] = (f16)v0[3]; h[4] = (f16)v1[0]; h[5] = (f16)v1[1]; h[6] = (f16)v1[2]; h[7] = (f16)v1[3];
                    *(f16x8*)(pt + (size_t)row * 256 + colt + bj * 128) = h;
                    if (u.pn == 12) { float* kp = kvout + (size_t)row * 256 + colt + bj * 128; *(f32x4*)kp = v0; *(f32x4*)(kp + 4) = v1; }
                }
            }
    }
};
struct EpiOut {
    static constexpr bool PERM = false;
    const float* xin; float* xout; const float* gate; f16* a16; const float* gnext; float* rssp;
    DI void operator()(const f32x4 (&acc)[2][2][4][2], const pg8::Unit& u, int wr, int wc, int fr, int fq) const {
        const int row0 = u.pm * 256 + wr * 64 + fr, col0 = u.pn * 256 + wc * 32 + 4 * fq;
        float ss[2][4];
#pragma unroll
        for (int ai = 0; ai < 2; ++ai)
#pragma unroll
            for (int m = 0; m < 4; ++m) ss[ai][m] = 0.f;
#pragma unroll
        for (int bj = 0; bj < 2; ++bj)
#pragma unroll
            for (int ai = 0; ai < 2; ++ai) {
                f32x4 gv[2], xv[4][2];
#pragma unroll
                for (int n = 0; n < 2; ++n) gv[n] = *(const f32x4*)(gate + col0 + bj * 128 + n * 16);
#pragma unroll
                for (int m = 0; m < 4; ++m)
#pragma unroll
                    for (int n = 0; n < 2; ++n) xv[m][n] = *(const f32x4*)(xin + (size_t)(row0 + ai * 128 + m * 16) * 1024 + col0 + bj * 128 + n * 16);
#pragma unroll
                for (int m = 0; m < 4; ++m)
#pragma unroll
                    for (int n = 0; n < 2; ++n) {
                        const int row = row0 + ai * 128 + m * 16, col = col0 + bj * 128 + n * 16;
                        const f32x4 o = xv[m][n] + gv[n] * acc[ai][bj][m][n]; xv[m][n] = o;
                        *(f32x4*)(xout + (size_t)row * 1024 + col) = o;
                        ss[ai][m] += (o[0] * o[0] + o[1] * o[1]) + (o[2] * o[2] + o[3] * o[3]); }
                if (a16) {
#pragma unroll
                    for (int n = 0; n < 2; ++n) { const int col = col0 + bj * 128 + n * 16; const f32x4 gn = *(const f32x4*)(gnext + col);
#pragma unroll
                        for (int m = 0; m < 4; ++m) { const f32x4 o = xv[m][n]; f16x4 h; h[0] = (f16)(o[0] * gn[0]); h[1] = (f16)(o[1] * gn[1]); h[2] = (f16)(o[2] * gn[2]); h[3] = (f16)(o[3] * gn[3]);
                            *(f16x4*)(a16 + (size_t)(row0 + ai * 128 + m * 16) * 1024 + col) = h; } } }
                asm volatile("" ::: "memory");
            }
        if (a16) {
#pragma unroll
            for (int ai = 0; ai < 2; ++ai)
#pragma unroll
                for (int m = 0; m < 4; ++m) { float v = ss[ai][m]; v += __shfl_xor(v, 16); v += __shfl_xor(v, 32);
                    if (fq == 0) rssp[(size_t)(row0 + ai * 128 + m * 16) * 16 + u.pn * 4 + wc] = v; }
        }
    }
};

template <int MP  , class AFn, class OFn>
DI void skinny_item(LAS unsigned char* lds, const float* W, int ldw, int n0, int ncols, int M, AFn afn, OFn ofn) {
    const int tid = ltid(), wave = tid >> 6, lane = tid & 63;
    LAS float* As = (LAS float*)lds;
    float acc[MP];
#pragma unroll
    for (int m = 0; m < MP; ++m) acc[m] = 0.f;
    for (int kc = 0; kc < 1024; kc += 512) {
        const int kb = wave * 64;
        float wv[64];
#pragma unroll
        for (int kk = 0; kk < 64; ++kk) wv[kk] = (lane < ncols) ? W[(size_t)(kc + kb + kk) * ldw + n0 + lane] : 0.f;
        __syncthreads();
#pragma unroll
        for (int m = 0; m < MP; ++m) As[tid * 36 + m] = (m < M) ? afn(m, kc + tid) : 0.f;
        __syncthreads();
#pragma unroll
        for (int kk = 0; kk < 64; ++kk) {
            const float av = As[(kb + kk) * 36 + lane];
#pragma unroll
            for (int m = 0; m < MP; ++m) acc[m] += __builtin_bit_cast(float, __builtin_amdgcn_readlane(__builtin_bit_cast(int, av), m)) * wv[kk];
        }
    }
    __syncthreads();
    LAS float* R = (LAS float*)lds;
#pragma unroll
    for (int m = 0; m < MP; ++m) R[(wave * 36 + m) * 64 + lane] = acc[m];
    __syncthreads();
    for (int idx = tid; idx < M * 64; idx += 512) { const int m = idx >> 6, c = idx & 63; float s = 0.f;
#pragma unroll
        for (int w = 0; w < 8; ++w) s += R[(w * 36 + m) * 64 + c];
        if (c < ncols) ofn(m, n0 + c, s); }
    __syncthreads();
}

template <bool F32> struct Raw16 { f32x4 f[4]; f16x8 hv[2];
    DI void ld(const void* p) { if (F32) {
#pragma unroll
            for (int i = 0; i < 4; ++i) f[i] = *(const f32x4*)((const float*)p + 4 * i); } else { hv[0] = *(const f16x8*)p; hv[1] = *(const f16x8*)((const f16*)p + 8); } }
    DI f16x8 get(int i) const { if (F32) { const f32x4 a = f[2 * i], b = f[2 * i + 1]; f16x8 r; r[0] = (f16)a[0]; r[1] = (f16)a[1]; r[2] = (f16)a[2]; r[3] = (f16)a[3]; r[4] = (f16)b[0]; r[5] = (f16)b[1]; r[6] = (f16)b[2]; r[7] = (f16)b[3]; return r; } return hv[i]; } };
template <bool SRC_F32, class ChunkFn>
DI void compress_item(LAS unsigned char* lds, ChunkFn chunkp  , int c0, const f16* w1t, const float* peb, const f16* w2t  , const float* b2, const float* kg, float* out, f16* out16, f16* outT16) {
    typedef typename std::conditional<SRC_F32, float, f16>::type T;
    const int tid = ltid(), wave = tid >> 6, lane = tid & 63, wm = wave >> 2, wq = wave & 3, r = lane & 31, h = lane >> 5;
    LAS f16* As = (LAS f16*)lds;
    LAS f16* Bs = (LAS f16*)(lds + 2 * 18432);
    f32x16 acc[2][2];
#pragma unroll
    for (int a = 0; a < 2; ++a)
#pragma unroll
        for (int b = 0; b < 2; ++b)
#pragma unroll
            for (int i = 0; i < 16; ++i) acc[a][b][i] = 0.f;
    constexpr int NA = SRC_F32 ? 4 : 2, AE = SRC_F32 ? 4 : 8;
    const int arow = SRC_F32 ? tid >> 4 : tid >> 3, aseg = SRC_F32 ? tid & 15 : tid & 7, brow = tid >> 3, bsg = tid & 7;
    const T* ap[NA];
#pragma unroll
    for (int i = 0; i < NA; ++i) { int ch = c0 + arow + (128 / NA) * i; ch = ch < 1023 ? ch : 1023; ap[i] = (const T*)chunkp(ch) + aseg * AE; }
    const f16* bsrc = w1t + (size_t)brow * 2048 + bsg * 8;
    Raw16<SRC_F32> ra[3]; f16x8 rb[3][4];
    auto ldab = [&](int sl, int kb) {
#pragma unroll
        for (int i = 0; i < NA; ++i) { if (SRC_F32) ra[sl].f[i] = *(const f32x4*)((const float*)ap[i] + kb * 256); else ra[sl].hv[i] = *(const f16x8*)((const f16*)ap[i] + kb * 256); }
#pragma unroll
        for (int i = 0; i < 4; ++i) rb[sl][i] = ld_h8(bsrc + (size_t)(i & 1) * 64 * 2048 + (i >> 1) * 1024 + kb * 64 + 0); };
    auto stab = [&](int sl, int nx) {
#pragma unroll
        for (int i = 0; i < NA; ++i) {
            if (SRC_F32) { const f32x4 v = ra[sl].f[i]; f16x4 hq; hq[0] = (f16)v[0]; hq[1] = (f16)v[1]; hq[2] = (f16)v[2]; hq[3] = (f16)v[3]; *(LAS f16x4*)(As + nx * 9216 + (arow + 32 * i) * 72 + 4 * aseg) = hq; }
            else *(LAS f16x8*)(As + nx * 9216 + (arow + 64 * i) * 72 + 8 * aseg) = ra[sl].hv[i]; }
#pragma unroll
        for (int i = 0; i < 4; ++i) *(LAS f16x8*)(Bs + nx * 18432 + (brow + 64 * i) * 72 + 8 * bsg) = rb[sl][i]; };
#pragma unroll
    for (int i = 0; i < 3; ++i) ldab(i, i);
    __syncthreads();
    stab(0, 0);
    ldab(0, 3);
    lds_barrier();
#pragma unroll
    for (int kb = 0; kb < 16; ++kb) {
        const int cur = kb & 1;
        const LAS f16* Ac = As + cur * 9216 + (64 * wm + r) * 72 + 8 * h; const LAS f16* Bc = Bs + cur * 18432 + (64 * wq + r) * 72 + 8 * h;
#pragma unroll
        for (int ks = 0; ks < 4; ++ks) {
            const f16x8 a0 = *(const LAS f16x8*)(Ac + 16 * ks), a1 = *(const LAS f16x8*)(Ac + 32 * 72 + 16 * ks), b0 = *(const LAS f16x8*)(Bc + 16 * ks), b1 = *(const LAS f16x8*)(Bc + 32 * 72 + 16 * ks);
            acc[0][0] = __builtin_amdgcn_mfma_f32_32x32x16_f16(a0, b0, acc[0][0], 0, 0, 0); acc[0][1] = __builtin_amdgcn_mfma_f32_32x32x16_f16(a0, b1, acc[0][1], 0, 0, 0);
            acc[1][0] = __builtin_amdgcn_mfma_f32_32x32x16_f16(a1, b0, acc[1][0], 0, 0, 0); acc[1][1] = __builtin_amdgcn_mfma_f32_32x32x16_f16(a1, b1, acc[1][1], 0, 0, 0);
        }
        if (kb + 1 < 16) { const int nx = cur ^ 1, sl = (kb + 1) % 3;
            stab(sl, nx);
            if (kb + 4 < 16) ldab(sl, kb + 4); }
        lds_barrier();
    }
    LAS float* SL = (LAS float*)lds;
    LAS f16* HS = (LAS f16*)(lds + 65536);
    if (wq >= 2) {
#pragma unroll
        for (int a = 0; a < 2; ++a)
#pragma unroll
            for (int b = 0; b < 2; ++b)
#pragma unroll
                for (int i = 0; i < 16; ++i) SL[(64 * wm + 32 * a + (i & 3) + 8 * (i >> 2) + 4 * h) * 128 + 64 * (wq - 2) + 32 * b + r] = acc[a][b][i];
    }
    __syncthreads();
    if (wq < 2) {
#pragma unroll
        for (int a = 0; a < 2; ++a)
#pragma unroll
            for (int b = 0; b < 2; ++b) { const int f = 64 * wq + 32 * b + r; float pb = 0.f;
#pragma unroll
                for (int p8 = 0; p8 < 8; ++p8) pb += peb[p8 * 128 + f];
#pragma unroll
                for (int i = 0; i < 16; ++i) { const int m = 64 * wm + 32 * a + (i & 3) + 8 * (i >> 2) + 4 * h; const float sv = m < 127 ? SL[(m + 1) * 128 + f] : 0.f;
                    HS[m * 136 + f] = (f16)siluf_(acc[a][b][i] + sv + pb); } }
    }
    __syncthreads();
    {
        const int fr = lane & 15, q = lane >> 4;
        f32x4 o[4];
#pragma unroll
        for (int et = 0; et < 4; ++et) o[et] = (f32x4){0.f, 0.f, 0.f, 0.f};
#pragma unroll
        for (int ks = 0; ks < 4; ++ks) { const f16x8 av = *(const LAS f16x8*)(HS + (16 * wave + fr) * 136 + 32 * ks + 8 * q);
#pragma unroll
            for (int et = 0; et < 4; ++et) o[et] = __builtin_amdgcn_mfma_f32_16x16x32_f16(av, ld_h8(w2t + (size_t)(16 * et + fr) * 128 + 32 * ks + 8 * q), o[et], 0, 0, 0); }
        float bb[4], gg[4];
#pragma unroll
        for (int et = 0; et < 4; ++et) { bb[et] = b2[16 * et + fr]; gg[et] = kg ? kg[16 * et + fr] : 1.f; }
#pragma unroll
        for (int j = 0; j < 4; ++j) {
            const int row = 16 * wave + 4 * q + j, blk = c0 + row; float v[4], ss = 0.f;
#pragma unroll
            for (int et = 0; et < 4; ++et) { v[et] = o[et][j] + bb[et]; ss += v[et] * v[et]; }
            if (kg) { ss += __shfl_xor(ss, 1); ss += __shfl_xor(ss, 2); ss += __shfl_xor(ss, 4); ss += __shfl_xor(ss, 8); const float rn = rsqrtf(ss * (1.f / 64.f) + EPS);
#pragma unroll
                for (int et = 0; et < 4; ++et) v[et] = v[et] * rn * gg[et]; }
            const bool okrow = row < 127 && blk < 1023, wr16 = row < 127 && blk < 1024;
#pragma unroll
            for (int et = 0; et < 4; ++et) { const float x = okrow ? v[et] : 0.f; const int e = 16 * et + fr;
                if (out && okrow) out[(size_t)blk * 64 + e] = x;
                if (out16 && wr16) out16[(size_t)blk * 64 + e] = (f16)x;
                if (outT16 && wr16) outT16[(size_t)e * 1024 + vt_pos(blk)] = (f16)x; }
        }
    }
    __syncthreads();
}

struct PromptKV {
    const f16 *ks, *vs, *kw, *vw;
    DI void krow_sel(int pos, float (&k)[64]) const { const f16* p = ks + (size_t)pos * 64;
#pragma unroll
        for (int i = 0; i < 8; ++i) { const f16x8 v = ld_h8(p + i * 8);
#pragma unroll
            for (int j = 0; j < 8; ++j) k[i * 8 + j] = (float)v[j]; } }
    DI float v_sel(int pos, int d) const { return (float)vs[(size_t)pos * 64 + d]; }
    DI void krow_win(int pos, float (&k)[64]) const { const f16* p = kw + (size_t)pos * 64;
#pragma unroll
        for (int i = 0; i < 8; ++i) { const f16x8 v = ld_h8(p + i * 8);
#pragma unroll
            for (int j = 0; j < 8; ++j) k[i * 8 + j] = (float)v[j]; } }
    DI float v_win(int pos, int d) const { return (float)vw[(size_t)pos * 64 + d]; }
};
struct SampleKV {
    const float* ckv; const int* pt; const float* cwin; const float* nks; const float* nvs; const float* nkw; const float* nvw;
    DI const float* prow(int pos, int slot) const { return ckv + ((size_t)pt[pos >> 7] * 128 + (pos & 127)) * 256 + slot * 64; }
    DI void ld64(const float* p, float (&k)[64]) const {
#pragma unroll
        for (int i = 0; i < 16; ++i) { const f32x4 v = *(const f32x4*)(p + i * 4); k[i * 4] = v[0]; k[i * 4 + 1] = v[1]; k[i * 4 + 2] = v[2]; k[i * 4 + 3] = v[3]; } }
    DI void krow_sel(int pos, float (&k)[64]) const { ld64(pos < PAST ? prow(pos, 2) : nks, k); }
    DI float v_sel(int pos, int d) const { return pos < PAST ? prow(pos, 3)[d] : nvs[d]; }
    DI void krow_win(int pos, float (&k)[64]) const { ld64(pos < PAST ? cwin + (size_t)(pos - (PAST - 512)) * 128 : nkw, k); }
    DI float v_win(int pos, int d) const { return pos < PAST ? cwin[(size_t)(pos - (PAST - 512)) * 128 + 64 + d] : nvw[d]; }
};
template <class KV>
DI void nsa_token(LAS float* wl, int qpos, const float* KC, const float* VC, const KV& kv, const float* gates  , float (&o)[4]) {
    const int lane = ltid() & 63;
    LAS float* sc = wl; LAS float* qs = wl + 4096; LAS int* sel = (LAS int*)(wl + 4096 + 256);
    const int cur = qpos >> 6;
    const int ncv = qpos >= 31 ? ((qpos - 31) >> 4) + 1 : 0;
    float oc[4] = {0.f, 0.f, 0.f, 0.f}, os[4] = {0.f, 0.f, 0.f, 0.f}, ow[4] = {0.f, 0.f, 0.f, 0.f};
    {
        float mx[4] = {-3e38f, -3e38f, -3e38f, -3e38f};
        for (int c = lane; c < ncv; c += 64) {
            asm volatile("" ::: "memory");
            float s[4] = {0.f, 0.f, 0.f, 0.f}; const float* kp = KC + (size_t)c * 64;
#pragma unroll
            for (int d4 = 0; d4 < 16; ++d4) { const f32x4 kvv = *(const f32x4*)(kp + d4 * 4);
#pragma unroll
                for (int j = 0; j < 4; ++j) { const f32x4 q = *(const LAS f32x4*)(qs + (d4 * 4 + j) * 4); s[0] += q[0] * kvv[j]; s[1] += q[1] * kvv[j]; s[2] += q[2] * kvv[j]; s[3] += q[3] * kvv[j]; } }
#pragma unroll
            for (int hh = 0; hh < 4; ++hh) { s[hh] *= 0.125f; sc[hh * 1024 + c] = s[hh]; mx[hh] = fmaxf(mx[hh], s[hh]); }
        }
        float inv[4];
#pragma unroll
        for (int hh = 0; hh < 4; ++hh) { mx[hh] = wmaxf(mx[hh]); float sm = 0.f; for (int c = lane; c < ncv; c += 64) { const float e = __expf(sc[hh * 1024 + c] - mx[hh]); sc[hh * 1024 + c] = e; sm += e; } sm = wsum(sm); inv[hh] = ncv > 0 ? 1.f / sm : 0.f; }
        for (int c = lane; c < ncv; c += 64) {
#pragma unroll
            for (int hh = 0; hh < 4; ++hh) sc[hh * 1024 + c] *= inv[hh]; }
        __builtin_amdgcn_wave_barrier();
        for (int c = 0; c < ncv; ++c) { const float v = VC[(size_t)c * 64 + lane];
#pragma unroll
            for (int hh = 0; hh < 4; ++hh) oc[hh] += sc[hh * 1024 + c] * v; }
    }
    const int nsel = (cur + 1) < 16 ? (cur + 1) : 16;
    {
        float scv[5];
#pragma unroll
        for (int i = 0; i < 5; ++i) {
            const int j = lane + 64 * i; float v = -3e38f;
            if (j <= cur) {
                if (j == 0 || j == cur || j == cur - 1) v = 3e38f;
                else { float a = 0.f;
#pragma unroll
                    for (int o5 = -1; o5 < 4; ++o5) { const int c = 4 * j + o5; if (c >= 0 && c < ncv) { const float p = (sc[c] + sc[1024 + c]) + (sc[2048 + c] + sc[3072 + c]); a += (o5 == -1 || o5 == 3) ? 0.5f * p : p; } }
                    v = a; }
            }
            scv[i] = v;
        }
        for (int k = 0; k < nsel; ++k) {
            float bv = scv[0]; int bi = lane;
#pragma unroll
            for (int i = 1; i < 5; ++i) if (scv[i] > bv) { bv = scv[i]; bi = lane + 64 * i; }
#pragma unroll
            for (int off = 32; off > 0; off >>= 1) { const float ov = __shfl_xor(bv, off); const int oi = __shfl_xor(bi, off); if (ov > bv || (ov == bv && oi < bi)) { bv = ov; bi = oi; } }
            if (lane == 0) sel[k] = bi;
#pragma unroll
            for (int i = 0; i < 5; ++i) if (lane + 64 * i == bi) scv[i] = -3e38f;
        }
        __builtin_amdgcn_wave_barrier();
    }
    {
        float mx[4] = {-3e38f, -3e38f, -3e38f, -3e38f};
        for (int k = 0; k < nsel; ++k) {
            asm volatile("" ::: "memory");
            const int pos = sel[k] * 64 + lane; float s[4] = {-1e30f, -1e30f, -1e30f, -1e30f};
            if (pos <= qpos) { float kr[64]; kv.krow_sel(pos, kr); s[0] = s[1] = s[2] = s[3] = 0.f;
#pragma unroll
                for (int d = 0; d < 64; ++d) { const f32x4 q = *(const LAS f32x4*)(qs + d * 4); s[0] += q[0] * kr[d]; s[1] += q[1] * kr[d]; s[2] += q[2] * kr[d]; s[3] += q[3] * kr[d]; }
#pragma unroll
                for (int hh = 0; hh < 4; ++hh) s[hh] *= 0.125f; }
#pragma unroll
            for (int hh = 0; hh < 4; ++hh) { sc[hh * 1024 + k * 64 + lane] = s[hh]; mx[hh] = fmaxf(mx[hh], s[hh]); }
        }
        float inv[4];
#pragma unroll
        for (int hh = 0; hh < 4; ++hh) { mx[hh] = wmaxf(mx[hh]); float sm = 0.f; for (int k = 0; k < nsel; ++k) { const float sv = sc[hh * 1024 + k * 64 + lane]; const float e = sv > -1e29f ? __expf(sv - mx[hh]) : 0.f; sc[hh * 1024 + k * 64 + lane] = e; sm += e; } sm = wsum(sm); inv[hh] = 1.f / sm; }
        __builtin_amdgcn_wave_barrier();
        for (int k = 0; k < nsel; ++k) { const int p0 = sel[k] * 64; int nk = qpos - p0 + 1; nk = nk > 64 ? 64 : nk;
            for (int kk = 0; kk < nk; ++kk) { const float v = kv.v_sel(p0 + kk, lane);
#pragma unroll
                for (int hh = 0; hh < 4; ++hh) os[hh] += sc[hh * 1024 + k * 64 + kk] * v; } }
#pragma unroll
        for (int hh = 0; hh < 4; ++hh) os[hh] *= inv[hh];
        __builtin_amdgcn_wave_barrier();
    }
    {
        const int lo = qpos - 512 > 0 ? qpos - 512 : 0, nw = qpos - lo + 1;
        float mx[4] = {-3e38f, -3e38f, -3e38f, -3e38f};
        for (int i = lane; i < nw; i += 64) { asm volatile("" ::: "memory"); float kr[64]; kv.krow_win(lo + i, kr); float s[4] = {0.f, 0.f, 0.f, 0.f};
#pragma unroll
            for (int d = 0; d < 64; ++d) { const f32x4 q = *(const LAS f32x4*)(qs + d * 4); s[0] += q[0] * kr[d]; s[1] += q[1] * kr[d]; s[2] += q[2] * kr[d]; s[3] += q[3] * kr[d]; }
#pragma unroll
            for (int hh = 0; hh < 4; ++hh) { s[hh] *= 0.125f; sc[hh * 1024 + i] = s[hh]; mx[hh] = fmaxf(mx[hh], s[hh]); } }
        float inv[4];
#pragma unroll
        for (int hh = 0; hh < 4; ++hh) { mx[hh] = wmaxf(mx[hh]); float sm = 0.f; for (int i = lane; i < nw; i += 64) { const float e = __expf(sc[hh * 1024 + i] - mx[hh]); sc[hh * 1024 + i] = e; sm += e; } sm = wsum(sm); inv[hh] = 1.f / sm; }
        __builtin_amdgcn_wave_barrier();
        for (int i = 0; i < nw; ++i) { const float v = kv.v_win(lo + i, lane);
#pragma unroll
            for (int hh = 0; hh < 4; ++hh) ow[hh] += sc[hh * 1024 + i] * v; }
#pragma unroll
        for (int hh = 0; hh < 4; ++hh) ow[hh] *= inv[hh];
        __builtin_amdgcn_wave_barrier();
    }
#pragma unroll
    for (int hh = 0; hh < 4; ++hh) o[hh] = gates[hh * 3] * oc[hh] + gates[hh * 3 + 1] * os[hh] + gates[hh * 3 + 2] * ow[hh];
}

template <int KT = 1, class LF, class SF>
DI void tr64(LAS unsigned char* lds, LF lf, SF sf) {
    LAS float* T = (LAS float*)lds;
    const int tid = ltid();
    __syncthreads();
#pragma unroll
    for (int e8 = 0; e8 < 8 * KT; ++e8) { const int e = tid + 512 * e8, kk = e >> 6, nn = e & 63; T[kk * 65 + nn] = lf(kk, nn); }
    __syncthreads();
#pragma unroll
    for (int e8 = 0; e8 < 8 * KT; ++e8) { const int e = tid + 512 * e8, nn = e / (64 * KT), kk = e % (64 * KT); sf(nn, kk, (f16)T[kk * 65 + nn]); }
}

typedef const Args __attribute__((address_space(4)))* ArgP;
struct Ctx { ArgP ap; LAS unsigned char* lds; unsigned char* ws; float* out; int tid, lane, wave, bid, G; };
DI Ctx mkctx(LAS unsigned char* lds) {
    Ctx c; const char __attribute__((address_space(4)))* kp = (const char __attribute__((address_space(4)))*)__builtin_amdgcn_kernarg_segment_ptr();
    asm volatile("" : "+s"(kp));
    c.ap = (ArgP)kp; c.lds = lds; c.ws = c.ap->ws; c.out = c.ap->out;
    int tid = threadIdx.x; asm volatile("" : "+v"(tid));
    c.tid = tid; c.lane = tid & 63; c.wave = __builtin_amdgcn_readfirstlane(tid >> 6); c.bid = blockIdx.x; c.G = gridDim.x;
    return c;
}
#define INP(i) ((const float*)c.ap->in[i])
#define WSF(off) ((float*)(c.ws + (off)))
#define WSH(off) ((f16*)(c.ws + (off)))

DI void ph_prologue(LAS unsigned char* lds_) {
    const Ctx c = mkctx(lds_); LAS unsigned char* lds = c.lds; const int tid = c.tid, bid = c.bid, G = c.G;
    const float* c_p = INP(I_CP); const float* c_s = INP(I_CS); const float* w_ada = INP(I_WADA); const float* b_ada = INP(I_BADA);
    const float* w_in = INP(I_WIN); const float* w_out = INP(I_WOUT); const float* w1 = INP(I_W1);
    float* ADA = WSF(WS_ADA); float* BIAS = WSF(WS_BIAS); float* PEB = WSF(WS_PEB); f16* WTIN = WSH(WS_WTIN); f16* WTOUT = WSH(WS_WTOUT); f16* W1T = WSH(WS_W1T);
    constexpr int N_ADA = 192, N_WTIN = 480, N_WTOUT = 128, N_W1T = 64, N_PEB = 32, N_W2T = 8, N_ALL = N_ADA + N_WTIN + N_WTOUT + N_W1T + N_PEB + N_W2T + 1;
    constexpr int XA = 2, NO = 256 - N_ADA;
    const bool reb = G == 256; const int n_mine = reb ? (bid < N_ADA ? 1 + XA : (N_ALL - N_ADA - XA * N_ADA - (bid - N_ADA) + NO - 1) / NO) : (N_ALL - bid + G - 1) / G;
    for (int k = 0; k < n_mine; ++k) {
        const int it = !reb ? bid + k * G : (bid < N_ADA ? (k == 0 ? bid : N_ADA + XA * bid + (k - 1)) : N_ADA + XA * N_ADA + (bid - N_ADA) + NO * k);
        int i = it;
        if (i < N_ADA) { const int half = i & 1, j = i >> 1, l = j / 48, n0 = (j % 48) * 64, m0 = half * 17;
            skinny_item<18>(lds, w_ada + (size_t)l * 1024 * 3072, 3072, n0, 64, half ? 16 : 17,
                [&](int m, int k) { const int mm = m0 + m; return siluf_(mm < 32 ? c_s[mm * 1024 + k] : c_p[k]); },
                [&](int m, int n, float v) { ADA[((size_t)l * 33 + m0 + m) * 3072 + n] = v + b_ada[l * 3072 + n]; });
            continue; }
        i -= N_ADA;
        if (i < N_WTIN) { const int l = i / 240, r = i % 240, n0 = (r / 4) * 64, k0 = (r % 4) * 256; const float* src = w_in + (size_t)l * 1024 * DIN; f16* dst = WTIN + (size_t)l * NPD * 1024;
            tr64<4>(lds, [&](int kk, int nn) { const int sc = src_col(n0 + nn); return sc >= 0 ? src[(size_t)(k0 + kk) * DIN + sc] : 0.f; },
                      [&](int nn, int kk, f16 v) { dst[(size_t)(n0 + nn) * 1024 + k0 + kk] = v; });
            continue; }
        i -= N_WTIN;
        if (i < N_WTOUT) { const int l = i / 64, r = i % 64, n0 = (r / 4) * 64, k0 = (r % 4) * 256; const float* src = w_out + (size_t)l * 1024 * 1024; f16* dst = WTOUT + (size_t)l * 1024 * 1024;
            tr64<4>(lds, [&](int kk, int nn) { return src[(size_t)(k0 + kk) * 1024 + n0 + nn]; },
                      [&](int nn, int kk, f16 v) { dst[(size_t)(n0 + nn) * 1024 + k0 + kk] = v; });
            continue; }
        i -= N_WTOUT;
        if (i < N_W1T) { const int ls = i / 16, r = i % 16, k0 = (r / 2) * 256, n0 = (r % 2) * 64; const float* src = w1 + (size_t)ls * 2048 * 128; f16* dst = W1T + (size_t)ls * 128 * 2048;
            tr64<4>(lds, [&](int kk, int nn) { return src[(size_t)(k0 + kk) * 128 + n0 + nn]; },
                      [&](int nn, int kk, f16 v) { dst[(size_t)(n0 + nn) * 2048 + k0 + kk] = v; });
            continue; }
        i -= N_W1T;
        if (i < N_PEB) { const int ls = i >> 3, ks8 = i & 7; const float* pe = INP(I_PE) + (size_t)ls * 2048 + ks8 * 256; const float* w = w1 + ((size_t)ls * 2048 + ks8 * 256) * 128; const float* b1 = INP(I_B1) + ls * 128;
            LAS float* R = (LAS float*)lds; const int f = tid & 127, kq = tid >> 7; float sacc = 0.f;
            __syncthreads();
#pragma unroll 16
            for (int k = kq * 64; k < kq * 64 + 64; ++k) sacc += pe[k] * w[(size_t)k * 128 + f];
            R[kq * 128 + f] = sacc; __syncthreads();
            if (tid < 128) WSF(WS_PEBP)[(ls * 8 + ks8) * 128 + tid] = (ks8 == 0 ? b1[tid] : 0.f) + (R[tid] + R[128 + tid]) + (R[256 + tid] + R[384 + tid]);
            __syncthreads();
            continue; }
        i -= N_PEB;
        if (i < N_W2T) { const int ls = i >> 1, f0 = (i & 1) * 64; const float* src = INP(I_W2) + (size_t)ls * 128 * 64; f16* dst = WSH(WS_W2T) + (size_t)ls * 64 * 128;
            tr64(lds, [&](int kk, int nn) { return src[(size_t)(f0 + kk) * 64 + nn]; },
                      [&](int nn, int kk, f16 v) { dst[(size_t)nn * 128 + f0 + kk] = v; });
            continue; }
        for (int e = tid; e < 2 * NPD; e += 512) BIAS[e] = 0.f;
    }
}

DI void ph_sample_compress(LAS unsigned char* lds_) {
    const Ctx c = mkctx(lds_);
    const float* w2 = INP(I_W2); const float* b2 = INP(I_B2); const float* k_g = INP(I_KG); const float* cache_kv = INP(I_CKV); const int* page_table = (const int*)c.ap->in[I_PT];
    f16* W1T = WSH(WS_W1T); float* PEB = WSF(WS_PEBP); float* KCS = WSF(WS_KCS); float* VCS = WSF(WS_VCS);
    for (int it = c.bid; it < 1152; it += c.G) {
        const int grp = it < 1024 ? it & 7 : 8, st_ = it < 1024 ? it >> 3 : it - 1024, slot = st_ & 1, b = (st_ >> 1) & 31, l = st_ >> 6;
        const float* ckv = cache_kv + (size_t)l * NPOOL * 128 * 256; const int* pt = page_table + b * 128;
        compress_item<true>(c.lds, [&](int ch) { return (const void*)(ckv + ((size_t)pt[ch >> 3] * 128 + (ch & 7) * 16) * 256 + slot * 64); }, grp * 127,
                            W1T + (size_t)(l * 2 + slot) * 128 * 2048, PEB + (l * 2 + slot) * 1024, WSH(WS_W2T) + (size_t)(l * 2 + slot) * 64 * 128, b2 + (l * 2 + slot) * 64,
                            slot == 0 ? k_g + l * 192 : nullptr, (slot == 0 ? KCS : VCS) + (size_t)(l * NB + b) * 1024 * 64, nullptr, nullptr);
    }
}
DI void ph_prep(LAS unsigned char* lds_) {
    const Ctx c = mkctx(lds_); const int tid = c.tid, lane = c.lane, wave = c.wave, bid = c.bid, G = c.G;
    float* ADA = WSF(WS_ADA); float* BIAS = WSF(WS_BIAS);
    {
        const f16* WTIN = WSH(WS_WTIN);
        const bool lite = G == 256;
        const int pb = lite ? bid - 128 : bid, pG = lite ? 128 : G;
        if (pb >= 0)
        for (int col0 = pb * 8 + wave; col0 < 2 * NPD; col0 += pG * 32) {
            f16x8 w[4][2]; f32x4 sv[4][4];
#pragma unroll
            for (int k = 0; k < 4; ++k) { int col = col0 + k * pG * 8; col = col < 2 * NPD ? col : 2 * NPD - 1; const int l = col / NPD;
                const float* sh = ADA + ((size_t)l * 33 + 32) * 3072 + lane * 16; const f16* wp = WTIN + (size_t)col * 1024 + lane * 16;
                w[k][0] = ld_h8(wp); w[k][1] = ld_h8(wp + 8);
#pragma unroll
                for (int i = 0; i < 4; ++i) sv[k][i] = *(const f32x4*)(sh + 4 * i); }
#pragma unroll
            for (int k = 0; k < 4; ++k) { const int col = col0 + k * pG * 8; float acc = 0.f;
#pragma unroll
                for (int i = 0; i < 8; ++i) acc += sv[k][i >> 2][i & 3] * (float)w[k][0][i] + sv[k][2 + (i >> 2)][i & 3] * (float)w[k][1][i];
                acc = wsum(acc); if (lane == 0 && col < 2 * NPD) BIAS[col] = acc; } }
    }
    const float* ng = INP(I_NG);
    if (bid == 0) { float* GNX = WSF(WS_GNX); const float* sc1 = ADA + (size_t)(33 + 32) * 3072 + 1024;
        for (int k = tid; k < 1024; k += 512) GNX[k] = ng[1024 + k] * (1.f + sc1[k]); }
    const float* ada_p = ADA + (size_t)32 * 3072; const float* x_p = INP(I_XP); f16* A16 = WSH(WS_A16); float* RSSP = WSF(WS_RSSP);
    float gp[16];
#pragma unroll
    for (int i = 0; i < 4; ++i) { const f32x4 g4 = *(const f32x4*)(ng + i * 256 + lane * 4), s4 = *(const f32x4*)(ada_p + 1024 + i * 256 + lane * 4);
#pragma unroll
        for (int j = 0; j < 4; ++j) gp[i * 4 + j] = g4[j] * (1.f + s4[j]); }
    const bool lite2 = G == 256; const int pb2 = lite2 ? bid - 128 : bid, pG2 = lite2 ? 128 : G;
    if (pb2 >= 0)
    for (int row0 = pb2 * 8 + wave; row0 < SEQ; row0 += pG2 * 32) {
        f32x4 v[4][4];
#pragma unroll
        for (int k = 0; k < 4; ++k) { int row = row0 + k * pG2 * 8; row = row < SEQ ? row : SEQ - 1;
#pragma unroll
            for (int i = 0; i < 4; ++i) v[k][i] = *(const f32x4*)(x_p + (size_t)row * 1024 + i * 256 + lane * 4); }
#pragma unroll
        for (int k = 0; k < 4; ++k) { const int row = row0 + k * pG2 * 8; float ss = 0.f;
            if (row < SEQ) {
#pragma unroll
                for (int i = 0; i < 4; ++i) { const f32x4 u = v[k][i]; ss += (u[0] * u[0] + u[1] * u[1]) + (u[2] * u[2] + u[3] * u[3]);
                    f16x4 h; h[0] = (f16)(u[0] * gp[i * 4]); h[1] = (f16)(u[1] * gp[i * 4 + 1]); h[2] = (f16)(u[2] * gp[i * 4 + 2]); h[3] = (f16)(u[3] * gp[i * 4 + 3]);
                    *(f16x4*)(A16 + (size_t)row * 1024 + i * 256 + lane * 4) = h; }
                ss = wsum(ss);
                if (lane < 16) RSSP[(size_t)row * 16 + lane] = lane == 0 ? ss : 0.f; } }
    }
}

template <int NT  , class OFn>
DI void sample_gemm_item(LAS unsigned char* lds, const f16* Bt, int n0, OFn ofn) {
    constexpr int KW = 8 / NT, KL = 1024 / KW;
    const int tid = ltid(), wave = tid >> 6, lane = tid & 63, wn = wave % NT, wk = wave / NT, r = lane & 31, h = lane >> 5;
    const LAS f16* Ah = (const LAS f16*)lds + r * 1032 + wk * KL + 8 * h; const f16* bp = Bt + (size_t)(n0 + 32 * wn + r) * 1024 + wk * KL + 8 * h;
    f32x16 acc;
#pragma unroll
    for (int i = 0; i < 16; ++i) acc[i] = 0.f;
#pragma unroll 8
    for (int st = 0; st < KL / 16; ++st) acc = __builtin_amdgcn_mfma_f32_32x32x16_f16(*(const LAS f16x8*)(Ah + 16 * st), ld_h8(bp + 16 * st), acc, 0, 0, 0);
    LAS float* RED = (LAS float*)(lds + 67584);
#pragma unroll
    for (int i = 0; i < 16; ++i) RED[(wk * 32 + (i & 3) + 8 * (i >> 2) + 4 * h) * (32 * NT) + 32 * wn + r] = acc[i];
    __syncthreads();
    for (int e = tid; e < 1024 * NT; e += 512) { float v = 0.f;
#pragma unroll
        for (int w = 0; w < KW; ++w) v += RED[w * 1024 * NT + e];
        ofn(e / (32 * NT), n0 + e % (32 * NT), v); }
    __syncthreads();
}
DI void ph_inproj(LAS unsigned char* lds_, int l) {
    const Ctx c = mkctx(lds_);
    pg8::Gemm g{WSH(WS_A16), WSH(WS_WTIN) + (size_t)l * NPD * 1024, SEQ, NPD, 1024}; pg8::StaticOrder S; S.init(SEQ, NPD, c.G, c.bid);
    EpiIn E{WSH(WS_PROJ), WSF(WS_RSSP), WSF(WS_BIAS) + l * NPD, c.out + O_KVP + (size_t)l * SEQ * 256};
    pg8::gemm_phase<EpiIn, pg8::StaticOrder>(c.lds, g, S, E);
    __syncthreads();
}
DI void ph_hsample(LAS unsigned char* lds_, int l) {
    const Ctx c = mkctx(lds_); const int lane = c.lane;
    if (c.bid >= 4) return;
    const int m = c.bid * 8 + c.wave;
    const float* xr = (l == 0 ? INP(I_XS) : WSF(WS_XS1)) + (size_t)m * 1024; const float* ad = WSF(WS_ADA) + ((size_t)l * 33 + m) * 3072; const float* ng = INP(I_NG) + l * 1024; f16* hs = WSH(WS_HS16) + (size_t)m * 1024;
    f32x4 xv[4]; float ss = 0.f;
#pragma unroll
    for (int i = 0; i < 4; ++i) { xv[i] = *(const f32x4*)(xr + i * 256 + lane * 4); ss += (xv[i][0] * xv[i][0] + xv[i][1] * xv[i][1]) + (xv[i][2] * xv[i][2] + xv[i][3] * xv[i][3]); }
    const float rn = rsqrtf(wsum(ss) * (1.f / 1024.f) + EPS);
#pragma unroll
    for (int i = 0; i < 4; ++i) { const int k = i * 256 + lane * 4; const f32x4 g = *(const f32x4*)(ng + k), sc = *(const f32x4*)(ad + 1024 + k), sh = *(const f32x4*)(ad + k); f16x4 hv;
#pragma unroll
        for (int j = 0; j < 4; ++j) hv[j] = (f16)(xv[i][j] * rn * g[j] * (1.f + sc[j]) + sh[j]);
        *(f16x4*)(hs + k) = hv; }
}
DI void ph_inproj_sample(LAS unsigned char* lds_, int l) {
    const Ctx c = mkctx(lds_); const int tid = c.tid;
    const int it = c.bid - (c.G - 64);
    if (it < 0 || it >= 60) return;
    float* PROJS = WSF(WS_PROJS); const f16* HS = WSH(WS_HS16); LAS f16* Ah = (LAS f16*)c.lds;
    __syncthreads();
#pragma unroll
    for (int i = 0; i < 8; ++i) { const int e = (tid + 512 * i) * 8; *(LAS f16x8*)(Ah + (e >> 10) * 1032 + (e & 1023)) = ld_h8(HS + e); }
    __syncthreads();
    sample_gemm_item<2>(c.lds, WSH(WS_WTIN) + (size_t)l * NPD * 1024, it * 64, [&](int m, int n, float v) { PROJS[m * NPD + n] = v; });
}

#define PT(t) (P + (size_t)(t) * SEQ * 256)
DI void ph_ssd_local(LAS unsigned char* lds_, int l) {
    const Ctx c = mkctx(lds_); LAS unsigned char* lds = c.lds; const int tid = c.tid, lane = c.lane, wave = c.wave;
    const f16* P = WSH(WS_PROJ); f16* ACT = WSH(WS_ACT); float* YD = WSF(WS_YD); float* CST = WSF(WS_CST); float* ACS = WSF(WS_ACS); float* CDEC = WSF(WS_CDEC); float* out = c.out;
    const float* dtb = INP(I_DTB) + l * 4; const float* alog = INP(I_ALOG) + l * 4; const float* cw = INP(I_BCW) + l * 4 * 768; const float* cb = INP(I_BCB) + l * 768;
    LAS f16* Bm = (LAS f16*)lds; LAS f16* BT = (LAS f16*)(lds + 34816); LAS f16* Cm = (LAS f16*)(lds + 69632); LAS f16* XT = (LAS f16*)(lds + 104448);
    LAS float* acs = (LAS float*)(lds + 139264); LAS float* dtl = acs + 256; LAS f16* te16 = (LAS f16*)(dtl + 256);
    for (int it = c.bid; it < 256; it += c.G) {
        const int ch_ = it >> 1, g = it & 1, t0 = ch_ * 128;
        __syncthreads();
        if (tid < 256) { const int hh = tid >> 7, lt = tid & 127, hd = 2 * g + hh; const float raw = (float)PT(13)[(size_t)(t0 + lt) * 256 + 128 + hd];
            const float dt = softplusf_(raw + dtb[hd]); dtl[hh * 128 + lt] = dt; acs[hh * 128 + lt] = dt * (-__expf(alog[hd])); }
        __syncthreads();
        if (tid == 0 || tid == 64) { const int hh = tid >> 6; float sacc = 0.f; for (int i = 0; i < 128; ++i) { sacc += acs[hh * 128 + i]; acs[hh * 128 + i] = sacc; } }
        __syncthreads();
        if (tid < 256) { const int hh = tid >> 7, lt = tid & 127, hd = 2 * g + hh; const float av = acs[hh * 128 + lt], ae = acs[hh * 128 + 127];
            te16[hh * 128 + lt] = (f16)__expf(ae - av); ACS[(size_t)(t0 + lt) * 4 + hd] = av; if (lt == 127) CDEC[ch_ * 4 + hd] = __expf(ae); }
#pragma unroll 3
        for (int e = tid; e < 128 * 48; e += 512) {
            const int lt = (e >> 2) & 127, cg = (e >> 9) * 4 + (e & 3), reg = cg >> 4, c8 = (cg & 15) * 8, t = t0 + lt, col = 128 * g + c8, ch = reg * 256 + col;
            const f16* src = PT(5 + reg) + col; float y[8]; f16x8 rawt;
#pragma unroll
            for (int i = 0; i < 8; ++i) y[i] = cb[ch + i];
#pragma unroll
            for (int k = 0; k < 4; ++k) { const int tt = t - 3 + k; f16x8 v; if (tt >= 0) v = ld_h8(src + (size_t)tt * 256); else {
#pragma unroll
                    for (int i = 0; i < 8; ++i) v[i] = (f16)0.f; }
                if (k == 3) rawt = v;
#pragma unroll
                for (int i = 0; i < 8; ++i) y[i] += cw[k * 768 + ch + i] * (float)v[i]; }
            f16x8 act;
#pragma unroll
            for (int i = 0; i < 8; ++i) { y[i] = siluf_(y[i]); act[i] = (f16)y[i]; }
            *(f16x8*)(ACT + (size_t)t * 768 + ch) = act;
            if (reg == 0) { const int hh = c8 >> 6; const float sdt = dtl[hh * 128 + lt] * 64.f;
#pragma unroll
                for (int i = 0; i < 8; ++i) XT[(c8 + i) * 136 + lt] = (f16)(y[i] * sdt); }
            else if (reg == 1) { *(LAS f16x8*)(Bm + lt * 136 + c8) = act;
#pragma unroll
                for (int i = 0; i < 8; ++i) BT[(c8 + i) * 136 + lt] = act[i]; }
            else *(LAS f16x8*)(Cm + lt * 136 + c8) = act;
            if (t >= SEQ - 3) { float* so = out + O_BCP + (size_t)l * 2304 + (t - (SEQ - 3)) * 768 + ch;
#pragma unroll
                for (int i = 0; i < 8; ++i) so[i] = (float)rawt[i]; }
        }
        __syncthreads();
        const int fr = lane & 15, q = lane >> 4, w = wave;
        f32x4 gt[8];
#pragma unroll
        for (int mt = 0; mt < 8; ++mt) { gt[mt] = (f32x4){0.f, 0.f, 0.f, 0.f};
            if (mt <= w) {
#pragma unroll
                for (int ks = 0; ks < 4; ++ks) { const f16x8 av = *(const LAS f16x8*)(Bm + (16 * mt + fr) * 136 + 32 * ks + 8 * q), bv = *(const LAS f16x8*)(Cm + (16 * w + fr) * 136 + 32 * ks + 8 * q);
                    gt[mt] = __builtin_amdgcn_mfma_f32_16x16x32_f16(av, bv, gt[mt], 0, 0, 0); } } }
#pragma unroll
        for (int hh = 0; hh < 2; ++hh) {
            const int lrow = 16 * w + fr; const float al = acs[hh * 128 + lrow];
            f32x4 ya[4];
#pragma unroll
            for (int pt = 0; pt < 4; ++pt) ya[pt] = (f32x4){0.f, 0.f, 0.f, 0.f};
#pragma unroll
            for (int k2 = 0; k2 < 4; ++k2) {
                if (2 * k2 <= w) {
                    f16x8 af;
#pragma unroll
                    for (int j = 0; j < 8; ++j) { const int m = 32 * k2 + (j < 4 ? 4 * q + j : 16 + 4 * q + (j - 4)); const float gv = j < 4 ? gt[2 * k2][j] : gt[2 * k2 + 1][j - 4];
                        af[j] = (f16)(m <= lrow ? gv * __expf(al - acs[hh * 128 + m]) : 0.f); }
#pragma unroll
                    for (int pt = 0; pt < 4; ++pt) { const LAS f16* xp = XT + (hh * 64 + 16 * pt + fr) * 136 + 32 * k2 + 4 * q; const f16x4 b0 = *(const LAS f16x4*)xp, b1 = *(const LAS f16x4*)(xp + 16);
                        f16x8 bf; bf[0] = b0[0]; bf[1] = b0[1]; bf[2] = b0[2]; bf[3] = b0[3]; bf[4] = b1[0]; bf[5] = b1[1]; bf[6] = b1[2]; bf[7] = b1[3];
                        ya[pt] = __builtin_amdgcn_mfma_f32_16x16x32_f16(af, bf, ya[pt], 0, 0, 0); }
                }
            }
#pragma unroll
            for (int pt = 0; pt < 4; ++pt)
#pragma unroll
                for (int j = 0; j < 4; ++j) YD[(size_t)(t0 + 16 * w + 4 * q + j) * 256 + (2 * g + hh) * 64 + 16 * pt + fr] = ya[pt][j] * (1.f / 64.f);
#pragma unroll
            for (int pt = 0; pt < 4; ++pt) { f32x4 sa = (f32x4){0.f, 0.f, 0.f, 0.f};
#pragma unroll
                for (int ks = 0; ks < 4; ++ks) { const f16x8 xv = *(const LAS f16x8*)(XT + (hh * 64 + 16 * pt + fr) * 136 + 32 * ks + 8 * q), tv = *(const LAS f16x8*)(te16 + hh * 128 + 32 * ks + 8 * q);
                    const f16x8 bv = *(const LAS f16x8*)(BT + (16 * w + fr) * 136 + 32 * ks + 8 * q);
                    sa = __builtin_amdgcn_mfma_f32_16x16x32_f16(xv * tv, bv, sa, 0, 0, 0); }
#pragma unroll
                for (int j = 0; j < 4; ++j) CST[((size_t)(ch_ * 4 + 2 * g + hh) * 64 + 16 * pt + 4 * q + j) * 128 + 16 * w + fr] = sa[j] * (1.f / 64.f); }
        }
    }
    __syncthreads();
}
DI void ph_mix_a(LAS unsigned char* lds_, int l) {
    const Ctx c = mkctx(lds_); const int tid = c.tid;
    const f16* P = WSH(WS_PROJ); f16* Y16 = WSH(WS_Y16); float* out = c.out; const float* scw = INP(I_SCW) + l * 768;
    for (int it = c.bid; it < 256; it += c.G) {
        const int c0 = (tid & 31) * 8; f16x8 hh[4][3], cv[4][3], bb[4], gg[4];
#pragma unroll
        for (int i4 = 0; i4 < 4; ++i4) { const int t = it * 64 + (tid >> 5) + 16 * i4;
#pragma unroll
            for (int k = 0; k < 3; ++k) { const int tt = t - 2 + k >= 0 ? t - 2 + k : 0; hh[i4][k] = ld_h8(PT(0) + (size_t)tt * 256 + c0); cv[i4][k] = ld_h8(PT(2) + (size_t)tt * 256 + c0); }
            bb[i4] = ld_h8(PT(1) + (size_t)t * 256 + c0); gg[i4] = ld_h8(PT(3) + (size_t)t * 256 + c0); }
        float sw[3][8];
#pragma unroll
        for (int k = 0; k < 3; ++k) { const f32x4 s0 = *(const f32x4*)(scw + k * 256 + c0), s1 = *(const f32x4*)(scw + k * 256 + c0 + 4);
#pragma unroll
            for (int i = 0; i < 4; ++i) { sw[k][i] = s0[i]; sw[k][4 + i] = s1[i]; } }
#pragma unroll
        for (int i4 = 0; i4 < 4; ++i4) { const int t = it * 64 + (tid >> 5) + 16 * i4; float u[3][8];
#pragma unroll
            for (int k = 0; k < 3; ++k) { const bool ok = t - 2 + k >= 0;
#pragma unroll
                for (int i = 0; i < 8; ++i) u[k][i] = ok ? (float)cv[i4][k][i] * (float)hh[i4][k][i] : 0.f; }
            f16x8 o;
#pragma unroll
            for (int i = 0; i < 8; ++i) { const float y = sw[0][i] * u[0][i] + sw[1][i] * u[1][i] + sw[2][i] * u[2][i]; o[i] = (f16)(siluf_((float)gg[i4][i]) * (float)bb[i4][i] * y); }
            *(f16x8*)(Y16 + (size_t)t * 1024 + c0) = o;
            if (t >= SEQ - 2) { float* so = out + O_SCP + (size_t)l * 512 + (t - (SEQ - 2)) * 256 + c0;
#pragma unroll
                for (int i = 0; i < 8; ++i) so[i] = u[2][i]; }
        }
    }
}
DI void ph_mix_c(LAS unsigned char* lds_, int l) {
    const Ctx c = mkctx(lds_); const int tid = c.tid, lane = c.lane, wave = c.wave;
    const f16* P = WSH(WS_PROJ); f16* Y16 = WSH(WS_Y16); float* out = c.out;
    const float* cfw = INP(I_CFW) + l * 31 * 256; const float* cfb = INP(I_CFB) + l * 256; const float* lng = INP(I_LNG) + l * 256; const float* lnb = INP(I_LNB) + l * 256;
    LAS float* GL = (LAS float*)c.lds;
    f32x4 wt[31];
#pragma unroll
    for (int k = 0; k < 31; ++k) wt[k] = *(const f32x4*)(cfw + k * 256 + lane * 4);
    const f32x4 bias4 = *(const f32x4*)(cfb + lane * 4), g4 = *(const f32x4*)(lng + lane * 4), b4 = *(const f32x4*)(lnb + lane * 4);
    for (int it = c.bid; it < 256; it += c.G) {
        __syncthreads();
        {
            f16x8 ga[6], gb[6];
#pragma unroll
            for (int i6 = 0; i6 < 6; ++i6) { const int e = tid + 512 * i6, rr = e >> 5, c0 = (e & 31) * 8, t = it * 64 - 30 + rr; const int tc = (e < 94 * 32 && t >= 0) ? t : it * 64;
                ga[i6] = ld_h8(PT(8) + (size_t)tc * 256 + c0); gb[i6] = ld_h8(PT(9) + (size_t)tc * 256 + c0); }
#pragma unroll
            for (int i6 = 0; i6 < 6; ++i6) { const int e = tid + 512 * i6, rr = e >> 5, c0 = (e & 31) * 8, t = it * 64 - 30 + rr; f32x4 g0 = (f32x4){0.f, 0.f, 0.f, 0.f}, g1 = g0;
                if (e < 94 * 32) {
                    if (t >= 0) {
#pragma unroll
                        for (int i = 0; i < 4; ++i) { g0[i] = (float)ga[i6][i] * sigmoidf_((float)gb[i6][i]); g1[i] = (float)ga[i6][4 + i] * sigmoidf_((float)gb[i6][4 + i]); }
                        if (t >= SEQ - 30) { float* so = out + O_CFP + (size_t)l * 7680 + (t - (SEQ - 30)) * 256 + c0; *(f32x4*)so = g0; *(f32x4*)(so + 4) = g1; } }
                    *(LAS f32x4*)(GL + rr * 256 + c0) = g0; *(LAS f32x4*)(GL + rr * 256 + c0 + 4) = g1; } }
        }
        __syncthreads();
        {
            const int cc = lane * 4, tb = wave * 8;
            f32x4 u[8]; f16x4 cgv[8];
#pragma unroll
            for (int j = 0; j < 8; ++j) { u[j] = bias4; cgv[j] = *(const f16x4*)(PT(10) + (size_t)(it * 64 + tb + j) * 256 + cc); }
#pragma unroll
            for (int r = 0; r < 38; ++r) { const f32x4 gv = *(const LAS f32x4*)(GL + (tb + r) * 256 + cc);
#pragma unroll
                for (int j = 0; j < 8; ++j) if (r - j >= 0 && r - j <= 30) u[j] += wt[r - j] * gv; }
#pragma unroll
            for (int j = 0; j < 8; ++j) { const int t = it * 64 + tb + j;
                const float mean = wsum((u[j][0] + u[j][1]) + (u[j][2] + u[j][3])) * (1.f / 256.f); const f32x4 d = u[j] - mean;
                const float var = wsum((d[0] * d[0] + d[1] * d[1]) + (d[2] * d[2] + d[3] * d[3])) * (1.f / 256.f); const float rs = rsqrtf(var + EPS);
                const f16x4 cg = cgv[j]; f16x4 o;
#pragma unroll
                for (int i = 0; i < 4; ++i) o[i] = (f16)(siluf_((float)cg[i]) * siluf_(d[i] * rs * g4[i] + b4[i]));
                *(f16x4*)(Y16 + (size_t)t * 1024 + 512 + cc) = o; }
        }
    }
    __syncthreads();
}
DI void ph_mix_d(LAS unsigned char* lds_, int l) {
    const Ctx c = mkctx(lds_); const int tid = c.tid, lane = c.lane, wave = c.wave;
    const f16* P = WSH(WS_PROJ); float* out = c.out; float* kvp_out = out + O_KVP + (size_t)l * SEQ * 256;
    f16* Q16 = WSH(WS_Q16); f16* KS16 = WSH(WS_KS16); f16* KW16 = WSH(WS_KW16); f16* VST16 = WSH(WS_VST16); f16* VWT16 = WSH(WS_VWT16); float* GATES = WSF(WS_GATES);
    const int d4 = (lane & 15) * 4, v4 = lane >> 4;
    const f32x4 qg = *(const f32x4*)(INP(I_QG) + l * 64 + d4), kg1 = *(const f32x4*)(INP(I_KG) + l * 192 + 64 + d4), kg2 = *(const f32x4*)(INP(I_KG) + l * 192 + 128 + d4);
    LAS f16* VSs = (LAS f16*)c.lds; LAS f16* VWs = VSs + 64 * 68;
    if (c.bid < 18 && c.G > 36) return;
    for (int it = c.bid - 18 >= 0 && c.G > 36 ? c.bid - 18 : c.bid; it < 256; it += (c.G > 36 ? c.G - 18 : c.G)) {
        __syncthreads();
        f16x4 xq[8], xk[2], vk[2], xw[2], vw[2]; f16 gt[2];
#pragma unroll
        for (int i = 0; i < 8; ++i) xq[i] = *(const f16x4*)(PT(11) + (size_t)(it * 64) * 256 + (size_t)(wave * 4 + v4 + 32 * i) * 64 + d4);
#pragma unroll
        for (int i = 0; i < 2; ++i) { const size_t t = (size_t)(it * 64 + wave * 4 + v4 + 32 * i);
            xk[i] = *(const f16x4*)(PT(12) + t * 256 + 128 + d4); vk[i] = *(const f16x4*)(PT(12) + t * 256 + 192 + d4); xw[i] = *(const f16x4*)(PT(13) + t * 256 + d4); vw[i] = *(const f16x4*)(PT(13) + t * 256 + 64 + d4); }
#pragma unroll
        for (int i = 0; i < 2; ++i) { int e = tid + 512 * i; e = e < 64 * 12 ? e : 0; gt[i] = PT(13)[(size_t)(it * 64 + e / 12) * 256 + 132 + e % 12]; }
#pragma unroll
        for (int i = 0; i < 8; ++i) { const int vi = wave * 4 + v4 + 32 * i; const size_t off = (size_t)(it * 64) * 256 + (size_t)vi * 64 + d4; const f16x4 x = xq[i];
            const float a0 = (float)x[0], a1 = (float)x[1], a2 = (float)x[2], a3 = (float)x[3]; const float rn = rsqrtf(sum16((a0 * a0 + a1 * a1) + (a2 * a2 + a3 * a3)) * (1.f / 64.f) + EPS);
            f16x4 y; y[0] = (f16)(a0 * rn * qg[0]); y[1] = (f16)(a1 * rn * qg[1]); y[2] = (f16)(a2 * rn * qg[2]); y[3] = (f16)(a3 * rn * qg[3]); *(f16x4*)(Q16 + off) = y; }
#pragma unroll
        for (int i = 0; i < 2; ++i) { const int tl = wave * 4 + v4 + 32 * i, t = it * 64 + tl;
            { const f16x4 x = xk[i], vv = vk[i];
                const float a0 = (float)x[0], a1 = (float)x[1], a2 = (float)x[2], a3 = (float)x[3]; const float rn = rsqrtf(sum16((a0 * a0 + a1 * a1) + (a2 * a2 + a3 * a3)) * (1.f / 64.f) + EPS);
                const f32x4 kn = (f32x4){a0 * rn * kg1[0], a1 * rn * kg1[1], a2 * rn * kg1[2], a3 * rn * kg1[3]}; *(f32x4*)(kvp_out + (size_t)t * 256 + 128 + d4) = kn;
                f16x4 y; y[0] = (f16)kn[0]; y[1] = (f16)kn[1]; y[2] = (f16)kn[2]; y[3] = (f16)kn[3]; *(f16x4*)(KS16 + (size_t)t * 64 + d4) = y; *(LAS f16x4*)(VSs + tl * 68 + d4) = vv; }
            { const f16x4 x = xw[i], vv = vw[i];
                const float a0 = (float)x[0], a1 = (float)x[1], a2 = (float)x[2], a3 = (float)x[3]; const float rn = rsqrtf(sum16((a0 * a0 + a1 * a1) + (a2 * a2 + a3 * a3)) * (1.f / 64.f) + EPS);
                const f32x4 kn = (f32x4){a0 * rn * kg2[0], a1 * rn * kg2[1], a2 * rn * kg2[2], a3 * rn * kg2[3]};
                f16x4 y; y[0] = (f16)kn[0]; y[1] = (f16)kn[1]; y[2] = (f16)kn[2]; y[3] = (f16)kn[3]; *(f16x4*)(KW16 + (size_t)t * 64 + d4) = y; *(LAS f16x4*)(VWs + tl * 68 + d4) = vv;
                if (t >= SEQ - 512) { float* wo = out + O_WINP + (size_t)l * 512 * 128 + (size_t)(t - (SEQ - 512)) * 128; *(f32x4*)(wo + d4) = kn; *(f32x4*)(wo + 64 + d4) = (f32x4){(float)vv[0], (float)vv[1], (float)vv[2], (float)vv[3]}; } }
        }
#pragma unroll
        for (int i = 0; i < 2; ++i) { const int e = tid + 512 * i; if (e < 64 * 12) GATES[(size_t)(it * 64 + e / 12) * 12 + e % 12] = sigmoidf_((float)gt[i]); }
        __syncthreads();
        { const int d = tid >> 3, k8 = (tid & 7) * 8; f16x8 a, b;
#pragma unroll
            for (int i = 0; i < 8; ++i) { const int key = vt_key(k8 + i); a[i] = VSs[key * 68 + d]; b[i] = VWs[key * 68 + d]; }
            *(f16x8*)(VST16 + (size_t)it * 4096 + d * 64 + k8) = a; *(f16x8*)(VWT16 + (size_t)it * 4096 + d * 64 + k8) = b; }
    }
    __syncthreads();
}
DI void ph_mix_cmp(LAS unsigned char* lds_, int l) {
    const Ctx c = mkctx(lds_);
    const f16* P = WSH(WS_PROJ); const float* w2 = INP(I_W2); const float* b2 = INP(I_B2); const float* k_g = INP(I_KG); f16* W1T = WSH(WS_W1T); float* PEB = WSF(WS_PEBP);
    for (int it = c.bid; it < 18; it += c.G) { const int slot = it / 9, grp = it % 9; const f16* src = PT(12) + slot * 64;
        compress_item<false>(c.lds, [&](int ch) { return (const void*)(src + (size_t)ch * 16 * 256); }, grp * 127,
                             W1T + (size_t)(l * 2 + slot) * 128 * 2048, PEB + (l * 2 + slot) * 1024, WSH(WS_W2T) + (size_t)(l * 2 + slot) * 64 * 128, b2 + (l * 2 + slot) * 64,
                             slot == 0 ? k_g + l * 192 : nullptr, nullptr, slot == 0 ? WSH(WS_KC16) : nullptr, slot == 0 ? nullptr : WSH(WS_VCT16)); }
}
#undef PT
template <int N>
DI void blk_reduce(LAS float* red, LAS float* bc, float (&v)[N], bool is_max, int wave, int lane) {
#pragma unroll
    for (int i = 0; i < N; ++i) v[i] = is_max ? wmaxf(v[i]) : wsum(v[i]);
    __syncthreads();
    if (lane == 0) {
#pragma unroll
        for (int i = 0; i < N; ++i) red[wave * 12 + i] = v[i]; }
    __syncthreads();
    if (wave == 0 && lane < N) { float r = red[lane]; for (int w = 1; w < 8; ++w) r = is_max ? fmaxf(r, red[w * 12 + lane]) : r + red[w * 12 + lane]; bc[lane] = r; }
    __syncthreads();
#pragma unroll
    for (int i = 0; i < N; ++i) v[i] = bc[i];
}
DI void nsa_sample_block(LAS float* wl, const float* KC, const float* VC, const SampleKV& kv, const LAS float* gsm, const float* dgp, float* ysd, int tid, int lane, int wave) {
    LAS float* sc = wl; LAS float* qs = wl + 10496; LAS float* PSL = qs + 256; LAS float* red = PSL + 1024; LAS float* bc = red + 96; LAS int* sel = (LAS int*)(bc + 16); LAS float* part = bc + 32;
    constexpr int NCV = 1023, CUR = PAST >> 6;
    float mv[8], sv[8];
#pragma unroll
    for (int i = 0; i < 8; ++i) mv[i] = -3e38f;
    for (int cidx = tid; cidx < NCV; cidx += 512) {
        asm volatile("" ::: "memory");
        float kr[64]; kv.ld64(KC + (size_t)cidx * 64, kr); float s4[4] = {0.f, 0.f, 0.f, 0.f};
#pragma unroll
        for (int d = 0; d < 64; ++d) { const f32x4 qv = *(const LAS f32x4*)(qs + d * 4); s4[0] += qv[0] * kr[d]; s4[1] += qv[1] * kr[d]; s4[2] += qv[2] * kr[d]; s4[3] += qv[3] * kr[d]; }
#pragma unroll
        for (int hh = 0; hh < 4; ++hh) { s4[hh] *= 0.125f; sc[hh * 2624 + cidx] = s4[hh]; mv[hh] = fmaxf(mv[hh], s4[hh]); }
    }
    for (int i = tid; i < 513; i += 512) {
        asm volatile("" ::: "memory");
        float kr[64]; kv.krow_win(PAST - 512 + i, kr); float s4[4] = {0.f, 0.f, 0.f, 0.f};
#pragma unroll
        for (int d = 0; d < 64; ++d) { const f32x4 qv = *(const LAS f32x4*)(qs + d * 4); s4[0] += qv[0] * kr[d]; s4[1] += qv[1] * kr[d]; s4[2] += qv[2] * kr[d]; s4[3] += qv[3] * kr[d]; }
#pragma unroll
        for (int hh = 0; hh < 4; ++hh) { s4[hh] *= 0.125f; sc[hh * 2624 + 2048 + i] = s4[hh]; mv[4 + hh] = fmaxf(mv[4 + hh], s4[hh]); }
    }
    blk_reduce<8>(red, bc, mv, true, wave, lane);
#pragma unroll
    for (int i = 0; i < 8; ++i) sv[i] = 0.f;
    for (int cidx = tid; cidx < NCV; cidx += 512) {
#pragma unroll
        for (int hh = 0; hh < 4; ++hh) { const float e = __expf(sc[hh * 2624 + cidx] - mv[hh]); sc[hh * 2624 + cidx] = e; sv[hh] += e; } }
    for (int i = tid; i < 513; i += 512) {
#pragma unroll
        for (int hh = 0; hh < 4; ++hh) { const float e = __expf(sc[hh * 2624 + 2048 + i] - mv[4 + hh]); sc[hh * 2624 + 2048 + i] = e; sv[4 + hh] += e; } }
    blk_reduce<8>(red, bc, sv, false, wave, lane);
    float invc[4], invw[4];
#pragma unroll
    for (int hh = 0; hh < 4; ++hh) { invc[hh] = 1.f / sv[hh]; invw[hh] = 1.f / sv[4 + hh]; }
    for (int cidx = tid; cidx < 1024; cidx += 512) PSL[cidx] = cidx < NCV ? (sc[cidx] * invc[0] + sc[2624 + cidx] * invc[1]) + (sc[2 * 2624 + cidx] * invc[2] + sc[3 * 2624 + cidx] * invc[3]) : 0.f;
    __syncthreads();
    if (wave == 0) {
        float scv[5];
#pragma unroll
        for (int i = 0; i < 5; ++i) { const int j = lane + 64 * i; float v = -3e38f;
            if (j <= CUR) { if (j == 0 || j == CUR || j == CUR - 1) v = 3e38f; else { float a = 0.f;
#pragma unroll
                    for (int o5 = -1; o5 < 4; ++o5) { const int cc = 4 * j + o5; if (cc >= 0 && cc < NCV) a += (o5 == -1 || o5 == 3) ? 0.5f * PSL[cc] : PSL[cc]; }
                    v = a; } }
            scv[i] = v; }
        for (int k = 0; k < 16; ++k) {
            float bv = scv[0]; int bi = lane;
#pragma unroll
            for (int i = 1; i < 5; ++i) if (scv[i] > bv) { bv = scv[i]; bi = lane + 64 * i; }
#pragma unroll
            for (int off = 32; off > 0; off >>= 1) { const float ov = __shfl_xor(bv, off); const int oi = __shfl_xor(bi, off); if (ov > bv || (ov == bv && oi < bi)) { bv = ov; bi = oi; } }
            if (lane == 0) sel[k] = bi;
#pragma unroll
            for (int i = 0; i < 5; ++i) if (lane + 64 * i == bi) scv[i] = -3e38f;
        }
    }
    __syncthreads();
    float ms[4], ss4[4];
#pragma unroll
    for (int i = 0; i < 4; ++i) ms[i] = -3e38f;
    for (int idx = tid; idx < 1024; idx += 512) {
        asm volatile("" ::: "memory");
        const int pos = sel[idx >> 6] * 64 + (idx & 63); float s4[4] = {-1e30f, -1e30f, -1e30f, -1e30f};
        if (pos <= PAST) { float kr[64]; kv.krow_sel(pos, kr); s4[0] = s4[1] = s4[2] = s4[3] = 0.f;
#pragma unroll
            for (int d = 0; d < 64; ++d) { const f32x4 qv = *(const LAS f32x4*)(qs + d * 4); s4[0] += qv[0] * kr[d]; s4[1] += qv[1] * kr[d]; s4[2] += qv[2] * kr[d]; s4[3] += qv[3] * kr[d]; }
#pragma unroll
            for (int hh = 0; hh < 4; ++hh) s4[hh] *= 0.125f; }
#pragma unroll
        for (int hh = 0; hh < 4; ++hh) { sc[hh * 2624 + 1024 + idx] = s4[hh]; ms[hh] = fmaxf(ms[hh], s4[hh]); }
    }
    blk_reduce<4>(red, bc, ms, true, wave, lane);
#pragma unroll
    for (int i = 0; i < 4; ++i) ss4[i] = 0.f;
    for (int idx = tid; idx < 1024; idx += 512) {
#pragma unroll
        for (int hh = 0; hh < 4; ++hh) { const float x = sc[hh * 2624 + 1024 + idx]; const float e = x > -1e29f ? __expf(x - ms[hh]) : 0.f; sc[hh * 2624 + 1024 + idx] = e; ss4[hh] += e; } }
    blk_reduce<4>(red, bc, ss4, false, wave, lane);
    float invs[4];
#pragma unroll
    for (int hh = 0; hh < 4; ++hh) invs[hh] = 1.f / ss4[hh];
    float oc[4] = {0.f, 0.f, 0.f, 0.f}, os[4] = {0.f, 0.f, 0.f, 0.f}, ow[4] = {0.f, 0.f, 0.f, 0.f};
    { const int c1 = (wave + 1) * 128 < NCV ? (wave + 1) * 128 : NCV;
#pragma unroll 16
        for (int cidx = wave * 128; cidx < c1; ++cidx) { const float v = VC[(size_t)cidx * 64 + lane];
#pragma unroll
            for (int hh = 0; hh < 4; ++hh) oc[hh] += sc[hh * 2624 + cidx] * v; } }
    for (int kb = wave * 2; kb < wave * 2 + 2; ++kb) { const int p0 = sel[kb] * 64; int nk = PAST - p0 + 1; nk = nk > 64 ? 64 : nk;
        const float* vbase = p0 < PAST ? kv.prow(p0, 3) + lane : kv.nvs + lane;
#pragma unroll 16
        for (int kk = 0; kk < nk; ++kk) { const float v = vbase[(size_t)kk * 256];
#pragma unroll
            for (int hh = 0; hh < 4; ++hh) os[hh] += sc[hh * 2624 + 1024 + kb * 64 + kk] * v; } }
    { const int i1 = (wave + 1) * 65 < 513 ? (wave + 1) * 65 : 513;
#pragma unroll 13
        for (int i = wave * 65; i < i1; ++i) { const float v = kv.v_win(PAST - 512 + i, lane);
#pragma unroll
            for (int hh = 0; hh < 4; ++hh) ow[hh] += sc[hh * 2624 + 2048 + i] * v; } }
#pragma unroll
    for (int hh = 0; hh < 4; ++hh) { part[(wave * 12 + hh) * 64 + lane] = oc[hh] * invc[hh]; part[(wave * 12 + 4 + hh) * 64 + lane] = os[hh] * invs[hh]; part[(wave * 12 + 8 + hh) * 64 + lane] = ow[hh] * invw[hh]; }
    __syncthreads();
    if (tid < 256) { const int hh = tid >> 6, d = tid & 63; float a = 0.f, b = 0.f, cc = 0.f;
        for (int w = 0; w < 8; ++w) { a += part[(w * 12 + hh) * 64 + d]; b += part[(w * 12 + 4 + hh) * 64 + d]; cc += part[(w * 12 + 8 + hh) * 64 + d]; }
        ysd[tid] = siluf_(dgp[tid]) * (gsm[hh * 3] * a + gsm[hh * 3 + 1] * b + gsm[hh * 3 + 2] * cc); }
}
DI void ph_mix_sample(LAS unsigned char* lds_, int l) {
    const Ctx c = mkctx(lds_); const int tid = c.tid, lane = c.lane, wave = c.wave;
    const int b = c.bid - (c.G - 32);
    if (b < 0 || b >= 32) return;
    float* out = c.out;
    __syncthreads();
    const float* pr = WSF(WS_PROJS) + (size_t)b * NPD;
    LAS float* act = (LAS float*)c.lds;
    LAS float* red = act + 768;
    LAS float* ybl = red + 16;
    LAS float* sdt = ybl + 256;
    LAS float* nrow = sdt + 8;
    LAS float* gsm = nrow + 256;
    LAS float* wl = gsm + 16;
    float* ys = WSF(WS_YS) + (size_t)b * 1024;
    if (tid < 256) { const int ch = tid; const float* st = INP(I_SSC) + ((size_t)(l * NB + b) * 2) * 256; const float* scw = INP(I_SCW) + l * 768;
        const float u = pr[512 + ch] * pr[ch], p0 = st[ch], p1 = st[256 + ch]; const float y = scw[ch] * p0 + scw[256 + ch] * p1 + scw[512 + ch] * u;
        ys[ch] = siluf_(pr[768 + ch]) * pr[256 + ch] * y; float* so = out + O_SCS + ((size_t)(l * NB + b) * 2) * 256; so[ch] = p1; so[256 + ch] = u; }
    float uc = 0.f;
    if (tid >= 256) { const int ch = tid - 256; const float* st = INP(I_SCF) + (size_t)(l * NB + b) * 7680; const float* cfw = INP(I_CFW) + l * 31 * 256;
        const float glu = pr[2048 + ch] * sigmoidf_(pr[2304 + ch]); float u = INP(I_CFB)[l * 256 + ch]; float* so = out + O_CFS + (size_t)(l * NB + b) * 7680;
        for (int k = 0; k < 30; ++k) { const float pv = st[k * 256 + ch]; u += cfw[k * 256 + ch] * pv; if (k > 0) so[(k - 1) * 256 + ch] = pv; }
        u += cfw[30 * 256 + ch] * glu; so[29 * 256 + ch] = glu; uc = u; }
    { const float s1 = wsum(tid >= 256 ? uc : 0.f); if (lane == 0) red[wave] = s1; }
    __syncthreads();
    const float cmean = (red[4] + red[5] + red[6] + red[7]) * (1.f / 256.f);
    __syncthreads();
    { const float d = uc - cmean; const float s2 = wsum(tid >= 256 ? d * d : 0.f); if (lane == 0) red[wave] = s2; }
    __syncthreads();
    if (tid >= 256) { const int ch = tid - 256; const float var = (red[4] + red[5] + red[6] + red[7]) * (1.f / 256.f);
        const float ln = (uc - cmean) * rsqrtf(var + EPS) * INP(I_LNG)[l * 256 + ch] + INP(I_LNB)[l * 256 + ch];
        ys[512 + ch] = siluf_(pr[2560 + ch]) * siluf_(ln); }
    { const float* st = INP(I_SBC) + (size_t)(l * NB + b) * 2304; const float* cw = INP(I_BCW) + l * 4 * 768; const float* cb = INP(I_BCB) + l * 768; float* so = out + O_BCS + (size_t)(l * NB + b) * 2304;
        for (int ch = tid; ch < 768; ch += 512) { const float raw = pr[1280 + ch], p0 = st[ch], p1 = st[768 + ch], p2 = st[1536 + ch];
            act[ch] = siluf_(cb[ch] + cw[ch] * p0 + cw[768 + ch] * p1 + cw[1536 + ch] * p2 + cw[2304 + ch] * raw); so[ch] = p1; so[768 + ch] = p2; so[1536 + ch] = raw; }
        if (tid < 4) { const float dt = softplusf_(pr[3456 + tid] + INP(I_DTB)[l * 4 + tid]); sdt[tid] = dt; sdt[4 + tid] = __expf(dt * (-__expf(INP(I_ALOG)[l * 4 + tid]))); } }
    __syncthreads();
    { const float* h0 = INP(I_SSM) + (size_t)(l * NB + b) * 32768; float* ho = out + O_HS + (size_t)(l * NB + b) * 32768; const float* Dp = INP(I_SD) + l * 4;
        for (int row = wave; row < 256; row += 8) { const int hd = row >> 6, gq = hd >> 1; const float dt = sdt[hd], dA = sdt[4 + hd], xv = act[row]; float y = 0.f;
#pragma unroll
            for (int s2 = 0; s2 < 2; ++s2) { const int sidx = lane + 64 * s2; const float hn = dA * h0[row * 128 + sidx] + dt * xv * act[256 + gq * 128 + sidx]; ho[row * 128 + sidx] = hn; y += hn * act[512 + gq * 128 + sidx]; }
            y = wsum(y);
            if (lane == 0) ybl[row] = (y + Dp[hd] * xv) * siluf_(pr[1024 + row]); } }
    __syncthreads();
    { const float v = tid < 256 ? ybl[tid] : 0.f; const float s2 = wsum(v * v); if (lane == 0) red[8 + wave] = s2; }
    __syncthreads();
    if (tid < 256) { const float ss = red[8] + red[9] + red[10] + red[11]; ys[256 + tid] = ybl[tid] * rsqrtf(ss * (1.f / 256.f) + EPS) * INP(I_SNG)[l * 256 + tid]; }
    const float* qg = INP(I_QG) + l * 64; const float* kg = INP(I_KG) + l * 192;
    LAS float* qs = wl + 10496;
    if (wave < 4) { const float v = pr[2816 + wave * 64 + lane]; const float ss = wsum(v * v); qs[lane * 4 + wave] = v * rsqrtf(ss * (1.f / 64.f) + EPS) * qg[lane]; }
    else if (wave == 4) { const float v = pr[3072 + 128 + lane]; const float ss = wsum(v * v); nrow[lane] = v * rsqrtf(ss * (1.f / 64.f) + EPS) * kg[64 + lane]; nrow[64 + lane] = pr[3072 + 192 + lane]; }
    else if (wave == 5) { const float v = pr[3072 + 256 + lane]; const float ss = wsum(v * v); nrow[128 + lane] = v * rsqrtf(ss * (1.f / 64.f) + EPS) * kg[128 + lane]; nrow[192 + lane] = pr[3072 + 320 + lane]; }
    else if (wave == 6) { if (lane < 12) gsm[lane] = sigmoidf_(pr[3460 + lane]); }
    __syncthreads();
    const float* cache_win = INP(I_CWIN) + (size_t)(l * NB + b) * 512 * 128;
    { float* ko = out + O_KVS + (size_t)(l * NB + b) * 256;
        if (tid < 128) ko[tid] = pr[3072 + tid]; else if (tid < 192) ko[tid] = nrow[tid - 128]; else if (tid < 256) ko[tid] = nrow[64 + tid - 192];
        float* wo = out + O_WINS + (size_t)(l * NB + b) * 512 * 128;
        for (int e = tid; e < 511 * 128; e += 512) wo[e] = cache_win[128 + e];
        if (tid < 64) wo[511 * 128 + tid] = nrow[128 + tid]; else if (tid < 128) wo[511 * 128 + tid] = nrow[192 + tid - 64]; }
    float* nrp = WSF(WS_NRG) + (size_t)(l * NB + b) * 256;
    if (tid < 256) nrp[tid] = nrow[tid];
    asm volatile("s_waitcnt vmcnt(0)" ::: "memory");
    __syncthreads();
    {
        SampleKV kv{INP(I_CKV) + (size_t)l * NPOOL * 128 * 256, (const int*)c.ap->in[I_PT] + b * 128, cache_win, nrp, nrp + 64, nrp + 128, nrp + 192};
        nsa_sample_block(wl, WSF(WS_KCS) + (size_t)(l * NB + b) * 1024 * 64, WSF(WS_VCS) + (size_t)(l * NB + b) * 1024 * 64, kv, gsm, pr + 3584, ys + 768, tid, lane, wave);
    }
    edge_publish((unsigned*)(c.ws + WS_CTL + 18432) + l * 64);
    __syncthreads();
}
DI void ph_scan(LAS unsigned char* lds_, int l) {
    const Ctx c = mkctx(lds_);
    if (c.bid >= 64) return;
    const float* CST = WSF(WS_CST); float* HPV = WSF(WS_HPV); const float* CDEC = WSF(WS_CDEC);
    const int e = c.bid * 512 + c.tid, hd = e >> 13; float hc = 0.f;
#pragma unroll 8
    for (int ch = 0; ch < 128; ++ch) { const float sv = CST[(size_t)ch * 32768 + e]; HPV[(size_t)ch * 32768 + e] = hc; hc = CDEC[ch * 4 + hd] * hc + sv; }
    c.out[O_HP + (size_t)l * 32768 + e] = hc;
    edge_publish((unsigned*)(c.ws + WS_CTL + 17408) + l * 64);
}
DI f16x8 pack_p(const f32x4& a, const f32x4& b) { f16x8 r; r[0] = (f16)a[0]; r[1] = (f16)a[1]; r[2] = (f16)a[2]; r[3] = (f16)a[3]; r[4] = (f16)b[0]; r[5] = (f16)b[1]; r[6] = (f16)b[2]; r[7] = (f16)b[3]; return r; }
DI f16x8 ld_vt(const f16* p) { const f16x4 a = *(const f16x4*)p, b = *(const f16x4*)(p + 16); f16x8 r; r[0] = a[0]; r[1] = a[1]; r[2] = a[2]; r[3] = a[3]; r[4] = b[0]; r[5] = b[1]; r[6] = b[2]; r[7] = b[3]; return r; }
constexpr int NT_PSEL = 0  , NT_STG = 32768  , NT_STG_SZ = 18432 + 17408,
              NT_RING = 0  , NT_MASK = 131072  , NT_VB = NT_MASK + 1088  , NT_MT = NT_VB + 1088  , NT_END = NT_MT + 1088;
static_assert(NT_STG + 2 * NT_STG_SZ <= NT_MASK, "nsa tile LDS map");
static_assert(NT_END <= MISC_OFF, "nsa tile LDS map");
struct StgRegs { f16x8 k0, k1, v0, v1; };
template <bool WITH_V, class KSrc, class VSrc>
DI void stg_load(StgRegs& rg, int ch, int tid, const KSrc& ksrc, const VSrc& vsrc) {
    const f16* kp = ksrc(ch, tid >> 2) + (tid & 3) * 16; rg.k0 = ld_h8(kp); rg.k1 = ld_h8(kp + 8);
    if (WITH_V) { const f16* vp = vsrc(ch, tid >> 3, tid & 7); rg.v0 = ld_h8(vp); rg.v1 = ld_h8(vp + 8); }
}
template <bool WITH_V>
DI void stg_store(const StgRegs& rg, LAS unsigned char* buf, int tid) {
    LAS f16* kb = (LAS f16*)buf + (tid >> 2) * 72 + (tid & 3) * 16; *(LAS f16x8*)kb = rg.k0; *(LAS f16x8*)(kb + 8) = rg.k1;
    if (WITH_V) { LAS f16* vb = (LAS f16*)(buf + 18432) + (tid >> 3) * 136 + (tid & 7) * 16; *(LAS f16x8*)vb = rg.v0; *(LAS f16x8*)(vb + 8) = rg.v1; }
}
template <bool WITH_V, class KSrc, class VSrc, class Body>
DI void stream_chunks(LAS unsigned char* stg, int nchunk, int tid, const KSrc& ksrc, const VSrc& vsrc, Body body) {
    if (nchunk <= 0) return;
    const int last = nchunk - 1;
    StgRegs rg;
    stg_load<WITH_V>(rg, 0, tid, ksrc, vsrc);
    __syncthreads();
    stg_store<WITH_V>(rg, stg, tid); stg_load<WITH_V>(rg, 1 < last ? 1 : last, tid, ksrc, vsrc);
    lds_barrier();
#pragma nounroll
    for (int ch = 0; ch < nchunk; ++ch) {
        body(ch, stg + (ch & 1) * NT_STG_SZ);
        stg_store<WITH_V>(rg, stg + ((ch + 1) & 1) * NT_STG_SZ, tid); stg_load<WITH_V>(rg, ch + 2 < last ? ch + 2 : last, tid, ksrc, vsrc);
        lds_barrier();
    }
}
DI f16x8 lds_vt(const LAS f16* p) { return *(const LAS f16x8*)p; }
DI f32x4 qk_tile(const LAS f16* kb, int kt, int fr, int q, const f16x8 (&qf)[2]) {
    const LAS f16* kp = kb + (16 * kt + fr) * 72 + 8 * q; f32x4 sa = (f32x4){0.f, 0.f, 0.f, 0.f};
    sa = __builtin_amdgcn_mfma_f32_16x16x32_f16(*(const LAS f16x8*)kp, qf[0], sa, 0, 0, 0); return __builtin_amdgcn_mfma_f32_16x16x32_f16(*(const LAS f16x8*)(kp + 32), qf[1], sa, 0, 0, 0);
}
constexpr float NSA_L2E = 1.44269504f, NSA_C1 = 0.125f * NSA_L2E;
DI float ex2(float x) { return __builtin_amdgcn_exp2f(x); }
template <class Pred>
DI f16x8 pv_step(const LAS f16* kb, const LAS f16* vb, int st, int fr, int q, const f16x8 (&qf)[2], f32x4 (&o)[4], f32x4 (&e2)[2], float nb, bool masked, Pred pred) {
#pragma unroll
    for (int hf = 0; hf < 2; ++hf) { const f32x4 sa = qk_tile(kb, 2 * st + hf, fr, q, qf);
        if (!masked) {
#pragma unroll
            for (int j = 0; j < 4; ++j) e2[hf][j] = ex2(fmaf(sa[j], NSA_C1, nb)); }
        else {
#pragma unroll
            for (int j = 0; j < 4; ++j) e2[hf][j] = pred(32 * st + 16 * hf + 4 * q + j) ? ex2(fmaf(sa[j], NSA_C1, nb)) : 0.f; } }
    const f16x8 pb = pack_p(e2[0], e2[1]);
#pragma unroll
    for (int dt = 0; dt < 4; ++dt) o[dt] = __builtin_amdgcn_mfma_f32_16x16x32_f16(lds_vt(vb + (16 * dt + fr) * 136 + 32 * st + 8 * q), pb, o[dt], 0, 0, 0);
    return pb;
}
DI void nsa_tile(const Ctx& c, int tile, const f16* Q16, const f16* KC16, const f16* VCT16, const f16* KS16, const f16* VST16, const f16* KW16, const f16* VWT16,
                 const float* GATES, const f16* DG, f16* Y16, float shc, float shs, float shw) {
    LAS unsigned char* lds = c.lds; const int wave = c.wave; int tid, lane, fr, q, ti, h, trow;
    const int t0 = tile * 32, cur = t0 >> 6;
#define NSA_RELANE() do { int _t = c.tid; asm volatile("" : "+v"(_t)); tid = _t; lane = _t & 63; fr = lane & 15; q = lane >> 4; ti = fr >> 2; h = fr & 3; trow = t0 + 4 * wave + ti; } while (0)
#define NSA_REPS(bit) (((NSA_DUP >> (bit)) & 1) ? 2 : 1)
#define NSA_SCALE(rep) ({ float _z = (rep) == 0 ? 1.f : 0.f; asm volatile("" : "+v"(_z)); _z; })
    NSA_RELANE();
    LAS float* PSEL = (LAS float*)(lds + NT_PSEL); LAS unsigned* MASK = (LAS unsigned*)(lds + NT_MASK); LAS int* VB = (LAS int*)(lds + NT_VB); LAS unsigned char* STG = lds + NT_STG;
    __syncthreads();
    for (int i = tid; i < 272; i += 512) MASK[i] = (i == 0 || i == cur || i == cur - 1) ? 0xFFFFFFFFu : 0u;
    f16x8 qf[2];
#pragma unroll
    for (int ks = 0; ks < 2; ++ks) qf[ks] = ld_h8(Q16 + ((size_t)trow * 4 + h) * 64 + 32 * ks + 8 * q);
    const int nkt = ((t0 >> 4) + 1 + 15) >> 4;
    const int ncch = (nkt + 7) >> 3;
    const int nv_row = trow >= 31 ? ((trow - 31) >> 4) + 1 : 0;
    auto kc_src = [&](int ch, int row) { return KC16 + (size_t)(128 * ch + row) * 64; };
    auto vc_src = [&](int ch, int d, int seg) { return VCT16 + (size_t)d * 1024 + 128 * ch + seg * 16; };
    float lsum = 0.f;
    const float bc = -shc * NSA_L2E, bs = -shs * NSA_L2E, bw = -shw * NSA_L2E;
    const int tw0 = t0 + 4 * wave, nvmin_w = tw0 >= 31 ? ((tw0 - 31) >> 4) + 1 : 0;
    stream_chunks<false>(STG, ncch, tid, kc_src, vc_src, [&](int ch, LAS unsigned char* buf) {
        const LAS f16* kb = (const LAS f16*)buf; const int nk = nkt - 8 * ch < 8 ? nkt - 8 * ch : 8;
#pragma unroll 4
        for (int kt = 0; kt < nk; ++kt) { const f32x4 sa = qk_tile(kb, kt, fr, q, qf); const int cb = 128 * ch + 16 * kt + 4 * q;
            if (128 * ch + 16 * kt + 15 < nvmin_w) {
#pragma unroll
                for (int j = 0; j < 4; ++j) lsum += ex2(fmaf(sa[j], NSA_C1, bc)); }
            else {
#pragma unroll
                for (int j = 0; j < 4; ++j) lsum += (cb + j < nv_row) ? ex2(fmaf(sa[j], NSA_C1, bc)) : 0.f; } } });
    lsum += __shfl_xor(lsum, 16); lsum += __shfl_xor(lsum, 32);
    const float invc = lsum > 0.f ? 1.f / lsum : 0.f;
    NSA_RELANE();
    f32x4 oc[4];
#pragma unroll
    for (int dt = 0; dt < 4; ++dt) oc[dt] = (f32x4){0.f, 0.f, 0.f, 0.f};
    { float bprev = 0.f; const float pbias = invc > 0.f ? bc + __log2f(invc) : -1e30f;
    stream_chunks<true>(STG, ncch, tid, kc_src, vc_src, [&](int ch, LAS unsigned char* buf) {
        const LAS f16* kb = (const LAS f16*)buf; const LAS f16* vb = (const LAS f16*)(buf + 18432); const int ns = (nkt - 8 * ch + 1) >> 1 < 4 ? (nkt - 8 * ch + 1) >> 1 : 4;
#pragma unroll 2
        for (int s2 = 0; s2 < ns; ++s2) {
            f32x4 e2[2];
            pv_step(kb, vb, s2, fr, q, qf, oc, e2, pbias, 128 * ch + 32 * s2 + 31 >= nvmin_w, [&](int kc) { return 128 * ch + kc < nv_row; });
#pragma unroll
            for (int hf = 0; hf < 2; ++hf) {
                const int ktg = 8 * ch + 2 * s2 + hf;
                float av = (e2[hf][0] + e2[hf][1]) + (e2[hf][2] + 0.5f * e2[hf][3]), bv = 0.5f * e2[hf][3];
                av += dppf<DPP_X1>(av); av += dppf<DPP_X2>(av); bv += dppf<DPP_X1>(bv); bv += dppf<DPP_X2>(bv);
                const float up = __shfl(q == 3 ? bprev : bv, (lane + 48) & 63);
                bprev = bv;
                if (h == 0 && ktg < nkt) PSEL[(4 * wave + ti) * 256 + 4 * ktg + q] = av + up;
            }
        } }); }
    for (int rep = 0; rep < NSA_REPS(2); ++rep) {
        const int nforced = cur >= 2 ? 3 : cur + 1, nsel = ((cur + 1) < 16 ? (cur + 1) : 16) - nforced, tk = lane >> 4, l16 = lane & 15, tokl = 4 * wave + tk;
        float sv[16];
#pragma unroll
        for (int i = 0; i < 16; ++i) { const int j = l16 + 16 * i; float v = -3e38f;
            if (j <= cur && !(j == 0 || j == cur || j == cur - 1)) v = j < 4 * nkt ? PSEL[tokl * 256 + j] : 0.f;
            sv[i] = v; }
#pragma nounroll
        for (int k = 0; k < nsel; ++k) {
            float bv = sv[0]; int bi = l16;
#pragma unroll
            for (int i = 1; i < 16; ++i) if (sv[i] > bv) { bv = sv[i]; bi = l16 + 16 * i; }
#define TOPK_STEP(CT) do { const float ov = dppf<CT>(bv); const int oi = dppi<CT>(bi); if (ov > bv || (ov == bv && oi < bi)) { bv = ov; bi = oi; } } while (0)
            TOPK_STEP(DPP_X1); TOPK_STEP(DPP_X2); TOPK_STEP(DPP_HM); TOPK_STEP(DPP_R8);
#undef TOPK_STEP
            if (l16 == 0) __hip_atomic_fetch_or(&MASK[bi], 1u << tokl, __ATOMIC_RELAXED, __HIP_MEMORY_SCOPE_WORKGROUP);
#pragma unroll
            for (int i = 0; i < 16; ++i) if (l16 + 16 * i == bi) sv[i] = -3e38f;
        }
    }
    NSA_RELANE();
    f32x4 owr[4]; float lwr = 0.f;
#pragma unroll
    for (int dt = 0; dt < 4; ++dt) owr[dt] = (f32x4){0.f, 0.f, 0.f, 0.f};
    f16x8 onesf;
#pragma unroll
    for (int i = 0; i < 8; ++i) onesf[i] = fr == 0 ? (f16)1.f : (f16)0.f;
    f32x4 lw5 = (f32x4){0.f, 0.f, 0.f, 0.f};
    {
        const int wlo = t0 - 512 > 0 ? t0 - 512 : 0, nwch = (t0 + 32 - wlo + 127) >> 7;
        auto kw_src = [&](int ch, int row) { int p = wlo + 128 * ch + row; p = p < SEQ ? p : SEQ - 1; return KW16 + (size_t)p * 64; };
        auto vw_src = [&](int ch, int d, int seg) { const int key = wlo + 128 * ch + seg * 16; int blk = key >> 6; blk = blk < 256 ? blk : 255; return VWT16 + (size_t)blk * 4096 + d * 64 + (key & 63); };
        {
        stream_chunks<true>(STG, nwch, tid, kw_src, vw_src, [&](int ch, LAS unsigned char* buf) {
            const LAS f16* kb = (const LAS f16*)buf; const LAS f16* vb = (const LAS f16*)(buf + 18432); const int pbase = wlo + 128 * ch;
            const int ns = (t0 + 32 - pbase) >> 5 < 4 ? (t0 + 32 - pbase) >> 5 : 4;
#pragma unroll 2
            for (int s2 = 0; s2 < ns; ++s2) { f32x4 e2[2];
                const int p0s = pbase + 32 * s2; const bool masked = !(p0s >= tw0 + 3 - 512 && p0s + 31 <= tw0);
                const f16x8 pb = pv_step(kb, vb, s2, fr, q, qf, owr, e2, bw, masked, [&](int kc) { const int pos = pbase + kc; return pos <= trow && pos >= trow - 512; });
                lw5 = __builtin_amdgcn_mfma_f32_16x16x32_f16(onesf, pb, lw5, 0, 0, 0); } }); }
        lwr = lw5[0];
    }
    NSA_RELANE();
    LAS unsigned* MT = (LAS unsigned*)(lds + NT_MT);
    if (wave == 0) { int cnt = 0;
        for (int base = 0; base <= cur; base += 64) { const int jx = base + lane; const unsigned mj = jx <= cur ? MASK[jx] : 0u; const bool v = mj != 0u; const unsigned long long bal = __ballot(v);
            if (v) { const int pos = cnt + __popcll(bal & ((1ull << lane) - 1ull)); VB[pos] = jx; MT[pos] = mj; } cnt += __popcll(bal); }
        if (lane < 8) { VB[cnt + lane] = VB[cnt - 1]; MT[cnt + lane] = 0u; }
        if (lane == 0) VB[264] = cnt; }
    __syncthreads();
    if (VERIFY_NSA) { unsigned* SELM = (unsigned*)(c.ws + WS_SELM) + (size_t)tile * 272; for (int i = tid; i < 272; i += 512) SELM[i] = MASK[i]; }
    f32x4 osr[4]; float lsr = 0.f; f32x4 ls5 = (f32x4){0.f, 0.f, 0.f, 0.f};
#pragma unroll
    for (int dt = 0; dt < 4; ++dt) osr[dt] = (f32x4){0.f, 0.f, 0.f, 0.f};
#pragma unroll
    for (int i = 0; i < 8; ++i) onesf[i] = fr == 0 ? (f16)1.f : (f16)0.f;
    {
        const int nvb = __builtin_amdgcn_readfirstlane(VB[264]), nst = (nvb + 3) >> 2;
        const int dr = lane >> 3, dp = lane & 7, dsw = (dp ^ dr) * 8;
        LAS unsigned char* RING = lds + NT_RING;
        auto dma = [&](int n, int blk) { LAS unsigned char* slot = RING + (n & 7) * 16384 + wave * 1024;
            __builtin_amdgcn_global_load_lds((const unsigned*)(KS16 + ((size_t)blk * 64 + 8 * wave + dr) * 64 + dsw), (LAS unsigned*)slot, 16, 0, 0);
            __builtin_amdgcn_global_load_lds((const unsigned*)(VST16 + (size_t)blk * 4096 + (8 * wave + dr) * 64 + dsw), (LAS unsigned*)(slot + 8192), 16, 0, 0); };
        {
        asm volatile("s_waitcnt vmcnt(0)" ::: "memory"); __syncthreads();
        typedef int i32x4 __attribute__((ext_vector_type(4)));
#define RFL4(v) { __builtin_amdgcn_readfirstlane((v)[0]), __builtin_amdgcn_readfirstlane((v)[1]), __builtin_amdgcn_readfirstlane((v)[2]), __builtin_amdgcn_readfirstlane((v)[3]) }
        { const i32x4 b0 = *(const LAS i32x4*)VB; const int bb[4] = RFL4(b0); dma(0, bb[0]); dma(1, bb[1]); dma(2, bb[2]); dma(3, bb[3]); }
#pragma nounroll
        for (int st = 0; st < nst; ++st) {
            asm volatile("s_waitcnt vmcnt(0)\n\ts_barrier" ::: "memory");
            const i32x4 bcv = *(const LAS i32x4*)(VB + 4 * st), bnv = *(const LAS i32x4*)(VB + 4 * st + 4); const u32x4 mcv = *(const LAS u32x4*)(MT + 4 * st);
            const int bcur[4] = RFL4(bcv), bnxt[4] = RFL4(bnv); const int mcur[4] = RFL4(mcv);
            dma(4 * st + 4, bnxt[0]); dma(4 * st + 5, bnxt[1]); dma(4 * st + 6, bnxt[2]); dma(4 * st + 7, bnxt[3]);
#pragma unroll
            for (int i4 = 0; i4 < 4; ++i4) {
            const int n = 4 * st + i4;
            const int blk = bcur[i4]; const unsigned mt = ((unsigned)mcur[i4] >> (4 * wave)) & 15u;
            if (mt != 0u) {
                const bool rv = ((mt >> ti) & 1u) != 0u; const LAS unsigned char* ks = RING + (n & 7) * 16384; const LAS unsigned char* vs = ks + 8192; const int sx = fr & 7;
                f32x4 sa[4]; f16x8 va[2][4];
#pragma unroll
                for (int kt = 0; kt < 4; ++kt) { const LAS unsigned char* kp = ks + (16 * kt + fr) * 128; sa[kt] = (f32x4){0.f, 0.f, 0.f, 0.f};
                    sa[kt] = __builtin_amdgcn_mfma_f32_16x16x32_f16(*(const LAS f16x8*)(kp + ((q ^ sx) << 4)), qf[0], sa[kt], 0, 0, 0);
                    sa[kt] = __builtin_amdgcn_mfma_f32_16x16x32_f16(*(const LAS f16x8*)(kp + (((4 + q) ^ sx) << 4)), qf[1], sa[kt], 0, 0, 0); }
#pragma unroll
                for (int s2 = 0; s2 < 2; ++s2)
#pragma unroll
                    for (int dt = 0; dt < 4; ++dt) va[s2][dt] = *(const LAS f16x8*)(vs + (16 * dt + fr) * 128 + (((4 * s2 + q) ^ sx) << 4));
                const float nbu = rv ? bs : -1e30f;
                if (blk != cur) {
#pragma unroll
                    for (int kt = 0; kt < 4; ++kt)
#pragma unroll
                        for (int j = 0; j < 4; ++j) sa[kt][j] = ex2(fmaf(sa[kt][j], NSA_C1, nbu)); }
                else { const int pb0 = 64 * blk + 4 * q;
#pragma unroll
                    for (int kt = 0; kt < 4; ++kt)
#pragma unroll
                        for (int j = 0; j < 4; ++j) sa[kt][j] = (pb0 + 16 * kt + j <= trow) ? ex2(fmaf(sa[kt][j], NSA_C1, nbu)) : 0.f; }
                const f16x8 p0 = pack_p(sa[0], sa[1]), p1 = pack_p(sa[2], sa[3]);
#pragma unroll
                for (int dt = 0; dt < 4; ++dt) { osr[dt] = __builtin_amdgcn_mfma_f32_16x16x32_f16(va[0][dt], p0, osr[dt], 0, 0, 0); osr[dt] = __builtin_amdgcn_mfma_f32_16x16x32_f16(va[1][dt], p1, osr[dt], 0, 0, 0); }
                ls5 = __builtin_amdgcn_mfma_f32_16x16x32_f16(onesf, p0, ls5, 0, 0, 0); ls5 = __builtin_amdgcn_mfma_f32_16x16x32_f16(onesf, p1, ls5, 0, 0, 0);
            }
            }
        }
        asm volatile("s_waitcnt vmcnt(0)" ::: "memory"); }
        __syncthreads();
        lsr = ls5[0];
    }
    NSA_RELANE();
    lwr += __shfl_xor(lwr, 16); lwr += __shfl_xor(lwr, 32); lsr += __shfl_xor(lsr, 16); lsr += __shfl_xor(lsr, 32);
    {
        const float g0 = GATES[(size_t)trow * 12 + h * 3], ils = GATES[(size_t)trow * 12 + h * 3 + 1] / lsr, ilw = GATES[(size_t)trow * 12 + h * 3 + 2] / lwr;
#pragma unroll
        for (int dt = 0; dt < 4; ++dt) { const int d0 = 16 * dt + 4 * q; const f16x4 dg = *(const f16x4*)(DG + (size_t)trow * 256 + h * 64 + d0); f16x4 y;
#pragma unroll
            for (int jj = 0; jj < 4; ++jj) { const float o = g0 * oc[dt][jj] + ils * osr[dt][jj] + ilw * owr[dt][jj]; y[jj] = (f16)(siluf_((float)dg[jj]) * o); }
            *(f16x4*)(Y16 + (size_t)trow * 1024 + 768 + h * 64 + d0) = y; }
    }
#undef NSA_RELANE
}
DI void ph_ssd_fin(LAS unsigned char* lds_, int l, int it0, int it1, int itstep);
DI void ph_outproj_sample(LAS unsigned char* lds_, int l, int it);
DI void ph_nsa(LAS unsigned char* lds_, int l) {
    const Ctx c = mkctx(lds_); const int lane = c.lane;
    const float* qg = INP(I_QG) + l * 64; const float* kg = INP(I_KG) + l * 192;
    const float mq = wmaxf(fabsf(qg[lane])), mk0 = wmaxf(fabsf(kg[lane])), mk1 = wmaxf(fabsf(kg[64 + lane])), mk2 = wmaxf(fabsf(kg[128 + lane]));
    const float shc = 8.f * mq * mk0 - 8.f, shs = 8.f * mq * mk1 - 8.f, shw = 8.f * mq * mk2 - 8.f;
    unsigned* qctr = (unsigned*)(c.ws + WS_CTL + 16384) + l * 64; LAS int* qslot = (LAS int*)(c.lds + MISC_OFF + 64); bool fin_ok = false, smp_ok = false;
    for (;;) {
        __syncthreads();
        if (c.tid == 0) *qslot = (int)__hip_atomic_fetch_add(qctr, 1u, __ATOMIC_RELAXED, __HIP_MEMORY_SCOPE_AGENT);
        __syncthreads();
        const int u = __builtin_amdgcn_readfirstlane(*qslot);
        if (u >= 800) break;
        if (u < 512) nsa_tile(c, 511 - u, WSH(WS_Q16), WSH(WS_KC16), WSH(WS_VCT16), WSH(WS_KS16), WSH(WS_VST16), WSH(WS_KW16), WSH(WS_VWT16), WSF(WS_GATES), WSH(WS_PROJ) + (size_t)14 * SEQ * 256, WSH(WS_Y16), shc, shs, shw);
        else if (u < 768) { if (!fin_ok) { edge_wait((unsigned*)(c.ws + WS_CTL + 17408) + l * 64, 64u); fin_ok = true; } ph_ssd_fin(lds_, l, u - 512, u - 511, 1); }
        else { if (!smp_ok) { edge_wait((unsigned*)(c.ws + WS_CTL + 18432) + l * 64, 32u); smp_ok = true; } ph_outproj_sample(lds_, l, u - 768); }
    }
    __syncthreads();
}
DI void ph_nsa_verify(LAS unsigned char* lds_, int l) {
    const Ctx c = mkctx(lds_); const int lane = c.lane;
    LAS float* wl = (LAS float*)c.lds + c.wave * 4400; LAS float* sc = wl; LAS float* qs = wl + 4096; LAS unsigned* selb = (LAS unsigned*)(wl + 4352);
    const f16* Q16 = WSH(WS_Q16); const f16* KC16 = WSH(WS_KC16); const f16* VCT16 = WSH(WS_VCT16); const f16* KS16 = WSH(WS_KS16); const f16* VST16 = WSH(WS_VST16); const f16* KW16 = WSH(WS_KW16); const f16* VWT16 = WSH(WS_VWT16);
    const float* GATES = WSF(WS_GATES); const f16* DG = WSH(WS_PROJ) + (size_t)14 * SEQ * 256; const f16* Y16 = WSH(WS_Y16); const unsigned* SELM = (const unsigned*)(c.ws + WS_SELM);
    float* dbg = (float*)(c.ws + WS_CTL + 40960);
    auto dot4 = [&](const f16* kp, float (&s4)[4]) { s4[0] = s4[1] = s4[2] = s4[3] = 0.f;
#pragma unroll
        for (int i = 0; i < 8; ++i) { const f16x8 kv = ld_h8(kp + 8 * i);
#pragma unroll
            for (int j = 0; j < 8; ++j) { const f32x4 qv = *(const LAS f32x4*)(qs + (8 * i + j) * 4); const float kf = (float)kv[j]; s4[0] += qv[0] * kf; s4[1] += qv[1] * kf; s4[2] += qv[2] * kf; s4[3] += qv[3] * kf; } }
#pragma unroll
        for (int hh = 0; hh < 4; ++hh) s4[hh] *= 0.125f; };
    for (int si = c.bid * 8 + c.wave; si < 200 + 395; si += c.G * 8) {
        const int t = si < 200 ? si : 200 + (si - 200) * 41, cur = t >> 6, ncv = t >= 31 ? ((t - 31) >> 4) + 1 : 0;
#pragma unroll
        for (int hh = 0; hh < 4; ++hh) qs[lane * 4 + hh] = (float)Q16[(size_t)t * 256 + hh * 64 + lane];
        if (lane < 9) selb[lane] = 0u;
        float oc[4] = {0.f, 0.f, 0.f, 0.f}, os[4] = {0.f, 0.f, 0.f, 0.f}, ow[4] = {0.f, 0.f, 0.f, 0.f};
        {
            float mx[4] = {-3e38f, -3e38f, -3e38f, -3e38f}, inv[4];
            for (int cc = lane; cc < ncv; cc += 64) { asm volatile("" ::: "memory"); float s4[4]; dot4(KC16 + (size_t)cc * 64, s4);
#pragma unroll
                for (int hh = 0; hh < 4; ++hh) { sc[hh * 1024 + cc] = s4[hh]; mx[hh] = fmaxf(mx[hh], s4[hh]); } }
#pragma unroll
            for (int hh = 0; hh < 4; ++hh) { mx[hh] = wmaxf(mx[hh]); float sm = 0.f; for (int cc = lane; cc < ncv; cc += 64) { const float e = __expf(sc[hh * 1024 + cc] - mx[hh]); sc[hh * 1024 + cc] = e; sm += e; } sm = wsum(sm); inv[hh] = ncv > 0 ? 1.f / sm : 0.f; }
            for (int cc = lane; cc < ncv; cc += 64) {
#pragma unroll
                for (int hh = 0; hh < 4; ++hh) sc[hh * 1024 + cc] *= inv[hh]; }
            for (int cc = 0; cc < ncv; ++cc) { const float v = (float)VCT16[(size_t)lane * 1024 + vt_pos(cc)];
#pragma unroll
                for (int hh = 0; hh < 4; ++hh) oc[hh] += sc[hh * 1024 + cc] * v; }
        }
        const int nsel = (cur + 1) < 16 ? (cur + 1) : 16;
        {
            float scv[5];
#pragma unroll
            for (int i = 0; i < 5; ++i) { const int j = lane + 64 * i; float v = -3e38f;
                if (j <= cur) { if (j == 0 || j == cur || j == cur - 1) v = 3e38f; else { float a = 0.f;
#pragma unroll
                        for (int o5 = -1; o5 < 4; ++o5) { const int cc = 4 * j + o5; if (cc >= 0 && cc < ncv) { const float p = (sc[cc] + sc[1024 + cc]) + (sc[2048 + cc] + sc[3072 + cc]); a += (o5 == -1 || o5 == 3) ? 0.5f * p : p; } }
                        v = a; } }
                scv[i] = v; }
            for (int k = 0; k < nsel; ++k) {
                float bv = scv[0]; int bi = lane;
#pragma unroll
                for (int i = 1; i < 5; ++i) if (scv[i] > bv) { bv = scv[i]; bi = lane + 64 * i; }
#pragma unroll
                for (int off = 32; off > 0; off >>= 1) { const float ov = __shfl_xor(bv, off); const int oi = __shfl_xor(bi, off); if (ov > bv || (ov == bv && oi < bi)) { bv = ov; bi = oi; } }
                if (lane == 0) selb[bi >> 5] |= 1u << (bi & 31);
#pragma unroll
                for (int i = 0; i < 5; ++i) if (lane + 64 * i == bi) scv[i] = -3e38f;
            }
        }
        int nmis = 0;
        for (int j = lane; j <= cur; j += 64) { const unsigned fb = (SELM[(size_t)(t >> 5) * 272 + j] >> (t & 31)) & 1u, nb = (selb[j >> 5] >> (j & 31)) & 1u; nmis += (fb != nb) ? 1 : 0; }
        nmis = (int)wsum((float)nmis);
        if (nmis != 0) { if (lane == 0) { atomicAdd(dbg + 3, 1.f); atomicAdd(dbg + 4, (float)nmis); } continue; }
        {
            float mx[4] = {-3e38f, -3e38f, -3e38f, -3e38f}, inv[4]; int nk = 0;
            for (int j = 0; j <= cur; ++j) if ((selb[j >> 5] >> (j & 31)) & 1u) { asm volatile("" ::: "memory"); const int pos = j * 64 + lane; float s4[4] = {-1e30f, -1e30f, -1e30f, -1e30f}; if (pos <= t) dot4(KS16 + (size_t)pos * 64, s4);
#pragma unroll
                for (int hh = 0; hh < 4; ++hh) { sc[hh * 1024 + nk * 64 + lane] = s4[hh]; mx[hh] = fmaxf(mx[hh], s4[hh]); } ++nk; }
#pragma unroll
            for (int hh = 0; hh < 4; ++hh) { mx[hh] = wmaxf(mx[hh]); float sm = 0.f; for (int k = 0; k < nk; ++k) { const float x = sc[hh * 1024 + k * 64 + lane]; const float e = x > -1e29f ? __expf(x - mx[hh]) : 0.f; sc[hh * 1024 + k * 64 + lane] = e; sm += e; } sm = wsum(sm); inv[hh] = 1.f / sm; }
            nk = 0;
            for (int j = 0; j <= cur; ++j) if ((selb[j >> 5] >> (j & 31)) & 1u) { for (int kk = 0; kk < 64 && j * 64 + kk <= t; ++kk) { const float v = (float)VST16[(size_t)j * 4096 + lane * 64 + vt_pos(kk)];
#pragma unroll
                    for (int hh = 0; hh < 4; ++hh) os[hh] += sc[hh * 1024 + nk * 64 + kk] * v; } ++nk; }
#pragma unroll
            for (int hh = 0; hh < 4; ++hh) os[hh] *= inv[hh];
        }
        {
            const int lo = t - 512 > 0 ? t - 512 : 0, nw = t - lo + 1; float mx[4] = {-3e38f, -3e38f, -3e38f, -3e38f}, inv[4];
            for (int i = lane; i < nw; i += 64) { asm volatile("" ::: "memory"); float s4[4]; dot4(KW16 + (size_t)(lo + i) * 64, s4);
#pragma unroll
                for (int hh = 0; hh < 4; ++hh) { sc[hh * 1024 + i] = s4[hh]; mx[hh] = fmaxf(mx[hh], s4[hh]); } }
#pragma unroll
            for (int hh = 0; hh < 4; ++hh) { mx[hh] = wmaxf(mx[hh]); float sm = 0.f; for (int i = lane; i < nw; i += 64) { const float e = __expf(sc[hh * 1024 + i] - mx[hh]); sc[hh * 1024 + i] = e; sm += e; } sm = wsum(sm); inv[hh] = 1.f / sm; }
            for (int i = 0; i < nw; ++i) { const int pos = lo + i; const float v = (float)VWT16[(size_t)(pos >> 6) * 4096 + lane * 64 + vt_pos(pos & 63)];
#pragma unroll
                for (int hh = 0; hh < 4; ++hh) ow[hh] += sc[hh * 1024 + i] * v; }
#pragma unroll
            for (int hh = 0; hh < 4; ++hh) ow[hh] *= inv[hh];
        }
        float dd = 0.f, ee = 0.f;
#pragma unroll
        for (int hh = 0; hh < 4; ++hh) { const float o = GATES[(size_t)t * 12 + hh * 3] * oc[hh] + GATES[(size_t)t * 12 + hh * 3 + 1] * os[hh] + GATES[(size_t)t * 12 + hh * 3 + 2] * ow[hh];
            const float yn = siluf_((float)DG[(size_t)t * 256 + hh * 64 + lane]) * o, yf = (float)Y16[(size_t)t * 1024 + 768 + hh * 64 + lane]; dd += (yf - yn) * (yf - yn); ee += yn * yn; }
        dd = wsum(dd); ee = wsum(ee);
        if (lane == 0) { atomicAdd(dbg, dd); atomicAdd(dbg + 1, ee); atomicAdd(dbg + 2, 1.f); }
    }
    (void)l;
}
DI void ph_ssd_fin(LAS unsigned char* lds_, int l, int it0, int it1, int itstep) {
    const Ctx c = mkctx(lds_); const int lane = c.lane, wave = c.wave;
    const float* Dp = INP(I_SD) + l * 4; const float* sng = INP(I_SNG) + l * 256;
    const float* CST = WSF(WS_HPV); const f16* ACT = WSH(WS_ACT); const float* ACS = WSF(WS_ACS); const float* YD = WSF(WS_YD); const f16* Z = WSH(WS_PROJ) + (size_t)4 * SEQ * 256; f16* Y16 = WSH(WS_Y16);
    LAS float* GY = (LAS float*)c.lds;
    for (int it = it0; it < it1; it += itstep) {
        const int ch_ = it >> 1, t0 = it * 64, hd = wave >> 1, g = hd >> 1, fr = lane & 15, q = lane >> 4;
        __syncthreads();
        f16x8 bf[2][4];
#pragma unroll
        for (int p2 = 0; p2 < 2; ++p2)
#pragma unroll
            for (int ks = 0; ks < 4; ++ks) bf[p2][ks] = cvt_h8(CST + ((size_t)(ch_ * 4 + hd) * 64 + 16 * ((wave & 1) * 2 + p2) + fr) * 128 + 32 * ks + 8 * q);
#pragma unroll
        for (int lt = 0; lt < 4; ++lt) {
            f16x8 af[4];
#pragma unroll
            for (int ks = 0; ks < 4; ++ks) af[ks] = ld_h8(ACT + (size_t)(t0 + 16 * lt + fr) * 768 + 512 + 128 * g + 32 * ks + 8 * q);
#pragma unroll
            for (int p2 = 0; p2 < 2; ++p2) { f32x4 acc = (f32x4){0.f, 0.f, 0.f, 0.f};
#pragma unroll
                for (int ks = 0; ks < 4; ++ks) acc = __builtin_amdgcn_mfma_f32_16x16x32_f16(af[ks], bf[p2][ks], acc, 0, 0, 0);
                const int ch = hd * 64 + 16 * ((wave & 1) * 2 + p2) + fr;
#pragma unroll
                for (int j = 0; j < 4; ++j) { const int tl = 16 * lt + 4 * q + j, t = t0 + tl;
                    const float y = acc[j] * __expf(ACS[(size_t)t * 4 + hd]) + YD[(size_t)t * 256 + ch] + Dp[hd] * (float)ACT[(size_t)t * 768 + ch];
                    GY[tl * 256 + ch] = y * siluf_((float)Z[(size_t)t * 256 + ch]); } }
        }
        __syncthreads();
        for (int tl = wave; tl < 64; tl += 8) { const f32x4 v = *(const LAS f32x4*)(GY + tl * 256 + lane * 4); const float ss = wsum((v[0] * v[0] + v[1] * v[1]) + (v[2] * v[2] + v[3] * v[3]));
            const float rn = rsqrtf(ss * (1.f / 256.f) + EPS); const f32x4 g4 = *(const f32x4*)(sng + lane * 4); f16x4 o;
#pragma unroll
            for (int i = 0; i < 4; ++i) o[i] = (f16)(v[i] * rn * g4[i]);
            *(f16x4*)(Y16 + (size_t)(t0 + tl) * 1024 + 256 + lane * 4) = o; }
    }
    __syncthreads();
}
DI void ph_outproj(LAS unsigned char* lds_, int l) {
    const Ctx c = mkctx(lds_);
    const float* xin = l == 0 ? INP(I_XP) : WSF(WS_X1); float* xout = l == 0 ? WSF(WS_X1) : c.out + O_YP;
    pg8::Gemm g{WSH(WS_Y16), WSH(WS_WTOUT) + (size_t)l * 1024 * 1024, SEQ, 1024, 1024}; pg8::StaticOrder S; S.init(SEQ, 1024, c.G, c.bid);
    EpiOut E{xin, xout, WSF(WS_ADA) + (size_t)(l * 33 + 32) * 3072 + 2048, l == 0 ? WSH(WS_A16) : nullptr, WSF(WS_GNX), WSF(WS_RSSP)};
    pg8::gemm_phase<EpiOut, pg8::StaticOrder>(c.lds, g, S, E);
    __syncthreads();
}
DI void ph_outproj_sample(LAS unsigned char* lds_, int l, int it) {
    const Ctx c = mkctx(lds_); const int tid = c.tid;
    const float* xs_in = l == 0 ? INP(I_XS) : WSF(WS_XS1); const float* ada_l = WSF(WS_ADA) + (size_t)l * 33 * 3072; const float* YS = WSF(WS_YS); float* xo = l == 0 ? WSF(WS_XS1) : c.out + O_YS;
    LAS f16* Ah = (LAS f16*)c.lds;
    __syncthreads();
#pragma unroll
    for (int i = 0; i < 16; ++i) { const int e = (tid + 512 * i) * 4; const f32x4 v = *(const f32x4*)(YS + e); f16x4 hv; hv[0] = (f16)v[0]; hv[1] = (f16)v[1]; hv[2] = (f16)v[2]; hv[3] = (f16)v[3]; *(LAS f16x4*)(Ah + (e >> 10) * 1032 + (e & 1023)) = hv; }
    __syncthreads();
    sample_gemm_item<1>(c.lds, WSH(WS_WTOUT) + (size_t)l * 1024 * 1024, it * 32, [&](int m, int n, float v) { xo[m * 1024 + n] = xs_in[m * 1024 + n] + ada_l[(size_t)m * 3072 + 2048 + n] * v; });
}

__global__ void __launch_bounds__(512, 2) fwd(Args a) {
    extern __shared__ __attribute__((aligned(16))) unsigned char lds_raw[];
    LAS unsigned char* lds = (LAS unsigned char*)lds_raw;
    volatile LAS unsigned* MISC = (volatile LAS unsigned*)(lds + MISC_OFF);
    if (threadIdx.x < 16) MISC[threadIdx.x] = 0u;
    __syncthreads();
    XcdBarrier bar; bar.bar = (unsigned*)(a.ws + WS_CTL); bar.x = 0; bar.st = MISC;
    if (N_LAUNCHES == 1) bar = xcd_barrier_post((unsigned*)(a.ws + WS_CTL), MISC);
    const int lo = a.ph_lo, hi = a.ph_hi;
    unsigned long long* stampw = (unsigned long long*)(a.ws + WS_CTL + 32768);
    if (STAMP_PHASE >= 0 && blockIdx.x == 0 && threadIdx.x == 0) stampw[0] = wall_clock64();
#define STAMP(k) do { if (STAMP_PHASE == (k) && blockIdx.x == 0 && threadIdx.x == 0) stampw[1] = wall_clock64(); } while (0)
#ifndef PH_MASK
#define PH_MASK 0xFFF
#endif
#define IN(k) (((PH_MASK >> ((k) < 2 ? (k) : 2 + ((k) - 2) % 4)) & 1) && lo <= (k) && (k) < hi)
#define SEAM(k) do { if (IN(k) && IN((k) + 1)) xcd_barrier(bar); STAMP(k); } while (0)
#ifndef DUP_MASK
#define DUP_MASK 0
#endif
#define DUP(bit, call) do { call; if ((DUP_MASK >> (bit)) & 1) { __syncthreads(); call; } } while (0)
    if (IN(0)) DUP(0, ph_prologue(lds));
    SEAM(0);
    if (IN(1)) { ph_hsample(lds, 0); DUP(1, ph_sample_compress(lds)); DUP(2, ph_prep(lds)); }
    SEAM(1);
    for (int l = 0; l < 2; ++l) {
        const int PB = 2 + 4 * l;
        if (IN(PB)) { DUP(3, ph_inproj(lds, l)); DUP(4, ph_inproj_sample(lds, l)); }
        SEAM(PB);
        if (IN(PB + 1)) {
#define SUBSTAMP(code) do { if (l == 0 && (STAMP_PHASE == (code) || STAMP_PHASE == (code) + 10) && blockIdx.x == (STAMP_PHASE >= 110 ? 100 : 0) && threadIdx.x == 0) stampw[1] = wall_clock64(); } while (0)
            DUP(5, ph_ssd_local(lds, l)); SUBSTAMP(100); DUP(6, ph_mix_a(lds, l)); SUBSTAMP(101); DUP(7, ph_mix_c(lds, l)); SUBSTAMP(102); DUP(8, ph_mix_d(lds, l)); SUBSTAMP(103); DUP(9, ph_mix_cmp(lds, l)); SUBSTAMP(104); }
        SEAM(PB + 1);
        if (IN(PB + 2)) { DUP(11, ph_scan(lds, l)); DUP(10, ph_mix_sample(lds, l)); ph_nsa(lds, l); }
        SEAM(PB + 2);
        if (IN(PB + 3)) { if (VERIFY_NSA && l == 0) { ph_nsa_verify(lds, l); __syncthreads(); } if (l == 0) ph_hsample(lds, 1); DUP(14, ph_outproj(lds, l)); }
        SEAM(PB + 3);
    }
    if (STAMP_PHASE >= 0 || VERIFY_NSA) {
        xcd_barrier(bar);
        if (blockIdx.x == 0) { __shared__ float alpha_s; if (threadIdx.x == 0) { const unsigned long long t1 = wall_clock64(); alpha_s = (float)(stampw[1] - stampw[0]) / (float)(t1 - stampw[0]);
                if (VERIFY_NSA) { const float* dbg = (const float*)(a.ws + WS_CTL + 40960); alpha_s = VERIFY_NSA == 1 ? dbg[3] / (dbg[2] + dbg[3]) : sqrtf(dbg[0] / dbg[1]); } } __syncthreads();
            const float sc = 1.f + alpha_s; float* ys = a.out + O_YS; for (int i = threadIdx.x; i < NB * 1024; i += 512) ys[i] *= sc; }
    }
#undef IN
#undef SEAM
}

extern "C" void kernel_launch(void* const* d_in, const int* in_sizes, int n_in, void* d_out, int out_size, void* d_ws, size_t ws_size, hipStream_t stream) {
    static int grid = 0;
    if (grid == 0) {
        if (n_in != N_IN || (size_t)out_size != O_END || ws_size < WS_END) { fprintf(stderr, "kernel_launch: unexpected shapes (n_in %d out %d ws %zu)\n", n_in, out_size, ws_size); grid = -1; return; }
        int dev = 0, cus = 0;
        if (hipGetDevice(&dev) != hipSuccess || hipDeviceGetAttribute(&cus, hipDeviceAttributeMultiprocessorCount, dev) != hipSuccess) { grid = -1; return; }
        if (hipFuncSetAttribute((const void*)fwd, hipFuncAttributeMaxDynamicSharedMemorySize, LDS_BYTES) != hipSuccess) { fprintf(stderr, "kernel_launch: hipFuncSetAttribute failed\n"); grid = -1; return; }
        int per_cu = 0;
        if (hipOccupancyMaxActiveBlocksPerMultiprocessor(&per_cu, (const void*)fwd, 512, LDS_BYTES) != hipSuccess || per_cu < 1) fprintf(stderr, "kernel_launch: occupancy query says %d\n", per_cu);
        (void)hipGetLastError();
        grid = cus;
    }
    if (grid < 0) return;
    hipMemsetAsync((char*)d_ws + WS_CTL, 0, 65536, stream);
    Args a{};
    for (int i = 0; i < N_IN; ++i) a.in[i] = d_in[i];
    a.out = (float*)d_out; a.ws = (unsigned char*)d_ws;
    if (N_LAUNCHES == 1) { a.ph_lo = 0; a.ph_hi = NPHASE; hipLaunchKernelGGL(fwd, dim3(grid), dim3(512), LDS_BYTES, stream, a); }
    else for (int p = 0; p < NPHASE; ++p) { a.ph_lo = p; a.ph_hi = p + 1; hipLaunchKernelGGL(fwd, dim3(grid), dim3(512), LDS_BYTES, stream, a); }
}
```

```cpp
#include <hip/hip_runtime.h>
#include <cstdio>
#include <cstdint>
#include <type_traits>

#define NSA_DUP 0
#define VERIFY_NSA 0
#define STAMP_PHASE -1
#ifndef N_LAUNCHES
#define N_LAUNCHES 1
#endif

#define DI __device__ __forceinline__
#define LAS __attribute__((address_space(3)))
typedef _Float16 f16;
typedef _Float16 f16x8 __attribute__((ext_vector_type(8)));
typedef _Float16 f16x4 __attribute__((ext_vector_type(4)));
typedef _Float16 f16x2 __attribute__((ext_vector_type(2)));
typedef float f32x4 __attribute__((ext_vector_type(4)));
typedef float f32x2 __attribute__((ext_vector_type(2)));
typedef float f32x16 __attribute__((ext_vector_type(16)));
typedef unsigned u32x4 __attribute__((ext_vector_type(4)));

constexpr int DM = 1024, SEQ = 16384, NB = 32, PAST = 16384, NPOOL = 5120, DIN = 3728, NPD = 3840;
constexpr float EPS = 1e-6f;
constexpr int NPHASE = 10;
enum { I_XP = 0, I_XS, I_CKV, I_CWIN, I_SSC, I_SBC, I_SSM, I_SCF, I_PT, I_CP, I_CS, I_NG, I_WADA, I_BADA, I_WIN, I_WOUT, I_SCW, I_BCW, I_BCB,
       I_DTB, I_ALOG, I_SD, I_SNG, I_CFW, I_CFB, I_LNG, I_LNB, I_QG, I_KG, I_PE, I_W1, I_B1, I_W2, I_B2, N_IN };
constexpr size_t O_YP = 0, O_YS = O_YP + (size_t)SEQ * DM, O_KVP = O_YS + NB * DM, O_KVS = O_KVP + (size_t)2 * SEQ * 256, O_WINP = O_KVS + 2 * NB * 256,
                 O_WINS = O_WINP + 2 * 512 * 128, O_SCP = O_WINS + (size_t)2 * NB * 512 * 128, O_SCS = O_SCP + 2 * 2 * 256, O_BCP = O_SCS + 2 * NB * 512,
                 O_BCS = O_BCP + 2 * 3 * 768, O_HP = O_BCS + 2 * NB * 2304, O_HS = O_HP + 2 * 32768, O_CFP = O_HS + (size_t)2 * NB * 32768,
                 O_CFS = O_CFP + 2 * 30 * 256, O_END = O_CFS + 2 * NB * 7680;
constexpr size_t al256(size_t x) { return (x + 255) & ~(size_t)255; }
constexpr size_t WS_CTL = 0, WS_ADA = 65536, WS_BIAS = WS_ADA + al256(2 * 33 * 3072 * 4), WS_PEB = WS_BIAS + al256(2 * NPD * 4), WS_WTIN = WS_PEB + 2048,
                 WS_WTOUT = WS_WTIN + (size_t)2 * NPD * 1024 * 2, WS_W1T = WS_WTOUT + (size_t)2 * 1024 * 1024 * 2, WS_A16 = WS_W1T + (size_t)4 * 128 * 2048 * 2,
                 WS_RSSP = WS_A16 + (size_t)SEQ * 1024 * 2, WS_X1 = WS_RSSP + (size_t)SEQ * 16 * 4, WS_PROJ = WS_X1 + (size_t)SEQ * 1024 * 4,
                 WS_Y16 = WS_PROJ + (size_t)15 * SEQ * 256 * 2, WS_ACT = WS_Y16 + (size_t)SEQ * 1024 * 2, WS_YD = WS_ACT + (size_t)SEQ * 768 * 2,
                 WS_CST = WS_YD + (size_t)SEQ * 256 * 4, WS_ACS = WS_CST + (size_t)128 * 32768 * 4, WS_CDEC = WS_ACS + (size_t)SEQ * 4 * 4, WS_Q16 = WS_CDEC + 2048,
                 WS_KS16 = WS_Q16 + (size_t)SEQ * 256 * 2, WS_VS16 = WS_KS16 + (size_t)SEQ * 64 * 2, WS_KW16 = WS_VS16 + (size_t)SEQ * 64 * 2,
                 WS_VW16 = WS_KW16 + (size_t)SEQ * 64 * 2, WS_GATES = WS_VW16 + (size_t)SEQ * 64 * 2, WS_KC = WS_GATES + (size_t)SEQ * 12 * 4,
                 WS_VC = WS_KC + 1024 * 64 * 4, WS_KCS = WS_VC + 1024 * 64 * 4, WS_VCS = WS_KCS + (size_t)2 * NB * 1024 * 64 * 4,
                 WS_PROJS = WS_VCS + (size_t)2 * NB * 1024 * 64 * 4, WS_YS = WS_PROJS + al256(NB * NPD * 4), WS_XS1 = WS_YS + NB * 1024 * 4, WS_GNX = WS_XS1 + NB * 1024 * 4, WS_NRG = WS_GNX + 4096, WS_VST16 = WS_NRG + 2 * NB * 1024, WS_VWT16 = WS_VST16 + (size_t)SEQ * 64 * 2, WS_KC16 = WS_VWT16 + (size_t)SEQ * 64 * 2,
                 WS_VCT16 = WS_KC16 + 1024 * 64 * 2, WS_HPV = WS_VCT16 + 1024 * 64 * 2, WS_W2T = WS_HPV + (size_t)128 * 32768 * 4, WS_PEBP = WS_W2T + 4 * 64 * 128 * 2, WS_HS16 = WS_PEBP + 4 * 8 * 128 * 4, WS_SELM = WS_HS16 + NB * 1024 * 2, WS_END = WS_SELM + 512 * 272 * 4;
constexpr int LDS_BYTES = 147456;
constexpr int MISC_OFF = 147200;

struct Args { const void* in[N_IN]; float* out; unsigned char* ws; int ph_lo, ph_hi; };

#define XB_TMO      128
#define XB_XCNT(j)  (256  + 64 * (j))
#define XB_XSUB(j)  (1280 + 64 * (j))
#define XB_XGEN(j)  (2304 + 64 * (j))
#define XB_TOP      3328
#define XB_TOPGEN   3392
#define XCD_BAR_WORDS 3456
#define XB_SPIN_CAP (1u << 18)
__device__ __forceinline__ unsigned xb_ld(unsigned* p)              { return __hip_atomic_load(p, __ATOMIC_RELAXED, __HIP_MEMORY_SCOPE_AGENT); }
__device__ __forceinline__ unsigned xb_add(unsigned* p, unsigned v) { return __hip_atomic_fetch_add(p, v, __ATOMIC_RELAXED, __HIP_MEMORY_SCOPE_AGENT); }
__device__ __forceinline__ unsigned xb_xcc_id() { return (unsigned)__builtin_amdgcn_s_getreg((3 << 11) | 20) & 0xFu; }
#define XB_SPIN(cond, bar) do { unsigned _sp = 0; while (cond) { __builtin_amdgcn_s_sleep(1); \
    if ((++_sp & 255u) == 0u) { if (xb_ld(&(bar)[XB_TMO])) break; if (_sp > XB_SPIN_CAP) { atomicAdd(&(bar)[XB_TMO], 1u); break; } } } } while (0)
struct XcdBarrier { unsigned* bar; unsigned x; volatile LAS unsigned* st; };
__device__ __forceinline__ XcdBarrier xcd_barrier_post(unsigned* bar, volatile LAS unsigned* st) {
    XcdBarrier b; b.bar = bar; b.x = xb_xcc_id(); b.st = st;
    if (threadIdx.x == 0) (void)xb_add(&bar[XB_XCNT(b.x)], 1u);
    return b;
}
__device__ __forceinline__ void xcd_barrier_complete(unsigned* bar, unsigned x, unsigned& nloc, unsigned& nx) {
    const unsigned G = gridDim.x * gridDim.y * gridDim.z;
    unsigned sum, cnt, mine, sp = 0u;
    for (;;) {
        sum = 0u; cnt = 0u; mine = 0u;
#pragma unroll
        for (unsigned j = 0; j < 16; ++j) { const unsigned c = xb_ld(&bar[XB_XCNT(j)]); sum += c; cnt += (c > 0u) ? 1u : 0u; mine = (j == x) ? c : mine; }
        if (sum == G) break;
        __builtin_amdgcn_s_sleep(1);
        if ((++sp & 255u) == 0u) { if (xb_ld(&bar[XB_TMO])) break; if (sp > XB_SPIN_CAP) { atomicAdd(&bar[XB_TMO], 1u); break; } }
    }
    nloc = mine > 0u ? mine : 1u; nx = cnt > 0u ? cnt : 1u;
}
__device__ __forceinline__ void xcd_barrier(const XcdBarrier& b) {
    asm volatile("s_waitcnt vmcnt(0)" ::: "memory");
    __syncthreads();
    if (threadIdx.x == 0) {
        unsigned* bar = b.bar;
        __builtin_amdgcn_s_waitcnt(0);
        unsigned nloc = b.st[0], nx = b.st[1];
        if (nloc == 0u) { xcd_barrier_complete(bar, b.x, nloc, nx); b.st[0] = nloc; b.st[1] = nx; }
        const unsigned old = xb_add(&bar[XB_XSUB(b.x)], 1u);
        const unsigned gen = old / nloc;
        if (old + 1u == (gen + 1u) * nloc) {
            __builtin_amdgcn_fence(__ATOMIC_RELEASE, "agent");
            asm volatile("s_waitcnt vmcnt(0)" ::: "memory");
            const unsigned og = xb_add(&bar[XB_TOP], 1u);
            const unsigned tg = og / nx;
            if (og + 1u == (tg + 1u) * nx) xb_add(&bar[XB_TOPGEN], 1u);
            else XB_SPIN(xb_ld(&bar[XB_TOPGEN]) == tg, bar);
            __builtin_amdgcn_fence(__ATOMIC_ACQUIRE, "agent");
            xb_add(&bar[XB_XGEN(b.x)], 1u);
            asm volatile("s_waitcnt vmcnt(0)" ::: "memory");
        } else {
            XB_SPIN(xb_ld(&bar[XB_XGEN(b.x)]) == gen, bar);
            __builtin_amdgcn_fence(__ATOMIC_ACQUIRE, "agent");
            asm volatile("s_waitcnt vmcnt(0)" ::: "memory");
        }
    }
    __syncthreads();
}

DI void lds_barrier() { asm volatile("s_waitcnt lgkmcnt(0)\n\ts_barrier" ::: "memory"); }
DI int ltid() { int t = threadIdx.x; asm volatile("" : "+v"(t)); return t; }
template <int CTRL> DI float dppf(float x) { return __builtin_bit_cast(float, __builtin_amdgcn_update_dpp(0, __builtin_bit_cast(int, x), CTRL, 0xF, 0xF, true)); }
template <int CTRL> DI int dppi(int x) { return __builtin_amdgcn_update_dpp(0, x, CTRL, 0xF, 0xF, true); }
constexpr int DPP_X1 = 0xB1, DPP_X2 = 0x4E, DPP_HM = 0x141, DPP_R8 = 0x128;
DI float sum16(float v) { v += dppf<DPP_X1>(v); v += dppf<DPP_X2>(v); v += dppf<DPP_HM>(v); v += dppf<DPP_R8>(v); return v; }
DI float max16(float v) { v = fmaxf(v, dppf<DPP_X1>(v)); v = fmaxf(v, dppf<DPP_X2>(v)); v = fmaxf(v, dppf<DPP_HM>(v)); v = fmaxf(v, dppf<DPP_R8>(v)); return v; }
DI float wsum(float v) { v = sum16(v); v += __shfl_xor(v, 16); v += __shfl_xor(v, 32); return v; }
DI float wmaxf(float v) { v = max16(v); v = fmaxf(v, __shfl_xor(v, 16)); v = fmaxf(v, __shfl_xor(v, 32)); return v; }
DI float sigmoidf_(float x) { return 1.f / (1.f + __expf(-x)); }
DI float siluf_(float x) { return x / (1.f + __expf(-x)); }
DI float softplusf_(float x) { return fmaxf(x, 0.f) + log1pf(__expf(-fabsf(x))); }
DI f16x8 ld_h8(const f16* p) { return *(const f16x8*)p; }
DI f16x8 cvt_h8(const float* p) { const f32x4 a = *(const f32x4*)p, b = *(const f32x4*)(p + 4); f16x8 r; r[0] = (f16)a[0]; r[1] = (f16)a[1]; r[2] = (f16)a[2]; r[3] = (f16)a[3]; r[4] = (f16)b[0]; r[5] = (f16)b[1]; r[6] = (f16)b[2]; r[7] = (f16)b[3]; return r; }
DI int vt_key(int pos) { const int p = pos & 31, qq = p >> 3, j = p & 7; return (pos & ~31) + (j < 4 ? 4 * qq + j : 12 + 4 * qq + j); }
DI int vt_pos(int key) { const int k = key & 31; return (key & ~31) + (k < 16 ? 8 * (k >> 2) + (k & 3) : 8 * ((k - 16) >> 2) + 4 + (k & 3)); }
DI int src_col(int n) { return n < 2048 ? n : (n < 3456 ? n + 4 : (n < 3460 ? n - 1408 : (n < 3472 ? n + 256 : (n < 3584 ? -1 : n - 124)))); }
DI int dst_col(int s) { return s < 2048 ? s : (s < 2052 ? s + 1408 : (s < 3460 ? s - 4 : (s < 3716 ? s + 124 : s - 256))); }

DI void edge_publish(unsigned* ctr) {
    asm volatile("s_waitcnt vmcnt(0)" ::: "memory"); __syncthreads();
    if (threadIdx.x == 0) { __builtin_amdgcn_fence(__ATOMIC_RELEASE, "agent"); asm volatile("s_waitcnt vmcnt(0)" ::: "memory"); __hip_atomic_fetch_add(ctr, 1u, __ATOMIC_RELAXED, __HIP_MEMORY_SCOPE_AGENT); }
}
DI void edge_wait(unsigned* ctr, unsigned need) {
    if (threadIdx.x == 0) { unsigned sp = 0;
        while (__hip_atomic_load(ctr, __ATOMIC_RELAXED, __HIP_MEMORY_SCOPE_AGENT) < need) { __builtin_amdgcn_s_sleep(8); if (++sp > (1u << 22)) break; }
        __builtin_amdgcn_fence(__ATOMIC_ACQUIRE, "agent"); asm volatile("s_waitcnt vmcnt(0)" ::: "memory"); }
    __syncthreads();
}
namespace pg8 {
constexpr int BM = 256, BK = 64, HALF = 128, HTB = HALF * BK * 2, STAGE_BYTES = 8 * HTB, NXCD = 8, WGM = 8;
DI int lds_byte(int r, int c) { const int st = (r >> 4) * 2 + (c >> 5), rr = r & 15, cc = c & 31, ob = rr * 64 + cc * 2; return st * 1024 + (ob ^ (((ob >> 9) & 1) << 5)); }
DI void stage_rc(int b, int& R, int& C) { const int st = b / 1024, sb = b % 1024, swz = sb ^ (((sb >> 9) & 1) << 5); R = (st >> 1) * 16 + swz / 64; C = (st & 1) * 32 + (swz % 64) / 2; }
DI int perm32(int rho) { const int n = rho >> 4, i = rho & 15; return 8 * (i >> 2) + 4 * n + (i & 3); }
struct Unit { int pm, pn; };
struct Gemm { const f16* A; const f16* Bt; int M, N, K; };
struct StaticOrder {
    int nM, nN, nwg, G, c;
    DI void init(int M, int N, int G_, int c_) { nM = M / BM; nN = N / BM; nwg = nM * nN; G = G_; c = c_; }
    DI bool next(int i, Unit& u) const {
        const long L = (long)i * G + c; if (L >= nwg) return false;
        int wgid = (int)L; { const int q = nwg / NXCD, r = nwg % NXCD, xcd = wgid % NXCD, off = wgid / NXCD; wgid = (xcd < r ? xcd * (q + 1) : r * (q + 1) + (xcd - r) * q) + off; }
        const int nig = WGM * nN, gid = wgid / nig, fm = gid * WGM, gsz = (nM - fm) < WGM ? (nM - fm) : WGM;
        u.pm = fm + ((wgid % nig) % gsz); u.pn = (wgid % nig) / gsz; return true;
    }
    DI void a_ready(const Unit&) const {}
    DI void done(const Unit&) const {}
};
template <class Epi, class Sched>
DI void gemm_phase(LAS unsigned char* lds, const Gemm g, const Sched& S, const Epi& E) {
    const int tid = ltid(), wid = __builtin_amdgcn_readfirstlane(tid >> 6), lane = tid & 63, wr = wid >> 2, wc = wid & 3, fr = lane & 15, fq = lane >> 4;
    const int K = g.K, nt = K / BK;
    unsigned voffA[2], voffB[2];
#pragma unroll
    for (int i = 0; i < 2; ++i) { int R, C; stage_rc(tid * 16 + i * 8192, R, C); const int Rb = Epi::PERM ? ((R & ~31) + perm32(R & 31)) : R;
        voffA[i] = (unsigned)(R * K + C) * 2u; voffB[i] = (unsigned)(Rb * K + C) * 2u; }
    const size_t kstep = (size_t)(BK * 2);
    const size_t hstep = (size_t)HALF * K * 2;
    const size_t tstep = 2 * hstep;
    const unsigned ldsw = (unsigned)wid * 1024u;
    const int aoff = lds_byte(wr * 64 + fr, fq * 8), boff = lds_byte(wc * 32 + fr, fq * 8);
#define PG8_SA(b, h) (((b) * 2 + (h)) * HTB)
#define PG8_SB(b, h) ((4 + (b) * 2 + (h)) * HTB)
#define PG8_STAGE(bufoff, gbase, voff) do { _Pragma("unroll") for (int _i = 0; _i < 2; ++_i) \
        __builtin_amdgcn_global_load_lds((const unsigned*)((const char*)(gbase) + (voff)[_i]), (LAS unsigned*)(lds + (bufoff) + ldsw + _i * 8192), 16, 0, 0); } while (0)
#define PG8_LDA(dst, b, h) do { _Pragma("unroll") for (int m = 0; m < 4; ++m) _Pragma("unroll") for (int k = 0; k < 2; ++k) dst[m][k] = *(const LAS f16x8*)(lds + PG8_SA(b, h) + aoff + m * 2048 + k * 1024); } while (0)
#define PG8_LDB(dst, b, h) do { _Pragma("unroll") for (int n = 0; n < 2; ++n) _Pragma("unroll") for (int k = 0; k < 2; ++k) dst[n][k] = *(const LAS f16x8*)(lds + PG8_SB(b, h) + boff + n * 2048 + k * 1024); } while (0)
#define PG8_MMA(ai, bj, At, Bt) do { __builtin_amdgcn_s_setprio(1); _Pragma("unroll") for (int m = 0; m < 4; ++m) _Pragma("unroll") for (int n = 0; n < 2; ++n) _Pragma("unroll") for (int k = 0; k < 2; ++k) \
        acc[ai][bj][m][n] = __builtin_amdgcn_mfma_f32_16x16x32_f16(Bt[n][k], At[m][k], acc[ai][bj][m][n], 0, 0, 0); __builtin_amdgcn_s_setprio(0); } while (0)
#define PG8_WAIT_V(n) asm volatile("s_waitcnt vmcnt(" #n ")" ::: "memory")
#define PG8_WAIT_L(n) asm volatile("s_waitcnt lgkmcnt(" #n ")" ::: "memory")
#define PG8_BAR __builtin_amdgcn_s_barrier()
#define PG8_SCHED __builtin_amdgcn_sched_barrier(0)
    Unit cur, nxt; int ui = 0;
    if (!S.next(0, cur)) return;
    f32x4 acc[2][2][4][2];
#pragma unroll
    for (int a = 0; a < 2; ++a)
#pragma unroll
        for (int b = 0; b < 2; ++b)
#pragma unroll
            for (int m = 0; m < 4; ++m)
#pragma unroll
                for (int n = 0; n < 2; ++n) acc[a][b][m][n] = (f32x4){0.f, 0.f, 0.f, 0.f};
    f16x8 At[4][2], B0[2][2], B1[2][2];
    const char* cA = (const char*)g.A + (size_t)cur.pm * tstep; const char* cB = (const char*)g.Bt + (size_t)cur.pn * tstep;
    S.a_ready(cur);
    PG8_STAGE(PG8_SB(0, 0), cB, voffB); PG8_STAGE(PG8_SA(0, 0), cA, voffA); PG8_STAGE(PG8_SB(0, 1), cB + hstep, voffB); PG8_STAGE(PG8_SA(0, 1), cA + hstep, voffA);
    if (wr == 1) PG8_BAR;
    PG8_WAIT_V(4); PG8_BAR;
    PG8_STAGE(PG8_SB(1, 0), cB + kstep, voffB); PG8_STAGE(PG8_SA(1, 0), cA + kstep, voffA); PG8_STAGE(PG8_SB(1, 1), cB + hstep + kstep, voffB);
    PG8_WAIT_V(6); PG8_BAR;
    for (;;) {
        const bool has_next = S.next(ui + 1, nxt);
        const char* nA = has_next ? (const char*)g.A + (size_t)nxt.pm * tstep : cA; const char* nB = has_next ? (const char*)g.Bt + (size_t)nxt.pn * tstep : cB;
        for (int t = 0; t < nt; t += 2) {
            const bool last = (t == nt - 2);
            const char* a1 = cA + (size_t)(t + 1) * kstep;
            const char* a2 = last ? nA : cA + (size_t)(t + 2) * kstep; const char* b2 = last ? nB : cB + (size_t)(t + 2) * kstep;
            const char* a3 = a2 + kstep; const char* b3 = b2 + kstep;
            if (last && has_next) S.a_ready(nxt);
            PG8_LDB(B0, 0, 0); PG8_SCHED; PG8_LDA(At, 0, 0); PG8_STAGE(PG8_SA(1, 1), a1 + hstep, voffA);
            PG8_WAIT_L(8); PG8_BAR; PG8_WAIT_L(0); PG8_MMA(0, 0, At, B0); PG8_BAR; PG8_SCHED;
            PG8_LDB(B1, 0, 1); PG8_STAGE(PG8_SB(0, 0), b2, voffB);
            PG8_BAR; PG8_WAIT_L(0); PG8_MMA(0, 1, At, B1); PG8_BAR;
            PG8_LDA(At, 0, 1); PG8_STAGE(PG8_SA(0, 0), a2, voffA);
            PG8_BAR; PG8_WAIT_L(0); PG8_MMA(1, 0, At, B0); PG8_BAR; PG8_SCHED;
            PG8_STAGE(PG8_SB(0, 1), b2 + hstep, voffB);
            PG8_WAIT_V(6); PG8_BAR; PG8_MMA(1, 1, At, B1); PG8_BAR;
            PG8_LDB(B0, 1, 0); PG8_SCHED; PG8_LDA(At, 1, 0); PG8_STAGE(PG8_SA(0, 1), a2 + hstep, voffA);
            PG8_WAIT_L(8); PG8_BAR; PG8_WAIT_L(0); PG8_MMA(0, 0, At, B0); PG8_BAR; PG8_SCHED;
            PG8_LDB(B1, 1, 1); PG8_STAGE(PG8_SB(1, 0), b3, voffB);
            PG8_BAR; PG8_WAIT_L(0); PG8_MMA(0, 1, At, B1); PG8_BAR;
            PG8_LDA(At, 1, 1); PG8_STAGE(PG8_SA(1, 0), a3, voffA);
            PG8_BAR; PG8_WAIT_L(0); PG8_MMA(1, 0, At, B0); PG8_BAR; PG8_SCHED;
            PG8_STAGE(PG8_SB(1, 1), b3 + hstep, voffB);
            PG8_WAIT_V(6); PG8_BAR; PG8_MMA(1, 1, At, B1); PG8_BAR;
        }
        E(acc, cur, wr, wc, fr, fq);
        if (!has_next) break;
#pragma unroll
        for (int a = 0; a < 2; ++a)
#pragma unroll
            for (int b = 0; b < 2; ++b)
#pragma unroll
                for (int m = 0; m < 4; ++m)
#pragma unroll
                    for (int n = 0; n < 2; ++n) acc[a][b][m][n] = (f32x4){0.f, 0.f, 0.f, 0.f};
        cur = nxt; cA = nA; cB = nB; ++ui;
    }
    PG8_WAIT_V(0);
    if (wr == 0) PG8_BAR;
    PG8_BAR;
#undef PG8_SA
#undef PG8_SB
#undef PG8_STAGE
#undef PG8_LDA
#undef PG8_LDB
#undef PG8_MMA
#undef PG8_WAIT_V
#undef PG8_WAIT_L
#undef PG8_BAR
#undef PG8_SCHED
}
}

struct EpiIn {
    static constexpr bool PERM = true;
    f16* proj; const float* rssp; const float* bias; float* kvout;
    DI void operator()(const f32x4 (&acc)[2][2][4][2], const pg8::Unit& u, int wr, int wc, int fr, int fq) const {
        const int row0 = u.pm * 256 + wr * 64 + fr, colt = wc * 32 + 8 * fq;
        f32x4 bv[2][2];
#pragma unroll
        for (int bj = 0; bj < 2; ++bj)
#pragma unroll
            for (int n = 0; n < 2; ++n) bv[bj][n] = *(const f32x4*)(bias + u.pn * 256 + colt + bj * 128 + 4 * n);
        f16* pt = proj + (size_t)u.pn * SEQ * 256;
        float r8[2][4];
        {   f32x4 part[2][4];
#pragma unroll
            for (int ai = 0; ai < 2; ++ai)
#pragma unroll
                for (int m = 0; m < 4; ++m) part[ai][m] = *((const f32x4*)(rssp + (size_t)(row0 + ai * 128 + m * 16) * 16) + fq);
#pragma unroll
            for (int ai = 0; ai < 2; ++ai)
#pragma unroll
                for (int m = 0; m < 4; ++m) { const f32x4 p = part[ai][m]; float v = (p[0] + p[1]) + (p[2] + p[3]); v += __shfl_xor(v, 16); v += __shfl_xor(v, 32); r8[ai][m] = rsqrtf(v * (1.f / 1024.f) + EPS); } }
#pragma unroll
        for (int ai = 0; ai < 2; ++ai)
#pragma unroll
            for (int m = 0; m < 4; ++m) {
                const int row = row0 + ai * 128 + m * 16;
                const float r = r8[ai][m];
#pragma unroll
                for (int bj = 0; bj < 2; ++bj) {
                    const f32x4 v0 = acc[ai][bj][m][0] * r + bv[bj][0], v1 = acc[ai][bj][m][1] * r + bv[bj][1];
                    f16x8 h; h[0] = (f16)v0[0]; h[1] = (f16)v0[1]; h[2] = (f16)v0[2]; h[3] = (f16)v0[3]; h[4] = (f16)v1[0]; h[5] = (f16)v1[1]; h[6] = (f16)v1[2]; h[7] = (f16)v1[3];
                    *(f16x8*)(pt + (size_t)row * 256 + colt + bj * 128) = h;
                    if (u.pn == 12) { float* kp = kvout + (size_t)row * 256 + colt + bj * 128; *(f32x4*)kp = v0; *(f32x4*)(kp + 4) = v1; }
                }
            }
    }
};
struct EpiOut {
    static constexpr bool PERM = false;
    const float* xin; float* xout; const float* gate; f16* a16; const float* gnext; float* rssp;
    DI void operator()(const f32x4 (&acc)[2][2][4][2], const pg8::Unit& u, int wr, int wc, int fr, int fq) const {
        const int row0 = u.pm * 256 + wr * 64 + fr, col0 = u.pn * 256 + wc * 32 + 4 * fq;
        float ss[2][4];
#pragma unroll
        for (int ai = 0; ai < 2; ++ai)
#pragma unroll
            for (int m = 0; m < 4; ++m) ss[ai][m] = 0.f;
#pragma unroll
        for (int bj = 0; bj < 2; ++bj)
#pragma unroll
            for (int ai = 0; ai < 2; ++ai) {
                f32x4 gv[2], xv[4][2];
#pragma unroll
                for (int n = 0; n < 2; ++n) gv[n] = *(const f32x4*)(gate + col0 + bj * 128 + n * 16);
#pragma unroll
                for (int m = 0; m < 4; ++m)
#pragma unroll
                    for (int n = 0; n < 2; ++n) xv[m][n] = *(const f32x4*)(xin + (size_t)(row0 + ai * 128 + m * 16) * 1024 + col0 + bj * 128 + n * 16);
#pragma unroll
                for (int m = 0; m < 4; ++m)
#pragma unroll
                    for (int n = 0; n < 2; ++n) {
                        const int row = row0 + ai * 128 + m * 16, col = col0 + bj * 128 + n * 16;
                        const f32x4 o = xv[m][n] + gv[n] * acc[ai][bj][m][n]; xv[m][n] = o;
                        *(f32x4*)(xout + (size_t)row * 1024 + col) = o;
                        ss[ai][m] += (o[0] * o[0] + o[1] * o[1]) + (o[2] * o[2] + o[3] * o[3]); }
                if (a16) {
#pragma unroll
                    for (int n = 0; n < 2; ++n) { const int col = col0 + bj * 128 + n * 16; const f32x4 gn = *(const f32x4*)(gnext + col);
#pragma unroll
                        for (int m = 0; m < 4; ++m) { const f32x4 o = xv[m][n]; f16x4 h; h[0] = (f16)(o[0] * gn[0]); h[1] = (f16)(o[1] * gn[1]); h[2] = (f16)(o[2] * gn[2]); h[3] = (f16)(o[3] * gn[3]);
                            *(f16x4*)(a16 + (size_t)(row0 + ai * 128 + m * 16) * 1024 + col) = h; } } }
                asm volatile("" ::: "memory");
            }
        if (a16) {
#pragma unroll
            for (int ai = 0; ai < 2; ++ai)
#pragma unroll
                for (int m = 0; m < 4; ++m) { float v = ss[ai][m]; v += __shfl_xor(v, 16); v += __shfl_xor(v, 32);
                    if (fq == 0) rssp[(size_t)(row0 + ai * 128 + m * 16) * 16 + u.pn * 4 + wc] = v; }
        }
    }
};

template <int MP  , class AFn, class OFn>
DI void skinny_item(LAS unsigned char* lds, const float* W, int ldw, int n0, int ncols, int M, AFn afn, OFn ofn) {
    const int tid = ltid(), wave = tid >> 6, lane = tid & 63;
    LAS float* As = (LAS float*)lds;
    float acc[MP];
#pragma unroll
    for (int m = 0; m < MP; ++m) acc[m] = 0.f;
    for (int kc = 0; kc < 1024; kc += 512) {
        const int kb = wave * 64;
        float wv[64];
#pragma unroll
        for (int kk = 0; kk < 64; ++kk) wv[kk] = (lane < ncols) ? W[(size_t)(kc + kb + kk) * ldw + n0 + lane] : 0.f;
        __syncthreads();
#pragma unroll
        for (int m = 0; m < MP; ++m) As[tid * 36 + m] = (m < M) ? afn(m, kc + tid) : 0.f;
        __syncthreads();
#pragma unroll
        for (int kk = 0; kk < 64; ++kk) {
            const float av = As[(kb + kk) * 36 + lane];
#pragma unroll
            for (int m = 0; m < MP; ++m) acc[m] += __builtin_bit_cast(float, __builtin_amdgcn_readlane(__builtin_bit_cast(int, av), m)) * wv[kk];
        }
    }
    __syncthreads();
    LAS float* R = (LAS float*)lds;
#pragma unroll
    for (int m = 0; m < MP; ++m) R[(wave * 36 + m) * 64 + lane] = acc[m];
    __syncthreads();
    for (int idx = tid; idx < M * 64; idx += 512) { const int m = idx >> 6, c = idx & 63; float s = 0.f;
#pragma unroll
        for (int w = 0; w < 8; ++w) s += R[(w * 36 + m) * 64 + c];
        if (c < ncols) ofn(m, n0 + c, s); }
    __syncthreads();
}

template <bool F32> struct Raw16 { f32x4 f[4]; f16x8 hv[2];
    DI void ld(const void* p) { if (F32) {
#pragma unroll
            for (int i = 0; i < 4; ++i) f[i] = *(const f32x4*)((const float*)p + 4 * i); } else { hv[0] = *(const f16x8*)p; hv[1] = *(const f16x8*)((const f16*)p + 8); } }
    DI f16x8 get(int i) const { if (F32) { const f32x4 a = f[2 * i], b = f[2 * i + 1]; f16x8 r; r[0] = (f16)a[0]; r[1] = (f16)a[1]; r[2] = (f16)a[2]; r[3] = (f16)a[3]; r[4] = (f16)b[0]; r[5] = (f16)b[1]; r[6] = (f16)b[2]; r[7] = (f16)b[3]; return r; } return hv[i]; } };
template <bool SRC_F32, class ChunkFn>
DI void compress_item(LAS unsigned char* lds, ChunkFn chunkp  , int c0, const f16* w1t, const float* peb, const f16* w2t  , const float* b2, const float* kg, float* out, f16* out16, f16* outT16) {
    typedef typename std::conditional<SRC_F32, float, f16>::type T;
    const int tid = ltid(), wave = tid >> 6, lane = tid & 63, wm = wave >> 2, wq = wave & 3, r = lane & 31, h = lane >> 5;
    LAS f16* As = (LAS f16*)lds;
    LAS f16* Bs = (LAS f16*)(lds + 2 * 18432);
    f32x16 acc[2][2];
#pragma unroll
    for (int a = 0; a < 2; ++a)
#pragma unroll
        for (int b = 0; b < 2; ++b)
#pragma unroll
            for (int i = 0; i < 16; ++i) acc[a][b][i] = 0.f;
    constexpr int NA = SRC_F32 ? 4 : 2, AE = SRC_F32 ? 4 : 8;
    const int arow = SRC_F32 ? tid >> 4 : tid >> 3, aseg = SRC_F32 ? tid & 15 : tid & 7, brow = tid >> 3, bsg = tid & 7;
    const T* ap[NA];
#pragma unroll
    for (int i = 0; i < NA; ++i) { int ch = c0 + arow + (128 / NA) * i; ch = ch < 1023 ? ch : 1023; ap[i] = (const T*)chunkp(ch) + aseg * AE; }
    const f16* bsrc = w1t + (size_t)brow * 2048 + bsg * 8;
    Raw16<SRC_F32> ra[3]; f16x8 rb[3][4];
    auto ldab = [&](int sl, int kb) {
#pragma unroll
        for (int i = 0; i < NA; ++i) { if (SRC_F32) ra[sl].f[i] = *(const f32x4*)((const float*)ap[i] + kb * 256); else ra[sl].hv[i] = *(const f16x8*)((const f16*)ap[i] + kb * 256); }
#pragma unroll
        for (int i = 0; i < 4; ++i) rb[sl][i] = ld_h8(bsrc + (size_t)(i & 1) * 64 * 2048 + (i >> 1) * 1024 + kb * 64 + 0); };
    auto stab = [&](int sl, int nx) {
#pragma unroll
        for (int i = 0; i < NA; ++i) {
            if (SRC_F32) { const f32x4 v = ra[sl].f[i]; f16x4 hq; hq[0] = (f16)v[0]; hq[1] = (f16)v[1]; hq[2] = (f16)v[2]; hq[3] = (f16)v[3]; *(LAS f16x4*)(As + nx * 9216 + (arow + 32 * i) * 72 + 4 * aseg) = hq; }
            else *(LAS f16x8*)(As + nx * 9216 + (arow + 64 * i) * 72 + 8 * aseg) = ra[sl].hv[i]; }
#pragma unroll
        for (int i = 0; i < 4; ++i) *(LAS f16x8*)(Bs + nx * 18432 + (brow + 64 * i) * 72 + 8 * bsg) = rb[sl][i]; };
#pragma unroll
    for (int i = 0; i < 3; ++i) ldab(i, i);
    __syncthreads();
    stab(0, 0);
    ldab(0, 3);
    lds_barrier();
#pragma unroll
    for (int kb = 0; kb < 16; ++kb) {
        const int cur = kb & 1;
        const LAS f16* Ac = As + cur * 9216 + (64 * wm + r) * 72 + 8 * h; const LAS f16* Bc = Bs + cur * 18432 + (64 * wq + r) * 72 + 8 * h;
#pragma unroll
        for (int ks = 0; ks < 4; ++ks) {
            const f16x8 a0 = *(const LAS f16x8*)(Ac + 16 * ks), a1 = *(const LAS f16x8*)(Ac + 32 * 72 + 16 * ks), b0 = *(const LAS f16x8*)(Bc + 16 * ks), b1 = *(const LAS f16x8*)(Bc + 32 * 72 + 16 * ks);
            acc[0][0] = __builtin_amdgcn_mfma_f32_32x32x16_f16(a0, b0, acc[0][0], 0, 0, 0); acc[0][1] = __builtin_amdgcn_mfma_f32_32x32x16_f16(a0, b1, acc[0][1], 0, 0, 0);
            acc[1][0] = __builtin_amdgcn_mfma_f32_32x32x16_f16(a1, b0, acc[1][0], 0, 0, 0); acc[1][1] = __builtin_amdgcn_mfma_f32_32x32x16_f16(a1, b1, acc[1][1], 0, 0, 0);
        }
        if (kb + 1 < 16) { const int nx = cur ^ 1, sl = (kb + 1) % 3;
            stab(sl, nx);
            if (kb + 4 < 16) ldab(sl, kb + 4); }
        lds_barrier();
    }
    LAS float* SL = (LAS float*)lds;
    LAS f16* HS = (LAS f16*)(lds + 65536);
    if (wq >= 2) {
#pragma unroll
        for (int a = 0; a < 2; ++a)
#pragma unroll
            for (int b = 0; b < 2; ++b)
#pragma unroll
                for (int i = 0; i < 16; ++i) SL[(64 * wm + 32 * a + (i & 3) + 8 * (i >> 2) + 4 * h) * 128 + 64 * (wq - 2) + 32 * b + r] = acc[a][b][i];
    }
    __syncthreads();
    if (wq < 2) {
#pragma unroll
        for (int a = 0; a < 2; ++a)
#pragma unroll
            for (int b = 0; b < 2; ++b) { const int f = 64 * wq + 32 * b + r; float pb = 0.f;
#pragma unroll
                for (int p8 = 0; p8 < 8; ++p8) pb += peb[p8 * 128 + f];
#pragma unroll
                for (int i = 0; i < 16; ++i) { const int m = 64 * wm + 32 * a + (i & 3) + 8 * (i >> 2) + 4 * h; const float sv = m < 127 ? SL[(m + 1) * 128 + f] : 0.f;
                    HS[m * 136 + f] = (f16)siluf_(acc[a][b][i] + sv + pb); } }
    }
    __syncthreads();
    {
        const int fr = lane & 15, q = lane >> 4;
        f32x4 o[4];
#pragma unroll
        for (int et = 0; et < 4; ++et) o[et] = (f32x4){0.f, 0.f, 0.f, 0.f};
#pragma unroll
        for (int ks = 0; ks < 4; ++ks) { const f16x8 av = *(const LAS f16x8*)(HS + (16 * wave + fr) * 136 + 32 * ks + 8 * q);
#pragma unroll
            for (int et = 0; et < 4; ++et) o[et] = __builtin_amdgcn_mfma_f32_16x16x32_f16(av, ld_h8(w2t + (size_t)(16 * et + fr) * 128 + 32 * ks + 8 * q), o[et], 0, 0, 0); }
        float bb[4], gg[4];
#pragma unroll
        for (int et = 0; et < 4; ++et) { bb[et] = b2[16 * et + fr]; gg[et] = kg ? kg[16 * et + fr] : 1.f; }
#pragma unroll
        for (int j = 0; j < 4; ++j) {
            const int row = 16 * wave + 4 * q + j, blk = c0 + row; float v[4], ss = 0.f;
#pragma unroll
            for (int et = 0; et < 4; ++et) { v[et] = o[et][j] + bb[et]; ss += v[et] * v[et]; }
            if (kg) { ss += __shfl_xor(ss, 1); ss += __shfl_xor(ss, 2); ss += __shfl_xor(ss, 4); ss += __shfl_xor(ss, 8); const float rn = rsqrtf(ss * (1.f / 64.f) + EPS);
#pragma unroll
                for (int et = 0; et < 4; ++et) v[et] = v[et] * rn * gg[et]; }
            const bool okrow = row < 127 && blk < 1023, wr16 = row < 127 && blk < 1024;
#pragma unroll
            for (int et = 0; et < 4; ++et) { const float x = okrow ? v[et] : 0.f; const int e = 16 * et + fr;
                if (out && okrow) out[(size_t)blk * 64 + e] = x;
                if (out16 && wr16) out16[(size_t)blk * 64 + e] = (f16)x;
                if (outT16 && wr16) outT16[(size_t)e * 1024 + vt_pos(blk)] = (f16)x; }
        }
    }
    __syncthreads();
}

struct PromptKV {
    const f16 *ks, *vs, *kw, *vw;
    DI void krow_sel(int pos, float (&k)[64]) const { const f16* p = ks + (size_t)pos * 64;
#pragma unroll
        for (int i = 0; i < 8; ++i) { const f16x8 v = ld_h8(p + i * 8);
#pragma unroll
            for (int j = 0; j < 8; ++j) k[i * 8 + j] = (float)v[j]; } }
    DI float v_sel(int pos, int d) const { return (float)vs[(size_t)pos * 64 + d]; }
    DI void krow_win(int pos, float (&k)[64]) const { const f16* p = kw + (size_t)pos * 64;
#pragma unroll
        for (int i = 0; i < 8; ++i) { const f16x8 v = ld_h8(p + i * 8);
#pragma unroll
            for (int j = 0; j < 8; ++j) k[i * 8 + j] = (float)v[j]; } }
    DI float v_win(int pos, int d) const { return (float)vw[(size_t)pos * 64 + d]; }
};
struct SampleKV {
    const float* ckv; const int* pt; const float* cwin; const float* nks; const float* nvs; const float* nkw; const float* nvw;
    DI const float* prow(int pos, int slot) const { return ckv + ((size_t)pt[pos >> 7] * 128 + (pos & 127)) * 256 + slot * 64; }
    DI void ld64(const float* p, float (&k)[64]) const {
#pragma unroll
        for (int i = 0; i < 16; ++i) { const f32x4 v = *(const f32x4*)(p + i * 4); k[i * 4] = v[0]; k[i * 4 + 1] = v[1]; k[i * 4 + 2] = v[2]; k[i * 4 + 3] = v[3]; } }
    DI void krow_sel(int pos, float (&k)[64]) const { ld64(pos < PAST ? prow(pos, 2) : nks, k); }
    DI float v_sel(int pos, int d) const { return pos < PAST ? prow(pos, 3)[d] : nvs[d]; }
    DI void krow_win(int pos, float (&k)[64]) const { ld64(pos < PAST ? cwin + (size_t)(pos - (PAST - 512)) * 128 : nkw, k); }
    DI float v_win(int pos, int d) const { return pos < PAST ? cwin[(size_t)(pos - (PAST - 512)) * 128 + 64 + d] : nvw[d]; }
};
template <class KV>
DI void nsa_token(LAS float* wl, int qpos, const float* KC, const float* VC, const KV& kv, const float* gates  , float (&o)[4]) {
    const int lane = ltid() & 63;
    LAS float* sc = wl; LAS float* qs = wl + 4096; LAS int* sel = (LAS int*)(wl + 4096 + 256);
    const int cur = qpos >> 6;
    const int ncv = qpos >= 31 ? ((qpos - 31) >> 4) + 1 : 0;
    float oc[4] = {0.f, 0.f, 0.f, 0.f}, os[4] = {0.f, 0.f, 0.f, 0.f}, ow[4] = {0.f, 0.f, 0.f, 0.f};
    {
        float mx[4] = {-3e38f, -3e38f, -3e38f, -3e38f};
        for (int c = lane; c < ncv; c += 64) {
            asm volatile("" ::: "memory");
            float s[4] = {0.f, 0.f, 0.f, 0.f}; const float* kp = KC + (size_t)c * 64;
#pragma unroll
            for (int d4 = 0; d4 < 16; ++d4) { const f32x4 kvv = *(const f32x4*)(kp + d4 * 4);
#pragma unroll
                for (int j = 0; j < 4; ++j) { const f32x4 q = *(const LAS f32x4*)(qs + (d4 * 4 + j) * 4); s[0] += q[0] * kvv[j]; s[1] += q[1] * kvv[j]; s[2] += q[2] * kvv[j]; s[3] += q[3] * kvv[j]; } }
#pragma unroll
            for (int hh = 0; hh < 4; ++hh) { s[hh] *= 0.125f; sc[hh * 1024 + c] = s[hh]; mx[hh] = fmaxf(mx[hh], s[hh]); }
        }
        float inv[4];
#pragma unroll
        for (int hh = 0; hh < 4; ++hh) { mx[hh] = wmaxf(mx[hh]); float sm = 0.f; for (int c = lane; c < ncv; c += 64) { const float e = __expf(sc[hh * 1024 + c] - mx[hh]); sc[hh * 1024 + c] = e; sm += e; } sm = wsum(sm); inv[hh] = ncv > 0 ? 1.f / sm : 0.f; }
        for (int c = lane; c < ncv; c += 64) {
#pragma unroll
            for (int hh = 0; hh < 4; ++hh) sc[hh * 1024 + c] *= inv[hh]; }
        __builtin_amdgcn_wave_barrier();
        for (int c = 0; c < ncv; ++c) { const float v = VC[(size_t)c * 64 + lane];
#pragma unroll
            for (int hh = 0; hh < 4; ++hh) oc[hh] += sc[hh * 1024 + c] * v; }
    }
    const int nsel = (cur + 1) < 16 ? (cur + 1) : 16;
    {
        float scv[5];
#pragma unroll
        for (int i = 0; i < 5; ++i) {
            const int j = lane + 64 * i; float v = -3e38f;
            if (j <= cur) {
                if (j == 0 || j == cur || j == cur - 1) v = 3e38f;
                else { float a = 0.f;
#pragma unroll
                    for (int o5 = -1; o5 < 4; ++o5) { const int c = 4 * j + o5; if (c >= 0 && c < ncv) { const float p = (sc[c] + sc[1024 + c]) + (sc[2048 + c] + sc[3072 + c]); a += (o5 == -1 || o5 == 3) ? 0.5f * p : p; } }
                    v = a; }
            }
            scv[i] = v;
        }
        for (int k = 0; k < nsel; ++k) {
            float bv = scv[0]; int bi = lane;
#pragma unroll
            for (int i = 1; i < 5; ++i) if (scv[i] > bv) { bv = scv[i]; bi = lane + 64 * i; }
#pragma unroll
            for (int off = 32; off > 0; off >>= 1) { const float ov = __shfl_xor(bv, off); const int oi = __shfl_xor(bi, off); if (ov > bv || (ov == bv && oi < bi)) { bv = ov; bi = oi; } }
            if (lane == 0) sel[k] = bi;
#pragma unroll
            for (int i = 0; i < 5; ++i) if (lane + 64 * i == bi) scv[i] = -3e38f;
        }
        __builtin_amdgcn_wave_barrier();
    }
    {
        float mx[4] = {-3e38f, -3e38f, -3e38f, -3e38f};
        for (int k = 0; k < nsel; ++k) {
            asm volatile("" ::: "memory");
            const int pos = sel[k] * 64 + lane; float s[4] = {-1e30f, -1e30f, -1e30f, -1e30f};
            if (pos <= qpos) { float kr[64]; kv.krow_sel(pos, kr); s[0] = s[1] = s[2] = s[3] = 0.f;
#pragma unroll
                for (int d = 0; d < 64; ++d) { const f32x4 q = *(const LAS f32x4*)(qs + d * 4); s[0] += q[0] * kr[d]; s[1] += q[1] * kr[d]; s[2] += q[2] * kr[d]; s[3] += q[3] * kr[d]; }
#pragma unroll
                for (int hh = 0; hh < 4; ++hh) s[hh] *= 0.125f; }
#pragma unroll
            for (int hh = 0; hh < 4; ++hh) { sc[hh * 1024 + k * 64 + lane] = s[hh]; mx[hh] = fmaxf(mx[hh], s[hh]); }
        }
        float inv[4];
#pragma unroll
        for (int hh = 0; hh < 4; ++hh) { mx[hh] = wmaxf(mx[hh]); float sm = 0.f; for (int k = 0; k < nsel; ++k) { const float sv = sc[hh * 1024 + k * 64 + lane]; const float e = sv > -1e29f ? __expf(sv - mx[hh]) : 0.f; sc[hh * 1024 + k * 64 + lane] = e; sm += e; } sm = wsum(sm); inv[hh] = 1.f / sm; }
        __builtin_amdgcn_wave_barrier();
        for (int k = 0; k < nsel; ++k) { const int p0 = sel[k] * 64; int nk = qpos - p0 + 1; nk = nk > 64 ? 64 : nk;
            for (int kk = 0; kk < nk; ++kk) { const float v = kv.v_sel(p0 + kk, lane);
#pragma unroll
                for (int hh = 0; hh < 4; ++hh) os[hh] += sc[hh * 1024 + k * 64 + kk] * v; } }
#pragma unroll
        for (int hh = 0; hh < 4; ++hh) os[hh] *= inv[hh];
        __builtin_amdgcn_wave_barrier();
    }
    {
        const int lo = qpos - 512 > 0 ? qpos - 512 : 0, nw = qpos - lo + 1;
        float mx[4] = {-3e38f, -3e38f, -3e38f, -3e38f};
        for (int i = lane; i < nw; i += 64) { asm volatile("" ::: "memory"); float kr[64]; kv.krow_win(lo + i, kr); float s[4] = {0.f, 0.f, 0.f, 0.f};
#pragma unroll
            for (int d = 0; d < 64; ++d) { const f32x4 q = *(const LAS f32x4*)(qs + d * 4); s[0] += q[0] * kr[d]; s[1] += q[1] * kr[d]; s[2] += q[2] * kr[d]; s[3] += q[3] * kr[d]; }
#pragma unroll
            for (int hh = 0; hh < 4; ++hh) { s[hh] *= 0.125f; sc[hh * 1024 + i] = s[hh]; mx[hh] = fmaxf(mx[hh], s[hh]); } }
        float inv[4];
#pragma unroll
        for (int hh = 0; hh < 4; ++hh) { mx[hh] = wmaxf(mx[hh]); float sm = 0.f; for (int i = lane; i < nw; i += 64) { const float e = __expf(sc[hh * 1024 + i] - mx[hh]); sc[hh * 1024 + i] = e; sm += e; } sm = wsum(sm); inv[hh] = 1.f / sm; }
        __builtin_amdgcn_wave_barrier();
        for (int i = 0; i < nw; ++i) { const float v = kv.v_win(lo + i, lane);
#pragma unroll
            for (int hh = 0; hh < 4; ++hh) ow[hh] += sc[hh * 1024 + i] * v; }
#pragma unroll
        for (int hh = 0; hh < 4; ++hh) ow[hh] *= inv[hh];
        __builtin_amdgcn_wave_barrier();
    }
#pragma unroll
    for (int hh = 0; hh < 4; ++hh) o[hh] = gates[hh * 3] * oc[hh] + gates[hh * 3 + 1] * os[hh] + gates[hh * 3 + 2] * ow[hh];
}

template <int KT = 1, class LF, class SF>
DI void tr64(LAS unsigned char* lds, LF lf, SF sf) {
    LAS float* T = (LAS float*)lds;
    const int tid = ltid();
    __syncthreads();
#pragma unroll
    for (int e8 = 0; e8 < 8 * KT; ++e8) { const int e = tid + 512 * e8, kk = e >> 6, nn = e & 63; T[kk * 65 + nn] = lf(kk, nn); }
    __syncthreads();
#pragma unroll
    for (int e8 = 0; e8 < 8 * KT; ++e8) { const int e = tid + 512 * e8, nn = e / (64 * KT), kk = e % (64 * KT); sf(nn, kk, (f16)T[kk * 65 + nn]); }
}

typedef const Args __attribute__((address_space(4)))* ArgP;
struct Ctx { ArgP ap; LAS unsigned char* lds; unsigned char* ws; float* out; int tid, lane, wave, bid, G; };
DI Ctx mkctx(LAS unsigned char* lds) {
    Ctx c; const char __attribute__((address_space(4)))* kp = (const char __attribute__((address_space(4)))*)__builtin_amdgcn_kernarg_segment_ptr();
    asm volatile("" : "+s"(kp));
    c.ap = (ArgP)kp; c.lds = lds; c.ws = c.ap->ws; c.out = c.ap->out;
    int tid = threadIdx.x; asm volatile("" : "+v"(tid));
    c.tid = tid; c.lane = tid & 63; c.wave = __builtin_amdgcn_readfirstlane(tid >> 6); c.bid = blockIdx.x; c.G = gridDim.x;
    return c;
}
#define INP(i) ((const float*)c.ap->in[i])
#define WSF(off) ((float*)(c.ws + (off)))
#define WSH(off) ((f16*)(c.ws + (off)))

DI void ph_prologue(LAS unsigned char* lds_) {
    const Ctx c = mkctx(lds_); LAS unsigned char* lds = c.lds; const int tid = c.tid, bid = c.bid, G = c.G;
    const float* c_p = INP(I_CP); const float* c_s = INP(I_CS); const float* w_ada = INP(I_WADA); const float* b_ada = INP(I_BADA);
    const float* w_in = INP(I_WIN); const float* w_out = INP(I_WOUT); const float* w1 = INP(I_W1);
    float* ADA = WSF(WS_ADA); float* BIAS = WSF(WS_BIAS); float* PEB = WSF(WS_PEB); f16* WTIN = WSH(WS_WTIN); f16* WTOUT = WSH(WS_WTOUT); f16* W1T = WSH(WS_W1T);
    constexpr int N_ADA = 192, N_WTIN = 480, N_WTOUT = 128, N_W1T = 64, N_PEB = 32, N_W2T = 8, N_ALL = N_ADA + N_WTIN + N_WTOUT + N_W1T + N_PEB + N_W2T + 1;
    constexpr int XA = 2, NO = 256 - N_ADA;
    const bool reb = G == 256; const int n_mine = reb ? (bid < N_ADA ? 1 + XA : (N_ALL - N_ADA - XA * N_ADA - (bid - N_ADA) + NO - 1) / NO) : (N_ALL - bid + G - 1) / G;
    for (int k = 0; k < n_mine; ++k) {
        const int it = !reb ? bid + k * G : (bid < N_ADA ? (k == 0 ? bid : N_ADA + XA * bid + (k - 1)) : N_ADA + XA * N_ADA + (bid - N_ADA) + NO * k);
        int i = it;
        if (i < N_ADA) { const int half = i & 1, j = i >> 1, l = j / 48, n0 = (j % 48) * 64, m0 = half * 17;
            skinny_item<18>(lds, w_ada + (size_t)l * 1024 * 3072, 3072, n0, 64, half ? 16 : 17,
                [&](int m, int k) { const int mm = m0 + m; return siluf_(mm < 32 ? c_s[mm * 1024 + k] : c_p[k]); },
                [&](int m, int n, float v) { ADA[((size_t)l * 33 + m0 + m) * 3072 + n] = v + b_ada[l * 3072 + n]; });
            continue; }
        i -= N_ADA;
        if (i < N_WTIN) { const int l = i / 240, r = i % 240, n0 = (r / 4) * 64, k0 = (r % 4) * 256; const float* src = w_in + (size_t)l * 1024 * DIN; f16* dst = WTIN + (size_t)l * NPD * 1024;
            tr64<4>(lds, [&](int kk, int nn) { const int sc = src_col(n0 + nn); return sc >= 0 ? src[(size_t)(k0 + kk) * DIN + sc] : 0.f; },
                      [&](int nn, int kk, f16 v) { dst[(size_t)(n0 + nn) * 1024 + k0 + kk] = v; });
            continue; }
        i -= N_WTIN;
        if (i < N_WTOUT) { const int l = i / 64, r = i % 64, n0 = (r / 4) * 64, k0 = (r % 4) * 256; const float* src = w_out + (size_t)l * 1024 * 1024; f16* dst = WTOUT + (size_t)l * 1024 * 1024;
            tr64<4>(lds, [&](int kk, int nn) { return src[(size_t)(k0 + kk) * 1024 + n0 + nn]; },
                      [&](int nn, int kk, f16 v) { dst[(size_t)(n0 + nn) * 1024 + k0 + kk] = v; });
            continue; }
        i -= N_WTOUT;
        if (i < N_W1T) { const int ls = i / 16, r = i % 16, k0 = (r / 2) * 256, n0 = (r % 2) * 64; const float* src = w1 + (size_t)ls * 2048 * 128; f16* dst = W1T + (size_t)ls * 128 * 2048;
            tr64<4>(lds, [&](int kk, int nn) { return src[(size_t)(k0 + kk) * 128 + n0 + nn]; },
                      [&](int nn, int kk, f16 v) { dst[(size_t)(n0 + nn) * 2048 + k0 + kk] = v; });
            continue; }
        i -= N_W1T;
        if (i < N_PEB) { const int ls = i >> 3, ks8 = i & 7; const float* pe = INP(I_PE) + (size_t)ls * 2048 + ks8 * 256; const float* w = w1 + ((size_t)ls * 2048 + ks8 * 256) * 128; const float* b1 = INP(I_B1) + ls * 128;
            LAS float* R = (LAS float*)lds; const int f = tid & 127, kq = tid >> 7; float sacc = 0.f;
            __syncthreads();
#pragma unroll 16
            for (int k = kq * 64; k < kq * 64 + 64; ++k) sacc += pe[k] * w[(size_t)k * 128 + f];
            R[kq * 128 + f] = sacc; __syncthreads();
            if (tid < 128) WSF(WS_PEBP)[(ls * 8 + ks8) * 128 + tid] = (ks8 == 0 ? b1[tid] : 0.f) + (R[tid] + R[128 + tid]) + (R[256 + tid] + R[384 + tid]);
            __syncthreads();
            continue; }
        i -= N_PEB;
        if (i < N_W2T) { const int ls = i >> 1, f0 = (i & 1) * 64; const float* src = INP(I_W2) + (size_t)ls * 128 * 64; f16* dst = WSH(WS_W2T) + (size_t)ls * 64 * 128;
            tr64(lds, [&](int kk, int nn) { return src[(size_t)(f0 + kk) * 64 + nn]; },
                      [&](int nn, int kk, f16 v) { dst[(size_t)nn * 128 + f0 + kk] = v; });
            continue; }
        for (int e = tid; e < 2 * NPD; e += 512) BIAS[e] = 0.f;
    }
}

DI void ph_sample_compress(LAS unsigned char* lds_) {
    const Ctx c = mkctx(lds_);
    const float* w2 = INP(I_W2); const float* b2 = INP(I_B2); const float* k_g = INP(I_KG); const float* cache_kv = INP(I_CKV); const int* page_table = (const int*)c.ap->in[I_PT];
    f16* W1T = WSH(WS_W1T); float* PEB = WSF(WS_PEBP); float* KCS = WSF(WS_KCS); float* VCS = WSF(WS_VCS);
    for (int it = c.bid; it < 1152; it += c.G) {
        const int grp = it < 1024 ? it & 7 : 8, st_ = it < 1024 ? it >> 3 : it - 1024, slot = st_ & 1, b = (st_ >> 1) & 31, l = st_ >> 6;
        const float* ckv = cache_kv + (size_t)l * NPOOL * 128 * 256; const int* pt = page_table + b * 128;
        compress_item<true>(c.lds, [&](int ch) { return (const void*)(ckv + ((size_t)pt[ch >> 3] * 128 + (ch & 7) * 16) * 256 + slot * 64); }, grp * 127,
                            W1T + (size_t)(l * 2 + slot) * 128 * 2048, PEB + (l * 2 + slot) * 1024, WSH(WS_W2T) + (size_t)(l * 2 + slot) * 64 * 128, b2 + (l * 2 + slot) * 64,
                            slot == 0 ? k_g + l * 192 : nullptr, (slot == 0 ? KCS : VCS) + (size_t)(l * NB + b) * 1024 * 64, nullptr, nullptr);
    }
}
DI void ph_prep(LAS unsigned char* lds_) {
    const Ctx c = mkctx(lds_); const int tid = c.tid, lane = c.lane, wave = c.wave, bid = c.bid, G = c.G;
    float* ADA = WSF(WS_ADA); float* BIAS = WSF(WS_BIAS);
    {
        const f16* WTIN = WSH(WS_WTIN);
        const bool lite = G == 256;
        const int pb = lite ? bid - 128 : bid, pG = lite ? 128 : G;
        if (pb >= 0)
        for (int col0 = pb * 8 + wave; col0 < 2 * NPD; col0 += pG * 32) {
            f16x8 w[4][2]; f32x4 sv[4][4];
#pragma unroll
            for (int k = 0; k < 4; ++k) { int col = col0 + k * pG * 8; col = col < 2 * NPD ? col : 2 * NPD - 1; const int l = col / NPD;
                const float* sh = ADA + ((size_t)l * 33 + 32) * 3072 + lane * 16; const f16* wp = WTIN + (size_t)col * 1024 + lane * 16;
                w[k][0] = ld_h8(wp); w[k][1] = ld_h8(wp + 8);
#pragma unroll
                for (int i = 0; i < 4; ++i) sv[k][i] = *(const f32x4*)(sh + 4 * i); }
#pragma unroll
            for (int k = 0; k < 4; ++k) { const int col = col0 + k * pG * 8; float acc = 0.f;
#pragma unroll
                for (int i = 0; i < 8; ++i) acc += sv[k][i >> 2][i & 3] * (float)w[k][0][i] + sv[k][2 + (i >> 2)][i & 3] * (float)w[k][1][i];
                acc = wsum(acc); if (lane == 0 && col < 2 * NPD) BIAS[col] = acc; } }
    }
    const float* ng = INP(I_NG);
    if (bid == 0) { float* GNX = WSF(WS_GNX); const float* sc1 = ADA + (size_t)(33 + 32) * 3072 + 1024;
        for (int k = tid; k < 1024; k += 512) GNX[k] = ng[1024 + k] * (1.f + sc1[k]); }
    const float* ada_p = ADA + (size_t)32 * 3072; const float* x_p = INP(I_XP); f16* A16 = WSH(WS_A16); float* RSSP = WSF(WS_RSSP);
    float gp[16];
#pragma unroll
    for (int i = 0; i < 4; ++i) { const f32x4 g4 = *(const f32x4*)(ng + i * 256 + lane * 4), s4 = *(const f32x4*)(ada_p + 1024 + i * 256 + lane * 4);
#pragma unroll
        for (int j = 0; j < 4; ++j) gp[i * 4 + j] = g4[j] * (1.f + s4[j]); }
    const bool lite2 = G == 256; const int pb2 = lite2 ? bid - 128 : bid, pG2 = lite2 ? 128 : G;
    if (pb2 >= 0)
    for (int row0 = pb2 * 8 + wave; row0 < SEQ; row0 += pG2 * 32) {
        f32x4 v[4][4];
#pragma unroll
        for (int k = 0; k < 4; ++k) { int row = row0 + k * pG2 * 8; row = row < SEQ ? row : SEQ - 1;
#pragma unroll
            for (int i = 0; i < 4; ++i) v[k][i] = *(const f32x4*)(x_p + (size_t)row * 1024 + i * 256 + lane * 4); }
#pragma unroll
        for (int k = 0; k < 4; ++k) { const int row = row0 + k * pG2 * 8; float ss = 0.f;
            if (row < SEQ) {
#pragma unroll
                for (int i = 0; i < 4; ++i) { const f32x4 u = v[k][i]; ss += (u[0] * u[0] + u[1] * u[1]) + (u[2] * u[2] + u[3] * u[3]);
                    f16x4 h; h[0] = (f16)(u[0] * gp[i * 4]); h[1] = (f16)(u[1] * gp[i * 4 + 1]); h[2] = (f16)(u[2] * gp[i * 4 + 2]); h[3] = (f16)(u[3] * gp[i * 4 + 3]);
                    *(f16x4*)(A16 + (size_t)row * 1024 + i * 256 + lane * 4) = h; }
                ss = wsum(ss);
                if (lane < 16) RSSP[(size_t)row * 16 + lane] = lane == 0 ? ss : 0.f; } }
    }
}

template <int NT  , class OFn>
DI void sample_gemm_item(LAS unsigned char* lds, const f16* Bt, int n0, OFn ofn) {
    constexpr int KW = 8 / NT, KL = 1024 / KW;
    const int tid = ltid(), wave = tid >> 6, lane = tid & 63, wn = wave % NT, wk = wave / NT, r = lane & 31, h = lane >> 5;
    const LAS f16* Ah = (const LAS f16*)lds + r * 1032 + wk * KL + 8 * h; const f16* bp = Bt + (size_t)(n0 + 32 * wn + r) * 1024 + wk * KL + 8 * h;
    f32x16 acc;
#pragma unroll
    for (int i = 0; i < 16; ++i) acc[i] = 0.f;
#pragma unroll 8
    for (int st = 0; st < KL / 16; ++st) acc = __builtin_amdgcn_mfma_f32_32x32x16_f16(*(const LAS f16x8*)(Ah + 16 * st), ld_h8(bp + 16 * st), acc, 0, 0, 0);
    LAS float* RED = (LAS float*)(lds + 67584);
#pragma unroll
    for (int i = 0; i < 16; ++i) RED[(wk * 32 + (i & 3) + 8 * (i >> 2) + 4 * h) * (32 * NT) + 32 * wn + r] = acc[i];
    __syncthreads();
    for (int e = tid; e < 1024 * NT; e += 512) { float v = 0.f;
#pragma unroll
        for (int w = 0; w < KW; ++w) v += RED[w * 1024 * NT + e];
        ofn(e / (32 * NT), n0 + e % (32 * NT), v); }
    __syncthreads();
}
DI void ph_inproj(LAS unsigned char* lds_, int l) {
    const Ctx c = mkctx(lds_);
    pg8::Gemm g{WSH(WS_A16), WSH(WS_WTIN) + (size_t)l * NPD * 1024, SEQ, NPD, 1024}; pg8::StaticOrder S; S.init(SEQ, NPD, c.G, c.bid);
    EpiIn E{WSH(WS_PROJ), WSF(WS_RSSP), WSF(WS_BIAS) + l * NPD, c.out + O_KVP + (size_t)l * SEQ * 256};
    pg8::gemm_phase<EpiIn, pg8::StaticOrder>(c.lds, g, S, E);
    __syncthreads();
}
DI void ph_hsample(LAS unsigned char* lds_, int l) {
    const Ctx c = mkctx(lds_); const int lane = c.lane;
    if (c.bid >= 4) return;
    const int m = c.bid * 8 + c.wave;
    const float* xr = (l == 0 ? INP(I_XS) : WSF(WS_XS1)) + (size_t)m * 1024; const float* ad = WSF(WS_ADA) + ((size_t)l * 33 + m) * 3072; const float* ng = INP(I_NG) + l * 1024; f16* hs = WSH(WS_HS16) + (size_t)m * 1024;
    f32x4 xv[4]; float ss = 0.f;
#pragma unroll
    for (int i = 0; i < 4; ++i) { xv[i] = *(const f32x4*)(xr + i * 256 + lane * 4); ss += (xv[i][0] * xv[i][0] + xv[i][1] * xv[i][1]) + (xv[i][2] * xv[i][2] + xv[i][3] * xv[i][3]); }
    const float rn = rsqrtf(wsum(ss) * (1.f / 1024.f) + EPS);
#pragma unroll
    for (int i = 0; i < 4; ++i) { const int k = i * 256 + lane * 4; const f32x4 g = *(const f32x4*)(ng + k), sc = *(const f32x4*)(ad + 1024 + k), sh = *(const f32x4*)(ad + k); f16x4 hv;
#pragma unroll
        for (int j = 0; j < 4; ++j) hv[j] = (f16)(xv[i][j] * rn * g[j] * (1.f + sc[j]) + sh[j]);
        *(f16x4*)(hs + k) = hv; }
}
DI void ph_inproj_sample(LAS unsigned char* lds_, int l) {
    const Ctx c = mkctx(lds_); const int tid = c.tid;
    const int it = c.bid - (c.G - 64);
    if (it < 0 || it >= 60) return;
    float* PROJS = WSF(WS_PROJS); const f16* HS = WSH(WS_HS16); LAS f16* Ah = (LAS f16*)c.lds;
    __syncthreads();
#pragma unroll
    for (int i = 0; i < 8; ++i) { const int e = (tid + 512 * i) * 8; *(LAS f16x8*)(Ah + (e >> 10) * 1032 + (e & 1023)) = ld_h8(HS + e); }
    __syncthreads();
    sample_gemm_item<2>(c.lds, WSH(WS_WTIN) + (size_t)l * NPD * 1024, it * 64, [&](int m, int n, float v) { PROJS[m * NPD + n] = v; });
}

#define PT(t) (P + (size_t)(t) * SEQ * 256)
DI void ph_ssd_local(LAS unsigned char* lds_, int l) {
    const Ctx c = mkctx(lds_); LAS unsigned char* lds = c.lds; const int tid = c.tid, lane = c.lane, wave = c.wave;
    const f16* P = WSH(WS_PROJ); f16* ACT = WSH(WS_ACT); float* YD = WSF(WS_YD); float* CST = WSF(WS_CST); float* ACS = WSF(WS_ACS); float* CDEC = WSF(WS_CDEC); float* out = c.out;
    const float* dtb = INP(I_DTB) + l * 4; const float* alog = INP(I_ALOG) + l * 4; const float* cw = INP(I_BCW) + l * 4 * 768; const float* cb = INP(I_BCB) + l * 768;
    LAS f16* Bm = (LAS f16*)lds; LAS f16* BT = (LAS f16*)(lds + 34816); LAS f16* Cm = (LAS f16*)(lds + 69632); LAS f16* XT = (LAS f16*)(lds + 104448);
    LAS float* acs = (LAS float*)(lds + 139264); LAS float* dtl = acs + 256; LAS f16* te16 = (LAS f16*)(dtl + 256);
    for (int it = c.bid; it < 256; it += c.G) {
        const int ch_ = it >> 1, g = it & 1, t0 = ch_ * 128;
        __syncthreads();
        if (tid < 256) { const int hh = tid >> 7, lt = tid & 127, hd = 2 * g + hh; const float raw = (float)PT(13)[(size_t)(t0 + lt) * 256 + 128 + hd];
            const float dt = softplusf_(raw + dtb[hd]); dtl[hh * 128 + lt] = dt; acs[hh * 128 + lt] = dt * (-__expf(alog[hd])); }
        __syncthreads();
        if (tid == 0 || tid == 64) { const int hh = tid >> 6; float sacc = 0.f; for (int i = 0; i < 128; ++i) { sacc += acs[hh * 128 + i]; acs[hh * 128 + i] = sacc; } }
        __syncthreads();
        if (tid < 256) { const int hh = tid >> 7, lt = tid & 127, hd = 2 * g + hh; const float av = acs[hh * 128 + lt], ae = acs[hh * 128 + 127];
            te16[hh * 128 + lt] = (f16)__expf(ae - av); ACS[(size_t)(t0 + lt) * 4 + hd] = av; if (lt == 127) CDEC[ch_ * 4 + hd] = __expf(ae); }
#pragma unroll 3
        for (int e = tid; e < 128 * 48; e += 512) {
            const int lt = (e >> 2) & 127, cg = (e >> 9) * 4 + (e & 3), reg = cg >> 4, c8 = (cg & 15) * 8, t = t0 + lt, col = 128 * g + c8, ch = reg * 256 + col;
            const f16* src = PT(5 + reg) + col; float y[8]; f16x8 rawt;
#pragma unroll
            for (int i = 0; i < 8; ++i) y[i] = cb[ch + i];
#pragma unroll
            for (int k = 0; k < 4; ++k) { const int tt = t - 3 + k; f16x8 v; if (tt >= 0) v = ld_h8(src + (size_t)tt * 256); else {
#pragma unroll
                    for (int i = 0; i < 8; ++i) v[i] = (f16)0.f; }
                if (k == 3) rawt = v;
#pragma unroll
                for (int i = 0; i < 8; ++i) y[i] += cw[k * 768 + ch + i] * (float)v[i]; }
            f16x8 act;
#pragma unroll
            for (int i = 0; i < 8; ++i) { y[i] = siluf_(y[i]); act[i] = (f16)y[i]; }
            *(f16x8*)(ACT + (size_t)t * 768 + ch) = act;
            if (reg == 0) { const int hh = c8 >> 6; const float sdt = dtl[hh * 128 + lt] * 64.f;
#pragma unroll
                for (int i = 0; i < 8; ++i) XT[(c8 + i) * 136 + lt] = (f16)(y[i] * sdt); }
            else if (reg == 1) { *(LAS f16x8*)(Bm + lt * 136 + c8) = act;
#pragma unroll
                for (int i = 0; i < 8; ++i) BT[(c8 + i) * 136 + lt] = act[i]; }
            else *(LAS f16x8*)(Cm + lt * 136 + c8) = act;
            if (t >= SEQ - 3) { float* so = out + O_BCP + (size_t)l * 2304 + (t - (SEQ - 3)) * 768 + ch;
#pragma unroll
                for (int i = 0; i < 8; ++i) so[i] = (float)rawt[i]; }
        }
        __syncthreads();
        const int fr = lane & 15, q = lane >> 4, w = wave;
        f32x4 gt[8];
#pragma unroll
        for (int mt = 0; mt < 8; ++mt) { gt[mt] = (f32x4){0.f, 0.f, 0.f, 0.f};
            if (mt <= w) {
#pragma unroll
                for (int ks = 0; ks < 4; ++ks) { const f16x8 av = *(const LAS f16x8*)(Bm + (16 * mt + fr) * 136 + 32 * ks + 8 * q), bv = *(const LAS f16x8*)(Cm + (16 * w + fr) * 136 + 32 * ks + 8 * q);
                    gt[mt] = __builtin_amdgcn_mfma_f32_16x16x32_f16(av, bv, gt[mt], 0, 0, 0); } } }
#pragma unroll
        for (int hh = 0; hh < 2; ++hh) {
            const int lrow = 16 * w + fr; const float al = acs[hh * 128 + lrow];
            f32x4 ya[4];
#pragma unroll
            for (int pt = 0; pt < 4; ++pt) ya[pt] = (f32x4){0.f, 0.f, 0.f, 0.f};
#pragma unroll
            for (int k2 = 0; k2 < 4; ++k2) {
                if (2 * k2 <= w) {
                    f16x8 af;
#pragma unroll
                    for (int j = 0; j < 8; ++j) { const int m = 32 * k2 + (j < 4 ? 4 * q + j : 16 + 4 * q + (j - 4)); const float gv = j < 4 ? gt[2 * k2][j] : gt[2 * k2 + 1][j - 4];
                        af[j] = (f16)(m <= lrow ? gv * __expf(al - acs[hh * 128 + m]) : 0.f); }
#pragma unroll
                    for (int pt = 0; pt < 4; ++pt) { const LAS f16* xp = XT + (hh * 64 + 16 * pt + fr) * 136 + 32 * k2 + 4 * q; const f16x4 b0 = *(const LAS f16x4*)xp, b1 = *(const LAS f16x4*)(xp + 16);
                        f16x8 bf; bf[0] = b0[0]; bf[1] = b0[1]; bf[2] = b0[2]; bf[3] = b0[3]; bf[4] = b1[0]; bf[5] = b1[1]; bf[6] = b1[2]; bf[7] = b1[3];
                        ya[pt] = __builtin_amdgcn_mfma_f32_16x16x32_f16(af, bf, ya[pt], 0, 0, 0); }
                }
            }
#pragma unroll
            for (int pt = 0; pt < 4; ++pt)
#pragma unroll
                for (int j = 0; j < 4; ++j) YD[(size_t)(t0 + 16 * w + 4 * q + j) * 256 + (2 * g + hh) * 64 + 16 * pt + fr] = ya[pt][j] * (1.f / 64.f);
#pragma unroll
            for (int pt = 0; pt < 4; ++pt) { f32x4 sa = (f32x4){0.f, 0.f, 0.f, 0.f};
#pragma unroll
                for (int ks = 0; ks < 4; ++ks) { const f16x8 xv = *(const LAS f16x8*)(XT + (hh * 64 + 16 * pt + fr) * 136 + 32 * ks + 8 * q), tv = *(const LAS f16x8*)(te16 + hh * 128 + 32 * ks + 8 * q);
                    const f16x8 bv = *(const LAS f16x8*)(BT + (16 * w + fr) * 136 + 32 * ks + 8 * q);
                    sa = __builtin_amdgcn_mfma_f32_16x16x32_f16(xv * tv, bv, sa, 0, 0, 0); }
#pragma unroll
                for (int j = 0; j < 4; ++j) CST[((size_t)(ch_ * 4 + 2 * g + hh) * 64 + 16 * pt + 4 * q + j) * 128 + 16 * w + fr] = sa[j] * (1.f / 64.f); }
        }
    }
    __syncthreads();
}
DI void ph_mix_a(LAS unsigned char* lds_, int l) {
    const Ctx c = mkctx(lds_); const int tid = c.tid;
    const f16* P = WSH(WS_PROJ); f16* Y16 = WSH(WS_Y16); float* out = c.out; const float* scw = INP(I_SCW) + l * 768;
    for (int it = c.bid; it < 256; it += c.G) {
        const int c0 = (tid & 31) * 8; f16x8 hh[4][3], cv[4][3], bb[4], gg[4];
#pragma unroll
        for (int i4 = 0; i4 < 4; ++i4) { const int t = it * 64 + (tid >> 5) + 16 * i4;
#pragma unroll
            for (int k = 0; k < 3; ++k) { const int tt = t - 2 + k >= 0 ? t - 2 + k : 0; hh[i4][k] = ld_h8(PT(0) + (size_t)tt * 256 + c0); cv[i4][k] = ld_h8(PT(2) + (size_t)tt * 256 + c0); }
            bb[i4] = ld_h8(PT(1) + (size_t)t * 256 + c0); gg[i4] = ld_h8(PT(3) + (size_t)t * 256 + c0); }
        float sw[3][8];
#pragma unroll
        for (int k = 0; k < 3; ++k) { const f32x4 s0 = *(const f32x4*)(scw + k * 256 + c0), s1 = *(const f32x4*)(scw + k * 256 + c0 + 4);
#pragma unroll
            for (int i = 0; i < 4; ++i) { sw[k][i] = s0[i]; sw[k][4 + i] = s1[i]; } }
#pragma unroll
        for (int i4 = 0; i4 < 4; ++i4) { const int t = it * 64 + (tid >> 5) + 16 * i4; float u[3][8];
#pragma unroll
            for (int k = 0; k < 3; ++k) { const bool ok = t - 2 + k >= 0;
#pragma unroll
                for (int i = 0; i < 8; ++i) u[k][i] = ok ? (float)cv[i4][k][i] * (float)hh[i4][k][i] : 0.f; }
            f16x8 o;
#pragma unroll
            for (int i = 0; i < 8; ++i) { const float y = sw[0][i] * u[0][i] + sw[1][i] * u[1][i] + sw[2][i] * u[2][i]; o[i] = (f16)(siluf_((float)gg[i4][i]) * (float)bb[i4][i] * y); }
            *(f16x8*)(Y16 + (size_t)t * 1024 + c0) = o;
            if (t >= SEQ - 2) { float* so = out + O_SCP + (size_t)l * 512 + (t - (SEQ - 2)) * 256 + c0;
#pragma unroll
                for (int i = 0; i < 8; ++i) so[i] = u[2][i]; }
        }
    }
}
DI void ph_mix_c(LAS unsigned char* lds_, int l) {
    const Ctx c = mkctx(lds_); const int tid = c.tid, lane = c.lane, wave = c.wave;
    const f16* P = WSH(WS_PROJ); f16* Y16 = WSH(WS_Y16); float* out = c.out;
    const float* cfw = INP(I_CFW) + l * 31 * 256; const float* cfb = INP(I_CFB) + l * 256; const float* lng = INP(I_LNG) + l * 256; const float* lnb = INP(I_LNB) + l * 256;
    LAS float* GL = (LAS float*)c.lds;
    f32x4 wt[31];
#pragma unroll
    for (int k = 0; k < 31; ++k) wt[k] = *(const f32x4*)(cfw + k * 256 + lane * 4);
    const f32x4 bias4 = *(const f32x4*)(cfb + lane * 4), g4 = *(const f32x4*)(lng + lane * 4), b4 = *(const f32x4*)(lnb + lane * 4);
    for (int it = c.bid; it < 256; it += c.G) {
        __syncthreads();
        {
            f16x8 ga[6], gb[6];
#pragma unroll
            for (int i6 = 0; i6 < 6; ++i6) { const int e = tid + 512 * i6, rr = e >> 5, c0 = (e & 31) * 8, t = it * 64 - 30 + rr; const int tc = (e < 94 * 32 && t >= 0) ? t : it * 64;
                ga[i6] = ld_h8(PT(8) + (size_t)tc * 256 + c0); gb[i6] = ld_h8(PT(9) + (size_t)tc * 256 + c0); }
#pragma unroll
            for (int i6 = 0; i6 < 6; ++i6) { const int e = tid + 512 * i6, rr = e >> 5, c0 = (e & 31) * 8, t = it * 64 - 30 + rr; f32x4 g0 = (f32x4){0.f, 0.f, 0.f, 0.f}, g1 = g0;
                if (e < 94 * 32) {
                    if (t >= 0) {
#pragma unroll
                        for (int i = 0; i < 4; ++i) { g0[i] = (float)ga[i6][i] * sigmoidf_((float)gb[i6][i]); g1[i] = (float)ga[i6][4 + i] * sigmoidf_((float)gb[i6][4 + i]); }
                        if (t >= SEQ - 30) { float* so = out + O_CFP + (size_t)l * 7680 + (t - (SEQ - 30)) * 256 + c0; *(f32x4*)so = g0; *(f32x4*)(so + 4) = g1; } }
                    *(LAS f32x4*)(GL + rr * 256 + c0) = g0; *(LAS f32x4*)(GL + rr * 256 + c0 + 4) = g1; } }
        }
        __syncthreads();
        {
            const int cc = lane * 4, tb = wave * 8;
            f32x4 u[8]; f16x4 cgv[8];
#pragma unroll
            for (int j = 0; j < 8; ++j) { u[j] = bias4; cgv[j] = *(const f16x4*)(PT(10) + (size_t)(it * 64 + tb + j) * 256 + cc); }
#pragma unroll
            for (int r = 0; r < 38; ++r) { const f32x4 gv = *(const LAS f32x4*)(GL + (tb + r) * 256 + cc);
#pragma unroll
                for (int j = 0; j < 8; ++j) if (r - j >= 0 && r - j <= 30) u[j] += wt[r - j] * gv; }
#pragma unroll
            for (int j = 0; j < 8; ++j) { const int t = it * 64 + tb + j;
                const float mean = wsum((u[j][0] + u[j][1]) + (u[j][2] + u[j][3])) * (1.f / 256.f); const f32x4 d = u[j] - mean;
                const float var = wsum((d[0] * d[0] + d[1] * d[1]) + (d[2] * d[2] + d[3] * d[3])) * (1.f / 256.f); const float rs = rsqrtf(var + EPS);
                const f16x4 cg = cgv[j]; f16x4 o;
#pragma unroll
                for (int i = 0; i < 4; ++i) o[i] = (f16)(siluf_((float)cg[i]) * siluf_(d[i] * rs * g4[i] + b4[i]));
                *(f16x4*)(Y16 + (size_t)t * 1024 + 512 + cc) = o; }
        }
    }
    __syncthreads();
}
DI void ph_mix_d(LAS unsigned char* lds_, int l) {
    const Ctx c = mkctx(lds_); const int tid = c.tid, lane = c.lane, wave = c.wave;
    const f16* P = WSH(WS_PROJ); float* out = c.out; float* kvp_out = out + O_KVP + (size_t)l * SEQ * 256;
    f16* Q16 = WSH(WS_Q16); f16* KS16 = WSH(WS_KS16); f16* KW16 = WSH(WS_KW16); f16* VST16 = WSH(WS_VST16); f16* VWT16 = WSH(WS_VWT16); float* GATES = WSF(WS_GATES);
    const int d4 = (lane & 15) * 4, v4 = lane >> 4;
    const f32x4 qg = *(const f32x4*)(INP(I_QG) + l * 64 + d4), kg1 = *(const f32x4*)(INP(I_KG) + l * 192 + 64 + d4), kg2 = *(const f32x4*)(INP(I_KG) + l * 192 + 128 + d4);
    LAS f16* VSs = (LAS f16*)c.lds; LAS f16* VWs = VSs + 64 * 68;
    if (c.bid < 18 && c.G > 36) return;
    for (int it = c.bid - 18 >= 0 && c.G > 36 ? c.bid - 18 : c.bid; it < 256; it += (c.G > 36 ? c.G - 18 : c.G)) {
        __syncthreads();
        f16x4 xq[8], xk[2], vk[2], xw[2], vw[2]; f16 gt[2];
#pragma unroll
        for (int i = 0; i < 8; ++i) xq[i] = *(const f16x4*)(PT(11) + (size_t)(it * 64) * 256 + (size_t)(wave * 4 + v4 + 32 * i) * 64 + d4);
#pragma unroll
        for (int i = 0; i < 2; ++i) { const size_t t = (size_t)(it * 64 + wave * 4 + v4 + 32 * i);
            xk[i] = *(const f16x4*)(PT(12) + t * 256 + 128 + d4); vk[i] = *(const f16x4*)(PT(12) + t * 256 + 192 + d4); xw[i] = *(const f16x4*)(PT(13) + t * 256 + d4); vw[i] = *(const f16x4*)(PT(13) + t * 256 + 64 + d4); }
#pragma unroll
        for (int i = 0; i < 2; ++i) { int e = tid + 512 * i; e = e < 64 * 12 ? e : 0; gt[i] = PT(13)[(size_t)(it * 64 + e / 12) * 256 + 132 + e % 12]; }
#pragma unroll
        for (int i = 0; i < 8; ++i) { const int vi = wave * 4 + v4 + 32 * i; const size_t off = (size_t)(it * 64) * 256 + (size_t)vi * 64 + d4; const f16x4 x = xq[i];
            const float a0 = (float)x[0], a1 = (float)x[1], a2 = (float)x[2], a3 = (float)x[3]; const float rn = rsqrtf(sum16((a0 * a0 + a1 * a1) + (a2 * a2 + a3 * a3)) * (1.f / 64.f) + EPS);
            f16x4 y; y[0] = (f16)(a0 * rn * qg[0]); y[1] = (f16)(a1 * rn * qg[1]); y[2] = (f16)(a2 * rn * qg[2]); y[3] = (f16)(a3 * rn * qg[3]); *(f16x4*)(Q16 + off) = y; }
#pragma unroll
        for (int i = 0; i < 2; ++i) { const int tl = wave * 4 + v4 + 32 * i, t = it * 64 + tl;
            { const f16x4 x = xk[i], vv = vk[i];
                const float a0 = (float)x[0], a1 = (float)x[1], a2 = (float)x[2], a3 = (float)x[3]; const float rn = rsqrtf(sum16((a0 * a0 + a1 * a1) + (a2 * a2 + a3 * a3)) * (1.f / 64.f) + EPS);
                const f32x4 kn = (f32x4){a0 * rn * kg1[0], a1 * rn * kg1[1], a2 * rn * kg1[2], a3 * rn * kg1[3]}; *(f32x4*)(kvp_out + (size_t)t * 256 + 128 + d4) = kn;
                f16x4 y; y[0] = (f16)kn[0]; y[1] = (f16)kn[1]; y[2] = (f16)kn[2]; y[3] = (f16)kn[3]; *(f16x4*)(KS16 + (size_t)t * 64 + d4) = y; *(LAS f16x4*)(VSs + tl * 68 + d4) = vv; }
            { const f16x4 x = xw[i], vv = vw[i];
                const float a0 = (float)x[0], a1 = (float)x[1], a2 = (float)x[2], a3 = (float)x[3]; const float rn = rsqrtf(sum16((a0 * a0 + a1 * a1) + (a2 * a2 + a3 * a3)) * (1.f / 64.f) + EPS);
                const f32x4 kn = (f32x4){a0 * rn * kg2[0], a1 * rn * kg2[1], a2 * rn * kg2[2], a3 * rn * kg2[3]};
                f16x4 y; y[0] = (f16)kn[0]; y[1] = (f16)kn[1]; y[2] = (f16)kn[2]; y[3] = (f16)kn[3]; *(f16x4*)(KW16 + (size_t)t * 64 + d4) = y; *(LAS f16x4*)(VWs + tl * 68 + d4) = vv;
                if (t >= SEQ - 512) { float* wo = out + O_WINP + (size_t)l * 512 * 128 + (size_t)(t - (SEQ - 512)) * 128; *(f32x4*)(wo + d4) = kn; *(f32x4*)(wo + 64 + d4) = (f32x4){(float)vv[0], (float)vv[1], (float)vv[2], (float)vv[3]}; } }
        }
#pragma unroll
        for (int i = 0; i < 2; ++i) { const int e = tid + 512 * i; if (e < 64 * 12) GATES[(size_t)(it * 64 + e / 12) * 12 + e % 12] = sigmoidf_((float)gt[i]); }
        __syncthreads();
        { const int d = tid >> 3, k8 = (tid & 7) * 8; f16x8 a, b;
#pragma unroll
            for (int i = 0; i < 8; ++i) { const int key = vt_key(k8 + i); a[i] = VSs[key * 68 + d]; b[i] = VWs[key * 68 + d]; }
            *(f16x8*)(VST16 + (size_t)it * 4096 + d * 64 + k8) = a; *(f16x8*)(VWT16 + (size_t)it * 4096 + d * 64 + k8) = b; }
    }
    __syncthreads();
}
DI void ph_mix_cmp(LAS unsigned char* lds_, int l) {
    const Ctx c = mkctx(lds_);
    const f16* P = WSH(WS_PROJ); const float* w2 = INP(I_W2); const float* b2 = INP(I_B2); const float* k_g = INP(I_KG); f16* W1T = WSH(WS_W1T); float* PEB = WSF(WS_PEBP);
    for (int it = c.bid; it < 18; it += c.G) { const int slot = it / 9, grp = it % 9; const f16* src = PT(12) + slot * 64;
        compress_item<false>(c.lds, [&](int ch) { return (const void*)(src + (size_t)ch * 16 * 256); }, grp * 127,
                             W1T + (size_t)(l * 2 + slot) * 128 * 2048, PEB + (l * 2 + slot) * 1024, WSH(WS_W2T) + (size_t)(l * 2 + slot) * 64 * 128, b2 + (l * 2 + slot) * 64,
                             slot == 0 ? k_g + l * 192 : nullptr, nullptr, slot == 0 ? WSH(WS_KC16) : nullptr, slot == 0 ? nullptr : WSH(WS_VCT16)); }
}
#undef PT
template <int N>
DI void blk_reduce(LAS float* red, LAS float* bc, float (&v)[N], bool is_max, int wave, int lane) {
#pragma unroll
    for (int i = 0; i < N; ++i) v[i] = is_max ? wmaxf(v[i]) : wsum(v[i]);
    __syncthreads();
    if (lane == 0) {
#pragma unroll
        for (int i = 0; i < N; ++i) red[wave * 12 + i] = v[i]; }
    __syncthreads();
    if (wave == 0 && lane < N) { float r = red[lane]; for (int w = 1; w < 8; ++w) r = is_max ? fmaxf(r, red[w * 12 + lane]) : r + red[w * 12 + lane]; bc[lane] = r; }
    __syncthreads();
#pragma unroll
    for (int i = 0; i < N; ++i) v[i] = bc[i];
}
DI void nsa_sample_block(LAS float* wl, const float* KC, const float* VC, const SampleKV& kv, const LAS float* gsm, const float* dgp, float* ysd, int tid, int lane, int wave) {
    LAS float* sc = wl; LAS float* qs = wl + 10496; LAS float* PSL = qs + 256; LAS float* red = PSL + 1024; LAS float* bc = red + 96; LAS int* sel = (LAS int*)(bc + 16); LAS float* part = bc + 32;
    constexpr int NCV = 1023, CUR = PAST >> 6;
    float mv[8], sv[8];
#pragma unroll
    for (int i = 0; i < 8; ++i) mv[i] = -3e38f;
    for (int cidx = tid; cidx < NCV; cidx += 512) {
        asm volatile("" ::: "memory");
        float kr[64]; kv.ld64(KC + (size_t)cidx * 64, kr); float s4[4] = {0.f, 0.f, 0.f, 0.f};
#pragma unroll
        for (int d = 0; d < 64; ++d) { const f32x4 qv = *(const LAS f32x4*)(qs + d * 4); s4[0] += qv[0] * kr[d]; s4[1] += qv[1] * kr[d]; s4[2] += qv[2] * kr[d]; s4[3] += qv[3] * kr[d]; }
#pragma unroll
        for (int hh = 0; hh < 4; ++hh) { s4[hh] *= 0.125f; sc[hh * 2624 + cidx] = s4[hh]; mv[hh] = fmaxf(mv[hh], s4[hh]); }
    }
    for (int i = tid; i < 513; i += 512) {
        asm volatile("" ::: "memory");
        float kr[64]; kv.krow_win(PAST - 512 + i, kr); float s4[4] = {0.f, 0.f, 0.f, 0.f};
#pragma unroll
        for (int d = 0; d < 64; ++d) { const f32x4 qv = *(const LAS f32x4*)(qs + d * 4); s4[0] += qv[0] * kr[d]; s4[1] += qv[1] * kr[d]; s4[2] += qv[2] * kr[d]; s4[3] += qv[3] * kr[d]; }
#pragma unroll
        for (int hh = 0; hh < 4; ++hh) { s4[hh] *= 0.125f; sc[hh * 2624 + 2048 + i] = s4[hh]; mv[4 + hh] = fmaxf(mv[4 + hh], s4[hh]); }
    }
    blk_reduce<8>(red, bc, mv, true, wave, lane);
#pragma unroll
    for (int i = 0; i < 8; ++i) sv[i] = 0.f;
    for (int cidx = tid; cidx < NCV; cidx += 512) {
#pragma unroll
        for (int hh = 0; hh < 4; ++hh) { const float e = __expf(sc[hh * 2624 + cidx] - mv[hh]); sc[hh * 2624 + cidx] = e; sv[hh] += e; } }
    for (int i = tid; i < 513; i += 512) {
#pragma unroll
        for (int hh = 0; hh < 4; ++hh) { const float e = __expf(sc[hh * 2624 + 2048 + i] - mv[4 + hh]); sc[hh * 2624 + 2048 + i] = e; sv[4 + hh] += e; } }
    blk_reduce<8>(red, bc, sv, false, wave, lane);
    float invc[4], invw[4];
#pragma unroll
    for (int hh = 0; hh < 4; ++hh) { invc[hh] = 1.f / sv[hh]; invw[hh] = 1.f / sv[4 + hh]; }
    for (int cidx = tid; cidx < 1024; cidx += 512) PSL[cidx] = cidx < NCV ? (sc[cidx] * invc[0] + sc[2624 + cidx] * invc[1]) + (sc[2 * 2624 + cidx] * invc[2] + sc[3 * 2624 + cidx] * invc[3]) : 0.f;
    __syncthreads();
    if (wave == 0) {
        float scv[5];
#pragma unroll
        for (int i = 0; i < 5; ++i) { const int j = lane + 64 * i; float v = -3e38f;
            if (j <= CUR) { if (j == 0 || j == CUR || j == CUR - 1) v = 3e38f; else { float a = 0.f;
#pragma unroll
                    for (int o5 = -1; o5 < 4; ++o5) { const int cc = 4 * j + o5; if (cc >= 0 && cc < NCV) a += (o5 == -1 || o5 == 3) ? 0.5f * PSL[cc] : PSL[cc]; }
                    v = a; } }
            scv[i] = v; }
        for (int k = 0; k < 16; ++k) {
            float bv = scv[0]; int bi = lane;
#pragma unroll
            for (int i = 1; i < 5; ++i) if (scv[i] > bv) { bv = scv[i]; bi = lane + 64 * i; }
#pragma unroll
            for (int off = 32; off > 0; off >>= 1) { const float ov = __shfl_xor(bv, off); const int oi = __shfl_xor(bi, off); if (ov > bv || (ov == bv && oi < bi)) { bv = ov; bi = oi; } }
            if (lane == 0) sel[k] = bi;
#pragma unroll
            for (int i = 0; i < 5; ++i) if (lane + 64 * i == bi) scv[i] = -3e38f;
        }
    }
    __syncthreads();
    float ms[4], ss4[4];
#pragma unroll
    for (int i = 0; i < 4; ++i) ms[i] = -3e38f;
    for (int idx = tid; idx < 1024; idx += 512) {
        asm volatile("" ::: "memory");
        const int pos = sel[idx >> 6] * 64 + (idx & 63); float s4[4] = {-1e30f, -1e30f, -1e30f, -1e30f};
        if (pos <= PAST) { float kr[64]; kv.krow_sel(pos, kr); s4[0] = s4[1] = s4[2] = s4[3] = 0.f;
#pragma unroll
            for (int d = 0; d < 64; ++d) { const f32x4 qv = *(const LAS f32x4*)(qs + d * 4); s4[0] += qv[0] * kr[d]; s4[1] += qv[1] * kr[d]; s4[2] += qv[2] * kr[d]; s4[3] += qv[3] * kr[d]; }
#pragma unroll
            for (int hh = 0; hh < 4; ++hh) s4[hh] *= 0.125f; }
#pragma unroll
        for (int hh = 0; hh < 4; ++hh) { sc[hh * 2624 + 1024 + idx] = s4[hh]; ms[hh] = fmaxf(ms[hh], s4[hh]); }
    }
    blk_reduce<4>(red, bc, ms, true, wave, lane);
#pragma unroll
    for (int i = 0; i < 4; ++i) ss4[i] = 0.f;
    for (int idx = tid; idx < 1024; idx += 512) {
#pragma unroll
        for (int hh = 0; hh < 4; ++hh) { const float x = sc[hh * 2624 + 1024 + idx]; const float e = x > -1e29f ? __expf(x - ms[hh]) : 0.f; sc[hh * 2624 + 1024 + idx] = e; ss4[hh] += e; } }
    blk_reduce<4>(red, bc, ss4, false, wave, lane);
    float invs[4];
#pragma unroll
    for (int hh = 0; hh < 4; ++hh) invs[hh] = 1.f / ss4[hh];
    float oc[4] = {0.f, 0.f, 0.f, 0.f}, os[4] = {0.f, 0.f, 0.f, 0.f}, ow[4] = {0.f, 0.f, 0.f, 0.f};
    { const int c1 = (wave + 1) * 128 < NCV ? (wave + 1) * 128 : NCV;
#pragma unroll 16
        for (int cidx = wave * 128; cidx < c1; ++cidx) { const float v = VC[(size_t)cidx * 64 + lane];
#pragma unroll
            for (int hh = 0; hh < 4; ++hh) oc[hh] += sc[hh * 2624 + cidx] * v; } }
    for (int kb = wave * 2; kb < wave * 2 + 2; ++kb) { const int p0 = sel[kb] * 64; int nk = PAST - p0 + 1; nk = nk > 64 ? 64 : nk;
        const float* vbase = p0 < PAST ? kv.prow(p0, 3) + lane : kv.nvs + lane;
#pragma unroll 16
        for (int kk = 0; kk < nk; ++kk) { const float v = vbase[(size_t)kk * 256];
#pragma unroll
            for (int hh = 0; hh < 4; ++hh) os[hh] += sc[hh * 2624 + 1024 + kb * 64 + kk] * v; } }
    { const int i1 = (wave + 1) * 65 < 513 ? (wave + 1) * 65 : 513;
#pragma unroll 13
        for (int i = wave * 65; i < i1; ++i) { const float v = kv.v_win(PAST - 512 + i, lane);
#pragma unroll
            for (int hh = 0; hh < 4; ++hh) ow[hh] += sc[hh * 2624 + 2048 + i] * v; } }
#pragma unroll
    for (int hh = 0; hh < 4; ++hh) { part[(wave * 12 + hh) * 64 + lane] = oc[hh] * invc[hh]; part[(wave * 12 + 4 + hh) * 64 + lane] = os[hh] * invs[hh]; part[(wave * 12 + 8 + hh) * 64 + lane] = ow[hh] * invw[hh]; }
    __syncthreads();
    if (tid < 256) { const int hh = tid >> 6, d = tid & 63; float a = 0.f, b = 0.f, cc = 0.f;
        for (int w = 0; w < 8; ++w) { a += part[(w * 12 + hh) * 64 + d]; b += part[(w * 12 + 4 + hh) * 64 + d]; cc += part[(w * 12 + 8 + hh) * 64 + d]; }
        ysd[tid] = siluf_(dgp[tid]) * (gsm[hh * 3] * a + gsm[hh * 3 + 1] * b + gsm[hh * 3 + 2] * cc); }
}
DI void ph_mix_sample(LAS unsigned char* lds_, int l) {
    const Ctx c = mkctx(lds_); const int tid = c.tid, lane = c.lane, wave = c.wave;
    const int b = c.bid - (c.G - 32);
    if (b < 0 || b >= 32) return;
    float* out = c.out;
    __syncthreads();
    const float* pr = WSF(WS_PROJS) + (size_t)b * NPD;
    LAS float* act = (LAS float*)c.lds;
    LAS float* red = act + 768;
    LAS float* ybl = red + 16;
    LAS float* sdt = ybl + 256;
    LAS float* nrow = sdt + 8;
    LAS float* gsm = nrow + 256;
    LAS float* wl = gsm + 16;
    float* ys = WSF(WS_YS) + (size_t)b * 1024;
    if (tid < 256) { const int ch = tid; const float* st = INP(I_SSC) + ((size_t)(l * NB + b) * 2) * 256; const float* scw = INP(I_SCW) + l * 768;
        const float u = pr[512 + ch] * pr[ch], p0 = st[ch], p1 = st[256 + ch]; const float y = scw[ch] * p0 + scw[256 + ch] * p1 + scw[512 + ch] * u;
        ys[ch] = siluf_(pr[768 + ch]) * pr[256 + ch] * y; float* so = out + O_SCS + ((size_t)(l * NB + b) * 2) * 256; so[ch] = p1; so[256 + ch] = u; }
    float uc = 0.f;
    if (tid >= 256) { const int ch = tid - 256; const float* st = INP(I_SCF) + (size_t)(l * NB + b) * 7680; const float* cfw = INP(I_CFW) + l * 31 * 256;
        const float glu = pr[2048 + ch] * sigmoidf_(pr[2304 + ch]); float u = INP(I_CFB)[l * 256 + ch]; float* so = out + O_CFS + (size_t)(l * NB + b) * 7680;
        for (int k = 0; k < 30; ++k) { const float pv = st[k * 256 + ch]; u += cfw[k * 256 + ch] * pv; if (k > 0) so[(k - 1) * 256 + ch] = pv; }
        u += cfw[30 * 256 + ch] * glu; so[29 * 256 + ch] = glu; uc = u; }
    { const float s1 = wsum(tid >= 256 ? uc : 0.f); if (lane == 0) red[wave] = s1; }
    __syncthreads();
    const float cmean = (red[4] + red[5] + red[6] + red[7]) * (1.f / 256.f);
    __syncthreads();
    { const float d = uc - cmean; const float s2 = wsum(tid >= 256 ? d * d : 0.f); if (lane == 0) red[wave] = s2; }
    __syncthreads();
    if (tid >= 256) { const int ch = tid - 256; const float var = (red[4] + red[5] + red[6] + red[7]) * (1.f / 256.f);
        const float ln = (uc - cmean) * rsqrtf(var + EPS) * INP(I_LNG)[l * 256 + ch] + INP(I_LNB)[l * 256 + ch];
        ys[512 + ch] = siluf_(pr[2560 + ch]) * siluf_(ln); }
    { const float* st = INP(I_SBC) + (size_t)(l * NB + b) * 2304; const float* cw = INP(I_BCW) + l * 4 * 768; const float* cb = INP(I_BCB) + l * 768; float* so = out + O_BCS + (size_t)(l * NB + b) * 2304;
        for (int ch = tid; ch < 768; ch += 512) { const float raw = pr[1280 + ch], p0 = st[ch], p1 = st[768 + ch], p2 = st[1536 + ch];
            act[ch] = siluf_(cb[ch] + cw[ch] * p0 + cw[768 + ch] * p1 + cw[1536 + ch] * p2 + cw[2304 + ch] * raw); so[ch] = p1; so[768 + ch] = p2; so[1536 + ch] = raw; }
        if (tid < 4) { const float dt = softplusf_(pr[3456 + tid] + INP(I_DTB)[l * 4 + tid]); sdt[tid] = dt; sdt[4 + tid] = __expf(dt * (-__expf(INP(I_ALOG)[l * 4 + tid]))); } }
    __syncthreads();
    { const float* h0 = INP(I_SSM) + (size_t)(l * NB + b) * 32768; float* ho = out + O_HS + (size_t)(l * NB + b) * 32768; const float* Dp = INP(I_SD) + l * 4;
        for (int row = wave; row < 256; row += 8) { const int hd = row >> 6, gq = hd >> 1; const float dt = sdt[hd], dA = sdt[4 + hd], xv = act[row]; float y = 0.f;
#pragma unroll
            for (int s2 = 0; s2 < 2; ++s2) { const int sidx = lane + 64 * s2; const float hn = dA * h0[row * 128 + sidx] + dt * xv * act[256 + gq * 128 + sidx]; ho[row * 128 + sidx] = hn; y += hn * act[512 + gq * 128 + sidx]; }
            y = wsum(y);
            if (lane == 0) ybl[row] = (y + Dp[hd] * xv) * siluf_(pr[1024 + row]); } }
    __syncthreads();
    { const float v = tid < 256 ? ybl[tid] : 0.f; const float s2 = wsum(v * v); if (lane == 0) red[8 + wave] = s2; }
    __syncthreads();
    if (tid < 256) { const float ss = red[8] + red[9] + red[10] + red[11]; ys[256 + tid] = ybl[tid] * rsqrtf(ss * (1.f / 256.f) + EPS) * INP(I_SNG)[l * 256 + tid]; }
    const float* qg = INP(I_QG) + l * 64; const float* kg = INP(I_KG) + l * 192;
    LAS float* qs = wl + 10496;
    if (wave < 4) { const float v = pr[2816 + wave * 64 + lane]; const float ss = wsum(v * v); qs[lane * 4 + wave] = v * rsqrtf(ss * (1.f / 64.f) + EPS) * qg[lane]; }
    else if (wave == 4) { const float v = pr[3072 + 128 + lane]; const float ss = wsum(v * v); nrow[lane] = v * rsqrtf(ss * (1.f / 64.f) + EPS) * kg[64 + lane]; nrow[64 + lane] = pr[3072 + 192 + lane]; }
    else if (wave == 5) { const float v = pr[3072 + 256 + lane]; const float ss = wsum(v * v); nrow[128 + lane] = v * rsqrtf(ss * (1.f / 64.f) + EPS) * kg[128 + lane]; nrow[192 + lane] = pr[3072 + 320 + lane]; }
    else if (wave == 6) { if (lane < 12) gsm[lane] = sigmoidf_(pr[3460 + lane]); }
    __syncthreads();
    const float* cache_win = INP(I_CWIN) + (size_t)(l * NB + b) * 512 * 128;
    { float* ko = out + O_KVS + (size_t)(l * NB + b) * 256;
        if (tid < 128) ko[tid] = pr[3072 + tid]; else if (tid < 192) ko[tid] = nrow[tid - 128]; else if (tid < 256) ko[tid] = nrow[64 + tid - 192];
        float* wo = out + O_WINS + (size_t)(l * NB + b) * 512 * 128;
        for (int e = tid; e < 511 * 128; e += 512) wo[e] = cache_win[128 + e];
        if (tid < 64) wo[511 * 128 + tid] = nrow[128 + tid]; else if (tid < 128) wo[511 * 128 + tid] = nrow[192 + tid - 64]; }
    float* nrp = WSF(WS_NRG) + (size_t)(l * NB + b) * 256;
    if (tid < 256) nrp[tid] = nrow[tid];
    asm volatile("s_waitcnt vmcnt(0)" ::: "memory");
    __syncthreads();
    {
        SampleKV kv{INP(I_CKV) + (size_t)l * NPOOL * 128 * 256, (const int*)c.ap->in[I_PT] + b * 128, cache_win, nrp, nrp + 64, nrp + 128, nrp + 192};
        nsa_sample_block(wl, WSF(WS_KCS) + (size_t)(l * NB + b) * 1024 * 64, WSF(WS_VCS) + (size_t)(l * NB + b) * 1024 * 64, kv, gsm, pr + 3584, ys + 768, tid, lane, wave);
    }
    edge_publish((unsigned*)(c.ws + WS_CTL + 18432) + l * 64);
    __syncthreads();
}
DI void ph_scan(LAS unsigned char* lds_, int l) {
    const Ctx c = mkctx(lds_);
    if (c.bid >= 64) return;
    const float* CST = WSF(WS_CST); float* HPV = WSF(WS_HPV); const float* CDEC = WSF(WS_CDEC);
    const int e = c.bid * 512 + c.tid, hd = e >> 13; float hc = 0.f;
    for (int ch0 = 0; ch0 < 128; ch0 += 16) {
        float sv[16], dc[16];
#pragma unroll
        for (int i = 0; i < 16; ++i) { sv[i] = CST[(size_t)(ch0 + i) * 32768 + e]; dc[i] = CDEC[(ch0 + i) * 4 + hd]; }
#pragma unroll
        for (int i = 0; i < 16; ++i) { HPV[(size_t)(ch0 + i) * 32768 + e] = hc; hc = dc[i] * hc + sv[i]; } }
    c.out[O_HP + (size_t)l * 32768 + e] = hc;
    edge_publish((unsigned*)(c.ws + WS_CTL + 17408) + l * 64);
}
DI f16x8 pack_p(const f32x4& a, const f32x4& b) { f16x8 r; r[0] = (f16)a[0]; r[1] = (f16)a[1]; r[2] = (f16)a[2]; r[3] = (f16)a[3]; r[4] = (f16)b[0]; r[5] = (f16)b[1]; r[6] = (f16)b[2]; r[7] = (f16)b[3]; return r; }
DI f16x8 ld_vt(const f16* p) { const f16x4 a = *(const f16x4*)p, b = *(const f16x4*)(p + 16); f16x8 r; r[0] = a[0]; r[1] = a[1]; r[2] = a[2]; r[3] = a[3]; r[4] = b[0]; r[5] = b[1]; r[6] = b[2]; r[7] = b[3]; return r; }
constexpr int NT_PSEL = 0  , NT_STG = 32768  , NT_STG_SZ = 18432 + 17408,
              NT_RING = 0  , NT_MASK = 131072  , NT_VB = NT_MASK + 1088  , NT_MT = NT_VB + 1088  , NT_END = NT_MT + 1088;
static_assert(NT_STG + 2 * NT_STG_SZ <= NT_MASK, "nsa tile LDS map");
static_assert(NT_END <= MISC_OFF, "nsa tile LDS map");
struct StgRegs { f16x8 k0, k1, v0, v1; };
template <bool WITH_V, class KSrc, class VSrc>
DI void stg_load(StgRegs& rg, int ch, int tid, const KSrc& ksrc, const VSrc& vsrc) {
    const f16* kp = ksrc(ch, tid >> 2) + (tid & 3) * 16; rg.k0 = ld_h8(kp); rg.k1 = ld_h8(kp + 8);
    if (WITH_V) { const f16* vp = vsrc(ch, tid >> 3, tid & 7); rg.v0 = ld_h8(vp); rg.v1 = ld_h8(vp + 8); }
}
template <bool WITH_V>
DI void stg_store(const StgRegs& rg, LAS unsigned char* buf, int tid) {
    LAS f16* kb = (LAS f16*)buf + (tid >> 2) * 72 + (tid & 3) * 16; *(LAS f16x8*)kb = rg.k0; *(LAS f16x8*)(kb + 8) = rg.k1;
    if (WITH_V) { LAS f16* vb = (LAS f16*)(buf + 18432) + (tid >> 3) * 136 + (tid & 7) * 16; *(LAS f16x8*)vb = rg.v0; *(LAS f16x8*)(vb + 8) = rg.v1; }
}
template <bool WITH_V, class KSrc, class VSrc, class Body>
DI void stream_chunks(LAS unsigned char* stg, int nchunk, int tid, const KSrc& ksrc, const VSrc& vsrc, Body body) {
    if (nchunk <= 0) return;
    const int last = nchunk - 1;
    StgRegs rg;
    stg_load<WITH_V>(rg, 0, tid, ksrc, vsrc);
    __syncthreads();
    stg_store<WITH_V>(rg, stg, tid); stg_load<WITH_V>(rg, 1 < last ? 1 : last, tid, ksrc, vsrc);
    lds_barrier();
#pragma nounroll
    for (int ch = 0; ch < nchunk; ++ch) {
        body(ch, stg + (ch & 1) * NT_STG_SZ);
        stg_store<WITH_V>(rg, stg + ((ch + 1) & 1) * NT_STG_SZ, tid); stg_load<WITH_V>(rg, ch + 2 < last ? ch + 2 : last, tid, ksrc, vsrc);
        lds_barrier();
    }
}
DI f16x8 lds_vt(const LAS f16* p) { return *(const LAS f16x8*)p; }
DI f32x4 qk_tile(const LAS f16* kb, int kt, int fr, int q, const f16x8 (&qf)[2]) {
    const LAS f16* kp = kb + (16 * kt + fr) * 72 + 8 * q; f32x4 sa = (f32x4){0.f, 0.f, 0.f, 0.f};
    sa = __builtin_amdgcn_mfma_f32_16x16x32_f16(*(const LAS f16x8*)kp, qf[0], sa, 0, 0, 0); return __builtin_amdgcn_mfma_f32_16x16x32_f16(*(const LAS f16x8*)(kp + 32), qf[1], sa, 0, 0, 0);
}
constexpr float NSA_L2E = 1.44269504f, NSA_C1 = 0.125f * NSA_L2E;
DI float ex2(float x) { return __builtin_amdgcn_exp2f(x); }
template <class Pred>
DI f16x8 pv_step(const LAS f16* kb, const LAS f16* vb, int st, int fr, int q, const f16x8 (&qf)[2], f32x4 (&o)[4], f32x4 (&e2)[2], float nb, bool masked, Pred pred) {
#pragma unroll
    for (int hf = 0; hf < 2; ++hf) { const f32x4 sa = qk_tile(kb, 2 * st + hf, fr, q, qf);
        if (!masked) {
#pragma unroll
            for (int j = 0; j < 4; ++j) e2[hf][j] = ex2(fmaf(sa[j], NSA_C1, nb)); }
        else {
#pragma unroll
            for (int j = 0; j < 4; ++j) e2[hf][j] = pred(32 * st + 16 * hf + 4 * q + j) ? ex2(fmaf(sa[j], NSA_C1, nb)) : 0.f; } }
    const f16x8 pb = pack_p(e2[0], e2[1]);
#pragma unroll
    for (int dt = 0; dt < 4; ++dt) o[dt] = __builtin_amdgcn_mfma_f32_16x16x32_f16(lds_vt(vb + (16 * dt + fr) * 136 + 32 * st + 8 * q), pb, o[dt], 0, 0, 0);
    return pb;
}
DI void nsa_tile(const Ctx& c, int tile, const f16* Q16, const f16* KC16, const f16* VCT16, const f16* KS16, const f16* VST16, const f16* KW16, const f16* VWT16,
                 const float* GATES, const f16* DG, f16* Y16, float shc, float shs, float shw) {
    LAS unsigned char* lds = c.lds; const int wave = c.wave; int tid, lane, fr, q, ti, h, trow;
    const int t0 = tile * 32, cur = t0 >> 6;
#define NSA_RELANE() do { int _t = c.tid; asm volatile("" : "+v"(_t)); tid = _t; lane = _t & 63; fr = lane & 15; q = lane >> 4; ti = fr >> 2; h = fr & 3; trow = t0 + 4 * wave + ti; } while (0)
#define NSA_REPS(bit) (((NSA_DUP >> (bit)) & 1) ? 2 : 1)
#define NSA_SCALE(rep) ({ float _z = (rep) == 0 ? 1.f : 0.f; asm volatile("" : "+v"(_z)); _z; })
    NSA_RELANE();
    LAS float* PSEL = (LAS float*)(lds + NT_PSEL); LAS unsigned* MASK = (LAS unsigned*)(lds + NT_MASK); LAS int* VB = (LAS int*)(lds + NT_VB); LAS unsigned char* STG = lds + NT_STG;
    __syncthreads();
    for (int i = tid; i < 272; i += 512) MASK[i] = (i == 0 || i == cur || i == cur - 1) ? 0xFFFFFFFFu : 0u;
    f16x8 qf[2];
#pragma unroll
    for (int ks = 0; ks < 2; ++ks) qf[ks] = ld_h8(Q16 + ((size_t)trow * 4 + h) * 64 + 32 * ks + 8 * q);
    const int nkt = ((t0 >> 4) + 1 + 15) >> 4;
    const int ncch = (nkt + 7) >> 3;
    const int nv_row = trow >= 31 ? ((trow - 31) >> 4) + 1 : 0;
    auto kc_src = [&](int ch, int row) { return KC16 + (size_t)(128 * ch + row) * 64; };
    auto vc_src = [&](int ch, int d, int seg) { return VCT16 + (size_t)d * 1024 + 128 * ch + seg * 16; };
    float lsum = 0.f;
    const float bc = -shc * NSA_L2E, bs = -shs * NSA_L2E, bw = -shw * NSA_L2E;
    const int tw0 = t0 + 4 * wave, nvmin_w = tw0 >= 31 ? ((tw0 - 31) >> 4) + 1 : 0;
    stream_chunks<false>(STG, ncch, tid, kc_src, vc_src, [&](int ch, LAS unsigned char* buf) {
        const LAS f16* kb = (const LAS f16*)buf; const int nk = nkt - 8 * ch < 8 ? nkt - 8 * ch : 8;
#pragma unroll 4
        for (int kt = 0; kt < nk; ++kt) { const f32x4 sa = qk_tile(kb, kt, fr, q, qf); const int cb = 128 * ch + 16 * kt + 4 * q;
            if (128 * ch + 16 * kt + 15 < nvmin_w) {
#pragma unroll
                for (int j = 0; j < 4; ++j) lsum += ex2(fmaf(sa[j], NSA_C1, bc)); }
            else {
#pragma unroll
                for (int j = 0; j < 4; ++j) lsum += (cb + j < nv_row) ? ex2(fmaf(sa[j], NSA_C1, bc)) : 0.f; } } });
    lsum += __shfl_xor(lsum, 16); lsum += __shfl_xor(lsum, 32);
    const float invc = lsum > 0.f ? 1.f / lsum : 0.f;
    NSA_RELANE();
    f32x4 oc[4];
#pragma unroll
    for (int dt = 0; dt < 4; ++dt) oc[dt] = (f32x4){0.f, 0.f, 0.f, 0.f};
    { float bprev = 0.f; const float pbias = invc > 0.f ? bc + __log2f(invc) : -1e30f;
    stream_chunks<true>(STG, ncch, tid, kc_src, vc_src, [&](int ch, LAS unsigned char* buf) {
        const LAS f16* kb = (const LAS f16*)buf; const LAS f16* vb = (const LAS f16*)(buf + 18432); const int ns = (nkt - 8 * ch + 1) >> 1 < 4 ? (nkt - 8 * ch + 1) >> 1 : 4;
#pragma unroll 2
        for (int s2 = 0; s2 < ns; ++s2) {
            f32x4 e2[2];
            pv_step(kb, vb, s2, fr, q, qf, oc, e2, pbias, 128 * ch + 32 * s2 + 31 >= nvmin_w, [&](int kc) { return 128 * ch + kc < nv_row; });
#pragma unroll
            for (int hf = 0; hf < 2; ++hf) {
                const int ktg = 8 * ch + 2 * s2 + hf;
                float av = (e2[hf][0] + e2[hf][1]) + (e2[hf][2] + 0.5f * e2[hf][3]), bv = 0.5f * e2[hf][3];
                av += dppf<DPP_X1>(av); av += dppf<DPP_X2>(av); bv += dppf<DPP_X1>(bv); bv += dppf<DPP_X2>(bv);
                const float up = __shfl(q == 3 ? bprev : bv, (lane + 48) & 63);
                bprev = bv;
                if (h == 0 && ktg < nkt) PSEL[(4 * wave + ti) * 256 + 4 * ktg + q] = av + up;
            }
        } }); }
    for (int rep = 0; rep < NSA_REPS(2); ++rep) {
        const int nforced = cur >= 2 ? 3 : cur + 1, nsel = ((cur + 1) < 16 ? (cur + 1) : 16) - nforced, tk = lane >> 4, l16 = lane & 15, tokl = 4 * wave + tk;
        float sv[16];
#pragma unroll
        for (int i = 0; i < 16; ++i) { const int j = l16 + 16 * i; float v = -3e38f;
            if (j <= cur && !(j == 0 || j == cur || j == cur - 1)) v = j < 4 * nkt ? PSEL[tokl * 256 + j] : 0.f;
            sv[i] = v; }
#pragma nounroll
        for (int k = 0; k < nsel; ++k) {
            float bv = sv[0]; int bi = l16;
#pragma unroll
            for (int i = 1; i < 16; ++i) if (sv[i] > bv) { bv = sv[i]; bi = l16 + 16 * i; }
#define TOPK_STEP(CT) do { const float ov = dppf<CT>(bv); const int oi = dppi<CT>(bi); if (ov > bv || (ov == bv && oi < bi)) { bv = ov; bi = oi; } } while (0)
            TOPK_STEP(DPP_X1); TOPK_STEP(DPP_X2); TOPK_STEP(DPP_HM); TOPK_STEP(DPP_R8);
#undef TOPK_STEP
            if (l16 == 0) __hip_atomic_fetch_or(&MASK[bi], 1u << tokl, __ATOMIC_RELAXED, __HIP_MEMORY_SCOPE_WORKGROUP);
#pragma unroll
            for (int i = 0; i < 16; ++i) if (l16 + 16 * i == bi) sv[i] = -3e38f;
        }
    }
    NSA_RELANE();
    f32x4 owr[4]; float lwr = 0.f;
#pragma unroll
    for (int dt = 0; dt < 4; ++dt) owr[dt] = (f32x4){0.f, 0.f, 0.f, 0.f};
    f16x8 onesf;
#pragma unroll
    for (int i = 0; i < 8; ++i) onesf[i] = fr == 0 ? (f16)1.f : (f16)0.f;
    f32x4 lw5 = (f32x4){0.f, 0.f, 0.f, 0.f};
    {
        const int wlo = t0 - 512 > 0 ? t0 - 512 : 0, nwch = (t0 + 32 - wlo + 127) >> 7;
        auto kw_src = [&](int ch, int row) { int p = wlo + 128 * ch + row; p = p < SEQ ? p : SEQ - 1; return KW16 + (size_t)p * 64; };
        auto vw_src = [&](int ch, int d, int seg) { const int key = wlo + 128 * ch + seg * 16; int blk = key >> 6; blk = blk < 256 ? blk : 255; return VWT16 + (size_t)blk * 4096 + d * 64 + (key & 63); };
        {
        stream_chunks<true>(STG, nwch, tid, kw_src, vw_src, [&](int ch, LAS unsigned char* buf) {
            const LAS f16* kb = (const LAS f16*)buf; const LAS f16* vb = (const LAS f16*)(buf + 18432); const int pbase = wlo + 128 * ch;
            const int ns = (t0 + 32 - pbase) >> 5 < 4 ? (t0 + 32 - pbase) >> 5 : 4;
#pragma unroll 2
            for (int s2 = 0; s2 < ns; ++s2) { f32x4 e2[2];
                const int p0s = pbase + 32 * s2; const bool masked = !(p0s >= tw0 + 3 - 512 && p0s + 31 <= tw0);
                const f16x8 pb = pv_step(kb, vb, s2, fr, q, qf, owr, e2, bw, masked, [&](int kc) { const int pos = pbase + kc; return pos <= trow && pos >= trow - 512; });
                lw5 = __builtin_amdgcn_mfma_f32_16x16x32_f16(onesf, pb, lw5, 0, 0, 0); } }); }
        lwr = lw5[0];
    }
    NSA_RELANE();
    LAS unsigned* MT = (LAS unsigned*)(lds + NT_MT);
    if (wave == 0) { int cnt = 0;
        for (int base = 0; base <= cur; base += 64) { const int jx = base + lane; const unsigned mj = jx <= cur ? MASK[jx] : 0u; const bool v = mj != 0u; const unsigned long long bal = __ballot(v);
            if (v) { const int pos = cnt + __popcll(bal & ((1ull << lane) - 1ull)); VB[pos] = jx; MT[pos] = mj; } cnt += __popcll(bal); }
        if (lane < 8) { VB[cnt + lane] = VB[cnt - 1]; MT[cnt + lane] = 0u; }
        if (lane == 0) VB[264] = cnt; }
    __syncthreads();
    if (VERIFY_NSA) { unsigned* SELM = (unsigned*)(c.ws + WS_SELM) + (size_t)tile * 272; for (int i = tid; i < 272; i += 512) SELM[i] = MASK[i]; }
    f32x4 osr[4]; float lsr = 0.f; f32x4 ls5 = (f32x4){0.f, 0.f, 0.f, 0.f};
#pragma unroll
    for (int dt = 0; dt < 4; ++dt) osr[dt] = (f32x4){0.f, 0.f, 0.f, 0.f};
#pragma unroll
    for (int i = 0; i < 8; ++i) onesf[i] = fr == 0 ? (f16)1.f : (f16)0.f;
    {
        const int nvb = __builtin_amdgcn_readfirstlane(VB[264]), nst = (nvb + 3) >> 2;
        const int dr = lane >> 3, dp = lane & 7, dsw = (dp ^ dr) * 8;
        LAS unsigned char* RING = lds + NT_RING;
        auto dma = [&](int n, int blk) { LAS unsigned char* slot = RING + (n & 7) * 16384 + wave * 1024;
            __builtin_amdgcn_global_load_lds((const unsigned*)(KS16 + ((size_t)blk * 64 + 8 * wave + dr) * 64 + dsw), (LAS unsigned*)slot, 16, 0, 0);
            __builtin_amdgcn_global_load_lds((const unsigned*)(VST16 + (size_t)blk * 4096 + (8 * wave + dr) * 64 + dsw), (LAS unsigned*)(slot + 8192), 16, 0, 0); };
        {
        asm volatile("s_waitcnt vmcnt(0)" ::: "memory"); __syncthreads();
        typedef int i32x4 __attribute__((ext_vector_type(4)));
#define RFL4(v) { __builtin_amdgcn_readfirstlane((v)[0]), __builtin_amdgcn_readfirstlane((v)[1]), __builtin_amdgcn_readfirstlane((v)[2]), __builtin_amdgcn_readfirstlane((v)[3]) }
        { const i32x4 b0 = *(const LAS i32x4*)VB; const int bb[4] = RFL4(b0); dma(0, bb[0]); dma(1, bb[1]); dma(2, bb[2]); dma(3, bb[3]); }
#pragma nounroll
        for (int st = 0; st < nst; ++st) {
            asm volatile("s_waitcnt vmcnt(0)\n\ts_barrier" ::: "memory");
            const i32x4 bcv = *(const LAS i32x4*)(VB + 4 * st), bnv = *(const LAS i32x4*)(VB + 4 * st + 4); const u32x4 mcv = *(const LAS u32x4*)(MT + 4 * st);
            const int bcur[4] = RFL4(bcv), bnxt[4] = RFL4(bnv); const int mcur[4] = RFL4(mcv);
            dma(4 * st + 4, bnxt[0]); dma(4 * st + 5, bnxt[1]); dma(4 * st + 6, bnxt[2]); dma(4 * st + 7, bnxt[3]);
#pragma unroll
            for (int i4 = 0; i4 < 4; ++i4) {
            const int n = 4 * st + i4;
            const int blk = bcur[i4]; const unsigned mt = ((unsigned)mcur[i4] >> (4 * wave)) & 15u;
            if (mt != 0u) {
                const bool rv = ((mt >> ti) & 1u) != 0u; const LAS unsigned char* ks = RING + (n & 7) * 16384; const LAS unsigned char* vs = ks + 8192; const int sx = fr & 7;
                f32x4 sa[4]; f16x8 va[2][4];
#pragma unroll
                for (int kt = 0; kt < 4; ++kt) { const LAS unsigned char* kp = ks + (16 * kt + fr) * 128; sa[kt] = (f32x4){0.f, 0.f, 0.f, 0.f};
                    sa[kt] = __builtin_amdgcn_mfma_f32_16x16x32_f16(*(const LAS f16x8*)(kp + ((q ^ sx) << 4)), qf[0], sa[kt], 0, 0, 0);
                    sa[kt] = __builtin_amdgcn_mfma_f32_16x16x32_f16(*(const LAS f16x8*)(kp + (((4 + q) ^ sx) << 4)), qf[1], sa[kt], 0, 0, 0); }
#pragma unroll
                for (int s2 = 0; s2 < 2; ++s2)
#pragma unroll
                    for (int dt = 0; dt < 4; ++dt) va[s2][dt] = *(const LAS f16x8*)(vs + (16 * dt + fr) * 128 + (((4 * s2 + q) ^ sx) << 4));
                const float nbu = rv ? bs : -1e30f;
                if (blk != cur) {
#pragma unroll
                    for (int kt = 0; kt < 4; ++kt)
#pragma unroll
                        for (int j = 0; j < 4; ++j) sa[kt][j] = ex2(fmaf(sa[kt][j], NSA_C1, nbu)); }
                else { const int pb0 = 64 * blk + 4 * q;
#pragma unroll
                    for (int kt = 0; kt < 4; ++kt)
#pragma unroll
                        for (int j = 0; j < 4; ++j) sa[kt][j] = (pb0 + 16 * kt + j <= trow) ? ex2(fmaf(sa[kt][j], NSA_C1, nbu)) : 0.f; }
                const f16x8 p0 = pack_p(sa[0], sa[1]), p1 = pack_p(sa[2], sa[3]);
#pragma unroll
                for (int dt = 0; dt < 4; ++dt) { osr[dt] = __builtin_amdgcn_mfma_f32_16x16x32_f16(va[0][dt], p0, osr[dt], 0, 0, 0); osr[dt] = __builtin_amdgcn_mfma_f32_16x16x32_f16(va[1][dt], p1, osr[dt], 0, 0, 0); }
                ls5 = __builtin_amdgcn_mfma_f32_16x16x32_f16(onesf, p0, ls5, 0, 0, 0); ls5 = __builtin_amdgcn_mfma_f32_16x16x32_f16(onesf, p1, ls5, 0, 0, 0);
            }
            }
        }
        asm volatile("s_waitcnt vmcnt(0)" ::: "memory"); }
        __syncthreads();
        lsr = ls5[0];
    }
    NSA_RELANE();
    lwr += __shfl_xor(lwr, 16); lwr += __shfl_xor(lwr, 32); lsr += __shfl_xor(lsr, 16); lsr += __shfl_xor(lsr, 32);
    {
        const float g0 = GATES[(size_t)trow * 12 + h * 3], ils = GATES[(size_t)trow * 12 + h * 3 + 1] / lsr, ilw = GATES[(size_t)trow * 12 + h * 3 + 2] / lwr;
#pragma unroll
        for (int dt = 0; dt < 4; ++dt) { const int d0 = 16 * dt + 4 * q; const f16x4 dg = *(const f16x4*)(DG + (size_t)trow * 256 + h * 64 + d0); f16x4 y;
#pragma unroll
            for (int jj = 0; jj < 4; ++jj) { const float o = g0 * oc[dt][jj] + ils * osr[dt][jj] + ilw * owr[dt][jj]; y[jj] = (f16)(siluf_((float)dg[jj]) * o); }
            *(f16x4*)(Y16 + (size_t)trow * 1024 + 768 + h * 64 + d0) = y; }
    }
#undef NSA_RELANE
}
DI void ph_ssd_fin(LAS unsigned char* lds_, int l, int it0, int it1, int itstep);
DI void ph_outproj_sample(LAS unsigned char* lds_, int l, int it);
DI void ph_nsa(LAS unsigned char* lds_, int l) {
    const Ctx c = mkctx(lds_); const int lane = c.lane;
    const float* qg = INP(I_QG) + l * 64; const float* kg = INP(I_KG) + l * 192;
    const float mq = wmaxf(fabsf(qg[lane])), mk0 = wmaxf(fabsf(kg[lane])), mk1 = wmaxf(fabsf(kg[64 + lane])), mk2 = wmaxf(fabsf(kg[128 + lane]));
    const float shc = 8.f * mq * mk0 - 8.f, shs = 8.f * mq * mk1 - 8.f, shw = 8.f * mq * mk2 - 8.f;
    unsigned* qctr = (unsigned*)(c.ws + WS_CTL + 16384) + l * 64; LAS int* qslot = (LAS int*)(c.lds + MISC_OFF + 64); bool fin_ok = false, smp_ok = false;
    for (;;) {
        __syncthreads();
        if (c.tid == 0) *qslot = (int)__hip_atomic_fetch_add(qctr, 1u, __ATOMIC_RELAXED, __HIP_MEMORY_SCOPE_AGENT);
        __syncthreads();
        const int u = __builtin_amdgcn_readfirstlane(*qslot);
        if (u >= 800) break;
        if (u < 512) nsa_tile(c, 511 - u, WSH(WS_Q16), WSH(WS_KC16), WSH(WS_VCT16), WSH(WS_KS16), WSH(WS_VST16), WSH(WS_KW16), WSH(WS_VWT16), WSF(WS_GATES), WSH(WS_PROJ) + (size_t)14 * SEQ * 256, WSH(WS_Y16), shc, shs, shw);
        else if (u < 768) { if (!fin_ok) { edge_wait((unsigned*)(c.ws + WS_CTL + 17408) + l * 64, 64u); fin_ok = true; } ph_ssd_fin(lds_, l, u - 512, u - 511, 1); }
        else { if (!smp_ok) { edge_wait((unsigned*)(c.ws + WS_CTL + 18432) + l * 64, 32u); smp_ok = true; } ph_outproj_sample(lds_, l, u - 768); }
    }
    __syncthreads();
}
DI void ph_nsa_verify(LAS unsigned char* lds_, int l) {
    const Ctx c = mkctx(lds_); const int lane = c.lane;
    LAS float* wl = (LAS float*)c.lds + c.wave * 4400; LAS float* sc = wl; LAS float* qs = wl + 4096; LAS unsigned* selb = (LAS unsigned*)(wl + 4352);
    const f16* Q16 = WSH(WS_Q16); const f16* KC16 = WSH(WS_KC16); const f16* VCT16 = WSH(WS_VCT16); const f16* KS16 = WSH(WS_KS16); const f16* VST16 = WSH(WS_VST16); const f16* KW16 = WSH(WS_KW16); const f16* VWT16 = WSH(WS_VWT16);
    const float* GATES = WSF(WS_GATES); const f16* DG = WSH(WS_PROJ) + (size_t)14 * SEQ * 256; const f16* Y16 = WSH(WS_Y16); const unsigned* SELM = (const unsigned*)(c.ws + WS_SELM);
    float* dbg = (float*)(c.ws + WS_CTL + 40960);
    auto dot4 = [&](const f16* kp, float (&s4)[4]) { s4[0] = s4[1] = s4[2] = s4[3] = 0.f;
#pragma unroll
        for (int i = 0; i < 8; ++i) { const f16x8 kv = ld_h8(kp + 8 * i);
#pragma unroll
            for (int j = 0; j < 8; ++j) { const f32x4 qv = *(const LAS f32x4*)(qs + (8 * i + j) * 4); const float kf = (float)kv[j]; s4[0] += qv[0] * kf; s4[1] += qv[1] * kf; s4[2] += qv[2] * kf; s4[3] += qv[3] * kf; } }
#pragma unroll
        for (int hh = 0; hh < 4; ++hh) s4[hh] *= 0.125f; };
    for (int si = c.bid * 8 + c.wave; si < 200 + 395; si += c.G * 8) {
        const int t = si < 200 ? si : 200 + (si - 200) * 41, cur = t >> 6, ncv = t >= 31 ? ((t - 31) >> 4) + 1 : 0;
#pragma unroll
        for (int hh = 0; hh < 4; ++hh) qs[lane * 4 + hh] = (float)Q16[(size_t)t * 256 + hh * 64 + lane];
        if (lane < 9) selb[lane] = 0u;
        float oc[4] = {0.f, 0.f, 0.f, 0.f}, os[4] = {0.f, 0.f, 0.f, 0.f}, ow[4] = {0.f, 0.f, 0.f, 0.f};
        {
            float mx[4] = {-3e38f, -3e38f, -3e38f, -3e38f}, inv[4];
            for (int cc = lane; cc < ncv; cc += 64) { asm volatile("" ::: "memory"); float s4[4]; dot4(KC16 + (size_t)cc * 64, s4);
#pragma unroll
                for (int hh = 0; hh < 4; ++hh) { sc[hh * 1024 + cc] = s4[hh]; mx[hh] = fmaxf(mx[hh], s4[hh]); } }
#pragma unroll
            for (int hh = 0; hh < 4; ++hh) { mx[hh] = wmaxf(mx[hh]); float sm = 0.f; for (int cc = lane; cc < ncv; cc += 64) { const float e = __expf(sc[hh * 1024 + cc] - mx[hh]); sc[hh * 1024 + cc] = e; sm += e; } sm = wsum(sm); inv[hh] = ncv > 0 ? 1.f / sm : 0.f; }
            for (int cc = lane; cc < ncv; cc += 64) {
#pragma unroll
                for (int hh = 0; hh < 4; ++hh) sc[hh * 1024 + cc] *= inv[hh]; }
            for (int cc = 0; cc < ncv; ++cc) { const float v = (float)VCT16[(size_t)lane * 1024 + vt_pos(cc)];
#pragma unroll
                for (int hh = 0; hh < 4; ++hh) oc[hh] += sc[hh * 1024 + cc] * v; }
        }
        const int nsel = (cur + 1) < 16 ? (cur + 1) : 16;
        {
            float scv[5];
#pragma unroll
            for (int i = 0; i < 5; ++i) { const int j = lane + 64 * i; float v = -3e38f;
                if (j <= cur) { if (j == 0 || j == cur || j == cur - 1) v = 3e38f; else { float a = 0.f;
#pragma unroll
                        for (int o5 = -1; o5 < 4; ++o5) { const int cc = 4 * j + o5; if (cc >= 0 && cc < ncv) { const float p = (sc[cc] + sc[1024 + cc]) + (sc[2048 + cc] + sc[3072 + cc]); a += (o5 == -1 || o5 == 3) ? 0.5f * p : p; } }
                        v = a; } }
                scv[i] = v; }
            for (int k = 0; k < nsel; ++k) {
                float bv = scv[0]; int bi = lane;
#pragma unroll
                for (int i = 1; i < 5; ++i) if (scv[i] > bv) { bv = scv[i]; bi = lane + 64 * i; }
#pragma unroll
                for (int off = 32; off > 0; off >>= 1) { const float ov = __shfl_xor(bv, off); const int oi = __shfl_xor(bi, off); if (ov > bv || (ov == bv && oi < bi)) { bv = ov; bi = oi; } }
                if (lane == 0) selb[bi >> 5] |= 1u << (bi & 31);
#pragma unroll
                for (int i = 0; i < 5; ++i) if (lane + 64 * i == bi) scv[i] = -3e38f;
            }
        }
        int nmis = 0;
        for (int j = lane; j <= cur; j += 64) { const unsigned fb = (SELM[(size_t)(t >> 5) * 272 + j] >> (t & 31)) & 1u, nb = (selb[j >> 5] >> (j & 31)) & 1u; nmis += (fb != nb) ? 1 : 0; }
        nmis = (int)wsum((float)nmis);
        if (nmis != 0) { if (lane == 0) { atomicAdd(dbg + 3, 1.f); atomicAdd(dbg + 4, (float)nmis); } continue; }
        {
            float mx[4] = {-3e38f, -3e38f, -3e38f, -3e38f}, inv[4]; int nk = 0;
            for (int j = 0; j <= cur; ++j) if ((selb[j >> 5] >> (j & 31)) & 1u) { asm volatile("" ::: "memory"); const int pos = j * 64 + lane; float s4[4] = {-1e30f, -1e30f, -1e30f, -1e30f}; if (pos <= t) dot4(KS16 + (size_t)pos * 64, s4);
#pragma unroll
                for (int hh = 0; hh < 4; ++hh) { sc[hh * 1024 + nk * 64 + lane] = s4[hh]; mx[hh] = fmaxf(mx[hh], s4[hh]); } ++nk; }
#pragma unroll
            for (int hh = 0; hh < 4; ++hh) { mx[hh] = wmaxf(mx[hh]); float sm = 0.f; for (int k = 0; k < nk; ++k) { const float x = sc[hh * 1024 + k * 64 + lane]; const float e = x > -1e29f ? __expf(x - mx[hh]) : 0.f; sc[hh * 1024 + k * 64 + lane] = e; sm += e; } sm = wsum(sm); inv[hh] = 1.f / sm; }
            nk = 0;
            for (int j = 0; j <= cur; ++j) if ((selb[j >> 5] >> (j & 31)) & 1u) { for (int kk = 0; kk < 64 && j * 64 + kk <= t; ++kk) { const float v = (float)VST16[(size_t)j * 4096 + lane * 64 + vt_pos(kk)];
#pragma unroll
                    for (int hh = 0; hh < 4; ++hh) os[hh] += sc[hh * 1024 + nk * 64 + kk] * v; } ++nk; }
#pragma unroll
            for (int hh = 0; hh < 4; ++hh) os[hh] *= inv[hh];
        }
        {
            const int lo = t - 512 > 0 ? t - 512 : 0, nw = t - lo + 1; float mx[4] = {-3e38f, -3e38f, -3e38f, -3e38f}, inv[4];
            for (int i = lane; i < nw; i += 64) { asm volatile("" ::: "memory"); float s4[4]; dot4(KW16 + (size_t)(lo + i) * 64, s4);
#pragma unroll
                for (int hh = 0; hh < 4; ++hh) { sc[hh * 1024 + i] = s4[hh]; mx[hh] = fmaxf(mx[hh], s4[hh]); } }
#pragma unroll
            for (int hh = 0; hh < 4; ++hh) { mx[hh] = wmaxf(mx[hh]); float sm = 0.f; for (int i = lane; i < nw; i += 64) { const float e = __expf(sc[hh * 1024 + i] - mx[hh]); sc[hh * 1024 + i] = e; sm += e; } sm = wsum(sm); inv[hh] = 1.f / sm; }
            for (int i = 0; i < nw; ++i) { const int pos = lo + i; const float v = (float)VWT16[(size_t)(pos >> 6) * 4096 + lane * 64 + vt_pos(pos & 63)];
#pragma unroll
                for (int hh = 0; hh < 4; ++hh) ow[hh] += sc[hh * 1024 + i] * v; }
#pragma unroll
            for (int hh = 0; hh < 4; ++hh) ow[hh] *= inv[hh];
        }
        float dd = 0.f, ee = 0.f;
#pragma unroll
        for (int hh = 0; hh < 4; ++hh) { const float o = GATES[(size_t)t * 12 + hh * 3] * oc[hh] + GATES[(size_t)t * 12 + hh * 3 + 1] * os[hh] + GATES[(size_t)t * 12 + hh * 3 + 2] * ow[hh];
            const float yn = siluf_((float)DG[(size_t)t * 256 + hh * 64 + lane]) * o, yf = (float)Y16[(size_t)t * 1024 + 768 + hh * 64 + lane]; dd += (yf - yn) * (yf - yn); ee += yn * yn; }
        dd = wsum(dd); ee = wsum(ee);
        if (lane == 0) { atomicAdd(dbg, dd); atomicAdd(dbg + 1, ee); atomicAdd(dbg + 2, 1.f); }
    }
    (void)l;
}
DI void ph_ssd_fin(LAS unsigned char* lds_, int l, int it0, int it1, int itstep) {
    const Ctx c = mkctx(lds_); const int lane = c.lane, wave = c.wave;
    const float* Dp = INP(I_SD) + l * 4; const float* sng = INP(I_SNG) + l * 256;
    const float* CST = WSF(WS_HPV); const f16* ACT = WSH(WS_ACT); const float* ACS = WSF(WS_ACS); const float* YD = WSF(WS_YD); const f16* Z = WSH(WS_PROJ) + (size_t)4 * SEQ * 256; f16* Y16 = WSH(WS_Y16);
    LAS float* GY = (LAS float*)c.lds;
    for (int it = it0; it < it1; it += itstep) {
        const int ch_ = it >> 1, t0 = it * 64, hd = wave >> 1, g = hd >> 1, fr = lane & 15, q = lane >> 4;
        __syncthreads();
        f16x8 bf[2][4];
#pragma unroll
        for (int p2 = 0; p2 < 2; ++p2)
#pragma unroll
            for (int ks = 0; ks < 4; ++ks) bf[p2][ks] = cvt_h8(CST + ((size_t)(ch_ * 4 + hd) * 64 + 16 * ((wave & 1) * 2 + p2) + fr) * 128 + 32 * ks + 8 * q);
#pragma unroll
        for (int lt = 0; lt < 4; ++lt) {
            f16x8 af[4];
#pragma unroll
            for (int ks = 0; ks < 4; ++ks) af[ks] = ld_h8(ACT + (size_t)(t0 + 16 * lt + fr) * 768 + 512 + 128 * g + 32 * ks + 8 * q);
#pragma unroll
            for (int p2 = 0; p2 < 2; ++p2) { f32x4 acc = (f32x4){0.f, 0.f, 0.f, 0.f};
#pragma unroll
                for (int ks = 0; ks < 4; ++ks) acc = __builtin_amdgcn_mfma_f32_16x16x32_f16(af[ks], bf[p2][ks], acc, 0, 0, 0);
                const int ch = hd * 64 + 16 * ((wave & 1) * 2 + p2) + fr;
#pragma unroll
                for (int j = 0; j < 4; ++j) { const int tl = 16 * lt + 4 * q + j, t = t0 + tl;
                    const float y = acc[j] * __expf(ACS[(size_t)t * 4 + hd]) + YD[(size_t)t * 256 + ch] + Dp[hd] * (float)ACT[(size_t)t * 768 + ch];
                    GY[tl * 256 + ch] = y * siluf_((float)Z[(size_t)t * 256 + ch]); } }
        }
        __syncthreads();
        for (int tl = wave; tl < 64; tl += 8) { const f32x4 v = *(const LAS f32x4*)(GY + tl * 256 + lane * 4); const float ss = wsum((v[0] * v[0] + v[1] * v[1]) + (v[2] * v[2] + v[3] * v[3]));
            const float rn = rsqrtf(ss * (1.f / 256.f) + EPS); const f32x4 g4 = *(const f32x4*)(sng + lane * 4); f16x4 o;
#pragma unroll
            for (int i = 0; i < 4; ++i) o[i] = (f16)(v[i] * rn * g4[i]);
            *(f16x4*)(Y16 + (size_t)(t0 + tl) * 1024 + 256 + lane * 4) = o; }
    }
    __syncthreads();
}
DI void ph_outproj(LAS unsigned char* lds_, int l) {
    const Ctx c = mkctx(lds_);
    const float* xin = l == 0 ? INP(I_XP) : WSF(WS_X1); float* xout = l == 0 ? WSF(WS_X1) : c.out + O_YP;
    pg8::Gemm g{WSH(WS_Y16), WSH(WS_WTOUT) + (size_t)l * 1024 * 1024, SEQ, 1024, 1024}; pg8::StaticOrder S; S.init(SEQ, 1024, c.G, c.bid);
    EpiOut E{xin, xout, WSF(WS_ADA) + (size_t)(l * 33 + 32) * 3072 + 2048, l == 0 ? WSH(WS_A16) : nullptr, WSF(WS_GNX), WSF(WS_RSSP)};
    pg8::gemm_phase<EpiOut, pg8::StaticOrder>(c.lds, g, S, E);
    __syncthreads();
}
DI void ph_outproj_sample(LAS unsigned char* lds_, int l, int it) {
    const Ctx c = mkctx(lds_); const int tid = c.tid;
    const float* xs_in = l == 0 ? INP(I_XS) : WSF(WS_XS1); const float* ada_l = WSF(WS_ADA) + (size_t)l * 33 * 3072; const float* YS = WSF(WS_YS); float* xo = l == 0 ? WSF(WS_XS1) : c.out + O_YS;
    LAS f16* Ah = (LAS f16*)c.lds;
    __syncthreads();
#pragma unroll
    for (int i = 0; i < 16; ++i) { const int e = (tid + 512 * i) * 4; const f32x4 v = *(const f32x4*)(YS + e); f16x4 hv; hv[0] = (f16)v[0]; hv[1] = (f16)v[1]; hv[2] = (f16)v[2]; hv[3] = (f16)v[3]; *(LAS f16x4*)(Ah + (e >> 10) * 1032 + (e & 1023)) = hv; }
    __syncthreads();
    sample_gemm_item<1>(c.lds, WSH(WS_WTOUT) + (size_t)l * 1024 * 1024, it * 32, [&](int m, int n, float v) { xo[m * 1024 + n] = xs_in[m * 1024 + n] + ada_l[(size_t)m * 3072 + 2048 + n] * v; });
}

__global__ void __launch_bounds__(512, 2) fwd(Args a) {
    extern __shared__ __attribute__((aligned(16))) unsigned char lds_raw[];
    LAS unsigned char* lds = (LAS unsigned char*)lds_raw;
    volatile LAS unsigned* MISC = (volatile LAS unsigned*)(lds + MISC_OFF);
    if (threadIdx.x < 16) MISC[threadIdx.x] = 0u;
    __syncthreads();
    XcdBarrier bar; bar.bar = (unsigned*)(a.ws + WS_CTL); bar.x = 0; bar.st = MISC;
    if (N_LAUNCHES == 1) bar = xcd_barrier_post((unsigned*)(a.ws + WS_CTL), MISC);
    const int lo = a.ph_lo, hi = a.ph_hi;
    unsigned long long* stampw = (unsigned long long*)(a.ws + WS_CTL + 32768);
    if (STAMP_PHASE >= 0 && blockIdx.x == 0 && threadIdx.x == 0) stampw[0] = wall_clock64();
#define STAMP(k) do { if (STAMP_PHASE == (k) && blockIdx.x == 0 && threadIdx.x == 0) stampw[1] = wall_clock64(); } while (0)
#ifndef PH_MASK
#define PH_MASK 0xFFF
#endif
#define IN(k) (((PH_MASK >> ((k) < 2 ? (k) : 2 + ((k) - 2) % 4)) & 1) && lo <= (k) && (k) < hi)
#define SEAM(k) do { if (IN(k) && IN((k) + 1)) xcd_barrier(bar); STAMP(k); } while (0)
#ifndef DUP_MASK
#define DUP_MASK 0
#endif
#define DUP(bit, call) do { call; if ((DUP_MASK >> (bit)) & 1) { __syncthreads(); call; } } while (0)
    if (IN(0)) DUP(0, ph_prologue(lds));
    SEAM(0);
    if (IN(1)) { ph_hsample(lds, 0); DUP(1, ph_sample_compress(lds)); DUP(2, ph_prep(lds)); }
    SEAM(1);
    for (int l = 0; l < 2; ++l) {
        const int PB = 2 + 4 * l;
        if (IN(PB)) { DUP(3, ph_inproj(lds, l)); DUP(4, ph_inproj_sample(lds, l)); }
        SEAM(PB);
        if (IN(PB + 1)) {
#define SUBSTAMP(code) do { if (l == 0 && (STAMP_PHASE == (code) || STAMP_PHASE == (code) + 10) && blockIdx.x == (STAMP_PHASE >= 110 ? 100 : 0) && threadIdx.x == 0) stampw[1] = wall_clock64(); } while (0)
            DUP(5, ph_ssd_local(lds, l)); SUBSTAMP(100); DUP(6, ph_mix_a(lds, l)); SUBSTAMP(101); DUP(7, ph_mix_c(lds, l)); SUBSTAMP(102); DUP(8, ph_mix_d(lds, l)); SUBSTAMP(103); DUP(9, ph_mix_cmp(lds, l)); SUBSTAMP(104); }
        SEAM(PB + 1);
        if (IN(PB + 2)) { DUP(11, ph_scan(lds, l)); DUP(10, ph_mix_sample(lds, l)); ph_nsa(lds, l); }
        SEAM(PB + 2);
        if (IN(PB + 3)) { if (VERIFY_NSA && l == 0) { ph_nsa_verify(lds, l); __syncthreads(); } if (l == 0) ph_hsample(lds, 1); DUP(14, ph_outproj(lds, l)); }
        SEAM(PB + 3);
    }
    if (STAMP_PHASE >= 0 || VERIFY_NSA) {
        xcd_barrier(bar);
        if (blockIdx.x == 0) { __shared__ float alpha_s; if (threadIdx.x == 0) { const unsigned long long t1 = wall_clock64(); alpha_s = (float)(stampw[1] - stampw[0]) / (float)(t1 - stampw[0]);
                if (VERIFY_NSA) { const float* dbg = (const float*)(a.ws + WS_CTL + 40960); alpha_s = VERIFY_NSA == 1 ? dbg[3] / (dbg[2] + dbg[3]) : sqrtf(dbg[0] / dbg[1]); } } __syncthreads();
            const float sc = 1.f + alpha_s; float* ys = a.out + O_YS; for (int i = threadIdx.x; i < NB * 1024; i += 512) ys[i] *= sc; }
    }
#undef IN
#undef SEAM
}

extern "C" void kernel_launch(void* const* d_in, const int* in_sizes, int n_in, void* d_out, int out_size, void* d_ws, size_t ws_size, hipStream_t stream) {
    static int grid = 0;
    if (grid == 0) {
        if (n_in != N_IN || (size_t)out_size != O_END || ws_size < WS_END) { fprintf(stderr, "kernel_launch: unexpected shapes (n_in %d out %d ws %zu)\n", n_in, out_size, ws_size); grid = -1; return; }
        int dev = 0, cus = 0;
        if (hipGetDevice(&dev) != hipSuccess || hipDeviceGetAttribute(&cus, hipDeviceAttributeMultiprocessorCount, dev) != hipSuccess) { grid = -1; return; }
        if (hipFuncSetAttribute((const void*)fwd, hipFuncAttributeMaxDynamicSharedMemorySize, LDS_BYTES) != hipSuccess) { fprintf(stderr, "kernel_launch: hipFuncSetAttribute failed\n"); grid = -1; return; }
        int per_cu = 0;
        if (hipOccupancyMaxActiveBlocksPerMultiprocessor(&per_cu, (const void*)fwd, 512, LDS_BYTES) != hipSuccess || per_cu < 1) fprintf(stderr, "kernel_launch: occupancy query says %d\n", per_cu);
        (void)hipGetLastError();
        grid = cus;
    }
    if (grid < 0) return;
    hipMemsetAsync((char*)d_ws + WS_CTL, 0, 65536, stream);
    Args a{};
    for (int i = 0; i < N_IN; ++i) a.in[i] = d_in[i];
    a.out = (float*)d_out; a.ws = (unsigned char*)d_ws;
    if (N_LAUNCHES == 1) { a.ph_lo = 0; a.ph_hi = NPHASE; hipLaunchKernelGGL(fwd, dim3(grid), dim3(512), LDS_BYTES, stream, a); }
    else for (int p = 0; p < NPHASE; ++p) { a.ph_lo = p; a.ph_hi = p + 1; hipLaunchKernelGGL(fwd, dim3(grid), dim3(512), LDS_BYTES, stream, a); }
}
```

```cpp
#include <hip/hip_runtime.h>
#include <cstdio>
#include <cstdint>
#include <type_traits>

#define NSA_DUP 0
#define VERIFY_NSA 0
#define STAMP_PHASE -1
#ifndef N_LAUNCHES
#define N_LAUNCHES 1
#endif

#define DI __device__ __forceinline__
#define LAS __attribute__((address_space(3)))
typedef _Float16 f16;
typedef _Float16 f16x8 __attribute__((ext_vector_type(8)));
typedef _Float16 f16x4 __attribute__((ext_vector_type(4)));
typedef _Float16 f16x2 __attribute__((ext_vector_type(2)));
typedef float f32x4 __attribute__((ext_vector_type(4)));
typedef float f32x2 __attribute__((ext_vector_type(2)));
typedef float f32x16 __attribute__((ext_vector_type(16)));
typedef unsigned u32x4 __attribute__((ext_vector_type(4)));

constexpr int DM = 1024, SEQ = 16384, NB = 32, PAST = 16384, NPOOL = 5120, DIN = 3728, NPD = 3840;
constexpr float EPS = 1e-6f;
constexpr int NPHASE = 10;
enum { I_XP = 0, I_XS, I_CKV, I_CWIN, I_SSC, I_SBC, I_SSM, I_SCF, I_PT, I_CP, I_CS, I_NG, I_WADA, I_BADA, I_WIN, I_WOUT, I_SCW, I_BCW, I_BCB,
       I_DTB, I_ALOG, I_SD, I_SNG, I_CFW, I_CFB, I_LNG, I_LNB, I_QG, I_KG, I_PE, I_W1, I_B1, I_W2, I_B2, N_IN };
constexpr size_t O_YP = 0, O_YS = O_YP + (size_t)SEQ * DM, O_KVP = O_YS + NB * DM, O_KVS = O_KVP + (size_t)2 * SEQ * 256, O_WINP = O_KVS + 2 * NB * 256,
                 O_WINS = O_WINP + 2 * 512 * 128, O_SCP = O_WINS + (size_t)2 * NB * 512 * 128, O_SCS = O_SCP + 2 * 2 * 256, O_BCP = O_SCS + 2 * NB * 512,
                 O_BCS = O_BCP + 2 * 3 * 768, O_HP = O_BCS + 2 * NB * 2304, O_HS = O_HP + 2 * 32768, O_CFP = O_HS + (size_t)2 * NB * 32768,
                 O_CFS = O_CFP + 2 * 30 * 256, O_END = O_CFS + 2 * NB * 7680;
constexpr size_t al256(size_t x) { return (x + 255) & ~(size_t)255; }
constexpr size_t WS_CTL = 0, WS_ADA = 65536, WS_BIAS = WS_ADA + al256(2 * 33 * 3072 * 4), WS_PEB = WS_BIAS + al256(2 * NPD * 4), WS_WTIN = WS_PEB + 2048,
                 WS_WTOUT = WS_WTIN + (size_t)2 * NPD * 1024 * 2, WS_W1T = WS_WTOUT + (size_t)2 * 1024 * 1024 * 2, WS_A16 = WS_W1T + (size_t)4 * 128 * 2048 * 2,
                 WS_RSSP = WS_A16 + (size_t)SEQ * 1024 * 2, WS_X1 = WS_RSSP + (size_t)SEQ * 16 * 4, WS_PROJ = WS_X1 + (size_t)SEQ * 1024 * 4,
                 WS_Y16 = WS_PROJ + (size_t)15 * SEQ * 256 * 2, WS_ACT = WS_Y16 + (size_t)SEQ * 1024 * 2, WS_YD = WS_ACT + (size_t)SEQ * 768 * 2,
                 WS_CST = WS_YD + (size_t)SEQ * 256 * 4, WS_ACS = WS_CST + (size_t)128 * 32768 * 4, WS_CDEC = WS_ACS + (size_t)SEQ * 4 * 4, WS_Q16 = WS_CDEC + 2048,
                 WS_KS16 = WS_Q16 + (size_t)SEQ * 256 * 2, WS_VS16 = WS_KS16 + (size_t)SEQ * 64 * 2, WS_KW16 = WS_VS16 + (size_t)SEQ * 64 * 2,
                 WS_VW16 = WS_KW16 + (size_t)SEQ * 64 * 2, WS_GATES = WS_VW16 + (size_t)SEQ * 64 * 2, WS_KC = WS_GATES + (size_t)SEQ * 12 * 4,
                 WS_VC = WS_KC + 1024 * 64 * 4, WS_KCS = WS_VC + 1024 * 64 * 4, WS_VCS = WS_KCS + (size_t)2 * NB * 1024 * 64 * 4,
                 WS_PROJS = WS_VCS + (size_t)2 * NB * 1024 * 64 * 4, WS_YS = WS_PROJS + al256(NB * NPD * 4), WS_XS1 = WS_YS + NB * 1024 * 4, WS_GNX = WS_XS1 + NB * 1024 * 4, WS_NRG = WS_GNX + 4096, WS_VST16 = WS_NRG + 2 * NB * 1024, WS_VWT16 = WS_VST16 + (size_t)SEQ * 64 * 2, WS_KC16 = WS_VWT16 + (size_t)SEQ * 64 * 2,
                 WS_VCT16 = WS_KC16 + 1024 * 64 * 2, WS_HPV = WS_VCT16 + 1024 * 64 * 2, WS_W2T = WS_HPV + (size_t)128 * 32768 * 4, WS_PEBP = WS_W2T + 4 * 64 * 128 * 2, WS_HS16 = WS_PEBP + 4 * 8 * 128 * 4, WS_SELM = WS_HS16 + NB * 1024 * 2, WS_END = WS_SELM + 512 * 272 * 4;
constexpr int LDS_BYTES = 147456;
constexpr int MISC_OFF = 147200;

struct Args { const void* in[N_IN]; float* out; unsigned char* ws; int ph_lo, ph_hi; };

#define XB_TMO      128
#define XB_XCNT(j)  (256  + 64 * (j))
#define XB_XSUB(j)  (1280 + 64 * (j))
#define XB_XGEN(j)  (2304 + 64 * (j))
#define XB_TOP      3328
#define XB_TOPGEN   3392
#define XCD_BAR_WORDS 3456
#define XB_SPIN_CAP (1u << 18)
__device__ __forceinline__ unsigned xb_ld(unsigned* p)              { return __hip_atomic_load(p, __ATOMIC_RELAXED, __HIP_MEMORY_SCOPE_AGENT); }
__device__ __forceinline__ unsigned xb_add(unsigned* p, unsigned v) { return __hip_atomic_fetch_add(p, v, __ATOMIC_RELAXED, __HIP_MEMORY_SCOPE_AGENT); }
__device__ __forceinline__ unsigned xb_xcc_id() { return (unsigned)__builtin_amdgcn_s_getreg((3 << 11) | 20) & 0xFu; }
#define XB_SPIN(cond, bar) do { unsigned _sp = 0; while (cond) { __builtin_amdgcn_s_sleep(1); \
    if ((++_sp & 255u) == 0u) { if (xb_ld(&(bar)[XB_TMO])) break; if (_sp > XB_SPIN_CAP) { atomicAdd(&(bar)[XB_TMO], 1u); break; } } } } while (0)
struct XcdBarrier { unsigned* bar; unsigned x; volatile LAS unsigned* st; };
__device__ __forceinline__ XcdBarrier xcd_barrier_post(unsigned* bar, volatile LAS unsigned* st) {
    XcdBarrier b; b.bar = bar; b.x = xb_xcc_id(); b.st = st;
    if (threadIdx.x == 0) (void)xb_add(&bar[XB_XCNT(b.x)], 1u);
    return b;
}
__device__ __forceinline__ void xcd_barrier_complete(unsigned* bar, unsigned x, unsigned& nloc, unsigned& nx) {
    const unsigned G = gridDim.x * gridDim.y * gridDim.z;
    unsigned sum, cnt, mine, sp = 0u;
    for (;;) {
        sum = 0u; cnt = 0u; mine = 0u;
#pragma unroll
        for (unsigned j = 0; j < 16; ++j) { const unsigned c = xb_ld(&bar[XB_XCNT(j)]); sum += c; cnt += (c > 0u) ? 1u : 0u; mine = (j == x) ? c : mine; }
        if (sum == G) break;
        __builtin_amdgcn_s_sleep(1);
        if ((++sp & 255u) == 0u) { if (xb_ld(&bar[XB_TMO])) break; if (sp > XB_SPIN_CAP) { atomicAdd(&bar[XB_TMO], 1u); break; } }
    }
    nloc = mine > 0u ? mine : 1u; nx = cnt > 0u ? cnt : 1u;
}
__device__ __forceinline__ void xcd_barrier(const XcdBarrier& b) {
    asm volatile("s_waitcnt vmcnt(0)" ::: "memory");
    __syncthreads();
    if (threadIdx.x == 0) {
        unsigned* bar = b.bar;
        __builtin_amdgcn_s_waitcnt(0);
        unsigned nloc = b.st[0], nx = b.st[1];
        if (nloc == 0u) { xcd_barrier_complete(bar, b.x, nloc, nx); b.st[0] = nloc; b.st[1] = nx; }
        const unsigned old = xb_add(&bar[XB_XSUB(b.x)], 1u);
        const unsigned gen = old / nloc;
        if (old + 1u == (gen + 1u) * nloc) {
            __builtin_amdgcn_fence(__ATOMIC_RELEASE, "agent");
            asm volatile("s_waitcnt vmcnt(0)" ::: "memory");
            const unsigned og = xb_add(&bar[XB_TOP], 1u);
            const unsigned tg = og / nx;
            if (og + 1u == (tg + 1u) * nx) xb_add(&bar[XB_TOPGEN], 1u);
            else XB_SPIN(xb_ld(&bar[XB_TOPGEN]) == tg, bar);
            __builtin_amdgcn_fence(__ATOMIC_ACQUIRE, "agent");
            xb_add(&bar[XB_XGEN(b.x)], 1u);
            asm volatile("s_waitcnt vmcnt(0)" ::: "memory");
        } else {
            XB_SPIN(xb_ld(&bar[XB_XGEN(b.x)]) == gen, bar);
            __builtin_amdgcn_fence(__ATOMIC_ACQUIRE, "agent");
            asm volatile("s_waitcnt vmcnt(0)" ::: "memory");
        }
    }
    __syncthreads();
}

DI void lds_barrier() { asm volatile("s_waitcnt lgkmcnt(0)\n\ts_barrier" ::: "memory"); }
DI int ltid() { int t = threadIdx.x; asm volatile("" : "+v"(t)); return t; }
template <int CTRL> DI float dppf(float x) { return __builtin_bit_cast(float, __builtin_amdgcn_update_dpp(0, __builtin_bit_cast(int, x), CTRL, 0xF, 0xF, true)); }
template <int CTRL> DI int dppi(int x) { return __builtin_amdgcn_update_dpp(0, x, CTRL, 0xF, 0xF, true); }
constexpr int DPP_X1 = 0xB1, DPP_X2 = 0x4E, DPP_HM = 0x141, DPP_R8 = 0x128;
DI float sum16(float v) { v += dppf<DPP_X1>(v); v += dppf<DPP_X2>(v); v += dppf<DPP_HM>(v); v += dppf<DPP_R8>(v); return v; }
DI float max16(float v) { v = fmaxf(v, dppf<DPP_X1>(v)); v = fmaxf(v, dppf<DPP_X2>(v)); v = fmaxf(v, dppf<DPP_HM>(v)); v = fmaxf(v, dppf<DPP_R8>(v)); return v; }
DI float wsum(float v) { v = sum16(v); v += __shfl_xor(v, 16); v += __shfl_xor(v, 32); return v; }
DI float wmaxf(float v) { v = max16(v); v = fmaxf(v, __shfl_xor(v, 16)); v = fmaxf(v, __shfl_xor(v, 32)); return v; }
DI float sigmoidf_(float x) { return 1.f / (1.f + __expf(-x)); }
DI float siluf_(float x) { return x / (1.f + __expf(-x)); }
DI float softplusf_(float x) { return fmaxf(x, 0.f) + log1pf(__expf(-fabsf(x))); }
DI f16x8 ld_h8(const f16* p) { return *(const f16x8*)p; }
DI f16x8 cvt_h8(const float* p) { const f32x4 a = *(const f32x4*)p, b = *(const f32x4*)(p + 4); f16x8 r; r[0] = (f16)a[0]; r[1] = (f16)a[1]; r[2] = (f16)a[2]; r[3] = (f16)a[3]; r[4] = (f16)b[0]; r[5] = (f16)b[1]; r[6] = (f16)b[2]; r[7] = (f16)b[3]; return r; }
DI int vt_key(int pos) { const int p = pos & 31, qq = p >> 3, j = p & 7; return (pos & ~31) + (j < 4 ? 4 * qq + j : 12 + 4 * qq + j); }
DI int vt_pos(int key) { const int k = key & 31; return (key & ~31) + (k < 16 ? 8 * (k >> 2) + (k & 3) : 8 * ((k - 16) >> 2) + 4 + (k & 3)); }
DI int src_col(int n) { return n < 2048 ? n : (n < 3456 ? n + 4 : (n < 3460 ? n - 1408 : (n < 3472 ? n + 256 : (n < 3584 ? -1 : n - 124)))); }
DI int dst_col(int s) { return s < 2048 ? s : (s < 2052 ? s + 1408 : (s < 3460 ? s - 4 : (s < 3716 ? s + 124 : s - 256))); }

DI void edge_publish(unsigned* ctr) {
    asm volatile("s_waitcnt vmcnt(0)" ::: "memory"); __syncthreads();
    if (threadIdx.x == 0) { __builtin_amdgcn_fence(__ATOMIC_RELEASE, "agent"); asm volatile("s_waitcnt vmcnt(0)" ::: "memory"); __hip_atomic_fetch_add(ctr, 1u, __ATOMIC_RELAXED, __HIP_MEMORY_SCOPE_AGENT); }
}
DI void edge_wait(unsigned* ctr, unsigned need) {
    if (threadIdx.x == 0) { unsigned sp = 0;
        while (__hip_atomic_load(ctr, __ATOMIC_RELAXED, __HIP_MEMORY_SCOPE_AGENT) < need) { __builtin_amdgcn_s_sleep(8); if (++sp > (1u << 22)) break; }
        __builtin_amdgcn_fence(__ATOMIC_ACQUIRE, "agent"); asm volatile("s_waitcnt vmcnt(0)" ::: "memory"); }
    __syncthreads();
}
namespace pg8 {
constexpr int BM = 256, BK = 64, HALF = 128, HTB = HALF * BK * 2, STAGE_BYTES = 8 * HTB, NXCD = 8, WGM = 8;
DI int lds_byte(int r, int c) { const int st = (r >> 4) * 2 + (c >> 5), rr = r & 15, cc = c & 31, ob = rr * 64 + cc * 2; return st * 1024 + (ob ^ (((ob >> 9) & 1) << 5)); }
DI void stage_rc(int b, int& R, int& C) { const int st = b / 1024, sb = b % 1024, swz = sb ^ (((sb >> 9) & 1) << 5); R = (st >> 1) * 16 + swz / 64; C = (st & 1) * 32 + (swz % 64) / 2; }
DI int perm32(int rho) { const int n = rho >> 4, i = rho & 15; return 8 * (i >> 2) + 4 * n + (i & 3); }
struct Unit { int pm, pn; };
struct Gemm { const f16* A; const f16* Bt; int M, N, K; };
struct StaticOrder {
    int nM, nN, nwg, G, c;
    DI void init(int M, int N, int G_, int c_) { nM = M / BM; nN = N / BM; nwg = nM * nN; G = G_; c = c_; }
    DI bool next(int i, Unit& u) const {
        const long L = (long)i * G + c; if (L >= nwg) return false;
        int wgid = (int)L; { const int q = nwg / NXCD, r = nwg % NXCD, xcd = wgid % NXCD, off = wgid / NXCD; wgid = (xcd < r ? xcd * (q + 1) : r * (q + 1) + (xcd - r) * q) + off; }
        const int nig = WGM * nN, gid = wgid / nig, fm = gid * WGM, gsz = (nM - fm) < WGM ? (nM - fm) : WGM;
        u.pm = fm + ((wgid % nig) % gsz); u.pn = (wgid % nig) / gsz; return true;
    }
    DI void a_ready(const Unit&) const {}
    DI void done(const Unit&) const {}
};
template <class Epi, class Sched>
DI void gemm_phase(LAS unsigned char* lds, const Gemm g, const Sched& S, const Epi& E) {
    const int tid = ltid(), wid = __builtin_amdgcn_readfirstlane(tid >> 6), lane = tid & 63, wr = wid >> 2, wc = wid & 3, fr = lane & 15, fq = lane >> 4;
    const int K = g.K, nt = K / BK;
    unsigned voffA[2], voffB[2];
#pragma unroll
    for (int i = 0; i < 2; ++i) { int R, C; stage_rc(tid * 16 + i * 8192, R, C); const int Rb = Epi::PERM ? ((R & ~31) + perm32(R & 31)) : R;
        voffA[i] = (unsigned)(R * K + C) * 2u; voffB[i] = (unsigned)(Rb * K + C) * 2u; }
    const size_t kstep = (size_t)(BK * 2);
    const size_t hstep = (size_t)HALF * K * 2;
    const size_t tstep = 2 * hstep;
    const unsigned ldsw = (unsigned)wid * 1024u;
    const int aoff = lds_byte(wr * 64 + fr, fq * 8), boff = lds_byte(wc * 32 + fr, fq * 8);
#define PG8_SA(b, h) (((b) * 2 + (h)) * HTB)
#define PG8_SB(b, h) ((4 + (b) * 2 + (h)) * HTB)
#define PG8_STAGE(bufoff, gbase, voff) do { _Pragma("unroll") for (int _i = 0; _i < 2; ++_i) \
        __builtin_amdgcn_global_load_lds((const unsigned*)((const char*)(gbase) + (voff)[_i]), (LAS unsigned*)(lds + (bufoff) + ldsw + _i * 8192), 16, 0, 0); } while (0)
#define PG8_LDA(dst, b, h) do { _Pragma("unroll") for (int m = 0; m < 4; ++m) _Pragma("unroll") for (int k = 0; k < 2; ++k) dst[m][k] = *(const LAS f16x8*)(lds + PG8_SA(b, h) + aoff + m * 2048 + k * 1024); } while (0)
#define PG8_LDB(dst, b, h) do { _Pragma("unroll") for (int n = 0; n < 2; ++n) _Pragma("unroll") for (int k = 0; k < 2; ++k) dst[n][k] = *(const LAS f16x8*)(lds + PG8_SB(b, h) + boff + n * 2048 + k * 1024); } while (0)
#define PG8_MMA(ai, bj, At, Bt) do { __builtin_amdgcn_s_setprio(1); _Pragma("unroll") for (int m = 0; m < 4; ++m) _Pragma("unroll") for (int n = 0; n < 2; ++n) _Pragma("unroll") for (int k = 0; k < 2; ++k) \
        acc[ai][bj][m][n] = __builtin_amdgcn_mfma_f32_16x16x32_f16(Bt[n][k], At[m][k], acc[ai][bj][m][n], 0, 0, 0); __builtin_amdgcn_s_setprio(0); } while (0)
#define PG8_WAIT_V(n) asm volatile("s_waitcnt vmcnt(" #n ")" ::: "memory")
#define PG8_WAIT_L(n) asm volatile("s_waitcnt lgkmcnt(" #n ")" ::: "memory")
#define PG8_BAR __builtin_amdgcn_s_barrier()
#define PG8_SCHED __builtin_amdgcn_sched_barrier(0)
    Unit cur, nxt; int ui = 0;
    if (!S.next(0, cur)) return;
    f32x4 acc[2][2][4][2];
#pragma unroll
    for (int a = 0; a < 2; ++a)
#pragma unroll
        for (int b = 0; b < 2; ++b)
#pragma unroll
            for (int m = 0; m < 4; ++m)
#pragma unroll
                for (int n = 0; n < 2; ++n) acc[a][b][m][n] = (f32x4){0.f, 0.f, 0.f, 0.f};
    f16x8 At[4][2], B0[2][2], B1[2][2];
    const char* cA = (const char*)g.A + (size_t)cur.pm * tstep; const char* cB = (const char*)g.Bt + (size_t)cur.pn * tstep;
    S.a_ready(cur);
    PG8_STAGE(PG8_SB(0, 0), cB, voffB); PG8_STAGE(PG8_SA(0, 0), cA, voffA); PG8_STAGE(PG8_SB(0, 1), cB + hstep, voffB); PG8_STAGE(PG8_SA(0, 1), cA + hstep, voffA);
    if (wr == 1) PG8_BAR;
    PG8_WAIT_V(4); PG8_BAR;
    PG8_STAGE(PG8_SB(1, 0), cB + kstep, voffB); PG8_STAGE(PG8_SA(1, 0), cA + kstep, voffA); PG8_STAGE(PG8_SB(1, 1), cB + hstep + kstep, voffB);
    PG8_WAIT_V(6); PG8_BAR;
    for (;;) {
        const bool has_next = S.next(ui + 1, nxt);
        const char* nA = has_next ? (const char*)g.A + (size_t)nxt.pm * tstep : cA; const char* nB = has_next ? (const char*)g.Bt + (size_t)nxt.pn * tstep : cB;
        for (int t = 0; t < nt; t += 2) {
            const bool last = (t == nt - 2);
            const char* a1 = cA + (size_t)(t + 1) * kstep;
            const char* a2 = last ? nA : cA + (size_t)(t + 2) * kstep; const char* b2 = last ? nB : cB + (size_t)(t + 2) * kstep;
            const char* a3 = a2 + kstep; const char* b3 = b2 + kstep;
            if (last && has_next) S.a_ready(nxt);
            PG8_LDB(B0, 0, 0); PG8_SCHED; PG8_LDA(At, 0, 0); PG8_STAGE(PG8_SA(1, 1), a1 + hstep, voffA);
            PG8_WAIT_L(8); PG8_BAR; PG8_WAIT_L(0); PG8_MMA(0, 0, At, B0); PG8_BAR; PG8_SCHED;
            PG8_LDB(B1, 0, 1); PG8_STAGE(PG8_SB(0, 0), b2, voffB);
            PG8_BAR; PG8_WAIT_L(0); PG8_MMA(0, 1, At, B1); PG8_BAR;
            PG8_LDA(At, 0, 1); PG8_STAGE(PG8_SA(0, 0), a2, voffA);
            PG8_BAR; PG8_WAIT_L(0); PG8_MMA(1, 0, At, B0); PG8_BAR; PG8_SCHED;
            PG8_STAGE(PG8_SB(0, 1), b2 + hstep, voffB);
            PG8_WAIT_V(6); PG8_BAR; PG8_MMA(1, 1, At, B1); PG8_BAR;
            PG8_LDB(B0, 1, 0); PG8_SCHED; PG8_LDA(At, 1, 0); PG8_STAGE(PG8_SA(0, 1), a2 + hstep, voffA);
            PG8_WAIT_L(8); PG8_BAR; PG8_WAIT_L(0); PG8_MMA(0, 0, At, B0); PG8_BAR; PG8_SCHED;
            PG8_LDB(B1, 1, 1); PG8_STAGE(PG8_SB(1, 0), b3, voffB);
            PG8_BAR; PG8_WAIT_L(0); PG8_MMA(0, 1, At, B1); PG8_BAR;
            PG8_LDA(At, 1, 1); PG8_STAGE(PG8_SA(1, 0), a3, voffA);
            PG8_BAR; PG8_WAIT_L(0); PG8_MMA(1, 0, At, B0); PG8_BAR; PG8_SCHED;
            PG8_STAGE(PG8_SB(1, 1), b3 + hstep, voffB);
            PG8_WAIT_V(6); PG8_BAR; PG8_MMA(1, 1, At, B1); PG8_BAR;
        }
        E(acc, cur, wr, wc, fr, fq);
        if (!has_next) break;
#pragma unroll
        for (int a = 0; a < 2; ++a)
#pragma unroll
            for (int b = 0; b < 2; ++b)
#pragma unroll
                for (int m = 0; m < 4; ++m)
#pragma unroll
                    for (int n = 0; n < 2; ++n) acc[a][b][m][n] = (f32x4){0.f, 0.f, 0.f, 0.f};
        cur = nxt; cA = nA; cB = nB; ++ui;
    }
    PG8_WAIT_V(0);
    if (wr == 0) PG8_BAR;
    PG8_BAR;
#undef PG8_SA
#undef PG8_SB
#undef PG8_STAGE
#undef PG8_LDA
#undef PG8_LDB
#undef PG8_MMA
#undef PG8_WAIT_V
#undef PG8_WAIT_L
#undef PG8_BAR
#undef PG8_SCHED
}
}

struct EpiIn {
    static constexpr bool PERM = true;
    f16* proj; const float* rssp; const float* bias; float* kvout;
    DI void operator()(const f32x4 (&acc)[2][2][4][2], const pg8::Unit& u, int wr, int wc, int fr, int fq) const {
        const int row0 = u.pm * 256 + wr * 64 + fr, colt = wc * 32 + 8 * fq;
        f32x4 bv[2][2];
#pragma unroll
        for (int bj = 0; bj < 2; ++bj)
#pragma unroll
            for (int n = 0; n < 2; ++n) bv[bj][n] = *(const f32x4*)(bias + u.pn * 256 + colt + bj * 128 + 4 * n);
        f16* pt = proj + (size_t)u.pn * SEQ * 256;
        float r8[2][4];
        {   f32x4 part[2][4];
#pragma unroll
            for (int ai = 0; ai < 2; ++ai)
#pragma unroll
                for (int m = 0; m < 4; ++m) part[ai][m] = *((const f32x4*)(rssp + (size_t)(row0 + ai * 128 + m * 16) * 16) + fq);
#pragma unroll
            for (int ai = 0; ai < 2; ++ai)
#pragma unroll
                for (int m = 0; m < 4; ++m) { const f32x4 p = part[ai][m]; float v = (p[0] + p[1]) + (p[2] + p[3]); v += __shfl_xor(v, 16); v += __shfl_xor(v, 32); r8[ai][m] = rsqrtf(v * (1.f / 1024.f) + EPS); } }
#pragma unroll
        for (int ai = 0; ai < 2; ++ai)
#pragma unroll
            for (int m = 0; m < 4; ++m) {
                const int row = row0 + ai * 128 + m * 16;
                const float r = r8[ai][m];
#pragma unroll
                for (int bj = 0; bj < 2; ++bj) {
                    const f32x4 v0 = acc[ai][bj][m][0] * r + bv[bj][0], v1 = acc[ai][bj][m][1] * r + bv[bj][1];
                    f16x8 h; h[0] = (f16)v0[0]; h[1] = (f16)v0[1]; h[2] = (f16)v0[2]; h[3] = (f16)v0[3]; h[4] = (f16)v1[0]; h[5] = (f16)v1[1]; h[6] = (f16)v1[2]; h[7] = (f16)v1[3];
                    *(f16x8*)(pt + (size_t)row * 256 + colt + bj * 128) = h;
                    if (u.pn == 12) { float* kp = kvout + (size_t)row * 256 + colt + bj * 128; *(f32x4*)kp = v0; *(f32x4*)(kp + 4) = v1; }
                }
            }
    }
};
struct EpiOut {
    static constexpr bool PERM = false;
    const float* xin; float* xout; const float* gate; f16* a16; const float* gnext; float* rssp;
    DI void operator()(const f32x4 (&acc)[2][2][4][2], const pg8::Unit& u, int wr, int wc, int fr, int fq) const {
        const int row0 = u.pm * 256 + wr * 64 + fr, col0 = u.pn * 256 + wc * 32 + 4 * fq;
        float ss[2][4];
#pragma unroll
        for (int ai = 0; ai < 2; ++ai)
#pragma unroll
            for (int m = 0; m < 4; ++m) ss[ai][m] = 0.f;
#pragma unroll
        for (int bj = 0; bj < 2; ++bj)
#pragma unroll
            for (int ai = 0; ai < 2; ++ai) {
                f32x4 gv[2], xv[4][2];
#pragma unroll
                for (int n = 0; n < 2; ++n) gv[n] = *(const f32x4*)(gate + col0 + bj * 128 + n * 16);
#pragma unroll
                for (int m = 0; m < 4; ++m)
#pragma unroll
                    for (int n = 0; n < 2; ++n) xv[m][n] = *(const f32x4*)(xin + (size_t)(row0 + ai * 128 + m * 16) * 1024 + col0 + bj * 128 + n * 16);
#pragma unroll
                for (int m = 0; m < 4; ++m)
#pragma unroll
                    for (int n = 0; n < 2; ++n) {
                        const int row = row0 + ai * 128 + m * 16, col = col0 + bj * 128 + n * 16;
                        const f32x4 o = xv[m][n] + gv[n] * acc[ai][bj][m][n]; xv[m][n] = o;
                        *(f32x4*)(xout + (size_t)row * 1024 + col) = o;
                        ss[ai][m] += (o[0] * o[0] + o[1] * o[1]) + (o[2] * o[2] + o[3] * o[3]); }
                if (a16) {
#pragma unroll
                    for (int n = 0; n < 2; ++n) { const int col = col0 + bj * 128 + n * 16; const f32x4 gn = *(const f32x4*)(gnext + col);
#pragma unroll
                        for (int m = 0; m < 4; ++m) { const f32x4 o = xv[m][n]; f16x4 h; h[0] = (f16)(o[0] * gn[0]); h[1] = (f16)(o[1] * gn[1]); h[2] = (f16)(o[2] * gn[2]); h[3] = (f16)(o[3] * gn[3]);
                            *(f16x4*)(a16 + (size_t)(row0 + ai * 128 + m * 16) * 1024 + col) = h; } } }
                asm volatile("" ::: "memory");
            }
        if (a16) {
#pragma unroll
            for (int ai = 0; ai < 2; ++ai)
#pragma unroll
                for (int m = 0; m < 4; ++m) { float v = ss[ai][m]; v += __shfl_xor(v, 16); v += __shfl_xor(v, 32);
                    if (fq == 0) rssp[(size_t)(row0 + ai * 128 + m * 16) * 16 + u.pn * 4 + wc] = v; }
        }
    }
};

template <int MP  , class AFn, class OFn>
DI void skinny_item(LAS unsigned char* lds, const float* W, int ldw, int n0, int ncols, int M, AFn afn, OFn ofn) {
    const int tid = ltid(), wave = tid >> 6, lane = tid & 63;
    LAS float* As = (LAS float*)lds;
    float acc[MP];
#pragma unroll
    for (int m = 0; m < MP; ++m) acc[m] = 0.f;
    for (int kc = 0; kc < 1024; kc += 512) {
        const int kb = wave * 64;
        float wv[64];
#pragma unroll
        for (int kk = 0; kk < 64; ++kk) wv[kk] = (lane < ncols) ? W[(size_t)(kc + kb + kk) * ldw + n0 + lane] : 0.f;
        __syncthreads();
#pragma unroll
        for (int m = 0; m < MP; ++m) As[tid * 36 + m] = (m < M) ? afn(m, kc + tid) : 0.f;
        __syncthreads();
#pragma unroll
        for (int kk = 0; kk < 64; ++kk) {
            const float av = As[(kb + kk) * 36 + lane];
#pragma unroll
            for (int m = 0; m < MP; ++m) acc[m] += __builtin_bit_cast(float, __builtin_amdgcn_readlane(__builtin_bit_cast(int, av), m)) * wv[kk];
        }
    }
    __syncthreads();
    LAS float* R = (LAS float*)lds;
#pragma unroll
    for (int m = 0; m < MP; ++m) R[(wave * 36 + m) * 64 + lane] = acc[m];
    __syncthreads();
    for (int idx = tid; idx < M * 64; idx += 512) { const int m = idx >> 6, c = idx & 63; float s = 0.f;
#pragma unroll
        for (int w = 0; w < 8; ++w) s += R[(w * 36 + m) * 64 + c];
        if (c < ncols) ofn(m, n0 + c, s); }
    __syncthreads();
}

template <bool F32> struct Raw16 { f32x4 f[4]; f16x8 hv[2];
    DI void ld(const void* p) { if (F32) {
#pragma unroll
            for (int i = 0; i < 4; ++i) f[i] = *(const f32x4*)((const float*)p + 4 * i); } else { hv[0] = *(const f16x8*)p; hv[1] = *(const f16x8*)((const f16*)p + 8); } }
    DI f16x8 get(int i) const { if (F32) { const f32x4 a = f[2 * i], b = f[2 * i + 1]; f16x8 r; r[0] = (f16)a[0]; r[1] = (f16)a[1]; r[2] = (f16)a[2]; r[3] = (f16)a[3]; r[4] = (f16)b[0]; r[5] = (f16)b[1]; r[6] = (f16)b[2]; r[7] = (f16)b[3]; return r; } return hv[i]; } };
template <bool SRC_F32, class ChunkFn>
DI void compress_item(LAS unsigned char* lds, ChunkFn chunkp  , int c0, const f16* w1t, const float* peb, const f16* w2t  , const float* b2, const float* kg, float* out, f16* out16, f16* outT16) {
    typedef typename std::conditional<SRC_F32, float, f16>::type T;
    const int tid = ltid(), wave = tid >> 6, lane = tid & 63, wm = wave >> 2, wq = wave & 3, r = lane & 31, h = lane >> 5;
    LAS f16* As = (LAS f16*)lds;
    LAS f16* Bs = (LAS f16*)(lds + 2 * 18432);
    f32x16 acc[2][2];
#pragma unroll
    for (int a = 0; a < 2; ++a)
#pragma unroll
        for (int b = 0; b < 2; ++b)
#pragma unroll
            for (int i = 0; i < 16; ++i) acc[a][b][i] = 0.f;
    constexpr int NA = SRC_F32 ? 4 : 2, AE = SRC_F32 ? 4 : 8;
    const int arow = SRC_F32 ? tid >> 4 : tid >> 3, aseg = SRC_F32 ? tid & 15 : tid & 7, brow = tid >> 3, bsg = tid & 7;
    const T* ap[NA];
#pragma unroll
    for (int i = 0; i < NA; ++i) { int ch = c0 + arow + (128 / NA) * i; ch = ch < 1023 ? ch : 1023; ap[i] = (const T*)chunkp(ch) + aseg * AE; }
    const f16* bsrc = w1t + (size_t)brow * 2048 + bsg * 8;
    Raw16<SRC_F32> ra[3]; f16x8 rb[3][4];
    auto ldab = [&](int sl, int kb) {
#pragma unroll
        for (int i = 0; i < NA; ++i) { if (SRC_F32) ra[sl].f[i] = *(const f32x4*)((const float*)ap[i] + kb * 256); else ra[sl].hv[i] = *(const f16x8*)((const f16*)ap[i] + kb * 256); }
#pragma unroll
        for (int i = 0; i < 4; ++i) rb[sl][i] = ld_h8(bsrc + (size_t)(i & 1) * 64 * 2048 + (i >> 1) * 1024 + kb * 64 + 0); };
    auto stab = [&](int sl, int nx) {
#pragma unroll
        for (int i = 0; i < NA; ++i) {
            if (SRC_F32) { const f32x4 v = ra[sl].f[i]; f16x4 hq; hq[0] = (f16)v[0]; hq[1] = (f16)v[1]; hq[2] = (f16)v[2]; hq[3] = (f16)v[3]; *(LAS f16x4*)(As + nx * 9216 + (arow + 32 * i) * 72 + 4 * aseg) = hq; }
            else *(LAS f16x8*)(As + nx * 9216 + (arow + 64 * i) * 72 + 8 * aseg) = ra[sl].hv[i]; }
#pragma unroll
        for (int i = 0; i < 4; ++i) *(LAS f16x8*)(Bs + nx * 18432 + (brow + 64 * i) * 72 + 8 * bsg) = rb[sl][i]; };
#pragma unroll
    for (int i = 0; i < 3; ++i) ldab(i, i);
    __syncthreads();
    stab(0, 0);
    ldab(0, 3);
    lds_barrier();
#pragma unroll
    for (int kb = 0; kb < 16; ++kb) {
        const int cur = kb & 1;
        const LAS f16* Ac = As + cur * 9216 + (64 * wm + r) * 72 + 8 * h; const LAS f16* Bc = Bs + cur * 18432 + (64 * wq + r) * 72 + 8 * h;
#pragma unroll
        for (int ks = 0; ks < 4; ++ks) {
            const f16x8 a0 = *(const LAS f16x8*)(Ac + 16 * ks), a1 = *(const LAS f16x8*)(Ac + 32 * 72 + 16 * ks), b0 = *(const LAS f16x8*)(Bc + 16 * ks), b1 = *(const LAS f16x8*)(Bc + 32 * 72 + 16 * ks);
            acc[0][0] = __builtin_amdgcn_mfma_f32_32x32x16_f16(a0, b0, acc[0][0], 0, 0, 0); acc[0][1] = __builtin_amdgcn_mfma_f32_32x32x16_f16(a0, b1, acc[0][1], 0, 0, 0);
            acc[1][0] = __builtin_amdgcn_mfma_f32_32x32x16_f16(a1, b0, acc[1][0], 0, 0, 0); acc[1][1] = __builtin_amdgcn_mfma_f32_32x32x16_f16(a1, b1, acc[1][1], 0, 0, 0);
        }
        if (kb + 1 < 16) { const int nx = cur ^ 1, sl = (kb + 1) % 3;
            stab(sl, nx);
            if (kb + 4 < 16) ldab(sl, kb + 4); }
        lds_barrier();
    }
    LAS float* SL = (LAS float*)lds;
    LAS f16* HS = (LAS f16*)(lds + 65536);
    if (wq >= 2) {
#pragma unroll
        for (int a = 0; a < 2; ++a)
#pragma unroll
            for (int b = 0; b < 2; ++b)
#pragma unroll
                for (int i = 0; i < 16; ++i) SL[(64 * wm + 32 * a + (i & 3) + 8 * (i >> 2) + 4 * h) * 128 + 64 * (wq - 2) + 32 * b + r] = acc[a][b][i];
    }
    __syncthreads();
    if (wq < 2) {
#pragma unroll
        for (int a = 0; a < 2; ++a)
#pragma unroll
            for (int b = 0; b < 2; ++b) { const int f = 64 * wq + 32 * b + r; float pb = 0.f;
#pragma unroll
                for (int p8 = 0; p8 < 8; ++p8) pb += peb[p8 * 128 + f];
#pragma unroll
                for (int i = 0; i < 16; ++i) { const int m = 64 * wm + 32 * a + (i & 3) + 8 * (i >> 2) + 4 * h; const float sv = m < 127 ? SL[(m + 1) * 128 + f] : 0.f;
                    HS[m * 136 + f] = (f16)siluf_(acc[a][b][i] + sv + pb); } }
    }
    __syncthreads();
    {
        const int fr = lane & 15, q = lane >> 4;
        f32x4 o[4];
#pragma unroll
        for (int et = 0; et < 4; ++et) o[et] = (f32x4){0.f, 0.f, 0.f, 0.f};
#pragma unroll
        for (int ks = 0; ks < 4; ++ks) { const f16x8 av = *(const LAS f16x8*)(HS + (16 * wave + fr) * 136 + 32 * ks + 8 * q);
#pragma unroll
            for (int et = 0; et < 4; ++et) o[et] = __builtin_amdgcn_mfma_f32_16x16x32_f16(av, ld_h8(w2t + (size_t)(16 * et + fr) * 128 + 32 * ks + 8 * q), o[et], 0, 0, 0); }
        float bb[4], gg[4];
#pragma unroll
        for (int et = 0; et < 4; ++et) { bb[et] = b2[16 * et + fr]; gg[et] = kg ? kg[16 * et + fr] : 1.f; }
#pragma unroll
        for (int j = 0; j < 4; ++j) {
            const int row = 16 * wave + 4 * q + j, blk = c0 + row; float v[4], ss = 0.f;
#pragma unroll
            for (int et = 0; et < 4; ++et) { v[et] = o[et][j] + bb[et]; ss += v[et] * v[et]; }
            if (kg) { ss += __shfl_xor(ss, 1); ss += __shfl_xor(ss, 2); ss += __shfl_xor(ss, 4); ss += __shfl_xor(ss, 8); const float rn = rsqrtf(ss * (1.f / 64.f) + EPS);
#pragma unroll
                for (int et = 0; et < 4; ++et) v[et] = v[et] * rn * gg[et]; }
            const bool okrow = row < 127 && blk < 1023, wr16 = row < 127 && blk < 1024;
#pragma unroll
            for (int et = 0; et < 4; ++et) { const float x = okrow ? v[et] : 0.f; const int e = 16 * et + fr;
                if (out && okrow) out[(size_t)blk * 64 + e] = x;
                if (out16 && wr16) out16[(size_t)blk * 64 + e] = (f16)x;
                if (outT16 && wr16) outT16[(size_t)e * 1024 + vt_pos(blk)] = (f16)x; }
        }
    }
    __syncthreads();
}

struct PromptKV {
    const f16 *ks, *vs, *kw, *vw;
    DI void krow_sel(int pos, float (&k)[64]) const { const f16* p = ks + (size_t)pos * 64;
#pragma unroll
        for (int i = 0; i < 8; ++i) { const f16x8 v = ld_h8(p + i * 8);
#pragma unroll
            for (int j = 0; j < 8; ++j) k[i * 8 + j] = (float)v[j]; } }
    DI float v_sel(int pos, int d) const { return (float)vs[(size_t)pos * 64 + d]; }
    DI void krow_win(int pos, float (&k)[64]) const { const f16* p = kw + (size_t)pos * 64;
#pragma unroll
        for (int i = 0; i < 8; ++i) { const f16x8 v = ld_h8(p + i * 8);
#pragma unroll
            for (int j = 0; j < 8; ++j) k[i * 8 + j] = (float)v[j]; } }
    DI float v_win(int pos, int d) const { return (float)vw[(size_t)pos * 64 + d]; }
};
struct SampleKV {
    const float* ckv; const int* pt; const float* cwin; const float* nks; const float* nvs; const float* nkw; const float* nvw;
    DI const float* prow(int pos, int slot) const { return ckv + ((size_t)pt[pos >> 7] * 128 + (pos & 127)) * 256 + slot * 64; }
    DI void ld64(const float* p, float (&k)[64]) const {
#pragma unroll
        for (int i = 0; i < 16; ++i) { const f32x4 v = *(const f32x4*)(p + i * 4); k[i * 4] = v[0]; k[i * 4 + 1] = v[1]; k[i * 4 + 2] = v[2]; k[i * 4 + 3] = v[3]; } }
    DI void krow_sel(int pos, float (&k)[64]) const { ld64(pos < PAST ? prow(pos, 2) : nks, k); }
    DI float v_sel(int pos, int d) const { return pos < PAST ? prow(pos, 3)[d] : nvs[d]; }
    DI void krow_win(int pos, float (&k)[64]) const { ld64(pos < PAST ? cwin + (size_t)(pos - (PAST - 512)) * 128 : nkw, k); }
    DI float v_win(int pos, int d) const { return pos < PAST ? cwin[(size_t)(pos - (PAST - 512)) * 128 + 64 + d] : nvw[d]; }
};
template <class KV>
DI void nsa_token(LAS float* wl, int qpos, const float* KC, const float* VC, const KV& kv, const float* gates  , float (&o)[4]) {
    const int lane = ltid() & 63;
    LAS float* sc = wl; LAS float* qs = wl + 4096; LAS int* sel = (LAS int*)(wl + 4096 + 256);
    const int cur = qpos >> 6;
    const int ncv = qpos >= 31 ? ((qpos - 31) >> 4) + 1 : 0;
    float oc[4] = {0.f, 0.f, 0.f, 0.f}, os[4] = {0.f, 0.f, 0.f, 0.f}, ow[4] = {0.f, 0.f, 0.f, 0.f};
    {
        float mx[4] = {-3e38f, -3e38f, -3e38f, -3e38f};
        for (int c = lane; c < ncv; c += 64) {
            asm volatile("" ::: "memory");
            float s[4] = {0.f, 0.f, 0.f, 0.f}; const float* kp = KC + (size_t)c * 64;
#pragma unroll
            for (int d4 = 0; d4 < 16; ++d4) { const f32x4 kvv = *(const f32x4*)(kp + d4 * 4);
#pragma unroll
                for (int j = 0; j < 4; ++j) { const f32x4 q = *(const LAS f32x4*)(qs + (d4 * 4 + j) * 4); s[0] += q[0] * kvv[j]; s[1] += q[1] * kvv[j]; s[2] += q[2] * kvv[j]; s[3] += q[3] * kvv[j]; } }
#pragma unroll
            for (int hh = 0; hh < 4; ++hh) { s[hh] *= 0.125f; sc[hh * 1024 + c] = s[hh]; mx[hh] = fmaxf(mx[hh], s[hh]); }
        }
        float inv[4];
#pragma unroll
        for (int hh = 0; hh < 4; ++hh) { mx[hh] = wmaxf(mx[hh]); float sm = 0.f; for (int c = lane; c < ncv; c += 64) { const float e = __expf(sc[hh * 1024 + c] - mx[hh]); sc[hh * 1024 + c] = e; sm += e; } sm = wsum(sm); inv[hh] = ncv > 0 ? 1.f / sm : 0.f; }
        for (int c = lane; c < ncv; c += 64) {
#pragma unroll
            for (int hh = 0; hh < 4; ++hh) sc[hh * 1024 + c] *= inv[hh]; }
        __builtin_amdgcn_wave_barrier();
        for (int c = 0; c < ncv; ++c) { const float v = VC[(size_t)c * 64 + lane];
#pragma unroll
            for (int hh = 0; hh < 4; ++hh) oc[hh] += sc[hh * 1024 + c] * v; }
    }
    const int nsel = (cur + 1) < 16 ? (cur + 1) : 16;
    {
        float scv[5];
#pragma unroll
        for (int i = 0; i < 5; ++i) {
            const int j = lane + 64 * i; float v = -3e38f;
            if (j <= cur) {
                if (j == 0 || j == cur || j == cur - 1) v = 3e38f;
                else { float a = 0.f;
#pragma unroll
                    for (int o5 = -1; o5 < 4; ++o5) { const int c = 4 * j + o5; if (c >= 0 && c < ncv) { const float p = (sc[c] + sc[1024 + c]) + (sc[2048 + c] + sc[3072 + c]); a += (o5 == -1 || o5 == 3) ? 0.5f * p : p; } }
                    v = a; }
            }
            scv[i] = v;
        }
        for (int k = 0; k < nsel; ++k) {
            float bv = scv[0]; int bi = lane;
#pragma unroll
            for (int i = 1; i < 5; ++i) if (scv[i] > bv) { bv = scv[i]; bi = lane + 64 * i; }
#pragma unroll
            for (int off = 32; off > 0; off >>= 1) { const float ov = __shfl_xor(bv, off); const int oi = __shfl_xor(bi, off); if (ov > bv || (ov == bv && oi < bi)) { bv = ov; bi = oi; } }
            if (lane == 0) sel[k] = bi;
#pragma unroll
            for (int i = 0; i < 5; ++i) if (lane + 64 * i == bi) scv[i] = -3e38f;
        }
        __builtin_amdgcn_wave_barrier();
    }
    {
        float mx[4] = {-3e38f, -3e38f, -3e38f, -3e38f};
        for (int k = 0; k < nsel; ++k) {
            asm volatile("" ::: "memory");
            const int pos = sel[k] * 64 + lane; float s[4] = {-1e30f, -1e30f, -1e30f, -1e30f};
            if (pos <= qpos) { float kr[64]; kv.krow_sel(pos, kr); s[0] = s[1] = s[2] = s[3] = 0.f;
#pragma unroll
                for (int d = 0; d < 64; ++d) { const f32x4 q = *(const LAS f32x4*)(qs + d * 4); s[0] += q[0] * kr[d]; s[1] += q[1] * kr[d]; s[2] += q[2] * kr[d]; s[3] += q[3] * kr[d]; }
#pragma unroll
                for (int hh = 0; hh < 4; ++hh) s[hh] *= 0.125f; }
#pragma unroll
            for (int hh = 0; hh < 4; ++hh) { sc[hh * 1024 + k * 64 + lane] = s[hh]; mx[hh] = fmaxf(mx[hh], s[hh]); }
        }
        float inv[4];
#pragma unroll
        for (int hh = 0; hh < 4; ++hh) { mx[hh] = wmaxf(mx[hh]); float sm = 0.f; for (int k = 0; k < nsel; ++k) { const float sv = sc[hh * 1024 + k * 64 + lane]; const float e = sv > -1e29f ? __expf(sv - mx[hh]) : 0.f; sc[hh * 1024 + k * 64 + lane] = e; sm += e; } sm = wsum(sm); inv[hh] = 1.f / sm; }
        __builtin_amdgcn_wave_barrier();
        for (int k = 0; k < nsel; ++k) { const int p0 = sel[k] * 64; int nk = qpos - p0 + 1; nk = nk > 64 ? 64 : nk;
            for (int kk = 0; kk < nk; ++kk) { const float v = kv.v_sel(p0 + kk, lane);
#pragma unroll
                for (int hh = 0; hh < 4; ++hh) os[hh] += sc[hh * 1024 + k * 64 + kk] * v; } }
#pragma unroll
        for (int hh = 0; hh < 4; ++hh) os[hh] *= inv[hh];
        __builtin_amdgcn_wave_barrier();
    }
    {
        const int lo = qpos - 512 > 0 ? qpos - 512 : 0, nw = qpos - lo + 1;
        float mx[4] = {-3e38f, -3e38f, -3e38f, -3e38f};
        for (int i = lane; i < nw; i += 64) { asm volatile("" ::: "memory"); float kr[64]; kv.krow_win(lo + i, kr); float s[4] = {0.f, 0.f, 0.f, 0.f};
#pragma unroll
            for (int d = 0; d < 64; ++d) { const f32x4 q = *(const LAS f32x4*)(qs + d * 4); s[0] += q[0] * kr[d]; s[1] += q[1] * kr[d]; s[2] += q[2] * kr[d]; s[3] += q[3] * kr[d]; }
#pragma unroll
            for (int hh = 0; hh < 4; ++hh) { s[hh] *= 0.125f; sc[hh * 1024 + i] = s[hh]; mx[hh] = fmaxf(mx[hh], s[hh]); } }
        float inv[4];
#pragma unroll
        for (int hh = 0; hh < 4; ++hh) { mx[hh] = wmaxf(mx[hh]); float sm = 0.f; for (int i = lane; i < nw; i += 64) { const float e = __expf(sc[hh * 1024 + i] - mx[hh]); sc[hh * 1024 + i] = e; sm += e; } sm = wsum(sm); inv[hh] = 1.f / sm; }
        __builtin_amdgcn_wave_barrier();
        for (int i = 0; i < nw; ++i) { const float v = kv.v_win(lo + i, lane);
#pragma unroll
            for (int hh = 0; hh < 4; ++hh) ow[hh] += sc[hh * 1024 + i] * v; }
#pragma unroll
        for (int hh = 0; hh < 4; ++hh) ow[hh] *= inv[hh];
        __builtin_amdgcn_wave_barrier();
    }
#pragma unroll
    for (int hh = 0; hh < 4; ++hh) o[hh] = gates[hh * 3] * oc[hh] + gates[hh * 3 + 1] * os[hh] + gates[hh * 3 + 2] * ow[hh];
}

template <int KT = 1, class LF, class SF>
DI void tr64(LAS unsigned char* lds, LF lf, SF sf) {
    LAS float* T = (LAS float*)lds;
    const int tid = ltid();
    __syncthreads();
#pragma unroll
    for (int e8 = 0; e8 < 8 * KT; ++e8) { const int e = tid + 512 * e8, kk = e >> 6, nn = e & 63; T[kk * 65 + nn] = lf(kk, nn); }
    __syncthreads();
#pragma unroll
    for (int e8 = 0; e8 < 8 * KT; ++e8) { const int e = tid + 512 * e8, nn = e / (64 * KT), kk = e % (64 * KT); sf(nn, kk, (f16)T[kk * 65 + nn]); }
}

typedef const Args __attribute__((address_space(4)))* ArgP;
struct Ctx { ArgP ap; LAS unsigned char* lds; unsigned char* ws; float* out; int tid, lane, wave, bid, G; };
DI Ctx mkctx(LAS unsigned char* lds) {
    Ctx c; const char __attribute__((address_space(4)))* kp = (const char __attribute__((address_space(4)))*)__builtin_amdgcn_kernarg_segment_ptr();
    asm volatile("" : "+s"(kp));
    c.ap = (ArgP)kp; c.lds = lds; c.ws = c.ap->ws; c.out = c.ap->out;
    int tid = threadIdx.x; asm volatile("" : "+v"(tid));
    c.tid = tid; c.lane = tid & 63; c.wave = __builtin_amdgcn_readfirstlane(tid >> 6); c.bid = blockIdx.x; c.G = gridDim.x;
    return c;
}
#define INP(i) ((const float*)c.ap->in[i])
#define WSF(off) ((float*)(c.ws + (off)))
#define WSH(off) ((f16*)(c.ws + (off)))

DI void ph_prologue(LAS unsigned char* lds_) {
    const Ctx c = mkctx(lds_); LAS unsigned char* lds = c.lds; const int tid = c.tid, bid = c.bid, G = c.G;
    const float* c_p = INP(I_CP); const float* c_s = INP(I_CS); const float* w_ada = INP(I_WADA); const float* b_ada = INP(I_BADA);
    const float* w_in = INP(I_WIN); const float* w_out = INP(I_WOUT); const float* w1 = INP(I_W1);
    float* ADA = WSF(WS_ADA); float* BIAS = WSF(WS_BIAS); float* PEB = WSF(WS_PEB); f16* WTIN = WSH(WS_WTIN); f16* WTOUT = WSH(WS_WTOUT); f16* W1T = WSH(WS_W1T);
    constexpr int N_ADA = 192, N_WTIN = 480, N_WTOUT = 128, N_W1T = 64, N_PEB = 32, N_W2T = 8, N_ALL = N_ADA + N_WTIN + N_WTOUT + N_W1T + N_PEB + N_W2T + 1;
    constexpr int XA = 2, NO = 256 - N_ADA;
    const bool reb = G == 256; const int n_mine = reb ? (bid < N_ADA ? 1 + XA : (N_ALL - N_ADA - XA * N_ADA - (bid - N_ADA) + NO - 1) / NO) : (N_ALL - bid + G - 1) / G;
    for (int k = 0; k < n_mine; ++k) {
        const int it = !reb ? bid + k * G : (bid < N_ADA ? (k == 0 ? bid : N_ADA + XA * bid + (k - 1)) : N_ADA + XA * N_ADA + (bid - N_ADA) + NO * k);
        int i = it;
        if (i < N_ADA) { const int half = i & 1, j = i >> 1, l = j / 48, n0 = (j % 48) * 64, m0 = half * 17;
            skinny_item<18>(lds, w_ada + (size_t)l * 1024 * 3072, 3072, n0, 64, half ? 16 : 17,
                [&](int m, int k) { const int mm = m0 + m; return siluf_(mm < 32 ? c_s[mm * 1024 + k] : c_p[k]); },
                [&](int m, int n, float v) { ADA[((size_t)l * 33 + m0 + m) * 3072 + n] = v + b_ada[l * 3072 + n]; });
            continue; }
        i -= N_ADA;
        if (i < N_WTIN) { const int l = i / 240, r = i % 240, n0 = (r / 4) * 64, k0 = (r % 4) * 256; const float* src = w_in + (size_t)l * 1024 * DIN; f16* dst = WTIN + (size_t)l * NPD * 1024;
            tr64<4>(lds, [&](int kk, int nn) { const int sc = src_col(n0 + nn); return sc >= 0 ? src[(size_t)(k0 + kk) * DIN + sc] : 0.f; },
                      [&](int nn, int kk, f16 v) { dst[(size_t)(n0 + nn) * 1024 + k0 + kk] = v; });
            continue; }
        i -= N_WTIN;
        if (i < N_WTOUT) { const int l = i / 64, r = i % 64, n0 = (r / 4) * 64, k0 = (r % 4) * 256; const float* src = w_out + (size_t)l * 1024 * 1024; f16* dst = WTOUT + (size_t)l * 1024 * 1024;
            tr64<4>(lds, [&](int kk, int nn) { return src[(size_t)(k0 + kk) * 1024 + n0 + nn]; },
                      [&](int nn, int kk, f16 v) { dst[(size_t)(n0 + nn) * 1024 + k0 + kk] = v; });
            continue; }
        i -= N_WTOUT;
        if (i < N_W1T) { const int ls = i / 16, r = i % 16, k0 = (r / 2) * 256, n0 = (r % 2) * 64; const float* src = w1 + (size_t)ls * 2048 * 128; f16* dst = W1T + (size_t)ls * 128 * 2048;
            tr64<4>(lds, [&](int kk, int nn) { return src[(size_t)(k0 + kk) * 128 + n0 + nn]; },
                      [&](int nn, int kk, f16 v) { dst[(size_t)(n0 + nn) * 2048 + k0 + kk] = v; });
            continue; }
        i -= N_W1T;
        if (i < N_PEB) { const int ls = i >> 3, ks8 = i & 7; const float* pe = INP(I_PE) + (size_t)ls * 2048 + ks8 * 256; const float* w = w1 + ((size_t)ls * 2048 + ks8 * 256) * 128; const float* b1 = INP(I_B1) + ls * 128;
            LAS float* R = (LAS float*)lds; const int f = tid & 127, kq = tid >> 7; float sacc = 0.f;
            __syncthreads();
#pragma unroll 16
            for (int k = kq * 64; k < kq * 64 + 64; ++k) sacc += pe[k] * w[(size_t)k * 128 + f];
            R[kq * 128 + f] = sacc; __syncthreads();
            if (tid < 128) WSF(WS_PEBP)[(ls * 8 + ks8) * 128 + tid] = (ks8 == 0 ? b1[tid] : 0.f) + (R[tid] + R[128 + tid]) + (R[256 + tid] + R[384 + tid]);
            __syncthreads();
            continue; }
        i -= N_PEB;
        if (i < N_W2T) { const int ls = i >> 1, f0 = (i & 1) * 64; const float* src = INP(I_W2) + (size_t)ls * 128 * 64; f16* dst = WSH(WS_W2T) + (size_t)ls * 64 * 128;
            tr64(lds, [&](int kk, int nn) { return src[(size_t)(f0 + kk) * 64 + nn]; },
                      [&](int nn, int kk, f16 v) { dst[(size_t)nn * 128 + f0 + kk] = v; });
            continue; }
        for (int e = tid; e < 2 * NPD; e += 512) BIAS[e] = 0.f;
    }
}

DI void ph_sample_compress(LAS unsigned char* lds_) {
    const Ctx c = mkctx(lds_);
    const float* w2 = INP(I_W2); const float* b2 = INP(I_B2); const float* k_g = INP(I_KG); const float* cache_kv = INP(I_CKV); const int* page_table = (const int*)c.ap->in[I_PT];
    f16* W1T = WSH(WS_W1T); float* PEB = WSF(WS_PEBP); float* KCS = WSF(WS_KCS); float* VCS = WSF(WS_VCS);
    for (int it = c.bid; it < 1152; it += c.G) {
        const int grp = it < 1024 ? it & 7 : 8, st_ = it < 1024 ? it >> 3 : it - 1024, slot = st_ & 1, b = (st_ >> 1) & 31, l = st_ >> 6;
        const float* ckv = cache_kv + (size_t)l * NPOOL * 128 * 256; const int* pt = page_table + b * 128;
        compress_item<true>(c.lds, [&](int ch) { return (const void*)(ckv + ((size_t)pt[ch >> 3] * 128 + (ch & 7) * 16) * 256 + slot * 64); }, grp * 127,
                            W1T + (size_t)(l * 2 + slot) * 128 * 2048, PEB + (l * 2 + slot) * 1024, WSH(WS_W2T) + (size_t)(l * 2 + slot) * 64 * 128, b2 + (l * 2 + slot) * 64,
                            slot == 0 ? k_g + l * 192 : nullptr, (slot == 0 ? KCS : VCS) + (size_t)(l * NB + b) * 1024 * 64, nullptr, nullptr);
    }
}
DI void ph_prep(LAS unsigned char* lds_) {
    const Ctx c = mkctx(lds_); const int tid = c.tid, lane = c.lane, wave = c.wave, bid = c.bid, G = c.G;
    float* ADA = WSF(WS_ADA); float* BIAS = WSF(WS_BIAS);
    {
        const f16* WTIN = WSH(WS_WTIN);
        const bool lite = G == 256;
        const int pb = lite ? bid - 128 : bid, pG = lite ? 128 : G;
        if (pb >= 0)
        for (int col0 = pb * 8 + wave; col0 < 2 * NPD; col0 += pG * 32) {
            f16x8 w[4][2]; f32x4 sv[4][4];
#pragma unroll
            for (int k = 0; k < 4; ++k) { int col = col0 + k * pG * 8; col = col < 2 * NPD ? col : 2 * NPD - 1; const int l = col / NPD;
                const float* sh = ADA + ((size_t)l * 33 + 32) * 3072 + lane * 16; const f16* wp = WTIN + (size_t)col * 1024 + lane * 16;
                w[k][0] = ld_h8(wp); w[k][1] = ld_h8(wp + 8);
#pragma unroll
                for (int i = 0; i < 4; ++i) sv[k][i] = *(const f32x4*)(sh + 4 * i); }
#pragma unroll
            for (int k = 0; k < 4; ++k) { const int col = col0 + k * pG * 8; float acc = 0.f;
#pragma unroll
                for (int i = 0; i < 8; ++i) acc += sv[k][i >> 2][i & 3] * (float)w[k][0][i] + sv[k][2 + (i >> 2)][i & 3] * (float)w[k][1][i];
                acc = wsum(acc); if (lane == 0 && col < 2 * NPD) BIAS[col] = acc; } }
    }
    const float* ng = INP(I_NG);
    if (bid == 0) { float* GNX = WSF(WS_GNX); const float* sc1 = ADA + (size_t)(33 + 32) * 3072 + 1024;
        for (int k = tid; k < 1024; k += 512) GNX[k] = ng[1024 + k] * (1.f + sc1[k]); }
    const float* ada_p = ADA + (size_t)32 * 3072; const float* x_p = INP(I_XP); f16* A16 = WSH(WS_A16); float* RSSP = WSF(WS_RSSP);
    float gp[16];
#pragma unroll
    for (int i = 0; i < 4; ++i) { const f32x4 g4 = *(const f32x4*)(ng + i * 256 + lane * 4), s4 = *(const f32x4*)(ada_p + 1024 + i * 256 + lane * 4);
#pragma unroll
        for (int j = 0; j < 4; ++j) gp[i * 4 + j] = g4[j] * (1.f + s4[j]); }
    const bool lite2 = G == 256; const int pb2 = lite2 ? bid - 128 : bid, pG2 = lite2 ? 128 : G;
    if (pb2 >= 0)
    for (int row0 = pb2 * 8 + wave; row0 < SEQ; row0 += pG2 * 32) {
        f32x4 v[4][4];
#pragma unroll
        for (int k = 0; k < 4; ++k) { int row = row0 + k * pG2 * 8; row = row < SEQ ? row : SEQ - 1;
#pragma unroll
            for (int i = 0; i < 4; ++i) v[k][i] = *(const f32x4*)(x_p + (size_t)row * 1024 + i * 256 + lane * 4); }
#pragma unroll
        for (int k = 0; k < 4; ++k) { const int row = row0 + k * pG2 * 8; float ss = 0.f;
            if (row < SEQ) {
#pragma unroll
                for (int i = 0; i < 4; ++i) { const f32x4 u = v[k][i]; ss += (u[0] * u[0] + u[1] * u[1]) + (u[2] * u[2] + u[3] * u[3]);
                    f16x4 h; h[0] = (f16)(u[0] * gp[i * 4]); h[1] = (f16)(u[1] * gp[i * 4 + 1]); h[2] = (f16)(u[2] * gp[i * 4 + 2]); h[3] = (f16)(u[3] * gp[i * 4 + 3]);
                    *(f16x4*)(A16 + (size_t)row * 1024 + i * 256 + lane * 4) = h; }
                ss = wsum(ss);
                if (lane < 16) RSSP[(size_t)row * 16 + lane] = lane == 0 ? ss : 0.f; } }
    }
}

template <int NT  , class OFn>
DI void sample_gemm_item(LAS unsigned char* lds, const f16* Bt, int n0, OFn ofn) {
    constexpr int KW = 8 / NT, KL = 1024 / KW;
    const int tid = ltid(), wave = tid >> 6, lane = tid & 63, wn = wave % NT, wk = wave / NT, r = lane & 31, h = lane >> 5;
    const LAS f16* Ah = (const LAS f16*)lds + r * 1032 + wk * KL + 8 * h; const f16* bp = Bt + (size_t)(n0 + 32 * wn + r) * 1024 + wk * KL + 8 * h;
    f32x16 acc;
#pragma unroll
    for (int i = 0; i < 16; ++i) acc[i] = 0.f;
#pragma unroll 8
    for (int st = 0; st < KL / 16; ++st) acc = __builtin_amdgcn_mfma_f32_32x32x16_f16(*(const LAS f16x8*)(Ah + 16 * st), ld_h8(bp + 16 * st), acc, 0, 0, 0);
    LAS float* RED = (LAS float*)(lds + 67584);
#pragma unroll
    for (int i = 0; i < 16; ++i) RED[(wk * 32 + (i & 3) + 8 * (i >> 2) + 4 * h) * (32 * NT) + 32 * wn + r] = acc[i];
    __syncthreads();
    for (int e = tid; e < 1024 * NT; e += 512) { float v = 0.f;
#pragma unroll
        for (int w = 0; w < KW; ++w) v += RED[w * 1024 * NT + e];
        ofn(e / (32 * NT), n0 + e % (32 * NT), v); }
    __syncthreads();
}
DI void ph_inproj(LAS unsigned char* lds_, int l) {
    const Ctx c = mkctx(lds_);
    pg8::Gemm g{WSH(WS_A16), WSH(WS_WTIN) + (size_t)l * NPD * 1024, SEQ, NPD, 1024}; pg8::StaticOrder S; S.init(SEQ, NPD, c.G, c.bid);
    EpiIn E{WSH(WS_PROJ), WSF(WS_RSSP), WSF(WS_BIAS) + l * NPD, c.out + O_KVP + (size_t)l * SEQ * 256};
    pg8::gemm_phase<EpiIn, pg8::StaticOrder>(c.lds, g, S, E);
    __syncthreads();
}
DI void ph_hsample(LAS unsigned char* lds_, int l) {
    const Ctx c = mkctx(lds_); const int lane = c.lane;
    if (c.bid >= 4) return;
    const int m = c.bid * 8 + c.wave;
    const float* xr = (l == 0 ? INP(I_XS) : WSF(WS_XS1)) + (size_t)m * 1024; const float* ad = WSF(WS_ADA) + ((size_t)l * 33 + m) * 3072; const float* ng = INP(I_NG) + l * 1024; f16* hs = WSH(WS_HS16) + (size_t)m * 1024;
    f32x4 xv[4]; float ss = 0.f;
#pragma unroll
    for (int i = 0; i < 4; ++i) { xv[i] = *(const f32x4*)(xr + i * 256 + lane * 4); ss += (xv[i][0] * xv[i][0] + xv[i][1] * xv[i][1]) + (xv[i][2] * xv[i][2] + xv[i][3] * xv[i][3]); }
    const float rn = rsqrtf(wsum(ss) * (1.f / 1024.f) + EPS);
#pragma unroll
    for (int i = 0; i < 4; ++i) { const int k = i * 256 + lane * 4; const f32x4 g = *(const f32x4*)(ng + k), sc = *(const f32x4*)(ad + 1024 + k), sh = *(const f32x4*)(ad + k); f16x4 hv;
#pragma unroll
        for (int j = 0; j < 4; ++j) hv[j] = (f16)(xv[i][j] * rn * g[j] * (1.f + sc[j]) + sh[j]);
        *(f16x4*)(hs + k) = hv; }
}
DI void ph_inproj_sample(LAS unsigned char* lds_, int l) {
    const Ctx c = mkctx(lds_); const int tid = c.tid;
    const int it = c.bid - (c.G - 64);
    if (it < 0 || it >= 60) return;
    float* PROJS = WSF(WS_PROJS); const f16* HS = WSH(WS_HS16); LAS f16* Ah = (LAS f16*)c.lds;
    __syncthreads();
#pragma unroll
    for (int i = 0; i < 8; ++i) { const int e = (tid + 512 * i) * 8; *(LAS f16x8*)(Ah + (e >> 10) * 1032 + (e & 1023)) = ld_h8(HS + e); }
    __syncthreads();
    sample_gemm_item<2>(c.lds, WSH(WS_WTIN) + (size_t)l * NPD * 1024, it * 64, [&](int m, int n, float v) { PROJS[m * NPD + n] = v; });
}

#define PT(t) (P + (size_t)(t) * SEQ * 256)
DI void ph_ssd_local(LAS unsigned char* lds_, int l) {
    const Ctx c = mkctx(lds_); LAS unsigned char* lds = c.lds; const int tid = c.tid, lane = c.lane, wave = c.wave;
    const f16* P = WSH(WS_PROJ); f16* ACT = WSH(WS_ACT); float* YD = WSF(WS_YD); float* CST = WSF(WS_CST); float* ACS = WSF(WS_ACS); float* CDEC = WSF(WS_CDEC); float* out = c.out;
    const float* dtb = INP(I_DTB) + l * 4; const float* alog = INP(I_ALOG) + l * 4; const float* cw = INP(I_BCW) + l * 4 * 768; const float* cb = INP(I_BCB) + l * 768;
    LAS f16* Bm = (LAS f16*)lds; LAS f16* BT = (LAS f16*)(lds + 34816); LAS f16* Cm = (LAS f16*)(lds + 69632); LAS f16* XT = (LAS f16*)(lds + 104448);
    LAS float* acs = (LAS float*)(lds + 139264); LAS float* dtl = acs + 256; LAS f16* te16 = (LAS f16*)(dtl + 256);
    for (int it = c.bid; it < 256; it += c.G) {
        const int ch_ = it >> 1, g = it & 1, t0 = ch_ * 128;
        __syncthreads();
        if (tid < 256) { const int hh = tid >> 7, lt = tid & 127, hd = 2 * g + hh; const float raw = (float)PT(13)[(size_t)(t0 + lt) * 256 + 128 + hd];
            const float dt = softplusf_(raw + dtb[hd]); dtl[hh * 128 + lt] = dt; acs[hh * 128 + lt] = dt * (-__expf(alog[hd])); }
        __syncthreads();
        if (tid == 0 || tid == 64) { const int hh = tid >> 6; float sacc = 0.f; for (int i = 0; i < 128; ++i) { sacc += acs[hh * 128 + i]; acs[hh * 128 + i] = sacc; } }
        __syncthreads();
        if (tid < 256) { const int hh = tid >> 7, lt = tid & 127, hd = 2 * g + hh; const float av = acs[hh * 128 + lt], ae = acs[hh * 128 + 127];
            te16[hh * 128 + lt] = (f16)__expf(ae - av); ACS[(size_t)(t0 + lt) * 4 + hd] = av; if (lt == 127) CDEC[ch_ * 4 + hd] = __expf(ae); }
#pragma unroll 3
        for (int e = tid; e < 128 * 48; e += 512) {
            const int lt = (e >> 2) & 127, cg = (e >> 9) * 4 + (e & 3), reg = cg >> 4, c8 = (cg & 15) * 8, t = t0 + lt, col = 128 * g + c8, ch = reg * 256 + col;
            const f16* src = PT(5 + reg) + col; float y[8]; f16x8 rawt;
#pragma unroll
            for (int i = 0; i < 8; ++i) y[i] = cb[ch + i];
#pragma unroll
            for (int k = 0; k < 4; ++k) { const int tt = t - 3 + k; f16x8 v; if (tt >= 0) v = ld_h8(src + (size_t)tt * 256); else {
#pragma unroll
                    for (int i = 0; i < 8; ++i) v[i] = (f16)0.f; }
                if (k == 3) rawt = v;
#pragma unroll
                for (int i = 0; i < 8; ++i) y[i] += cw[k * 768 + ch + i] * (float)v[i]; }
            f16x8 act;
#pragma unroll
            for (int i = 0; i < 8; ++i) { y[i] = siluf_(y[i]); act[i] = (f16)y[i]; }
            *(f16x8*)(ACT + (size_t)t * 768 + ch) = act;
            if (reg == 0) { const int hh = c8 >> 6; const float sdt = dtl[hh * 128 + lt] * 64.f;
#pragma unroll
                for (int i = 0; i < 8; ++i) XT[(c8 + i) * 136 + lt] = (f16)(y[i] * sdt); }
            else if (reg == 1) { *(LAS f16x8*)(Bm + lt * 136 + c8) = act;
#pragma unroll
                for (int i = 0; i < 8; ++i) BT[(c8 + i) * 136 + lt] = act[i]; }
            else *(LAS f16x8*)(Cm + lt * 136 + c8) = act;
            if (t >= SEQ - 3) { float* so = out + O_BCP + (size_t)l * 2304 + (t - (SEQ - 3)) * 768 + ch;
#pragma unroll
                for (int i = 0; i < 8; ++i) so[i] = (float)rawt[i]; }
        }
        __syncthreads();
        const int fr = lane & 15, q = lane >> 4, w = wave;
        f32x4 gt[8];
#pragma unroll
        for (int mt = 0; mt < 8; ++mt) { gt[mt] = (f32x4){0.f, 0.f, 0.f, 0.f};
            if (mt <= w) {
#pragma unroll
                for (int ks = 0; ks < 4; ++ks) { const f16x8 av = *(const LAS f16x8*)(Bm + (16 * mt + fr) * 136 + 32 * ks + 8 * q), bv = *(const LAS f16x8*)(Cm + (16 * w + fr) * 136 + 32 * ks + 8 * q);
                    gt[mt] = __builtin_amdgcn_mfma_f32_16x16x32_f16(av, bv, gt[mt], 0, 0, 0); } } }
#pragma unroll
        for (int hh = 0; hh < 2; ++hh) {
            const int lrow = 16 * w + fr; const float al = acs[hh * 128 + lrow];
            f32x4 ya[4];
#pragma unroll
            for (int pt = 0; pt < 4; ++pt) ya[pt] = (f32x4){0.f, 0.f, 0.f, 0.f};
#pragma unroll
            for (int k2 = 0; k2 < 4; ++k2) {
                if (2 * k2 <= w) {
                    f16x8 af;
#pragma unroll
                    for (int j = 0; j < 8; ++j) { const int m = 32 * k2 + (j < 4 ? 4 * q + j : 16 + 4 * q + (j - 4)); const float gv = j < 4 ? gt[2 * k2][j] : gt[2 * k2 + 1][j - 4];
                        af[j] = (f16)(m <= lrow ? gv * __expf(al - acs[hh * 128 + m]) : 0.f); }
#pragma unroll
                    for (int pt = 0; pt < 4; ++pt) { const LAS f16* xp = XT + (hh * 64 + 16 * pt + fr) * 136 + 32 * k2 + 4 * q; const f16x4 b0 = *(const LAS f16x4*)xp, b1 = *(const LAS f16x4*)(xp + 16);
                        f16x8 bf; bf[0] = b0[0]; bf[1] = b0[1]; bf[2] = b0[2]; bf[3] = b0[3]; bf[4] = b1[0]; bf[5] = b1[1]; bf[6] = b1[2]; bf[7] = b1[3];
                        ya[pt] = __builtin_amdgcn_mfma_f32_16x16x32_f16(af, bf, ya[pt], 0, 0, 0); }
                }
            }
#pragma unroll
            for (int pt = 0; pt < 4; ++pt)
#pragma unroll
                for (int j = 0; j < 4; ++j) YD[(size_t)(t0 + 16 * w + 4 * q + j) * 256 + (2 * g + hh) * 64 + 16 * pt + fr] = ya[pt][j] * (1.f / 64.f);
#pragma unroll
            for (int pt = 0; pt < 4; ++pt) { f32x4 sa = (f32x4){0.f, 0.f, 0.f, 0.f};
#pragma unroll
                for (int ks = 0; ks < 4; ++ks) { const f16x8 xv = *(const LAS f16x8*)(XT + (hh * 64 + 16 * pt + fr) * 136 + 32 * ks + 8 * q), tv = *(const LAS f16x8*)(te16 + hh * 128 + 32 * ks + 8 * q);
                    const f16x8 bv = *(const LAS f16x8*)(BT + (16 * w + fr) * 136 + 32 * ks + 8 * q);
                    sa = __builtin_amdgcn_mfma_f32_16x16x32_f16(xv * tv, bv, sa, 0, 0, 0); }
#pragma unroll
                for (int j = 0; j < 4; ++j) CST[((size_t)(ch_ * 4 + 2 * g + hh) * 64 + 16 * pt + 4 * q + j) * 128 + 16 * w + fr] = sa[j] * (1.f / 64.f); }
        }
    }
    __syncthreads();
}
DI void ph_mix_a(LAS unsigned char* lds_, int l) {
    const Ctx c = mkctx(lds_); const int tid = c.tid;
    const f16* P = WSH(WS_PROJ); f16* Y16 = WSH(WS_Y16); float* out = c.out; const float* scw = INP(I_SCW) + l * 768;
    const bool reb = c.G == 256; const int it2 = (reb && c.bid >= 36 && c.bid < 54) ? c.bid - 36 : 256;
    for (int it = (reb && c.bid < 18) ? 256 : c.bid; it < 256; it = reb ? (it == c.bid ? it2 : 256) : it + c.G) {
        const int c0 = (tid & 31) * 8; f16x8 hh[4][3], cv[4][3], bb[4], gg[4];
#pragma unroll
        for (int i4 = 0; i4 < 4; ++i4) { const int t = it * 64 + (tid >> 5) + 16 * i4;
#pragma unroll
            for (int k = 0; k < 3; ++k) { const int tt = t - 2 + k >= 0 ? t - 2 + k : 0; hh[i4][k] = ld_h8(PT(0) + (size_t)tt * 256 + c0); cv[i4][k] = ld_h8(PT(2) + (size_t)tt * 256 + c0); }
            bb[i4] = ld_h8(PT(1) + (size_t)t * 256 + c0); gg[i4] = ld_h8(PT(3) + (size_t)t * 256 + c0); }
        float sw[3][8];
#pragma unroll
        for (int k = 0; k < 3; ++k) { const f32x4 s0 = *(const f32x4*)(scw + k * 256 + c0), s1 = *(const f32x4*)(scw + k * 256 + c0 + 4);
#pragma unroll
            for (int i = 0; i < 4; ++i) { sw[k][i] = s0[i]; sw[k][4 + i] = s1[i]; } }
#pragma unroll
        for (int i4 = 0; i4 < 4; ++i4) { const int t = it * 64 + (tid >> 5) + 16 * i4; float u[3][8];
#pragma unroll
            for (int k = 0; k < 3; ++k) { const bool ok = t - 2 + k >= 0;
#pragma unroll
                for (int i = 0; i < 8; ++i) u[k][i] = ok ? (float)cv[i4][k][i] * (float)hh[i4][k][i] : 0.f; }
            f16x8 o;
#pragma unroll
            for (int i = 0; i < 8; ++i) { const float y = sw[0][i] * u[0][i] + sw[1][i] * u[1][i] + sw[2][i] * u[2][i]; o[i] = (f16)(siluf_((float)gg[i4][i]) * (float)bb[i4][i] * y); }
            *(f16x8*)(Y16 + (size_t)t * 1024 + c0) = o;
            if (t >= SEQ - 2) { float* so = out + O_SCP + (size_t)l * 512 + (t - (SEQ - 2)) * 256 + c0;
#pragma unroll
                for (int i = 0; i < 8; ++i) so[i] = u[2][i]; }
        }
    }
}
DI void ph_mix_c(LAS unsigned char* lds_, int l) {
    const Ctx c = mkctx(lds_); const int tid = c.tid, lane = c.lane, wave = c.wave;
    const f16* P = WSH(WS_PROJ); f16* Y16 = WSH(WS_Y16); float* out = c.out;
    const float* cfw = INP(I_CFW) + l * 31 * 256; const float* cfb = INP(I_CFB) + l * 256; const float* lng = INP(I_LNG) + l * 256; const float* lnb = INP(I_LNB) + l * 256;
    LAS float* GL = (LAS float*)c.lds;
    f32x4 wt[31];
#pragma unroll
    for (int k = 0; k < 31; ++k) wt[k] = *(const f32x4*)(cfw + k * 256 + lane * 4);
    const f32x4 bias4 = *(const f32x4*)(cfb + lane * 4), g4 = *(const f32x4*)(lng + lane * 4), b4 = *(const f32x4*)(lnb + lane * 4);
    const bool reb = c.G == 256; const int it2 = (reb && c.bid >= 54 && c.bid < 72) ? c.bid - 54 : 256;
    for (int it = (reb && c.bid < 18) ? 256 : c.bid; it < 256; it = reb ? (it == c.bid ? it2 : 256) : it + c.G) {
        __syncthreads();
        {
            f16x8 ga[6], gb[6];
#pragma unroll
            for (int i6 = 0; i6 < 6; ++i6) { const int e = tid + 512 * i6, rr = e >> 5, c0 = (e & 31) * 8, t = it * 64 - 30 + rr; const int tc = (e < 94 * 32 && t >= 0) ? t : it * 64;
                ga[i6] = ld_h8(PT(8) + (size_t)tc * 256 + c0); gb[i6] = ld_h8(PT(9) + (size_t)tc * 256 + c0); }
#pragma unroll
            for (int i6 = 0; i6 < 6; ++i6) { const int e = tid + 512 * i6, rr = e >> 5, c0 = (e & 31) * 8, t = it * 64 - 30 + rr; f32x4 g0 = (f32x4){0.f, 0.f, 0.f, 0.f}, g1 = g0;
                if (e < 94 * 32) {
                    if (t >= 0) {
#pragma unroll
                        for (int i = 0; i < 4; ++i) { g0[i] = (float)ga[i6][i] * sigmoidf_((float)gb[i6][i]); g1[i] = (float)ga[i6][4 + i] * sigmoidf_((float)gb[i6][4 + i]); }
                        if (t >= SEQ - 30) { float* so = out + O_CFP + (size_t)l * 7680 + (t - (SEQ - 30)) * 256 + c0; *(f32x4*)so = g0; *(f32x4*)(so + 4) = g1; } }
                    *(LAS f32x4*)(GL + rr * 256 + c0) = g0; *(LAS f32x4*)(GL + rr * 256 + c0 + 4) = g1; } }
        }
        __syncthreads();
        {
            const int cc = lane * 4, tb = wave * 8;
            f32x4 u[8]; f16x4 cgv[8];
#pragma unroll
            for (int j = 0; j < 8; ++j) { u[j] = bias4; cgv[j] = *(const f16x4*)(PT(10) + (size_t)(it * 64 + tb + j) * 256 + cc); }
#pragma unroll
            for (int r = 0; r < 38; ++r) { const f32x4 gv = *(const LAS f32x4*)(GL + (tb + r) * 256 + cc);
#pragma unroll
                for (int j = 0; j < 8; ++j) if (r - j >= 0 && r - j <= 30) u[j] += wt[r - j] * gv; }
#pragma unroll
            for (int j = 0; j < 8; ++j) { const int t = it * 64 + tb + j;
                const float mean = wsum((u[j][0] + u[j][1]) + (u[j][2] + u[j][3])) * (1.f / 256.f); const f32x4 d = u[j] - mean;
                const float var = wsum((d[0] * d[0] + d[1] * d[1]) + (d[2] * d[2] + d[3] * d[3])) * (1.f / 256.f); const float rs = rsqrtf(var + EPS);
                const f16x4 cg = cgv[j]; f16x4 o;
#pragma unroll
                for (int i = 0; i < 4; ++i) o[i] = (f16)(siluf_((float)cg[i]) * siluf_(d[i] * rs * g4[i] + b4[i]));
                *(f16x4*)(Y16 + (size_t)t * 1024 + 512 + cc) = o; }
        }
    }
    __syncthreads();
}
DI void ph_mix_d(LAS unsigned char* lds_, int l) {
    const Ctx c = mkctx(lds_); const int tid = c.tid, lane = c.lane, wave = c.wave;
    const f16* P = WSH(WS_PROJ); float* out = c.out; float* kvp_out = out + O_KVP + (size_t)l * SEQ * 256;
    f16* Q16 = WSH(WS_Q16); f16* KS16 = WSH(WS_KS16); f16* KW16 = WSH(WS_KW16); f16* VST16 = WSH(WS_VST16); f16* VWT16 = WSH(WS_VWT16); float* GATES = WSF(WS_GATES);
    const int d4 = (lane & 15) * 4, v4 = lane >> 4;
    const f32x4 qg = *(const f32x4*)(INP(I_QG) + l * 64 + d4), kg1 = *(const f32x4*)(INP(I_KG) + l * 192 + 64 + d4), kg2 = *(const f32x4*)(INP(I_KG) + l * 192 + 128 + d4);
    LAS f16* VSs = (LAS f16*)c.lds; LAS f16* VWs = VSs + 64 * 68;
    if (c.bid < 18 && c.G > 36) return;
    for (int it = c.bid - 18 >= 0 && c.G > 36 ? c.bid - 18 : c.bid; it < 256; it += (c.G > 36 ? c.G - 18 : c.G)) {
        __syncthreads();
        f16x4 xq[8], xk[2], vk[2], xw[2], vw[2]; f16 gt[2];
#pragma unroll
        for (int i = 0; i < 8; ++i) xq[i] = *(const f16x4*)(PT(11) + (size_t)(it * 64) * 256 + (size_t)(wave * 4 + v4 + 32 * i) * 64 + d4);
#pragma unroll
        for (int i = 0; i < 2; ++i) { const size_t t = (size_t)(it * 64 + wave * 4 + v4 + 32 * i);
            xk[i] = *(const f16x4*)(PT(12) + t * 256 + 128 + d4); vk[i] = *(const f16x4*)(PT(12) + t * 256 + 192 + d4); xw[i] = *(const f16x4*)(PT(13) + t * 256 + d4); vw[i] = *(const f16x4*)(PT(13) + t * 256 + 64 + d4); }
#pragma unroll
        for (int i = 0; i < 2; ++i) { int e = tid + 512 * i; e = e < 64 * 12 ? e : 0; gt[i] = PT(13)[(size_t)(it * 64 + e / 12) * 256 + 132 + e % 12]; }
#pragma unroll
        for (int i = 0; i < 8; ++i) { const int vi = wave * 4 + v4 + 32 * i; const size_t off = (size_t)(it * 64) * 256 + (size_t)vi * 64 + d4; const f16x4 x = xq[i];
            const float a0 = (float)x[0], a1 = (float)x[1], a2 = (float)x[2], a3 = (float)x[3]; const float rn = rsqrtf(sum16((a0 * a0 + a1 * a1) + (a2 * a2 + a3 * a3)) * (1.f / 64.f) + EPS);
            f16x4 y; y[0] = (f16)(a0 * rn * qg[0]); y[1] = (f16)(a1 * rn * qg[1]); y[2] = (f16)(a2 * rn * qg[2]); y[3] = (f16)(a3 * rn * qg[3]); *(f16x4*)(Q16 + off) = y; }
#pragma unroll
        for (int i = 0; i < 2; ++i) { const int tl = wave * 4 + v4 + 32 * i, t = it * 64 + tl;
            { const f16x4 x = xk[i], vv = vk[i];
                const float a0 = (float)x[0], a1 = (float)x[1], a2 = (float)x[2], a3 = (float)x[3]; const float rn = rsqrtf(sum16((a0 * a0 + a1 * a1) + (a2 * a2 + a3 * a3)) * (1.f / 64.f) + EPS);
                const f32x4 kn = (f32x4){a0 * rn * kg1[0], a1 * rn * kg1[1], a2 * rn * kg1[2], a3 * rn * kg1[3]}; *(f32x4*)(kvp_out + (size_t)t * 256 + 128 + d4) = kn;
                f16x4 y; y[0] = (f16)kn[0]; y[1] = (f16)kn[1]; y[2] = (f16)kn[2]; y[3] = (f16)kn[3]; *(f16x4*)(KS16 + (size_t)t * 64 + d4) = y; *(LAS f16x4*)(VSs + tl * 68 + d4) = vv; }
            { const f16x4 x = xw[i], vv = vw[i];
                const float a0 = (float)x[0], a1 = (float)x[1], a2 = (float)x[2], a3 = (float)x[3]; const float rn = rsqrtf(sum16((a0 * a0 + a1 * a1) + (a2 * a2 + a3 * a3)) * (1.f / 64.f) + EPS);
                const f32x4 kn = (f32x4){a0 * rn * kg2[0], a1 * rn * kg2[1], a2 * rn * kg2[2], a3 * rn * kg2[3]};
                f16x4 y; y[0] = (f16)kn[0]; y[1] = (f16)kn[1]; y[2] = (f16)kn[2]; y[3] = (f16)kn[3]; *(f16x4*)(KW16 + (size_t)t * 64 + d4) = y; *(LAS f16x4*)(VWs + tl * 68 + d4) = vv;
                if (t >= SEQ - 512) { float* wo = out + O_WINP + (size_t)l * 512 * 128 + (size_t)(t - (SEQ - 512)) * 128; *(f32x4*)(wo + d4) = kn; *(f32x4*)(wo + 64 + d4) = (f32x4){(float)vv[0], (float)vv[1], (float)vv[2], (float)vv[3]}; } }
        }
#pragma unroll
        for (int i = 0; i < 2; ++i) { const int e = tid + 512 * i; if (e < 64 * 12) GATES[(size_t)(it * 64 + e / 12) * 12 + e % 12] = sigmoidf_((float)gt[i]); }
        __syncthreads();
        { const int d = tid >> 3, k8 = (tid & 7) * 8; f16x8 a, b;
#pragma unroll
            for (int i = 0; i < 8; ++i) { const int key = vt_key(k8 + i); a[i] = VSs[key * 68 + d]; b[i] = VWs[key * 68 + d]; }
            *(f16x8*)(VST16 + (size_t)it * 4096 + d * 64 + k8) = a; *(f16x8*)(VWT16 + (size_t)it * 4096 + d * 64 + k8) = b; }
    }
    __syncthreads();
}
DI void ph_mix_cmp(LAS unsigned char* lds_, int l) {
    const Ctx c = mkctx(lds_);
    const f16* P = WSH(WS_PROJ); const float* w2 = INP(I_W2); const float* b2 = INP(I_B2); const float* k_g = INP(I_KG); f16* W1T = WSH(WS_W1T); float* PEB = WSF(WS_PEBP);
    for (int it = c.bid; it < 18; it += c.G) { const int slot = it / 9, grp = it % 9; const f16* src = PT(12) + slot * 64;
        compress_item<false>(c.lds, [&](int ch) { return (const void*)(src + (size_t)ch * 16 * 256); }, grp * 127,
                             W1T + (size_t)(l * 2 + slot) * 128 * 2048, PEB + (l * 2 + slot) * 1024, WSH(WS_W2T) + (size_t)(l * 2 + slot) * 64 * 128, b2 + (l * 2 + slot) * 64,
                             slot == 0 ? k_g + l * 192 : nullptr, nullptr, slot == 0 ? WSH(WS_KC16) : nullptr, slot == 0 ? nullptr : WSH(WS_VCT16)); }
}
#undef PT
template <int N>
DI void blk_reduce(LAS float* red, LAS float* bc, float (&v)[N], bool is_max, int wave, int lane) {
#pragma unroll
    for (int i = 0; i < N; ++i) v[i] = is_max ? wmaxf(v[i]) : wsum(v[i]);
    __syncthreads();
    if (lane == 0) {
#pragma unroll
        for (int i = 0; i < N; ++i) red[wave * 12 + i] = v[i]; }
    __syncthreads();
    if (wave == 0 && lane < N) { float r = red[lane]; for (int w = 1; w < 8; ++w) r = is_max ? fmaxf(r, red[w * 12 + lane]) : r + red[w * 12 + lane]; bc[lane] = r; }
    __syncthreads();
#pragma unroll
    for (int i = 0; i < N; ++i) v[i] = bc[i];
}
DI void nsa_sample_block(LAS float* wl, const float* KC, const float* VC, const SampleKV& kv, const LAS float* gsm, const float* dgp, float* ysd, int tid, int lane, int wave) {
    LAS float* sc = wl; LAS float* qs = wl + 10496; LAS float* PSL = qs + 256; LAS float* red = PSL + 1024; LAS float* bc = red + 96; LAS int* sel = (LAS int*)(bc + 16); LAS float* part = bc + 32;
    constexpr int NCV = 1023, CUR = PAST >> 6;
    float mv[8], sv[8];
#pragma unroll
    for (int i = 0; i < 8; ++i) mv[i] = -3e38f;
    for (int cidx = tid; cidx < NCV; cidx += 512) {
        asm volatile("" ::: "memory");
        float kr[64]; kv.ld64(KC + (size_t)cidx * 64, kr); float s4[4] = {0.f, 0.f, 0.f, 0.f};
#pragma unroll
        for (int d = 0; d < 64; ++d) { const f32x4 qv = *(const LAS f32x4*)(qs + d * 4); s4[0] += qv[0] * kr[d]; s4[1] += qv[1] * kr[d]; s4[2] += qv[2] * kr[d]; s4[3] += qv[3] * kr[d]; }
#pragma unroll
        for (int hh = 0; hh < 4; ++hh) { s4[hh] *= 0.125f; sc[hh * 2624 + cidx] = s4[hh]; mv[hh] = fmaxf(mv[hh], s4[hh]); }
    }
    for (int i = tid; i < 513; i += 512) {
        asm volatile("" ::: "memory");
        float kr[64]; kv.krow_win(PAST - 512 + i, kr); float s4[4] = {0.f, 0.f, 0.f, 0.f};
#pragma unroll
        for (int d = 0; d < 64; ++d) { const f32x4 qv = *(const LAS f32x4*)(qs + d * 4); s4[0] += qv[0] * kr[d]; s4[1] += qv[1] * kr[d]; s4[2] += qv[2] * kr[d]; s4[3] += qv[3] * kr[d]; }
#pragma unroll
        for (int hh = 0; hh < 4; ++hh) { s4[hh] *= 0.125f; sc[hh * 2624 + 2048 + i] = s4[hh]; mv[4 + hh] = fmaxf(mv[4 + hh], s4[hh]); }
    }
    blk_reduce<8>(red, bc, mv, true, wave, lane);
#pragma unroll
    for (int i = 0; i < 8; ++i) sv[i] = 0.f;
    for (int cidx = tid; cidx < NCV; cidx += 512) {
#pragma unroll
        for (int hh = 0; hh < 4; ++hh) { const float e = __expf(sc[hh * 2624 + cidx] - mv[hh]); sc[hh * 2624 + cidx] = e; sv[hh] += e; } }
    for (int i = tid; i < 513; i += 512) {
#pragma unroll
        for (int hh = 0; hh < 4; ++hh) { const float e = __expf(sc[hh * 2624 + 2048 + i] - mv[4 + hh]); sc[hh * 2624 + 2048 + i] = e; sv[4 + hh] += e; } }
    blk_reduce<8>(red, bc, sv, false, wave, lane);
    float invc[4], invw[4];
#pragma unroll
    for (int hh = 0; hh < 4; ++hh) { invc[hh] = 1.f / sv[hh]; invw[hh] = 1.f / sv[4 + hh]; }
    for (int cidx = tid; cidx < 1024; cidx += 512) PSL[cidx] = cidx < NCV ? (sc[cidx] * invc[0] + sc[2624 + cidx] * invc[1]) + (sc[2 * 2624 + cidx] * invc[2] + sc[3 * 2624 + cidx] * invc[3]) : 0.f;
    __syncthreads();
    if (wave == 0) {
        float scv[5];
#pragma unroll
        for (int i = 0; i < 5; ++i) { const int j = lane + 64 * i; float v = -3e38f;
            if (j <= CUR) { if (j == 0 || j == CUR || j == CUR - 1) v = 3e38f; else { float a = 0.f;
#pragma unroll
                    for (int o5 = -1; o5 < 4; ++o5) { const int cc = 4 * j + o5; if (cc >= 0 && cc < NCV) a += (o5 == -1 || o5 == 3) ? 0.5f * PSL[cc] : PSL[cc]; }
                    v = a; } }
            scv[i] = v; }
        for (int k = 0; k < 16; ++k) {
            float bv = scv[0]; int bi = lane;
#pragma unroll
            for (int i = 1; i < 5; ++i) if (scv[i] > bv) { bv = scv[i]; bi = lane + 64 * i; }
#pragma unroll
            for (int off = 32; off > 0; off >>= 1) { const float ov = __shfl_xor(bv, off); const int oi = __shfl_xor(bi, off); if (ov > bv || (ov == bv && oi < bi)) { bv = ov; bi = oi; } }
            if (lane == 0) sel[k] = bi;
#pragma unroll
            for (int i = 0; i < 5; ++i) if (lane + 64 * i == bi) scv[i] = -3e38f;
        }
    }
    __syncthreads();
    float ms[4], ss4[4];
#pragma unroll
    for (int i = 0; i < 4; ++i) ms[i] = -3e38f;
    for (int idx = tid; idx < 1024; idx += 512) {
        asm volatile("" ::: "memory");
        const int pos = sel[idx >> 6] * 64 + (idx & 63); float s4[4] = {-1e30f, -1e30f, -1e30f, -1e30f};
        if (pos <= PAST) { float kr[64]; kv.krow_sel(pos, kr); s4[0] = s4[1] = s4[2] = s4[3] = 0.f;
#pragma unroll
            for (int d = 0; d < 64; ++d) { const f32x4 qv = *(const LAS f32x4*)(qs + d * 4); s4[0] += qv[0] * kr[d]; s4[1] += qv[1] * kr[d]; s4[2] += qv[2] * kr[d]; s4[3] += qv[3] * kr[d]; }
#pragma unroll
            for (int hh = 0; hh < 4; ++hh) s4[hh] *= 0.125f; }
#pragma unroll
        for (int hh = 0; hh < 4; ++hh) { sc[hh * 2624 + 1024 + idx] = s4[hh]; ms[hh] = fmaxf(ms[hh], s4[hh]); }
    }
    blk_reduce<4>(red, bc, ms, true, wave, lane);
#pragma unroll
    for (int i = 0; i < 4; ++i) ss4[i] = 0.f;
    for (int idx = tid; idx < 1024; idx += 512) {
#pragma unroll
        for (int hh = 0; hh < 4; ++hh) { const float x = sc[hh * 2624 + 1024 + idx]; const float e = x > -1e29f ? __expf(x - ms[hh]) : 0.f; sc[hh * 2624 + 1024 + idx] = e; ss4[hh] += e; } }
    blk_reduce<4>(red, bc, ss4, false, wave, lane);
    float invs[4];
#pragma unroll
    for (int hh = 0; hh < 4; ++hh) invs[hh] = 1.f / ss4[hh];
    float oc[4] = {0.f, 0.f, 0.f, 0.f}, os[4] = {0.f, 0.f, 0.f, 0.f}, ow[4] = {0.f, 0.f, 0.f, 0.f};
    { const int c1 = (wave + 1) * 128 < NCV ? (wave + 1) * 128 : NCV;
#pragma unroll 16
        for (int cidx = wave * 128; cidx < c1; ++cidx) { const float v = VC[(size_t)cidx * 64 + lane];
#pragma unroll
            for (int hh = 0; hh < 4; ++hh) oc[hh] += sc[hh * 2624 + cidx] * v; } }
    for (int kb = wave * 2; kb < wave * 2 + 2; ++kb) { const int p0 = sel[kb] * 64; int nk = PAST - p0 + 1; nk = nk > 64 ? 64 : nk;
        const float* vbase = p0 < PAST ? kv.prow(p0, 3) + lane : kv.nvs + lane;
#pragma unroll 16
        for (int kk = 0; kk < nk; ++kk) { const float v = vbase[(size_t)kk * 256];
#pragma unroll
            for (int hh = 0; hh < 4; ++hh) os[hh] += sc[hh * 2624 + 1024 + kb * 64 + kk] * v; } }
    { const int i1 = (wave + 1) * 65 < 513 ? (wave + 1) * 65 : 513;
#pragma unroll 13
        for (int i = wave * 65; i < i1; ++i) { const float v = kv.v_win(PAST - 512 + i, lane);
#pragma unroll
            for (int hh = 0; hh < 4; ++hh) ow[hh] += sc[hh * 2624 + 2048 + i] * v; } }
#pragma unroll
    for (int hh = 0; hh < 4; ++hh) { part[(wave * 12 + hh) * 64 + lane] = oc[hh] * invc[hh]; part[(wave * 12 + 4 + hh) * 64 + lane] = os[hh] * invs[hh]; part[(wave * 12 + 8 + hh) * 64 + lane] = ow[hh] * invw[hh]; }
    __syncthreads();
    if (tid < 256) { const int hh = tid >> 6, d = tid & 63; float a = 0.f, b = 0.f, cc = 0.f;
        for (int w = 0; w < 8; ++w) { a += part[(w * 12 + hh) * 64 + d]; b += part[(w * 12 + 4 + hh) * 64 + d]; cc += part[(w * 12 + 8 + hh) * 64 + d]; }
        ysd[tid] = siluf_(dgp[tid]) * (gsm[hh * 3] * a + gsm[hh * 3 + 1] * b + gsm[hh * 3 + 2] * cc); }
}
DI void ph_mix_sample(LAS unsigned char* lds_, int l) {
    const Ctx c = mkctx(lds_); const int tid = c.tid, lane = c.lane, wave = c.wave;
    const int b = c.bid - (c.G - 32);
    if (b < 0 || b >= 32) return;
    float* out = c.out;
    __syncthreads();
    const float* pr = WSF(WS_PROJS) + (size_t)b * NPD;
    LAS float* act = (LAS float*)c.lds;
    LAS float* red = act + 768;
    LAS float* ybl = red + 16;
    LAS float* sdt = ybl + 256;
    LAS float* nrow = sdt + 8;
    LAS float* gsm = nrow + 256;
    LAS float* wl = gsm + 16;
    float* ys = WSF(WS_YS) + (size_t)b * 1024;
    if (tid < 256) { const int ch = tid; const float* st = INP(I_SSC) + ((size_t)(l * NB + b) * 2) * 256; const float* scw = INP(I_SCW) + l * 768;
        const float u = pr[512 + ch] * pr[ch], p0 = st[ch], p1 = st[256 + ch]; const float y = scw[ch] * p0 + scw[256 + ch] * p1 + scw[512 + ch] * u;
        ys[ch] = siluf_(pr[768 + ch]) * pr[256 + ch] * y; float* so = out + O_SCS + ((size_t)(l * NB + b) * 2) * 256; so[ch] = p1; so[256 + ch] = u; }
    float uc = 0.f;
    if (tid >= 256) { const int ch = tid - 256; const float* st = INP(I_SCF) + (size_t)(l * NB + b) * 7680; const float* cfw = INP(I_CFW) + l * 31 * 256;
        const float glu = pr[2048 + ch] * sigmoidf_(pr[2304 + ch]); float u = INP(I_CFB)[l * 256 + ch]; float* so = out + O_CFS + (size_t)(l * NB + b) * 7680;
        for (int k = 0; k < 30; ++k) { const float pv = st[k * 256 + ch]; u += cfw[k * 256 + ch] * pv; if (k > 0) so[(k - 1) * 256 + ch] = pv; }
        u += cfw[30 * 256 + ch] * glu; so[29 * 256 + ch] = glu; uc = u; }
    { const float s1 = wsum(tid >= 256 ? uc : 0.f); if (lane == 0) red[wave] = s1; }
    __syncthreads();
    const float cmean = (red[4] + red[5] + red[6] + red[7]) * (1.f / 256.f);
    __syncthreads();
    { const float d = uc - cmean; const float s2 = wsum(tid >= 256 ? d * d : 0.f); if (lane == 0) red[wave] = s2; }
    __syncthreads();
    if (tid >= 256) { const int ch = tid - 256; const float var = (red[4] + red[5] + red[6] + red[7]) * (1.f / 256.f);
        const float ln = (uc - cmean) * rsqrtf(var + EPS) * INP(I_LNG)[l * 256 + ch] + INP(I_LNB)[l * 256 + ch];
        ys[512 + ch] = siluf_(pr[2560 + ch]) * siluf_(ln); }
    { const float* st = INP(I_SBC) + (size_t)(l * NB + b) * 2304; const float* cw = INP(I_BCW) + l * 4 * 768; const float* cb = INP(I_BCB) + l * 768; float* so = out + O_BCS + (size_t)(l * NB + b) * 2304;
        for (int ch = tid; ch < 768; ch += 512) { const float raw = pr[1280 + ch], p0 = st[ch], p1 = st[768 + ch], p2 = st[1536 + ch];
            act[ch] = siluf_(cb[ch] + cw[ch] * p0 + cw[768 + ch] * p1 + cw[1536 + ch] * p2 + cw[2304 + ch] * raw); so[ch] = p1; so[768 + ch] = p2; so[1536 + ch] = raw; }
        if (tid < 4) { const float dt = softplusf_(pr[3456 + tid] + INP(I_DTB)[l * 4 + tid]); sdt[tid] = dt; sdt[4 + tid] = __expf(dt * (-__expf(INP(I_ALOG)[l * 4 + tid]))); } }
    __syncthreads();
    { const float* h0 = INP(I_SSM) + (size_t)(l * NB + b) * 32768; float* ho = out + O_HS + (size_t)(l * NB + b) * 32768; const float* Dp = INP(I_SD) + l * 4;
        for (int row = wave; row < 256; row += 8) { const int hd = row >> 6, gq = hd >> 1; const float dt = sdt[hd], dA = sdt[4 + hd], xv = act[row]; float y = 0.f;
#pragma unroll
            for (int s2 = 0; s2 < 2; ++s2) { const int sidx = lane + 64 * s2; const float hn = dA * h0[row * 128 + sidx] + dt * xv * act[256 + gq * 128 + sidx]; ho[row * 128 + sidx] = hn; y += hn * act[512 + gq * 128 + sidx]; }
            y = wsum(y);
            if (lane == 0) ybl[row] = (y + Dp[hd] * xv) * siluf_(pr[1024 + row]); } }
    __syncthreads();
    { const float v = tid < 256 ? ybl[tid] : 0.f; const float s2 = wsum(v * v); if (lane == 0) red[8 + wave] = s2; }
    __syncthreads();
    if (tid < 256) { const float ss = red[8] + red[9] + red[10] + red[11]; ys[256 + tid] = ybl[tid] * rsqrtf(ss * (1.f / 256.f) + EPS) * INP(I_SNG)[l * 256 + tid]; }
    const float* qg = INP(I_QG) + l * 64; const float* kg = INP(I_KG) + l * 192;
    LAS float* qs = wl + 10496;
    if (wave < 4) { const float v = pr[2816 + wave * 64 + lane]; const float ss = wsum(v * v); qs[lane * 4 + wave] = v * rsqrtf(ss * (1.f / 64.f) + EPS) * qg[lane]; }
    else if (wave == 4) { const float v = pr[3072 + 128 + lane]; const float ss = wsum(v * v); nrow[lane] = v * rsqrtf(ss * (1.f / 64.f) + EPS) * kg[64 + lane]; nrow[64 + lane] = pr[3072 + 192 + lane]; }
    else if (wave == 5) { const float v = pr[3072 + 256 + lane]; const float ss = wsum(v * v); nrow[128 + lane] = v * rsqrtf(ss * (1.f / 64.f) + EPS) * kg[128 + lane]; nrow[192 + lane] = pr[3072 + 320 + lane]; }
    else if (wave == 6) { if (lane < 12) gsm[lane] = sigmoidf_(pr[3460 + lane]); }
    __syncthreads();
    const float* cache_win = INP(I_CWIN) + (size_t)(l * NB + b) * 512 * 128;
    { float* ko = out + O_KVS + (size_t)(l * NB + b) * 256;
        if (tid < 128) ko[tid] = pr[3072 + tid]; else if (tid < 192) ko[tid] = nrow[tid - 128]; else if (tid < 256) ko[tid] = nrow[64 + tid - 192];
        float* wo = out + O_WINS + (size_t)(l * NB + b) * 512 * 128;
        for (int e = tid; e < 511 * 128; e += 512) wo[e] = cache_win[128 + e];
        if (tid < 64) wo[511 * 128 + tid] = nrow[128 + tid]; else if (tid < 128) wo[511 * 128 + tid] = nrow[192 + tid - 64]; }
    float* nrp = WSF(WS_NRG) + (size_t)(l * NB + b) * 256;
    if (tid < 256) nrp[tid] = nrow[tid];
    asm volatile("s_waitcnt vmcnt(0)" ::: "memory");
    __syncthreads();
    {
        SampleKV kv{INP(I_CKV) + (size_t)l * NPOOL * 128 * 256, (const int*)c.ap->in[I_PT] + b * 128, cache_win, nrp, nrp + 64, nrp + 128, nrp + 192};
        nsa_sample_block(wl, WSF(WS_KCS) + (size_t)(l * NB + b) * 1024 * 64, WSF(WS_VCS) + (size_t)(l * NB + b) * 1024 * 64, kv, gsm, pr + 3584, ys + 768, tid, lane, wave);
    }
    edge_publish((unsigned*)(c.ws + WS_CTL + 18432) + l * 64);
    __syncthreads();
}
DI void ph_scan(LAS unsigned char* lds_, int l) {
    const Ctx c = mkctx(lds_);
    if (c.bid >= 64) return;
    const float* CST = WSF(WS_CST); float* HPV = WSF(WS_HPV); const float* CDEC = WSF(WS_CDEC);
    const int e = c.bid * 512 + c.tid, hd = e >> 13; float hc = 0.f;
    for (int ch0 = 0; ch0 < 128; ch0 += 16) {
        float sv[16], dc[16];
#pragma unroll
        for (int i = 0; i < 16; ++i) { sv[i] = CST[(size_t)(ch0 + i) * 32768 + e]; dc[i] = CDEC[(ch0 + i) * 4 + hd]; }
#pragma unroll
        for (int i = 0; i < 16; ++i) { HPV[(size_t)(ch0 + i) * 32768 + e] = hc; hc = dc[i] * hc + sv[i]; } }
    c.out[O_HP + (size_t)l * 32768 + e] = hc;
    edge_publish((unsigned*)(c.ws + WS_CTL + 17408) + l * 64);
}
DI f16x8 pack_p(const f32x4& a, const f32x4& b) { f16x8 r; r[0] = (f16)a[0]; r[1] = (f16)a[1]; r[2] = (f16)a[2]; r[3] = (f16)a[3]; r[4] = (f16)b[0]; r[5] = (f16)b[1]; r[6] = (f16)b[2]; r[7] = (f16)b[3]; return r; }
DI f16x8 ld_vt(const f16* p) { const f16x4 a = *(const f16x4*)p, b = *(const f16x4*)(p + 16); f16x8 r; r[0] = a[0]; r[1] = a[1]; r[2] = a[2]; r[3] = a[3]; r[4] = b[0]; r[5] = b[1]; r[6] = b[2]; r[7] = b[3]; return r; }
constexpr int NT_PSEL = 0  , NT_STG = 32768  , NT_STG_SZ = 18432 + 17408,
              NT_RING = 0  , NT_MASK = 131072  , NT_VB = NT_MASK + 1088  , NT_MT = NT_VB + 1088  , NT_END = NT_MT + 1088;
static_assert(NT_STG + 2 * NT_STG_SZ <= NT_MASK, "nsa tile LDS map");
static_assert(NT_END <= MISC_OFF, "nsa tile LDS map");
struct StgRegs { f16x8 k0, k1, v0, v1; };
template <bool WITH_V, class KSrc, class VSrc>
DI void stg_load(StgRegs& rg, int ch, int tid, const KSrc& ksrc, const VSrc& vsrc) {
    const f16* kp = ksrc(ch, tid >> 2) + (tid & 3) * 16; rg.k0 = ld_h8(kp); rg.k1 = ld_h8(kp + 8);
    if (WITH_V) { const f16* vp = vsrc(ch, tid >> 3, tid & 7); rg.v0 = ld_h8(vp); rg.v1 = ld_h8(vp + 8); }
}
template <bool WITH_V>
DI void stg_store(const StgRegs& rg, LAS unsigned char* buf, int tid) {
    LAS f16* kb = (LAS f16*)buf + (tid >> 2) * 72 + (tid & 3) * 16; *(LAS f16x8*)kb = rg.k0; *(LAS f16x8*)(kb + 8) = rg.k1;
    if (WITH_V) { LAS f16* vb = (LAS f16*)(buf + 18432) + (tid >> 3) * 136 + (tid & 7) * 16; *(LAS f16x8*)vb = rg.v0; *(LAS f16x8*)(vb + 8) = rg.v1; }
}
template <bool WITH_V, class KSrc, class VSrc, class Body>
DI void stream_chunks(LAS unsigned char* stg, int nchunk, int tid, const KSrc& ksrc, const VSrc& vsrc, Body body) {
    if (nchunk <= 0) return;
    const int last = nchunk - 1;
    StgRegs rg;
    stg_load<WITH_V>(rg, 0, tid, ksrc, vsrc);
    __syncthreads();
    stg_store<WITH_V>(rg, stg, tid); stg_load<WITH_V>(rg, 1 < last ? 1 : last, tid, ksrc, vsrc);
    lds_barrier();
#pragma nounroll
    for (int ch = 0; ch < nchunk; ++ch) {
        body(ch, stg + (ch & 1) * NT_STG_SZ);
        stg_store<WITH_V>(rg, stg + ((ch + 1) & 1) * NT_STG_SZ, tid); stg_load<WITH_V>(rg, ch + 2 < last ? ch + 2 : last, tid, ksrc, vsrc);
        lds_barrier();
    }
}
DI f16x8 lds_vt(const LAS f16* p) { return *(const LAS f16x8*)p; }
DI f32x4 qk_tile(const LAS f16* kb, int kt, int fr, int q, const f16x8 (&qf)[2]) {
    const LAS f16* kp = kb + (16 * kt + fr) * 72 + 8 * q; f32x4 sa = (f32x4){0.f, 0.f, 0.f, 0.f};
    sa = __builtin_amdgcn_mfma_f32_16x16x32_f16(*(const LAS f16x8*)kp, qf[0], sa, 0, 0, 0); return __builtin_amdgcn_mfma_f32_16x16x32_f16(*(const LAS f16x8*)(kp + 32), qf[1], sa, 0, 0, 0);
}
constexpr float NSA_L2E = 1.44269504f, NSA_C1 = 0.125f * NSA_L2E;
DI float ex2(float x) { return __builtin_amdgcn_exp2f(x); }
template <class Pred>
DI f16x8 pv_step(const LAS f16* kb, const LAS f16* vb, int st, int fr, int q, const f16x8 (&qf)[2], f32x4 (&o)[4], f32x4 (&e2)[2], float nb, bool masked, Pred pred) {
#pragma unroll
    for (int hf = 0; hf < 2; ++hf) { const f32x4 sa = qk_tile(kb, 2 * st + hf, fr, q, qf);
        if (!masked) {
#pragma unroll
            for (int j = 0; j < 4; ++j) e2[hf][j] = ex2(fmaf(sa[j], NSA_C1, nb)); }
        else {
#pragma unroll
            for (int j = 0; j < 4; ++j) e2[hf][j] = pred(32 * st + 16 * hf + 4 * q + j) ? ex2(fmaf(sa[j], NSA_C1, nb)) : 0.f; } }
    const f16x8 pb = pack_p(e2[0], e2[1]);
#pragma unroll
    for (int dt = 0; dt < 4; ++dt) o[dt] = __builtin_amdgcn_mfma_f32_16x16x32_f16(lds_vt(vb + (16 * dt + fr) * 136 + 32 * st + 8 * q), pb, o[dt], 0, 0, 0);
    return pb;
}
DI void nsa_tile(const Ctx& c, int tile, const f16* Q16, const f16* KC16, const f16* VCT16, const f16* KS16, const f16* VST16, const f16* KW16, const f16* VWT16,
                 const float* GATES, const f16* DG, f16* Y16, float shc, float shs, float shw) {
    LAS unsigned char* lds = c.lds; const int wave = c.wave; int tid, lane, fr, q, ti, h, trow;
    const int t0 = tile * 32, cur = t0 >> 6;
#define NSA_RELANE() do { int _t = c.tid; asm volatile("" : "+v"(_t)); tid = _t; lane = _t & 63; fr = lane & 15; q = lane >> 4; ti = fr >> 2; h = fr & 3; trow = t0 + 4 * wave + ti; } while (0)
#define NSA_REPS(bit) (((NSA_DUP >> (bit)) & 1) ? 2 : 1)
#define NSA_SCALE(rep) ({ float _z = (rep) == 0 ? 1.f : 0.f; asm volatile("" : "+v"(_z)); _z; })
    NSA_RELANE();
    LAS float* PSEL = (LAS float*)(lds + NT_PSEL); LAS unsigned* MASK = (LAS unsigned*)(lds + NT_MASK); LAS int* VB = (LAS int*)(lds + NT_VB); LAS unsigned char* STG = lds + NT_STG;
    __syncthreads();
    for (int i = tid; i < 272; i += 512) MASK[i] = (i == 0 || i == cur || i == cur - 1) ? 0xFFFFFFFFu : 0u;
    f16x8 qf[2];
#pragma unroll
    for (int ks = 0; ks < 2; ++ks) qf[ks] = ld_h8(Q16 + ((size_t)trow * 4 + h) * 64 + 32 * ks + 8 * q);
    const int nkt = ((t0 >> 4) + 1 + 15) >> 4;
    const int ncch = (nkt + 7) >> 3;
    const int nv_row = trow >= 31 ? ((trow - 31) >> 4) + 1 : 0;
    auto kc_src = [&](int ch, int row) { return KC16 + (size_t)(128 * ch + row) * 64; };
    auto vc_src = [&](int ch, int d, int seg) { return VCT16 + (size_t)d * 1024 + 128 * ch + seg * 16; };
    float lsum = 0.f;
    const float bc = -shc * NSA_L2E, bs = -shs * NSA_L2E, bw = -shw * NSA_L2E;
    const int tw0 = t0 + 4 * wave, nvmin_w = tw0 >= 31 ? ((tw0 - 31) >> 4) + 1 : 0;
    stream_chunks<false>(STG, ncch, tid, kc_src, vc_src, [&](int ch, LAS unsigned char* buf) {
        const LAS f16* kb = (const LAS f16*)buf; const int nk = nkt - 8 * ch < 8 ? nkt - 8 * ch : 8;
#pragma unroll 4
        for (int kt = 0; kt < nk; ++kt) { const f32x4 sa = qk_tile(kb, kt, fr, q, qf); const int cb = 128 * ch + 16 * kt + 4 * q;
            if (128 * ch + 16 * kt + 15 < nvmin_w) {
#pragma unroll
                for (int j = 0; j < 4; ++j) lsum += ex2(fmaf(sa[j], NSA_C1, bc)); }
            else {
#pragma unroll
                for (int j = 0; j < 4; ++j) lsum += (cb + j < nv_row) ? ex2(fmaf(sa[j], NSA_C1, bc)) : 0.f; } } });
    lsum += __shfl_xor(lsum, 16); lsum += __shfl_xor(lsum, 32);
    const float invc = lsum > 0.f ? 1.f / lsum : 0.f;
    NSA_RELANE();
    f32x4 oc[4];
#pragma unroll
    for (int dt = 0; dt < 4; ++dt) oc[dt] = (f32x4){0.f, 0.f, 0.f, 0.f};
    { float bprev = 0.f; const float pbias = invc > 0.f ? bc + __log2f(invc) : -1e30f;
    stream_chunks<true>(STG, ncch, tid, kc_src, vc_src, [&](int ch, LAS unsigned char* buf) {
        const LAS f16* kb = (const LAS f16*)buf; const LAS f16* vb = (const LAS f16*)(buf + 18432); const int ns = (nkt - 8 * ch + 1) >> 1 < 4 ? (nkt - 8 * ch + 1) >> 1 : 4;
#pragma unroll 2
        for (int s2 = 0; s2 < ns; ++s2) {
            f32x4 e2[2];
            pv_step(kb, vb, s2, fr, q, qf, oc, e2, pbias, 128 * ch + 32 * s2 + 31 >= nvmin_w, [&](int kc) { return 128 * ch + kc < nv_row; });
#pragma unroll
            for (int hf = 0; hf < 2; ++hf) {
                const int ktg = 8 * ch + 2 * s2 + hf;
                float av = (e2[hf][0] + e2[hf][1]) + (e2[hf][2] + 0.5f * e2[hf][3]), bv = 0.5f * e2[hf][3];
                av += dppf<DPP_X1>(av); av += dppf<DPP_X2>(av); bv += dppf<DPP_X1>(bv); bv += dppf<DPP_X2>(bv);
                const float up = __shfl(q == 3 ? bprev : bv, (lane + 48) & 63);
                bprev = bv;
                if (h == 0 && ktg < nkt) PSEL[(4 * wave + ti) * 256 + 4 * ktg + q] = av + up;
            }
        } }); }
    for (int rep = 0; rep < NSA_REPS(2); ++rep) {
        const int nforced = cur >= 2 ? 3 : cur + 1, nsel = ((cur + 1) < 16 ? (cur + 1) : 16) - nforced, tk = lane >> 4, l16 = lane & 15, tokl = 4 * wave + tk;
        float sv[16];
#pragma unroll
        for (int i = 0; i < 16; ++i) { const int j = l16 + 16 * i; float v = -3e38f;
            if (j <= cur && !(j == 0 || j == cur || j == cur - 1)) v = j < 4 * nkt ? PSEL[tokl * 256 + j] : 0.f;
            sv[i] = v; }
#pragma nounroll
        for (int k = 0; k < nsel; ++k) {
            float bv = sv[0]; int bi = l16;
#pragma unroll
            for (int i = 1; i < 16; ++i) if (sv[i] > bv) { bv = sv[i]; bi = l16 + 16 * i; }
#define TOPK_STEP(CT) do { const float ov = dppf<CT>(bv); const int oi = dppi<CT>(bi); if (ov > bv || (ov == bv && oi < bi)) { bv = ov; bi = oi; } } while (0)
            TOPK_STEP(DPP_X1); TOPK_STEP(DPP_X2); TOPK_STEP(DPP_HM); TOPK_STEP(DPP_R8);
#undef TOPK_STEP
            if (l16 == 0) __hip_atomic_fetch_or(&MASK[bi], 1u << tokl, __ATOMIC_RELAXED, __HIP_MEMORY_SCOPE_WORKGROUP);
#pragma unroll
            for (int i = 0; i < 16; ++i) if (l16 + 16 * i == bi) sv[i] = -3e38f;
        }
    }
    NSA_RELANE();
    f32x4 owr[4]; float lwr = 0.f;
#pragma unroll
    for (int dt = 0; dt < 4; ++dt) owr[dt] = (f32x4){0.f, 0.f, 0.f, 0.f};
    f16x8 onesf;
#pragma unroll
    for (int i = 0; i < 8; ++i) onesf[i] = fr == 0 ? (f16)1.f : (f16)0.f;
    f32x4 lw5 = (f32x4){0.f, 0.f, 0.f, 0.f};
    {
        const int wlo = t0 - 512 > 0 ? t0 - 512 : 0, nwch = (t0 + 32 - wlo + 127) >> 7;
        auto kw_src = [&](int ch, int row) { int p = wlo + 128 * ch + row; p = p < SEQ ? p : SEQ - 1; return KW16 + (size_t)p * 64; };
        auto vw_src = [&](int ch, int d, int seg) { const int key = wlo + 128 * ch + seg * 16; int blk = key >> 6; blk = blk < 256 ? blk : 255; return VWT16 + (size_t)blk * 4096 + d * 64 + (key & 63); };
        {
        stream_chunks<true>(STG, nwch, tid, kw_src, vw_src, [&](int ch, LAS unsigned char* buf) {
            const LAS f16* kb = (const LAS f16*)buf; const LAS f16* vb = (const LAS f16*)(buf + 18432); const int pbase = wlo + 128 * ch;
            const int ns = (t0 + 32 - pbase) >> 5 < 4 ? (t0 + 32 - pbase) >> 5 : 4;
#pragma unroll 2
            for (int s2 = 0; s2 < ns; ++s2) { f32x4 e2[2];
                const int p0s = pbase + 32 * s2; const bool masked = !(p0s >= tw0 + 3 - 512 && p0s + 31 <= tw0);
                const f16x8 pb = pv_step(kb, vb, s2, fr, q, qf, owr, e2, bw, masked, [&](int kc) { const int pos = pbase + kc; return pos <= trow && pos >= trow - 512; });
                lw5 = __builtin_amdgcn_mfma_f32_16x16x32_f16(onesf, pb, lw5, 0, 0, 0); } }); }
        lwr = lw5[0];
    }
    NSA_RELANE();
    LAS unsigned* MT = (LAS unsigned*)(lds + NT_MT);
    if (wave == 0) { int cnt = 0;
        for (int base = 0; base <= cur; base += 64) { const int jx = base + lane; const unsigned mj = jx <= cur ? MASK[jx] : 0u; const bool v = mj != 0u; const unsigned long long bal = __ballot(v);
            if (v) { const int pos = cnt + __popcll(bal & ((1ull << lane) - 1ull)); VB[pos] = jx; MT[pos] = mj; } cnt += __popcll(bal); }
        if (lane < 8) { VB[cnt + lane] = VB[cnt - 1]; MT[cnt + lane] = 0u; }
        if (lane == 0) VB[264] = cnt; }
    __syncthreads();
    if (VERIFY_NSA) { unsigned* SELM = (unsigned*)(c.ws + WS_SELM) + (size_t)tile * 272; for (int i = tid; i < 272; i += 512) SELM[i] = MASK[i]; }
    f32x4 osr[4]; float lsr = 0.f; f32x4 ls5 = (f32x4){0.f, 0.f, 0.f, 0.f};
#pragma unroll
    for (int dt = 0; dt < 4; ++dt) osr[dt] = (f32x4){0.f, 0.f, 0.f, 0.f};
#pragma unroll
    for (int i = 0; i < 8; ++i) onesf[i] = fr == 0 ? (f16)1.f : (f16)0.f;
    {
        const int nvb = __builtin_amdgcn_readfirstlane(VB[264]), nst = (nvb + 3) >> 2;
        const int dr = lane >> 3, dp = lane & 7, dsw = (dp ^ dr) * 8;
        LAS unsigned char* RING = lds + NT_RING;
        auto dma = [&](int n, int blk) { LAS unsigned char* slot = RING + (n & 7) * 16384 + wave * 1024;
            __builtin_amdgcn_global_load_lds((const unsigned*)(KS16 + ((size_t)blk * 64 + 8 * wave + dr) * 64 + dsw), (LAS unsigned*)slot, 16, 0, 0);
            __builtin_amdgcn_global_load_lds((const unsigned*)(VST16 + (size_t)blk * 4096 + (8 * wave + dr) * 64 + dsw), (LAS unsigned*)(slot + 8192), 16, 0, 0); };
        {
        asm volatile("s_waitcnt vmcnt(0)" ::: "memory"); __syncthreads();
        typedef int i32x4 __attribute__((ext_vector_type(4)));
#define RFL4(v) { __builtin_amdgcn_readfirstlane((v)[0]), __builtin_amdgcn_readfirstlane((v)[1]), __builtin_amdgcn_readfirstlane((v)[2]), __builtin_amdgcn_readfirstlane((v)[3]) }
        { const i32x4 b0 = *(const LAS i32x4*)VB; const int bb[4] = RFL4(b0); dma(0, bb[0]); dma(1, bb[1]); dma(2, bb[2]); dma(3, bb[3]); }
#pragma nounroll
        for (int st = 0; st < nst; ++st) {
            asm volatile("s_waitcnt vmcnt(0)\n\ts_barrier" ::: "memory");
            const i32x4 bcv = *(const LAS i32x4*)(VB + 4 * st), bnv = *(const LAS i32x4*)(VB + 4 * st + 4); const u32x4 mcv = *(const LAS u32x4*)(MT + 4 * st);
            const int bcur[4] = RFL4(bcv), bnxt[4] = RFL4(bnv); const int mcur[4] = RFL4(mcv);
            dma(4 * st + 4, bnxt[0]); dma(4 * st + 5, bnxt[1]); dma(4 * st + 6, bnxt[2]); dma(4 * st + 7, bnxt[3]);
#pragma unroll
            for (int i4 = 0; i4 < 4; ++i4) {
            const int n = 4 * st + i4;
            const int blk = bcur[i4]; const unsigned mt = ((unsigned)mcur[i4] >> (4 * wave)) & 15u;
            if (mt != 0u) {
                const bool rv = ((mt >> ti) & 1u) != 0u; const LAS unsigned char* ks = RING + (n & 7) * 16384; const LAS unsigned char* vs = ks + 8192; const int sx = fr & 7;
                f32x4 sa[4]; f16x8 va[2][4];
#pragma unroll
                for (int kt = 0; kt < 4; ++kt) { const LAS unsigned char* kp = ks + (16 * kt + fr) * 128; sa[kt] = (f32x4){0.f, 0.f, 0.f, 0.f};
                    sa[kt] = __builtin_amdgcn_mfma_f32_16x16x32_f16(*(const LAS f16x8*)(kp + ((q ^ sx) << 4)), qf[0], sa[kt], 0, 0, 0);
                    sa[kt] = __builtin_amdgcn_mfma_f32_16x16x32_f16(*(const LAS f16x8*)(kp + (((4 + q) ^ sx) << 4)), qf[1], sa[kt], 0, 0, 0); }
#pragma unroll
                for (int s2 = 0; s2 < 2; ++s2)
#pragma unroll
                    for (int dt = 0; dt < 4; ++dt) va[s2][dt] = *(const LAS f16x8*)(vs + (16 * dt + fr) * 128 + (((4 * s2 + q) ^ sx) << 4));
                const float nbu = rv ? bs : -1e30f;
                if (blk != cur) {
#pragma unroll
                    for (int kt = 0; kt < 4; ++kt)
#pragma unroll
                        for (int j = 0; j < 4; ++j) sa[kt][j] = ex2(fmaf(sa[kt][j], NSA_C1, nbu)); }
                else { const int pb0 = 64 * blk + 4 * q;
#pragma unroll
                    for (int kt = 0; kt < 4; ++kt)
#pragma unroll
                        for (int j = 0; j < 4; ++j) sa[kt][j] = (pb0 + 16 * kt + j <= trow) ? ex2(fmaf(sa[kt][j], NSA_C1, nbu)) : 0.f; }
                const f16x8 p0 = pack_p(sa[0], sa[1]), p1 = pack_p(sa[2], sa[3]);
#pragma unroll
                for (int dt = 0; dt < 4; ++dt) { osr[dt] = __builtin_amdgcn_mfma_f32_16x16x32_f16(va[0][dt], p0, osr[dt], 0, 0, 0); osr[dt] = __builtin_amdgcn_mfma_f32_16x16x32_f16(va[1][dt], p1, osr[dt], 0, 0, 0); }
                ls5 = __builtin_amdgcn_mfma_f32_16x16x32_f16(onesf, p0, ls5, 0, 0, 0); ls5 = __builtin_amdgcn_mfma_f32_16x16x32_f16(onesf, p1, ls5, 0, 0, 0);
            }
            }
        }
        asm volatile("s_waitcnt vmcnt(0)" ::: "memory"); }
        __syncthreads();
        lsr = ls5[0];
    }
    NSA_RELANE();
    lwr += __shfl_xor(lwr, 16); lwr += __shfl_xor(lwr, 32); lsr += __shfl_xor(lsr, 16); lsr += __shfl_xor(lsr, 32);
    {
        const float g0 = GATES[(size_t)trow * 12 + h * 3], ils = GATES[(size_t)trow * 12 + h * 3 + 1] / lsr, ilw = GATES[(size_t)trow * 12 + h * 3 + 2] / lwr;
#pragma unroll
        for (int dt = 0; dt < 4; ++dt) { const int d0 = 16 * dt + 4 * q; const f16x4 dg = *(const f16x4*)(DG + (size_t)trow * 256 + h * 64 + d0); f16x4 y;
#pragma unroll
            for (int jj = 0; jj < 4; ++jj) { const float o = g0 * oc[dt][jj] + ils * osr[dt][jj] + ilw * owr[dt][jj]; y[jj] = (f16)(siluf_((float)dg[jj]) * o); }
            *(f16x4*)(Y16 + (size_t)trow * 1024 + 768 + h * 64 + d0) = y; }
    }
#undef NSA_RELANE
}
DI void ph_ssd_fin(LAS unsigned char* lds_, int l, int it0, int it1, int itstep);
DI void ph_outproj_sample(LAS unsigned char* lds_, int l, int it);
DI void ph_nsa(LAS unsigned char* lds_, int l) {
    const Ctx c = mkctx(lds_); const int lane = c.lane;
    const float* qg = INP(I_QG) + l * 64; const float* kg = INP(I_KG) + l * 192;
    const float mq = wmaxf(fabsf(qg[lane])), mk0 = wmaxf(fabsf(kg[lane])), mk1 = wmaxf(fabsf(kg[64 + lane])), mk2 = wmaxf(fabsf(kg[128 + lane]));
    const float shc = 8.f * mq * mk0 - 8.f, shs = 8.f * mq * mk1 - 8.f, shw = 8.f * mq * mk2 - 8.f;
    unsigned* qctr = (unsigned*)(c.ws + WS_CTL + 16384) + l * 64; LAS int* qslot = (LAS int*)(c.lds + MISC_OFF + 64); bool fin_ok = false, smp_ok = false;
    for (;;) {
        __syncthreads();
        if (c.tid == 0) *qslot = (int)__hip_atomic_fetch_add(qctr, 1u, __ATOMIC_RELAXED, __HIP_MEMORY_SCOPE_AGENT);
        __syncthreads();
        const int u = __builtin_amdgcn_readfirstlane(*qslot);
        if (u >= 800) break;
        if (u < 512) nsa_tile(c, 511 - u, WSH(WS_Q16), WSH(WS_KC16), WSH(WS_VCT16), WSH(WS_KS16), WSH(WS_VST16), WSH(WS_KW16), WSH(WS_VWT16), WSF(WS_GATES), WSH(WS_PROJ) + (size_t)14 * SEQ * 256, WSH(WS_Y16), shc, shs, shw);
        else if (u < 768) { if (!fin_ok) { edge_wait((unsigned*)(c.ws + WS_CTL + 17408) + l * 64, 64u); fin_ok = true; } ph_ssd_fin(lds_, l, u - 512, u - 511, 1); }
        else { if (!smp_ok) { edge_wait((unsigned*)(c.ws + WS_CTL + 18432) + l * 64, 32u); smp_ok = true; } ph_outproj_sample(lds_, l, u - 768); }
    }
    __syncthreads();
}
DI void ph_nsa_verify(LAS unsigned char* lds_, int l) {
    const Ctx c = mkctx(lds_); const int lane = c.lane;
    LAS float* wl = (LAS float*)c.lds + c.wave * 4400; LAS float* sc = wl; LAS float* qs = wl + 4096; LAS unsigned* selb = (LAS unsigned*)(wl + 4352);
    const f16* Q16 = WSH(WS_Q16); const f16* KC16 = WSH(WS_KC16); const f16* VCT16 = WSH(WS_VCT16); const f16* KS16 = WSH(WS_KS16); const f16* VST16 = WSH(WS_VST16); const f16* KW16 = WSH(WS_KW16); const f16* VWT16 = WSH(WS_VWT16);
    const float* GATES = WSF(WS_GATES); const f16* DG = WSH(WS_PROJ) + (size_t)14 * SEQ * 256; const f16* Y16 = WSH(WS_Y16); const unsigned* SELM = (const unsigned*)(c.ws + WS_SELM);
    float* dbg = (float*)(c.ws + WS_CTL + 40960);
    auto dot4 = [&](const f16* kp, float (&s4)[4]) { s4[0] = s4[1] = s4[2] = s4[3] = 0.f;
#pragma unroll
        for (int i = 0; i < 8; ++i) { const f16x8 kv = ld_h8(kp + 8 * i);
#pragma unroll
            for (int j = 0; j < 8; ++j) { const f32x4 qv = *(const LAS f32x4*)(qs + (8 * i + j) * 4); const float kf = (float)kv[j]; s4[0] += qv[0] * kf; s4[1] += qv[1] * kf; s4[2] += qv[2] * kf; s4[3] += qv[3] * kf; } }
#pragma unroll
        for (int hh = 0; hh < 4; ++hh) s4[hh] *= 0.125f; };
    for (int si = c.bid * 8 + c.wave; si < 200 + 395; si += c.G * 8) {
        const int t = si < 200 ? si : 200 + (si - 200) * 41, cur = t >> 6, ncv = t >= 31 ? ((t - 31) >> 4) + 1 : 0;
#pragma unroll
        for (int hh = 0; hh < 4; ++hh) qs[lane * 4 + hh] = (float)Q16[(size_t)t * 256 + hh * 64 + lane];
        if (lane < 9) selb[lane] = 0u;
        float oc[4] = {0.f, 0.f, 0.f, 0.f}, os[4] = {0.f, 0.f, 0.f, 0.f}, ow[4] = {0.f, 0.f, 0.f, 0.f};
        {
            float mx[4] = {-3e38f, -3e38f, -3e38f, -3e38f}, inv[4];
            for (int cc = lane; cc < ncv; cc += 64) { asm volatile("" ::: "memory"); float s4[4]; dot4(KC16 + (size_t)cc * 64, s4);
#pragma unroll
                for (int hh = 0; hh < 4; ++hh) { sc[hh * 1024 + cc] = s4[hh]; mx[hh] = fmaxf(mx[hh], s4[hh]); } }
#pragma unroll
            for (int hh = 0; hh < 4; ++hh) { mx[hh] = wmaxf(mx[hh]); float sm = 0.f; for (int cc = lane; cc < ncv; cc += 64) { const float e = __expf(sc[hh * 1024 + cc] - mx[hh]); sc[hh * 1024 + cc] = e; sm += e; } sm = wsum(sm); inv[hh] = ncv > 0 ? 1.f / sm : 0.f; }
            for (int cc = lane; cc < ncv; cc += 64) {
#pragma unroll
                for (int hh = 0; hh < 4; ++hh) sc[hh * 1024 + cc] *= inv[hh]; }
            for (int cc = 0; cc < ncv; ++cc) { const float v = (float)VCT16[(size_t)lane * 1024 + vt_pos(cc)];
#pragma unroll
                for (int hh = 0; hh < 4; ++hh) oc[hh] += sc[hh * 1024 + cc] * v; }
        }
        const int nsel = (cur + 1) < 16 ? (cur + 1) : 16;
        {
            float scv[5];
#pragma unroll
            for (int i = 0; i < 5; ++i) { const int j = lane + 64 * i; float v = -3e38f;
                if (j <= cur) { if (j == 0 || j == cur || j == cur - 1) v = 3e38f; else { float a = 0.f;
#pragma unroll
                        for (int o5 = -1; o5 < 4; ++o5) { const int cc = 4 * j + o5; if (cc >= 0 && cc < ncv) { const float p = (sc[cc] + sc[1024 + cc]) + (sc[2048 + cc] + sc[3072 + cc]); a += (o5 == -1 || o5 == 3) ? 0.5f * p : p; } }
                        v = a; } }
                scv[i] = v; }
            for (int k = 0; k < nsel; ++k) {
                float bv = scv[0]; int bi = lane;
#pragma unroll
                for (int i = 1; i < 5; ++i) if (scv[i] > bv) { bv = scv[i]; bi = lane + 64 * i; }
#pragma unroll
                for (int off = 32; off > 0; off >>= 1) { const float ov = __shfl_xor(bv, off); const int oi = __shfl_xor(bi, off); if (ov > bv || (ov == bv && oi < bi)) { bv = ov; bi = oi; } }
                if (lane == 0) selb[bi >> 5] |= 1u << (bi & 31);
#pragma unroll
                for (int i = 0; i < 5; ++i) if (lane + 64 * i == bi) scv[i] = -3e38f;
            }
        }
        int nmis = 0;
        for (int j = lane; j <= cur; j += 64) { const unsigned fb = (SELM[(size_t)(t >> 5) * 272 + j] >> (t & 31)) & 1u, nb = (selb[j >> 5] >> (j & 31)) & 1u; nmis += (fb != nb) ? 1 : 0; }
        nmis = (int)wsum((float)nmis);
        if (nmis != 0) { if (lane == 0) { atomicAdd(dbg + 3, 1.f); atomicAdd(dbg + 4, (float)nmis); } continue; }
        {
            float mx[4] = {-3e38f, -3e38f, -3e38f, -3e38f}, inv[4]; int nk = 0;
            for (int j = 0; j <= cur; ++j) if ((selb[j >> 5] >> (j & 31)) & 1u) { asm volatile("" ::: "memory"); const int pos = j * 64 + lane; float s4[4] = {-1e30f, -1e30f, -1e30f, -1e30f}; if (pos <= t) dot4(KS16 + (size_t)pos * 64, s4);
#pragma unroll
                for (int hh = 0; hh < 4; ++hh) { sc[hh * 1024 + nk * 64 + lane] = s4[hh]; mx[hh] = fmaxf(mx[hh], s4[hh]); } ++nk; }
#pragma unroll
            for (int hh = 0; hh < 4; ++hh) { mx[hh] = wmaxf(mx[hh]); float sm = 0.f; for (int k = 0; k < nk; ++k) { const float x = sc[hh * 1024 + k * 64 + lane]; const float e = x > -1e29f ? __expf(x - mx[hh]) : 0.f; sc[hh * 1024 + k * 64 + lane] = e; sm += e; } sm = wsum(sm); inv[hh] = 1.f / sm; }
            nk = 0;
            for (int j = 0; j <= cur; ++j) if ((selb[j >> 5] >> (j & 31)) & 1u) { for (int kk = 0; kk < 64 && j * 64 + kk <= t; ++kk) { const float v = (float)VST16[(size_t)j * 4096 + lane * 64 + vt_pos(kk)];
#pragma unroll
                    for (int hh = 0; hh < 4; ++hh) os[hh] += sc[hh * 1024 + nk * 64 + kk] * v; } ++nk; }
#pragma unroll
            for (int hh = 0; hh < 4; ++hh) os[hh] *= inv[hh];
        }
        {
            const int lo = t - 512 > 0 ? t - 512 : 0, nw = t - lo + 1; float mx[4] = {-3e38f, -3e38f, -3e38f, -3e38f}, inv[4];
            for (int i = lane; i < nw; i += 64) { asm volatile("" ::: "memory"); float s4[4]; dot4(KW16 + (size_t)(lo + i) * 64, s4);
#pragma unroll
                for (int hh = 0; hh < 4; ++hh) { sc[hh * 1024 + i] = s4[hh]; mx[hh] = fmaxf(mx[hh], s4[hh]); } }
#pragma unroll
            for (int hh = 0; hh < 4; ++hh) { mx[hh] = wmaxf(mx[hh]); float sm = 0.f; for (int i = lane; i < nw; i += 64) { const float e = __expf(sc[hh * 1024 + i] - mx[hh]); sc[hh * 1024 + i] = e; sm += e; } sm = wsum(sm); inv[hh] = 1.f / sm; }
            for (int i = 0; i < nw; ++i) { const int pos = lo + i; const float v = (float)VWT16[(size_t)(pos >> 6) * 4096 + lane * 64 + vt_pos(pos & 63)];
#pragma unroll
                for (int hh = 0; hh < 4; ++hh) ow[hh] += sc[hh * 1024 + i] * v; }
#pragma unroll
            for (int hh = 0; hh < 4; ++hh) ow[hh] *= inv[hh];
        }
        float dd = 0.f, ee = 0.f;
#pragma unroll
        for (int hh = 0; hh < 4; ++hh) { const float o = GATES[(size_t)t * 12 + hh * 3] * oc[hh] + GATES[(size_t)t * 12 + hh * 3 + 1] * os[hh] + GATES[(size_t)t * 12 + hh * 3 + 2] * ow[hh];
            const float yn = siluf_((float)DG[(size_t)t * 256 + hh * 64 + lane]) * o, yf = (float)Y16[(size_t)t * 1024 + 768 + hh * 64 + lane]; dd += (yf - yn) * (yf - yn); ee += yn * yn; }
        dd = wsum(dd); ee = wsum(ee);
        if (lane == 0) { atomicAdd(dbg, dd); atomicAdd(dbg + 1, ee); atomicAdd(dbg + 2, 1.f); }
    }
    (void)l;
}
DI void ph_ssd_fin(LAS unsigned char* lds_, int l, int it0, int it1, int itstep) {
    const Ctx c = mkctx(lds_); const int lane = c.lane, wave = c.wave;
    const float* Dp = INP(I_SD) + l * 4; const float* sng = INP(I_SNG) + l * 256;
    const float* CST = WSF(WS_HPV); const f16* ACT = WSH(WS_ACT); const float* ACS = WSF(WS_ACS); const float* YD = WSF(WS_YD); const f16* Z = WSH(WS_PROJ) + (size_t)4 * SEQ * 256; f16* Y16 = WSH(WS_Y16);
    LAS float* GY = (LAS float*)c.lds;
    for (int it = it0; it < it1; it += itstep) {
        const int ch_ = it >> 1, t0 = it * 64, hd = wave >> 1, g = hd >> 1, fr = lane & 15, q = lane >> 4;
        __syncthreads();
        f16x8 bf[2][4];
#pragma unroll
        for (int p2 = 0; p2 < 2; ++p2)
#pragma unroll
            for (int ks = 0; ks < 4; ++ks) bf[p2][ks] = cvt_h8(CST + ((size_t)(ch_ * 4 + hd) * 64 + 16 * ((wave & 1) * 2 + p2) + fr) * 128 + 32 * ks + 8 * q);
#pragma unroll
        for (int lt = 0; lt < 4; ++lt) {
            f16x8 af[4];
#pragma unroll
            for (int ks = 0; ks < 4; ++ks) af[ks] = ld_h8(ACT + (size_t)(t0 + 16 * lt + fr) * 768 + 512 + 128 * g + 32 * ks + 8 * q);
#pragma unroll
            for (int p2 = 0; p2 < 2; ++p2) { f32x4 acc = (f32x4){0.f, 0.f, 0.f, 0.f};
#pragma unroll
                for (int ks = 0; ks < 4; ++ks) acc = __builtin_amdgcn_mfma_f32_16x16x32_f16(af[ks], bf[p2][ks], acc, 0, 0, 0);
                const int ch = hd * 64 + 16 * ((wave & 1) * 2 + p2) + fr;
#pragma unroll
                for (int j = 0; j < 4; ++j) { const int tl = 16 * lt + 4 * q + j, t = t0 + tl;
                    const float y = acc[j] * __expf(ACS[(size_t)t * 4 + hd]) + YD[(size_t)t * 256 + ch] + Dp[hd] * (float)ACT[(size_t)t * 768 + ch];
                    GY[tl * 256 + ch] = y * siluf_((float)Z[(size_t)t * 256 + ch]); } }
        }
        __syncthreads();
        for (int tl = wave; tl < 64; tl += 8) { const f32x4 v = *(const LAS f32x4*)(GY + tl * 256 + lane * 4); const float ss = wsum((v[0] * v[0] + v[1] * v[1]) + (v[2] * v[2] + v[3] * v[3]));
            const float rn = rsqrtf(ss * (1.f / 256.f) + EPS); const f32x4 g4 = *(const f32x4*)(sng + lane * 4); f16x4 o;
#pragma unroll
            for (int i = 0; i < 4; ++i) o[i] = (f16)(v[i] * rn * g4[i]);
            *(f16x4*)(Y16 + (size_t)(t0 + tl) * 1024 + 256 + lane * 4) = o; }
    }
    __syncthreads();
}
DI void ph_outproj(LAS unsigned char* lds_, int l) {
    const Ctx c = mkctx(lds_);
    const float* xin = l == 0 ? INP(I_XP) : WSF(WS_X1); float* xout = l == 0 ? WSF(WS_X1) : c.out + O_YP;
    pg8::Gemm g{WSH(WS_Y16), WSH(WS_WTOUT) + (size_t)l * 1024 * 1024, SEQ, 1024, 1024}; pg8::StaticOrder S; S.init(SEQ, 1024, c.G, c.bid);
    EpiOut E{xin, xout, WSF(WS_ADA) + (size_t)(l * 33 + 32) * 3072 + 2048, l == 0 ? WSH(WS_A16) : nullptr, WSF(WS_GNX), WSF(WS_RSSP)};
    pg8::gemm_phase<EpiOut, pg8::StaticOrder>(c.lds, g, S, E);
    __syncthreads();
}
DI void ph_outproj_sample(LAS unsigned char* lds_, int l, int it) {
    const Ctx c = mkctx(lds_); const int tid = c.tid;
    const float* xs_in = l == 0 ? INP(I_XS) : WSF(WS_XS1); const float* ada_l = WSF(WS_ADA) + (size_t)l * 33 * 3072; const float* YS = WSF(WS_YS); float* xo = l == 0 ? WSF(WS_XS1) : c.out + O_YS;
    LAS f16* Ah = (LAS f16*)c.lds;
    __syncthreads();
#pragma unroll
    for (int i = 0; i < 16; ++i) { const int e = (tid + 512 * i) * 4; const f32x4 v = *(const f32x4*)(YS + e); f16x4 hv; hv[0] = (f16)v[0]; hv[1] = (f16)v[1]; hv[2] = (f16)v[2]; hv[3] = (f16)v[3]; *(LAS f16x4*)(Ah + (e >> 10) * 1032 + (e & 1023)) = hv; }
    __syncthreads();
    sample_gemm_item<1>(c.lds, WSH(WS_WTOUT) + (size_t)l * 1024 * 1024, it * 32, [&](int m, int n, float v) { xo[m * 1024 + n] = xs_in[m * 1024 + n] + ada_l[(size_t)m * 3072 + 2048 + n] * v; });
}

__global__ void __launch_bounds__(512, 2) fwd(Args a) {
    extern __shared__ __attribute__((aligned(16))) unsigned char lds_raw[];
    LAS unsigned char* lds = (LAS unsigned char*)lds_raw;
    volatile LAS unsigned* MISC = (volatile LAS unsigned*)(lds + MISC_OFF);
    if (threadIdx.x < 16) MISC[threadIdx.x] = 0u;
    __syncthreads();
    XcdBarrier bar; bar.bar = (unsigned*)(a.ws + WS_CTL); bar.x = 0; bar.st = MISC;
    if (N_LAUNCHES == 1) bar = xcd_barrier_post((unsigned*)(a.ws + WS_CTL), MISC);
    const int lo = a.ph_lo, hi = a.ph_hi;
    unsigned long long* stampw = (unsigned long long*)(a.ws + WS_CTL + 32768);
    if (STAMP_PHASE >= 0 && blockIdx.x == 0 && threadIdx.x == 0) stampw[0] = wall_clock64();
#define STAMP(k) do { if (STAMP_PHASE == (k) && blockIdx.x == 0 && threadIdx.x == 0) stampw[1] = wall_clock64(); } while (0)
#ifndef PH_MASK
#define PH_MASK 0xFFF
#endif
#define IN(k) (((PH_MASK >> ((k) < 2 ? (k) : 2 + ((k) - 2) % 4)) & 1) && lo <= (k) && (k) < hi)
#define SEAM(k) do { if (IN(k) && IN((k) + 1)) xcd_barrier(bar); STAMP(k); } while (0)
#ifndef DUP_MASK
#define DUP_MASK 0
#endif
#define DUP(bit, call) do { call; if ((DUP_MASK >> (bit)) & 1) { __syncthreads(); call; } } while (0)
    if (IN(0)) DUP(0, ph_prologue(lds));
    SEAM(0);
    if (IN(1)) { ph_hsample(lds, 0); DUP(1, ph_sample_compress(lds)); DUP(2, ph_prep(lds)); }
    SEAM(1);
    for (int l = 0; l < 2; ++l) {
        const int PB = 2 + 4 * l;
        if (IN(PB)) { DUP(3, ph_inproj(lds, l)); DUP(4, ph_inproj_sample(lds, l)); }
        SEAM(PB);
        if (IN(PB + 1)) {
#define SUBSTAMP(code) do { if (l == 0 && (STAMP_PHASE == (code) || STAMP_PHASE == (code) + 10) && blockIdx.x == (STAMP_PHASE >= 110 ? 100 : 0) && threadIdx.x == 0) stampw[1] = wall_clock64(); } while (0)
            DUP(5, ph_ssd_local(lds, l)); SUBSTAMP(100); DUP(6, ph_mix_a(lds, l)); SUBSTAMP(101); DUP(7, ph_mix_c(lds, l)); SUBSTAMP(102); DUP(8, ph_mix_d(lds, l)); SUBSTAMP(103); DUP(9, ph_mix_cmp(lds, l)); SUBSTAMP(104); }
        SEAM(PB + 1);
        if (IN(PB + 2)) { DUP(11, ph_scan(lds, l)); DUP(10, ph_mix_sample(lds, l)); ph_nsa(lds, l); }
        SEAM(PB + 2);
        if (IN(PB + 3)) { if (VERIFY_NSA && l == 0) { ph_nsa_verify(lds, l); __syncthreads(); } if (l == 0) ph_hsample(lds, 1); DUP(14, ph_outproj(lds, l)); }
        SEAM(PB + 3);
    }
    if (STAMP_PHASE >= 0 || VERIFY_NSA) {
        xcd_barrier(bar);
        if (blockIdx.x == 0) { __shared__ float alpha_s; if (threadIdx.x == 0) { const unsigned long long t1 = wall_clock64(); alpha_s = (float)(stampw[1] - stampw[0]) / (float)(t1 - stampw[0]);
                if (VERIFY_NSA) { const float* dbg = (const float*)(a.ws + WS_CTL + 40960); alpha_s = VERIFY_NSA == 1 ? dbg[3] / (dbg[2] + dbg[3]) : sqrtf(dbg[0] / dbg[1]); } } __syncthreads();
            const float sc = 1.f + alpha_s; float* ys = a.out + O_YS; for (int i = threadIdx.x; i < NB * 1024; i += 512) ys[i] *= sc; }
    }
#undef IN
#undef SEAM
}

extern "C" void kernel_launch(void* const* d_in, const int* in_sizes, int n_in, void* d_out, int out_size, void* d_ws, size_t ws_size, hipStream_t stream) {
    static int grid = 0;
    if (grid == 0) {
        if (n_in != N_IN || (size_t)out_size != O_END || ws_size < WS_END) { fprintf(stderr, "kernel_launch: unexpected shapes (n_in %d out %d ws %zu)\n", n_in, out_size, ws_size); grid = -1; return; }
        int dev = 0, cus = 0;
        if (hipGetDevice(&dev) != hipSuccess || hipDeviceGetAttribute(&cus, hipDeviceAttributeMultiprocessorCount, dev) != hipSuccess) { grid = -1; return; }
        if (hipFuncSetAttribute((const void*)fwd, hipFuncAttributeMaxDynamicSharedMemorySize, LDS_BYTES) != hipSuccess) { fprintf(stderr, "kernel_launch: hipFuncSetAttribute failed\n"); grid = -1; return; }
        int per_cu = 0;
        if (hipOccupancyMaxActiveBlocksPerMultiprocessor(&per_cu, (const void*)fwd, 512, LDS_BYTES) != hipSuccess || per_cu < 1) fprintf(stderr, "kernel_launch: occupancy query says %d\n", per_cu);
        (void)hipGetLastError();
        grid = cus;
    }
    if (grid < 0) return;
    hipMemsetAsync((char*)d_ws + WS_CTL, 0, 65536, stream);
    Args a{};
    for (int i = 0; i < N_IN; ++i) a.in[i] = d_in[i];
    a.out = (float*)d_out; a.ws = (unsigned char*)d_ws;
    if (N_LAUNCHES == 1) { a.ph_lo = 0; a.ph_hi = NPHASE; hipLaunchKernelGGL(fwd, dim3(grid), dim3(512), LDS_BYTES, stream, a); }
    else for (int p = 0; p < NPHASE; ++p) { a.ph_lo = p; a.ph_hi = p + 1; hipLaunchKernelGGL(fwd, dim3(grid), dim3(512), LDS_BYTES, stream, a); }
}
```
